# Optimizing an MI355X kernel written in HIP

```python
import jax, jax.numpy as jnp
from jax import lax
import numpy as np

D_MODEL = 2048
BATCH = 1
SEQ = 16384
DEPTH = 1

HEAD_DIM = 128
ROPE_THETA = 10000.0
Q_BLOCK = 128
LN_EPS = 1e-5
DEEPNORM_ALPHA = (2 * DEPTH) ** 0.25
DEEPNORM_BETA = (8 * DEPTH) ** -0.25
FFN_HIDDEN = 256 * ((8 * D_MODEL // 3 + 255) // 256)

NSA_HEADS = 8
NSA_KV_GROUPS = 2
NSA_HPG = NSA_HEADS // NSA_KV_GROUPS
CMP_BLOCK = 32
CMP_STRIDE = 16
CMP_HIDDEN = 2 * HEAD_DIM
SEL_BLOCK = 64
SEL_TOPK = 16
WIN = 512

DIL_PATTERNS = ((128, 1), (512, 4), (2048, 16))
N_DIL = len(DIL_PATTERNS)
DIL_HPG = 4
DIL_HEADS = N_DIL * DIL_HPG

NSA_Q_W = NSA_HEADS * HEAD_DIM
NSA_KV_W = NSA_KV_GROUPS * HEAD_DIM
NSA_GATE_W = NSA_HEADS * 3
DIL_W = DIL_HEADS * HEAD_DIM
IN_SIZES = (NSA_Q_W, NSA_KV_W, NSA_KV_W, NSA_KV_W, NSA_KV_W, NSA_KV_W, NSA_KV_W, NSA_GATE_W,
            DIL_W, DIL_W, DIL_W, D_MODEL, D_MODEL)
IN_WIDTH = sum(IN_SIZES)
BRANCH_A_W = NSA_HEADS * HEAD_DIM
BRANCH_B_W = DIL_HPG * HEAD_DIM

kernel_name = "hybrid_nsa_dilated_macaron_deepnorm"


def _layer_norm(x, g, b):
    xf = x.astype(jnp.float32)
    mu = jnp.mean(xf, -1, keepdims=True)
    var = jnp.mean(jnp.square(xf - mu), -1, keepdims=True)
    y = (xf - mu) * lax.rsqrt(var + LN_EPS) * g.astype(jnp.float32) + b.astype(jnp.float32)
    return y.astype(x.dtype)


def _swiglu(x, w_gate, w_up, w_down):
    return (jax.nn.silu(x @ w_gate) * (x @ w_up)) @ w_down


def _rope(x):
    s = x.shape[-2]
    inv = ROPE_THETA ** (-jnp.arange(0, HEAD_DIM, 2, dtype=jnp.float32) / HEAD_DIM)
    ang = jnp.arange(s, dtype=jnp.float32)[:, None] * inv[None, :]
    cos, sin = jnp.cos(ang), jnp.sin(ang)
    x1, x2 = jnp.split(x.astype(jnp.float32), 2, axis=-1)
    return jnp.concatenate([x1 * cos - x2 * sin, x2 * cos + x1 * sin], -1).astype(x.dtype)


def _masked_softmax(s, mask):
    s = jnp.where(mask, s, -jnp.inf)
    m = jnp.max(s, -1, keepdims=True)
    m = jnp.where(jnp.isfinite(m), m, 0.0)
    e = jnp.exp(s - m)
    d = jnp.sum(e, -1, keepdims=True)
    return e / jnp.where(d > 0, d, 1.0)


def _compress(t, pos, w1, w2):
    s = t.shape[2]
    n_cmp = (s - CMP_BLOCK) // CMP_STRIDE + 1
    idx = jnp.arange(n_cmp)[:, None] * CMP_STRIDE + jnp.arange(CMP_BLOCK)[None, :]
    blk = t[:, :, idx] + pos.astype(t.dtype)
    blk = blk.reshape(blk.shape[:3] + (CMP_BLOCK * HEAD_DIM,))
    return jax.nn.gelu(blk @ w1) @ w2


def _nsa(q, k_cmp, v_cmp, k_slc, v_slc, k_win, v_win, gate_logits,
         ck_pos, ck_w1, ck_w2, cv_pos, cv_w1, cv_w2):
    b, _, s, _ = q.shape
    G, HPG, dh = NSA_KV_GROUPS, NSA_HPG, HEAD_DIM
    scale = dh ** -0.5
    q_plain = q.reshape(b, G, HPG, s, dh)
    q_rot = _rope(q).reshape(b, G, HPG, s, dh)
    kc = _compress(k_cmp, ck_pos, ck_w1, ck_w2)
    vc = _compress(v_cmp, cv_pos, cv_w1, cv_w2)
    n_cmp = kc.shape[2]
    n_sel = s // SEL_BLOCK
    top = min(SEL_TOPK, n_sel)
    cmp_end = jnp.arange(n_cmp) * CMP_STRIDE + CMP_BLOCK - 1
    c0 = jnp.arange(n_cmp) * CMP_STRIDE
    s0 = jnp.arange(n_sel) * SEL_BLOCK
    overlap = jnp.clip(jnp.minimum(c0[:, None] + CMP_BLOCK, s0[None, :] + SEL_BLOCK)
                       - jnp.maximum(c0[:, None], s0[None, :]), 0)
    cmp_to_sel = overlap.astype(jnp.float32) / CMP_STRIDE
    ks = _rope(k_slc).reshape(b, G, n_sel, SEL_BLOCK, dh)
    vs = v_slc.reshape(b, G, n_sel, SEL_BLOCK, dh)
    pad = ((0, 0), (0, 0), (WIN, 0), (0, 0))
    kw = jnp.pad(_rope(k_win), pad)
    vw = jnp.pad(v_win, pad)
    gates = jax.nn.sigmoid(gate_logits.astype(jnp.float32)).reshape(b, s, G, HPG, 3).transpose(0, 2, 3, 1, 4)
    bi = jnp.arange(b)[:, None, None, None]
    gi = jnp.arange(G)[None, :, None, None]
    blk_id = jnp.arange(n_sel)

    def block(i):
        start = i * Q_BLOCK
        t = start + jnp.arange(Q_BLOCK)
        qc = lax.dynamic_slice_in_dim(q_plain, start, Q_BLOCK, axis=3)
        qr = lax.dynamic_slice_in_dim(q_rot, start, Q_BLOCK, axis=3)
        sc = jnp.einsum('bghqd,bgnd->bghqn', qc, kc).astype(jnp.float32) * scale
        pc = _masked_softmax(sc, cmp_end[None, :] <= t[:, None])
        o_cmp = jnp.einsum('bghqn,bgnd->bghqd', pc.astype(vc.dtype), vc)
        imp = jnp.einsum('bghqn,nj->bgqj', pc, cmp_to_sel)
        cur = t // SEL_BLOCK
        valid = blk_id[None, :] <= cur[:, None]
        forced = (blk_id[None, :] == 0) | (blk_id[None, :] == cur[:, None]) | (blk_id[None, :] == cur[:, None] - 1)
        imp = jnp.where(valid, jnp.where(forced, jnp.inf, imp), -jnp.inf)
        _, top_idx = lax.top_k(imp, top)
        k_sel = ks[bi, gi, top_idx].reshape(b, G, Q_BLOCK, top * SEL_BLOCK, dh)
        v_sel = vs[bi, gi, top_idx].reshape(b, G, Q_BLOCK, top * SEL_BLOCK, dh)
        kpos = (top_idx[..., None] * SEL_BLOCK + jnp.arange(SEL_BLOCK)).reshape(b, G, Q_BLOCK, top * SEL_BLOCK)
        sel_mask = kpos <= t[:, None]
        ssl = jnp.einsum('bghqd,bgqkd->bghqk', qr, k_sel).astype(jnp.float32) * scale
        ps = _masked_softmax(ssl, sel_mask[:, :, None])
        o_slc = jnp.einsum('bghqk,bgqkd->bghqd', ps.astype(v_sel.dtype), v_sel)
        kwb = lax.dynamic_slice_in_dim(kw, start, Q_BLOCK + WIN, axis=2)
        vwb = lax.dynamic_slice_in_dim(vw, start, Q_BLOCK + WIN, axis=2)
        wpos = start - WIN + jnp.arange(Q_BLOCK + WIN)
        wmask = (wpos[None, :] >= 0) & (wpos[None, :] <= t[:, None]) & (wpos[None, :] > t[:, None] - WIN)
        sw = jnp.einsum('bghqd,bgkd->bghqk', qr, kwb).astype(jnp.float32) * scale
        pw = _masked_softmax(sw, wmask)
        o_win = jnp.einsum('bghqk,bgkd->bghqd', pw.astype(vwb.dtype), vwb)
        g = lax.dynamic_slice_in_dim(gates, start, Q_BLOCK, axis=3)
        o = g[..., 0:1] * o_cmp + g[..., 1:2] * o_slc + g[..., 2:3] * o_win
        return o.astype(q.dtype)

    out = lax.map(block, jnp.arange(s // Q_BLOCK))
    return out.transpose(1, 0, 4, 2, 3, 5).reshape(b, s, NSA_HEADS * dh)


def _dilated(q, k, v):
    b, _, s, dh = q.shape
    scale = dh ** -0.5
    qg = q.reshape(b, N_DIL, DIL_HPG, s, dh)
    kg = k.reshape(b, N_DIL, DIL_HPG, s, dh)
    vg = v.reshape(b, N_DIL, DIL_HPG, s, dh)

    def block(i):
        start = i * Q_BLOCK
        t = start + jnp.arange(Q_BLOCK)
        qb = lax.dynamic_slice_in_dim(qg, start, Q_BLOCK, axis=3)
        outs, lses = [], []
        for gidx, (win, dil) in enumerate(DIL_PATTERNS):
            n_keys = win // dil + 1
            kpos = t[:, None] - dil * jnp.arange(n_keys)[None, :]
            idx = jnp.maximum(kpos, 0)
            kk = kg[:, gidx][:, :, idx]
            vv = vg[:, gidx][:, :, idx]
            sc = jnp.einsum('bhqd,bhqkd->bhqk', qb[:, gidx], kk).astype(jnp.float32) * scale
            sc = jnp.where(kpos >= 0, sc, -jnp.inf)
            lse = jax.nn.logsumexp(sc, axis=-1)
            p = jnp.exp(sc - lse[..., None])
            outs.append(jnp.einsum('bhqk,bhqkd->bhqd', p.astype(vv.dtype), vv).astype(jnp.float32))
            lses.append(lse)
        w = jax.nn.softmax(jnp.stack(lses), axis=0)
        o = jnp.sum(w[..., None] * jnp.stack(outs), axis=0)
        return o.astype(q.dtype)

    out = lax.map(block, jnp.arange(s // Q_BLOCK))
    return out.transpose(1, 0, 3, 2, 4).reshape(b, s, DIL_HPG * dh)


def _mixer(h, w_in, ck_pos, ck_w1, ck_w2, cv_pos, cv_w1, cv_w2, w_branch_a, w_branch_b, w_o):
    b, s, _ = h.shape
    proj = h @ w_in
    points, acc = [], 0
    for size in IN_SIZES[:-1]:
        acc += size
        points.append(acc)
    (q_a, kc, vc, ksl, vsl, kwn, vwn, g_nsa, q_b, k_b, v_b, g_a, g_b) = jnp.split(proj, points, axis=-1)

    def heads(t, n):
        return t.reshape(b, s, n, HEAD_DIM).transpose(0, 2, 1, 3)

    y_a = _nsa(heads(q_a, NSA_HEADS), heads(kc, NSA_KV_GROUPS), heads(vc, NSA_KV_GROUPS),
               heads(ksl, NSA_KV_GROUPS), heads(vsl, NSA_KV_GROUPS), heads(kwn, NSA_KV_GROUPS),
               heads(vwn, NSA_KV_GROUPS), g_nsa, ck_pos, ck_w1, ck_w2, cv_pos, cv_w1, cv_w2) @ w_branch_a
    y_b = _dilated(_rope(heads(q_b, DIL_HEADS)), _rope(heads(k_b, DIL_HEADS)), heads(v_b, DIL_HEADS)) @ w_branch_b
    merged = jax.nn.sigmoid(g_a) * y_a + jax.nn.sigmoid(g_b) * y_b
    return merged @ w_o


def setup_inputs(seed: int = 0) -> dict:
    key = jax.random.key(seed)
    ks = jax.random.split(key, 26)
    L = DEPTH

    def nrm(k, shape, scale):
        return jax.random.normal(k, shape, jnp.float32) * scale

    def gain(k):
        return 1.0 + nrm(k, (L, D_MODEL), 0.02)

    return {
        "x": nrm(ks[0], (BATCH, SEQ, D_MODEL), 1.0),
        "ffn1_w_gate": nrm(ks[1], (L, D_MODEL, FFN_HIDDEN), D_MODEL ** -0.5),
        "ffn1_w_up": nrm(ks[2], (L, D_MODEL, FFN_HIDDEN), D_MODEL ** -0.5),
        "ffn1_w_down": nrm(ks[3], (L, FFN_HIDDEN, D_MODEL), DEEPNORM_BETA * FFN_HIDDEN ** -0.5),
        "ln_ffn1_g": gain(ks[4]),
        "ln_ffn1_b": nrm(ks[5], (L, D_MODEL), 0.02),
        "w_in": nrm(ks[6], (L, D_MODEL, IN_WIDTH), D_MODEL ** -0.5),
        "cmp_k_pos": nrm(ks[7], (L, CMP_BLOCK, HEAD_DIM), 0.1),
        "cmp_k_w1": nrm(ks[8], (L, CMP_BLOCK * HEAD_DIM, CMP_HIDDEN), (CMP_BLOCK * HEAD_DIM) ** -0.5),
        "cmp_k_w2": nrm(ks[9], (L, CMP_HIDDEN, HEAD_DIM), CMP_HIDDEN ** -0.5),
        "cmp_v_pos": nrm(ks[10], (L, CMP_BLOCK, HEAD_DIM), 0.1),
        "cmp_v_w1": nrm(ks[11], (L, CMP_BLOCK * HEAD_DIM, CMP_HIDDEN), (CMP_BLOCK * HEAD_DIM) ** -0.5),
        "cmp_v_w2": nrm(ks[12], (L, CMP_HIDDEN, HEAD_DIM), CMP_HIDDEN ** -0.5),
        "w_branch_a": nrm(ks[13], (L, BRANCH_A_W, D_MODEL), BRANCH_A_W ** -0.5),
        "w_branch_b": nrm(ks[14], (L, BRANCH_B_W, D_MODEL), BRANCH_B_W ** -0.5),
        "w_o": nrm(ks[15], (L, D_MODEL, D_MODEL), DEEPNORM_BETA * D_MODEL ** -0.5),
        "ln_mix_g": gain(ks[16]),
        "ln_mix_b": nrm(ks[17], (L, D_MODEL), 0.02),
        "ffn2_w_gate": nrm(ks[18], (L, D_MODEL, FFN_HIDDEN), D_MODEL ** -0.5),
        "ffn2_w_up": nrm(ks[19], (L, D_MODEL, FFN_HIDDEN), D_MODEL ** -0.5),
        "ffn2_w_down": nrm(ks[20], (L, FFN_HIDDEN, D_MODEL), DEEPNORM_BETA * FFN_HIDDEN ** -0.5),
        "ln_ffn2_g": gain(ks[21]),
        "ln_ffn2_b": nrm(ks[22], (L, D_MODEL), 0.02),
    }


def reference(x, ffn1_w_gate, ffn1_w_up, ffn1_w_down, ln_ffn1_g, ln_ffn1_b, w_in,
              cmp_k_pos, cmp_k_w1, cmp_k_w2, cmp_v_pos, cmp_v_w1, cmp_v_w2,
              w_branch_a, w_branch_b, w_o, ln_mix_g, ln_mix_b,
              ffn2_w_gate, ffn2_w_up, ffn2_w_down, ln_ffn2_g, ln_ffn2_b):
    h = x
    for l in range(DEPTH):
        h = _layer_norm(DEEPNORM_ALPHA * h + 0.5 * _swiglu(h, ffn1_w_gate[l], ffn1_w_up[l], ffn1_w_down[l]),
                        ln_ffn1_g[l], ln_ffn1_b[l])
        mix = _mixer(h, w_in[l], cmp_k_pos[l], cmp_k_w1[l], cmp_k_w2[l], cmp_v_pos[l], cmp_v_w1[l], cmp_v_w2[l],
                     w_branch_a[l], w_branch_b[l], w_o[l])
        h = _layer_norm(DEEPNORM_ALPHA * h + mix, ln_mix_g[l], ln_mix_b[l])
        h = _layer_norm(DEEPNORM_ALPHA * h + 0.5 * _swiglu(h, ffn2_w_gate[l], ffn2_w_up[l], ffn2_w_down[l]),
                        ln_ffn2_g[l], ln_ffn2_b[l])
    return h
```

```cpp
#include <hip/hip_runtime.h>
#include <hip/hip_cooperative_groups.h>
#include <cstdio>
#include <cstdint>
#include <cmath>
namespace cg = cooperative_groups;

#define LAS __attribute__((address_space(3)))
typedef unsigned short bf16_t;
typedef short bf16x8 __attribute__((ext_vector_type(8)));
typedef short s16x4 __attribute__((ext_vector_type(4)));
typedef float f32x4 __attribute__((ext_vector_type(4)));
typedef float f32x2 __attribute__((ext_vector_type(2)));
typedef unsigned u32x4 __attribute__((ext_vector_type(4)));
typedef unsigned u32x2 __attribute__((ext_vector_type(2)));

constexpr int S = 16384, DM = 2048, FF = 5632, NGU = 2 * FF, NWIN = 11520, WIN_SRC = 11288, PLD = 7168, NOLD = 1536;
constexpr float ALPHA = 1.189207115002721f;
constexpr float LN_EPS = 1e-5f;
constexpr float SL2 = 0.08838834764831845f * 1.4426950408889634f;
constexpr int PC_QA = 0, PC_KC = 1024, PC_VC = 1280, PC_KSL = 1536, PC_VSL = 1792, PC_KWN = 2048, PC_VWN = 2304, PC_QB = 2560, PC_KB = 4096, PC_VB = 5632;
constexpr size_t MiB = 1u << 20;
constexpr size_t WS_WAB = 1 * MiB, WS_WO = 13 * MiB, WS_CW1K = 21 * MiB, WS_CW1V = 23 * MiB, WS_CW2K = 25 * MiB, WS_CW2V = 25 * MiB + 65536, WS_CBIAS = 25 * MiB + 131072;
constexpr size_t WS_KC = 26 * MiB, WS_VC = 26 * MiB + 524288, WS_GN = 27 * MiB;
constexpr size_t WS_HF = 32 * MiB, WS_HB = 160 * MiB, WS_BIG = 224 * MiB;
constexpr size_t WS_GU = WS_BIG, WS_DN = WS_BIG + 44 * MiB, WS_ACT = WS_BIG + 66 * MiB;
constexpr size_t WS_PROJ = WS_BIG, WS_ROPE = WS_BIG + 224 * MiB;
constexpr size_t WS_WIN = 466 * MiB, WS_NSAOUT = 466 * MiB, WS_END = 514 * MiB;

constexpr int VROW = 272, VBUF_BYTES = 32 * VROW;
constexpr int IMP_LD = 260;
constexpr int WAVE_LDS = VBUF_BYTES + 4 * IMP_LD * 4 + 256;
constexpr int LDS_BYTES = 147456;

typedef __bf16 bf16x2_t __attribute__((ext_vector_type(2)));
__device__ __forceinline__ unsigned cvt_pk_bf16(float lo, float hi) { f32x2 v = {lo, hi}; bf16x2_t b = __builtin_convertvector(v, bf16x2_t); return __builtin_bit_cast(unsigned, b); }
__device__ __forceinline__ float bf2f(unsigned short b) { return __uint_as_float(((unsigned)b) << 16); }
__device__ __forceinline__ float bflo(unsigned w) { return __uint_as_float(w << 16); }
__device__ __forceinline__ float bfhi(unsigned w) { return __uint_as_float(w & 0xffff0000u); }
__device__ __forceinline__ float fsigmoid(float x) { return __builtin_amdgcn_rcpf(1.f + __expf(-x)); }
__device__ __forceinline__ float wave_sum(float v) {
#pragma unroll
    for (int o = 1; o < 64; o <<= 1) v += __shfl_xor(v, o);
    return v;
}
__device__ __forceinline__ u32x4 pack8(const f32x4 a, const f32x4 b) { u32x4 w; w.x = cvt_pk_bf16(a[0], a[1]); w.y = cvt_pk_bf16(a[2], a[3]); w.z = cvt_pk_bf16(b[0], b[1]); w.w = cvt_pk_bf16(b[2], b[3]); return w; }

namespace pg8 {
constexpr int BM = 256, BK = 64, HALF = 128, HTB = HALF * BK * 2, STAGE_BYTES = 8 * HTB, NXCD = 8, WGM = 8;
__host__ __device__ __forceinline__ int lds_byte(int r, int c) { const int st = (r >> 4) * 2 + (c >> 5), rr = r & 15, cc = c & 31, ob = rr * 64 + cc * 2; return st * 1024 + (ob ^ (((ob >> 9) & 1) << 5)); }
__host__ __device__ __forceinline__ void stage_rc(int b, int& R, int& C) { const int st = b / 1024, sb = b % 1024, swz = sb ^ (((sb >> 9) & 1) << 5); R = (st >> 1) * 16 + swz / 64; C = (st & 1) * 32 + (swz % 64) / 2; }
__host__ __device__ __forceinline__ int perm32(int rho) { const int n = rho >> 4, i = rho & 15; return 8 * (i >> 2) + 4 * n + (i & 3); }
struct Unit { int pm, pn; };
struct Gemm { const bf16_t* A; const bf16_t* Bt; int M, N, K, lda, ldb; };
struct StaticOrder {
    int nM, nN, nwg, G, c;
    __device__ void init(int M, int N, int G_, int c_) { nM = M / BM; nN = N / BM; nwg = nM * nN; G = G_; c = c_; }
    __device__ bool next(int i, Unit& u) const {
        const long L = (long)i * G + c; if (L >= nwg) return false;
        int wgid = (int)L; { const int q = nwg / NXCD, r = nwg % NXCD, xcd = wgid % NXCD, off = wgid / NXCD; wgid = (xcd < r ? xcd * (q + 1) : r * (q + 1) + (xcd - r) * q) + off; }
        const int nig = WGM * nN, gid = wgid / nig, fm = gid * WGM, gsz = (nM - fm) < WGM ? (nM - fm) : WGM;
        u.pm = fm + ((wgid % nig) % gsz); u.pn = (wgid % nig) / gsz; return true;
    }
};
typedef f32x4 Acc[2][2][4][2];

template <class Epi>
__device__ __forceinline__ void gemm_phase(LAS unsigned char* lds, const Gemm g, const StaticOrder& S_, const Epi& E) {
    const int tid = threadIdx.x, wid = __builtin_amdgcn_readfirstlane(tid >> 6), lane = tid & 63, wr = wid >> 2, wc = wid & 3, fr = lane & 15, fq = lane >> 4;
    const int K = g.K, nt = K / BK;
    unsigned voffA[2], voffB[2];
#pragma unroll
    for (int i = 0; i < 2; ++i) { int R, C; stage_rc(tid * 16 + i * 8192, R, C); const int Rb = Epi::PERM ? ((R & ~31) + perm32(R & 31)) : R;
        voffA[i] = (unsigned)(R * g.lda + C) * 2u; voffB[i] = (unsigned)(Rb * g.ldb + C) * 2u; }
    const size_t kstep = (size_t)(BK * 2);
    const size_t hstepA = (size_t)HALF * g.lda * 2, hstepB = (size_t)HALF * g.ldb * 2;
    const size_t tstepA = 2 * hstepA, tstepB = 2 * hstepB;
    const unsigned ldsw = (unsigned)wid * 1024u;
    const int aoff = lds_byte(wr * 64 + fr, fq * 8), boff = lds_byte(wc * 32 + fr, fq * 8);
#define PG8_SA(b, h) (((b) * 2 + (h)) * HTB)
#define PG8_SB(b, h) ((4 + (b) * 2 + (h)) * HTB)
#define PG8_STAGE(bufoff, gbase, voff) do { _Pragma("unroll") for (int _i = 0; _i < 2; ++_i) \
        __builtin_amdgcn_global_load_lds((const unsigned*)((const char*)(gbase) + (voff)[_i]), (LAS unsigned*)(lds + (bufoff) + ldsw + _i * 8192), 16, 0, 0); } while (0)
#define PG8_LDA(dst, b, h) do { _Pragma("unroll") for (int m = 0; m < 4; ++m) _Pragma("unroll") for (int k = 0; k < 2; ++k) dst[m][k] = *(const LAS bf16x8*)(lds + PG8_SA(b, h) + aoff + m * 2048 + k * 1024); } while (0)
#define PG8_LDB(dst, b, h) do { _Pragma("unroll") for (int n = 0; n < 2; ++n) _Pragma("unroll") for (int k = 0; k < 2; ++k) dst[n][k] = *(const LAS bf16x8*)(lds + PG8_SB(b, h) + boff + n * 2048 + k * 1024); } while (0)
#define PG8_MMA(ai, bj, At, Bt) do { __builtin_amdgcn_s_setprio(1); _Pragma("unroll") for (int m = 0; m < 4; ++m) _Pragma("unroll") for (int n = 0; n < 2; ++n) _Pragma("unroll") for (int k = 0; k < 2; ++k) \
        acc[ai][bj][m][n] = __builtin_amdgcn_mfma_f32_16x16x32_bf16(Bt[n][k], At[m][k], acc[ai][bj][m][n], 0, 0, 0); __builtin_amdgcn_s_setprio(0); } while (0)
#define PG8_WAIT_V(n) asm volatile("s_waitcnt vmcnt(" #n ")" ::: "memory")
#define PG8_WAIT_L(n) asm volatile("s_waitcnt lgkmcnt(" #n ")" ::: "memory")
#define PG8_BAR __builtin_amdgcn_s_barrier()
#define PG8_SCHED __builtin_amdgcn_sched_barrier(0)
    Unit cur, nxt; int ui = 0;
    if (!S_.next(0, cur)) return;
    Acc acc;
#pragma unroll
    for (int a = 0; a < 2; ++a)
#pragma unroll
        for (int b = 0; b < 2; ++b)
#pragma unroll
            for (int m = 0; m < 4; ++m)
#pragma unroll
                for (int n = 0; n < 2; ++n) acc[a][b][m][n] = (f32x4){0.f, 0.f, 0.f, 0.f};
    bf16x8 At[4][2], B0[2][2], B1[2][2];
    const char* cA = (const char*)g.A + (size_t)cur.pm * tstepA; const char* cB = (const char*)g.Bt + (size_t)cur.pn * tstepB;
    PG8_STAGE(PG8_SB(0, 0), cB, voffB); PG8_STAGE(PG8_SB(0, 1), cB + hstepB, voffB); PG8_STAGE(PG8_SA(0, 0), cA, voffA); PG8_STAGE(PG8_SA(0, 1), cA + hstepA, voffA);
    if (wr == 1) PG8_BAR;
    PG8_WAIT_V(2); PG8_BAR;
    PG8_STAGE(PG8_SB(1, 0), cB + kstep, voffB); PG8_STAGE(PG8_SA(1, 0), cA + kstep, voffA); PG8_STAGE(PG8_SB(1, 1), cB + hstepB + kstep, voffB);
    PG8_WAIT_V(6); PG8_BAR;
    for (;;) {
        const bool has_next = S_.next(ui + 1, nxt);
        const char* nA = has_next ? (const char*)g.A + (size_t)nxt.pm * tstepA : cA; const char* nB = has_next ? (const char*)g.Bt + (size_t)nxt.pn * tstepB : cB;
        for (int t = 0; t < nt; t += 2) {
            const bool last = (t == nt - 2);
            const char* a1 = cA + (size_t)(t + 1) * kstep;
            const char* a2 = last ? nA : cA + (size_t)(t + 2) * kstep; const char* b2 = last ? nB : cB + (size_t)(t + 2) * kstep;
            const char* a3 = a2 + kstep; const char* b3 = b2 + kstep;
            PG8_LDB(B0, 0, 0); PG8_LDB(B1, 0, 1); PG8_SCHED; PG8_LDA(At, 0, 0); PG8_STAGE(PG8_SA(1, 1), a1 + hstepA, voffA);
            PG8_WAIT_V(8); PG8_WAIT_L(0); PG8_BAR; PG8_MMA(0, 0, At, B0); PG8_MMA(0, 1, At, B1); PG8_BAR; PG8_SCHED;
            PG8_LDA(At, 0, 1); PG8_STAGE(PG8_SB(0, 0), b2, voffB); PG8_STAGE(PG8_SB(0, 1), b2 + hstepB, voffB); PG8_STAGE(PG8_SA(0, 0), a2, voffA);
            PG8_WAIT_V(8); PG8_WAIT_L(0); PG8_BAR; PG8_MMA(1, 0, At, B0); PG8_MMA(1, 1, At, B1); PG8_BAR; PG8_SCHED;
            PG8_LDB(B0, 1, 0); PG8_LDB(B1, 1, 1); PG8_SCHED; PG8_LDA(At, 1, 0); PG8_STAGE(PG8_SA(0, 1), a2 + hstepA, voffA);
            PG8_WAIT_V(8); PG8_WAIT_L(0); PG8_BAR; PG8_MMA(0, 0, At, B0); PG8_MMA(0, 1, At, B1); PG8_BAR; PG8_SCHED;
            PG8_LDA(At, 1, 1); PG8_STAGE(PG8_SB(1, 0), b3, voffB); PG8_STAGE(PG8_SB(1, 1), b3 + hstepB, voffB); PG8_STAGE(PG8_SA(1, 0), a3, voffA);
            PG8_WAIT_V(8); PG8_WAIT_L(0); PG8_BAR; PG8_MMA(1, 0, At, B0); PG8_MMA(1, 1, At, B1); PG8_BAR; PG8_SCHED;
        }
        if (wr == 0) PG8_BAR;
        E(acc, cur, wr, wc, fr, fq);
        if (!has_next) break;
#pragma unroll
        for (int a = 0; a < 2; ++a)
#pragma unroll
            for (int b = 0; b < 2; ++b)
#pragma unroll
                for (int m = 0; m < 4; ++m)
#pragma unroll
                    for (int n = 0; n < 2; ++n) acc[a][b][m][n] = (f32x4){0.f, 0.f, 0.f, 0.f};
        cur = nxt; cA = nA; cB = nB; ++ui;
        if (wr == 1) PG8_BAR;
    }
    PG8_WAIT_V(0);
    PG8_BAR;
#undef PG8_SA
#undef PG8_SB
#undef PG8_STAGE
#undef PG8_LDA
#undef PG8_LDB
#undef PG8_MMA
#undef PG8_WAIT_V
#undef PG8_WAIT_L
#undef PG8_BAR
#undef PG8_SCHED
}
}

struct EpiSwiglu {
    static constexpr bool PERM = true;
    bf16_t* O;
    __device__ __forceinline__ void operator()(const pg8::Acc& acc, const pg8::Unit& u, int wr, int wc, int fr, int fq) const {
        const int row0 = u.pm * 256 + wr * 64 + fr, col0 = u.pn * 128 + wc * 32 + 8 * fq;
#pragma unroll
        for (int ai = 0; ai < 2; ++ai)
#pragma unroll
            for (int m = 0; m < 4; ++m) {
                f32x4 v[2];
#pragma unroll
                for (int n = 0; n < 2; ++n)
#pragma unroll
                    for (int e = 0; e < 4; ++e) { const float gt = acc[ai][0][m][n][e], up = acc[ai][1][m][n][e]; v[n][e] = gt * fsigmoid(gt) * up; }
                *(u32x4*)(O + (size_t)(row0 + ai * 128 + m * 16) * FF + col0) = pack8(v[0], v[1]);
            }
    }
};
struct EpiResF32 {
    static constexpr bool PERM = false;
    const float* res; float* out; float a, b;
    __device__ __forceinline__ void operator()(const pg8::Acc& acc, const pg8::Unit& u, int wr, int wc, int fr, int fq) const {
        const int row0 = u.pm * 256 + wr * 64 + fr, col0 = u.pn * 256 + wc * 32 + 4 * fq;
#pragma unroll
        for (int ai = 0; ai < 2; ++ai)
#pragma unroll
            for (int m = 0; m < 4; ++m) {
                const size_t off = (size_t)(row0 + ai * 128 + m * 16) * DM + col0;
#pragma unroll
                for (int bj = 0; bj < 2; ++bj)
#pragma unroll
                    for (int n = 0; n < 2; ++n) { const f32x4 r = *(const f32x4*)(res + off + bj * 128 + n * 16); *(f32x4*)(out + off + bj * 128 + n * 16) = r * a + acc[ai][bj][m][n] * b; }
            }
    }
};
struct EpiWin {
    static constexpr bool PERM = true;
    bf16_t* proj; bf16_t* sigg; bf16_t* gn; const float* cs; const float* sn;
    __device__ __forceinline__ void operator()(const pg8::Acc& acc, const pg8::Unit& u, int wr, int wc, int fr, int fq) const {
        const int tile = u.pn, row0 = u.pm * 256 + wr * 64 + fr, cw = wc * 32 + 8 * fq;
        if (tile < 28) {
            const bool rope = (tile == 6) | (tile == 8) | (tile >= 10 && tile < 22);
            if (!rope) {
#pragma unroll
                for (int ai = 0; ai < 2; ++ai)
#pragma unroll
                    for (int m = 0; m < 4; ++m)
#pragma unroll
                        for (int bj = 0; bj < 2; ++bj)
                            *(u32x4*)(proj + (size_t)(row0 + ai * 128 + m * 16) * PLD + tile * 256 + bj * 128 + cw) = pack8(acc[ai][bj][m][0], acc[ai][bj][m][1]);
            } else {
                const int head = cw >> 6, d = cw & 63;
#pragma unroll
                for (int ai = 0; ai < 2; ++ai)
#pragma unroll
                    for (int m = 0; m < 4; ++m) {
                        const int row = row0 + ai * 128 + m * 16;
                        f32x4 o1[2], o2[2];
#pragma unroll
                        for (int n = 0; n < 2; ++n) {
                            const f32x4 c = *(const f32x4*)(cs + (size_t)row * 64 + d + 4 * n), s = *(const f32x4*)(sn + (size_t)row * 64 + d + 4 * n);
                            const f32x4 x1 = acc[ai][0][m][n], x2 = acc[ai][1][m][n];
                            o1[n] = x1 * c - x2 * s; o2[n] = x2 * c + x1 * s;
                        }
                        bf16_t* p = proj + (size_t)row * PLD + tile * 256 + head * 128 + d;
                        *(u32x4*)p = pack8(o1[0], o1[1]); *(u32x4*)(p + 64) = pack8(o2[0], o2[1]);
                    }
            }
        } else if (tile < 44) {
#pragma unroll
            for (int ai = 0; ai < 2; ++ai)
#pragma unroll
                for (int m = 0; m < 4; ++m)
#pragma unroll
                    for (int bj = 0; bj < 2; ++bj) {
                        f32x4 v[2];
#pragma unroll
                        for (int n = 0; n < 2; ++n)
#pragma unroll
                            for (int e = 0; e < 4; ++e) v[n][e] = fsigmoid(acc[ai][bj][m][n][e]);
                        *(u32x4*)(sigg + (size_t)(row0 + ai * 128 + m * 16) * 4096 + (tile - 28) * 256 + bj * 128 + cw) = pack8(v[0], v[1]);
                    }
        } else {
            if (wc == 0) {
#pragma unroll
                for (int ai = 0; ai < 2; ++ai)
#pragma unroll
                    for (int m = 0; m < 4; ++m) {
                        f32x4 v[2];
#pragma unroll
                        for (int n = 0; n < 2; ++n)
#pragma unroll
                            for (int e = 0; e < 4; ++e) v[n][e] = fsigmoid(acc[ai][0][m][n][e]);
                        *(u32x4*)(gn + (size_t)(row0 + ai * 128 + m * 16) * 32 + cw) = pack8(v[0], v[1]);
                    }
            }
        }
    }
};
struct EpiMerge {
    static constexpr bool PERM = true;
    const bf16_t* sigg; bf16_t* O;
    __device__ __forceinline__ void operator()(const pg8::Acc& acc, const pg8::Unit& u, int wr, int wc, int fr, int fq) const {
        const int row0 = u.pm * 256 + wr * 64 + fr, col0 = u.pn * 128 + wc * 32 + 8 * fq;
#pragma unroll
        for (int ai = 0; ai < 2; ++ai)
#pragma unroll
            for (int m = 0; m < 4; ++m) {
                const int row = row0 + ai * 128 + m * 16;
                const u32x4 ga = *(const u32x4*)(sigg + (size_t)row * 4096 + col0), gb = *(const u32x4*)(sigg + (size_t)row * 4096 + 2048 + col0);
                f32x4 v[2];
#pragma unroll
                for (int n = 0; n < 2; ++n) {
                    const unsigned a0 = n ? ga.z : ga.x, a1 = n ? ga.w : ga.y, b0 = n ? gb.z : gb.x, b1 = n ? gb.w : gb.y;
                    const f32x4 ya = acc[ai][0][m][n], yb = acc[ai][1][m][n];
                    v[n][0] = bflo(a0) * ya[0] + bflo(b0) * yb[0]; v[n][1] = bfhi(a0) * ya[1] + bfhi(b0) * yb[1];
                    v[n][2] = bflo(a1) * ya[2] + bflo(b1) * yb[2]; v[n][3] = bfhi(a1) * ya[3] + bfhi(b1) * yb[3];
                }
                *(u32x4*)(O + (size_t)row * DM + col0) = pack8(v[0], v[1]);
            }
    }
};

__device__ __forceinline__ void tr_item(const float* W, int ldw, int k0, int scol0, int nvalid, bf16_t* WT, int ldt, int drow0, int dk0, LAS float* scr, int lane) {
    const int c = lane & 31;
#pragma unroll 8
    for (int i = 0; i < 32; ++i) { const int kk = 2 * i + (lane >> 5); scr[kk * 33 + c] = (c < nvalid) ? W[(size_t)(k0 + kk) * ldw + scol0 + c] : 0.f; }
    asm volatile("s_waitcnt lgkmcnt(0)" ::: "memory");
    const int c8 = lane & 7;
#pragma unroll
    for (int j = 0; j < 4; ++j) { const int n = (lane >> 3) + 8 * j; const LAS float* s = scr + (8 * c8) * 33 + n;
        u32x4 o; o.x = cvt_pk_bf16(s[0 * 33], s[1 * 33]); o.y = cvt_pk_bf16(s[2 * 33], s[3 * 33]); o.z = cvt_pk_bf16(s[4 * 33], s[5 * 33]); o.w = cvt_pk_bf16(s[6 * 33], s[7 * 33]);
        *(u32x4*)(WT + (size_t)(drow0 + n) * ldt + dk0 + 8 * c8) = o; }
    asm volatile("s_waitcnt lgkmcnt(0)" ::: "memory");
}
__device__ __forceinline__ int win_src_col(int r) {
    if (r >= WIN_SRC) return -1;
    if (r >= 11264) return 2560 + (r - 11264);
    const int tile = r >> 8; int j = r & 255;
    const bool rope = (tile == 6) | (tile == 8) | (tile >= 10 && tile < 22);
    if (rope) { const int q = j >> 6, d = j & 63; j = (q & 1) * 128 + (q >> 1) * 64 + d; }
    const int c = tile * 256 + j;
    return c < 2560 ? c : c + 24;
}
__device__ __forceinline__ void conv_ffn(const float* Wg, const float* Wu, const float* Wd, bf16_t* GU, bf16_t* DN, LAS float* scr, int gw, int ngw, int lane) {
    constexpr int I_G = 32 * 176;
    for (int it = gw; it < 2 * I_G; it += ngw) { const int which = it / I_G, r = it % I_G, kb = r / 176, nb = r % 176, c0 = nb * 32;
        tr_item(which ? Wu : Wg, FF, kb * 64, c0, 32, GU, DM, 256 * (c0 >> 7) + (c0 & 127) + which * 128, kb * 64, scr, lane); }
    for (int it = gw; it < 88 * 64; it += ngw) { const int kb = it / 64, nb = it % 64; tr_item(Wd, DM, kb * 64, nb * 32, 32, DN, FF, nb * 32, kb * 64, scr, lane); }
}
__device__ __forceinline__ void ln_rows(const float* in, float* outf, bf16_t* outb, const float* g, const float* b, int gw, int ngw, int lane) {
    f32x4 gv[8], bv[8];
#pragma unroll
    for (int j = 0; j < 8; ++j) { gv[j] = *(const f32x4*)(g + 4 * (lane + 64 * j)); bv[j] = *(const f32x4*)(b + 4 * (lane + 64 * j)); }
    for (int row = gw; row < S; row += ngw) {
        const float* xr = in + (size_t)row * DM; f32x4 v[8]; float s = 0.f;
#pragma unroll
        for (int j = 0; j < 8; ++j) { v[j] = *(const f32x4*)(xr + 4 * (lane + 64 * j)); s += (v[j][0] + v[j][1]) + (v[j][2] + v[j][3]); }
        const float mean = wave_sum(s) * (1.f / DM); float s2 = 0.f;
#pragma unroll
        for (int j = 0; j < 8; ++j) { v[j] = v[j] - mean; s2 += (v[j][0] * v[j][0] + v[j][1] * v[j][1]) + (v[j][2] * v[j][2] + v[j][3] * v[j][3]); }
        const float rstd = 1.f / sqrtf(wave_sum(s2) * (1.f / DM) + LN_EPS);
#pragma unroll
        for (int j = 0; j < 8; ++j) { const f32x4 o = v[j] * rstd * gv[j] + bv[j];
            *(f32x4*)(outf + (size_t)row * DM + 4 * (lane + 64 * j)) = o;
            if (outb) { u32x2 w; w.x = cvt_pk_bf16(o[0], o[1]); w.y = cvt_pk_bf16(o[2], o[3]); *(u32x2*)(outb + (size_t)row * DM + 4 * (lane + 64 * j)) = w; } }
    }
}

struct AState { float m, l; f32x4 o[8]; };
__device__ __forceinline__ void astate_init(AState& s) { s.m = -1e30f; s.l = 0.f;
#pragma unroll
    for (int i = 0; i < 8; ++i) s.o[i] = (f32x4){0.f, 0.f, 0.f, 0.f}; }
__device__ __forceinline__ int clampi(int v, int lo, int hi) { return v < lo ? lo : (v > hi ? hi : v); }

template <int MODE>
__device__ __forceinline__ void attn_step(const bf16x8 (&qf)[4], const bf16_t* __restrict__ Kb, const bf16_t* __restrict__ Vb, int ld,
                                          int pos0, int dpos, int posmax, int lo, int hi, AState& st, LAS unsigned char* vbuf, int lane,
                                          LAS float* imp = nullptr, int impbase = 0) {
    const int l16 = lane & 15, kq = lane >> 4;
    bf16x8 kf[2][4];
#pragma unroll
    for (int T = 0; T < 2; ++T) { const int p = clampi(pos0 + dpos * (16 * T + l16), 0, posmax); const bf16_t* kp = Kb + (size_t)p * ld + 8 * kq;
#pragma unroll
        for (int s = 0; s < 4; ++s) kf[T][s] = *(const bf16x8*)(kp + 32 * s); }
    if (MODE != 1) {
#pragma unroll
        for (int i = 0; i < 8; ++i) { const int p = clampi(pos0 + dpos * (4 * i + kq), 0, posmax);
            const u32x4 v = *(const u32x4*)(Vb + (size_t)p * ld + 8 * l16);
            *(LAS u32x4*)(vbuf + (4 * i + kq) * VROW + 16 * l16) = v; }
    }
    f32x4 sa[2] = {(f32x4){0.f, 0.f, 0.f, 0.f}, (f32x4){0.f, 0.f, 0.f, 0.f}};
#pragma unroll
    for (int T = 0; T < 2; ++T)
#pragma unroll
        for (int s = 0; s < 4; ++s) sa[T] = __builtin_amdgcn_mfma_f32_16x16x32_bf16(kf[T][s], qf[s], sa[T], 0, 0, 0);
    float sc[8]; bool vd[8]; float mx = -1e30f;
#pragma unroll
    for (int T = 0; T < 2; ++T)
#pragma unroll
        for (int r = 0; r < 4; ++r) { const int p = pos0 + dpos * (16 * T + 4 * kq + r); const bool v = (p >= lo) & (p <= hi); const float x = sa[T][r] * SL2;
            sc[4 * T + r] = x; vd[4 * T + r] = v; mx = v ? fmaxf(mx, x) : mx; }
    float p[8];
    if (MODE == 2) {
#pragma unroll
        for (int i = 0; i < 8; ++i) p[i] = vd[i] ? __builtin_amdgcn_exp2f(sc[i] - st.m) * st.l : 0.f;
#pragma unroll
        for (int T = 0; T < 2; ++T) {
            float x = 2.f * (p[4 * T] + p[4 * T + 1] + p[4 * T + 2]) + p[4 * T + 3], y = p[4 * T + 3];
            x += __shfl_xor(x, 1); x += __shfl_xor(x, 2); y += __shfl_xor(y, 1); y += __shfl_xor(y, 2);
            if ((l16 & 3) == 0) { const int a = (pos0 >> 2) + 4 * T + kq; LAS float* ip = imp + (l16 >> 2) * IMP_LD + a;
                ip[0] += x;
                asm volatile("s_waitcnt lgkmcnt(0)" ::: "memory");
                ip[1] += y; }
            asm volatile("s_waitcnt lgkmcnt(0)" ::: "memory");
        }
    } else {
        mx = fmaxf(mx, __shfl_xor(mx, 16)); mx = fmaxf(mx, __shfl_xor(mx, 32));
        const float mn = fmaxf(st.m, mx), alpha = __builtin_amdgcn_exp2f(st.m - mn); st.m = mn;
        float ps = 0.f;
#pragma unroll
        for (int i = 0; i < 8; ++i) { p[i] = vd[i] ? __builtin_amdgcn_exp2f(sc[i] - mn) : 0.f; ps += p[i]; }
        st.l = st.l * alpha + ps;
        if (MODE == 0) {
#pragma unroll
            for (int i = 0; i < 8; ++i) st.o[i] = st.o[i] * alpha;
        }
    }
    if (MODE != 1) {
        u32x4 pw; pw.x = cvt_pk_bf16(p[0], p[1]); pw.y = cvt_pk_bf16(p[2], p[3]); pw.z = cvt_pk_bf16(p[4], p[5]); pw.w = cvt_pk_bf16(p[6], p[7]);
        const bf16x8 pf = __builtin_bit_cast(bf16x8, pw);
        const unsigned addr = (unsigned)(uintptr_t)(vbuf) + (4 * kq + (l16 >> 2)) * VROW + (l16 & 3) * 8;
        s16x4 a[16];
        asm volatile("s_waitcnt lgkmcnt(0)\n\t"
                     "ds_read_b64_tr_b16 %0, %16 offset:0\n\t"    "ds_read_b64_tr_b16 %1, %16 offset:32\n\t"
                     "ds_read_b64_tr_b16 %2, %16 offset:64\n\t"   "ds_read_b64_tr_b16 %3, %16 offset:96\n\t"
                     "ds_read_b64_tr_b16 %4, %16 offset:128\n\t"  "ds_read_b64_tr_b16 %5, %16 offset:160\n\t"
                     "ds_read_b64_tr_b16 %6, %16 offset:192\n\t"  "ds_read_b64_tr_b16 %7, %16 offset:224\n\t"
                     "ds_read_b64_tr_b16 %8, %16 offset:4352\n\t" "ds_read_b64_tr_b16 %9, %16 offset:4384\n\t"
                     "ds_read_b64_tr_b16 %10, %16 offset:4416\n\t" "ds_read_b64_tr_b16 %11, %16 offset:4448\n\t"
                     "ds_read_b64_tr_b16 %12, %16 offset:4480\n\t" "ds_read_b64_tr_b16 %13, %16 offset:4512\n\t"
                     "ds_read_b64_tr_b16 %14, %16 offset:4544\n\t" "ds_read_b64_tr_b16 %15, %16 offset:4576\n\t"
                     "s_waitcnt lgkmcnt(0)"
                     : "=&v"(a[0]), "=&v"(a[1]), "=&v"(a[2]), "=&v"(a[3]), "=&v"(a[4]), "=&v"(a[5]), "=&v"(a[6]), "=&v"(a[7]),
                       "=&v"(a[8]), "=&v"(a[9]), "=&v"(a[10]), "=&v"(a[11]), "=&v"(a[12]), "=&v"(a[13]), "=&v"(a[14]), "=&v"(a[15])
                     : "v"(addr) : "memory");
#pragma unroll
        for (int db = 0; db < 8; ++db) {
            bf16x8 af; af[0] = a[db][0]; af[1] = a[db][1]; af[2] = a[db][2]; af[3] = a[db][3]; af[4] = a[db + 8][0]; af[5] = a[db + 8][1]; af[6] = a[db + 8][2]; af[7] = a[db + 8][3];
            st.o[db] = __builtin_amdgcn_mfma_f32_16x16x32_bf16(af, pf, st.o[db], 0, 0, 0);
        }
    }
}
__device__ __forceinline__ float quad_total(float v) { v += __shfl_xor(v, 16); v += __shfl_xor(v, 32); return v; }

__device__ __forceinline__ void dilated_unit(int unit, const bf16_t* proj, bf16_t* nsaout, LAS unsigned char* vbuf, int lane) {
    const int l16 = lane & 15, kq = lane >> 4;
    const int hg = unit & 3, r16 = (unit >> 2) & 15, ut = unit >> 6;
    const int t0 = r16 + 256 * ut, tc = t0 + 16 * l16;
    AState st; astate_init(st);
#pragma unroll 1
    for (int pt = 0; pt < 3; ++pt) {
        const int d = pt == 0 ? 1 : (pt == 1 ? 4 : 16), head = 4 * pt + hg;
        const bf16_t* qrow = proj + (size_t)tc * PLD + PC_QB + head * 128 + 8 * kq;
        bf16x8 qf[4];
#pragma unroll
        for (int s = 0; s < 4; ++s) qf[s] = *(const bf16x8*)(qrow + 32 * s);
        const int nk = 129 + 240 / d, nsteps = (nk + 31) >> 5;
        const int lo = tc - 128 * d < 0 ? 0 : tc - 128 * d, hi = tc;
        const int base = t0 - 128 * d;
#pragma unroll 1
        for (int sp = 0; sp < nsteps; ++sp) {
            const int pos0 = base + d * 32 * sp;
            if (pos0 + d * 31 < 0) continue;
            attn_step<0>(qf, proj + PC_KB + head * 128, proj + PC_VB + head * 128, PLD, pos0, d, S - 1, lo, hi, st, vbuf, lane);
        }
    }
    const float lt = quad_total(st.l), inv = lt > 0.f ? 1.f / lt : 0.f;
    bf16_t* op = nsaout + (size_t)tc * NOLD + 1024 + hg * 128 + 4 * kq;
#pragma unroll
    for (int db = 0; db < 8; ++db) { const f32x4 o = st.o[db] * inv; u32x2 w; w.x = cvt_pk_bf16(o[0], o[1]); w.y = cvt_pk_bf16(o[2], o[3]); *(u32x2*)(op + 16 * db) = w; }
}

__device__ __forceinline__ void compress_unit(int unit, const bf16_t* proj, const bf16_t* w1t, const bf16_t* w2t, const float* bias, bf16_t* outc, LAS unsigned char* scr, int lane) {
    const int l16 = lane & 15, kq = lane >> 4;
    const int rt = unit & 63, g = (unit >> 6) & 1, kv = unit >> 7;
    const bf16_t* raw = proj + (kv ? PC_VC : PC_KC) + 128 * g;
    const int n = 16 * rt + l16;
    f32x4 acc[16];
#pragma unroll
    for (int i = 0; i < 16; ++i) acc[i] = (f32x4){0.f, 0.f, 0.f, 0.f};
#pragma unroll 2
    for (int s = 0; s < 128; ++s) {
        const int tok = clampi(16 * n + (s >> 2), 0, S - 1);
        const bf16x8 af = *(const bf16x8*)(raw + (size_t)tok * PLD + (s & 3) * 32 + 8 * kq);
#pragma unroll
        for (int ct = 0; ct < 16; ++ct) { const bf16x8 bfr = *(const bf16x8*)(w1t + (size_t)(16 * ct + l16) * 4096 + 32 * s + 8 * kq);
            acc[ct] = __builtin_amdgcn_mfma_f32_16x16x32_bf16(af, bfr, acc[ct], 0, 0, 0); }
    }
#pragma unroll
    for (int ct = 0; ct < 16; ++ct) { const float bb = bias[16 * ct + l16];
#pragma unroll
        for (int r = 0; r < 4; ++r) { const float x = acc[ct][r] + bb; const float u2 = 1.5957691216f * (x + 0.044715f * x * x * x); const float gl = x * fsigmoid(u2);
            *(LAS bf16_t*)(scr + (4 * kq + r) * 528 + (16 * ct + l16) * 2) = (bf16_t)(cvt_pk_bf16(gl, 0.f) & 0xffffu); } }
    asm volatile("s_waitcnt lgkmcnt(0)" ::: "memory");
    f32x4 o2[8];
#pragma unroll
    for (int i = 0; i < 8; ++i) o2[i] = (f32x4){0.f, 0.f, 0.f, 0.f};
#pragma unroll
    for (int s = 0; s < 8; ++s) {
        const bf16x8 af = *(const LAS bf16x8*)(scr + l16 * 528 + (32 * s + 8 * kq) * 2);
#pragma unroll
        for (int dt = 0; dt < 8; ++dt) { const bf16x8 bfr = *(const bf16x8*)(w2t + (size_t)(16 * dt + l16) * 256 + 32 * s + 8 * kq);
            o2[dt] = __builtin_amdgcn_mfma_f32_16x16x32_bf16(af, bfr, o2[dt], 0, 0, 0); }
    }
    asm volatile("s_waitcnt lgkmcnt(0)" ::: "memory");
#pragma unroll
    for (int dt = 0; dt < 8; ++dt)
#pragma unroll
        for (int r = 0; r < 4; ++r) { const int nn = 16 * rt + 4 * kq + r; if (nn < 1023) outc[((size_t)g * 1024 + nn) * 128 + 16 * dt + l16] = (bf16_t)(cvt_pk_bf16(o2[dt][r], 0.f) & 0xffffu); }
}

__device__ __forceinline__ void nsa_unit(int unit, const bf16_t* proj, const bf16_t* kc, const bf16_t* vc, const bf16_t* gn, const float* cs, const float* sn,
                                         bf16_t* nsaout, LAS unsigned char* wl, int lane) {
    const int l16 = lane & 15, kq = lane >> 4;
    const int g = unit & 1, tb = unit >> 1, t0 = 4 * tb, qi = l16 >> 2, h = l16 & 3, tc = t0 + qi, head = 4 * g + h;
    LAS unsigned char* vbuf = wl; LAS float* imp = (LAS float*)(wl + VBUF_BYTES); LAS int* sel = (LAS int*)(wl + VBUF_BYTES + 4 * IMP_LD * 4);
    bf16x8 qp[4], qr[4];
    { const bf16_t* qrow = proj + (size_t)tc * PLD + PC_QA + head * 128 + 8 * kq;
#pragma unroll
        for (int s = 0; s < 4; ++s) qp[s] = *(const bf16x8*)(qrow + 32 * s);
#pragma unroll
        for (int s = 0; s < 2; ++s) {
            const int d = 32 * s + 8 * kq; f32x4 c[2], sv[2];
            c[0] = *(const f32x4*)(cs + (size_t)tc * 64 + d); c[1] = *(const f32x4*)(cs + (size_t)tc * 64 + d + 4);
            sv[0] = *(const f32x4*)(sn + (size_t)tc * 64 + d); sv[1] = *(const f32x4*)(sn + (size_t)tc * 64 + d + 4);
            float o1[8], o2[8];
#pragma unroll
            for (int j = 0; j < 8; ++j) { const float x1 = bf2f((unsigned short)qp[s][j]), x2 = bf2f((unsigned short)qp[s + 2][j]), cc = c[j >> 2][j & 3], ss = sv[j >> 2][j & 3];
                o1[j] = x1 * cc - x2 * ss; o2[j] = x2 * cc + x1 * ss; }
            u32x4 w1, w2; w1.x = cvt_pk_bf16(o1[0], o1[1]); w1.y = cvt_pk_bf16(o1[2], o1[3]); w1.z = cvt_pk_bf16(o1[4], o1[5]); w1.w = cvt_pk_bf16(o1[6], o1[7]);
            w2.x = cvt_pk_bf16(o2[0], o2[1]); w2.y = cvt_pk_bf16(o2[2], o2[3]); w2.z = cvt_pk_bf16(o2[4], o2[5]); w2.w = cvt_pk_bf16(o2[6], o2[7]);
            qr[s] = __builtin_bit_cast(bf16x8, w1); qr[s + 2] = __builtin_bit_cast(bf16x8, w2);
        } }
    const float g0 = bf2f(gn[(size_t)tc * 32 + head * 3 + 0]), g1 = bf2f(gn[(size_t)tc * 32 + head * 3 + 1]), g2 = bf2f(gn[(size_t)tc * 32 + head * 3 + 2]);
    f32x4 out[8];
#pragma unroll
    for (int i = 0; i < 8; ++i) out[i] = (f32x4){0.f, 0.f, 0.f, 0.f};
    for (int i = lane; i < 4 * IMP_LD; i += 64) imp[i] = 0.f;
    const int hic = (tc - 31) >> 4;
    const int nkmax = ((t0 + 3 - 31) >> 4) + 1, nsc = nkmax > 0 ? (nkmax + 31) >> 5 : 0;
    const bf16_t* kcg = kc + (size_t)g * 1024 * 128; const bf16_t* vcg = vc + (size_t)g * 1024 * 128;
    AState st; astate_init(st);
#pragma unroll 1
    for (int sp = 0; sp < nsc; ++sp) attn_step<1>(qp, kcg, vcg, 128, 32 * sp, 1, 1022, 0, hic, st, vbuf, lane);
    { const float lt = quad_total(st.l); st.l = lt > 0.f ? 1.f / lt : 0.f; }
    asm volatile("s_waitcnt lgkmcnt(0)" ::: "memory");
#pragma unroll 1
    for (int sp = 0; sp < nsc; ++sp) attn_step<2>(qp, kcg, vcg, 128, 32 * sp, 1, 1022, 0, hic, st, vbuf, lane, imp, 0);
#pragma unroll
    for (int i = 0; i < 8; ++i) out[i] = st.o[i] * g0;
    asm volatile("s_waitcnt lgkmcnt(0)" ::: "memory");
    unsigned key[4][4];
#pragma unroll
    for (int q = 0; q < 4; ++q) { const int cur = (t0 + q) >> 6; const f32x4 v = *(const LAS f32x4*)(imp + q * IMP_LD + 4 * lane);
#pragma unroll
        for (int i = 0; i < 4; ++i) { const int j = 4 * lane + i; const bool valid = j <= cur, forced = (j == 0) | (j == cur) | (j == cur - 1);
            const unsigned kb = forced ? 0xffffffu : ((__float_as_uint(fmaxf(v[i], 0.f)) >> 8) + 1u);
            key[q][i] = valid ? ((kb << 8) | (unsigned)(255 - j)) : 0u; } }
#pragma unroll 1
    for (int r = 0; r < 16; ++r) {
        unsigned mx[4];
#pragma unroll
        for (int q = 0; q < 4; ++q) { unsigned a = key[q][0] > key[q][1] ? key[q][0] : key[q][1], b = key[q][2] > key[q][3] ? key[q][2] : key[q][3]; mx[q] = a > b ? a : b; }
#pragma unroll
        for (int o = 1; o < 64; o <<= 1)
#pragma unroll
            for (int q = 0; q < 4; ++q) { const unsigned other = (unsigned)__shfl_xor((int)mx[q], o); mx[q] = other > mx[q] ? other : mx[q]; }
#pragma unroll
        for (int q = 0; q < 4; ++q) {
#pragma unroll
            for (int i = 0; i < 4; ++i) if (key[q][i] == mx[q]) key[q][i] = 0u;
            if (lane == 0) sel[q * 16 + r] = mx[q] ? (int)(255u - (mx[q] & 255u)) : -1;
        }
    }
    asm volatile("s_waitcnt lgkmcnt(0)" ::: "memory");
    astate_init(st);
    const bf16_t* ksl = proj + PC_KSL + 128 * g; const bf16_t* vsl = proj + PC_VSL + 128 * g;
#pragma unroll 1
    for (int q = 0; q < 4; ++q) {
        const int lo = (qi == q) ? 0 : (1 << 30);
#pragma unroll 1
        for (int r = 0; r < 16; ++r) {
            const int b = __builtin_amdgcn_readfirstlane(sel[q * 16 + r]);
            if (b < 0) break;
            attn_step<0>(qr, ksl, vsl, PLD, 64 * b, 1, S - 1, lo, tc, st, vbuf, lane);
            attn_step<0>(qr, ksl, vsl, PLD, 64 * b + 32, 1, S - 1, lo, tc, st, vbuf, lane);
        }
    }
    { const float lt = quad_total(st.l), inv = (lt > 0.f ? 1.f / lt : 0.f) * g1;
#pragma unroll
        for (int i = 0; i < 8; ++i) out[i] += st.o[i] * inv; }
    astate_init(st);
    const bf16_t* kwn = proj + PC_KWN + 128 * g; const bf16_t* vwn = proj + PC_VWN + 128 * g;
    { const int lo = tc - 511 < 0 ? 0 : tc - 511;
#pragma unroll 1
        for (int sp = 0; sp < 17; ++sp) { const int pos0 = t0 - 511 + 32 * sp; if (pos0 + 31 < 0) continue;
            attn_step<0>(qr, kwn, vwn, PLD, pos0, 1, S - 1, lo, tc, st, vbuf, lane); } }
    { const float lt = quad_total(st.l), inv = (lt > 0.f ? 1.f / lt : 0.f) * g2;
#pragma unroll
        for (int i = 0; i < 8; ++i) out[i] += st.o[i] * inv; }
    bf16_t* op = nsaout + (size_t)tc * NOLD + head * 128 + 4 * kq;
#pragma unroll
    for (int db = 0; db < 8; ++db) { u32x2 w; w.x = cvt_pk_bf16(out[db][0], out[db][1]); w.y = cvt_pk_bf16(out[db][2], out[db][3]); *(u32x2*)(op + 16 * db) = w; }
}

struct Params { const float* in[23]; float* out; unsigned char* ws; float inv_freq[64]; };

__global__ void __launch_bounds__(512, 2) fwd_megakernel(Params P) {
    extern __shared__ __attribute__((aligned(16))) unsigned char lds_raw[];
    LAS unsigned char* lds = (LAS unsigned char*)lds_raw;
    cg::grid_group grid = cg::this_grid();
#define PHASE_WS unsigned char* ws = P.ws; asm volatile("" : "+s"(ws)); int tid = threadIdx.x; asm volatile("" : "+v"(tid)); \
    const int lane = tid & 63, wave = __builtin_amdgcn_readfirstlane(tid >> 6), G = gridDim.x, gw = blockIdx.x * 8 + wave, ngw = G * 8; \
    const size_t gtid = (size_t)blockIdx.x * 512 + tid, gthreads = (size_t)G * 512; \
    LAS unsigned char* wl = lds + wave * WAVE_LDS; LAS float* scr = (LAS float*)wl; (void)lane; (void)gw; (void)ngw; (void)gtid; (void)gthreads; (void)wl; (void)scr
#define WAB ((bf16_t*)(ws + WS_WAB))
#define WO ((bf16_t*)(ws + WS_WO))
#define CW1K ((bf16_t*)(ws + WS_CW1K))
#define CW1V ((bf16_t*)(ws + WS_CW1V))
#define CW2K ((bf16_t*)(ws + WS_CW2K))
#define CW2V ((bf16_t*)(ws + WS_CW2V))
#define CBIAS ((float*)(ws + WS_CBIAS))
#define KC ((bf16_t*)(ws + WS_KC))
#define VC ((bf16_t*)(ws + WS_VC))
#define GN ((bf16_t*)(ws + WS_GN))
#define HF ((float*)(ws + WS_HF))
#define HB ((bf16_t*)(ws + WS_HB))
#define GU ((bf16_t*)(ws + WS_GU))
#define DN ((bf16_t*)(ws + WS_DN))
#define ACT ((bf16_t*)(ws + WS_ACT))
#define PROJ ((bf16_t*)(ws + WS_PROJ))
#define RCOS ((float*)(ws + WS_ROPE))
#define RSIN ((float*)(ws + WS_ROPE) + (size_t)S * 64)
#define WINT ((bf16_t*)(ws + WS_WIN))
#define NSAOUT ((bf16_t*)(ws + WS_NSAOUT))
#define SIGG ((bf16_t*)P.out)
    pg8::StaticOrder SO;
#define GRID_SYNC() do { __builtin_amdgcn_fence(__ATOMIC_RELEASE, "agent"); asm volatile("s_waitcnt vmcnt(0) lgkmcnt(0)" ::: "memory"); grid.sync(); __builtin_amdgcn_fence(__ATOMIC_ACQUIRE, "agent"); asm volatile("s_waitcnt vmcnt(0)" ::: "memory"); } while (0)

    { PHASE_WS;
        conv_ffn(P.in[1], P.in[2], P.in[3], GU, DN, scr, gw, ngw, lane);
        for (int it = gw; it < 32 * 360; it += ngw) { const int kb = it / 360, nb = it % 360, dr = nb * 32; const int sc = win_src_col(dr);
            tr_item(P.in[6], WIN_SRC, kb * 64, sc < 0 ? 0 : sc, sc < 0 ? 0 : (dr == 11264 ? 24 : 32), WINT, DM, dr, kb * 64, scr, lane); }
        for (int it = gw; it < 16 * 64; it += ngw) { const int kb = it / 64, nb = it % 64, c0 = nb * 32; tr_item(P.in[13], DM, kb * 64, c0, 32, WAB, 1536, 256 * (c0 >> 7) + (c0 & 127), kb * 64, scr, lane); }
        for (int it = gw; it < 8 * 64; it += ngw) { const int kb = it / 64, nb = it % 64, c0 = nb * 32; tr_item(P.in[14], DM, kb * 64, c0, 32, WAB, 1536, 256 * (c0 >> 7) + 128 + (c0 & 127), 1024 + kb * 64, scr, lane); }
        for (size_t i = gtid; i < (size_t)4096 * 64; i += gthreads) { const int r = (int)(i >> 6), c = (int)(i & 63); if ((r & 128) == 0) *(u32x4*)(WAB + (size_t)r * 1536 + 1024 + 8 * c) = (u32x4){0u, 0u, 0u, 0u}; }
        for (size_t i = gtid; i < (size_t)4096 * 128; i += gthreads) { const int r = (int)(i >> 7), c = (int)(i & 127); if (r & 128) *(u32x4*)(WAB + (size_t)r * 1536 + 8 * c) = (u32x4){0u, 0u, 0u, 0u}; }
        for (int it = gw; it < 32 * 64; it += ngw) { const int kb = it / 64, nb = it % 64; tr_item(P.in[15], DM, kb * 64, nb * 32, 32, WO, DM, nb * 32, kb * 64, scr, lane); }
        for (int it = gw; it < 2 * 64 * 8; it += ngw) { const int w = it / 512, r = it % 512, kb = r / 8, nb = r % 8; tr_item(w ? P.in[11] : P.in[8], 256, kb * 64, nb * 32, 32, w ? CW1V : CW1K, 4096, nb * 32, kb * 64, scr, lane); }
        for (int it = gw; it < 2 * 4 * 4; it += ngw) { const int w = it / 16, r = it % 16, kb = r / 4, nb = r % 4; tr_item(w ? P.in[12] : P.in[9], 128, kb * 64, nb * 32, 32, w ? CW2V : CW2K, 256, nb * 32, kb * 64, scr, lane); }
        { const float* x = P.in[0];
            for (size_t i = gtid; i < (size_t)S * DM / 8; i += gthreads) { const f32x4 a = *(const f32x4*)(x + 8 * i), b = *(const f32x4*)(x + 8 * i + 4); *(u32x4*)(HB + 8 * i) = pack8(a, b); } }
        for (int o = gw; o < 512; o += ngw) { const int w = o >> 8, c = o & 255; const float* pos = w ? P.in[10] : P.in[7]; const float* w1 = w ? P.in[11] : P.in[8];
            float s = 0.f; for (int kk = lane; kk < 4096; kk += 64) s += pos[kk] * w1[(size_t)kk * 256 + c];
            s = wave_sum(s); if (lane == 0) CBIAS[o] = s; }
    }
    GRID_SYNC();
    { PHASE_WS; pg8::Gemm g{HB, GU, S, NGU, DM, DM, DM}; SO.init(S, NGU, G, (int)blockIdx.x); EpiSwiglu E{ACT}; pg8::gemm_phase(lds, g, SO, E); }
    GRID_SYNC();
    { PHASE_WS; pg8::Gemm g{ACT, DN, S, DM, FF, FF, FF}; SO.init(S, DM, G, (int)blockIdx.x); EpiResF32 E{P.in[0], HF, ALPHA, 0.5f}; pg8::gemm_phase(lds, g, SO, E); }
    GRID_SYNC();
    { PHASE_WS;
        ln_rows(HF, HF, HB, P.in[4], P.in[5], gw, ngw, lane);
        for (size_t i = gtid; i < (size_t)S * 64; i += gthreads) { const int t = (int)(i >> 6), j = (int)(i & 63); const float ang = (float)t * P.inv_freq[j]; RCOS[i] = cosf(ang); RSIN[i] = sinf(ang); }
    }
    GRID_SYNC();
    { PHASE_WS; pg8::Gemm g{HB, WINT, S, NWIN, DM, DM, DM}; SO.init(S, NWIN, G, (int)blockIdx.x); EpiWin E{PROJ, SIGG, GN, RCOS, RSIN}; pg8::gemm_phase(lds, g, SO, E); }
    GRID_SYNC();
    { PHASE_WS;
        if (wave == 0) { for (int u = blockIdx.x; u < 256; u += G) { const int kv = u >> 7; compress_unit(u, PROJ, kv ? CW1V : CW1K, kv ? CW2V : CW2K, CBIAS + 256 * kv, kv ? VC : KC, wl, lane); } }
        else { for (int u = blockIdx.x * 7 + (wave - 1); u < 4096; u += G * 7) dilated_unit(u, PROJ, NSAOUT, wl, lane); }
    }
    GRID_SYNC();
    { PHASE_WS; for (int u = gw; u < 8192; u += ngw) nsa_unit(u, PROJ, KC, VC, GN, RCOS, RSIN, NSAOUT, wl, lane); }
    GRID_SYNC();
    { PHASE_WS; pg8::Gemm g{NSAOUT, WAB, S, 4096, NOLD, NOLD, NOLD}; SO.init(S, 4096, G, (int)blockIdx.x); EpiMerge E{SIGG, HB}; pg8::gemm_phase(lds, g, SO, E); }
    GRID_SYNC();
    { PHASE_WS; pg8::Gemm g{HB, WO, S, DM, DM, DM, DM}; SO.init(S, DM, G, (int)blockIdx.x); EpiResF32 E{HF, HF, ALPHA, 1.0f}; pg8::gemm_phase(lds, g, SO, E); }
    GRID_SYNC();
    { PHASE_WS;
        ln_rows(HF, HF, HB, P.in[16], P.in[17], gw, ngw, lane);
        conv_ffn(P.in[18], P.in[19], P.in[20], GU, DN, scr, gw, ngw, lane);
    }
    GRID_SYNC();
    { PHASE_WS; pg8::Gemm g{HB, GU, S, NGU, DM, DM, DM}; SO.init(S, NGU, G, (int)blockIdx.x); EpiSwiglu E{ACT}; pg8::gemm_phase(lds, g, SO, E); }
    GRID_SYNC();
    { PHASE_WS; pg8::Gemm g{ACT, DN, S, DM, FF, FF, FF}; SO.init(S, DM, G, (int)blockIdx.x); EpiResF32 E{HF, P.out, ALPHA, 0.5f}; pg8::gemm_phase(lds, g, SO, E); }
    GRID_SYNC();
    { PHASE_WS; (void)ws; ln_rows(P.out, P.out, nullptr, P.in[21], P.in[22], gw, ngw, lane); }
}

extern "C" void kernel_launch(void* const* d_in, const int* in_sizes, int n_in, void* d_out, int out_size, void* d_ws, size_t ws_size, hipStream_t stream) {
    static int grid = 0;
    if (grid == 0) {
        if (n_in != 23 || out_size != S * DM || ws_size < WS_END) { fprintf(stderr, "kernel_launch: unexpected shapes (n_in %d out %d ws %zu, need %zu)\n", n_in, out_size, ws_size, (size_t)WS_END); grid = -1; return; }
        int dev = 0, cus = 0, per_cu = 0;
        hipGetDevice(&dev); hipDeviceGetAttribute(&cus, hipDeviceAttributeMultiprocessorCount, dev);
        if (hipFuncSetAttribute((const void*)fwd_megakernel, hipFuncAttributeMaxDynamicSharedMemorySize, LDS_BYTES) != hipSuccess) { fprintf(stderr, "kernel_launch: hipFuncSetAttribute failed\n"); grid = -1; return; }
        if (hipOccupancyMaxActiveBlocksPerMultiprocessor(&per_cu, (const void*)fwd_megakernel, 512, LDS_BYTES) != hipSuccess || per_cu < 1) { fprintf(stderr, "kernel_launch: occupancy query failed (%d)\n", per_cu); (void)hipGetLastError(); per_cu = 1; }
        grid = cus * per_cu;
    }
    if (grid < 0) return;
    Params p{};
    for (int i = 0; i < 23; ++i) p.in[i] = (const float*)d_in[i];
    p.out = (float*)d_out; p.ws = (unsigned char*)d_ws;
    for (int i = 0; i < 64; ++i) p.inv_freq[i] = (float)pow(10000.0, -(double)i / 64.0);
    void* args[] = {&p};
    hipError_t e = hipLaunchCooperativeKernel((const void*)fwd_megakernel, dim3(grid), dim3(512), args, LDS_BYTES, stream);
    if (e != hipSuccess) fprintf(stderr, "kernel_launch: cooperative launch failed: %s (grid %d)\n", hipGetErrorString(e), grid);
}
```

```cpp
#include <hip/hip_runtime.h>
#include <hip/hip_cooperative_groups.h>
#include <cstdio>
#include <cstdint>
#include <cmath>
namespace cg = cooperative_groups;

#define LAS __attribute__((address_space(3)))
typedef unsigned short bf16_t;
typedef short bf16x8 __attribute__((ext_vector_type(8)));
typedef short s16x4 __attribute__((ext_vector_type(4)));
typedef float f32x4 __attribute__((ext_vector_type(4)));
typedef float f32x2 __attribute__((ext_vector_type(2)));
typedef unsigned u32x4 __attribute__((ext_vector_type(4)));
typedef unsigned u32x2 __attribute__((ext_vector_type(2)));

constexpr int S = 16384, DM = 2048, FF = 5632, NGU = 2 * FF, NWIN = 11520, WIN_SRC = 11288, PLD = 7168, NOLD = 1536;
constexpr float ALPHA = 1.189207115002721f;
constexpr float LN_EPS = 1e-5f;
constexpr float SL2 = 0.08838834764831845f * 1.4426950408889634f;
constexpr int PC_QA = 0, PC_KC = 1024, PC_VC = 1280, PC_KSL = 1536, PC_VSL = 1792, PC_KWN = 2048, PC_VWN = 2304, PC_QB = 2560, PC_KB = 4096, PC_VB = 5632;
constexpr size_t MiB = 1u << 20;
constexpr size_t WS_WAB = 1 * MiB, WS_WO = 13 * MiB, WS_CW1K = 21 * MiB, WS_CW1V = 23 * MiB, WS_CW2K = 25 * MiB, WS_CW2V = 25 * MiB + 65536, WS_CBIAS = 25 * MiB + 131072;
constexpr size_t WS_KC = 26 * MiB, WS_VC = 26 * MiB + 524288, WS_GN = 27 * MiB;
constexpr size_t WS_HF = 32 * MiB, WS_HB = 160 * MiB, WS_BIG = 224 * MiB;
constexpr size_t WS_GU = WS_BIG, WS_DN = WS_BIG + 44 * MiB, WS_ACT = WS_BIG + 66 * MiB;
constexpr size_t WS_PROJ = WS_BIG, WS_ROPE = WS_BIG + 224 * MiB;
constexpr size_t WS_WIN = 466 * MiB, WS_NSAOUT = 466 * MiB, WS_END = 514 * MiB;

constexpr int VROW = 272, VBUF_BYTES = 32 * VROW;
constexpr int IMP_LD = 260;
constexpr int OUT_OFF = VBUF_BYTES + 4 * IMP_LD * 4 + 256 + 512;
constexpr int WAVE_LDS = OUT_OFF + 4096;
constexpr int LDS_BYTES = 147456;

typedef __bf16 bf16x2_t __attribute__((ext_vector_type(2)));
__device__ __forceinline__ unsigned cvt_pk_bf16(float lo, float hi) { f32x2 v = {lo, hi}; bf16x2_t b = __builtin_convertvector(v, bf16x2_t); return __builtin_bit_cast(unsigned, b); }
__device__ __forceinline__ float bf2f(unsigned short b) { return __uint_as_float(((unsigned)b) << 16); }
__device__ __forceinline__ float bflo(unsigned w) { return __uint_as_float(w << 16); }
__device__ __forceinline__ float bfhi(unsigned w) { return __uint_as_float(w & 0xffff0000u); }
__device__ __forceinline__ float fsigmoid(float x) { return __builtin_amdgcn_rcpf(1.f + __expf(-x)); }
__device__ __forceinline__ float wave_sum(float v) {
#pragma unroll
    for (int o = 1; o < 64; o <<= 1) v += __shfl_xor(v, o);
    return v;
}
__device__ __forceinline__ u32x4 pack8(const f32x4 a, const f32x4 b) { u32x4 w; w.x = cvt_pk_bf16(a[0], a[1]); w.y = cvt_pk_bf16(a[2], a[3]); w.z = cvt_pk_bf16(b[0], b[1]); w.w = cvt_pk_bf16(b[2], b[3]); return w; }

namespace pg8 {
constexpr int BM = 256, BK = 64, HALF = 128, HTB = HALF * BK * 2, STAGE_BYTES = 8 * HTB, NXCD = 8, WGM = 8;
__host__ __device__ __forceinline__ int lds_byte(int r, int c) { const int st = (r >> 4) * 2 + (c >> 5), rr = r & 15, cc = c & 31, ob = rr * 64 + cc * 2; return st * 1024 + (ob ^ (((ob >> 9) & 1) << 5)); }
__host__ __device__ __forceinline__ void stage_rc(int b, int& R, int& C) { const int st = b / 1024, sb = b % 1024, swz = sb ^ (((sb >> 9) & 1) << 5); R = (st >> 1) * 16 + swz / 64; C = (st & 1) * 32 + (swz % 64) / 2; }
__host__ __device__ __forceinline__ int perm32(int rho) { const int n = rho >> 4, i = rho & 15; return 8 * (i >> 2) + 4 * n + (i & 3); }
struct Unit { int pm, pn; };
struct Gemm { const bf16_t* A; const bf16_t* Bt; int M, N, K, lda, ldb; };
struct StaticOrder {
    int nM, nN, nwg, G, c;
    __device__ void init(int M, int N, int G_, int c_) { nM = M / BM; nN = N / BM; nwg = nM * nN; G = G_; c = c_; }
    __device__ bool next(int i, Unit& u) const {
        const long L = (long)i * G + c; if (L >= nwg) return false;
        int wgid = (int)L; { const int q = nwg / NXCD, r = nwg % NXCD, xcd = wgid % NXCD, off = wgid / NXCD; wgid = (xcd < r ? xcd * (q + 1) : r * (q + 1) + (xcd - r) * q) + off; }
        const int nig = WGM * nN, gid = wgid / nig, fm = gid * WGM, gsz = (nM - fm) < WGM ? (nM - fm) : WGM;
        u.pm = fm + ((wgid % nig) % gsz); u.pn = (wgid % nig) / gsz; return true;
    }
};
typedef f32x4 Acc[2][2][4][2];

template <class Epi>
__device__ __forceinline__ void gemm_phase(LAS unsigned char* lds, const Gemm g, const StaticOrder& S_, const Epi& E) {
    const int tid = threadIdx.x, wid = __builtin_amdgcn_readfirstlane(tid >> 6), lane = tid & 63, wr = wid >> 2, wc = wid & 3, fr = lane & 15, fq = lane >> 4;
    const int K = g.K, nt = K / BK;
    unsigned voffA[2], voffB[2];
#pragma unroll
    for (int i = 0; i < 2; ++i) { int R, C; stage_rc(tid * 16 + i * 8192, R, C); const int Rb = Epi::PERM ? ((R & ~31) + perm32(R & 31)) : R;
        voffA[i] = (unsigned)(R * g.lda + C) * 2u; voffB[i] = (unsigned)(Rb * g.ldb + C) * 2u; }
    const size_t kstep = (size_t)(BK * 2);
    const size_t hstepA = (size_t)HALF * g.lda * 2, hstepB = (size_t)HALF * g.ldb * 2;
    const size_t tstepA = 2 * hstepA, tstepB = 2 * hstepB;
    const unsigned ldsw = (unsigned)wid * 1024u;
    const int aoff = lds_byte(wr * 64 + fr, fq * 8), boff = lds_byte(wc * 32 + fr, fq * 8);
#define PG8_SA(b, h) (((b) * 2 + (h)) * HTB)
#define PG8_SB(b, h) ((4 + (b) * 2 + (h)) * HTB)
#define PG8_STAGE(bufoff, gbase, voff) do { _Pragma("unroll") for (int _i = 0; _i < 2; ++_i) \
        __builtin_amdgcn_global_load_lds((const unsigned*)((const char*)(gbase) + (voff)[_i]), (LAS unsigned*)(lds + (bufoff) + ldsw + _i * 8192), 16, 0, 0); } while (0)
#define PG8_LDA(dst, b, h) do { _Pragma("unroll") for (int m = 0; m < 4; ++m) _Pragma("unroll") for (int k = 0; k < 2; ++k) dst[m][k] = *(const LAS bf16x8*)(lds + PG8_SA(b, h) + aoff + m * 2048 + k * 1024); } while (0)
#define PG8_LDB(dst, b, h) do { _Pragma("unroll") for (int n = 0; n < 2; ++n) _Pragma("unroll") for (int k = 0; k < 2; ++k) dst[n][k] = *(const LAS bf16x8*)(lds + PG8_SB(b, h) + boff + n * 2048 + k * 1024); } while (0)
#define PG8_MMA(ai, bj, At, Bt) do { __builtin_amdgcn_s_setprio(1); _Pragma("unroll") for (int m = 0; m < 4; ++m) _Pragma("unroll") for (int n = 0; n < 2; ++n) _Pragma("unroll") for (int k = 0; k < 2; ++k) \
        acc[ai][bj][m][n] = __builtin_amdgcn_mfma_f32_16x16x32_bf16(Bt[n][k], At[m][k], acc[ai][bj][m][n], 0, 0, 0); __builtin_amdgcn_s_setprio(0); } while (0)
#define PG8_WAIT_V(n) asm volatile("s_waitcnt vmcnt(" #n ")" ::: "memory")
#define PG8_WAIT_L(n) asm volatile("s_waitcnt lgkmcnt(" #n ")" ::: "memory")
#define PG8_BAR __builtin_amdgcn_s_barrier()
#define PG8_SCHED __builtin_amdgcn_sched_barrier(0)
    Unit cur, nxt; int ui = 0;
    if (!S_.next(0, cur)) return;
    Acc acc;
#pragma unroll
    for (int a = 0; a < 2; ++a)
#pragma unroll
        for (int b = 0; b < 2; ++b)
#pragma unroll
            for (int m = 0; m < 4; ++m)
#pragma unroll
                for (int n = 0; n < 2; ++n) acc[a][b][m][n] = (f32x4){0.f, 0.f, 0.f, 0.f};
    bf16x8 At[4][2], B0[2][2], B1[2][2];
    const char* cA = (const char*)g.A + (size_t)cur.pm * tstepA; const char* cB = (const char*)g.Bt + (size_t)cur.pn * tstepB;
    PG8_STAGE(PG8_SB(0, 0), cB, voffB); PG8_STAGE(PG8_SB(0, 1), cB + hstepB, voffB); PG8_STAGE(PG8_SA(0, 0), cA, voffA); PG8_STAGE(PG8_SA(0, 1), cA + hstepA, voffA);
    if (wr == 1) PG8_BAR;
    PG8_WAIT_V(2); PG8_BAR;
    PG8_STAGE(PG8_SB(1, 0), cB + kstep, voffB); PG8_STAGE(PG8_SA(1, 0), cA + kstep, voffA); PG8_STAGE(PG8_SB(1, 1), cB + hstepB + kstep, voffB);
    PG8_WAIT_V(6); PG8_BAR;
    for (;;) {
        const bool has_next = S_.next(ui + 1, nxt);
        const char* nA = has_next ? (const char*)g.A + (size_t)nxt.pm * tstepA : cA; const char* nB = has_next ? (const char*)g.Bt + (size_t)nxt.pn * tstepB : cB;
        for (int t = 0; t < nt; t += 2) {
            const bool last = (t == nt - 2);
            const char* a1 = cA + (size_t)(t + 1) * kstep;
            const char* a2 = last ? nA : cA + (size_t)(t + 2) * kstep; const char* b2 = last ? nB : cB + (size_t)(t + 2) * kstep;
            const char* a3 = a2 + kstep; const char* b3 = b2 + kstep;
            PG8_LDB(B0, 0, 0); PG8_LDB(B1, 0, 1); PG8_SCHED; PG8_LDA(At, 0, 0); PG8_STAGE(PG8_SA(1, 1), a1 + hstepA, voffA);
            PG8_WAIT_V(8); PG8_WAIT_L(0); PG8_BAR; PG8_MMA(0, 0, At, B0); PG8_MMA(0, 1, At, B1); PG8_BAR; PG8_SCHED;
            PG8_LDA(At, 0, 1); PG8_STAGE(PG8_SB(0, 0), b2, voffB); PG8_STAGE(PG8_SB(0, 1), b2 + hstepB, voffB); PG8_STAGE(PG8_SA(0, 0), a2, voffA);
            PG8_WAIT_V(8); PG8_WAIT_L(0); PG8_BAR; PG8_MMA(1, 0, At, B0); PG8_MMA(1, 1, At, B1); PG8_BAR; PG8_SCHED;
            PG8_LDB(B0, 1, 0); PG8_LDB(B1, 1, 1); PG8_SCHED; PG8_LDA(At, 1, 0); PG8_STAGE(PG8_SA(0, 1), a2 + hstepA, voffA);
            PG8_WAIT_V(8); PG8_WAIT_L(0); PG8_BAR; PG8_MMA(0, 0, At, B0); PG8_MMA(0, 1, At, B1); PG8_BAR; PG8_SCHED;
            PG8_LDA(At, 1, 1); PG8_STAGE(PG8_SB(1, 0), b3, voffB); PG8_STAGE(PG8_SB(1, 1), b3 + hstepB, voffB); PG8_STAGE(PG8_SA(1, 0), a3, voffA);
            PG8_WAIT_V(8); PG8_WAIT_L(0); PG8_BAR; PG8_MMA(1, 0, At, B0); PG8_MMA(1, 1, At, B1); PG8_BAR; PG8_SCHED;
        }
        if (wr == 0) PG8_BAR;
        E(acc, cur, wr, wc, fr, fq);
        if (!has_next) break;
#pragma unroll
        for (int a = 0; a < 2; ++a)
#pragma unroll
            for (int b = 0; b < 2; ++b)
#pragma unroll
                for (int m = 0; m < 4; ++m)
#pragma unroll
                    for (int n = 0; n < 2; ++n) acc[a][b][m][n] = (f32x4){0.f, 0.f, 0.f, 0.f};
        cur = nxt; cA = nA; cB = nB; ++ui;
        if (wr == 1) PG8_BAR;
    }
    PG8_WAIT_V(0);
    PG8_BAR;
#undef PG8_SA
#undef PG8_SB
#undef PG8_STAGE
#undef PG8_LDA
#undef PG8_LDB
#undef PG8_MMA
#undef PG8_WAIT_V
#undef PG8_WAIT_L
#undef PG8_BAR
#undef PG8_SCHED
}
}

struct EpiSwiglu {
    static constexpr bool PERM = true;
    bf16_t* O;
    __device__ __forceinline__ void operator()(const pg8::Acc& acc, const pg8::Unit& u, int wr, int wc, int fr, int fq) const {
        const int row0 = u.pm * 256 + wr * 64 + fr, col0 = u.pn * 128 + wc * 32 + 8 * fq;
#pragma unroll
        for (int ai = 0; ai < 2; ++ai)
#pragma unroll
            for (int m = 0; m < 4; ++m) {
                f32x4 v[2];
#pragma unroll
                for (int n = 0; n < 2; ++n)
#pragma unroll
                    for (int e = 0; e < 4; ++e) { const float gt = acc[ai][0][m][n][e], up = acc[ai][1][m][n][e]; v[n][e] = gt * fsigmoid(gt) * up; }
                *(u32x4*)(O + (size_t)(row0 + ai * 128 + m * 16) * FF + col0) = pack8(v[0], v[1]);
            }
    }
};
struct EpiResF32 {
    static constexpr bool PERM = false;
    const float* res; float* out; float a, b;
    __device__ __forceinline__ void operator()(const pg8::Acc& acc, const pg8::Unit& u, int wr, int wc, int fr, int fq) const {
        const int row0 = u.pm * 256 + wr * 64 + fr, col0 = u.pn * 256 + wc * 32 + 4 * fq;
#pragma unroll
        for (int ai = 0; ai < 2; ++ai)
#pragma unroll
            for (int m = 0; m < 4; ++m) {
                const size_t off = (size_t)(row0 + ai * 128 + m * 16) * DM + col0;
#pragma unroll
                for (int bj = 0; bj < 2; ++bj)
#pragma unroll
                    for (int n = 0; n < 2; ++n) { const f32x4 r = *(const f32x4*)(res + off + bj * 128 + n * 16); *(f32x4*)(out + off + bj * 128 + n * 16) = r * a + acc[ai][bj][m][n] * b; }
            }
    }
};
struct EpiWin {
    static constexpr bool PERM = true;
    bf16_t* proj; bf16_t* sigg; bf16_t* gn; const float* cs; const float* sn;
    __device__ __forceinline__ void operator()(const pg8::Acc& acc, const pg8::Unit& u, int wr, int wc, int fr, int fq) const {
        const int tile = u.pn, row0 = u.pm * 256 + wr * 64 + fr, cw = wc * 32 + 8 * fq;
        if (tile < 28) {
            const bool rope = (tile == 6) | (tile == 8) | (tile >= 10 && tile < 22);
            if (!rope) {
#pragma unroll
                for (int ai = 0; ai < 2; ++ai)
#pragma unroll
                    for (int m = 0; m < 4; ++m)
#pragma unroll
                        for (int bj = 0; bj < 2; ++bj)
                            *(u32x4*)(proj + (size_t)(row0 + ai * 128 + m * 16) * PLD + tile * 256 + bj * 128 + cw) = pack8(acc[ai][bj][m][0], acc[ai][bj][m][1]);
            } else {
                const int head = cw >> 6, d = cw & 63;
#pragma unroll
                for (int ai = 0; ai < 2; ++ai)
#pragma unroll
                    for (int m = 0; m < 4; ++m) {
                        const int row = row0 + ai * 128 + m * 16;
                        f32x4 o1[2], o2[2];
#pragma unroll
                        for (int n = 0; n < 2; ++n) {
                            const f32x4 c = *(const f32x4*)(cs + (size_t)row * 64 + d + 4 * n), s = *(const f32x4*)(sn + (size_t)row * 64 + d + 4 * n);
                            const f32x4 x1 = acc[ai][0][m][n], x2 = acc[ai][1][m][n];
                            o1[n] = x1 * c - x2 * s; o2[n] = x2 * c + x1 * s;
                        }
                        bf16_t* p = proj + (size_t)row * PLD + tile * 256 + head * 128 + d;
                        *(u32x4*)p = pack8(o1[0], o1[1]); *(u32x4*)(p + 64) = pack8(o2[0], o2[1]);
                    }
            }
        } else if (tile < 44) {
#pragma unroll
            for (int ai = 0; ai < 2; ++ai)
#pragma unroll
                for (int m = 0; m < 4; ++m)
#pragma unroll
                    for (int bj = 0; bj < 2; ++bj) {
                        f32x4 v[2];
#pragma unroll
                        for (int n = 0; n < 2; ++n)
#pragma unroll
                            for (int e = 0; e < 4; ++e) v[n][e] = fsigmoid(acc[ai][bj][m][n][e]);
                        *(u32x4*)(sigg + (size_t)(row0 + ai * 128 + m * 16) * 4096 + (tile - 28) * 256 + bj * 128 + cw) = pack8(v[0], v[1]);
                    }
        } else {
            if (wc == 0) {
#pragma unroll
                for (int ai = 0; ai < 2; ++ai)
#pragma unroll
                    for (int m = 0; m < 4; ++m) {
                        f32x4 v[2];
#pragma unroll
                        for (int n = 0; n < 2; ++n)
#pragma unroll
                            for (int e = 0; e < 4; ++e) v[n][e] = fsigmoid(acc[ai][0][m][n][e]);
                        *(u32x4*)(gn + (size_t)(row0 + ai * 128 + m * 16) * 32 + cw) = pack8(v[0], v[1]);
                    }
            }
        }
    }
};
struct EpiMerge {
    static constexpr bool PERM = true;
    const bf16_t* sigg; bf16_t* O;
    __device__ __forceinline__ void operator()(const pg8::Acc& acc, const pg8::Unit& u, int wr, int wc, int fr, int fq) const {
        const int row0 = u.pm * 256 + wr * 64 + fr, col0 = u.pn * 128 + wc * 32 + 8 * fq;
#pragma unroll
        for (int ai = 0; ai < 2; ++ai)
#pragma unroll
            for (int m = 0; m < 4; ++m) {
                const int row = row0 + ai * 128 + m * 16;
                const u32x4 ga = *(const u32x4*)(sigg + (size_t)row * 4096 + col0), gb = *(const u32x4*)(sigg + (size_t)row * 4096 + 2048 + col0);
                f32x4 v[2];
#pragma unroll
                for (int n = 0; n < 2; ++n) {
                    const unsigned a0 = n ? ga.z : ga.x, a1 = n ? ga.w : ga.y, b0 = n ? gb.z : gb.x, b1 = n ? gb.w : gb.y;
                    const f32x4 ya = acc[ai][0][m][n], yb = acc[ai][1][m][n];
                    v[n][0] = bflo(a0) * ya[0] + bflo(b0) * yb[0]; v[n][1] = bfhi(a0) * ya[1] + bfhi(b0) * yb[1];
                    v[n][2] = bflo(a1) * ya[2] + bflo(b1) * yb[2]; v[n][3] = bfhi(a1) * ya[3] + bfhi(b1) * yb[3];
                }
                *(u32x4*)(O + (size_t)row * DM + col0) = pack8(v[0], v[1]);
            }
    }
};

__device__ __forceinline__ void tr_item(const float* W, int ldw, int k0, int scol0, int nvalid, bf16_t* WT, int ldt, int drow0, int dk0, LAS float* scr, int lane) {
    const int c = lane & 31;
#pragma unroll 8
    for (int i = 0; i < 32; ++i) { const int kk = 2 * i + (lane >> 5); scr[kk * 33 + c] = (c < nvalid) ? W[(size_t)(k0 + kk) * ldw + scol0 + c] : 0.f; }
    asm volatile("s_waitcnt lgkmcnt(0)" ::: "memory");
    const int c8 = lane & 7;
#pragma unroll
    for (int j = 0; j < 4; ++j) { const int n = (lane >> 3) + 8 * j; const LAS float* s = scr + (8 * c8) * 33 + n;
        u32x4 o; o.x = cvt_pk_bf16(s[0 * 33], s[1 * 33]); o.y = cvt_pk_bf16(s[2 * 33], s[3 * 33]); o.z = cvt_pk_bf16(s[4 * 33], s[5 * 33]); o.w = cvt_pk_bf16(s[6 * 33], s[7 * 33]);
        *(u32x4*)(WT + (size_t)(drow0 + n) * ldt + dk0 + 8 * c8) = o; }
    asm volatile("s_waitcnt lgkmcnt(0)" ::: "memory");
}
__device__ __forceinline__ int win_src_col(int r) {
    if (r >= WIN_SRC) return -1;
    if (r >= 11264) return 2560 + (r - 11264);
    const int tile = r >> 8; int j = r & 255;
    const bool rope = (tile == 6) | (tile == 8) | (tile >= 10 && tile < 22);
    if (rope) { const int q = j >> 6, d = j & 63; j = (q & 1) * 128 + (q >> 1) * 64 + d; }
    const int c = tile * 256 + j;
    return c < 2560 ? c : c + 24;
}
__device__ __forceinline__ void conv_ffn(const float* Wg, const float* Wu, const float* Wd, bf16_t* GU, bf16_t* DN, LAS float* scr, int gw, int ngw, int lane) {
    constexpr int I_G = 32 * 176;
    for (int it = gw; it < 2 * I_G; it += ngw) { const int which = it / I_G, r = it % I_G, kb = r / 176, nb = r % 176, c0 = nb * 32;
        tr_item(which ? Wu : Wg, FF, kb * 64, c0, 32, GU, DM, 256 * (c0 >> 7) + (c0 & 127) + which * 128, kb * 64, scr, lane); }
    for (int it = gw; it < 88 * 64; it += ngw) { const int kb = it / 64, nb = it % 64; tr_item(Wd, DM, kb * 64, nb * 32, 32, DN, FF, nb * 32, kb * 64, scr, lane); }
}
__device__ __forceinline__ void ln_rows(const float* in, float* outf, bf16_t* outb, const float* g, const float* b, int gw, int ngw, int lane) {
    f32x4 gv[8], bv[8];
#pragma unroll
    for (int j = 0; j < 8; ++j) { gv[j] = *(const f32x4*)(g + 4 * (lane + 64 * j)); bv[j] = *(const f32x4*)(b + 4 * (lane + 64 * j)); }
    for (int row = gw; row < S; row += ngw) {
        const float* xr = in + (size_t)row * DM; f32x4 v[8]; float s = 0.f;
#pragma unroll
        for (int j = 0; j < 8; ++j) { v[j] = *(const f32x4*)(xr + 4 * (lane + 64 * j)); s += (v[j][0] + v[j][1]) + (v[j][2] + v[j][3]); }
        const float mean = wave_sum(s) * (1.f / DM); float s2 = 0.f;
#pragma unroll
        for (int j = 0; j < 8; ++j) { v[j] = v[j] - mean; s2 += (v[j][0] * v[j][0] + v[j][1] * v[j][1]) + (v[j][2] * v[j][2] + v[j][3] * v[j][3]); }
        const float rstd = 1.f / sqrtf(wave_sum(s2) * (1.f / DM) + LN_EPS);
#pragma unroll
        for (int j = 0; j < 8; ++j) { const f32x4 o = v[j] * rstd * gv[j] + bv[j];
            *(f32x4*)(outf + (size_t)row * DM + 4 * (lane + 64 * j)) = o;
            if (outb) { u32x2 w; w.x = cvt_pk_bf16(o[0], o[1]); w.y = cvt_pk_bf16(o[2], o[3]); *(u32x2*)(outb + (size_t)row * DM + 4 * (lane + 64 * j)) = w; } }
    }
}

struct AState { float m, l; f32x4 o[8]; };
__device__ __forceinline__ void astate_init(AState& s) { s.m = -1e30f; s.l = 0.f;
#pragma unroll
    for (int i = 0; i < 8; ++i) s.o[i] = (f32x4){0.f, 0.f, 0.f, 0.f}; }
__device__ __forceinline__ int clampi(int v, int lo, int hi) { return v < lo ? lo : (v > hi ? hi : v); }

__device__ __forceinline__ void load_k(bf16x8 (&kf)[2][4], const bf16_t* __restrict__ Kb, int ld, int pos0, int dpos, int posmax, int l16, int kq) {
#pragma unroll
    for (int T = 0; T < 2; ++T) { const int p = clampi(pos0 + dpos * (16 * T + l16), 0, posmax); const bf16_t* kp = Kb + (size_t)p * ld + 8 * kq;
#pragma unroll
        for (int s = 0; s < 4; ++s) kf[T][s] = *(const bf16x8*)(kp + 32 * s); }
}
__device__ __forceinline__ void load_v(u32x4 (&vr)[8], const bf16_t* __restrict__ Vb, int ld, int pos0, int dpos, int posmax, int l16, int kq) {
#pragma unroll
    for (int i = 0; i < 8; ++i) { const int p = clampi(pos0 + dpos * (4 * i + kq), 0, posmax); vr[i] = *(const u32x4*)(Vb + (size_t)p * ld + 8 * l16); }
}
__device__ __forceinline__ void store_v(const u32x4 (&vr)[8], LAS unsigned char* vbuf, int l16, int kq) {
#pragma unroll
    for (int i = 0; i < 8; ++i) *(LAS u32x4*)(vbuf + (4 * i + kq) * VROW + 16 * l16) = vr[i];
}
template <int MODE, bool SLC, class Desc>
__device__ __forceinline__ void attn_run(const bf16x8 (&qf)[4], const bf16_t* __restrict__ Kb, const bf16_t* __restrict__ Vb, int ld, int dpos, int posmax,
                                         const Desc& desc, int n, int lo_in, int hi, int qi, AState& st, LAS unsigned char* vbuf, int lane, LAS float* imp = nullptr) {
    if (n <= 0) return;
    const int l16 = lane & 15, kq = lane >> 4;
    u32x4 kr[8];
    int dcur = desc(0);
    load_v(kr, Kb, ld, SLC ? (dcur & 0xfffff) : dcur, dpos, posmax, l16, kq);
#pragma unroll 1
    for (int i = 0; i < n; ++i) {
        const int pos0 = SLC ? (dcur & 0xfffff) : dcur;
        const int lo = SLC ? (((dcur >> 20) == qi) ? 0 : (1 << 30)) : lo_in;
        store_v(kr, vbuf, l16, kq);
        u32x4 vr[8];
        if (MODE != 1) load_v(vr, Vb, ld, pos0, dpos, posmax, l16, kq);
        bf16x8 kf[2][4];
#pragma unroll
        for (int T = 0; T < 2; ++T)
#pragma unroll
            for (int s = 0; s < 4; ++s) kf[T][s] = *(const LAS bf16x8*)(vbuf + (16 * T + l16) * VROW + 64 * s + 16 * kq);
        f32x4 sa[2] = {(f32x4){0.f, 0.f, 0.f, 0.f}, (f32x4){0.f, 0.f, 0.f, 0.f}};
#pragma unroll
        for (int T = 0; T < 2; ++T)
#pragma unroll
            for (int s = 0; s < 4; ++s) sa[T] = __builtin_amdgcn_mfma_f32_16x16x32_bf16(kf[T][s], qf[s], sa[T], 0, 0, 0);
        const int dnext = desc(i + 1 < n ? i + 1 : i);
        load_v(kr, Kb, ld, SLC ? (dnext & 0xfffff) : dnext, dpos, posmax, l16, kq);
        float sc[8]; bool vd[8]; float mx = -1e30f;
#pragma unroll
        for (int T = 0; T < 2; ++T)
#pragma unroll
            for (int r = 0; r < 4; ++r) { const int p = pos0 + dpos * (16 * T + 4 * kq + r); const bool v = (p >= lo) & (p <= hi); const float x = sa[T][r] * SL2;
                sc[4 * T + r] = x; vd[4 * T + r] = v; mx = v ? fmaxf(mx, x) : mx; }
        float p[8];
        if (MODE == 2) {
#pragma unroll
            for (int j = 0; j < 8; ++j) p[j] = vd[j] ? __builtin_amdgcn_exp2f(sc[j] - st.m) * st.l : 0.f;
#pragma unroll
            for (int T = 0; T < 2; ++T) {
                float x = 2.f * (p[4 * T] + p[4 * T + 1] + p[4 * T + 2]) + p[4 * T + 3], y = p[4 * T + 3];
                x += __shfl_xor(x, 1); x += __shfl_xor(x, 2); y += __shfl_xor(y, 1); y += __shfl_xor(y, 2);
                if ((l16 & 3) == 0) { const int a = (pos0 >> 2) + 4 * T + kq; LAS float* ip = imp + (l16 >> 2) * IMP_LD + a;
                    ip[0] += x;
                    asm volatile("s_waitcnt lgkmcnt(0)" ::: "memory");
                    ip[1] += y; }
                asm volatile("s_waitcnt lgkmcnt(0)" ::: "memory");
            }
        } else {
            mx = fmaxf(mx, __shfl_xor(mx, 16)); mx = fmaxf(mx, __shfl_xor(mx, 32));
            const float mn = fmaxf(st.m, mx), alpha = __builtin_amdgcn_exp2f(st.m - mn); st.m = mn;
            float ps = 0.f;
#pragma unroll
            for (int j = 0; j < 8; ++j) { p[j] = vd[j] ? __builtin_amdgcn_exp2f(sc[j] - mn) : 0.f; ps += p[j]; }
            st.l = st.l * alpha + ps;
            if (MODE == 0) {
#pragma unroll
                for (int j = 0; j < 8; ++j) st.o[j] = st.o[j] * alpha;
            }
        }
        if (MODE != 1) {
            store_v(vr, vbuf, l16, kq);
            u32x4 pw; pw.x = cvt_pk_bf16(p[0], p[1]); pw.y = cvt_pk_bf16(p[2], p[3]); pw.z = cvt_pk_bf16(p[4], p[5]); pw.w = cvt_pk_bf16(p[6], p[7]);
            const bf16x8 pf = __builtin_bit_cast(bf16x8, pw);
            const unsigned addr = (unsigned)(uintptr_t)(vbuf) + (4 * kq + (l16 >> 2)) * VROW + (l16 & 3) * 8;
#pragma unroll
            for (int hf = 0; hf < 2; ++hf) {
                s16x4 a[8];
                asm volatile("s_waitcnt lgkmcnt(0)\n\t"
                             "ds_read_b64_tr_b16 %0, %8 offset:0\n\t"    "ds_read_b64_tr_b16 %1, %8 offset:32\n\t"
                             "ds_read_b64_tr_b16 %2, %8 offset:64\n\t"   "ds_read_b64_tr_b16 %3, %8 offset:96\n\t"
                             "ds_read_b64_tr_b16 %4, %8 offset:4352\n\t" "ds_read_b64_tr_b16 %5, %8 offset:4384\n\t"
                             "ds_read_b64_tr_b16 %6, %8 offset:4416\n\t" "ds_read_b64_tr_b16 %7, %8 offset:4448\n\t"
                             "s_waitcnt lgkmcnt(0)"
                             : "=&v"(a[0]), "=&v"(a[1]), "=&v"(a[2]), "=&v"(a[3]), "=&v"(a[4]), "=&v"(a[5]), "=&v"(a[6]), "=&v"(a[7])
                             : "v"(addr + 128 * hf) : "memory");
#pragma unroll
                for (int d4 = 0; d4 < 4; ++d4) { const int db = 4 * hf + d4;
                    bf16x8 af; af[0] = a[d4][0]; af[1] = a[d4][1]; af[2] = a[d4][2]; af[3] = a[d4][3]; af[4] = a[d4 + 4][0]; af[5] = a[d4 + 4][1]; af[6] = a[d4 + 4][2]; af[7] = a[d4 + 4][3];
                    st.o[db] = __builtin_amdgcn_mfma_f32_16x16x32_bf16(af, pf, st.o[db], 0, 0, 0); }
            }
        }
        dcur = dnext;
    }
}
__device__ __forceinline__ float quad_total(float v) { v += __shfl_xor(v, 16); v += __shfl_xor(v, 32); return v; }

__device__ __forceinline__ void dilated_unit(int unit, const bf16_t* proj, bf16_t* nsaout, LAS unsigned char* vbuf, int lane) {
    const int l16 = lane & 15, kq = lane >> 4;
    const int hg = unit & 3, r16 = (unit >> 2) & 15, ut = unit >> 6;
    const int t0 = r16 + 256 * ut, tc = t0 + 16 * l16;
    AState st; astate_init(st);
#pragma unroll 1
    for (int pt = 0; pt < 3; ++pt) {
        const int d = pt == 0 ? 1 : (pt == 1 ? 4 : 16), head = 4 * pt + hg;
        const bf16_t* qrow = proj + (size_t)tc * PLD + PC_QB + head * 128 + 8 * kq;
        bf16x8 qf[4];
#pragma unroll
        for (int s = 0; s < 4; ++s) qf[s] = *(const bf16x8*)(qrow + 32 * s);
        const int nk = 129 + 240 / d, nsteps = (nk + 31) >> 5;
        const int lo = tc - 128 * d < 0 ? 0 : tc - 128 * d, hi = tc;
        const int base = t0 - 128 * d;
        const int i0 = base < 0 ? (-base + d - 1) / (32 * d) : 0;
        auto desc = [&](int i) { return base + 32 * d * (i0 + i); };
        attn_run<0, false>(qf, proj + PC_KB + head * 128, proj + PC_VB + head * 128, PLD, d, S - 1, desc, nsteps - i0, lo, hi, 0, st, vbuf, lane);
    }
    const float lt = quad_total(st.l), inv = lt > 0.f ? 1.f / lt : 0.f;
    bf16_t* op = nsaout + (size_t)tc * NOLD + 1024 + hg * 128 + 4 * kq;
#pragma unroll
    for (int db = 0; db < 8; ++db) { const f32x4 o = st.o[db] * inv; u32x2 w; w.x = cvt_pk_bf16(o[0], o[1]); w.y = cvt_pk_bf16(o[2], o[3]); *(u32x2*)(op + 16 * db) = w; }
}

__device__ __forceinline__ void compress_unit(int unit, const bf16_t* proj, const bf16_t* w1t, const bf16_t* w2t, const float* bias, bf16_t* outc, LAS unsigned char* scr, int lane) {
    const int l16 = lane & 15, kq = lane >> 4;
    const int rt = unit & 63, g = (unit >> 6) & 1, kv = unit >> 7;
    const bf16_t* raw = proj + (kv ? PC_VC : PC_KC) + 128 * g;
    const int n = 16 * rt + l16;
    f32x4 acc[16];
#pragma unroll
    for (int i = 0; i < 16; ++i) acc[i] = (f32x4){0.f, 0.f, 0.f, 0.f};
#pragma unroll 2
    for (int s = 0; s < 128; ++s) {
        const int tok = clampi(16 * n + (s >> 2), 0, S - 1);
        const bf16x8 af = *(const bf16x8*)(raw + (size_t)tok * PLD + (s & 3) * 32 + 8 * kq);
#pragma unroll
        for (int ct = 0; ct < 16; ++ct) { const bf16x8 bfr = *(const bf16x8*)(w1t + (size_t)(16 * ct + l16) * 4096 + 32 * s + 8 * kq);
            acc[ct] = __builtin_amdgcn_mfma_f32_16x16x32_bf16(af, bfr, acc[ct], 0, 0, 0); }
    }
#pragma unroll
    for (int ct = 0; ct < 16; ++ct) { const float bb = bias[16 * ct + l16];
#pragma unroll
        for (int r = 0; r < 4; ++r) { const float x = acc[ct][r] + bb; const float u2 = 1.5957691216f * (x + 0.044715f * x * x * x); const float gl = x * fsigmoid(u2);
            *(LAS bf16_t*)(scr + (4 * kq + r) * 528 + (16 * ct + l16) * 2) = (bf16_t)(cvt_pk_bf16(gl, 0.f) & 0xffffu); } }
    asm volatile("s_waitcnt lgkmcnt(0)" ::: "memory");
    f32x4 o2[8];
#pragma unroll
    for (int i = 0; i < 8; ++i) o2[i] = (f32x4){0.f, 0.f, 0.f, 0.f};
#pragma unroll
    for (int s = 0; s < 8; ++s) {
        const bf16x8 af = *(const LAS bf16x8*)(scr + l16 * 528 + (32 * s + 8 * kq) * 2);
#pragma unroll
        for (int dt = 0; dt < 8; ++dt) { const bf16x8 bfr = *(const bf16x8*)(w2t + (size_t)(16 * dt + l16) * 256 + 32 * s + 8 * kq);
            o2[dt] = __builtin_amdgcn_mfma_f32_16x16x32_bf16(af, bfr, o2[dt], 0, 0, 0); }
    }
    asm volatile("s_waitcnt lgkmcnt(0)" ::: "memory");
#pragma unroll
    for (int dt = 0; dt < 8; ++dt)
#pragma unroll
        for (int r = 0; r < 4; ++r) { const int nn = 16 * rt + 4 * kq + r; if (nn < 1023) outc[((size_t)g * 1024 + nn) * 128 + 16 * dt + l16] = (bf16_t)(cvt_pk_bf16(o2[dt][r], 0.f) & 0xffffu); }
}

__device__ __forceinline__ void nsa_unit(int unit, const bf16_t* proj, const bf16_t* kc, const bf16_t* vc, const bf16_t* gn, const float* cs, const float* sn,
                                         bf16_t* nsaout, LAS unsigned char* wl, int lane) {
    const int l16 = lane & 15, kq = lane >> 4;
    const int g = unit & 1, tb = unit >> 1, t0 = 4 * tb, qi = l16 >> 2, h = l16 & 3, tc = t0 + qi, head = 4 * g + h;
    LAS unsigned char* vbuf = wl; LAS float* imp = (LAS float*)(wl + VBUF_BYTES); LAS int* sel = (LAS int*)(wl + VBUF_BYTES + 4 * IMP_LD * 4);
    bf16x8 qf[4];
    { const bf16_t* qrow = proj + (size_t)tc * PLD + PC_QA + head * 128 + 8 * kq;
#pragma unroll
        for (int s = 0; s < 4; ++s) qf[s] = *(const bf16x8*)(qrow + 32 * s); }
    LAS u32x2* outl = (LAS u32x2*)(wl + OUT_OFF) + lane;
    for (int i = lane; i < 4 * IMP_LD; i += 64) imp[i] = 0.f;
    const int hic = (tc - 31) >> 4;
    const int nkmax = ((t0 + 3 - 31) >> 4) + 1, nsc = nkmax > 0 ? (nkmax + 31) >> 5 : 0;
    const bf16_t* kcg = kc + (size_t)g * 1024 * 128; const bf16_t* vcg = vc + (size_t)g * 1024 * 128;
    AState st; astate_init(st);
    { auto desc = [&](int i) { return 32 * i; };
      attn_run<1, false>(qf, kcg, vcg, 128, 1, 1022, desc, nsc, 0, hic, 0, st, vbuf, lane);
      { const float lt = quad_total(st.l); st.l = lt > 0.f ? 1.f / lt : 0.f; }
      asm volatile("s_waitcnt lgkmcnt(0)" ::: "memory");
      attn_run<2, false>(qf, kcg, vcg, 128, 1, 1022, desc, nsc, 0, hic, 0, st, vbuf, lane, imp); }
    const float g0 = bf2f(gn[(size_t)tc * 32 + head * 3 + 0]);
#pragma unroll
    for (int i = 0; i < 8; ++i) { const f32x4 o = st.o[i] * g0; u32x2 w; w.x = cvt_pk_bf16(o[0], o[1]); w.y = cvt_pk_bf16(o[2], o[3]); outl[64 * i] = w; }
    asm volatile("s_waitcnt lgkmcnt(0)" ::: "memory");
#pragma unroll
    for (int s2 = 0; s2 < 2; ++s2) {
        const int d = 32 * s2 + 8 * kq; f32x4 c[2], sv[2];
        c[0] = *(const f32x4*)(cs + (size_t)tc * 64 + d); c[1] = *(const f32x4*)(cs + (size_t)tc * 64 + d + 4);
        sv[0] = *(const f32x4*)(sn + (size_t)tc * 64 + d); sv[1] = *(const f32x4*)(sn + (size_t)tc * 64 + d + 4);
        float o1[8], o2[8];
#pragma unroll
        for (int j = 0; j < 8; ++j) { const float x1 = bf2f((unsigned short)qf[s2][j]), x2 = bf2f((unsigned short)qf[s2 + 2][j]), cc = c[j >> 2][j & 3], ss = sv[j >> 2][j & 3];
            o1[j] = x1 * cc - x2 * ss; o2[j] = x2 * cc + x1 * ss; }
        u32x4 w1, w2; w1.x = cvt_pk_bf16(o1[0], o1[1]); w1.y = cvt_pk_bf16(o1[2], o1[3]); w1.z = cvt_pk_bf16(o1[4], o1[5]); w1.w = cvt_pk_bf16(o1[6], o1[7]);
        w2.x = cvt_pk_bf16(o2[0], o2[1]); w2.y = cvt_pk_bf16(o2[2], o2[3]); w2.z = cvt_pk_bf16(o2[4], o2[5]); w2.w = cvt_pk_bf16(o2[6], o2[7]);
        qf[s2] = __builtin_bit_cast(bf16x8, w1); qf[s2 + 2] = __builtin_bit_cast(bf16x8, w2);
    }
    unsigned key[4][4];
#pragma unroll
    for (int q = 0; q < 4; ++q) { const int cur = (t0 + q) >> 6; const f32x4 v = *(const LAS f32x4*)(imp + q * IMP_LD + 4 * lane);
#pragma unroll
        for (int i = 0; i < 4; ++i) { const int j = 4 * lane + i; const bool valid = j <= cur, forced = (j == 0) | (j == cur) | (j == cur - 1);
            const unsigned kb = forced ? 0xffffffu : ((__float_as_uint(fmaxf(v[i], 0.f)) >> 8) + 1u);
            key[q][i] = valid ? ((kb << 8) | (unsigned)(255 - j)) : 0u; } }
#pragma unroll 1
    for (int r = 0; r < 16; ++r) {
        unsigned mx[4];
#pragma unroll
        for (int q = 0; q < 4; ++q) { unsigned a = key[q][0] > key[q][1] ? key[q][0] : key[q][1], b = key[q][2] > key[q][3] ? key[q][2] : key[q][3]; mx[q] = a > b ? a : b; }
#pragma unroll
        for (int o = 1; o < 64; o <<= 1)
#pragma unroll
            for (int q = 0; q < 4; ++q) { const unsigned other = (unsigned)__shfl_xor((int)mx[q], o); mx[q] = other > mx[q] ? other : mx[q]; }
#pragma unroll
        for (int q = 0; q < 4; ++q) {
#pragma unroll
            for (int i = 0; i < 4; ++i) if (key[q][i] == mx[q]) key[q][i] = 0u;
            if (lane == 0) sel[q * 16 + r] = mx[q] ? (int)(255u - (mx[q] & 255u)) : -1;
        }
    }
    asm volatile("s_waitcnt lgkmcnt(0)" ::: "memory");
    LAS int* list = (LAS int*)(wl + VBUF_BYTES + 4 * IMP_LD * 4 + 256);
    int nslc;
    { const int b = sel[lane]; const bool valid = b >= 0; const unsigned long long mask = __ballot(valid);
      const int idx = __popcll(mask & ((1ull << lane) - 1ull)); nslc = 2 * __popcll(mask);
      if (valid) { const int q = lane >> 4; list[2 * idx] = (64 * b) | (q << 20); list[2 * idx + 1] = (64 * b + 32) | (q << 20); } }
    asm volatile("s_waitcnt lgkmcnt(0)" ::: "memory");
    astate_init(st);
    { auto desc = [&](int i) { return __builtin_amdgcn_readfirstlane(list[i]); };
      attn_run<0, true>(qf, proj + PC_KSL + 128 * g, proj + PC_VSL + 128 * g, PLD, 1, S - 1, desc, nslc, 0, tc, qi, st, vbuf, lane); }
    { const float g1 = bf2f(gn[(size_t)tc * 32 + head * 3 + 1]); const float lt = quad_total(st.l), inv = (lt > 0.f ? 1.f / lt : 0.f) * g1;
#pragma unroll
        for (int i = 0; i < 8; ++i) { const f32x4 o = st.o[i] * inv; u32x2 w = outl[64 * i]; w.x = cvt_pk_bf16(bflo(w.x) + o[0], bfhi(w.x) + o[1]); w.y = cvt_pk_bf16(bflo(w.y) + o[2], bfhi(w.y) + o[3]); outl[64 * i] = w; } }
    astate_init(st);
    { const int lo = tc - 511 < 0 ? 0 : tc - 511; const int i0 = t0 < 511 ? (511 - t0) >> 5 : 0;
      auto desc = [&](int i) { return t0 - 511 + 32 * (i0 + i); };
      attn_run<0, false>(qf, proj + PC_KWN + 128 * g, proj + PC_VWN + 128 * g, PLD, 1, S - 1, desc, 17 - i0, lo, tc, 0, st, vbuf, lane); }
    { const float g2 = bf2f(gn[(size_t)tc * 32 + head * 3 + 2]); const float lt = quad_total(st.l), inv = (lt > 0.f ? 1.f / lt : 0.f) * g2;
#pragma unroll
        for (int i = 0; i < 8; ++i) { const f32x4 o = st.o[i] * inv; u32x2 w = outl[64 * i]; w.x = cvt_pk_bf16(bflo(w.x) + o[0], bfhi(w.x) + o[1]); w.y = cvt_pk_bf16(bflo(w.y) + o[2], bfhi(w.y) + o[3]); outl[64 * i] = w; } }
    bf16_t* op = nsaout + (size_t)tc * NOLD + head * 128 + 4 * kq;
#pragma unroll
    for (int db = 0; db < 8; ++db) *(u32x2*)(op + 16 * db) = outl[64 * db];
}

struct Params { const float* in[23]; float* out; unsigned char* ws; float inv_freq[64]; };

__global__ void __launch_bounds__(512, 2) fwd_megakernel(Params P) {
    extern __shared__ __attribute__((aligned(16))) unsigned char lds_raw[];
    LAS unsigned char* lds = (LAS unsigned char*)lds_raw;
    cg::grid_group grid = cg::this_grid();
#define PHASE_WS unsigned long long wsv_ = (unsigned long long)P.ws; asm volatile("" : "+s"(wsv_)); unsigned char* ws = (unsigned char*)(__attribute__((address_space(1))) unsigned char*)wsv_; int tid = threadIdx.x; asm volatile("" : "+v"(tid)); \
    const int lane = tid & 63, wave = __builtin_amdgcn_readfirstlane(tid >> 6), G = gridDim.x, gw = blockIdx.x * 8 + wave, ngw = G * 8; \
    const size_t gtid = (size_t)blockIdx.x * 512 + tid, gthreads = (size_t)G * 512; \
    LAS unsigned char* wl = lds + wave * WAVE_LDS; LAS float* scr = (LAS float*)wl; (void)lane; (void)gw; (void)ngw; (void)gtid; (void)gthreads; (void)wl; (void)scr
#define WAB ((bf16_t*)(ws + WS_WAB))
#define WO ((bf16_t*)(ws + WS_WO))
#define CW1K ((bf16_t*)(ws + WS_CW1K))
#define CW1V ((bf16_t*)(ws + WS_CW1V))
#define CW2K ((bf16_t*)(ws + WS_CW2K))
#define CW2V ((bf16_t*)(ws + WS_CW2V))
#define CBIAS ((float*)(ws + WS_CBIAS))
#define KC ((bf16_t*)(ws + WS_KC))
#define VC ((bf16_t*)(ws + WS_VC))
#define GN ((bf16_t*)(ws + WS_GN))
#define HF ((float*)(ws + WS_HF))
#define HB ((bf16_t*)(ws + WS_HB))
#define GU ((bf16_t*)(ws + WS_GU))
#define DN ((bf16_t*)(ws + WS_DN))
#define ACT ((bf16_t*)(ws + WS_ACT))
#define PROJ ((bf16_t*)(ws + WS_PROJ))
#define RCOS ((float*)(ws + WS_ROPE))
#define RSIN ((float*)(ws + WS_ROPE) + (size_t)S * 64)
#define WINT ((bf16_t*)(ws + WS_WIN))
#define NSAOUT ((bf16_t*)(ws + WS_NSAOUT))
#define SIGG ((bf16_t*)P.out)
    pg8::StaticOrder SO;
#define GRID_SYNC() do { __builtin_amdgcn_fence(__ATOMIC_RELEASE, "agent"); asm volatile("s_waitcnt vmcnt(0) lgkmcnt(0)" ::: "memory"); grid.sync(); __builtin_amdgcn_fence(__ATOMIC_ACQUIRE, "agent"); asm volatile("s_waitcnt vmcnt(0)" ::: "memory"); } while (0)

    { PHASE_WS;
        conv_ffn(P.in[1], P.in[2], P.in[3], GU, DN, scr, gw, ngw, lane);
        for (int it = gw; it < 32 * 360; it += ngw) { const int kb = it / 360, nb = it % 360, dr = nb * 32; const int sc = win_src_col(dr);
            tr_item(P.in[6], WIN_SRC, kb * 64, sc < 0 ? 0 : sc, sc < 0 ? 0 : (dr == 11264 ? 24 : 32), WINT, DM, dr, kb * 64, scr, lane); }
        for (int it = gw; it < 16 * 64; it += ngw) { const int kb = it / 64, nb = it % 64, c0 = nb * 32; tr_item(P.in[13], DM, kb * 64, c0, 32, WAB, 1536, 256 * (c0 >> 7) + (c0 & 127), kb * 64, scr, lane); }
        for (int it = gw; it < 8 * 64; it += ngw) { const int kb = it / 64, nb = it % 64, c0 = nb * 32; tr_item(P.in[14], DM, kb * 64, c0, 32, WAB, 1536, 256 * (c0 >> 7) + 128 + (c0 & 127), 1024 + kb * 64, scr, lane); }
        for (size_t i = gtid; i < (size_t)4096 * 64; i += gthreads) { const int r = (int)(i >> 6), c = (int)(i & 63); if ((r & 128) == 0) *(u32x4*)(WAB + (size_t)r * 1536 + 1024 + 8 * c) = (u32x4){0u, 0u, 0u, 0u}; }
        for (size_t i = gtid; i < (size_t)4096 * 128; i += gthreads) { const int r = (int)(i >> 7), c = (int)(i & 127); if (r & 128) *(u32x4*)(WAB + (size_t)r * 1536 + 8 * c) = (u32x4){0u, 0u, 0u, 0u}; }
        for (int it = gw; it < 32 * 64; it += ngw) { const int kb = it / 64, nb = it % 64; tr_item(P.in[15], DM, kb * 64, nb * 32, 32, WO, DM, nb * 32, kb * 64, scr, lane); }
        for (int it = gw; it < 2 * 64 * 8; it += ngw) { const int w = it / 512, r = it % 512, kb = r / 8, nb = r % 8; tr_item(w ? P.in[11] : P.in[8], 256, kb * 64, nb * 32, 32, w ? CW1V : CW1K, 4096, nb * 32, kb * 64, scr, lane); }
        for (int it = gw; it < 2 * 4 * 4; it += ngw) { const int w = it / 16, r = it % 16, kb = r / 4, nb = r % 4; tr_item(w ? P.in[12] : P.in[9], 128, kb * 64, nb * 32, 32, w ? CW2V : CW2K, 256, nb * 32, kb * 64, scr, lane); }
        { const float* x = P.in[0];
            for (size_t i = gtid; i < (size_t)S * DM / 8; i += gthreads) { const f32x4 a = *(const f32x4*)(x + 8 * i), b = *(const f32x4*)(x + 8 * i + 4); *(u32x4*)(HB + 8 * i) = pack8(a, b); } }
        for (int o = gw; o < 512; o += ngw) { const int w = o >> 8, c = o & 255; const float* pos = w ? P.in[10] : P.in[7]; const float* w1 = w ? P.in[11] : P.in[8];
            float s = 0.f; for (int kk = lane; kk < 4096; kk += 64) s += pos[kk] * w1[(size_t)kk * 256 + c];
            s = wave_sum(s); if (lane == 0) CBIAS[o] = s; }
    }
    GRID_SYNC();
    { PHASE_WS; pg8::Gemm g{HB, GU, S, NGU, DM, DM, DM}; SO.init(S, NGU, G, (int)blockIdx.x); EpiSwiglu E{ACT}; pg8::gemm_phase(lds, g, SO, E); }
    GRID_SYNC();
    { PHASE_WS; pg8::Gemm g{ACT, DN, S, DM, FF, FF, FF}; SO.init(S, DM, G, (int)blockIdx.x); EpiResF32 E{P.in[0], HF, ALPHA, 0.5f}; pg8::gemm_phase(lds, g, SO, E); }
    GRID_SYNC();
    { PHASE_WS;
        ln_rows(HF, HF, HB, P.in[4], P.in[5], gw, ngw, lane);
        for (size_t i = gtid; i < (size_t)S * 64; i += gthreads) { const int t = (int)(i >> 6), j = (int)(i & 63); const float ang = (float)t * P.inv_freq[j]; RCOS[i] = cosf(ang); RSIN[i] = sinf(ang); }
    }
    GRID_SYNC();
    { PHASE_WS; pg8::Gemm g{HB, WINT, S, NWIN, DM, DM, DM}; SO.init(S, NWIN, G, (int)blockIdx.x); EpiWin E{PROJ, SIGG, GN, RCOS, RSIN}; pg8::gemm_phase(lds, g, SO, E); }
    GRID_SYNC();
    { PHASE_WS;
        if (wave == 0) { for (int u = blockIdx.x; u < 256; u += G) { const int kv = u >> 7; compress_unit(u, PROJ, kv ? CW1V : CW1K, kv ? CW2V : CW2K, CBIAS + 256 * kv, kv ? VC : KC, wl, lane); } }
        else { for (int u = blockIdx.x * 7 + (wave - 1); u < 4096; u += G * 7) dilated_unit(u, PROJ, NSAOUT, wl, lane); }
    }
    GRID_SYNC();
    { PHASE_WS;
      if ((G & 7) == 0) {
          const int bx = blockIdx.x, x = bx & 7, g = x & 1, wj = ((bx >> 3) * 4 + (x >> 1)) * 8 + wave, nwj = (G >> 1) * 8;
          for (int tb = wj; tb < 4096; tb += nwj) nsa_unit(2 * tb + g, PROJ, KC, VC, GN, RCOS, RSIN, NSAOUT, wl, lane);
      } else { for (int u = gw; u < 8192; u += ngw) nsa_unit(u, PROJ, KC, VC, GN, RCOS, RSIN, NSAOUT, wl, lane); } }
    GRID_SYNC();
    { PHASE_WS; pg8::Gemm g{NSAOUT, WAB, S, 4096, NOLD, NOLD, NOLD}; SO.init(S, 4096, G, (int)blockIdx.x); EpiMerge E{SIGG, HB}; pg8::gemm_phase(lds, g, SO, E); }
    GRID_SYNC();
    { PHASE_WS; pg8::Gemm g{HB, WO, S, DM, DM, DM, DM}; SO.init(S, DM, G, (int)blockIdx.x); EpiResF32 E{HF, HF, ALPHA, 1.0f}; pg8::gemm_phase(lds, g, SO, E); }
    GRID_SYNC();
    { PHASE_WS;
        ln_rows(HF, HF, HB, P.in[16], P.in[17], gw, ngw, lane);
        conv_ffn(P.in[18], P.in[19], P.in[20], GU, DN, scr, gw, ngw, lane);
    }
    GRID_SYNC();
    { PHASE_WS; pg8::Gemm g{HB, GU, S, NGU, DM, DM, DM}; SO.init(S, NGU, G, (int)blockIdx.x); EpiSwiglu E{ACT}; pg8::gemm_phase(lds, g, SO, E); }
    GRID_SYNC();
    { PHASE_WS; pg8::Gemm g{ACT, DN, S, DM, FF, FF, FF}; SO.init(S, DM, G, (int)blockIdx.x); EpiResF32 E{HF, P.out, ALPHA, 0.5f}; pg8::gemm_phase(lds, g, SO, E); }
    GRID_SYNC();
    { PHASE_WS; (void)ws; ln_rows(P.out, P.out, nullptr, P.in[21], P.in[22], gw, ngw, lane); }
}

extern "C" void kernel_launch(void* const* d_in, const int* in_sizes, int n_in, void* d_out, int out_size, void* d_ws, size_t ws_size, hipStream_t stream) {
    static int grid = 0;
    if (grid == 0) {
        if (n_in != 23 || out_size != S * DM || ws_size < WS_END) { fprintf(stderr, "kernel_launch: unexpected shapes (n_in %d out %d ws %zu, need %zu)\n", n_in, out_size, ws_size, (size_t)WS_END); grid = -1; return; }
        int dev = 0, cus = 0, per_cu = 0;
        hipGetDevice(&dev); hipDeviceGetAttribute(&cus, hipDeviceAttributeMultiprocessorCount, dev);
        if (hipFuncSetAttribute((const void*)fwd_megakernel, hipFuncAttributeMaxDynamicSharedMemorySize, LDS_BYTES) != hipSuccess) { fprintf(stderr, "kernel_launch: hipFuncSetAttribute failed\n"); grid = -1; return; }
        if (hipOccupancyMaxActiveBlocksPerMultiprocessor(&per_cu, (const void*)fwd_megakernel, 512, LDS_BYTES) != hipSuccess || per_cu < 1) { fprintf(stderr, "kernel_launch: occupancy query failed (%d)\n", per_cu); (void)hipGetLastError(); per_cu = 1; }
        grid = cus * per_cu;
    }
    if (grid < 0) return;
    Params p{};
    for (int i = 0; i < 23; ++i) p.in[i] = (const float*)d_in[i];
    p.out = (float*)d_out; p.ws = (unsigned char*)d_ws;
    for (int i = 0; i < 64; ++i) p.inv_freq[i] = (float)pow(10000.0, -(double)i / 64.0);
    void* args[] = {&p};
    hipError_t e = hipLaunchCooperativeKernel((const void*)fwd_megakernel, dim3(grid), dim3(512), args, LDS_BYTES, stream);
    if (e != hipSuccess) fprintf(stderr, "kernel_launch: cooperative launch failed: %s (grid %d)\n", hipGetErrorString(e), grid);
}
```

```cpp
#include <hip/hip_runtime.h>
#include <hip/hip_cooperative_groups.h>
#include <cstdio>
#include <cstdint>
#include <cmath>
namespace cg = cooperative_groups;

#define LAS __attribute__((address_space(3)))
typedef unsigned short bf16_t;
typedef short bf16x8 __attribute__((ext_vector_type(8)));
typedef short s16x4 __attribute__((ext_vector_type(4)));
typedef float f32x4 __attribute__((ext_vector_type(4)));
typedef float f32x2 __attribute__((ext_vector_type(2)));
typedef unsigned u32x4 __attribute__((ext_vector_type(4)));
typedef unsigned u32x2 __attribute__((ext_vector_type(2)));

constexpr int S = 16384, DM = 2048, FF = 5632, NGU = 2 * FF, NWIN = 11520, WIN_SRC = 11288, PLD = 7168, NOLD = 1536;
constexpr float ALPHA = 1.189207115002721f;
constexpr float LN_EPS = 1e-5f;
constexpr float SL2 = 0.08838834764831845f * 1.4426950408889634f;
constexpr int PC_QA = 0, PC_KC = 1024, PC_VC = 1280, PC_KSL = 1536, PC_VSL = 1792, PC_KWN = 2048, PC_VWN = 2304, PC_QB = 2560, PC_KB = 4096, PC_VB = 5632;
constexpr size_t MiB = 1u << 20;
constexpr size_t WS_WAB = 1 * MiB, WS_WO = 13 * MiB, WS_CW1K = 21 * MiB, WS_CW1V = 23 * MiB, WS_CW2K = 25 * MiB, WS_CW2V = 25 * MiB + 65536, WS_CBIAS = 25 * MiB + 131072;
constexpr size_t WS_KC = 26 * MiB, WS_VC = 26 * MiB + 524288, WS_GN = 27 * MiB;
constexpr size_t WS_HF = 32 * MiB, WS_HB = 160 * MiB, WS_BIG = 224 * MiB;
constexpr size_t WS_GU = WS_BIG, WS_DN = WS_BIG + 44 * MiB, WS_ACT = WS_BIG + 66 * MiB;
constexpr size_t WS_PROJ = WS_BIG, WS_ROPE = WS_BIG + 224 * MiB;
constexpr size_t WS_WIN = 466 * MiB, WS_NSAOUT = 466 * MiB, WS_END = 514 * MiB;

constexpr int VROW = 272, VBUF_BYTES = 32 * VROW;
constexpr int IMP_LD = 260;
constexpr int OUT_OFF = VBUF_BYTES + 4 * IMP_LD * 4 + 256 + 512;
constexpr int WAVE_LDS = OUT_OFF + 4096;
constexpr int LDS_BYTES = 147456;

typedef __bf16 bf16x2_t __attribute__((ext_vector_type(2)));
__device__ __forceinline__ unsigned cvt_pk_bf16(float lo, float hi) { f32x2 v = {lo, hi}; bf16x2_t b = __builtin_convertvector(v, bf16x2_t); return __builtin_bit_cast(unsigned, b); }
__device__ __forceinline__ float bf2f(unsigned short b) { return __uint_as_float(((unsigned)b) << 16); }
__device__ __forceinline__ float bflo(unsigned w) { return __uint_as_float(w << 16); }
__device__ __forceinline__ float bfhi(unsigned w) { return __uint_as_float(w & 0xffff0000u); }
__device__ __forceinline__ float fsigmoid(float x) { return __builtin_amdgcn_rcpf(1.f + __expf(-x)); }
__device__ __forceinline__ float wave_sum(float v) {
#pragma unroll
    for (int o = 1; o < 64; o <<= 1) v += __shfl_xor(v, o);
    return v;
}
__device__ __forceinline__ u32x4 pack8(const f32x4 a, const f32x4 b) { u32x4 w; w.x = cvt_pk_bf16(a[0], a[1]); w.y = cvt_pk_bf16(a[2], a[3]); w.z = cvt_pk_bf16(b[0], b[1]); w.w = cvt_pk_bf16(b[2], b[3]); return w; }

namespace pg8 {
constexpr int BM = 256, BK = 64, HALF = 128, HTB = HALF * BK * 2, STAGE_BYTES = 8 * HTB, NXCD = 8, WGM = 8;
__host__ __device__ __forceinline__ int lds_byte(int r, int c) { const int st = (r >> 4) * 2 + (c >> 5), rr = r & 15, cc = c & 31, ob = rr * 64 + cc * 2; return st * 1024 + (ob ^ (((ob >> 9) & 1) << 5)); }
__host__ __device__ __forceinline__ void stage_rc(int b, int& R, int& C) { const int st = b / 1024, sb = b % 1024, swz = sb ^ (((sb >> 9) & 1) << 5); R = (st >> 1) * 16 + swz / 64; C = (st & 1) * 32 + (swz % 64) / 2; }
__host__ __device__ __forceinline__ int perm32(int rho) { const int n = rho >> 4, i = rho & 15; return 8 * (i >> 2) + 4 * n + (i & 3); }
struct Unit { int pm, pn; };
struct Gemm { const bf16_t* A; const bf16_t* Bt; int M, N, K, lda, ldb; };
struct StaticOrder {
    int nM, nN, nwg, G, c;
    __device__ void init(int M, int N, int G_, int c_) { nM = M / BM; nN = N / BM; nwg = nM * nN; G = G_; c = c_; }
    __device__ bool next(int i, Unit& u) const {
        const long L = (long)i * G + c; if (L >= nwg) return false;
        int wgid = (int)L; { const int q = nwg / NXCD, r = nwg % NXCD, xcd = wgid % NXCD, off = wgid / NXCD; wgid = (xcd < r ? xcd * (q + 1) : r * (q + 1) + (xcd - r) * q) + off; }
        const int nig = WGM * nN, gid = wgid / nig, fm = gid * WGM, gsz = (nM - fm) < WGM ? (nM - fm) : WGM;
        u.pm = fm + ((wgid % nig) % gsz); u.pn = (wgid % nig) / gsz; return true;
    }
};
typedef f32x4 Acc[2][2][4][2];

template <class Epi>
__device__ __forceinline__ void gemm_phase(LAS unsigned char* lds, const Gemm g, const StaticOrder& S_, const Epi& E) {
    const int tid = threadIdx.x, wid = __builtin_amdgcn_readfirstlane(tid >> 6), lane = tid & 63, wr = wid >> 2, wc = wid & 3, fr = lane & 15, fq = lane >> 4;
    const int K = g.K, nt = K / BK;
    unsigned voffA[2], voffB[2];
#pragma unroll
    for (int i = 0; i < 2; ++i) { int R, C; stage_rc(tid * 16 + i * 8192, R, C); const int Rb = Epi::PERM ? ((R & ~31) + perm32(R & 31)) : R;
        voffA[i] = (unsigned)(R * g.lda + C) * 2u; voffB[i] = (unsigned)(Rb * g.ldb + C) * 2u; }
    const size_t kstep = (size_t)(BK * 2);
    const size_t hstepA = (size_t)HALF * g.lda * 2, hstepB = (size_t)HALF * g.ldb * 2;
    const size_t tstepA = 2 * hstepA, tstepB = 2 * hstepB;
    const unsigned ldsw = (unsigned)wid * 1024u;
    const int aoff = lds_byte(wr * 64 + fr, fq * 8), boff = lds_byte(wc * 32 + fr, fq * 8);
#define PG8_SA(b, h) (((b) * 2 + (h)) * HTB)
#define PG8_SB(b, h) ((4 + (b) * 2 + (h)) * HTB)
#define PG8_STAGE(bufoff, gbase, voff) do { _Pragma("unroll") for (int _i = 0; _i < 2; ++_i) \
        __builtin_amdgcn_global_load_lds((const unsigned*)((const char*)(gbase) + (voff)[_i]), (LAS unsigned*)(lds + (bufoff) + ldsw + _i * 8192), 16, 0, 0); } while (0)
#define PG8_LDA(dst, b, h) do { _Pragma("unroll") for (int m = 0; m < 4; ++m) _Pragma("unroll") for (int k = 0; k < 2; ++k) dst[m][k] = *(const LAS bf16x8*)(lds + PG8_SA(b, h) + aoff + m * 2048 + k * 1024); } while (0)
#define PG8_LDB(dst, b, h) do { _Pragma("unroll") for (int n = 0; n < 2; ++n) _Pragma("unroll") for (int k = 0; k < 2; ++k) dst[n][k] = *(const LAS bf16x8*)(lds + PG8_SB(b, h) + boff + n * 2048 + k * 1024); } while (0)
#define PG8_MMA(ai, bj, At, Bt) do { __builtin_amdgcn_s_setprio(1); _Pragma("unroll") for (int m = 0; m < 4; ++m) _Pragma("unroll") for (int n = 0; n < 2; ++n) _Pragma("unroll") for (int k = 0; k < 2; ++k) \
        acc[ai][bj][m][n] = __builtin_amdgcn_mfma_f32_16x16x32_bf16(Bt[n][k], At[m][k], acc[ai][bj][m][n], 0, 0, 0); __builtin_amdgcn_s_setprio(0); } while (0)
#define PG8_WAIT_V(n) asm volatile("s_waitcnt vmcnt(" #n ")" ::: "memory")
#define PG8_WAIT_L(n) asm volatile("s_waitcnt lgkmcnt(" #n ")" ::: "memory")
#define PG8_BAR __builtin_amdgcn_s_barrier()
#define PG8_SCHED __builtin_amdgcn_sched_barrier(0)
    Unit cur, nxt; int ui = 0;
    if (!S_.next(0, cur)) return;
    Acc acc;
#pragma unroll
    for (int a = 0; a < 2; ++a)
#pragma unroll
        for (int b = 0; b < 2; ++b)
#pragma unroll
            for (int m = 0; m < 4; ++m)
#pragma unroll
                for (int n = 0; n < 2; ++n) acc[a][b][m][n] = (f32x4){0.f, 0.f, 0.f, 0.f};
    bf16x8 At[4][2], B0[2][2], B1[2][2];
    const char* cA = (const char*)g.A + (size_t)cur.pm * tstepA; const char* cB = (const char*)g.Bt + (size_t)cur.pn * tstepB;
    PG8_STAGE(PG8_SB(0, 0), cB, voffB); PG8_STAGE(PG8_SB(0, 1), cB + hstepB, voffB); PG8_STAGE(PG8_SA(0, 0), cA, voffA); PG8_STAGE(PG8_SA(0, 1), cA + hstepA, voffA);
    if (wr == 1) PG8_BAR;
    PG8_WAIT_V(2); PG8_BAR;
    PG8_STAGE(PG8_SB(1, 0), cB + kstep, voffB); PG8_STAGE(PG8_SA(1, 0), cA + kstep, voffA); PG8_STAGE(PG8_SB(1, 1), cB + hstepB + kstep, voffB);
    PG8_WAIT_V(6); PG8_BAR;
    for (;;) {
        const bool has_next = S_.next(ui + 1, nxt);
        const char* nA = has_next ? (const char*)g.A + (size_t)nxt.pm * tstepA : cA; const char* nB = has_next ? (const char*)g.Bt + (size_t)nxt.pn * tstepB : cB;
        for (int t = 0; t < nt; t += 2) {
            const bool last = (t == nt - 2);
            const char* a1 = cA + (size_t)(t + 1) * kstep;
            const char* a2 = last ? nA : cA + (size_t)(t + 2) * kstep; const char* b2 = last ? nB : cB + (size_t)(t + 2) * kstep;
            const char* a3 = a2 + kstep; const char* b3 = b2 + kstep;
            PG8_LDB(B0, 0, 0); PG8_LDB(B1, 0, 1); PG8_SCHED; PG8_LDA(At, 0, 0); PG8_STAGE(PG8_SA(1, 1), a1 + hstepA, voffA);
            PG8_WAIT_V(8); PG8_WAIT_L(0); PG8_BAR; PG8_MMA(0, 0, At, B0); PG8_MMA(0, 1, At, B1); PG8_BAR; PG8_SCHED;
            PG8_LDA(At, 0, 1); PG8_STAGE(PG8_SB(0, 0), b2, voffB); PG8_STAGE(PG8_SB(0, 1), b2 + hstepB, voffB); PG8_STAGE(PG8_SA(0, 0), a2, voffA);
            PG8_WAIT_V(8); PG8_WAIT_L(0); PG8_BAR; PG8_MMA(1, 0, At, B0); PG8_MMA(1, 1, At, B1); PG8_BAR; PG8_SCHED;
            PG8_LDB(B0, 1, 0); PG8_LDB(B1, 1, 1); PG8_SCHED; PG8_LDA(At, 1, 0); PG8_STAGE(PG8_SA(0, 1), a2 + hstepA, voffA);
            PG8_WAIT_V(8); PG8_WAIT_L(0); PG8_BAR; PG8_MMA(0, 0, At, B0); PG8_MMA(0, 1, At, B1); PG8_BAR; PG8_SCHED;
            PG8_LDA(At, 1, 1); PG8_STAGE(PG8_SB(1, 0), b3, voffB); PG8_STAGE(PG8_SB(1, 1), b3 + hstepB, voffB); PG8_STAGE(PG8_SA(1, 0), a3, voffA);
            PG8_WAIT_V(8); PG8_WAIT_L(0); PG8_BAR; PG8_MMA(1, 0, At, B0); PG8_MMA(1, 1, At, B1); PG8_BAR; PG8_SCHED;
        }
        if (wr == 0) PG8_BAR;
        E(acc, cur, wr, wc, fr, fq);
        if (!has_next) break;
#pragma unroll
        for (int a = 0; a < 2; ++a)
#pragma unroll
            for (int b = 0; b < 2; ++b)
#pragma unroll
                for (int m = 0; m < 4; ++m)
#pragma unroll
                    for (int n = 0; n < 2; ++n) acc[a][b][m][n] = (f32x4){0.f, 0.f, 0.f, 0.f};
        cur = nxt; cA = nA; cB = nB; ++ui;
        if (wr == 1) PG8_BAR;
    }
    PG8_WAIT_V(0);
    PG8_BAR;
#undef PG8_SA
#undef PG8_SB
#undef PG8_STAGE
#undef PG8_LDA
#undef PG8_LDB
#undef PG8_MMA
#undef PG8_WAIT_V
#undef PG8_WAIT_L
#undef PG8_BAR
#undef PG8_SCHED
}
}

struct EpiSwiglu {
    static constexpr bool PERM = true;
    bf16_t* O;
    __device__ __forceinline__ void operator()(const pg8::Acc& acc, const pg8::Unit& u, int wr, int wc, int fr, int fq) const {
        const int row0 = u.pm * 256 + wr * 64 + fr, col0 = u.pn * 128 + wc * 32 + 8 * fq;
#pragma unroll
        for (int ai = 0; ai < 2; ++ai)
#pragma unroll
            for (int m = 0; m < 4; ++m) {
                f32x4 v[2];
#pragma unroll
                for (int n = 0; n < 2; ++n)
#pragma unroll
                    for (int e = 0; e < 4; ++e) { const float gt = acc[ai][0][m][n][e], up = acc[ai][1][m][n][e]; v[n][e] = gt * fsigmoid(gt) * up; }
                *(u32x4*)(O + (size_t)(row0 + ai * 128 + m * 16) * FF + col0) = pack8(v[0], v[1]);
            }
    }
};
struct EpiResF32 {
    static constexpr bool PERM = false;
    const float* res; float* out; float a, b;
    __device__ __forceinline__ void operator()(const pg8::Acc& acc, const pg8::Unit& u, int wr, int wc, int fr, int fq) const {
        const int row0 = u.pm * 256 + wr * 64 + fr, col0 = u.pn * 256 + wc * 32 + 4 * fq;
#pragma unroll
        for (int ai = 0; ai < 2; ++ai)
#pragma unroll
            for (int m = 0; m < 4; ++m) {
                const size_t off = (size_t)(row0 + ai * 128 + m * 16) * DM + col0;
#pragma unroll
                for (int bj = 0; bj < 2; ++bj)
#pragma unroll
                    for (int n = 0; n < 2; ++n) { const f32x4 r = *(const f32x4*)(res + off + bj * 128 + n * 16); *(f32x4*)(out + off + bj * 128 + n * 16) = r * a + acc[ai][bj][m][n] * b; }
            }
    }
};
struct EpiWin {
    static constexpr bool PERM = true;
    bf16_t* proj; bf16_t* sigg; bf16_t* gn; const float* cs; const float* sn;
    __device__ __forceinline__ void operator()(const pg8::Acc& acc, const pg8::Unit& u, int wr, int wc, int fr, int fq) const {
        const int tile = u.pn, row0 = u.pm * 256 + wr * 64 + fr, cw = wc * 32 + 8 * fq;
        if (tile < 28) {
            const bool rope = (tile == 6) | (tile == 8) | (tile >= 10 && tile < 22);
            if (!rope) {
#pragma unroll
                for (int ai = 0; ai < 2; ++ai)
#pragma unroll
                    for (int m = 0; m < 4; ++m)
#pragma unroll
                        for (int bj = 0; bj < 2; ++bj)
                            *(u32x4*)(proj + (size_t)(row0 + ai * 128 + m * 16) * PLD + tile * 256 + bj * 128 + cw) = pack8(acc[ai][bj][m][0], acc[ai][bj][m][1]);
            } else {
                const int head = cw >> 6, d = cw & 63;
#pragma unroll
                for (int ai = 0; ai < 2; ++ai)
#pragma unroll
                    for (int m = 0; m < 4; ++m) {
                        const int row = row0 + ai * 128 + m * 16;
                        f32x4 o1[2], o2[2];
#pragma unroll
                        for (int n = 0; n < 2; ++n) {
                            const f32x4 c = *(const f32x4*)(cs + (size_t)row * 64 + d + 4 * n), s = *(const f32x4*)(sn + (size_t)row * 64 + d + 4 * n);
                            const f32x4 x1 = acc[ai][0][m][n], x2 = acc[ai][1][m][n];
                            o1[n] = x1 * c - x2 * s; o2[n] = x2 * c + x1 * s;
                        }
                        bf16_t* p = proj + (size_t)row * PLD + tile * 256 + head * 128 + d;
                        *(u32x4*)p = pack8(o1[0], o1[1]); *(u32x4*)(p + 64) = pack8(o2[0], o2[1]);
                    }
            }
        } else if (tile < 44) {
#pragma unroll
            for (int ai = 0; ai < 2; ++ai)
#pragma unroll
                for (int m = 0; m < 4; ++m)
#pragma unroll
                    for (int bj = 0; bj < 2; ++bj) {
                        f32x4 v[2];
#pragma unroll
                        for (int n = 0; n < 2; ++n)
#pragma unroll
                            for (int e = 0; e < 4; ++e) v[n][e] = fsigmoid(acc[ai][bj][m][n][e]);
                        *(u32x4*)(sigg + (size_t)(row0 + ai * 128 + m * 16) * 4096 + (tile - 28) * 256 + bj * 128 + cw) = pack8(v[0], v[1]);
                    }
        } else {
            if (wc == 0) {
#pragma unroll
                for (int ai = 0; ai < 2; ++ai)
#pragma unroll
                    for (int m = 0; m < 4; ++m) {
                        f32x4 v[2];
#pragma unroll
                        for (int n = 0; n < 2; ++n)
#pragma unroll
                            for (int e = 0; e < 4; ++e) v[n][e] = fsigmoid(acc[ai][0][m][n][e]);
                        *(u32x4*)(gn + (size_t)(row0 + ai * 128 + m * 16) * 32 + cw) = pack8(v[0], v[1]);
                    }
            }
        }
    }
};
struct EpiMerge {
    static constexpr bool PERM = true;
    const bf16_t* sigg; bf16_t* O;
    __device__ __forceinline__ void operator()(const pg8::Acc& acc, const pg8::Unit& u, int wr, int wc, int fr, int fq) const {
        const int row0 = u.pm * 256 + wr * 64 + fr, col0 = u.pn * 128 + wc * 32 + 8 * fq;
#pragma unroll
        for (int ai = 0; ai < 2; ++ai)
#pragma unroll
            for (int m = 0; m < 4; ++m) {
                const int row = row0 + ai * 128 + m * 16;
                const u32x4 ga = *(const u32x4*)(sigg + (size_t)row * 4096 + col0), gb = *(const u32x4*)(sigg + (size_t)row * 4096 + 2048 + col0);
                f32x4 v[2];
#pragma unroll
                for (int n = 0; n < 2; ++n) {
                    const unsigned a0 = n ? ga.z : ga.x, a1 = n ? ga.w : ga.y, b0 = n ? gb.z : gb.x, b1 = n ? gb.w : gb.y;
                    const f32x4 ya = acc[ai][0][m][n], yb = acc[ai][1][m][n];
                    v[n][0] = bflo(a0) * ya[0] + bflo(b0) * yb[0]; v[n][1] = bfhi(a0) * ya[1] + bfhi(b0) * yb[1];
                    v[n][2] = bflo(a1) * ya[2] + bflo(b1) * yb[2]; v[n][3] = bfhi(a1) * ya[3] + bfhi(b1) * yb[3];
                }
                *(u32x4*)(O + (size_t)row * DM + col0) = pack8(v[0], v[1]);
            }
    }
};

__device__ __forceinline__ void tr_item(const float* W, int ldw, int k0, int scol0, int nvalid, bf16_t* WT, int ldt, int drow0, int dk0, LAS float* scr, int lane) {
    const int c = lane & 31;
#pragma unroll 8
    for (int i = 0; i < 32; ++i) { const int kk = 2 * i + (lane >> 5); scr[kk * 33 + c] = (c < nvalid) ? W[(size_t)(k0 + kk) * ldw + scol0 + c] : 0.f; }
    asm volatile("s_waitcnt lgkmcnt(0)" ::: "memory");
    const int c8 = lane & 7;
#pragma unroll
    for (int j = 0; j < 4; ++j) { const int n = (lane >> 3) + 8 * j; const LAS float* s = scr + (8 * c8) * 33 + n;
        u32x4 o; o.x = cvt_pk_bf16(s[0 * 33], s[1 * 33]); o.y = cvt_pk_bf16(s[2 * 33], s[3 * 33]); o.z = cvt_pk_bf16(s[4 * 33], s[5 * 33]); o.w = cvt_pk_bf16(s[6 * 33], s[7 * 33]);
        *(u32x4*)(WT + (size_t)(drow0 + n) * ldt + dk0 + 8 * c8) = o; }
    asm volatile("s_waitcnt lgkmcnt(0)" ::: "memory");
}
__device__ __forceinline__ int win_src_col(int r) {
    if (r >= WIN_SRC) return -1;
    if (r >= 11264) return 2560 + (r - 11264);
    const int tile = r >> 8; int j = r & 255;
    const bool rope = (tile == 6) | (tile == 8) | (tile >= 10 && tile < 22);
    if (rope) { const int q = j >> 6, d = j & 63; j = (q & 1) * 128 + (q >> 1) * 64 + d; }
    const int c = tile * 256 + j;
    return c < 2560 ? c : c + 24;
}
__device__ __forceinline__ void conv_ffn(const float* Wg, const float* Wu, const float* Wd, bf16_t* GU, bf16_t* DN, LAS float* scr, int gw, int ngw, int lane) {
    constexpr int I_G = 32 * 176;
    for (int it = gw; it < 2 * I_G; it += ngw) { const int which = it / I_G, r = it % I_G, kb = r / 176, nb = r % 176, c0 = nb * 32;
        tr_item(which ? Wu : Wg, FF, kb * 64, c0, 32, GU, DM, 256 * (c0 >> 7) + (c0 & 127) + which * 128, kb * 64, scr, lane); }
    for (int it = gw; it < 88 * 64; it += ngw) { const int kb = it / 64, nb = it % 64; tr_item(Wd, DM, kb * 64, nb * 32, 32, DN, FF, nb * 32, kb * 64, scr, lane); }
}
__device__ __forceinline__ void ln_rows(const float* in, float* outf, bf16_t* outb, const float* g, const float* b, int gw, int ngw, int lane) {
    f32x4 gv[8], bv[8];
#pragma unroll
    for (int j = 0; j < 8; ++j) { gv[j] = *(const f32x4*)(g + 4 * (lane + 64 * j)); bv[j] = *(const f32x4*)(b + 4 * (lane + 64 * j)); }
    for (int row = gw; row < S; row += ngw) {
        const float* xr = in + (size_t)row * DM; f32x4 v[8]; float s = 0.f;
#pragma unroll
        for (int j = 0; j < 8; ++j) { v[j] = *(const f32x4*)(xr + 4 * (lane + 64 * j)); s += (v[j][0] + v[j][1]) + (v[j][2] + v[j][3]); }
        const float mean = wave_sum(s) * (1.f / DM); float s2 = 0.f;
#pragma unroll
        for (int j = 0; j < 8; ++j) { v[j] = v[j] - mean; s2 += (v[j][0] * v[j][0] + v[j][1] * v[j][1]) + (v[j][2] * v[j][2] + v[j][3] * v[j][3]); }
        const float rstd = 1.f / sqrtf(wave_sum(s2) * (1.f / DM) + LN_EPS);
#pragma unroll
        for (int j = 0; j < 8; ++j) { const f32x4 o = v[j] * rstd * gv[j] + bv[j];
            *(f32x4*)(outf + (size_t)row * DM + 4 * (lane + 64 * j)) = o;
            if (outb) { u32x2 w; w.x = cvt_pk_bf16(o[0], o[1]); w.y = cvt_pk_bf16(o[2], o[3]); *(u32x2*)(outb + (size_t)row * DM + 4 * (lane + 64 * j)) = w; } }
    }
}

struct AState { float m, l; f32x4 o[8]; };
__device__ __forceinline__ void astate_init(AState& s) { s.m = -1e30f; s.l = 0.f;
#pragma unroll
    for (int i = 0; i < 8; ++i) s.o[i] = (f32x4){0.f, 0.f, 0.f, 0.f}; }
__device__ __forceinline__ int clampi(int v, int lo, int hi) { return v < lo ? lo : (v > hi ? hi : v); }

__device__ __forceinline__ void load_k(bf16x8 (&kf)[2][4], const bf16_t* __restrict__ Kb, int ld, int pos0, int dpos, int posmax, int l16, int kq) {
#pragma unroll
    for (int T = 0; T < 2; ++T) { const int p = clampi(pos0 + dpos * (16 * T + l16), 0, posmax); const bf16_t* kp = Kb + (size_t)p * ld + 8 * kq;
#pragma unroll
        for (int s = 0; s < 4; ++s) kf[T][s] = *(const bf16x8*)(kp + 32 * s); }
}
__device__ __forceinline__ void load_v(u32x4 (&vr)[8], const bf16_t* __restrict__ Vb, int ld, int pos0, int dpos, int posmax, int l16, int kq) {
#pragma unroll
    for (int i = 0; i < 8; ++i) { const int p = clampi(pos0 + dpos * (4 * i + kq), 0, posmax); vr[i] = *(const u32x4*)(Vb + (size_t)p * ld + 8 * l16); }
}
__device__ __forceinline__ void store_v(const u32x4 (&vr)[8], LAS unsigned char* vbuf, int l16, int kq) {
#pragma unroll
    for (int i = 0; i < 8; ++i) *(LAS u32x4*)(vbuf + (4 * i + kq) * VROW + 16 * l16) = vr[i];
}
template <int MODE, bool SLC, class Desc>
__device__ __forceinline__ void attn_run(const bf16x8 (&qf)[4], const bf16_t* __restrict__ Kb, const bf16_t* __restrict__ Vb, int ld, int dpos, int posmax,
                                         const Desc& desc, int n, int lo_in, int hi, int qi, AState& st, LAS unsigned char* vbuf, int lane, LAS float* imp = nullptr) {
    if (n <= 0) return;
    const int l16 = lane & 15, kq = lane >> 4;
    u32x4 kr[8];
    int dcur = desc(0);
    load_v(kr, Kb, ld, SLC ? (dcur & 0xfffff) : dcur, dpos, posmax, l16, kq);
#pragma unroll 1
    for (int i = 0; i < n; ++i) {
        const int pos0 = SLC ? (dcur & 0xfffff) : dcur;
        const int lo = SLC ? (((dcur >> 20) == qi) ? 0 : (1 << 30)) : lo_in;
        store_v(kr, vbuf, l16, kq);
        u32x4 vr[8];
        if (MODE != 1) load_v(vr, Vb, ld, pos0, dpos, posmax, l16, kq);
        bf16x8 kf[2][4];
#pragma unroll
        for (int T = 0; T < 2; ++T)
#pragma unroll
            for (int s = 0; s < 4; ++s) kf[T][s] = *(const LAS bf16x8*)(vbuf + (16 * T + l16) * VROW + 64 * s + 16 * kq);
        f32x4 sa[2] = {(f32x4){0.f, 0.f, 0.f, 0.f}, (f32x4){0.f, 0.f, 0.f, 0.f}};
#pragma unroll
        for (int T = 0; T < 2; ++T)
#pragma unroll
            for (int s = 0; s < 4; ++s) sa[T] = __builtin_amdgcn_mfma_f32_16x16x32_bf16(kf[T][s], qf[s], sa[T], 0, 0, 0);
        const int dnext = desc(i + 1 < n ? i + 1 : i);
        load_v(kr, Kb, ld, SLC ? (dnext & 0xfffff) : dnext, dpos, posmax, l16, kq);
        float sc[8]; bool vd[8]; float mx = -1e30f;
#pragma unroll
        for (int T = 0; T < 2; ++T)
#pragma unroll
            for (int r = 0; r < 4; ++r) { const int p = pos0 + dpos * (16 * T + 4 * kq + r); const bool v = (p >= lo) & (p <= hi); const float x = sa[T][r] * SL2;
                sc[4 * T + r] = x; vd[4 * T + r] = v; mx = v ? fmaxf(mx, x) : mx; }
        float p[8];
        if (MODE == 2) {
#pragma unroll
            for (int j = 0; j < 8; ++j) p[j] = vd[j] ? __builtin_amdgcn_exp2f(sc[j] - st.m) * st.l : 0.f;
#pragma unroll
            for (int T = 0; T < 2; ++T) {
                float x = 2.f * (p[4 * T] + p[4 * T + 1] + p[4 * T + 2]) + p[4 * T + 3], y = p[4 * T + 3];
                x += __shfl_xor(x, 1); x += __shfl_xor(x, 2); y += __shfl_xor(y, 1); y += __shfl_xor(y, 2);
                if ((l16 & 3) == 0) { const int a = (pos0 >> 2) + 4 * T + kq; LAS float* ip = imp + (l16 >> 2) * IMP_LD + a;
                    ip[0] += x;
                    asm volatile("s_waitcnt lgkmcnt(0)" ::: "memory");
                    ip[1] += y; }
                asm volatile("s_waitcnt lgkmcnt(0)" ::: "memory");
            }
        } else {
            mx = fmaxf(mx, __shfl_xor(mx, 16)); mx = fmaxf(mx, __shfl_xor(mx, 32));
            const float mn = fmaxf(st.m, mx), alpha = __builtin_amdgcn_exp2f(st.m - mn); st.m = mn;
            float ps = 0.f;
#pragma unroll
            for (int j = 0; j < 8; ++j) { p[j] = vd[j] ? __builtin_amdgcn_exp2f(sc[j] - mn) : 0.f; ps += p[j]; }
            st.l = st.l * alpha + ps;
            if (MODE == 0) {
#pragma unroll
                for (int j = 0; j < 8; ++j) st.o[j] = st.o[j] * alpha;
            }
        }
        if (MODE != 1) {
            store_v(vr, vbuf, l16, kq);
            u32x4 pw; pw.x = cvt_pk_bf16(p[0], p[1]); pw.y = cvt_pk_bf16(p[2], p[3]); pw.z = cvt_pk_bf16(p[4], p[5]); pw.w = cvt_pk_bf16(p[6], p[7]);
            const bf16x8 pf = __builtin_bit_cast(bf16x8, pw);
            const unsigned addr = (unsigned)(uintptr_t)(vbuf) + (4 * kq + (l16 >> 2)) * VROW + (l16 & 3) * 8;
#pragma unroll
            for (int hf = 0; hf < 2; ++hf) {
                s16x4 a[8];
                asm volatile("s_waitcnt lgkmcnt(0)\n\t"
                             "ds_read_b64_tr_b16 %0, %8 offset:0\n\t"    "ds_read_b64_tr_b16 %1, %8 offset:32\n\t"
                             "ds_read_b64_tr_b16 %2, %8 offset:64\n\t"   "ds_read_b64_tr_b16 %3, %8 offset:96\n\t"
                             "ds_read_b64_tr_b16 %4, %8 offset:4352\n\t" "ds_read_b64_tr_b16 %5, %8 offset:4384\n\t"
                             "ds_read_b64_tr_b16 %6, %8 offset:4416\n\t" "ds_read_b64_tr_b16 %7, %8 offset:4448\n\t"
                             "s_waitcnt lgkmcnt(0)"
                             : "=&v"(a[0]), "=&v"(a[1]), "=&v"(a[2]), "=&v"(a[3]), "=&v"(a[4]), "=&v"(a[5]), "=&v"(a[6]), "=&v"(a[7])
                             : "v"(addr + 128 * hf) : "memory");
#pragma unroll
                for (int d4 = 0; d4 < 4; ++d4) { const int db = 4 * hf + d4;
                    bf16x8 af; af[0] = a[d4][0]; af[1] = a[d4][1]; af[2] = a[d4][2]; af[3] = a[d4][3]; af[4] = a[d4 + 4][0]; af[5] = a[d4 + 4][1]; af[6] = a[d4 + 4][2]; af[7] = a[d4 + 4][3];
                    st.o[db] = __builtin_amdgcn_mfma_f32_16x16x32_bf16(af, pf, st.o[db], 0, 0, 0); }
            }
        }
        dcur = dnext;
    }
}
__device__ __forceinline__ float quad_total(float v) { v += __shfl_xor(v, 16); v += __shfl_xor(v, 32); return v; }

__device__ __forceinline__ void dilated_unit(int unit, const bf16_t* proj, bf16_t* nsaout, LAS unsigned char* vbuf, int lane) {
    const int l16 = lane & 15, kq = lane >> 4;
    const int hg = unit & 3, r16 = (unit >> 2) & 15, ut = unit >> 6;
    const int t0 = r16 + 256 * ut, tc = t0 + 16 * l16;
    AState st; astate_init(st);
#pragma unroll 1
    for (int pt = 0; pt < 3; ++pt) {
        const int d = pt == 0 ? 1 : (pt == 1 ? 4 : 16), head = 4 * pt + hg;
        const bf16_t* qrow = proj + (size_t)tc * PLD + PC_QB + head * 128 + 8 * kq;
        bf16x8 qf[4];
#pragma unroll
        for (int s = 0; s < 4; ++s) qf[s] = *(const bf16x8*)(qrow + 32 * s);
        const int nk = 129 + 240 / d, nsteps = (nk + 31) >> 5;
        const int lo = tc - 128 * d < 0 ? 0 : tc - 128 * d, hi = tc;
        const int base = t0 - 128 * d;
        const int i0 = base < 0 ? (-base + d - 1) / (32 * d) : 0;
        auto desc = [&](int i) { return base + 32 * d * (i0 + i); };
        attn_run<0, false>(qf, proj + PC_KB + head * 128, proj + PC_VB + head * 128, PLD, d, S - 1, desc, nsteps - i0, lo, hi, 0, st, vbuf, lane);
    }
    const float lt = quad_total(st.l), inv = lt > 0.f ? 1.f / lt : 0.f;
    bf16_t* op = nsaout + (size_t)tc * NOLD + 1024 + hg * 128 + 4 * kq;
#pragma unroll
    for (int db = 0; db < 8; ++db) { const f32x4 o = st.o[db] * inv; u32x2 w; w.x = cvt_pk_bf16(o[0], o[1]); w.y = cvt_pk_bf16(o[2], o[3]); *(u32x2*)(op + 16 * db) = w; }
}

__device__ __forceinline__ void compress_unit(int unit, const bf16_t* proj, const bf16_t* w1t, const bf16_t* w2t, const float* bias, bf16_t* outc, LAS unsigned char* scr, int lane) {
    const int l16 = lane & 15, kq = lane >> 4;
    const int rt = unit & 63, g = (unit >> 6) & 1, kv = unit >> 7;
    const bf16_t* raw = proj + (kv ? PC_VC : PC_KC) + 128 * g;
    const int n = 16 * rt + l16;
    f32x4 acc[16];
#pragma unroll
    for (int i = 0; i < 16; ++i) acc[i] = (f32x4){0.f, 0.f, 0.f, 0.f};
#pragma unroll 2
    for (int s = 0; s < 128; ++s) {
        const int tok = clampi(16 * n + (s >> 2), 0, S - 1);
        const bf16x8 af = *(const bf16x8*)(raw + (size_t)tok * PLD + (s & 3) * 32 + 8 * kq);
#pragma unroll
        for (int ct = 0; ct < 16; ++ct) { const bf16x8 bfr = *(const bf16x8*)(w1t + (size_t)(16 * ct + l16) * 4096 + 32 * s + 8 * kq);
            acc[ct] = __builtin_amdgcn_mfma_f32_16x16x32_bf16(af, bfr, acc[ct], 0, 0, 0); }
    }
#pragma unroll
    for (int ct = 0; ct < 16; ++ct) { const float bb = bias[16 * ct + l16];
#pragma unroll
        for (int r = 0; r < 4; ++r) { const float x = acc[ct][r] + bb; const float u2 = 1.5957691216f * (x + 0.044715f * x * x * x); const float gl = x * fsigmoid(u2);
            *(LAS bf16_t*)(scr + (4 * kq + r) * 528 + (16 * ct + l16) * 2) = (bf16_t)(cvt_pk_bf16(gl, 0.f) & 0xffffu); } }
    asm volatile("s_waitcnt lgkmcnt(0)" ::: "memory");
    f32x4 o2[8];
#pragma unroll
    for (int i = 0; i < 8; ++i) o2[i] = (f32x4){0.f, 0.f, 0.f, 0.f};
#pragma unroll
    for (int s = 0; s < 8; ++s) {
        const bf16x8 af = *(const LAS bf16x8*)(scr + l16 * 528 + (32 * s + 8 * kq) * 2);
#pragma unroll
        for (int dt = 0; dt < 8; ++dt) { const bf16x8 bfr = *(const bf16x8*)(w2t + (size_t)(16 * dt + l16) * 256 + 32 * s + 8 * kq);
            o2[dt] = __builtin_amdgcn_mfma_f32_16x16x32_bf16(af, bfr, o2[dt], 0, 0, 0); }
    }
    asm volatile("s_waitcnt lgkmcnt(0)" ::: "memory");
#pragma unroll
    for (int dt = 0; dt < 8; ++dt)
#pragma unroll
        for (int r = 0; r < 4; ++r) { const int nn = 16 * rt + 4 * kq + r; if (nn < 1023) outc[((size_t)g * 1024 + nn) * 128 + 16 * dt + l16] = (bf16_t)(cvt_pk_bf16(o2[dt][r], 0.f) & 0xffffu); }
}

__device__ __forceinline__ void nsa_unit(int unit, const bf16_t* proj, const bf16_t* kc, const bf16_t* vc, const bf16_t* gn, const float* cs, const float* sn,
                                         bf16_t* nsaout, LAS unsigned char* wl, int lane) {
    const int l16 = lane & 15, kq = lane >> 4;
    const int g = unit & 1, tb = unit >> 1, t0 = 4 * tb, qi = l16 >> 2, h = l16 & 3, tc = t0 + qi, head = 4 * g + h;
    LAS unsigned char* vbuf = wl; LAS float* imp = (LAS float*)(wl + VBUF_BYTES); LAS int* sel = (LAS int*)(wl + VBUF_BYTES + 4 * IMP_LD * 4);
    bf16x8 qf[4];
    { const bf16_t* qrow = proj + (size_t)tc * PLD + PC_QA + head * 128 + 8 * kq;
#pragma unroll
        for (int s = 0; s < 4; ++s) qf[s] = *(const bf16x8*)(qrow + 32 * s); }
    LAS u32x2* outl = (LAS u32x2*)(wl + OUT_OFF) + lane;
    for (int i = lane; i < 4 * IMP_LD; i += 64) imp[i] = 0.f;
    const int hic = (tc - 31) >> 4;
    const int nkmax = ((t0 + 3 - 31) >> 4) + 1, nsc = nkmax > 0 ? (nkmax + 31) >> 5 : 0;
    const bf16_t* kcg = kc + (size_t)g * 1024 * 128; const bf16_t* vcg = vc + (size_t)g * 1024 * 128;
    AState st; astate_init(st);
    { auto desc = [&](int i) { return 32 * i; };
      attn_run<1, false>(qf, kcg, vcg, 128, 1, 1022, desc, nsc, 0, hic, 0, st, vbuf, lane);
      { const float lt = quad_total(st.l); st.l = lt > 0.f ? 1.f / lt : 0.f; }
      asm volatile("s_waitcnt lgkmcnt(0)" ::: "memory");
      attn_run<2, false>(qf, kcg, vcg, 128, 1, 1022, desc, nsc, 0, hic, 0, st, vbuf, lane, imp); }
    const float g0 = bf2f(gn[(size_t)tc * 32 + head * 3 + 0]);
#pragma unroll
    for (int i = 0; i < 8; ++i) { const f32x4 o = st.o[i] * g0; u32x2 w; w.x = cvt_pk_bf16(o[0], o[1]); w.y = cvt_pk_bf16(o[2], o[3]); outl[64 * i] = w; }
    asm volatile("s_waitcnt lgkmcnt(0)" ::: "memory");
#pragma unroll
    for (int s2 = 0; s2 < 2; ++s2) {
        const int d = 32 * s2 + 8 * kq; f32x4 c[2], sv[2];
        c[0] = *(const f32x4*)(cs + (size_t)tc * 64 + d); c[1] = *(const f32x4*)(cs + (size_t)tc * 64 + d + 4);
        sv[0] = *(const f32x4*)(sn + (size_t)tc * 64 + d); sv[1] = *(const f32x4*)(sn + (size_t)tc * 64 + d + 4);
        float o1[8], o2[8];
#pragma unroll
        for (int j = 0; j < 8; ++j) { const float x1 = bf2f((unsigned short)qf[s2][j]), x2 = bf2f((unsigned short)qf[s2 + 2][j]), cc = c[j >> 2][j & 3], ss = sv[j >> 2][j & 3];
            o1[j] = x1 * cc - x2 * ss; o2[j] = x2 * cc + x1 * ss; }
        u32x4 w1, w2; w1.x = cvt_pk_bf16(o1[0], o1[1]); w1.y = cvt_pk_bf16(o1[2], o1[3]); w1.z = cvt_pk_bf16(o1[4], o1[5]); w1.w = cvt_pk_bf16(o1[6], o1[7]);
        w2.x = cvt_pk_bf16(o2[0], o2[1]); w2.y = cvt_pk_bf16(o2[2], o2[3]); w2.z = cvt_pk_bf16(o2[4], o2[5]); w2.w = cvt_pk_bf16(o2[6], o2[7]);
        qf[s2] = __builtin_bit_cast(bf16x8, w1); qf[s2 + 2] = __builtin_bit_cast(bf16x8, w2);
    }
    unsigned key[4][4];
#pragma unroll
    for (int q = 0; q < 4; ++q) { const int cur = (t0 + q) >> 6; const f32x4 v = *(const LAS f32x4*)(imp + q * IMP_LD + 4 * lane);
#pragma unroll
        for (int i = 0; i < 4; ++i) { const int j = 4 * lane + i; const bool valid = j <= cur, forced = (j == 0) | (j == cur) | (j == cur - 1);
            const unsigned kb = forced ? 0xffffffu : ((__float_as_uint(fmaxf(v[i], 0.f)) >> 8) + 1u);
            key[q][i] = valid ? ((kb << 8) | (unsigned)(255 - j)) : 0u; } }
#pragma unroll 1
    for (int r = 0; r < 16; ++r) {
        unsigned mx[4];
#pragma unroll
        for (int q = 0; q < 4; ++q) { unsigned a = key[q][0] > key[q][1] ? key[q][0] : key[q][1], b = key[q][2] > key[q][3] ? key[q][2] : key[q][3]; mx[q] = a > b ? a : b; }
#pragma unroll
        for (int o = 1; o < 64; o <<= 1)
#pragma unroll
            for (int q = 0; q < 4; ++q) { const unsigned other = (unsigned)__shfl_xor((int)mx[q], o); mx[q] = other > mx[q] ? other : mx[q]; }
#pragma unroll
        for (int q = 0; q < 4; ++q) {
#pragma unroll
            for (int i = 0; i < 4; ++i) if (key[q][i] == mx[q]) key[q][i] = 0u;
            if (lane == 0) sel[q * 16 + r] = mx[q] ? (int)(255u - (mx[q] & 255u)) : -1;
        }
    }
    asm volatile("s_waitcnt lgkmcnt(0)" ::: "memory");
    LAS int* list = (LAS int*)(wl + VBUF_BYTES + 4 * IMP_LD * 4 + 256);
    int nslc;
    { const int b = sel[lane]; const bool valid = b >= 0; const unsigned long long mask = __ballot(valid);
      const int idx = __popcll(mask & ((1ull << lane) - 1ull)); nslc = 2 * __popcll(mask);
      if (valid) { const int q = lane >> 4; list[2 * idx] = (64 * b) | (q << 20); list[2 * idx + 1] = (64 * b + 32) | (q << 20); } }
    asm volatile("s_waitcnt lgkmcnt(0)" ::: "memory");
    astate_init(st);
    { auto desc = [&](int i) { return __builtin_amdgcn_readfirstlane(list[i]); };
      attn_run<0, true>(qf, proj + PC_KSL + 128 * g, proj + PC_VSL + 128 * g, PLD, 1, S - 1, desc, nslc, 0, tc, qi, st, vbuf, lane); }
    { const float g1 = bf2f(gn[(size_t)tc * 32 + head * 3 + 1]); const float lt = quad_total(st.l), inv = (lt > 0.f ? 1.f / lt : 0.f) * g1;
#pragma unroll
        for (int i = 0; i < 8; ++i) { const f32x4 o = st.o[i] * inv; u32x2 w = outl[64 * i]; w.x = cvt_pk_bf16(bflo(w.x) + o[0], bfhi(w.x) + o[1]); w.y = cvt_pk_bf16(bflo(w.y) + o[2], bfhi(w.y) + o[3]); outl[64 * i] = w; } }
    astate_init(st);
    { const int lo = tc - 511 < 0 ? 0 : tc - 511; const int i0 = t0 < 511 ? (511 - t0) >> 5 : 0;
      auto desc = [&](int i) { return t0 - 511 + 32 * (i0 + i); };
      attn_run<0, false>(qf, proj + PC_KWN + 128 * g, proj + PC_VWN + 128 * g, PLD, 1, S - 1, desc, 17 - i0, lo, tc, 0, st, vbuf, lane); }
    { const float g2 = bf2f(gn[(size_t)tc * 32 + head * 3 + 2]); const float lt = quad_total(st.l), inv = (lt > 0.f ? 1.f / lt : 0.f) * g2;
#pragma unroll
        for (int i = 0; i < 8; ++i) { const f32x4 o = st.o[i] * inv; u32x2 w = outl[64 * i]; w.x = cvt_pk_bf16(bflo(w.x) + o[0], bfhi(w.x) + o[1]); w.y = cvt_pk_bf16(bflo(w.y) + o[2], bfhi(w.y) + o[3]); outl[64 * i] = w; } }
    bf16_t* op = nsaout + (size_t)tc * NOLD + head * 128 + 4 * kq;
#pragma unroll
    for (int db = 0; db < 8; ++db) *(u32x2*)(op + 16 * db) = outl[64 * db];
}

struct Params { const float* in[23]; float* out; unsigned char* ws; float inv_freq[64]; };

__global__ void __launch_bounds__(512, 2) fwd_megakernel(Params P) {
    extern __shared__ __attribute__((aligned(16))) unsigned char lds_raw[];
    LAS unsigned char* lds = (LAS unsigned char*)lds_raw;
    cg::grid_group grid = cg::this_grid();
#define PHASE_WS unsigned long long wsv_ = (unsigned long long)P.ws; asm volatile("" : "+s"(wsv_)); unsigned char* ws = (unsigned char*)(__attribute__((address_space(1))) unsigned char*)wsv_; int tid = threadIdx.x; asm volatile("" : "+v"(tid)); \
    const int lane = tid & 63, wave = __builtin_amdgcn_readfirstlane(tid >> 6), G = gridDim.x, gw = blockIdx.x * 8 + wave, ngw = G * 8; \
    const size_t gtid = (size_t)blockIdx.x * 512 + tid, gthreads = (size_t)G * 512; \
    LAS unsigned char* wl = lds + wave * WAVE_LDS; LAS float* scr = (LAS float*)wl; (void)lane; (void)gw; (void)ngw; (void)gtid; (void)gthreads; (void)wl; (void)scr
#define WAB ((bf16_t*)(ws + WS_WAB))
#define WO ((bf16_t*)(ws + WS_WO))
#define CW1K ((bf16_t*)(ws + WS_CW1K))
#define CW1V ((bf16_t*)(ws + WS_CW1V))
#define CW2K ((bf16_t*)(ws + WS_CW2K))
#define CW2V ((bf16_t*)(ws + WS_CW2V))
#define CBIAS ((float*)(ws + WS_CBIAS))
#define KC ((bf16_t*)(ws + WS_KC))
#define VC ((bf16_t*)(ws + WS_VC))
#define GN ((bf16_t*)(ws + WS_GN))
#define HF ((float*)(ws + WS_HF))
#define HB ((bf16_t*)(ws + WS_HB))
#define GU ((bf16_t*)(ws + WS_GU))
#define DN ((bf16_t*)(ws + WS_DN))
#define ACT ((bf16_t*)(ws + WS_ACT))
#define PROJ ((bf16_t*)(ws + WS_PROJ))
#define RCOS ((float*)(ws + WS_ROPE))
#define RSIN ((float*)(ws + WS_ROPE) + (size_t)S * 64)
#define WINT ((bf16_t*)(ws + WS_WIN))
#define NSAOUT ((bf16_t*)(ws + WS_NSAOUT))
#define SIGG ((bf16_t*)P.out)
    pg8::StaticOrder SO;
#define GRID_SYNC() do { asm volatile("s_waitcnt vmcnt(0) lgkmcnt(0)" ::: "memory"); grid.sync(); \
        if (__builtin_amdgcn_readfirstlane(threadIdx.x >> 6) == 0) { __builtin_amdgcn_fence(__ATOMIC_ACQUIRE, "agent"); asm volatile("s_waitcnt vmcnt(0)" ::: "memory"); } \
        __syncthreads(); } while (0)

    { PHASE_WS;
        conv_ffn(P.in[1], P.in[2], P.in[3], GU, DN, scr, gw, ngw, lane);
        for (int it = gw; it < 32 * 360; it += ngw) { const int kb = it / 360, nb = it % 360, dr = nb * 32; const int sc = win_src_col(dr);
            tr_item(P.in[6], WIN_SRC, kb * 64, sc < 0 ? 0 : sc, sc < 0 ? 0 : (dr == 11264 ? 24 : 32), WINT, DM, dr, kb * 64, scr, lane); }
        for (int it = gw; it < 16 * 64; it += ngw) { const int kb = it / 64, nb = it % 64, c0 = nb * 32; tr_item(P.in[13], DM, kb * 64, c0, 32, WAB, 1536, 256 * (c0 >> 7) + (c0 & 127), kb * 64, scr, lane); }
        for (int it = gw; it < 8 * 64; it += ngw) { const int kb = it / 64, nb = it % 64, c0 = nb * 32; tr_item(P.in[14], DM, kb * 64, c0, 32, WAB, 1536, 256 * (c0 >> 7) + 128 + (c0 & 127), 1024 + kb * 64, scr, lane); }
        for (size_t i = gtid; i < (size_t)4096 * 64; i += gthreads) { const int r = (int)(i >> 6), c = (int)(i & 63); if ((r & 128) == 0) *(u32x4*)(WAB + (size_t)r * 1536 + 1024 + 8 * c) = (u32x4){0u, 0u, 0u, 0u}; }
        for (size_t i = gtid; i < (size_t)4096 * 128; i += gthreads) { const int r = (int)(i >> 7), c = (int)(i & 127); if (r & 128) *(u32x4*)(WAB + (size_t)r * 1536 + 8 * c) = (u32x4){0u, 0u, 0u, 0u}; }
        for (int it = gw; it < 32 * 64; it += ngw) { const int kb = it / 64, nb = it % 64; tr_item(P.in[15], DM, kb * 64, nb * 32, 32, WO, DM, nb * 32, kb * 64, scr, lane); }
        for (int it = gw; it < 2 * 64 * 8; it += ngw) { const int w = it / 512, r = it % 512, kb = r / 8, nb = r % 8; tr_item(w ? P.in[11] : P.in[8], 256, kb * 64, nb * 32, 32, w ? CW1V : CW1K, 4096, nb * 32, kb * 64, scr, lane); }
        for (int it = gw; it < 2 * 4 * 4; it += ngw) { const int w = it / 16, r = it % 16, kb = r / 4, nb = r % 4; tr_item(w ? P.in[12] : P.in[9], 128, kb * 64, nb * 32, 32, w ? CW2V : CW2K, 256, nb * 32, kb * 64, scr, lane); }
        { const float* x = P.in[0];
            for (size_t i = gtid; i < (size_t)S * DM / 8; i += gthreads) { const f32x4 a = *(const f32x4*)(x + 8 * i), b = *(const f32x4*)(x + 8 * i + 4); *(u32x4*)(HB + 8 * i) = pack8(a, b); } }
        for (int o = gw; o < 512; o += ngw) { const int w = o >> 8, c = o & 255; const float* pos = w ? P.in[10] : P.in[7]; const float* w1 = w ? P.in[11] : P.in[8];
            float s = 0.f; for (int kk = lane; kk < 4096; kk += 64) s += pos[kk] * w1[(size_t)kk * 256 + c];
            s = wave_sum(s); if (lane == 0) CBIAS[o] = s; }
    }
    GRID_SYNC();
    { PHASE_WS; pg8::Gemm g{HB, GU, S, NGU, DM, DM, DM}; SO.init(S, NGU, G, (int)blockIdx.x); EpiSwiglu E{ACT}; pg8::gemm_phase(lds, g, SO, E); }
    GRID_SYNC();
    { PHASE_WS; pg8::Gemm g{ACT, DN, S, DM, FF, FF, FF}; SO.init(S, DM, G, (int)blockIdx.x); EpiResF32 E{P.in[0], HF, ALPHA, 0.5f}; pg8::gemm_phase(lds, g, SO, E); }
    GRID_SYNC();
    { PHASE_WS;
        ln_rows(HF, HF, HB, P.in[4], P.in[5], gw, ngw, lane);
        for (size_t i = gtid; i < (size_t)S * 64; i += gthreads) { const int t = (int)(i >> 6), j = (int)(i & 63); const float ang = (float)t * P.inv_freq[j]; RCOS[i] = cosf(ang); RSIN[i] = sinf(ang); }
    }
    GRID_SYNC();
    { PHASE_WS; pg8::Gemm g{HB, WINT, S, NWIN, DM, DM, DM}; SO.init(S, NWIN, G, (int)blockIdx.x); EpiWin E{PROJ, SIGG, GN, RCOS, RSIN}; pg8::gemm_phase(lds, g, SO, E); }
    GRID_SYNC();
    { PHASE_WS;
        if (wave == 0) { for (int u = blockIdx.x; u < 256; u += G) { const int kv = u >> 7; compress_unit(u, PROJ, kv ? CW1V : CW1K, kv ? CW2V : CW2K, CBIAS + 256 * kv, kv ? VC : KC, wl, lane); } }
        else { for (int u = blockIdx.x * 7 + (wave - 1); u < 4096; u += G * 7) dilated_unit(u, PROJ, NSAOUT, wl, lane); }
    }
    GRID_SYNC();
    { PHASE_WS;
      if ((G & 7) == 0) {
          const int bx = blockIdx.x, x = bx & 7, g = x & 1, wj = ((bx >> 3) * 4 + (x >> 1)) * 8 + wave, nwj = (G >> 1) * 8;
          for (int tb = wj; tb < 4096; tb += nwj) nsa_unit(2 * tb + g, PROJ, KC, VC, GN, RCOS, RSIN, NSAOUT, wl, lane);
      } else { for (int u = gw; u < 8192; u += ngw) nsa_unit(u, PROJ, KC, VC, GN, RCOS, RSIN, NSAOUT, wl, lane); } }
    GRID_SYNC();
    { PHASE_WS; pg8::Gemm g{NSAOUT, WAB, S, 4096, NOLD, NOLD, NOLD}; SO.init(S, 4096, G, (int)blockIdx.x); EpiMerge E{SIGG, HB}; pg8::gemm_phase(lds, g, SO, E); }
    GRID_SYNC();
    { PHASE_WS; pg8::Gemm g{HB, WO, S, DM, DM, DM, DM}; SO.init(S, DM, G, (int)blockIdx.x); EpiResF32 E{HF, HF, ALPHA, 1.0f}; pg8::gemm_phase(lds, g, SO, E); }
    GRID_SYNC();
    { PHASE_WS;
        ln_rows(HF, HF, HB, P.in[16], P.in[17], gw, ngw, lane);
        conv_ffn(P.in[18], P.in[19], P.in[20], GU, DN, scr, gw, ngw, lane);
    }
    GRID_SYNC();
    { PHASE_WS; pg8::Gemm g{HB, GU, S, NGU, DM, DM, DM}; SO.init(S, NGU, G, (int)blockIdx.x); EpiSwiglu E{ACT}; pg8::gemm_phase(lds, g, SO, E); }
    GRID_SYNC();
    { PHASE_WS; pg8::Gemm g{ACT, DN, S, DM, FF, FF, FF}; SO.init(S, DM, G, (int)blockIdx.x); EpiResF32 E{HF, P.out, ALPHA, 0.5f}; pg8::gemm_phase(lds, g, SO, E); }
    GRID_SYNC();
    { PHASE_WS; (void)ws; ln_rows(P.out, P.out, nullptr, P.in[21], P.in[22], gw, ngw, lane); }
}

extern "C" void kernel_launch(void* const* d_in, const int* in_sizes, int n_in, void* d_out, int out_size, void* d_ws, size_t ws_size, hipStream_t stream) {
    static int grid = 0;
    if (grid == 0) {
        if (n_in != 23 || out_size != S * DM || ws_size < WS_END) { fprintf(stderr, "kernel_launch: unexpected shapes (n_in %d out %d ws %zu, need %zu)\n", n_in, out_size, ws_size, (size_t)WS_END); grid = -1; return; }
        int dev = 0, cus = 0, per_cu = 0;
        hipGetDevice(&dev); hipDeviceGetAttribute(&cus, hipDeviceAttributeMultiprocessorCount, dev);
        if (hipFuncSetAttribute((const void*)fwd_megakernel, hipFuncAttributeMaxDynamicSharedMemorySize, LDS_BYTES) != hipSuccess) { fprintf(stderr, "kernel_launch: hipFuncSetAttribute failed\n"); grid = -1; return; }
        if (hipOccupancyMaxActiveBlocksPerMultiprocessor(&per_cu, (const void*)fwd_megakernel, 512, LDS_BYTES) != hipSuccess || per_cu < 1) { fprintf(stderr, "kernel_launch: occupancy query failed (%d)\n", per_cu); (void)hipGetLastError(); per_cu = 1; }
        grid = cus * per_cu;
    }
    if (grid < 0) return;
    Params p{};
    for (int i = 0; i < 23; ++i) p.in[i] = (const float*)d_in[i];
    p.out = (float*)d_out; p.ws = (unsigned char*)d_ws;
    for (int i = 0; i < 64; ++i) p.inv_freq[i] = (float)pow(10000.0, -(double)i / 64.0);
    void* args[] = {&p};
    hipError_t e = hipLaunchCooperativeKernel((const void*)fwd_megakernel, dim3(grid), dim3(512), args, LDS_BYTES, stream);
    if (e != hipSuccess) fprintf(stderr, "kernel_launch: cooperative launch failed: %s (grid %d)\n", hipGetErrorString(e), grid);
}
```

```cpp
#include <hip/hip_runtime.h>
#include <hip/hip_cooperative_groups.h>
#include <cstdio>
#include <cstdint>
#include <cmath>
namespace cg = cooperative_groups;

#define LAS __attribute__((address_space(3)))
typedef unsigned short bf16_t;
typedef short bf16x8 __attribute__((ext_vector_type(8)));
typedef short s16x4 __attribute__((ext_vector_type(4)));
typedef float f32x4 __attribute__((ext_vector_type(4)));
typedef float f32x2 __attribute__((ext_vector_type(2)));
typedef unsigned u32x4 __attribute__((ext_vector_type(4)));
typedef unsigned u32x2 __attribute__((ext_vector_type(2)));

constexpr int S = 16384, DM = 2048, FF = 5632, NGU = 2 * FF, NWIN = 11520, WIN_SRC = 11288, PLD = 7168, NOLD = 1536;
constexpr float ALPHA = 1.189207115002721f;
constexpr float LN_EPS = 1e-5f;
constexpr float SL2 = 0.08838834764831845f * 1.4426950408889634f;
constexpr int PC_QA = 0, PC_KC = 1024, PC_VC = 1280, PC_KSL = 1536, PC_VSL = 1792, PC_KWN = 2048, PC_VWN = 2304, PC_QB = 2560, PC_KB = 4096, PC_VB = 5632;
constexpr size_t MiB = 1u << 20;
constexpr size_t WS_WAB = 1 * MiB, WS_WO = 13 * MiB, WS_CW1K = 21 * MiB, WS_CW1V = 23 * MiB, WS_CW2K = 25 * MiB, WS_CW2V = 25 * MiB + 65536, WS_CBIAS = 25 * MiB + 131072;
constexpr size_t WS_KC = 26 * MiB, WS_VC = 26 * MiB + 524288, WS_GN = 27 * MiB;
constexpr size_t WS_HF = 32 * MiB, WS_HB = 160 * MiB, WS_BIG = 224 * MiB;
constexpr size_t WS_GU = WS_BIG, WS_DN = WS_BIG + 44 * MiB, WS_ACT = WS_BIG + 66 * MiB;
constexpr size_t WS_PROJ = WS_BIG, WS_ROPE = WS_BIG + 224 * MiB;
constexpr size_t WS_WIN = 466 * MiB, WS_NSAOUT = 466 * MiB, WS_END = 514 * MiB;

constexpr int VROW = 272, VBUF_BYTES = 32 * VROW;
constexpr int IMP_LD = 260;
constexpr int OUT_OFF = VBUF_BYTES + 4 * IMP_LD * 4 + 256 + 512;
constexpr int WAVE_LDS = OUT_OFF + 4096;
constexpr int LDS_BYTES = 147456;

typedef __bf16 bf16x2_t __attribute__((ext_vector_type(2)));
__device__ __forceinline__ unsigned cvt_pk_bf16(float lo, float hi) { f32x2 v = {lo, hi}; bf16x2_t b = __builtin_convertvector(v, bf16x2_t); return __builtin_bit_cast(unsigned, b); }
__device__ __forceinline__ float bf2f(unsigned short b) { return __uint_as_float(((unsigned)b) << 16); }
__device__ __forceinline__ float bflo(unsigned w) { return __uint_as_float(w << 16); }
__device__ __forceinline__ float bfhi(unsigned w) { return __uint_as_float(w & 0xffff0000u); }
__device__ __forceinline__ float fsigmoid(float x) { return __builtin_amdgcn_rcpf(1.f + __expf(-x)); }
__device__ __forceinline__ float wave_sum(float v) {
#pragma unroll
    for (int o = 1; o < 64; o <<= 1) v += __shfl_xor(v, o);
    return v;
}
__device__ __forceinline__ u32x4 pack8(const f32x4 a, const f32x4 b) { u32x4 w; w.x = cvt_pk_bf16(a[0], a[1]); w.y = cvt_pk_bf16(a[2], a[3]); w.z = cvt_pk_bf16(b[0], b[1]); w.w = cvt_pk_bf16(b[2], b[3]); return w; }

namespace pg8 {
constexpr int BM = 256, BK = 64, HALF = 128, HTB = HALF * BK * 2, STAGE_BYTES = 8 * HTB, NXCD = 8, WGM = 8;
__host__ __device__ __forceinline__ int lds_byte(int r, int c) { const int st = (r >> 4) * 2 + (c >> 5), rr = r & 15, cc = c & 31, ob = rr * 64 + cc * 2; return st * 1024 + (ob ^ (((ob >> 9) & 1) << 5)); }
__host__ __device__ __forceinline__ void stage_rc(int b, int& R, int& C) { const int st = b / 1024, sb = b % 1024, swz = sb ^ (((sb >> 9) & 1) << 5); R = (st >> 1) * 16 + swz / 64; C = (st & 1) * 32 + (swz % 64) / 2; }
__host__ __device__ __forceinline__ int perm32(int rho) { const int n = rho >> 4, i = rho & 15; return 8 * (i >> 2) + 4 * n + (i & 3); }
struct Unit { int pm, pn; };
struct Gemm { const bf16_t* A; const bf16_t* Bt; int M, N, K, lda, ldb; };
struct StaticOrder {
    int nM, nN, nwg, G, c;
    __device__ void init(int M, int N, int G_, int c_) { nM = M / BM; nN = N / BM; nwg = nM * nN; G = G_; c = c_; }
    __device__ bool next(int i, Unit& u) const {
        const long L = (long)i * G + c; if (L >= nwg) return false;
        int wgid = (int)L; { const int q = nwg / NXCD, r = nwg % NXCD, xcd = wgid % NXCD, off = wgid / NXCD; wgid = (xcd < r ? xcd * (q + 1) : r * (q + 1) + (xcd - r) * q) + off; }
        const int nig = WGM * nN, gid = wgid / nig, fm = gid * WGM, gsz = (nM - fm) < WGM ? (nM - fm) : WGM;
        u.pm = fm + ((wgid % nig) % gsz); u.pn = (wgid % nig) / gsz; return true;
    }
};
typedef f32x4 Acc[2][2][4][2];

template <class Epi>
__device__ __forceinline__ void gemm_phase(LAS unsigned char* lds, const Gemm g, const StaticOrder& S_, const Epi& E) {
    const int tid = threadIdx.x, wid = __builtin_amdgcn_readfirstlane(tid >> 6), lane = tid & 63, wr = wid >> 2, wc = wid & 3, fr = lane & 15, fq = lane >> 4;
    const int K = g.K, nt = K / BK;
    unsigned voffA[2], voffB[2];
#pragma unroll
    for (int i = 0; i < 2; ++i) { int R, C; stage_rc(tid * 16 + i * 8192, R, C); const int Rb = Epi::PERM ? ((R & ~31) + perm32(R & 31)) : R;
        voffA[i] = (unsigned)(R * g.lda + C) * 2u; voffB[i] = (unsigned)(Rb * g.ldb + C) * 2u; }
    const size_t kstep = (size_t)(BK * 2);
    const size_t hstepA = (size_t)HALF * g.lda * 2, hstepB = (size_t)HALF * g.ldb * 2;
    const size_t tstepA = 2 * hstepA, tstepB = 2 * hstepB;
    const unsigned ldsw = (unsigned)wid * 1024u;
    const int aoff = lds_byte(wr * 64 + fr, fq * 8), boff = lds_byte(wc * 32 + fr, fq * 8);
#define PG8_SA(b, h) (((b) * 2 + (h)) * HTB)
#define PG8_SB(b, h) ((4 + (b) * 2 + (h)) * HTB)
#define PG8_STAGE(bufoff, gbase, voff) do { _Pragma("unroll") for (int _i = 0; _i < 2; ++_i) \
        __builtin_amdgcn_global_load_lds((const unsigned*)((const char*)(gbase) + (voff)[_i]), (LAS unsigned*)(lds + (bufoff) + ldsw + _i * 8192), 16, 0, 0); } while (0)
#define PG8_LDA(dst, b, h) do { _Pragma("unroll") for (int m = 0; m < 4; ++m) _Pragma("unroll") for (int k = 0; k < 2; ++k) dst[m][k] = *(const LAS bf16x8*)(lds + PG8_SA(b, h) + aoff + m * 2048 + k * 1024); } while (0)
#define PG8_LDB(dst, b, h) do { _Pragma("unroll") for (int n = 0; n < 2; ++n) _Pragma("unroll") for (int k = 0; k < 2; ++k) dst[n][k] = *(const LAS bf16x8*)(lds + PG8_SB(b, h) + boff + n * 2048 + k * 1024); } while (0)
#define PG8_MMA(ai, bj, At, Bt) do { __builtin_amdgcn_s_setprio(1); _Pragma("unroll") for (int m = 0; m < 4; ++m) _Pragma("unroll") for (int n = 0; n < 2; ++n) _Pragma("unroll") for (int k = 0; k < 2; ++k) \
        acc[ai][bj][m][n] = __builtin_amdgcn_mfma_f32_16x16x32_bf16(Bt[n][k], At[m][k], acc[ai][bj][m][n], 0, 0, 0); __builtin_amdgcn_s_setprio(0); } while (0)
#define PG8_WAIT_V(n) asm volatile("s_waitcnt vmcnt(" #n ")" ::: "memory")
#define PG8_WAIT_L(n) asm volatile("s_waitcnt lgkmcnt(" #n ")" ::: "memory")
#define PG8_BAR __builtin_amdgcn_s_barrier()
#define PG8_SCHED __builtin_amdgcn_sched_barrier(0)
    Unit cur, nxt; int ui = 0;
    if (!S_.next(0, cur)) return;
    Acc acc;
#pragma unroll
    for (int a = 0; a < 2; ++a)
#pragma unroll
        for (int b = 0; b < 2; ++b)
#pragma unroll
            for (int m = 0; m < 4; ++m)
#pragma unroll
                for (int n = 0; n < 2; ++n) acc[a][b][m][n] = (f32x4){0.f, 0.f, 0.f, 0.f};
    bf16x8 At[4][2], B0[2][2], B1[2][2];
    const char* cA = (const char*)g.A + (size_t)cur.pm * tstepA; const char* cB = (const char*)g.Bt + (size_t)cur.pn * tstepB;
    PG8_STAGE(PG8_SB(0, 0), cB, voffB); PG8_STAGE(PG8_SB(0, 1), cB + hstepB, voffB); PG8_STAGE(PG8_SA(0, 0), cA, voffA); PG8_STAGE(PG8_SA(0, 1), cA + hstepA, voffA);
    if (wr == 1) PG8_BAR;
    PG8_WAIT_V(2); PG8_BAR;
    PG8_STAGE(PG8_SB(1, 0), cB + kstep, voffB); PG8_STAGE(PG8_SA(1, 0), cA + kstep, voffA); PG8_STAGE(PG8_SB(1, 1), cB + hstepB + kstep, voffB);
    PG8_WAIT_V(6); PG8_BAR;
    for (;;) {
        const bool has_next = S_.next(ui + 1, nxt);
        const char* nA = has_next ? (const char*)g.A + (size_t)nxt.pm * tstepA : cA; const char* nB = has_next ? (const char*)g.Bt + (size_t)nxt.pn * tstepB : cB;
        for (int t = 0; t < nt; t += 2) {
            const bool last = (t == nt - 2);
            const char* a1 = cA + (size_t)(t + 1) * kstep;
            const char* a2 = last ? nA : cA + (size_t)(t + 2) * kstep; const char* b2 = last ? nB : cB + (size_t)(t + 2) * kstep;
            const char* a3 = a2 + kstep; const char* b3 = b2 + kstep;
            PG8_LDB(B0, 0, 0); PG8_LDB(B1, 0, 1); PG8_SCHED; PG8_LDA(At, 0, 0); PG8_STAGE(PG8_SA(1, 1), a1 + hstepA, voffA);
            PG8_WAIT_V(8); PG8_WAIT_L(0); PG8_BAR; PG8_MMA(0, 0, At, B0); PG8_MMA(0, 1, At, B1); PG8_BAR; PG8_SCHED;
            PG8_LDA(At, 0, 1); PG8_STAGE(PG8_SB(0, 0), b2, voffB); PG8_STAGE(PG8_SB(0, 1), b2 + hstepB, voffB); PG8_STAGE(PG8_SA(0, 0), a2, voffA);
            PG8_WAIT_V(8); PG8_WAIT_L(0); PG8_BAR; PG8_MMA(1, 0, At, B0); PG8_MMA(1, 1, At, B1); PG8_BAR; PG8_SCHED;
            PG8_LDB(B0, 1, 0); PG8_LDB(B1, 1, 1); PG8_SCHED; PG8_LDA(At, 1, 0); PG8_STAGE(PG8_SA(0, 1), a2 + hstepA, voffA);
            PG8_WAIT_V(8); PG8_WAIT_L(0); PG8_BAR; PG8_MMA(0, 0, At, B0); PG8_MMA(0, 1, At, B1); PG8_BAR; PG8_SCHED;
            PG8_LDA(At, 1, 1); PG8_STAGE(PG8_SB(1, 0), b3, voffB); PG8_STAGE(PG8_SB(1, 1), b3 + hstepB, voffB); PG8_STAGE(PG8_SA(1, 0), a3, voffA);
            PG8_WAIT_V(8); PG8_WAIT_L(0); PG8_BAR; PG8_MMA(1, 0, At, B0); PG8_MMA(1, 1, At, B1); PG8_BAR; PG8_SCHED;
        }
        if (wr == 0) PG8_BAR;
        E(acc, cur, wr, wc, fr, fq);
        if (!has_next) break;
#pragma unroll
        for (int a = 0; a < 2; ++a)
#pragma unroll
            for (int b = 0; b < 2; ++b)
#pragma unroll
                for (int m = 0; m < 4; ++m)
#pragma unroll
                    for (int n = 0; n < 2; ++n) acc[a][b][m][n] = (f32x4){0.f, 0.f, 0.f, 0.f};
        cur = nxt; cA = nA; cB = nB; ++ui;
        if (wr == 1) PG8_BAR;
    }
    PG8_WAIT_V(0);
    PG8_BAR;
#undef PG8_SA
#undef PG8_SB
#undef PG8_STAGE
#undef PG8_LDA
#undef PG8_LDB
#undef PG8_MMA
#undef PG8_WAIT_V
#undef PG8_WAIT_L
#undef PG8_BAR
#undef PG8_SCHED
}
}

struct EpiSwiglu {
    static constexpr bool PERM = true;
    bf16_t* O;
    __device__ __forceinline__ void operator()(const pg8::Acc& acc, const pg8::Unit& u, int wr, int wc, int fr, int fq) const {
        const int row0 = u.pm * 256 + wr * 64 + fr, col0 = u.pn * 128 + wc * 32 + 8 * fq;
#pragma unroll
        for (int ai = 0; ai < 2; ++ai)
#pragma unroll
            for (int m = 0; m < 4; ++m) {
                f32x4 v[2];
#pragma unroll
                for (int n = 0; n < 2; ++n)
#pragma unroll
                    for (int e = 0; e < 4; ++e) { const float gt = acc[ai][0][m][n][e], up = acc[ai][1][m][n][e]; v[n][e] = gt * fsigmoid(gt) * up; }
                *(u32x4*)(O + (size_t)(row0 + ai * 128 + m * 16) * FF + col0) = pack8(v[0], v[1]);
            }
    }
};
struct EpiResF32 {
    static constexpr bool PERM = false;
    const float* res; float* out; float a, b;
    __device__ __forceinline__ void operator()(const pg8::Acc& acc, const pg8::Unit& u, int wr, int wc, int fr, int fq) const {
        const int row0 = u.pm * 256 + wr * 64 + fr, col0 = u.pn * 256 + wc * 32 + 4 * fq;
#pragma unroll
        for (int ai = 0; ai < 2; ++ai)
#pragma unroll
            for (int m = 0; m < 4; ++m) {
                const size_t off = (size_t)(row0 + ai * 128 + m * 16) * DM + col0;
#pragma unroll
                for (int bj = 0; bj < 2; ++bj)
#pragma unroll
                    for (int n = 0; n < 2; ++n) { const f32x4 r = *(const f32x4*)(res + off + bj * 128 + n * 16); *(f32x4*)(out + off + bj * 128 + n * 16) = r * a + acc[ai][bj][m][n] * b; }
            }
    }
};
struct EpiWin {
    static constexpr bool PERM = true;
    bf16_t* proj; bf16_t* sigg; bf16_t* gn; const float* cs; const float* sn;
    __device__ __forceinline__ void operator()(const pg8::Acc& acc, const pg8::Unit& u, int wr, int wc, int fr, int fq) const {
        const int tile = u.pn, row0 = u.pm * 256 + wr * 64 + fr, cw = wc * 32 + 8 * fq;
        if (tile < 28) {
            const bool rope = (tile == 6) | (tile == 8) | (tile >= 10 && tile < 22);
            if (!rope) {
#pragma unroll
                for (int ai = 0; ai < 2; ++ai)
#pragma unroll
                    for (int m = 0; m < 4; ++m)
#pragma unroll
                        for (int bj = 0; bj < 2; ++bj)
                            *(u32x4*)(proj + (size_t)(row0 + ai * 128 + m * 16) * PLD + tile * 256 + bj * 128 + cw) = pack8(acc[ai][bj][m][0], acc[ai][bj][m][1]);
            } else {
                const int head = cw >> 6, d = cw & 63;
#pragma unroll
                for (int ai = 0; ai < 2; ++ai)
#pragma unroll
                    for (int m = 0; m < 4; ++m) {
                        const int row = row0 + ai * 128 + m * 16;
                        f32x4 o1[2], o2[2];
#pragma unroll
                        for (int n = 0; n < 2; ++n) {
                            const f32x4 c = *(const f32x4*)(cs + (size_t)row * 64 + d + 4 * n), s = *(const f32x4*)(sn + (size_t)row * 64 + d + 4 * n);
                            const f32x4 x1 = acc[ai][0][m][n], x2 = acc[ai][1][m][n];
                            o1[n] = x1 * c - x2 * s; o2[n] = x2 * c + x1 * s;
                        }
                        bf16_t* p = proj + (size_t)row * PLD + tile * 256 + head * 128 + d;
                        *(u32x4*)p = pack8(o1[0], o1[1]); *(u32x4*)(p + 64) = pack8(o2[0], o2[1]);
                    }
            }
        } else if (tile < 44) {
#pragma unroll
            for (int ai = 0; ai < 2; ++ai)
#pragma unroll
                for (int m = 0; m < 4; ++m)
#pragma unroll
                    for (int bj = 0; bj < 2; ++bj) {
                        f32x4 v[2];
#pragma unroll
                        for (int n = 0; n < 2; ++n)
#pragma unroll
                            for (int e = 0; e < 4; ++e) v[n][e] = fsigmoid(acc[ai][bj][m][n][e]);
                        *(u32x4*)(sigg + (size_t)(row0 + ai * 128 + m * 16) * 4096 + (tile - 28) * 256 + bj * 128 + cw) = pack8(v[0], v[1]);
                    }
        } else {
            if (wc == 0) {
#pragma unroll
                for (int ai = 0; ai < 2; ++ai)
#pragma unroll
                    for (int m = 0; m < 4; ++m) {
                        f32x4 v[2];
#pragma unroll
                        for (int n = 0; n < 2; ++n)
#pragma unroll
                            for (int e = 0; e < 4; ++e) v[n][e] = fsigmoid(acc[ai][0][m][n][e]);
                        *(u32x4*)(gn + (size_t)(row0 + ai * 128 + m * 16) * 32 + cw) = pack8(v[0], v[1]);
                    }
            }
        }
    }
};
template <bool FIRST> struct EpiGate {
    static constexpr bool PERM = true;
    const bf16_t* sg; bf16_t* O;
    __device__ __forceinline__ void operator()(const pg8::Acc& acc, const pg8::Unit& u, int wr, int wc, int fr, int fq) const {
        const int row0 = u.pm * 256 + wr * 64 + fr, col0 = u.pn * 256 + wc * 32 + 8 * fq;
#pragma unroll
        for (int ai = 0; ai < 2; ++ai)
#pragma unroll
            for (int m = 0; m < 4; ++m)
#pragma unroll
                for (int bj = 0; bj < 2; ++bj) {
                    const int row = row0 + ai * 128 + m * 16, col = col0 + bj * 128;
                    const u32x4 gv = *(const u32x4*)(sg + (size_t)row * 4096 + col);
                    u32x4 pv = (u32x4){0u, 0u, 0u, 0u}; if (!FIRST) pv = *(const u32x4*)(O + (size_t)row * DM + col);
                    f32x4 v[2];
#pragma unroll
                    for (int n = 0; n < 2; ++n) {
                        const unsigned g0 = n ? gv.z : gv.x, g1 = n ? gv.w : gv.y, p0 = n ? pv.z : pv.x, p1 = n ? pv.w : pv.y;
                        const f32x4 y = acc[ai][bj][m][n];
                        v[n][0] = bflo(p0) + bflo(g0) * y[0]; v[n][1] = bfhi(p0) + bfhi(g0) * y[1];
                        v[n][2] = bflo(p1) + bflo(g1) * y[2]; v[n][3] = bfhi(p1) + bfhi(g1) * y[3];
                    }
                    *(u32x4*)(O + (size_t)row * DM + col) = pack8(v[0], v[1]);
                }
    }
};

__device__ __forceinline__ void tr_item(const float* W, int ldw, int k0, int scol0, int nvalid, bf16_t* WT, int ldt, int drow0, int dk0, LAS float* scr, int lane) {
    const int c = lane & 31;
#pragma unroll 8
    for (int i = 0; i < 32; ++i) { const int kk = 2 * i + (lane >> 5); scr[kk * 33 + c] = (c < nvalid) ? W[(size_t)(k0 + kk) * ldw + scol0 + c] : 0.f; }
    asm volatile("s_waitcnt lgkmcnt(0)" ::: "memory");
    const int c8 = lane & 7;
#pragma unroll
    for (int j = 0; j < 4; ++j) { const int n = (lane >> 3) + 8 * j; const LAS float* s = scr + (8 * c8) * 33 + n;
        u32x4 o; o.x = cvt_pk_bf16(s[0 * 33], s[1 * 33]); o.y = cvt_pk_bf16(s[2 * 33], s[3 * 33]); o.z = cvt_pk_bf16(s[4 * 33], s[5 * 33]); o.w = cvt_pk_bf16(s[6 * 33], s[7 * 33]);
        *(u32x4*)(WT + (size_t)(drow0 + n) * ldt + dk0 + 8 * c8) = o; }
    asm volatile("s_waitcnt lgkmcnt(0)" ::: "memory");
}
__device__ __forceinline__ int win_src_col(int r) {
    if (r >= WIN_SRC) return -1;
    if (r >= 11264) return 2560 + (r - 11264);
    const int tile = r >> 8; int j = r & 255;
    const bool rope = (tile == 6) | (tile == 8) | (tile >= 10 && tile < 22);
    if (rope) { const int q = j >> 6, d = j & 63; j = (q & 1) * 128 + (q >> 1) * 64 + d; }
    const int c = tile * 256 + j;
    return c < 2560 ? c : c + 24;
}
__device__ __forceinline__ void conv_ffn(const float* Wg, const float* Wu, const float* Wd, bf16_t* GU, bf16_t* DN, LAS float* scr, int gw, int ngw, int lane) {
    constexpr int I_G = 32 * 176;
    for (int it = gw; it < 2 * I_G; it += ngw) { const int which = it / I_G, r = it % I_G, kb = r / 176, nb = r % 176, c0 = nb * 32;
        tr_item(which ? Wu : Wg, FF, kb * 64, c0, 32, GU, DM, 256 * (c0 >> 7) + (c0 & 127) + which * 128, kb * 64, scr, lane); }
    for (int it = gw; it < 88 * 64; it += ngw) { const int kb = it / 64, nb = it % 64; tr_item(Wd, DM, kb * 64, nb * 32, 32, DN, FF, nb * 32, kb * 64, scr, lane); }
}
__device__ __forceinline__ void ln_rows(const float* in, float* outf, bf16_t* outb, const float* g, const float* b, int gw, int ngw, int lane) {
    f32x4 gv[8], bv[8];
#pragma unroll
    for (int j = 0; j < 8; ++j) { gv[j] = *(const f32x4*)(g + 4 * (lane + 64 * j)); bv[j] = *(const f32x4*)(b + 4 * (lane + 64 * j)); }
    for (int row = gw; row < S; row += ngw) {
        const float* xr = in + (size_t)row * DM; f32x4 v[8]; float s = 0.f;
#pragma unroll
        for (int j = 0; j < 8; ++j) { v[j] = *(const f32x4*)(xr + 4 * (lane + 64 * j)); s += (v[j][0] + v[j][1]) + (v[j][2] + v[j][3]); }
        const float mean = wave_sum(s) * (1.f / DM); float s2 = 0.f;
#pragma unroll
        for (int j = 0; j < 8; ++j) { v[j] = v[j] - mean; s2 += (v[j][0] * v[j][0] + v[j][1] * v[j][1]) + (v[j][2] * v[j][2] + v[j][3] * v[j][3]); }
        const float rstd = 1.f / sqrtf(wave_sum(s2) * (1.f / DM) + LN_EPS);
#pragma unroll
        for (int j = 0; j < 8; ++j) { const f32x4 o = v[j] * rstd * gv[j] + bv[j];
            *(f32x4*)(outf + (size_t)row * DM + 4 * (lane + 64 * j)) = o;
            if (outb) { u32x2 w; w.x = cvt_pk_bf16(o[0], o[1]); w.y = cvt_pk_bf16(o[2], o[3]); *(u32x2*)(outb + (size_t)row * DM + 4 * (lane + 64 * j)) = w; } }
    }
}

struct AState { float m, l; f32x4 o[8]; };
__device__ __forceinline__ void astate_init(AState& s) { s.m = -1e30f; s.l = 0.f;
#pragma unroll
    for (int i = 0; i < 8; ++i) s.o[i] = (f32x4){0.f, 0.f, 0.f, 0.f}; }
__device__ __forceinline__ int clampi(int v, int lo, int hi) { return v < lo ? lo : (v > hi ? hi : v); }

__device__ __forceinline__ void load_k(bf16x8 (&kf)[2][4], const bf16_t* __restrict__ Kb, int ld, int pos0, int dpos, int posmax, int l16, int kq) {
#pragma unroll
    for (int T = 0; T < 2; ++T) { const int p = clampi(pos0 + dpos * (16 * T + l16), 0, posmax); const bf16_t* kp = Kb + (size_t)p * ld + 8 * kq;
#pragma unroll
        for (int s = 0; s < 4; ++s) kf[T][s] = *(const bf16x8*)(kp + 32 * s); }
}
__device__ __forceinline__ void load_v(u32x4 (&vr)[8], const bf16_t* __restrict__ Vb, int ld, int pos0, int dpos, int posmax, int l16, int kq) {
#pragma unroll
    for (int i = 0; i < 8; ++i) { const int p = clampi(pos0 + dpos * (4 * i + kq), 0, posmax); vr[i] = *(const u32x4*)(Vb + (size_t)p * ld + 8 * l16); }
}
__device__ __forceinline__ void store_v(const u32x4 (&vr)[8], LAS unsigned char* vbuf, int l16, int kq) {
#pragma unroll
    for (int i = 0; i < 8; ++i) *(LAS u32x4*)(vbuf + (4 * i + kq) * VROW + 16 * l16) = vr[i];
}
template <int MODE, bool SLC, class Desc>
__device__ __forceinline__ void attn_run(const bf16x8 (&qf)[4], const bf16_t* __restrict__ Kb, const bf16_t* __restrict__ Vb, int ld, int dpos, int posmax,
                                         const Desc& desc, int n, int lo_in, int hi, int qi, AState& st, LAS unsigned char* vbuf, int lane, LAS float* imp = nullptr) {
    if (n <= 0) return;
    const int l16 = lane & 15, kq = lane >> 4;
    u32x4 kr[8];
    int dcur = desc(0);
    load_v(kr, Kb, ld, SLC ? (dcur & 0xfffff) : dcur, dpos, posmax, l16, kq);
#pragma unroll 1
    for (int i = 0; i < n; ++i) {
        const int pos0 = SLC ? (dcur & 0xfffff) : dcur;
        const int lo = SLC ? ((((dcur >> 20) == qi) | ((dcur >> 20) == 4)) ? 0 : (1 << 30)) : lo_in;
        store_v(kr, vbuf, l16, kq);
        u32x4 vr[8];
        if (MODE != 1) load_v(vr, Vb, ld, pos0, dpos, posmax, l16, kq);
        bf16x8 kf[2][4];
#pragma unroll
        for (int T = 0; T < 2; ++T)
#pragma unroll
            for (int s = 0; s < 4; ++s) kf[T][s] = *(const LAS bf16x8*)(vbuf + (16 * T + l16) * VROW + 64 * s + 16 * kq);
        f32x4 sa[2] = {(f32x4){0.f, 0.f, 0.f, 0.f}, (f32x4){0.f, 0.f, 0.f, 0.f}};
#pragma unroll
        for (int T = 0; T < 2; ++T)
#pragma unroll
            for (int s = 0; s < 4; ++s) sa[T] = __builtin_amdgcn_mfma_f32_16x16x32_bf16(kf[T][s], qf[s], sa[T], 0, 0, 0);
        const int dnext = desc(i + 1 < n ? i + 1 : i);
        load_v(kr, Kb, ld, SLC ? (dnext & 0xfffff) : dnext, dpos, posmax, l16, kq);
        float sc[8]; bool vd[8]; float mx = -1e30f;
#pragma unroll
        for (int T = 0; T < 2; ++T)
#pragma unroll
            for (int r = 0; r < 4; ++r) { const int p = pos0 + dpos * (16 * T + 4 * kq + r); const bool v = (p >= lo) & (p <= hi); const float x = sa[T][r] * SL2;
                sc[4 * T + r] = x; vd[4 * T + r] = v; mx = v ? fmaxf(mx, x) : mx; }
        float p[8];
        if (MODE == 2) {
#pragma unroll
            for (int j = 0; j < 8; ++j) p[j] = vd[j] ? __builtin_amdgcn_exp2f(sc[j] - st.m) * st.l : 0.f;
#pragma unroll
            for (int T = 0; T < 2; ++T) {
                float x = 2.f * (p[4 * T] + p[4 * T + 1] + p[4 * T + 2]) + p[4 * T + 3], y = p[4 * T + 3];
                x += __shfl_xor(x, 1); x += __shfl_xor(x, 2); y += __shfl_xor(y, 1); y += __shfl_xor(y, 2);
                if ((l16 & 3) == 0) { const int a = (pos0 >> 2) + 4 * T + kq; LAS float* ip = imp + (l16 >> 2) * IMP_LD + a;
                    ip[0] += x;
                    asm volatile("s_waitcnt lgkmcnt(0)" ::: "memory");
                    ip[1] += y; }
                asm volatile("s_waitcnt lgkmcnt(0)" ::: "memory");
            }
        } else {
            if (__builtin_amdgcn_ballot_w64(mx > st.m + 40.f) != 0ull) {
                mx = fmaxf(mx, __shfl_xor(mx, 16)); mx = fmaxf(mx, __shfl_xor(mx, 32));
                const float mn = fmaxf(st.m, mx), alpha = __builtin_amdgcn_exp2f(st.m - mn); st.m = mn; st.l *= alpha;
                if (MODE == 0) {
#pragma unroll
                    for (int j = 0; j < 8; ++j) st.o[j] = st.o[j] * alpha;
                }
            }
            float ps = 0.f;
#pragma unroll
            for (int j = 0; j < 8; ++j) { p[j] = vd[j] ? __builtin_amdgcn_exp2f(sc[j] - st.m) : 0.f; ps += p[j]; }
            st.l += ps;
        }
        if (MODE != 1) {
            store_v(vr, vbuf, l16, kq);
            u32x4 pw; pw.x = cvt_pk_bf16(p[0], p[1]); pw.y = cvt_pk_bf16(p[2], p[3]); pw.z = cvt_pk_bf16(p[4], p[5]); pw.w = cvt_pk_bf16(p[6], p[7]);
            const bf16x8 pf = __builtin_bit_cast(bf16x8, pw);
            const unsigned addr = (unsigned)(uintptr_t)(vbuf) + (4 * kq + (l16 >> 2)) * VROW + (l16 & 3) * 8;
#pragma unroll
            for (int hf = 0; hf < 2; ++hf) {
                s16x4 a[8];
                asm volatile("s_waitcnt lgkmcnt(0)\n\t"
                             "ds_read_b64_tr_b16 %0, %8 offset:0\n\t"    "ds_read_b64_tr_b16 %1, %8 offset:32\n\t"
                             "ds_read_b64_tr_b16 %2, %8 offset:64\n\t"   "ds_read_b64_tr_b16 %3, %8 offset:96\n\t"
                             "ds_read_b64_tr_b16 %4, %8 offset:4352\n\t" "ds_read_b64_tr_b16 %5, %8 offset:4384\n\t"
                             "ds_read_b64_tr_b16 %6, %8 offset:4416\n\t" "ds_read_b64_tr_b16 %7, %8 offset:4448\n\t"
                             "s_waitcnt lgkmcnt(0)"
                             : "=&v"(a[0]), "=&v"(a[1]), "=&v"(a[2]), "=&v"(a[3]), "=&v"(a[4]), "=&v"(a[5]), "=&v"(a[6]), "=&v"(a[7])
                             : "v"(addr + 128 * hf) : "memory");
#pragma unroll
                for (int d4 = 0; d4 < 4; ++d4) { const int db = 4 * hf + d4;
                    bf16x8 af; af[0] = a[d4][0]; af[1] = a[d4][1]; af[2] = a[d4][2]; af[3] = a[d4][3]; af[4] = a[d4 + 4][0]; af[5] = a[d4 + 4][1]; af[6] = a[d4 + 4][2]; af[7] = a[d4 + 4][3];
                    st.o[db] = __builtin_amdgcn_mfma_f32_16x16x32_bf16(af, pf, st.o[db], 0, 0, 0); }
            }
        }
        dcur = dnext;
    }
}
__device__ __forceinline__ float quad_total(float v) { v += __shfl_xor(v, 16); v += __shfl_xor(v, 32); return v; }

__device__ __forceinline__ void dilated_unit(int unit, const bf16_t* proj, bf16_t* nsaout, LAS unsigned char* vbuf, int lane) {
    const int l16 = lane & 15, kq = lane >> 4;
    const int hg = unit & 3, r16 = (unit >> 2) & 15, ut = unit >> 6;
    const int t0 = r16 + 256 * ut, tc = t0 + 16 * l16;
    AState st; astate_init(st);
#pragma unroll 1
    for (int pt = 0; pt < 3; ++pt) {
        const int d = pt == 0 ? 1 : (pt == 1 ? 4 : 16), head = 4 * pt + hg;
        const bf16_t* qrow = proj + (size_t)tc * PLD + PC_QB + head * 128 + 8 * kq;
        bf16x8 qf[4];
#pragma unroll
        for (int s = 0; s < 4; ++s) qf[s] = *(const bf16x8*)(qrow + 32 * s);
        const int nk = 129 + 240 / d, nsteps = (nk + 31) >> 5;
        const int lo = tc - 128 * d < 0 ? 0 : tc - 128 * d, hi = tc;
        const int base = t0 - 128 * d;
        const int i0 = base < 0 ? (-base + d - 1) / (32 * d) : 0;
        auto desc = [&](int i) { return base + 32 * d * (i0 + i); };
        attn_run<0, false>(qf, proj + PC_KB + head * 128, proj + PC_VB + head * 128, PLD, d, S - 1, desc, nsteps - i0, lo, hi, 0, st, vbuf, lane);
    }
    const float lt = quad_total(st.l), inv = lt > 0.f ? 1.f / lt : 0.f;
    bf16_t* op = nsaout + (size_t)tc * NOLD + 1024 + hg * 128 + 4 * kq;
#pragma unroll
    for (int db = 0; db < 8; ++db) { const f32x4 o = st.o[db] * inv; u32x2 w; w.x = cvt_pk_bf16(o[0], o[1]); w.y = cvt_pk_bf16(o[2], o[3]); *(u32x2*)(op + 16 * db) = w; }
}

__device__ __forceinline__ void compress_unit(int unit, const bf16_t* proj, const bf16_t* w1t, const bf16_t* w2t, const float* bias, bf16_t* outc, LAS unsigned char* scr, int lane) {
    const int l16 = lane & 15, kq = lane >> 4;
    const int rt = unit & 63, g = (unit >> 6) & 1, kv = unit >> 7;
    const bf16_t* raw = proj + (kv ? PC_VC : PC_KC) + 128 * g;
    const int n = 16 * rt + l16;
    f32x4 acc[16];
#pragma unroll
    for (int i = 0; i < 16; ++i) acc[i] = (f32x4){0.f, 0.f, 0.f, 0.f};
#pragma unroll 2
    for (int s = 0; s < 128; ++s) {
        const int tok = clampi(16 * n + (s >> 2), 0, S - 1);
        const bf16x8 af = *(const bf16x8*)(raw + (size_t)tok * PLD + (s & 3) * 32 + 8 * kq);
#pragma unroll
        for (int ct = 0; ct < 16; ++ct) { const bf16x8 bfr = *(const bf16x8*)(w1t + (size_t)(16 * ct + l16) * 4096 + 32 * s + 8 * kq);
            acc[ct] = __builtin_amdgcn_mfma_f32_16x16x32_bf16(af, bfr, acc[ct], 0, 0, 0); }
    }
#pragma unroll
    for (int ct = 0; ct < 16; ++ct) { const float bb = bias[16 * ct + l16];
#pragma unroll
        for (int r = 0; r < 4; ++r) { const float x = acc[ct][r] + bb; const float u2 = 1.5957691216f * (x + 0.044715f * x * x * x); const float gl = x * fsigmoid(u2);
            *(LAS bf16_t*)(scr + (4 * kq + r) * 528 + (16 * ct + l16) * 2) = (bf16_t)(cvt_pk_bf16(gl, 0.f) & 0xffffu); } }
    asm volatile("s_waitcnt lgkmcnt(0)" ::: "memory");
    f32x4 o2[8];
#pragma unroll
    for (int i = 0; i < 8; ++i) o2[i] = (f32x4){0.f, 0.f, 0.f, 0.f};
#pragma unroll
    for (int s = 0; s < 8; ++s) {
        const bf16x8 af = *(const LAS bf16x8*)(scr + l16 * 528 + (32 * s + 8 * kq) * 2);
#pragma unroll
        for (int dt = 0; dt < 8; ++dt) { const bf16x8 bfr = *(const bf16x8*)(w2t + (size_t)(16 * dt + l16) * 256 + 32 * s + 8 * kq);
            o2[dt] = __builtin_amdgcn_mfma_f32_16x16x32_bf16(af, bfr, o2[dt], 0, 0, 0); }
    }
    asm volatile("s_waitcnt lgkmcnt(0)" ::: "memory");
#pragma unroll
    for (int dt = 0; dt < 8; ++dt)
#pragma unroll
        for (int r = 0; r < 4; ++r) { const int nn = 16 * rt + 4 * kq + r; if (nn < 1023) outc[((size_t)g * 1024 + nn) * 128 + 16 * dt + l16] = (bf16_t)(cvt_pk_bf16(o2[dt][r], 0.f) & 0xffffu); }
}

__device__ __forceinline__ void nsa_unit(int unit, const bf16_t* proj, const bf16_t* kc, const bf16_t* vc, const bf16_t* gn, const float* cs, const float* sn,
                                         bf16_t* nsaout, LAS unsigned char* wl, int lane) {
    const int l16 = lane & 15, kq = lane >> 4;
    const int g = unit & 1, tb = unit >> 1, t0 = 4 * tb, qi = l16 >> 2, h = l16 & 3, tc = t0 + qi, head = 4 * g + h;
    LAS unsigned char* vbuf = wl; LAS float* imp = (LAS float*)(wl + VBUF_BYTES); LAS int* sel = (LAS int*)(wl + VBUF_BYTES + 4 * IMP_LD * 4);
    bf16x8 qf[4];
    { const bf16_t* qrow = proj + (size_t)tc * PLD + PC_QA + head * 128 + 8 * kq;
#pragma unroll
        for (int s = 0; s < 4; ++s) qf[s] = *(const bf16x8*)(qrow + 32 * s); }
    LAS u32x2* outl = (LAS u32x2*)(wl + OUT_OFF) + lane;
    for (int i = lane; i < 4 * IMP_LD; i += 64) imp[i] = 0.f;
    const int hic = (tc - 31) >> 4;
    const int nkmax = ((t0 + 3 - 31) >> 4) + 1, nsc = nkmax > 0 ? (nkmax + 31) >> 5 : 0;
    const bf16_t* kcg = kc + (size_t)g * 1024 * 128; const bf16_t* vcg = vc + (size_t)g * 1024 * 128;
    AState st; astate_init(st);
    { auto desc = [&](int i) { return 32 * i; };
      attn_run<1, false>(qf, kcg, vcg, 128, 1, 1022, desc, nsc, 0, hic, 0, st, vbuf, lane);
      { const float lt = quad_total(st.l); st.l = lt > 0.f ? 1.f / lt : 0.f; }
      asm volatile("s_waitcnt lgkmcnt(0)" ::: "memory");
      attn_run<2, false>(qf, kcg, vcg, 128, 1, 1022, desc, nsc, 0, hic, 0, st, vbuf, lane, imp); }
    const float g0 = bf2f(gn[(size_t)tc * 32 + head * 3 + 0]);
#pragma unroll
    for (int i = 0; i < 8; ++i) { const f32x4 o = st.o[i] * g0; u32x2 w; w.x = cvt_pk_bf16(o[0], o[1]); w.y = cvt_pk_bf16(o[2], o[3]); outl[64 * i] = w; }
    asm volatile("s_waitcnt lgkmcnt(0)" ::: "memory");
#pragma unroll
    for (int s2 = 0; s2 < 2; ++s2) {
        const int d = 32 * s2 + 8 * kq; f32x4 c[2], sv[2];
        c[0] = *(const f32x4*)(cs + (size_t)tc * 64 + d); c[1] = *(const f32x4*)(cs + (size_t)tc * 64 + d + 4);
        sv[0] = *(const f32x4*)(sn + (size_t)tc * 64 + d); sv[1] = *(const f32x4*)(sn + (size_t)tc * 64 + d + 4);
        float o1[8], o2[8];
#pragma unroll
        for (int j = 0; j < 8; ++j) { const float x1 = bf2f((unsigned short)qf[s2][j]), x2 = bf2f((unsigned short)qf[s2 + 2][j]), cc = c[j >> 2][j & 3], ss = sv[j >> 2][j & 3];
            o1[j] = x1 * cc - x2 * ss; o2[j] = x2 * cc + x1 * ss; }
        u32x4 w1, w2; w1.x = cvt_pk_bf16(o1[0], o1[1]); w1.y = cvt_pk_bf16(o1[2], o1[3]); w1.z = cvt_pk_bf16(o1[4], o1[5]); w1.w = cvt_pk_bf16(o1[6], o1[7]);
        w2.x = cvt_pk_bf16(o2[0], o2[1]); w2.y = cvt_pk_bf16(o2[2], o2[3]); w2.z = cvt_pk_bf16(o2[4], o2[5]); w2.w = cvt_pk_bf16(o2[6], o2[7]);
        qf[s2] = __builtin_bit_cast(bf16x8, w1); qf[s2 + 2] = __builtin_bit_cast(bf16x8, w2);
    }
    unsigned key[4][4];
#pragma unroll
    for (int q = 0; q < 4; ++q) { const int cur = (t0 + q) >> 6; const f32x4 v = *(const LAS f32x4*)(imp + q * IMP_LD + 4 * lane);
#pragma unroll
        for (int i = 0; i < 4; ++i) { const int j = 4 * lane + i; const bool valid = j <= cur, forced = (j == 0) | (j == cur) | (j == cur - 1);
            const unsigned kb = forced ? 0xffffffu : ((__float_as_uint(fmaxf(v[i], 0.f)) >> 8) + 1u);
            key[q][i] = valid ? ((kb << 8) | (unsigned)(255 - j)) : 0u; } }
#pragma unroll 1
    for (int r = 0; r < 16; ++r) {
        unsigned mx[4];
#pragma unroll
        for (int q = 0; q < 4; ++q) { unsigned a = key[q][0] > key[q][1] ? key[q][0] : key[q][1], b = key[q][2] > key[q][3] ? key[q][2] : key[q][3]; mx[q] = a > b ? a : b; }
#pragma unroll
        for (int o = 1; o < 64; o <<= 1)
#pragma unroll
            for (int q = 0; q < 4; ++q) { const unsigned other = (unsigned)__shfl_xor((int)mx[q], o); mx[q] = other > mx[q] ? other : mx[q]; }
#pragma unroll
        for (int q = 0; q < 4; ++q) {
#pragma unroll
            for (int i = 0; i < 4; ++i) if (key[q][i] == mx[q]) key[q][i] = 0u;
            if (lane == 0) sel[q * 16 + r] = mx[q] ? (int)(255u - (mx[q] & 255u)) : -1;
        }
    }
    asm volatile("s_waitcnt lgkmcnt(0)" ::: "memory");
    LAS int* list = (LAS int*)(wl + VBUF_BYTES + 4 * IMP_LD * 4 + 256);
    int nslc;
    { const int b = sel[lane], q = lane >> 4, cur0 = t0 >> 6;
      const bool forced = (b == 0) | (b == cur0) | (b == cur0 - 1);
      const bool valid = (b >= 0) & !(forced & (q > 0)); const unsigned long long mask = __ballot(valid);
      const int idx = __popcll(mask & ((1ull << lane) - 1ull)); nslc = 2 * __popcll(mask);
      if (valid) { const int qc = forced ? 4 : q; list[2 * idx] = (64 * b) | (qc << 20); list[2 * idx + 1] = (64 * b + 32) | (qc << 20); } }
    asm volatile("s_waitcnt lgkmcnt(0)" ::: "memory");
    astate_init(st);
    { auto desc = [&](int i) { return __builtin_amdgcn_readfirstlane(list[i]); };
      attn_run<0, true>(qf, proj + PC_KSL + 128 * g, proj + PC_VSL + 128 * g, PLD, 1, S - 1, desc, nslc, 0, tc, qi, st, vbuf, lane); }
    { const float g1 = bf2f(gn[(size_t)tc * 32 + head * 3 + 1]); const float lt = quad_total(st.l), inv = (lt > 0.f ? 1.f / lt : 0.f) * g1;
#pragma unroll
        for (int i = 0; i < 8; ++i) { const f32x4 o = st.o[i] * inv; u32x2 w = outl[64 * i]; w.x = cvt_pk_bf16(bflo(w.x) + o[0], bfhi(w.x) + o[1]); w.y = cvt_pk_bf16(bflo(w.y) + o[2], bfhi(w.y) + o[3]); outl[64 * i] = w; } }
    astate_init(st);
    { const int lo = tc - 511 < 0 ? 0 : tc - 511; const int i0 = t0 < 511 ? (511 - t0) >> 5 : 0;
      auto desc = [&](int i) { return t0 - 511 + 32 * (i0 + i); };
      attn_run<0, false>(qf, proj + PC_KWN + 128 * g, proj + PC_VWN + 128 * g, PLD, 1, S - 1, desc, 17 - i0, lo, tc, 0, st, vbuf, lane); }
    { const float g2 = bf2f(gn[(size_t)tc * 32 + head * 3 + 2]); const float lt = quad_total(st.l), inv = (lt > 0.f ? 1.f / lt : 0.f) * g2;
#pragma unroll
        for (int i = 0; i < 8; ++i) { const f32x4 o = st.o[i] * inv; u32x2 w = outl[64 * i]; w.x = cvt_pk_bf16(bflo(w.x) + o[0], bfhi(w.x) + o[1]); w.y = cvt_pk_bf16(bflo(w.y) + o[2], bfhi(w.y) + o[3]); outl[64 * i] = w; } }
    bf16_t* op = nsaout + (size_t)tc * NOLD + head * 128 + 4 * kq;
#pragma unroll
    for (int db = 0; db < 8; ++db) *(u32x2*)(op + 16 * db) = outl[64 * db];
}

struct Params { const float* in[23]; float* out; unsigned char* ws; float inv_freq[64]; };

__global__ void __launch_bounds__(512, 2) fwd_megakernel(Params P) {
    extern __shared__ __attribute__((aligned(16))) unsigned char lds_raw[];
    LAS unsigned char* lds = (LAS unsigned char*)lds_raw;
    cg::grid_group grid = cg::this_grid();
#define PHASE_WS unsigned long long wsv_ = (unsigned long long)P.ws; asm volatile("" : "+s"(wsv_)); unsigned char* ws = (unsigned char*)(__attribute__((address_space(1))) unsigned char*)wsv_; int tid = threadIdx.x; asm volatile("" : "+v"(tid)); \
    const int lane = tid & 63, wave = __builtin_amdgcn_readfirstlane(tid >> 6), G = gridDim.x, gw = blockIdx.x * 8 + wave, ngw = G * 8; \
    const size_t gtid = (size_t)blockIdx.x * 512 + tid, gthreads = (size_t)G * 512; \
    LAS unsigned char* wl = lds + wave * WAVE_LDS; LAS float* scr = (LAS float*)wl; (void)lane; (void)gw; (void)ngw; (void)gtid; (void)gthreads; (void)wl; (void)scr
#define WAB ((bf16_t*)(ws + WS_WAB))
#define WO ((bf16_t*)(ws + WS_WO))
#define CW1K ((bf16_t*)(ws + WS_CW1K))
#define CW1V ((bf16_t*)(ws + WS_CW1V))
#define CW2K ((bf16_t*)(ws + WS_CW2K))
#define CW2V ((bf16_t*)(ws + WS_CW2V))
#define CBIAS ((float*)(ws + WS_CBIAS))
#define KC ((bf16_t*)(ws + WS_KC))
#define VC ((bf16_t*)(ws + WS_VC))
#define GN ((bf16_t*)(ws + WS_GN))
#define HF ((float*)(ws + WS_HF))
#define HB ((bf16_t*)(ws + WS_HB))
#define GU ((bf16_t*)(ws + WS_GU))
#define DN ((bf16_t*)(ws + WS_DN))
#define ACT ((bf16_t*)(ws + WS_ACT))
#define PROJ ((bf16_t*)(ws + WS_PROJ))
#define RCOS ((float*)(ws + WS_ROPE))
#define RSIN ((float*)(ws + WS_ROPE) + (size_t)S * 64)
#define WINT ((bf16_t*)(ws + WS_WIN))
#define NSAOUT ((bf16_t*)(ws + WS_NSAOUT))
#define SIGG ((bf16_t*)P.out)
    pg8::StaticOrder SO;
#define GRID_SYNC() do { asm volatile("s_waitcnt vmcnt(0) lgkmcnt(0)" ::: "memory"); grid.sync(); \
        if (__builtin_amdgcn_readfirstlane(threadIdx.x >> 6) == 0) { __builtin_amdgcn_fence(__ATOMIC_ACQUIRE, "agent"); asm volatile("s_waitcnt vmcnt(0)" ::: "memory"); } \
        __syncthreads(); } while (0)

    { PHASE_WS;
        conv_ffn(P.in[1], P.in[2], P.in[3], GU, DN, scr, gw, ngw, lane);
        for (int it = gw; it < 32 * 360; it += ngw) { const int kb = it / 360, nb = it % 360, dr = nb * 32; const int sc = win_src_col(dr);
            tr_item(P.in[6], WIN_SRC, kb * 64, sc < 0 ? 0 : sc, sc < 0 ? 0 : (dr == 11264 ? 24 : 32), WINT, DM, dr, kb * 64, scr, lane); }
        for (int it = gw; it < 16 * 64; it += ngw) { const int kb = it / 64, nb = it % 64; tr_item(P.in[13], DM, kb * 64, nb * 32, 32, WAB, 1024, nb * 32, kb * 64, scr, lane); }
        for (int it = gw; it < 8 * 64; it += ngw) { const int kb = it / 64, nb = it % 64; tr_item(P.in[14], DM, kb * 64, nb * 32, 32, WAB + (size_t)DM * 1024, 512, nb * 32, kb * 64, scr, lane); }
        for (int it = gw; it < 32 * 64; it += ngw) { const int kb = it / 64, nb = it % 64; tr_item(P.in[15], DM, kb * 64, nb * 32, 32, WO, DM, nb * 32, kb * 64, scr, lane); }
        for (int it = gw; it < 2 * 64 * 8; it += ngw) { const int w = it / 512, r = it % 512, kb = r / 8, nb = r % 8; tr_item(w ? P.in[11] : P.in[8], 256, kb * 64, nb * 32, 32, w ? CW1V : CW1K, 4096, nb * 32, kb * 64, scr, lane); }
        for (int it = gw; it < 2 * 4 * 4; it += ngw) { const int w = it / 16, r = it % 16, kb = r / 4, nb = r % 4; tr_item(w ? P.in[12] : P.in[9], 128, kb * 64, nb * 32, 32, w ? CW2V : CW2K, 256, nb * 32, kb * 64, scr, lane); }
        { const float* x = P.in[0];
            for (size_t i = gtid; i < (size_t)S * DM / 8; i += gthreads) { const f32x4 a = *(const f32x4*)(x + 8 * i), b = *(const f32x4*)(x + 8 * i + 4); *(u32x4*)(HB + 8 * i) = pack8(a, b); } }
        for (int o = gw; o < 512; o += ngw) { const int w = o >> 8, c = o & 255; const float* pos = w ? P.in[10] : P.in[7]; const float* w1 = w ? P.in[11] : P.in[8];
            float s = 0.f; for (int kk = lane; kk < 4096; kk += 64) s += pos[kk] * w1[(size_t)kk * 256 + c];
            s = wave_sum(s); if (lane == 0) CBIAS[o] = s; }
    }
    GRID_SYNC();
    { PHASE_WS; pg8::Gemm g{HB, GU, S, NGU, DM, DM, DM}; SO.init(S, NGU, G, (int)blockIdx.x); EpiSwiglu E{ACT}; pg8::gemm_phase(lds, g, SO, E); }
    GRID_SYNC();
    { PHASE_WS; pg8::Gemm g{ACT, DN, S, DM, FF, FF, FF}; SO.init(S, DM, G, (int)blockIdx.x); EpiResF32 E{P.in[0], HF, ALPHA, 0.5f}; pg8::gemm_phase(lds, g, SO, E); }
    GRID_SYNC();
    { PHASE_WS;
        ln_rows(HF, HF, HB, P.in[4], P.in[5], gw, ngw, lane);
        for (size_t i = gtid; i < (size_t)S * 64; i += gthreads) { const int t = (int)(i >> 6), j = (int)(i & 63); const float ang = (float)t * P.inv_freq[j]; RCOS[i] = cosf(ang); RSIN[i] = sinf(ang); }
    }
    GRID_SYNC();
    { PHASE_WS; pg8::Gemm g{HB, WINT, S, NWIN, DM, DM, DM}; SO.init(S, NWIN, G, (int)blockIdx.x); EpiWin E{PROJ, SIGG, GN, RCOS, RSIN}; pg8::gemm_phase(lds, g, SO, E); }
    GRID_SYNC();
    { PHASE_WS;
        if (wave == 0) { for (int u = blockIdx.x; u < 256; u += G) { const int kv = u >> 7; compress_unit(u, PROJ, kv ? CW1V : CW1K, kv ? CW2V : CW2K, CBIAS + 256 * kv, kv ? VC : KC, wl, lane); } }
        else { for (int u = blockIdx.x * 7 + (wave - 1); u < 4096; u += G * 7) dilated_unit(u, PROJ, NSAOUT, wl, lane); }
    }
    GRID_SYNC();
    { PHASE_WS;
      if ((G & 7) == 0) {
          const int bx = blockIdx.x, x = bx & 7, g = x & 1, wj = ((bx >> 3) * 4 + (x >> 1)) * 8 + wave, nwj = (G >> 1) * 8;
          for (int tb = wj; tb < 4096; tb += nwj) nsa_unit(2 * tb + g, PROJ, KC, VC, GN, RCOS, RSIN, NSAOUT, wl, lane);
      } else { for (int u = gw; u < 8192; u += ngw) nsa_unit(u, PROJ, KC, VC, GN, RCOS, RSIN, NSAOUT, wl, lane); } }
    GRID_SYNC();
    { PHASE_WS; SO.init(S, DM, G, (int)blockIdx.x);
      { pg8::Gemm g{NSAOUT, WAB, S, DM, 1024, NOLD, 1024}; EpiGate<true> E{SIGG, HB}; pg8::gemm_phase(lds, g, SO, E); }
      { pg8::Gemm g{NSAOUT + 1024, WAB + (size_t)DM * 1024, S, DM, 512, NOLD, 512}; EpiGate<false> E{SIGG + 2048, HB}; pg8::gemm_phase(lds, g, SO, E); } }
    GRID_SYNC();
    { PHASE_WS; pg8::Gemm g{HB, WO, S, DM, DM, DM, DM}; SO.init(S, DM, G, (int)blockIdx.x); EpiResF32 E{HF, HF, ALPHA, 1.0f}; pg8::gemm_phase(lds, g, SO, E); }
    GRID_SYNC();
    { PHASE_WS;
        ln_rows(HF, HF, HB, P.in[16], P.in[17], gw, ngw, lane);
        conv_ffn(P.in[18], P.in[19], P.in[20], GU, DN, scr, gw, ngw, lane);
    }
    GRID_SYNC();
    { PHASE_WS; pg8::Gemm g{HB, GU, S, NGU, DM, DM, DM}; SO.init(S, NGU, G, (int)blockIdx.x); EpiSwiglu E{ACT}; pg8::gemm_phase(lds, g, SO, E); }
    GRID_SYNC();
    { PHASE_WS; pg8::Gemm g{ACT, DN, S, DM, FF, FF, FF}; SO.init(S, DM, G, (int)blockIdx.x); EpiResF32 E{HF, P.out, ALPHA, 0.5f}; pg8::gemm_phase(lds, g, SO, E); }
    GRID_SYNC();
    { PHASE_WS; (void)ws; ln_rows(P.out, P.out, nullptr, P.in[21], P.in[22], gw, ngw, lane); }
}

extern "C" void kernel_launch(void* const* d_in, const int* in_sizes, int n_in, void* d_out, int out_size, void* d_ws, size_t ws_size, hipStream_t stream) {
    static int grid = 0;
    if (grid == 0) {
        if (n_in != 23 || out_size != S * DM || ws_size < WS_END) { fprintf(stderr, "kernel_launch: unexpected shapes (n_in %d out %d ws %zu, need %zu)\n", n_in, out_size, ws_size, (size_t)WS_END); grid = -1; return; }
        int dev = 0, cus = 0, per_cu = 0;
        hipGetDevice(&dev); hipDeviceGetAttribute(&cus, hipDeviceAttributeMultiprocessorCount, dev);
        if (hipFuncSetAttribute((const void*)fwd_megakernel, hipFuncAttributeMaxDynamicSharedMemorySize, LDS_BYTES) != hipSuccess) { fprintf(stderr, "kernel_launch: hipFuncSetAttribute failed\n"); grid = -1; return; }
        if (hipOccupancyMaxActiveBlocksPerMultiprocessor(&per_cu, (const void*)fwd_megakernel, 512, LDS_BYTES) != hipSuccess || per_cu < 1) { fprintf(stderr, "kernel_launch: occupancy query failed (%d)\n", per_cu); (void)hipGetLastError(); per_cu = 1; }
        grid = cus * per_cu;
    }
    if (grid < 0) return;
    Params p{};
    for (int i = 0; i < 23; ++i) p.in[i] = (const float*)d_in[i];
    p.out = (float*)d_out; p.ws = (unsigned char*)d_ws;
    for (int i = 0; i < 64; ++i) p.inv_freq[i] = (float)pow(10000.0, -(double)i / 64.0);
    void* args[] = {&p};
    hipError_t e = hipLaunchCooperativeKernel((const void*)fwd_megakernel, dim3(grid), dim3(512), args, LDS_BYTES, stream);
    if (e != hipSuccess) fprintf(stderr, "kernel_launch: cooperative launch failed: %s (grid %d)\n", hipGetErrorString(e), grid);
}
```

```cpp
#include <hip/hip_runtime.h>
#include <hip/hip_cooperative_groups.h>
#include <cstdio>
#include <cstdint>
#include <cmath>
namespace cg = cooperative_groups;

#define LAS __attribute__((address_space(3)))
typedef unsigned short bf16_t;
typedef short bf16x8 __attribute__((ext_vector_type(8)));
typedef short s16x4 __attribute__((ext_vector_type(4)));
typedef float f32x4 __attribute__((ext_vector_type(4)));
typedef float f32x2 __attribute__((ext_vector_type(2)));
typedef unsigned u32x4 __attribute__((ext_vector_type(4)));
typedef unsigned u32x2 __attribute__((ext_vector_type(2)));

constexpr int S = 16384, DM = 2048, FF = 5632, NGU = 2 * FF, NWIN = 11520, WIN_SRC = 11288, PLD = 7168, NOLD = 1536;
constexpr float ALPHA = 1.189207115002721f;
constexpr float LN_EPS = 1e-5f;
constexpr float SL2 = 0.08838834764831845f * 1.4426950408889634f;
constexpr int PC_QA = 0, PC_KC = 1024, PC_VC = 1280, PC_KSL = 1536, PC_VSL = 1792, PC_KWN = 2048, PC_VWN = 2304, PC_QB = 2560, PC_KB = 4096, PC_VB = 5632;
constexpr size_t MiB = 1u << 20;
constexpr size_t WS_WAB = 1 * MiB, WS_WO = 13 * MiB, WS_CW1K = 21 * MiB, WS_CW1V = 23 * MiB, WS_CW2K = 25 * MiB, WS_CW2V = 25 * MiB + 65536, WS_CBIAS = 25 * MiB + 131072;
constexpr size_t WS_KC = 26 * MiB, WS_VC = 26 * MiB + 524288, WS_GN = 27 * MiB;
constexpr size_t WS_HF = 32 * MiB, WS_HB = 160 * MiB, WS_BIG = 224 * MiB;
constexpr size_t WS_GU = WS_BIG, WS_DN = WS_BIG + 44 * MiB, WS_ACT = WS_BIG + 66 * MiB;
constexpr size_t WS_PROJ = WS_BIG, WS_ROPE = WS_BIG + 224 * MiB;
constexpr size_t WS_WIN = 466 * MiB, WS_NSAOUT = 466 * MiB, WS_END = 514 * MiB;

constexpr int VROW = 288, VBUF_BYTES = 32 * VROW;
constexpr int IMP_LD = 260;
constexpr int OUT_OFF = VBUF_BYTES + 4 * IMP_LD * 4 + 256 + 512;
constexpr int WAVE_LDS = OUT_OFF + 4096;
constexpr int LDS_BYTES = 147456;
static_assert(8 * WAVE_LDS + 16 <= LDS_BYTES && 131072 <= LDS_BYTES, "LDS map");

typedef __bf16 bf16x2_t __attribute__((ext_vector_type(2)));
__device__ __forceinline__ unsigned cvt_pk_bf16(float lo, float hi) { f32x2 v = {lo, hi}; bf16x2_t b = __builtin_convertvector(v, bf16x2_t); return __builtin_bit_cast(unsigned, b); }
__device__ __forceinline__ float bf2f(unsigned short b) { return __uint_as_float(((unsigned)b) << 16); }
__device__ __forceinline__ float bflo(unsigned w) { return __uint_as_float(w << 16); }
__device__ __forceinline__ float bfhi(unsigned w) { return __uint_as_float(w & 0xffff0000u); }
__device__ __forceinline__ float fsigmoid(float x) { return __builtin_amdgcn_rcpf(1.f + __expf(-x)); }
__device__ __forceinline__ float wave_sum(float v) {
#pragma unroll
    for (int o = 1; o < 64; o <<= 1) v += __shfl_xor(v, o);
    return v;
}
__device__ __forceinline__ u32x4 pack8(const f32x4 a, const f32x4 b) { u32x4 w; w.x = cvt_pk_bf16(a[0], a[1]); w.y = cvt_pk_bf16(a[2], a[3]); w.z = cvt_pk_bf16(b[0], b[1]); w.w = cvt_pk_bf16(b[2], b[3]); return w; }

namespace pg8 {
constexpr int BM = 256, BK = 64, HALF = 128, HTB = HALF * BK * 2, STAGE_BYTES = 8 * HTB, NXCD = 8, WGM = 8;
__host__ __device__ __forceinline__ int lds_byte(int r, int c) { const int st = (r >> 4) * 2 + (c >> 5), rr = r & 15, cc = c & 31, ob = rr * 64 + cc * 2; return st * 1024 + (ob ^ (((ob >> 9) & 1) << 5)); }
__host__ __device__ __forceinline__ void stage_rc(int b, int& R, int& C) { const int st = b / 1024, sb = b % 1024, swz = sb ^ (((sb >> 9) & 1) << 5); R = (st >> 1) * 16 + swz / 64; C = (st & 1) * 32 + (swz % 64) / 2; }
__host__ __device__ __forceinline__ int perm32(int rho) { const int n = rho >> 4, i = rho & 15; return 8 * (i >> 2) + 4 * n + (i & 3); }
struct Unit { int pm, pn; };
struct Gemm { const bf16_t* A; const bf16_t* Bt; int M, N, K, lda, ldb; };
struct StaticOrder {
    int nM, nN, nwg, G, c;
    __device__ void init(int M, int N, int G_, int c_) { nM = M / BM; nN = N / BM; nwg = nM * nN; G = G_; c = c_; }
    __device__ bool next(int i, Unit& u) const {
        const long L = (long)i * G + c; if (L >= nwg) return false;
        int wgid = (int)L; { const int q = nwg / NXCD, r = nwg % NXCD, xcd = wgid % NXCD, off = wgid / NXCD; wgid = (xcd < r ? xcd * (q + 1) : r * (q + 1) + (xcd - r) * q) + off; }
        const int nig = WGM * nN, gid = wgid / nig, fm = gid * WGM, gsz = (nM - fm) < WGM ? (nM - fm) : WGM;
        u.pm = fm + ((wgid % nig) % gsz); u.pn = (wgid % nig) / gsz; return true;
    }
};
typedef f32x4 Acc[2][2][4][2];

template <class Epi>
__device__ __forceinline__ void gemm_phase(LAS unsigned char* lds, const Gemm g, const StaticOrder& S_, const Epi& E) {
    const int tid = threadIdx.x, wid = __builtin_amdgcn_readfirstlane(tid >> 6), lane = tid & 63, wr = wid >> 2, wc = wid & 3, fr = lane & 15, fq = lane >> 4;
    const int K = g.K, nt = K / BK;
    unsigned voffA[2], voffB[2];
#pragma unroll
    for (int i = 0; i < 2; ++i) { int R, C; stage_rc(tid * 16 + i * 8192, R, C); const int Rb = Epi::PERM ? ((R & ~31) + perm32(R & 31)) : R;
        voffA[i] = (unsigned)(R * g.lda + C) * 2u; voffB[i] = (unsigned)(Rb * g.ldb + C) * 2u; }
    const size_t kstep = (size_t)(BK * 2);
    const size_t hstepA = (size_t)HALF * g.lda * 2, hstepB = (size_t)HALF * g.ldb * 2;
    const size_t tstepA = 2 * hstepA, tstepB = 2 * hstepB;
    const unsigned ldsw = (unsigned)wid * 1024u;
    const int aoff = lds_byte(wr * 64 + fr, fq * 8), boff = lds_byte(wc * 32 + fr, fq * 8);
#define PG8_SA(b, h) (((b) * 2 + (h)) * HTB)
#define PG8_SB(b, h) ((4 + (b) * 2 + (h)) * HTB)
#define PG8_STAGE(bufoff, gbase, voff) do { _Pragma("unroll") for (int _i = 0; _i < 2; ++_i) \
        __builtin_amdgcn_global_load_lds((const unsigned*)((const char*)(gbase) + (voff)[_i]), (LAS unsigned*)(lds + (bufoff) + ldsw + _i * 8192), 16, 0, 0); } while (0)
#define PG8_LDA(dst, b, h) do { _Pragma("unroll") for (int m = 0; m < 4; ++m) _Pragma("unroll") for (int k = 0; k < 2; ++k) dst[m][k] = *(const LAS bf16x8*)(lds + PG8_SA(b, h) + aoff + m * 2048 + k * 1024); } while (0)
#define PG8_LDB(dst, b, h) do { _Pragma("unroll") for (int n = 0; n < 2; ++n) _Pragma("unroll") for (int k = 0; k < 2; ++k) dst[n][k] = *(const LAS bf16x8*)(lds + PG8_SB(b, h) + boff + n * 2048 + k * 1024); } while (0)
#define PG8_MMA(ai, bj, At, Bt) do { __builtin_amdgcn_s_setprio(1); _Pragma("unroll") for (int m = 0; m < 4; ++m) _Pragma("unroll") for (int n = 0; n < 2; ++n) _Pragma("unroll") for (int k = 0; k < 2; ++k) \
        acc[ai][bj][m][n] = __builtin_amdgcn_mfma_f32_16x16x32_bf16(Bt[n][k], At[m][k], acc[ai][bj][m][n], 0, 0, 0); __builtin_amdgcn_s_setprio(0); } while (0)
#define PG8_WAIT_V(n) asm volatile("s_waitcnt vmcnt(" #n ")" ::: "memory")
#define PG8_WAIT_L(n) asm volatile("s_waitcnt lgkmcnt(" #n ")" ::: "memory")
#define PG8_BAR __builtin_amdgcn_s_barrier()
#define PG8_SCHED __builtin_amdgcn_sched_barrier(0)
    Unit cur, nxt; int ui = 0;
    if (!S_.next(0, cur)) return;
    Acc acc;
#pragma unroll
    for (int a = 0; a < 2; ++a)
#pragma unroll
        for (int b = 0; b < 2; ++b)
#pragma unroll
            for (int m = 0; m < 4; ++m)
#pragma unroll
                for (int n = 0; n < 2; ++n) acc[a][b][m][n] = (f32x4){0.f, 0.f, 0.f, 0.f};
    bf16x8 At[4][2], B0[2][2], B1[2][2];
    const char* cA = (const char*)g.A + (size_t)cur.pm * tstepA; const char* cB = (const char*)g.Bt + (size_t)cur.pn * tstepB;
    PG8_STAGE(PG8_SB(0, 0), cB, voffB); PG8_STAGE(PG8_SB(0, 1), cB + hstepB, voffB); PG8_STAGE(PG8_SA(0, 0), cA, voffA); PG8_STAGE(PG8_SA(0, 1), cA + hstepA, voffA);
    if (wr == 1) PG8_BAR;
    PG8_WAIT_V(2); PG8_BAR;
    PG8_STAGE(PG8_SB(1, 0), cB + kstep, voffB); PG8_STAGE(PG8_SA(1, 0), cA + kstep, voffA); PG8_STAGE(PG8_SB(1, 1), cB + hstepB + kstep, voffB);
    PG8_WAIT_V(6); PG8_BAR;
    for (;;) {
        const bool has_next = S_.next(ui + 1, nxt);
        const char* nA = has_next ? (const char*)g.A + (size_t)nxt.pm * tstepA : cA; const char* nB = has_next ? (const char*)g.Bt + (size_t)nxt.pn * tstepB : cB;
        for (int t = 0; t < nt; t += 2) {
            const bool last = (t == nt - 2);
            const char* a1 = cA + (size_t)(t + 1) * kstep;
            const char* a2 = last ? nA : cA + (size_t)(t + 2) * kstep; const char* b2 = last ? nB : cB + (size_t)(t + 2) * kstep;
            const char* a3 = a2 + kstep; const char* b3 = b2 + kstep;
            PG8_LDB(B0, 0, 0); PG8_LDB(B1, 0, 1); PG8_SCHED; PG8_LDA(At, 0, 0); PG8_STAGE(PG8_SA(1, 1), a1 + hstepA, voffA);
            PG8_WAIT_V(8); PG8_WAIT_L(0); PG8_BAR; PG8_MMA(0, 0, At, B0); PG8_MMA(0, 1, At, B1); PG8_BAR; PG8_SCHED;
            PG8_LDA(At, 0, 1); PG8_STAGE(PG8_SB(0, 0), b2, voffB); PG8_STAGE(PG8_SB(0, 1), b2 + hstepB, voffB); PG8_STAGE(PG8_SA(0, 0), a2, voffA);
            PG8_WAIT_V(8); PG8_WAIT_L(0); PG8_BAR; PG8_MMA(1, 0, At, B0); PG8_MMA(1, 1, At, B1); PG8_BAR; PG8_SCHED;
            PG8_LDB(B0, 1, 0); PG8_LDB(B1, 1, 1); PG8_SCHED; PG8_LDA(At, 1, 0); PG8_STAGE(PG8_SA(0, 1), a2 + hstepA, voffA);
            PG8_WAIT_V(8); PG8_WAIT_L(0); PG8_BAR; PG8_MMA(0, 0, At, B0); PG8_MMA(0, 1, At, B1); PG8_BAR; PG8_SCHED;
            PG8_LDA(At, 1, 1); PG8_STAGE(PG8_SB(1, 0), b3, voffB); PG8_STAGE(PG8_SB(1, 1), b3 + hstepB, voffB); PG8_STAGE(PG8_SA(1, 0), a3, voffA);
            PG8_WAIT_V(8); PG8_WAIT_L(0); PG8_BAR; PG8_MMA(1, 0, At, B0); PG8_MMA(1, 1, At, B1); PG8_BAR; PG8_SCHED;
        }
        if (wr == 0) PG8_BAR;
        E(acc, cur, wr, wc, fr, fq);
        if (!has_next) break;
#pragma unroll
        for (int a = 0; a < 2; ++a)
#pragma unroll
            for (int b = 0; b < 2; ++b)
#pragma unroll
                for (int m = 0; m < 4; ++m)
#pragma unroll
                    for (int n = 0; n < 2; ++n) acc[a][b][m][n] = (f32x4){0.f, 0.f, 0.f, 0.f};
        cur = nxt; cA = nA; cB = nB; ++ui;
        if (wr == 1) PG8_BAR;
    }
    PG8_WAIT_V(0);
    PG8_BAR;
#undef PG8_SA
#undef PG8_SB
#undef PG8_STAGE
#undef PG8_LDA
#undef PG8_LDB
#undef PG8_MMA
#undef PG8_WAIT_V
#undef PG8_WAIT_L
#undef PG8_BAR
#undef PG8_SCHED
}
}

struct EpiSwiglu {
    static constexpr bool PERM = true;
    bf16_t* O;
    __device__ __forceinline__ void operator()(const pg8::Acc& acc, const pg8::Unit& u, int wr, int wc, int fr, int fq) const {
        const int row0 = u.pm * 256 + wr * 64 + fr, col0 = u.pn * 128 + wc * 32 + 8 * fq;
#pragma unroll
        for (int ai = 0; ai < 2; ++ai)
#pragma unroll
            for (int m = 0; m < 4; ++m) {
                f32x4 v[2];
#pragma unroll
                for (int n = 0; n < 2; ++n)
#pragma unroll
                    for (int e = 0; e < 4; ++e) { const float gt = acc[ai][0][m][n][e], up = acc[ai][1][m][n][e]; v[n][e] = gt * fsigmoid(gt) * up; }
                *(u32x4*)(O + (size_t)(row0 + ai * 128 + m * 16) * FF + col0) = pack8(v[0], v[1]);
            }
    }
};
struct EpiResF32 {
    static constexpr bool PERM = false;
    const float* res; float* out; float a, b;
    __device__ __forceinline__ void operator()(const pg8::Acc& acc, const pg8::Unit& u, int wr, int wc, int fr, int fq) const {
        const int row0 = u.pm * 256 + wr * 64 + fr, col0 = u.pn * 256 + wc * 32 + 4 * fq;
#pragma unroll
        for (int ai = 0; ai < 2; ++ai)
#pragma unroll
            for (int m = 0; m < 4; ++m) {
                const size_t off = (size_t)(row0 + ai * 128 + m * 16) * DM + col0;
#pragma unroll
                for (int bj = 0; bj < 2; ++bj)
#pragma unroll
                    for (int n = 0; n < 2; ++n) { const f32x4 r = *(const f32x4*)(res + off + bj * 128 + n * 16); *(f32x4*)(out + off + bj * 128 + n * 16) = r * a + acc[ai][bj][m][n] * b; }
            }
    }
};
struct EpiWin {
    static constexpr bool PERM = true;
    bf16_t* proj; bf16_t* sigg; bf16_t* gn; const float* cs; const float* sn;
    __device__ __forceinline__ void operator()(const pg8::Acc& acc, const pg8::Unit& u, int wr, int wc, int fr, int fq) const {
        const int tile = u.pn, row0 = u.pm * 256 + wr * 64 + fr, cw = wc * 32 + 8 * fq;
        if (tile < 28) {
            const bool rope = (tile == 6) | (tile == 8) | (tile >= 10 && tile < 22);
            if (!rope) {
#pragma unroll
                for (int ai = 0; ai < 2; ++ai)
#pragma unroll
                    for (int m = 0; m < 4; ++m)
#pragma unroll
                        for (int bj = 0; bj < 2; ++bj)
                            *(u32x4*)(proj + (size_t)(row0 + ai * 128 + m * 16) * PLD + tile * 256 + bj * 128 + cw) = pack8(acc[ai][bj][m][0], acc[ai][bj][m][1]);
            } else {
                const int head = cw >> 6, d = cw & 63;
#pragma unroll
                for (int ai = 0; ai < 2; ++ai)
#pragma unroll
                    for (int m = 0; m < 4; ++m) {
                        const int row = row0 + ai * 128 + m * 16;
                        f32x4 o1[2], o2[2];
#pragma unroll
                        for (int n = 0; n < 2; ++n) {
                            const f32x4 c = *(const f32x4*)(cs + (size_t)row * 64 + d + 4 * n), s = *(const f32x4*)(sn + (size_t)row * 64 + d + 4 * n);
                            const f32x4 x1 = acc[ai][0][m][n], x2 = acc[ai][1][m][n];
                            o1[n] = x1 * c - x2 * s; o2[n] = x2 * c + x1 * s;
                        }
                        bf16_t* p = proj + (size_t)row * PLD + tile * 256 + head * 128 + d;
                        *(u32x4*)p = pack8(o1[0], o1[1]); *(u32x4*)(p + 64) = pack8(o2[0], o2[1]);
                    }
            }
        } else if (tile < 44) {
#pragma unroll
            for (int ai = 0; ai < 2; ++ai)
#pragma unroll
                for (int m = 0; m < 4; ++m)
#pragma unroll
                    for (int bj = 0; bj < 2; ++bj) {
                        f32x4 v[2];
#pragma unroll
                        for (int n = 0; n < 2; ++n)
#pragma unroll
                            for (int e = 0; e < 4; ++e) v[n][e] = fsigmoid(acc[ai][bj][m][n][e]);
                        *(u32x4*)(sigg + (size_t)(row0 + ai * 128 + m * 16) * 4096 + (tile - 28) * 256 + bj * 128 + cw) = pack8(v[0], v[1]);
                    }
        } else {
            if (wc == 0) {
#pragma unroll
                for (int ai = 0; ai < 2; ++ai)
#pragma unroll
                    for (int m = 0; m < 4; ++m) {
                        f32x4 v[2];
#pragma unroll
                        for (int n = 0; n < 2; ++n)
#pragma unroll
                            for (int e = 0; e < 4; ++e) v[n][e] = fsigmoid(acc[ai][0][m][n][e]);
                        *(u32x4*)(gn + (size_t)(row0 + ai * 128 + m * 16) * 32 + cw) = pack8(v[0], v[1]);
                    }
            }
        }
    }
};
template <bool FIRST> struct EpiGate {
    static constexpr bool PERM = true;
    const bf16_t* sg; bf16_t* O;
    __device__ __forceinline__ void operator()(const pg8::Acc& acc, const pg8::Unit& u, int wr, int wc, int fr, int fq) const {
        const int row0 = u.pm * 256 + wr * 64 + fr, col0 = u.pn * 256 + wc * 32 + 8 * fq;
#pragma unroll
        for (int ai = 0; ai < 2; ++ai)
#pragma unroll
            for (int m = 0; m < 4; ++m)
#pragma unroll
                for (int bj = 0; bj < 2; ++bj) {
                    const int row = row0 + ai * 128 + m * 16, col = col0 + bj * 128;
                    const u32x4 gv = *(const u32x4*)(sg + (size_t)row * 4096 + col);
                    u32x4 pv = (u32x4){0u, 0u, 0u, 0u}; if (!FIRST) pv = *(const u32x4*)(O + (size_t)row * DM + col);
                    f32x4 v[2];
#pragma unroll
                    for (int n = 0; n < 2; ++n) {
                        const unsigned g0 = n ? gv.z : gv.x, g1 = n ? gv.w : gv.y, p0 = n ? pv.z : pv.x, p1 = n ? pv.w : pv.y;
                        const f32x4 y = acc[ai][bj][m][n];
                        v[n][0] = bflo(p0) + bflo(g0) * y[0]; v[n][1] = bfhi(p0) + bfhi(g0) * y[1];
                        v[n][2] = bflo(p1) + bflo(g1) * y[2]; v[n][3] = bfhi(p1) + bfhi(g1) * y[3];
                    }
                    *(u32x4*)(O + (size_t)row * DM + col) = pack8(v[0], v[1]);
                }
    }
};

__device__ __forceinline__ void tr_item(const float* W, int ldw, int k0, int scol0, int nvalid, bf16_t* WT, int ldt, int drow0, int dk0, LAS float* scr, int lane) {
    const int c = lane & 31;
#pragma unroll 8
    for (int i = 0; i < 32; ++i) { const int kk = 2 * i + (lane >> 5); scr[kk * 33 + c] = (c < nvalid) ? W[(size_t)(k0 + kk) * ldw + scol0 + c] : 0.f; }
    asm volatile("s_waitcnt lgkmcnt(0)" ::: "memory");
    const int c8 = lane & 7;
#pragma unroll
    for (int j = 0; j < 4; ++j) { const int n = (lane >> 3) + 8 * j; const LAS float* s = scr + (8 * c8) * 33 + n;
        u32x4 o; o.x = cvt_pk_bf16(s[0 * 33], s[1 * 33]); o.y = cvt_pk_bf16(s[2 * 33], s[3 * 33]); o.z = cvt_pk_bf16(s[4 * 33], s[5 * 33]); o.w = cvt_pk_bf16(s[6 * 33], s[7 * 33]);
        *(u32x4*)(WT + (size_t)(drow0 + n) * ldt + dk0 + 8 * c8) = o; }
    asm volatile("s_waitcnt lgkmcnt(0)" ::: "memory");
}
__device__ __forceinline__ int win_src_col(int r) {
    if (r >= WIN_SRC) return -1;
    if (r >= 11264) return 2560 + (r - 11264);
    const int tile = r >> 8; int j = r & 255;
    const bool rope = (tile == 6) | (tile == 8) | (tile >= 10 && tile < 22);
    if (rope) { const int q = j >> 6, d = j & 63; j = (q & 1) * 128 + (q >> 1) * 64 + d; }
    const int c = tile * 256 + j;
    return c < 2560 ? c : c + 24;
}
__device__ __forceinline__ void conv_ffn(const float* Wg, const float* Wu, const float* Wd, bf16_t* GU, bf16_t* DN, LAS float* scr, int gw, int ngw, int lane) {
    constexpr int I_G = 32 * 176;
    for (int it = gw; it < 2 * I_G; it += ngw) { const int which = it / I_G, r = it % I_G, kb = r / 176, nb = r % 176, c0 = nb * 32;
        tr_item(which ? Wu : Wg, FF, kb * 64, c0, 32, GU, DM, 256 * (c0 >> 7) + (c0 & 127) + which * 128, kb * 64, scr, lane); }
    for (int it = gw; it < 88 * 64; it += ngw) { const int kb = it / 64, nb = it % 64; tr_item(Wd, DM, kb * 64, nb * 32, 32, DN, FF, nb * 32, kb * 64, scr, lane); }
}
__device__ __forceinline__ void ln_rows(const float* in, float* outf, bf16_t* outb, const float* g, const float* b, int gw, int ngw, int lane) {
    f32x4 gv[8], bv[8];
#pragma unroll
    for (int j = 0; j < 8; ++j) { gv[j] = *(const f32x4*)(g + 4 * (lane + 64 * j)); bv[j] = *(const f32x4*)(b + 4 * (lane + 64 * j)); }
    for (int row = gw; row < S; row += ngw) {
        const float* xr = in + (size_t)row * DM; f32x4 v[8]; float s = 0.f;
#pragma unroll
        for (int j = 0; j < 8; ++j) { v[j] = *(const f32x4*)(xr + 4 * (lane + 64 * j)); s += (v[j][0] + v[j][1]) + (v[j][2] + v[j][3]); }
        const float mean = wave_sum(s) * (1.f / DM); float s2 = 0.f;
#pragma unroll
        for (int j = 0; j < 8; ++j) { v[j] = v[j] - mean; s2 += (v[j][0] * v[j][0] + v[j][1] * v[j][1]) + (v[j][2] * v[j][2] + v[j][3] * v[j][3]); }
        const float rstd = 1.f / sqrtf(wave_sum(s2) * (1.f / DM) + LN_EPS);
#pragma unroll
        for (int j = 0; j < 8; ++j) { const f32x4 o = v[j] * rstd * gv[j] + bv[j];
            *(f32x4*)(outf + (size_t)row * DM + 4 * (lane + 64 * j)) = o;
            if (outb) { u32x2 w; w.x = cvt_pk_bf16(o[0], o[1]); w.y = cvt_pk_bf16(o[2], o[3]); *(u32x2*)(outb + (size_t)row * DM + 4 * (lane + 64 * j)) = w; } }
    }
}

struct AState { float m, l; f32x4 o[8]; };
__device__ __forceinline__ void astate_init(AState& s) { s.m = -1e30f; s.l = 0.f;
#pragma unroll
    for (int i = 0; i < 8; ++i) s.o[i] = (f32x4){0.f, 0.f, 0.f, 0.f}; }
__device__ __forceinline__ int clampi(int v, int lo, int hi) { return v < lo ? lo : (v > hi ? hi : v); }

__device__ __forceinline__ void load_k(bf16x8 (&kf)[2][4], const bf16_t* __restrict__ Kb, int ld, int pos0, int dpos, int posmax, int l16, int kq) {
#pragma unroll
    for (int T = 0; T < 2; ++T) { const int p = clampi(pos0 + dpos * (16 * T + l16), 0, posmax); const bf16_t* kp = Kb + (size_t)p * ld + 8 * kq;
#pragma unroll
        for (int s = 0; s < 4; ++s) kf[T][s] = *(const bf16x8*)(kp + 32 * s); }
}
__device__ __forceinline__ void load_v(u32x4 (&vr)[8], const bf16_t* __restrict__ Vb, int ld, int pos0, int dpos, int posmax, int l16, int kq) {
#pragma unroll
    for (int i = 0; i < 8; ++i) { const int p = clampi(pos0 + dpos * (4 * i + kq), 0, posmax); vr[i] = *(const u32x4*)(Vb + (size_t)p * ld + 8 * l16); }
}
__device__ __forceinline__ void store_v(const u32x4 (&vr)[8], LAS unsigned char* vbuf, int l16, int kq) {
#pragma unroll
    for (int i = 0; i < 8; ++i) *(LAS u32x4*)(vbuf + (4 * i + kq) * VROW + 16 * l16) = vr[i];
}
template <int MODE, bool SLC, class Desc>
__device__ __forceinline__ void attn_run(const bf16x8 (&qf)[4], const bf16_t* __restrict__ Kb, const bf16_t* __restrict__ Vb, int ld, int dpos, int posmax,
                                         const Desc& desc, int n, int lo_in, int hi, int qi, AState& st, LAS unsigned char* vbuf, int lane, LAS float* imp = nullptr) {
    if (n <= 0) return;
    const int l16 = lane & 15, kq = lane >> 4;
    u32x4 kr[8];
    int dcur = desc(0);
    load_v(kr, Kb, ld, SLC ? (dcur & 0xfffff) : dcur, dpos, posmax, l16, kq);
#pragma unroll 1
    for (int i = 0; i < n; ++i) {
        const int pos0 = SLC ? (dcur & 0xfffff) : dcur;
        const int lo = SLC ? ((((dcur >> 20) == qi) | ((dcur >> 20) == 4)) ? 0 : (1 << 30)) : lo_in;
        store_v(kr, vbuf, l16, kq);
        u32x4 vr[8];
        if (MODE != 1) load_v(vr, Vb, ld, pos0, dpos, posmax, l16, kq);
        bf16x8 kf[2][4];
#pragma unroll
        for (int T = 0; T < 2; ++T)
#pragma unroll
            for (int s = 0; s < 4; ++s) kf[T][s] = *(const LAS bf16x8*)(vbuf + (16 * T + l16) * VROW + 64 * s + 16 * kq);
        f32x4 sa[2] = {(f32x4){0.f, 0.f, 0.f, 0.f}, (f32x4){0.f, 0.f, 0.f, 0.f}};
#pragma unroll
        for (int T = 0; T < 2; ++T)
#pragma unroll
            for (int s = 0; s < 4; ++s) sa[T] = __builtin_amdgcn_mfma_f32_16x16x32_bf16(kf[T][s], qf[s], sa[T], 0, 0, 0);
        const int dnext = desc(i + 1 < n ? i + 1 : i);
        load_v(kr, Kb, ld, SLC ? (dnext & 0xfffff) : dnext, dpos, posmax, l16, kq);
        float sc[8]; bool vd[8]; float mx = -1e30f;
#pragma unroll
        for (int T = 0; T < 2; ++T)
#pragma unroll
            for (int r = 0; r < 4; ++r) { const int p = pos0 + dpos * (16 * T + 4 * kq + r); const bool v = (p >= lo) & (p <= hi); const float x = sa[T][r] * SL2;
                sc[4 * T + r] = x; vd[4 * T + r] = v; mx = v ? fmaxf(mx, x) : mx; }
        float p[8];
        if (MODE == 2) {
#pragma unroll
            for (int j = 0; j < 8; ++j) p[j] = vd[j] ? __builtin_amdgcn_exp2f(sc[j] - st.m) * st.l : 0.f;
#pragma unroll
            for (int T = 0; T < 2; ++T) {
                float x = 2.f * (p[4 * T] + p[4 * T + 1] + p[4 * T + 2]) + p[4 * T + 3], y = p[4 * T + 3];
                x += __shfl_xor(x, 1); x += __shfl_xor(x, 2); y += __shfl_xor(y, 1); y += __shfl_xor(y, 2);
                if ((l16 & 3) == 0) { const int a = (pos0 >> 2) + 4 * T + kq; LAS float* ip = imp + (l16 >> 2) * IMP_LD + a;
                    ip[0] += x;
                    asm volatile("s_waitcnt lgkmcnt(0)" ::: "memory");
                    ip[1] += y; }
                asm volatile("s_waitcnt lgkmcnt(0)" ::: "memory");
            }
        } else {
            if (__builtin_amdgcn_ballot_w64(mx > st.m + 40.f) != 0ull) {
                mx = fmaxf(mx, __shfl_xor(mx, 16)); mx = fmaxf(mx, __shfl_xor(mx, 32));
                const float mn = fmaxf(st.m, mx), alpha = __builtin_amdgcn_exp2f(st.m - mn); st.m = mn; st.l *= alpha;
                if (MODE == 0) {
#pragma unroll
                    for (int j = 0; j < 8; ++j) st.o[j] = st.o[j] * alpha;
                }
            }
            float ps = 0.f;
#pragma unroll
            for (int j = 0; j < 8; ++j) { p[j] = vd[j] ? __builtin_amdgcn_exp2f(sc[j] - st.m) : 0.f; ps += p[j]; }
            st.l += ps;
        }
        if (MODE != 1) {
            store_v(vr, vbuf, l16, kq);
            u32x4 pw; pw.x = cvt_pk_bf16(p[0], p[1]); pw.y = cvt_pk_bf16(p[2], p[3]); pw.z = cvt_pk_bf16(p[4], p[5]); pw.w = cvt_pk_bf16(p[6], p[7]);
            const bf16x8 pf = __builtin_bit_cast(bf16x8, pw);
            const unsigned addr = (unsigned)(uintptr_t)(vbuf) + (4 * kq + (l16 >> 2)) * VROW + (l16 & 3) * 8;
#pragma unroll
            for (int hf = 0; hf < 2; ++hf) {
                s16x4 a[8];
                asm volatile("s_waitcnt lgkmcnt(0)\n\t"
                             "ds_read_b64_tr_b16 %0, %8 offset:0\n\t"    "ds_read_b64_tr_b16 %1, %8 offset:32\n\t"
                             "ds_read_b64_tr_b16 %2, %8 offset:64\n\t"   "ds_read_b64_tr_b16 %3, %8 offset:96\n\t"
                             "ds_read_b64_tr_b16 %4, %8 offset:4608\n\t" "ds_read_b64_tr_b16 %5, %8 offset:4640\n\t"
                             "ds_read_b64_tr_b16 %6, %8 offset:4672\n\t" "ds_read_b64_tr_b16 %7, %8 offset:4704\n\t"
                             "s_waitcnt lgkmcnt(0)"
                             : "=&v"(a[0]), "=&v"(a[1]), "=&v"(a[2]), "=&v"(a[3]), "=&v"(a[4]), "=&v"(a[5]), "=&v"(a[6]), "=&v"(a[7])
                             : "v"(addr + 128 * hf) : "memory");
#pragma unroll
                for (int d4 = 0; d4 < 4; ++d4) { const int db = 4 * hf + d4;
                    bf16x8 af; af[0] = a[d4][0]; af[1] = a[d4][1]; af[2] = a[d4][2]; af[3] = a[d4][3]; af[4] = a[d4 + 4][0]; af[5] = a[d4 + 4][1]; af[6] = a[d4 + 4][2]; af[7] = a[d4 + 4][3];
                    st.o[db] = __builtin_amdgcn_mfma_f32_16x16x32_bf16(af, pf, st.o[db], 0, 0, 0); }
            }
        }
        dcur = dnext;
    }
}
__device__ __forceinline__ float quad_total(float v) { v += __shfl_xor(v, 16); v += __shfl_xor(v, 32); return v; }

__device__ __forceinline__ void dilated_unit(int unit, const bf16_t* proj, bf16_t* nsaout, LAS unsigned char* vbuf, int lane) {
    const int l16 = lane & 15, kq = lane >> 4;
    const int hg = unit & 3, r16 = (unit >> 2) & 15, ut = unit >> 6;
    const int t0 = r16 + 256 * ut, tc = t0 + 16 * l16;
    AState st; astate_init(st);
#pragma unroll 1
    for (int pt = 0; pt < 3; ++pt) {
        const int d = pt == 0 ? 1 : (pt == 1 ? 4 : 16), head = 4 * pt + hg;
        const bf16_t* qrow = proj + (size_t)tc * PLD + PC_QB + head * 128 + 8 * kq;
        bf16x8 qf[4];
#pragma unroll
        for (int s = 0; s < 4; ++s) qf[s] = *(const bf16x8*)(qrow + 32 * s);
        const int nk = 129 + 240 / d, nsteps = (nk + 31) >> 5;
        const int lo = tc - 128 * d < 0 ? 0 : tc - 128 * d, hi = tc;
        const int base = t0 - 128 * d;
        const int i0 = base < 0 ? (-base + d - 1) / (32 * d) : 0;
        auto desc = [&](int i) { return base + 32 * d * (i0 + i); };
        attn_run<0, false>(qf, proj + PC_KB + head * 128, proj + PC_VB + head * 128, PLD, d, S - 1, desc, nsteps - i0, lo, hi, 0, st, vbuf, lane);
    }
    const float lt = quad_total(st.l), inv = lt > 0.f ? 1.f / lt : 0.f;
    bf16_t* op = nsaout + (size_t)tc * NOLD + 1024 + hg * 128 + 4 * kq;
#pragma unroll
    for (int db = 0; db < 8; ++db) { const f32x4 o = st.o[db] * inv; u32x2 w; w.x = cvt_pk_bf16(o[0], o[1]); w.y = cvt_pk_bf16(o[2], o[3]); *(u32x2*)(op + 16 * db) = w; }
}

__device__ __forceinline__ void compress_unit(int unit, const bf16_t* proj, const bf16_t* w1t, const bf16_t* w2t, const float* bias, bf16_t* outc, LAS unsigned char* scr, int lane) {
    const int l16 = lane & 15, kq = lane >> 4;
    const int rt = unit & 63, g = (unit >> 6) & 1, kv = unit >> 7;
    const bf16_t* raw = proj + (kv ? PC_VC : PC_KC) + 128 * g;
    const int n = 16 * rt + l16;
    f32x4 acc[16];
#pragma unroll
    for (int i = 0; i < 16; ++i) acc[i] = (f32x4){0.f, 0.f, 0.f, 0.f};
#pragma unroll 2
    for (int s = 0; s < 128; ++s) {
        const int tok = clampi(16 * n + (s >> 2), 0, S - 1);
        const bf16x8 af = *(const bf16x8*)(raw + (size_t)tok * PLD + (s & 3) * 32 + 8 * kq);
#pragma unroll
        for (int ct = 0; ct < 16; ++ct) { const bf16x8 bfr = *(const bf16x8*)(w1t + (size_t)(16 * ct + l16) * 4096 + 32 * s + 8 * kq);
            acc[ct] = __builtin_amdgcn_mfma_f32_16x16x32_bf16(af, bfr, acc[ct], 0, 0, 0); }
    }
#pragma unroll
    for (int ct = 0; ct < 16; ++ct) { const float bb = bias[16 * ct + l16];
#pragma unroll
        for (int r = 0; r < 4; ++r) { const float x = acc[ct][r] + bb; const float u2 = 1.5957691216f * (x + 0.044715f * x * x * x); const float gl = x * fsigmoid(u2);
            *(LAS bf16_t*)(scr + (4 * kq + r) * 528 + (16 * ct + l16) * 2) = (bf16_t)(cvt_pk_bf16(gl, 0.f) & 0xffffu); } }
    asm volatile("s_waitcnt lgkmcnt(0)" ::: "memory");
    f32x4 o2[8];
#pragma unroll
    for (int i = 0; i < 8; ++i) o2[i] = (f32x4){0.f, 0.f, 0.f, 0.f};
#pragma unroll
    for (int s = 0; s < 8; ++s) {
        const bf16x8 af = *(const LAS bf16x8*)(scr + l16 * 528 + (32 * s + 8 * kq) * 2);
#pragma unroll
        for (int dt = 0; dt < 8; ++dt) { const bf16x8 bfr = *(const bf16x8*)(w2t + (size_t)(16 * dt + l16) * 256 + 32 * s + 8 * kq);
            o2[dt] = __builtin_amdgcn_mfma_f32_16x16x32_bf16(af, bfr, o2[dt], 0, 0, 0); }
    }
    asm volatile("s_waitcnt lgkmcnt(0)" ::: "memory");
#pragma unroll
    for (int dt = 0; dt < 8; ++dt)
#pragma unroll
        for (int r = 0; r < 4; ++r) { const int nn = 16 * rt + 4 * kq + r; if (nn < 1023) outc[((size_t)g * 1024 + nn) * 128 + 16 * dt + l16] = (bf16_t)(cvt_pk_bf16(o2[dt][r], 0.f) & 0xffffu); }
}

__device__ __forceinline__ void nsa_unit(int unit, const bf16_t* proj, const bf16_t* kc, const bf16_t* vc, const bf16_t* gn, const float* cs, const float* sn,
                                         bf16_t* nsaout, LAS unsigned char* wl, int lane) {
    const int l16 = lane & 15, kq = lane >> 4;
    const int g = unit & 1, tb = unit >> 1, t0 = 4 * tb, qi = l16 >> 2, h = l16 & 3, tc = t0 + qi, head = 4 * g + h;
    LAS unsigned char* vbuf = wl; LAS float* imp = (LAS float*)(wl + VBUF_BYTES); LAS int* sel = (LAS int*)(wl + VBUF_BYTES + 4 * IMP_LD * 4);
    bf16x8 qf[4];
    { const bf16_t* qrow = proj + (size_t)tc * PLD + PC_QA + head * 128 + 8 * kq;
#pragma unroll
        for (int s = 0; s < 4; ++s) qf[s] = *(const bf16x8*)(qrow + 32 * s); }
    LAS u32x2* outl = (LAS u32x2*)(wl + OUT_OFF) + lane;
    for (int i = lane; i < 4 * IMP_LD; i += 64) imp[i] = 0.f;
    const int hic = (tc - 31) >> 4;
    const int nkmax = ((t0 + 3 - 31) >> 4) + 1, nsc = nkmax > 0 ? (nkmax + 31) >> 5 : 0;
    const bf16_t* kcg = kc + (size_t)g * 1024 * 128; const bf16_t* vcg = vc + (size_t)g * 1024 * 128;
    AState st; astate_init(st);
    { auto desc = [&](int i) { return 32 * i; };
      attn_run<1, false>(qf, kcg, vcg, 128, 1, 1022, desc, nsc, 0, hic, 0, st, vbuf, lane);
      { const float lt = quad_total(st.l); st.l = lt > 0.f ? 1.f / lt : 0.f; }
      asm volatile("s_waitcnt lgkmcnt(0)" ::: "memory");
      attn_run<2, false>(qf, kcg, vcg, 128, 1, 1022, desc, nsc, 0, hic, 0, st, vbuf, lane, imp); }
    const float g0 = bf2f(gn[(size_t)tc * 32 + head * 3 + 0]);
#pragma unroll
    for (int i = 0; i < 8; ++i) { const f32x4 o = st.o[i] * g0; u32x2 w; w.x = cvt_pk_bf16(o[0], o[1]); w.y = cvt_pk_bf16(o[2], o[3]); outl[64 * i] = w; }
    asm volatile("s_waitcnt lgkmcnt(0)" ::: "memory");
#pragma unroll
    for (int s2 = 0; s2 < 2; ++s2) {
        const int d = 32 * s2 + 8 * kq; f32x4 c[2], sv[2];
        c[0] = *(const f32x4*)(cs + (size_t)tc * 64 + d); c[1] = *(const f32x4*)(cs + (size_t)tc * 64 + d + 4);
        sv[0] = *(const f32x4*)(sn + (size_t)tc * 64 + d); sv[1] = *(const f32x4*)(sn + (size_t)tc * 64 + d + 4);
        float o1[8], o2[8];
#pragma unroll
        for (int j = 0; j < 8; ++j) { const float x1 = bf2f((unsigned short)qf[s2][j]), x2 = bf2f((unsigned short)qf[s2 + 2][j]), cc = c[j >> 2][j & 3], ss = sv[j >> 2][j & 3];
            o1[j] = x1 * cc - x2 * ss; o2[j] = x2 * cc + x1 * ss; }
        u32x4 w1, w2; w1.x = cvt_pk_bf16(o1[0], o1[1]); w1.y = cvt_pk_bf16(o1[2], o1[3]); w1.z = cvt_pk_bf16(o1[4], o1[5]); w1.w = cvt_pk_bf16(o1[6], o1[7]);
        w2.x = cvt_pk_bf16(o2[0], o2[1]); w2.y = cvt_pk_bf16(o2[2], o2[3]); w2.z = cvt_pk_bf16(o2[4], o2[5]); w2.w = cvt_pk_bf16(o2[6], o2[7]);
        qf[s2] = __builtin_bit_cast(bf16x8, w1); qf[s2 + 2] = __builtin_bit_cast(bf16x8, w2);
    }
    unsigned key[4][4];
#pragma unroll
    for (int q = 0; q < 4; ++q) { const int cur = (t0 + q) >> 6; const f32x4 v = *(const LAS f32x4*)(imp + q * IMP_LD + 4 * lane);
#pragma unroll
        for (int i = 0; i < 4; ++i) { const int j = 4 * lane + i; const bool valid = j <= cur, forced = (j == 0) | (j == cur) | (j == cur - 1);
            const unsigned kb = forced ? 0xffffffu : ((__float_as_uint(fmaxf(v[i], 0.f)) >> 8) + 1u);
            key[q][i] = valid ? ((kb << 8) | (unsigned)(255 - j)) : 0u; } }
#pragma unroll 1
    for (int r = 0; r < 16; ++r) {
        unsigned mx[4];
#pragma unroll
        for (int q = 0; q < 4; ++q) { unsigned a = key[q][0] > key[q][1] ? key[q][0] : key[q][1], b = key[q][2] > key[q][3] ? key[q][2] : key[q][3]; mx[q] = a > b ? a : b; }
#pragma unroll
        for (int o = 1; o < 64; o <<= 1)
#pragma unroll
            for (int q = 0; q < 4; ++q) { const unsigned other = (unsigned)__shfl_xor((int)mx[q], o); mx[q] = other > mx[q] ? other : mx[q]; }
#pragma unroll
        for (int q = 0; q < 4; ++q) {
#pragma unroll
            for (int i = 0; i < 4; ++i) if (key[q][i] == mx[q]) key[q][i] = 0u;
            if (lane == 0) sel[q * 16 + r] = mx[q] ? (int)(255u - (mx[q] & 255u)) : -1;
        }
    }
    asm volatile("s_waitcnt lgkmcnt(0)" ::: "memory");
    LAS int* list = (LAS int*)(wl + VBUF_BYTES + 4 * IMP_LD * 4 + 256);
    int nslc;
    { const int b = sel[lane], q = lane >> 4, cur0 = t0 >> 6;
      const bool forced = (b == 0) | (b == cur0) | (b == cur0 - 1);
      const bool valid = (b >= 0) & !(forced & (q > 0)); const unsigned long long mask = __ballot(valid);
      const int idx = __popcll(mask & ((1ull << lane) - 1ull)); nslc = 2 * __popcll(mask);
      if (valid) { const int qc = forced ? 4 : q; list[2 * idx] = (64 * b) | (qc << 20); list[2 * idx + 1] = (64 * b + 32) | (qc << 20); } }
    asm volatile("s_waitcnt lgkmcnt(0)" ::: "memory");
    astate_init(st);
    { auto desc = [&](int i) { return __builtin_amdgcn_readfirstlane(list[i]); };
      attn_run<0, true>(qf, proj + PC_KSL + 128 * g, proj + PC_VSL + 128 * g, PLD, 1, S - 1, desc, nslc, 0, tc, qi, st, vbuf, lane); }
    { const float g1 = bf2f(gn[(size_t)tc * 32 + head * 3 + 1]); const float lt = quad_total(st.l), inv = (lt > 0.f ? 1.f / lt : 0.f) * g1;
#pragma unroll
        for (int i = 0; i < 8; ++i) { const f32x4 o = st.o[i] * inv; u32x2 w = outl[64 * i]; w.x = cvt_pk_bf16(bflo(w.x) + o[0], bfhi(w.x) + o[1]); w.y = cvt_pk_bf16(bflo(w.y) + o[2], bfhi(w.y) + o[3]); outl[64 * i] = w; } }
    astate_init(st);
    { const int lo = tc - 511 < 0 ? 0 : tc - 511; const int i0 = t0 < 511 ? (511 - t0) >> 5 : 0;
      auto desc = [&](int i) { return t0 - 511 + 32 * (i0 + i); };
      attn_run<0, false>(qf, proj + PC_KWN + 128 * g, proj + PC_VWN + 128 * g, PLD, 1, S - 1, desc, 17 - i0, lo, tc, 0, st, vbuf, lane); }
    { const float g2 = bf2f(gn[(size_t)tc * 32 + head * 3 + 2]); const float lt = quad_total(st.l), inv = (lt > 0.f ? 1.f / lt : 0.f) * g2;
#pragma unroll
        for (int i = 0; i < 8; ++i) { const f32x4 o = st.o[i] * inv; u32x2 w = outl[64 * i]; w.x = cvt_pk_bf16(bflo(w.x) + o[0], bfhi(w.x) + o[1]); w.y = cvt_pk_bf16(bflo(w.y) + o[2], bfhi(w.y) + o[3]); outl[64 * i] = w; } }
    bf16_t* op = nsaout + (size_t)tc * NOLD + head * 128 + 4 * kq;
#pragma unroll
    for (int db = 0; db < 8; ++db) *(u32x2*)(op + 16 * db) = outl[64 * db];
}


#define XB_TMO      128
#define XB_XCNT(j)  (256  + 64 * (j))
#define XB_XSUB(j)  (1280 + 64 * (j))
#define XB_XGEN(j)  (2304 + 64 * (j))
#define XB_TOP      3328
#define XB_TOPGEN   3392
#define XCD_BAR_WORDS 3456
#define XB_SPIN_CAP (1u << 18)
__device__ __forceinline__ unsigned xb_ld(unsigned* p)              { return __hip_atomic_load(p, __ATOMIC_RELAXED, __HIP_MEMORY_SCOPE_AGENT); }
__device__ __forceinline__ unsigned xb_add(unsigned* p, unsigned v) { return __hip_atomic_fetch_add(p, v, __ATOMIC_RELAXED, __HIP_MEMORY_SCOPE_AGENT); }
__device__ __forceinline__ unsigned xb_xcc_id() { return (unsigned)__builtin_amdgcn_s_getreg((3 << 11) | 20) & 0xFu; }
#define XB_SPIN(cond, bar) do { unsigned _sp = 0; while (cond) { __builtin_amdgcn_s_sleep(1); \
    if ((++_sp & 255u) == 0u) { if (xb_ld(&(bar)[XB_TMO])) break; if (_sp > XB_SPIN_CAP) { atomicAdd(&(bar)[XB_TMO], 1u); break; } } } } while (0)
struct XcdBarrier { unsigned* bar; unsigned x; volatile LAS unsigned* st; };
__device__ __forceinline__ XcdBarrier xcd_barrier_post(unsigned* bar, volatile LAS unsigned* st) {
    XcdBarrier b; b.bar = bar; b.x = xb_xcc_id(); b.st = st;
    if (threadIdx.x == 0) (void)xb_add(&bar[XB_XCNT(b.x)], 1u);
    return b;
}
__device__ __forceinline__ void xcd_barrier_complete(unsigned* bar, unsigned x, unsigned& nloc, unsigned& nx) {
    const unsigned G = gridDim.x * gridDim.y * gridDim.z;
    unsigned sum, cnt, mine, sp = 0u;
    for (;;) {
        sum = 0u; cnt = 0u; mine = 0u;
#pragma unroll
        for (unsigned j = 0; j < 16; ++j) { const unsigned c = xb_ld(&bar[XB_XCNT(j)]); sum += c; cnt += (c > 0u) ? 1u : 0u; mine = (j == x) ? c : mine; }
        if (sum == G) break;
        __builtin_amdgcn_s_sleep(1);
        if ((++sp & 255u) == 0u) { if (xb_ld(&bar[XB_TMO])) break; if (sp > XB_SPIN_CAP) { atomicAdd(&bar[XB_TMO], 1u); break; } }
    }
    nloc = mine > 0u ? mine : 1u; nx = cnt > 0u ? cnt : 1u;
}
__device__ __forceinline__ void xcd_barrier(const XcdBarrier& b) {
    asm volatile("s_waitcnt vmcnt(0)" ::: "memory");
    __syncthreads();
    if (threadIdx.x == 0) {
        unsigned* bar = b.bar;
        __builtin_amdgcn_s_waitcnt(0);
        unsigned nloc = b.st[0], nx = b.st[1];
        if (nloc == 0u) { xcd_barrier_complete(bar, b.x, nloc, nx); b.st[0] = nloc; b.st[1] = nx; }
        const unsigned old = xb_add(&bar[XB_XSUB(b.x)], 1u);
        const unsigned gen = old / nloc;
        if (old + 1u == (gen + 1u) * nloc) {
            __builtin_amdgcn_fence(__ATOMIC_RELEASE, "agent");
            asm volatile("s_waitcnt vmcnt(0)" ::: "memory");
            const unsigned og = xb_add(&bar[XB_TOP], 1u);
            const unsigned tg = og / nx;
            if (og + 1u == (tg + 1u) * nx) xb_add(&bar[XB_TOPGEN], 1u);
            else XB_SPIN(xb_ld(&bar[XB_TOPGEN]) == tg, bar);
            __builtin_amdgcn_fence(__ATOMIC_ACQUIRE, "agent");
            xb_add(&bar[XB_XGEN(b.x)], 1u);
            asm volatile("s_waitcnt vmcnt(0)" ::: "memory");
        } else {
            XB_SPIN(xb_ld(&bar[XB_XGEN(b.x)]) == gen, bar);
            __builtin_amdgcn_fence(__ATOMIC_ACQUIRE, "agent");
            asm volatile("s_waitcnt vmcnt(0)" ::: "memory");
        }
    }
    __syncthreads();
}

struct Params { const float* in[23]; float* out; unsigned char* ws; float inv_freq[64]; };

__global__ void __launch_bounds__(512, 2) fwd_megakernel(Params P) {
    extern __shared__ __attribute__((aligned(16))) unsigned char lds_raw[];
    LAS unsigned char* lds = (LAS unsigned char*)lds_raw;
    cg::grid_group grid = cg::this_grid();
#define PHASE_WS unsigned long long wsv_ = (unsigned long long)P.ws; asm volatile("" : "+s"(wsv_)); unsigned char* ws = (unsigned char*)(__attribute__((address_space(1))) unsigned char*)wsv_; int tid = threadIdx.x; asm volatile("" : "+v"(tid)); \
    const int lane = tid & 63, wave = __builtin_amdgcn_readfirstlane(tid >> 6), G = gridDim.x, gw = blockIdx.x * 8 + wave, ngw = G * 8; \
    const size_t gtid = (size_t)blockIdx.x * 512 + tid, gthreads = (size_t)G * 512; \
    LAS unsigned char* wl = lds + wave * WAVE_LDS; LAS float* scr = (LAS float*)wl; (void)lane; (void)gw; (void)ngw; (void)gtid; (void)gthreads; (void)wl; (void)scr
#define WAB ((bf16_t*)(ws + WS_WAB))
#define WO ((bf16_t*)(ws + WS_WO))
#define CW1K ((bf16_t*)(ws + WS_CW1K))
#define CW1V ((bf16_t*)(ws + WS_CW1V))
#define CW2K ((bf16_t*)(ws + WS_CW2K))
#define CW2V ((bf16_t*)(ws + WS_CW2V))
#define CBIAS ((float*)(ws + WS_CBIAS))
#define KC ((bf16_t*)(ws + WS_KC))
#define VC ((bf16_t*)(ws + WS_VC))
#define GN ((bf16_t*)(ws + WS_GN))
#define HF ((float*)(ws + WS_HF))
#define HB ((bf16_t*)(ws + WS_HB))
#define GU ((bf16_t*)(ws + WS_GU))
#define DN ((bf16_t*)(ws + WS_DN))
#define ACT ((bf16_t*)(ws + WS_ACT))
#define PROJ ((bf16_t*)(ws + WS_PROJ))
#define RCOS ((float*)(ws + WS_ROPE))
#define RSIN ((float*)(ws + WS_ROPE) + (size_t)S * 64)
#define WINT ((bf16_t*)(ws + WS_WIN))
#define NSAOUT ((bf16_t*)(ws + WS_NSAOUT))
#define SIGG ((bf16_t*)P.out)
    pg8::StaticOrder SO;
#define CG_SYNC() do { asm volatile("s_waitcnt vmcnt(0) lgkmcnt(0)" ::: "memory"); grid.sync(); \
        if (__builtin_amdgcn_readfirstlane(threadIdx.x >> 6) == 0) { __builtin_amdgcn_fence(__ATOMIC_ACQUIRE, "agent"); asm volatile("s_waitcnt vmcnt(0)" ::: "memory"); } \
        __syncthreads(); } while (0)
    volatile LAS unsigned* xst = (volatile LAS unsigned*)(lds + 8 * WAVE_LDS);
    if (threadIdx.x < 2) xst[threadIdx.x] = 0u;
    __syncthreads();
    const XcdBarrier xbar = xcd_barrier_post((unsigned*)P.ws, xst);
#define GRID_SYNC() do { asm volatile("s_waitcnt vmcnt(0) lgkmcnt(0)" ::: "memory"); xcd_barrier(xbar); } while (0)

    { PHASE_WS;
        conv_ffn(P.in[1], P.in[2], P.in[3], GU, DN, scr, gw, ngw, lane);
        for (int it = gw; it < 32 * 360; it += ngw) { const int kb = it / 360, nb = it % 360, dr = nb * 32; const int sc = win_src_col(dr);
            tr_item(P.in[6], WIN_SRC, kb * 64, sc < 0 ? 0 : sc, sc < 0 ? 0 : (dr == 11264 ? 24 : 32), WINT, DM, dr, kb * 64, scr, lane); }
        for (int it = gw; it < 16 * 64; it += ngw) { const int kb = it / 64, nb = it % 64; tr_item(P.in[13], DM, kb * 64, nb * 32, 32, WAB, 1024, nb * 32, kb * 64, scr, lane); }
        for (int it = gw; it < 8 * 64; it += ngw) { const int kb = it / 64, nb = it % 64; tr_item(P.in[14], DM, kb * 64, nb * 32, 32, WAB + (size_t)DM * 1024, 512, nb * 32, kb * 64, scr, lane); }
        for (int it = gw; it < 32 * 64; it += ngw) { const int kb = it / 64, nb = it % 64; tr_item(P.in[15], DM, kb * 64, nb * 32, 32, WO, DM, nb * 32, kb * 64, scr, lane); }
        for (int it = gw; it < 2 * 64 * 8; it += ngw) { const int w = it / 512, r = it % 512, kb = r / 8, nb = r % 8; tr_item(w ? P.in[11] : P.in[8], 256, kb * 64, nb * 32, 32, w ? CW1V : CW1K, 4096, nb * 32, kb * 64, scr, lane); }
        for (int it = gw; it < 2 * 4 * 4; it += ngw) { const int w = it / 16, r = it % 16, kb = r / 4, nb = r % 4; tr_item(w ? P.in[12] : P.in[9], 128, kb * 64, nb * 32, 32, w ? CW2V : CW2K, 256, nb * 32, kb * 64, scr, lane); }
        { const float* x = P.in[0];
            for (size_t i = gtid; i < (size_t)S * DM / 8; i += gthreads) { const f32x4 a = *(const f32x4*)(x + 8 * i), b = *(const f32x4*)(x + 8 * i + 4); *(u32x4*)(HB + 8 * i) = pack8(a, b); } }
        for (int o = gw; o < 512; o += ngw) { const int w = o >> 8, c = o & 255; const float* pos = w ? P.in[10] : P.in[7]; const float* w1 = w ? P.in[11] : P.in[8];
            float s = 0.f; for (int kk = lane; kk < 4096; kk += 64) s += pos[kk] * w1[(size_t)kk * 256 + c];
            s = wave_sum(s); if (lane == 0) CBIAS[o] = s; }
    }
    CG_SYNC();
    { PHASE_WS; pg8::Gemm g{HB, GU, S, NGU, DM, DM, DM}; SO.init(S, NGU, G, (int)blockIdx.x); EpiSwiglu E{ACT}; pg8::gemm_phase(lds, g, SO, E); }
    GRID_SYNC();
    { PHASE_WS; pg8::Gemm g{ACT, DN, S, DM, FF, FF, FF}; SO.init(S, DM, G, (int)blockIdx.x); EpiResF32 E{P.in[0], HF, ALPHA, 0.5f}; pg8::gemm_phase(lds, g, SO, E); }
    GRID_SYNC();
    { PHASE_WS;
        ln_rows(HF, HF, HB, P.in[4], P.in[5], gw, ngw, lane);
        for (size_t i = gtid; i < (size_t)S * 64; i += gthreads) { const int t = (int)(i >> 6), j = (int)(i & 63); const float ang = (float)t * P.inv_freq[j]; RCOS[i] = cosf(ang); RSIN[i] = sinf(ang); }
    }
    GRID_SYNC();
    { PHASE_WS; pg8::Gemm g{HB, WINT, S, NWIN, DM, DM, DM}; SO.init(S, NWIN, G, (int)blockIdx.x); EpiWin E{PROJ, SIGG, GN, RCOS, RSIN}; pg8::gemm_phase(lds, g, SO, E); }
    GRID_SYNC();
    { PHASE_WS;
        if (wave == 0) { for (int u = blockIdx.x; u < 256; u += G) { const int kv = u >> 7; compress_unit(u, PROJ, kv ? CW1V : CW1K, kv ? CW2V : CW2K, CBIAS + 256 * kv, kv ? VC : KC, wl, lane); } }
        else { for (int u = blockIdx.x * 7 + (wave - 1); u < 4096; u += G * 7) dilated_unit(u, PROJ, NSAOUT, wl, lane); }
    }
    GRID_SYNC();
    { PHASE_WS;
      if ((G & 7) == 0) {
          const int bx = blockIdx.x, x = bx & 7, g = x & 1, wj = ((bx >> 3) * 4 + (x >> 1)) * 8 + wave, nwj = (G >> 1) * 8;
          for (int tb = wj; tb < 4096; tb += nwj) nsa_unit(2 * tb + g, PROJ, KC, VC, GN, RCOS, RSIN, NSAOUT, wl, lane);
      } else { for (int u = gw; u < 8192; u += ngw) nsa_unit(u, PROJ, KC, VC, GN, RCOS, RSIN, NSAOUT, wl, lane); } }
    GRID_SYNC();
    { PHASE_WS; SO.init(S, DM, G, (int)blockIdx.x);
      { pg8::Gemm g{NSAOUT, WAB, S, DM, 1024, NOLD, 1024}; EpiGate<true> E{SIGG, HB}; pg8::gemm_phase(lds, g, SO, E); }
      { pg8::Gemm g{NSAOUT + 1024, WAB + (size_t)DM * 1024, S, DM, 512, NOLD, 512}; EpiGate<false> E{SIGG + 2048, HB}; pg8::gemm_phase(lds, g, SO, E); } }
    GRID_SYNC();
    { PHASE_WS; pg8::Gemm g{HB, WO, S, DM, DM, DM, DM}; SO.init(S, DM, G, (int)blockIdx.x); EpiResF32 E{HF, HF, ALPHA, 1.0f}; pg8::gemm_phase(lds, g, SO, E); }
    GRID_SYNC();
    { PHASE_WS;
        ln_rows(HF, HF, HB, P.in[16], P.in[17], gw, ngw, lane);
        conv_ffn(P.in[18], P.in[19], P.in[20], GU, DN, scr, gw, ngw, lane);
    }
    GRID_SYNC();
    { PHASE_WS; pg8::Gemm g{HB, GU, S, NGU, DM, DM, DM}; SO.init(S, NGU, G, (int)blockIdx.x); EpiSwiglu E{ACT}; pg8::gemm_phase(lds, g, SO, E); }
    GRID_SYNC();
    { PHASE_WS; pg8::Gemm g{ACT, DN, S, DM, FF, FF, FF}; SO.init(S, DM, G, (int)blockIdx.x); EpiResF32 E{HF, P.out, ALPHA, 0.5f}; pg8::gemm_phase(lds, g, SO, E); }
    GRID_SYNC();
    { PHASE_WS; (void)ws; ln_rows(P.out, P.out, nullptr, P.in[21], P.in[22], gw, ngw, lane); }
}

extern "C" void kernel_launch(void* const* d_in, const int* in_sizes, int n_in, void* d_out, int out_size, void* d_ws, size_t ws_size, hipStream_t stream) {
    static int grid = 0;
    if (grid == 0) {
        if (n_in != 23 || out_size != S * DM || ws_size < WS_END) { fprintf(stderr, "kernel_launch: unexpected shapes (n_in %d out %d ws %zu, need %zu)\n", n_in, out_size, ws_size, (size_t)WS_END); grid = -1; return; }
        int dev = 0, cus = 0, per_cu = 0;
        hipGetDevice(&dev); hipDeviceGetAttribute(&cus, hipDeviceAttributeMultiprocessorCount, dev);
        if (hipFuncSetAttribute((const void*)fwd_megakernel, hipFuncAttributeMaxDynamicSharedMemorySize, LDS_BYTES) != hipSuccess) { fprintf(stderr, "kernel_launch: hipFuncSetAttribute failed\n"); grid = -1; return; }
        if (hipOccupancyMaxActiveBlocksPerMultiprocessor(&per_cu, (const void*)fwd_megakernel, 512, LDS_BYTES) != hipSuccess || per_cu < 1) { fprintf(stderr, "kernel_launch: occupancy query failed (%d)\n", per_cu); (void)hipGetLastError(); per_cu = 1; }
        grid = cus * per_cu;
    }
    if (grid < 0) return;
    if (hipMemsetAsync(d_ws, 0, 16384, stream) != hipSuccess) { fprintf(stderr, "kernel_launch: memset of the barrier words failed\n"); return; }
    Params p{};
    for (int i = 0; i < 23; ++i) p.in[i] = (const float*)d_in[i];
    p.out = (float*)d_out; p.ws = (unsigned char*)d_ws;
    for (int i = 0; i < 64; ++i) p.inv_freq[i] = (float)pow(10000.0, -(double)i / 64.0);
    void* args[] = {&p};
    hipError_t e = hipLaunchCooperativeKernel((const void*)fwd_megakernel, dim3(grid), dim3(512), args, LDS_BYTES, stream);
    if (e != hipSuccess) fprintf(stderr, "kernel_launch: cooperative launch failed: %s (grid %d)\n", hipGetErrorString(e), grid);
}
```

```cpp
#include <hip/hip_runtime.h>
#include <hip/hip_cooperative_groups.h>
#include <cstdio>
#include <cstdint>
#include <cmath>
namespace cg = cooperative_groups;

#define LAS __attribute__((address_space(3)))
typedef unsigned short bf16_t;
typedef short bf16x8 __attribute__((ext_vector_type(8)));
typedef short s16x4 __attribute__((ext_vector_type(4)));
typedef float f32x4 __attribute__((ext_vector_type(4)));
typedef float f32x2 __attribute__((ext_vector_type(2)));
typedef unsigned u32x4 __attribute__((ext_vector_type(4)));
typedef unsigned u32x2 __attribute__((ext_vector_type(2)));

constexpr int S = 16384, DM = 2048, FF = 5632, NGU = 2 * FF, NWIN = 11520, WIN_SRC = 11288, PLD = 6144, NOLD = 1536;
constexpr float ALPHA = 1.189207115002721f;
constexpr float LN_EPS = 1e-5f;
constexpr float SL2 = 0.08838834764831845f * 1.4426950408889634f;
constexpr int PC_QA = 0, PC_KC = 1024, PC_VC = 1280, PC_QB = 1536, PC_KB = 3072, PC_VB = 4608;
constexpr size_t MiB = 1u << 20;
constexpr size_t WS_WAB = 1 * MiB, WS_WO = 13 * MiB, WS_CW1K = 21 * MiB, WS_CW1V = 23 * MiB, WS_CW2K = 25 * MiB, WS_CW2V = 25 * MiB + 65536, WS_CBIAS = 25 * MiB + 131072;
constexpr size_t WS_KC = 26 * MiB, WS_VC = 26 * MiB + 524288, WS_GN = 27 * MiB;
constexpr size_t WS_HF = 32 * MiB, WS_HB = 160 * MiB, WS_BIG = 224 * MiB;
constexpr size_t WS_GU = WS_BIG, WS_DN = WS_BIG + 44 * MiB, WS_ACT = WS_BIG + 66 * MiB;
constexpr size_t WS_PROJ = WS_BIG, WS_KSLF = WS_BIG + 192 * MiB, WS_VSLF = WS_BIG + 200 * MiB, WS_KWNF = WS_BIG + 208 * MiB, WS_VWNF = WS_BIG + 216 * MiB, WS_ROPE = WS_BIG + 224 * MiB;
constexpr size_t WS_WIN = 466 * MiB, WS_NSAOUT = 466 * MiB, WS_END = 514 * MiB;

constexpr int VROW = 288, VBUF_BYTES = 32 * VROW;
constexpr int IMP_LD = 260;
constexpr int OUT_OFF = VBUF_BYTES + 4 * IMP_LD * 4 + 256 + 512;
constexpr int WAVE_LDS = OUT_OFF + 4096;
constexpr int LDS_BYTES = 147456;
static_assert(8 * WAVE_LDS + 16 <= LDS_BYTES && 131072 <= LDS_BYTES, "LDS map");

typedef __bf16 bf16x2_t __attribute__((ext_vector_type(2)));
__device__ __forceinline__ unsigned cvt_pk_bf16(float lo, float hi) { f32x2 v = {lo, hi}; bf16x2_t b = __builtin_convertvector(v, bf16x2_t); return __builtin_bit_cast(unsigned, b); }
__device__ __forceinline__ float bf2f(unsigned short b) { return __uint_as_float(((unsigned)b) << 16); }
__device__ __forceinline__ float bflo(unsigned w) { return __uint_as_float(w << 16); }
__device__ __forceinline__ float bfhi(unsigned w) { return __uint_as_float(w & 0xffff0000u); }
__device__ __forceinline__ float fsigmoid(float x) { return __builtin_amdgcn_rcpf(1.f + __expf(-x)); }
__device__ __forceinline__ float wave_sum(float v) {
#pragma unroll
    for (int o = 1; o < 64; o <<= 1) v += __shfl_xor(v, o);
    return v;
}
__device__ __forceinline__ u32x4 pack8(const f32x4 a, const f32x4 b) { u32x4 w; w.x = cvt_pk_bf16(a[0], a[1]); w.y = cvt_pk_bf16(a[2], a[3]); w.z = cvt_pk_bf16(b[0], b[1]); w.w = cvt_pk_bf16(b[2], b[3]); return w; }

namespace pg8 {
constexpr int BM = 256, BK = 64, HALF = 128, HTB = HALF * BK * 2, STAGE_BYTES = 8 * HTB, NXCD = 8, WGM = 8;
__host__ __device__ __forceinline__ int lds_byte(int r, int c) { const int st = (r >> 4) * 2 + (c >> 5), rr = r & 15, cc = c & 31, ob = rr * 64 + cc * 2; return st * 1024 + (ob ^ (((ob >> 9) & 1) << 5)); }
__host__ __device__ __forceinline__ void stage_rc(int b, int& R, int& C) { const int st = b / 1024, sb = b % 1024, swz = sb ^ (((sb >> 9) & 1) << 5); R = (st >> 1) * 16 + swz / 64; C = (st & 1) * 32 + (swz % 64) / 2; }
__host__ __device__ __forceinline__ int perm32(int rho) { const int n = rho >> 4, i = rho & 15; return 8 * (i >> 2) + 4 * n + (i & 3); }
struct Unit { int pm, pn; };
struct Gemm { const bf16_t* A; const bf16_t* Bt; int M, N, K, lda, ldb; };
struct StaticOrder {
    int nM, nN, nwg, G, c;
    __device__ void init(int M, int N, int G_, int c_) { nM = M / BM; nN = N / BM; nwg = nM * nN; G = G_; c = c_; }
    __device__ bool next(int i, Unit& u) const {
        const long L = (long)i * G + c; if (L >= nwg) return false;
        int wgid = (int)L; { const int q = nwg / NXCD, r = nwg % NXCD, xcd = wgid % NXCD, off = wgid / NXCD; wgid = (xcd < r ? xcd * (q + 1) : r * (q + 1) + (xcd - r) * q) + off; }
        const int nig = WGM * nN, gid = wgid / nig, fm = gid * WGM, gsz = (nM - fm) < WGM ? (nM - fm) : WGM;
        u.pm = fm + ((wgid % nig) % gsz); u.pn = (wgid % nig) / gsz; return true;
    }
};
typedef f32x4 Acc[2][2][4][2];

template <class Epi>
__device__ __forceinline__ void gemm_phase(LAS unsigned char* lds, const Gemm g, const StaticOrder& S_, const Epi& E) {
    const int tid = threadIdx.x, wid = __builtin_amdgcn_readfirstlane(tid >> 6), lane = tid & 63, wr = wid >> 2, wc = wid & 3, fr = lane & 15, fq = lane >> 4;
    const int K = g.K, nt = K / BK;
    unsigned voffA[2], voffB[2];
#pragma unroll
    for (int i = 0; i < 2; ++i) { int R, C; stage_rc(tid * 16 + i * 8192, R, C); const int Rb = Epi::PERM ? ((R & ~31) + perm32(R & 31)) : R;
        voffA[i] = (unsigned)(R * g.lda + C) * 2u; voffB[i] = (unsigned)(Rb * g.ldb + C) * 2u; }
    const size_t kstep = (size_t)(BK * 2);
    const size_t hstepA = (size_t)HALF * g.lda * 2, hstepB = (size_t)HALF * g.ldb * 2;
    const size_t tstepA = 2 * hstepA, tstepB = 2 * hstepB;
    const unsigned ldsw = (unsigned)wid * 1024u;
    const int aoff = lds_byte(wr * 64 + fr, fq * 8), boff = lds_byte(wc * 32 + fr, fq * 8);
#define PG8_SA(b, h) (((b) * 2 + (h)) * HTB)
#define PG8_SB(b, h) ((4 + (b) * 2 + (h)) * HTB)
#define PG8_STAGE(bufoff, gbase, voff) do { _Pragma("unroll") for (int _i = 0; _i < 2; ++_i) \
        __builtin_amdgcn_global_load_lds((const unsigned*)((const char*)(gbase) + (voff)[_i]), (LAS unsigned*)(lds + (bufoff) + ldsw + _i * 8192), 16, 0, 0); } while (0)
#define PG8_LDA(dst, b, h) do { _Pragma("unroll") for (int m = 0; m < 4; ++m) _Pragma("unroll") for (int k = 0; k < 2; ++k) dst[m][k] = *(const LAS bf16x8*)(lds + PG8_SA(b, h) + aoff + m * 2048 + k * 1024); } while (0)
#define PG8_LDB(dst, b, h) do { _Pragma("unroll") for (int n = 0; n < 2; ++n) _Pragma("unroll") for (int k = 0; k < 2; ++k) dst[n][k] = *(const LAS bf16x8*)(lds + PG8_SB(b, h) + boff + n * 2048 + k * 1024); } while (0)
#define PG8_MMA(ai, bj, At, Bt) do { __builtin_amdgcn_s_setprio(1); _Pragma("unroll") for (int m = 0; m < 4; ++m) _Pragma("unroll") for (int n = 0; n < 2; ++n) _Pragma("unroll") for (int k = 0; k < 2; ++k) \
        acc[ai][bj][m][n] = __builtin_amdgcn_mfma_f32_16x16x32_bf16(Bt[n][k], At[m][k], acc[ai][bj][m][n], 0, 0, 0); __builtin_amdgcn_s_setprio(0); } while (0)
#define PG8_WAIT_V(n) asm volatile("s_waitcnt vmcnt(" #n ")" ::: "memory")
#define PG8_WAIT_L(n) asm volatile("s_waitcnt lgkmcnt(" #n ")" ::: "memory")
#define PG8_BAR __builtin_amdgcn_s_barrier()
#define PG8_SCHED __builtin_amdgcn_sched_barrier(0)
    Unit cur, nxt; int ui = 0;
    if (!S_.next(0, cur)) return;
    Acc acc;
#pragma unroll
    for (int a = 0; a < 2; ++a)
#pragma unroll
        for (int b = 0; b < 2; ++b)
#pragma unroll
            for (int m = 0; m < 4; ++m)
#pragma unroll
                for (int n = 0; n < 2; ++n) acc[a][b][m][n] = (f32x4){0.f, 0.f, 0.f, 0.f};
    bf16x8 At[4][2], B0[2][2], B1[2][2];
    const char* cA = (const char*)g.A + (size_t)cur.pm * tstepA; const char* cB = (const char*)g.Bt + (size_t)cur.pn * tstepB;
    PG8_STAGE(PG8_SB(0, 0), cB, voffB); PG8_STAGE(PG8_SB(0, 1), cB + hstepB, voffB); PG8_STAGE(PG8_SA(0, 0), cA, voffA); PG8_STAGE(PG8_SA(0, 1), cA + hstepA, voffA);
    if (wr == 1) PG8_BAR;
    PG8_WAIT_V(2); PG8_BAR;
    PG8_STAGE(PG8_SB(1, 0), cB + kstep, voffB); PG8_STAGE(PG8_SA(1, 0), cA + kstep, voffA); PG8_STAGE(PG8_SB(1, 1), cB + hstepB + kstep, voffB);
    PG8_WAIT_V(6); PG8_BAR;
    for (;;) {
        const bool has_next = S_.next(ui + 1, nxt);
        const char* nA = has_next ? (const char*)g.A + (size_t)nxt.pm * tstepA : cA; const char* nB = has_next ? (const char*)g.Bt + (size_t)nxt.pn * tstepB : cB;
        for (int t = 0; t < nt; t += 2) {
            const bool last = (t == nt - 2);
            const char* a1 = cA + (size_t)(t + 1) * kstep;
            const char* a2 = last ? nA : cA + (size_t)(t + 2) * kstep; const char* b2 = last ? nB : cB + (size_t)(t + 2) * kstep;
            const char* a3 = a2 + kstep; const char* b3 = b2 + kstep;
            PG8_LDB(B0, 0, 0); PG8_LDB(B1, 0, 1); PG8_SCHED; PG8_LDA(At, 0, 0); PG8_STAGE(PG8_SA(1, 1), a1 + hstepA, voffA);
            PG8_WAIT_V(8); PG8_WAIT_L(0); PG8_BAR; PG8_MMA(0, 0, At, B0); PG8_MMA(0, 1, At, B1); PG8_BAR; PG8_SCHED;
            PG8_LDA(At, 0, 1); PG8_STAGE(PG8_SB(0, 0), b2, voffB); PG8_STAGE(PG8_SB(0, 1), b2 + hstepB, voffB); PG8_STAGE(PG8_SA(0, 0), a2, voffA);
            PG8_WAIT_V(8); PG8_WAIT_L(0); PG8_BAR; PG8_MMA(1, 0, At, B0); PG8_MMA(1, 1, At, B1); PG8_BAR; PG8_SCHED;
            PG8_LDB(B0, 1, 0); PG8_LDB(B1, 1, 1); PG8_SCHED; PG8_LDA(At, 1, 0); PG8_STAGE(PG8_SA(0, 1), a2 + hstepA, voffA);
            PG8_WAIT_V(8); PG8_WAIT_L(0); PG8_BAR; PG8_MMA(0, 0, At, B0); PG8_MMA(0, 1, At, B1); PG8_BAR; PG8_SCHED;
            PG8_LDA(At, 1, 1); PG8_STAGE(PG8_SB(1, 0), b3, voffB); PG8_STAGE(PG8_SB(1, 1), b3 + hstepB, voffB); PG8_STAGE(PG8_SA(1, 0), a3, voffA);
            PG8_WAIT_V(8); PG8_WAIT_L(0); PG8_BAR; PG8_MMA(1, 0, At, B0); PG8_MMA(1, 1, At, B1); PG8_BAR; PG8_SCHED;
        }
        if (wr == 0) PG8_BAR;
        E(acc, cur, wr, wc, fr, fq);
        if (!has_next) break;
#pragma unroll
        for (int a = 0; a < 2; ++a)
#pragma unroll
            for (int b = 0; b < 2; ++b)
#pragma unroll
                for (int m = 0; m < 4; ++m)
#pragma unroll
                    for (int n = 0; n < 2; ++n) acc[a][b][m][n] = (f32x4){0.f, 0.f, 0.f, 0.f};
        cur = nxt; cA = nA; cB = nB; ++ui;
        if (wr == 1) PG8_BAR;
    }
    PG8_WAIT_V(0);
    PG8_BAR;
#undef PG8_SA
#undef PG8_SB
#undef PG8_STAGE
#undef PG8_LDA
#undef PG8_LDB
#undef PG8_MMA
#undef PG8_WAIT_V
#undef PG8_WAIT_L
#undef PG8_BAR
#undef PG8_SCHED
}
}

struct EpiSwiglu {
    static constexpr bool PERM = true;
    bf16_t* O;
    __device__ __forceinline__ void operator()(const pg8::Acc& acc, const pg8::Unit& u, int wr, int wc, int fr, int fq) const {
        const int row0 = u.pm * 256 + wr * 64 + fr, col0 = u.pn * 128 + wc * 32 + 8 * fq;
#pragma unroll
        for (int ai = 0; ai < 2; ++ai)
#pragma unroll
            for (int m = 0; m < 4; ++m) {
                f32x4 v[2];
#pragma unroll
                for (int n = 0; n < 2; ++n)
#pragma unroll
                    for (int e = 0; e < 4; ++e) { const float gt = acc[ai][0][m][n][e], up = acc[ai][1][m][n][e]; v[n][e] = gt * fsigmoid(gt) * up; }
                *(u32x4*)(O + (size_t)(row0 + ai * 128 + m * 16) * FF + col0) = pack8(v[0], v[1]);
            }
    }
};
struct EpiResF32 {
    static constexpr bool PERM = false;
    const float* res; float* out; float a, b;
    __device__ __forceinline__ void operator()(const pg8::Acc& acc, const pg8::Unit& u, int wr, int wc, int fr, int fq) const {
        const int row0 = u.pm * 256 + wr * 64 + fr, col0 = u.pn * 256 + wc * 32 + 4 * fq;
#pragma unroll
        for (int ai = 0; ai < 2; ++ai)
#pragma unroll
            for (int m = 0; m < 4; ++m) {
                const size_t off = (size_t)(row0 + ai * 128 + m * 16) * DM + col0;
#pragma unroll
                for (int bj = 0; bj < 2; ++bj)
#pragma unroll
                    for (int n = 0; n < 2; ++n) { const f32x4 r = *(const f32x4*)(res + off + bj * 128 + n * 16); *(f32x4*)(out + off + bj * 128 + n * 16) = r * a + acc[ai][bj][m][n] * b; }
            }
    }
};
struct EpiWin {
    static constexpr bool PERM = true;
    bf16_t* proj; bf16_t* sigg; bf16_t* gn; const float* cs; const float* sn; bf16_t* kslf; bf16_t* vslf; bf16_t* kwnf; bf16_t* vwnf;
    __device__ __forceinline__ void operator()(const pg8::Acc& acc, const pg8::Unit& u, int wr, int wc, int fr, int fq) const {
        const int tile = u.pn, row0 = u.pm * 256 + wr * 64 + fr, cw = wc * 32 + 8 * fq;
        if (tile < 28) {
            const bool rope = (tile == 6) | (tile == 8) | (tile >= 10 && tile < 22);
            const int dcol = (tile < 6 ? tile : tile - 4) * 256;
            if (!rope) {
                if (tile == 7 || tile == 9) {
                    bf16_t* VF = tile == 7 ? vslf : vwnf;
#pragma unroll
                    for (int ai = 0; ai < 2; ++ai)
#pragma unroll
                        for (int m = 0; m < 4; ++m) {
                            const int row = row0 + ai * 128 + m * 16, kp = row & 31;
                            const size_t rbase = (size_t)(row >> 5) * 4096 + (size_t)(((kp >> 2) & 3) * 16) * 8 + 4 * (kp >> 4) + (kp & 3);
#pragma unroll
                            for (int bj = 0; bj < 2; ++bj) {
                                const u32x4 w = pack8(acc[ai][bj][m][0], acc[ai][bj][m][1]);
                                bf16_t* vb = VF + (size_t)bj * 512 * 4096 + rbase + (size_t)(cw >> 4) * 512 + (size_t)(cw & 15) * 8;
                                vb[0] = (bf16_t)(w.x & 0xffffu); vb[8] = (bf16_t)(w.x >> 16); vb[16] = (bf16_t)(w.y & 0xffffu); vb[24] = (bf16_t)(w.y >> 16);
                                vb[32] = (bf16_t)(w.z & 0xffffu); vb[40] = (bf16_t)(w.z >> 16); vb[48] = (bf16_t)(w.w & 0xffffu); vb[56] = (bf16_t)(w.w >> 16);
                            }
                        }
                } else {
#pragma unroll
                    for (int ai = 0; ai < 2; ++ai)
#pragma unroll
                        for (int m = 0; m < 4; ++m)
#pragma unroll
                            for (int bj = 0; bj < 2; ++bj)
                                *(u32x4*)(proj + (size_t)(row0 + ai * 128 + m * 16) * PLD + dcol + bj * 128 + cw) = pack8(acc[ai][bj][m][0], acc[ai][bj][m][1]);
                }
            } else {
                const int head = cw >> 6, d = cw & 63;
                const bool frag = (tile == 6) | (tile == 8);
                bf16_t* KF = tile == 6 ? kslf : kwnf;
#pragma unroll
                for (int ai = 0; ai < 2; ++ai)
#pragma unroll
                    for (int m = 0; m < 4; ++m) {
                        const int row = row0 + ai * 128 + m * 16;
                        f32x4 o1[2], o2[2];
#pragma unroll
                        for (int n = 0; n < 2; ++n) {
                            const f32x4 c = *(const f32x4*)(cs + (size_t)row * 64 + d + 4 * n), sv = *(const f32x4*)(sn + (size_t)row * 64 + d + 4 * n);
                            const f32x4 x1 = acc[ai][0][m][n], x2 = acc[ai][1][m][n];
                            o1[n] = x1 * c - x2 * sv; o2[n] = x2 * c + x1 * sv;
                        }
                        if (frag) {
                            bf16_t* kb = KF + ((size_t)head * 1024 + (row >> 4)) * 2048 + (size_t)(d >> 5) * 512 + (size_t)(((d >> 3) & 3) * 16 + (row & 15)) * 8;
                            *(u32x4*)kb = pack8(o1[0], o1[1]); *(u32x4*)(kb + 1024) = pack8(o2[0], o2[1]);
                        } else {
                            bf16_t* p = proj + (size_t)row * PLD + dcol + head * 128 + d;
                            *(u32x4*)p = pack8(o1[0], o1[1]); *(u32x4*)(p + 64) = pack8(o2[0], o2[1]);
                        }
                    }
            }
        } else if (tile < 44) {
#pragma unroll
            for (int ai = 0; ai < 2; ++ai)
#pragma unroll
                for (int m = 0; m < 4; ++m)
#pragma unroll
                    for (int bj = 0; bj < 2; ++bj) {
                        f32x4 v[2];
#pragma unroll
                        for (int n = 0; n < 2; ++n)
#pragma unroll
                            for (int e = 0; e < 4; ++e) v[n][e] = fsigmoid(acc[ai][bj][m][n][e]);
                        *(u32x4*)(sigg + (size_t)(row0 + ai * 128 + m * 16) * 4096 + (tile - 28) * 256 + bj * 128 + cw) = pack8(v[0], v[1]);
                    }
        } else {
            if (wc == 0) {
#pragma unroll
                for (int ai = 0; ai < 2; ++ai)
#pragma unroll
                    for (int m = 0; m < 4; ++m) {
                        f32x4 v[2];
#pragma unroll
                        for (int n = 0; n < 2; ++n)
#pragma unroll
                            for (int e = 0; e < 4; ++e) v[n][e] = fsigmoid(acc[ai][0][m][n][e]);
                        *(u32x4*)(gn + (size_t)(row0 + ai * 128 + m * 16) * 32 + cw) = pack8(v[0], v[1]);
                    }
            }
        }
    }
};
template <bool FIRST> struct EpiGate {
    static constexpr bool PERM = true;
    const bf16_t* sg; bf16_t* O;
    __device__ __forceinline__ void operator()(const pg8::Acc& acc, const pg8::Unit& u, int wr, int wc, int fr, int fq) const {
        const int row0 = u.pm * 256 + wr * 64 + fr, col0 = u.pn * 256 + wc * 32 + 8 * fq;
#pragma unroll
        for (int ai = 0; ai < 2; ++ai)
#pragma unroll
            for (int m = 0; m < 4; ++m)
#pragma unroll
                for (int bj = 0; bj < 2; ++bj) {
                    const int row = row0 + ai * 128 + m * 16, col = col0 + bj * 128;
                    const u32x4 gv = *(const u32x4*)(sg + (size_t)row * 4096 + col);
                    u32x4 pv = (u32x4){0u, 0u, 0u, 0u}; if (!FIRST) pv = *(const u32x4*)(O + (size_t)row * DM + col);
                    f32x4 v[2];
#pragma unroll
                    for (int n = 0; n < 2; ++n) {
                        const unsigned g0 = n ? gv.z : gv.x, g1 = n ? gv.w : gv.y, p0 = n ? pv.z : pv.x, p1 = n ? pv.w : pv.y;
                        const f32x4 y = acc[ai][bj][m][n];
                        v[n][0] = bflo(p0) + bflo(g0) * y[0]; v[n][1] = bfhi(p0) + bfhi(g0) * y[1];
                        v[n][2] = bflo(p1) + bflo(g1) * y[2]; v[n][3] = bfhi(p1) + bfhi(g1) * y[3];
                    }
                    *(u32x4*)(O + (size_t)row * DM + col) = pack8(v[0], v[1]);
                }
    }
};

__device__ __forceinline__ void tr_item(const float* W, int ldw, int k0, int scol0, int nvalid, bf16_t* WT, int ldt, int drow0, int dk0, LAS float* scr, int lane) {
    const int c = lane & 31;
    float v[32];
#pragma unroll
    for (int i = 0; i < 32; ++i) { const int kk = 2 * i + (lane >> 5); v[i] = (c < nvalid) ? W[(size_t)(k0 + kk) * ldw + scol0 + c] : 0.f; }
#pragma unroll
    for (int i = 0; i < 32; ++i) { const int kk = 2 * i + (lane >> 5); scr[kk * 33 + c] = v[i]; }
    asm volatile("s_waitcnt lgkmcnt(0)" ::: "memory");
    const int c8 = lane & 7;
#pragma unroll
    for (int j = 0; j < 4; ++j) { const int n = (lane >> 3) + 8 * j; const LAS float* s = scr + (8 * c8) * 33 + n;
        u32x4 o; o.x = cvt_pk_bf16(s[0 * 33], s[1 * 33]); o.y = cvt_pk_bf16(s[2 * 33], s[3 * 33]); o.z = cvt_pk_bf16(s[4 * 33], s[5 * 33]); o.w = cvt_pk_bf16(s[6 * 33], s[7 * 33]);
        *(u32x4*)(WT + (size_t)(drow0 + n) * ldt + dk0 + 8 * c8) = o; }
    asm volatile("s_waitcnt lgkmcnt(0)" ::: "memory");
}
__device__ __forceinline__ int win_src_col(int r) {
    if (r >= WIN_SRC) return -1;
    if (r >= 11264) return 2560 + (r - 11264);
    const int tile = r >> 8; int j = r & 255;
    const bool rope = (tile == 6) | (tile == 8) | (tile >= 10 && tile < 22);
    if (rope) { const int q = j >> 6, d = j & 63; j = (q & 1) * 128 + (q >> 1) * 64 + d; }
    const int c = tile * 256 + j;
    return c < 2560 ? c : c + 24;
}
__device__ __forceinline__ void conv_ffn(const float* Wg, const float* Wu, const float* Wd, bf16_t* GU, bf16_t* DN, LAS float* scr, int gw, int ngw, int lane) {
    constexpr int I_G = 32 * 176;
    for (int it = gw; it < 2 * I_G; it += ngw) { const int which = it / I_G, r = it % I_G, kb = r / 176, nb = r % 176, c0 = nb * 32;
        tr_item(which ? Wu : Wg, FF, kb * 64, c0, 32, GU, DM, 256 * (c0 >> 7) + (c0 & 127) + which * 128, kb * 64, scr, lane); }
    for (int it = gw; it < 88 * 64; it += ngw) { const int kb = it / 64, nb = it % 64; tr_item(Wd, DM, kb * 64, nb * 32, 32, DN, FF, nb * 32, kb * 64, scr, lane); }
}
__device__ __forceinline__ void ln_rows(const float* in, float* outf, bf16_t* outb, const float* g, const float* b, int gw, int ngw, int lane) {
    f32x4 gv[8], bv[8];
#pragma unroll
    for (int j = 0; j < 8; ++j) { gv[j] = *(const f32x4*)(g + 4 * (lane + 64 * j)); bv[j] = *(const f32x4*)(b + 4 * (lane + 64 * j)); }
    for (int row = gw; row < S; row += ngw) {
        const float* xr = in + (size_t)row * DM; f32x4 v[8]; float s = 0.f;
#pragma unroll
        for (int j = 0; j < 8; ++j) { v[j] = *(const f32x4*)(xr + 4 * (lane + 64 * j)); s += (v[j][0] + v[j][1]) + (v[j][2] + v[j][3]); }
        const float mean = wave_sum(s) * (1.f / DM); float s2 = 0.f;
#pragma unroll
        for (int j = 0; j < 8; ++j) { v[j] = v[j] - mean; s2 += (v[j][0] * v[j][0] + v[j][1] * v[j][1]) + (v[j][2] * v[j][2] + v[j][3] * v[j][3]); }
        const float rstd = 1.f / sqrtf(wave_sum(s2) * (1.f / DM) + LN_EPS);
#pragma unroll
        for (int j = 0; j < 8; ++j) { const f32x4 o = v[j] * rstd * gv[j] + bv[j];
            *(f32x4*)(outf + (size_t)row * DM + 4 * (lane + 64 * j)) = o;
            if (outb) { u32x2 w; w.x = cvt_pk_bf16(o[0], o[1]); w.y = cvt_pk_bf16(o[2], o[3]); *(u32x2*)(outb + (size_t)row * DM + 4 * (lane + 64 * j)) = w; } }
    }
}

struct AState { float m, l; f32x4 o[8]; };
__device__ __forceinline__ void astate_init(AState& s) { s.m = -1e30f; s.l = 0.f;
#pragma unroll
    for (int i = 0; i < 8; ++i) s.o[i] = (f32x4){0.f, 0.f, 0.f, 0.f}; }
__device__ __forceinline__ int clampi(int v, int lo, int hi) { return v < lo ? lo : (v > hi ? hi : v); }

__device__ __forceinline__ void load_k(bf16x8 (&kf)[2][4], const bf16_t* __restrict__ Kb, int ld, int pos0, int dpos, int posmax, int l16, int kq) {
#pragma unroll
    for (int T = 0; T < 2; ++T) { const int p = clampi(pos0 + dpos * (16 * T + l16), 0, posmax); const bf16_t* kp = Kb + (size_t)p * ld + 8 * kq;
#pragma unroll
        for (int s = 0; s < 4; ++s) kf[T][s] = *(const bf16x8*)(kp + 32 * s); }
}
__device__ __forceinline__ void load_v(u32x4 (&vr)[8], const bf16_t* __restrict__ Vb, int ld, int pos0, int dpos, int posmax, int l16, int kq) {
#pragma unroll
    for (int i = 0; i < 8; ++i) { const int p = clampi(pos0 + dpos * (4 * i + kq), 0, posmax); vr[i] = *(const u32x4*)(Vb + (size_t)p * ld + 8 * l16); }
}
__device__ __forceinline__ void store_v(const u32x4 (&vr)[8], LAS unsigned char* vbuf, int l16, int kq) {
#pragma unroll
    for (int i = 0; i < 8; ++i) *(LAS u32x4*)(vbuf + (4 * i + kq) * VROW + 16 * l16) = vr[i];
}
template <int MODE, bool SLC, class Desc>
__device__ __forceinline__ void attn_run(const bf16x8 (&qf)[4], const bf16_t* __restrict__ Kb, const bf16_t* __restrict__ Vb, int ld, int dpos, int posmax,
                                         const Desc& desc, int n, int lo_in, int hi, int qi, AState& st, LAS unsigned char* vbuf, int lane, LAS float* imp = nullptr) {
    if (n <= 0) return;
    const int l16 = lane & 15, kq = lane >> 4;
    u32x4 kr[8];
    int dcur = desc(0);
    load_v(kr, Kb, ld, SLC ? (dcur & 0xfffff) : dcur, dpos, posmax, l16, kq);
#pragma unroll 1
    for (int i = 0; i < n; ++i) {
        const int pos0 = SLC ? (dcur & 0xfffff) : dcur;
        const int lo = SLC ? ((((dcur >> 20) == qi) | ((dcur >> 20) == 4)) ? 0 : (1 << 30)) : lo_in;
        store_v(kr, vbuf, l16, kq);
        u32x4 vr[8];
        if (MODE != 1) load_v(vr, Vb, ld, pos0, dpos, posmax, l16, kq);
        bf16x8 kf[2][4];
#pragma unroll
        for (int T = 0; T < 2; ++T)
#pragma unroll
            for (int s = 0; s < 4; ++s) kf[T][s] = *(const LAS bf16x8*)(vbuf + (16 * T + l16) * VROW + 64 * s + 16 * kq);
        f32x4 sa[2] = {(f32x4){0.f, 0.f, 0.f, 0.f}, (f32x4){0.f, 0.f, 0.f, 0.f}};
#pragma unroll
        for (int T = 0; T < 2; ++T)
#pragma unroll
            for (int s = 0; s < 4; ++s) sa[T] = __builtin_amdgcn_mfma_f32_16x16x32_bf16(kf[T][s], qf[s], sa[T], 0, 0, 0);
        const int dnext = desc(i + 1 < n ? i + 1 : i);
        load_v(kr, Kb, ld, SLC ? (dnext & 0xfffff) : dnext, dpos, posmax, l16, kq);
        float sc[8]; bool vd[8]; float mx = -1e30f;
#pragma unroll
        for (int T = 0; T < 2; ++T)
#pragma unroll
            for (int r = 0; r < 4; ++r) { const int p = pos0 + dpos * (16 * T + 4 * kq + r); const bool v = (p >= lo) & (p <= hi); const float x = sa[T][r] * SL2;
                sc[4 * T + r] = x; vd[4 * T + r] = v; mx = v ? fmaxf(mx, x) : mx; }
        float p[8];
        if (MODE == 2) {
#pragma unroll
            for (int j = 0; j < 8; ++j) p[j] = vd[j] ? __builtin_amdgcn_exp2f(sc[j] - st.m) * st.l : 0.f;
#pragma unroll
            for (int T = 0; T < 2; ++T) {
                float x = 2.f * (p[4 * T] + p[4 * T + 1] + p[4 * T + 2]) + p[4 * T + 3], y = p[4 * T + 3];
                x += __shfl_xor(x, 1); x += __shfl_xor(x, 2); y += __shfl_xor(y, 1); y += __shfl_xor(y, 2);
                if ((l16 & 3) == 0) { const int a = (pos0 >> 2) + 4 * T + kq; LAS float* ip = imp + (l16 >> 2) * IMP_LD + a;
                    ip[0] += x;
                    asm volatile("s_waitcnt lgkmcnt(0)" ::: "memory");
                    ip[1] += y; }
                asm volatile("s_waitcnt lgkmcnt(0)" ::: "memory");
            }
        } else {
            if (__builtin_amdgcn_ballot_w64(mx > st.m + 40.f) != 0ull) {
                mx = fmaxf(mx, __shfl_xor(mx, 16)); mx = fmaxf(mx, __shfl_xor(mx, 32));
                const float mn = fmaxf(st.m, mx), alpha = __builtin_amdgcn_exp2f(st.m - mn); st.m = mn; st.l *= alpha;
                if (MODE == 0) {
#pragma unroll
                    for (int j = 0; j < 8; ++j) st.o[j] = st.o[j] * alpha;
                }
            }
            float ps = 0.f;
#pragma unroll
            for (int j = 0; j < 8; ++j) { p[j] = vd[j] ? __builtin_amdgcn_exp2f(sc[j] - st.m) : 0.f; ps += p[j]; }
            st.l += ps;
        }
        if (MODE != 1) {
            store_v(vr, vbuf, l16, kq);
            u32x4 pw; pw.x = cvt_pk_bf16(p[0], p[1]); pw.y = cvt_pk_bf16(p[2], p[3]); pw.z = cvt_pk_bf16(p[4], p[5]); pw.w = cvt_pk_bf16(p[6], p[7]);
            const bf16x8 pf = __builtin_bit_cast(bf16x8, pw);
            const unsigned addr = (unsigned)(uintptr_t)(vbuf) + (4 * kq + (l16 >> 2)) * VROW + (l16 & 3) * 8;
#pragma unroll
            for (int hf = 0; hf < 2; ++hf) {
                s16x4 a[8];
                asm volatile("s_waitcnt lgkmcnt(0)\n\t"
                             "ds_read_b64_tr_b16 %0, %8 offset:0\n\t"    "ds_read_b64_tr_b16 %1, %8 offset:32\n\t"
                             "ds_read_b64_tr_b16 %2, %8 offset:64\n\t"   "ds_read_b64_tr_b16 %3, %8 offset:96\n\t"
                             "ds_read_b64_tr_b16 %4, %8 offset:4608\n\t" "ds_read_b64_tr_b16 %5, %8 offset:4640\n\t"
                             "ds_read_b64_tr_b16 %6, %8 offset:4672\n\t" "ds_read_b64_tr_b16 %7, %8 offset:4704\n\t"
                             "s_waitcnt lgkmcnt(0)"
                             : "=&v"(a[0]), "=&v"(a[1]), "=&v"(a[2]), "=&v"(a[3]), "=&v"(a[4]), "=&v"(a[5]), "=&v"(a[6]), "=&v"(a[7])
                             : "v"(addr + 128 * hf) : "memory");
#pragma unroll
                for (int d4 = 0; d4 < 4; ++d4) { const int db = 4 * hf + d4;
                    bf16x8 af; af[0] = a[d4][0]; af[1] = a[d4][1]; af[2] = a[d4][2]; af[3] = a[d4][3]; af[4] = a[d4 + 4][0]; af[5] = a[d4 + 4][1]; af[6] = a[d4 + 4][2]; af[7] = a[d4 + 4][3];
                    st.o[db] = __builtin_amdgcn_mfma_f32_16x16x32_bf16(af, pf, st.o[db], 0, 0, 0); }
            }
        }
        dcur = dnext;
    }
}
template <bool SLC, class Desc>
__device__ __forceinline__ void attn_run_frag(const bf16x8 (&qf)[4], const bf16_t* __restrict__ KF, const bf16_t* __restrict__ VF, const Desc& desc, int n,
                                              int lo_in, int hi, int qi, AState& st, int lane) {
    if (n <= 0) return;
    const int kq = lane >> 4;
    bf16x8 kf[2][4];
    int dcur = desc(0);
    { const int pos0 = SLC ? (dcur & 0xfffff) : dcur; const bf16_t* kp = KF + ((size_t)(pos0 >> 4) * 256 + lane) * 8;
#pragma unroll
      for (int T = 0; T < 2; ++T)
#pragma unroll
          for (int s2 = 0; s2 < 4; ++s2) kf[T][s2] = *(const bf16x8*)(kp + (T * 4 + s2) * 512); }
#pragma unroll 1
    for (int i = 0; i < n; ++i) {
        const int pos0 = SLC ? (dcur & 0xfffff) : dcur;
        const int lo = SLC ? ((((dcur >> 20) == qi) | ((dcur >> 20) == 4)) ? 0 : (1 << 30)) : lo_in;
        bf16x8 vf[8];
        { const bf16_t* vp = VF + ((size_t)(pos0 >> 5) * 512 + lane) * 8;
#pragma unroll
          for (int db = 0; db < 8; ++db) vf[db] = *(const bf16x8*)(vp + db * 512); }
        f32x4 sa[2] = {(f32x4){0.f, 0.f, 0.f, 0.f}, (f32x4){0.f, 0.f, 0.f, 0.f}};
#pragma unroll
        for (int T = 0; T < 2; ++T)
#pragma unroll
            for (int s2 = 0; s2 < 4; ++s2) sa[T] = __builtin_amdgcn_mfma_f32_16x16x32_bf16(kf[T][s2], qf[s2], sa[T], 0, 0, 0);
        const int dnext = desc(i + 1 < n ? i + 1 : i);
        { const int pn = SLC ? (dnext & 0xfffff) : dnext; const bf16_t* kp = KF + ((size_t)(pn >> 4) * 256 + lane) * 8;
#pragma unroll
          for (int T = 0; T < 2; ++T)
#pragma unroll
              for (int s2 = 0; s2 < 4; ++s2) kf[T][s2] = *(const bf16x8*)(kp + (T * 4 + s2) * 512); }
        float sc[8]; bool vd[8]; float mx = -1e30f;
#pragma unroll
        for (int T = 0; T < 2; ++T)
#pragma unroll
            for (int r = 0; r < 4; ++r) { const int p = pos0 + 16 * T + 4 * kq + r; const bool v = (p >= lo) & (p <= hi); const float x = sa[T][r] * SL2;
                sc[4 * T + r] = x; vd[4 * T + r] = v; mx = v ? fmaxf(mx, x) : mx; }
        if (__builtin_amdgcn_ballot_w64(mx > st.m + 40.f) != 0ull) {
            mx = fmaxf(mx, __shfl_xor(mx, 16)); mx = fmaxf(mx, __shfl_xor(mx, 32));
            const float mn = fmaxf(st.m, mx), alpha = __builtin_amdgcn_exp2f(st.m - mn); st.m = mn; st.l *= alpha;
#pragma unroll
            for (int j = 0; j < 8; ++j) st.o[j] = st.o[j] * alpha;
        }
        float p[8], ps = 0.f;
#pragma unroll
        for (int j = 0; j < 8; ++j) { p[j] = vd[j] ? __builtin_amdgcn_exp2f(sc[j] - st.m) : 0.f; ps += p[j]; }
        st.l += ps;
        u32x4 pw; pw.x = cvt_pk_bf16(p[0], p[1]); pw.y = cvt_pk_bf16(p[2], p[3]); pw.z = cvt_pk_bf16(p[4], p[5]); pw.w = cvt_pk_bf16(p[6], p[7]);
        const bf16x8 pf = __builtin_bit_cast(bf16x8, pw);
#pragma unroll
        for (int db = 0; db < 8; ++db) st.o[db] = __builtin_amdgcn_mfma_f32_16x16x32_bf16(vf[db], pf, st.o[db], 0, 0, 0);
        dcur = dnext;
    }
}
__device__ __forceinline__ float quad_total(float v) { v += __shfl_xor(v, 16); v += __shfl_xor(v, 32); return v; }

__device__ __forceinline__ void dilated_unit(int unit, const bf16_t* proj, bf16_t* nsaout, LAS unsigned char* vbuf, int lane) {
    const int l16 = lane & 15, kq = lane >> 4;
    const int hg = unit & 3, r16 = (unit >> 2) & 15, ut = unit >> 6;
    const int t0 = r16 + 256 * ut, tc = t0 + 16 * l16;
    AState st; astate_init(st);
#pragma unroll 1
    for (int pt = 0; pt < 3; ++pt) {
        const int d = pt == 0 ? 1 : (pt == 1 ? 4 : 16), head = 4 * pt + hg;
        const bf16_t* qrow = proj + (size_t)tc * PLD + PC_QB + head * 128 + 8 * kq;
        bf16x8 qf[4];
#pragma unroll
        for (int s = 0; s < 4; ++s) qf[s] = *(const bf16x8*)(qrow + 32 * s);
        const int nk = 129 + 240 / d, nsteps = (nk + 31) >> 5;
        const int lo = tc - 128 * d < 0 ? 0 : tc - 128 * d, hi = tc;
        const int base = t0 - 128 * d;
        const int i0 = base < 0 ? (-base + d - 1) / (32 * d) : 0;
        auto desc = [&](int i) { return base + 32 * d * (i0 + i); };
        attn_run<0, false>(qf, proj + PC_KB + head * 128, proj + PC_VB + head * 128, PLD, d, S - 1, desc, nsteps - i0, lo, hi, 0, st, vbuf, lane);
    }
    const float lt = quad_total(st.l), inv = lt > 0.f ? 1.f / lt : 0.f;
    bf16_t* op = nsaout + (size_t)tc * NOLD + 1024 + hg * 128 + 4 * kq;
#pragma unroll
    for (int db = 0; db < 8; ++db) { const f32x4 o = st.o[db] * inv; u32x2 w; w.x = cvt_pk_bf16(o[0], o[1]); w.y = cvt_pk_bf16(o[2], o[3]); *(u32x2*)(op + 16 * db) = w; }
}

__device__ __forceinline__ void compress_unit(int unit, const bf16_t* proj, const bf16_t* w1t, const bf16_t* w2t, const float* bias, bf16_t* outc, LAS unsigned char* scr, int lane) {
    const int l16 = lane & 15, kq = lane >> 4;
    const int rt = unit & 63, g = (unit >> 6) & 1, kv = unit >> 7;
    const bf16_t* raw = proj + (kv ? PC_VC : PC_KC) + 128 * g;
    const int n = 16 * rt + l16;
    f32x4 acc[16];
#pragma unroll
    for (int i = 0; i < 16; ++i) acc[i] = (f32x4){0.f, 0.f, 0.f, 0.f};
#pragma unroll 2
    for (int s = 0; s < 128; ++s) {
        const int tok = clampi(16 * n + (s >> 2), 0, S - 1);
        const bf16x8 af = *(const bf16x8*)(raw + (size_t)tok * PLD + (s & 3) * 32 + 8 * kq);
#pragma unroll
        for (int ct = 0; ct < 16; ++ct) { const bf16x8 bfr = *(const bf16x8*)(w1t + (size_t)(16 * ct + l16) * 4096 + 32 * s + 8 * kq);
            acc[ct] = __builtin_amdgcn_mfma_f32_16x16x32_bf16(af, bfr, acc[ct], 0, 0, 0); }
    }
#pragma unroll
    for (int ct = 0; ct < 16; ++ct) { const float bb = bias[16 * ct + l16];
#pragma unroll
        for (int r = 0; r < 4; ++r) { const float x = acc[ct][r] + bb; const float u2 = 1.5957691216f * (x + 0.044715f * x * x * x); const float gl = x * fsigmoid(u2);
            *(LAS bf16_t*)(scr + (4 * kq + r) * 528 + (16 * ct + l16) * 2) = (bf16_t)(cvt_pk_bf16(gl, 0.f) & 0xffffu); } }
    asm volatile("s_waitcnt lgkmcnt(0)" ::: "memory");
    f32x4 o2[8];
#pragma unroll
    for (int i = 0; i < 8; ++i) o2[i] = (f32x4){0.f, 0.f, 0.f, 0.f};
#pragma unroll
    for (int s = 0; s < 8; ++s) {
        const bf16x8 af = *(const LAS bf16x8*)(scr + l16 * 528 + (32 * s + 8 * kq) * 2);
#pragma unroll
        for (int dt = 0; dt < 8; ++dt) { const bf16x8 bfr = *(const bf16x8*)(w2t + (size_t)(16 * dt + l16) * 256 + 32 * s + 8 * kq);
            o2[dt] = __builtin_amdgcn_mfma_f32_16x16x32_bf16(af, bfr, o2[dt], 0, 0, 0); }
    }
    asm volatile("s_waitcnt lgkmcnt(0)" ::: "memory");
#pragma unroll
    for (int dt = 0; dt < 8; ++dt)
#pragma unroll
        for (int r = 0; r < 4; ++r) { const int nn = 16 * rt + 4 * kq + r; if (nn < 1023) outc[((size_t)g * 1024 + nn) * 128 + 16 * dt + l16] = (bf16_t)(cvt_pk_bf16(o2[dt][r], 0.f) & 0xffffu); }
}

__device__ __forceinline__ void nsa_unit(int unit, const bf16_t* proj, const bf16_t* kc, const bf16_t* vc, const bf16_t* gn, const float* cs, const float* sn,
                                         const bf16_t* kslf, const bf16_t* vslf, const bf16_t* kwnf, const bf16_t* vwnf, bf16_t* nsaout, LAS unsigned char* wl, int lane) {
    const int l16 = lane & 15, kq = lane >> 4;
    const int g = unit & 1, tb = unit >> 1, t0 = 4 * tb, qi = l16 >> 2, h = l16 & 3, tc = t0 + qi, head = 4 * g + h;
    LAS unsigned char* vbuf = wl; LAS float* imp = (LAS float*)(wl + VBUF_BYTES); LAS int* sel = (LAS int*)(wl + VBUF_BYTES + 4 * IMP_LD * 4);
    bf16x8 qf[4];
    { const bf16_t* qrow = proj + (size_t)tc * PLD + PC_QA + head * 128 + 8 * kq;
#pragma unroll
        for (int s = 0; s < 4; ++s) qf[s] = *(const bf16x8*)(qrow + 32 * s); }
    LAS u32x2* outl = (LAS u32x2*)(wl + OUT_OFF) + lane;
    for (int i = lane; i < 4 * IMP_LD; i += 64) imp[i] = 0.f;
    const int hic = (tc - 31) >> 4;
    const int nkmax = ((t0 + 3 - 31) >> 4) + 1, nsc = nkmax > 0 ? (nkmax + 31) >> 5 : 0;
    const bf16_t* kcg = kc + (size_t)g * 1024 * 128; const bf16_t* vcg = vc + (size_t)g * 1024 * 128;
    AState st; astate_init(st);
    { auto desc = [&](int i) { return 32 * i; };
      attn_run<1, false>(qf, kcg, vcg, 128, 1, 1022, desc, nsc, 0, hic, 0, st, vbuf, lane);
      { const float lt = quad_total(st.l); st.l = lt > 0.f ? 1.f / lt : 0.f; }
      asm volatile("s_waitcnt lgkmcnt(0)" ::: "memory");
      attn_run<2, false>(qf, kcg, vcg, 128, 1, 1022, desc, nsc, 0, hic, 0, st, vbuf, lane, imp); }
    const float g0 = bf2f(gn[(size_t)tc * 32 + head * 3 + 0]);
#pragma unroll
    for (int i = 0; i < 8; ++i) { const f32x4 o = st.o[i] * g0; u32x2 w; w.x = cvt_pk_bf16(o[0], o[1]); w.y = cvt_pk_bf16(o[2], o[3]); outl[64 * i] = w; }
    asm volatile("s_waitcnt lgkmcnt(0)" ::: "memory");
#pragma unroll
    for (int s2 = 0; s2 < 2; ++s2) {
        const int d = 32 * s2 + 8 * kq; f32x4 c[2], sv[2];
        c[0] = *(const f32x4*)(cs + (size_t)tc * 64 + d); c[1] = *(const f32x4*)(cs + (size_t)tc * 64 + d + 4);
        sv[0] = *(const f32x4*)(sn + (size_t)tc * 64 + d); sv[1] = *(const f32x4*)(sn + (size_t)tc * 64 + d + 4);
        float o1[8], o2[8];
#pragma unroll
        for (int j = 0; j < 8; ++j) { const float x1 = bf2f((unsigned short)qf[s2][j]), x2 = bf2f((unsigned short)qf[s2 + 2][j]), cc = c[j >> 2][j & 3], ss = sv[j >> 2][j & 3];
            o1[j] = x1 * cc - x2 * ss; o2[j] = x2 * cc + x1 * ss; }
        u32x4 w1, w2; w1.x = cvt_pk_bf16(o1[0], o1[1]); w1.y = cvt_pk_bf16(o1[2], o1[3]); w1.z = cvt_pk_bf16(o1[4], o1[5]); w1.w = cvt_pk_bf16(o1[6], o1[7]);
        w2.x = cvt_pk_bf16(o2[0], o2[1]); w2.y = cvt_pk_bf16(o2[2], o2[3]); w2.z = cvt_pk_bf16(o2[4], o2[5]); w2.w = cvt_pk_bf16(o2[6], o2[7]);
        qf[s2] = __builtin_bit_cast(bf16x8, w1); qf[s2 + 2] = __builtin_bit_cast(bf16x8, w2);
    }
    unsigned key[4][4];
#pragma unroll
    for (int q = 0; q < 4; ++q) { const int cur = (t0 + q) >> 6; const f32x4 v = *(const LAS f32x4*)(imp + q * IMP_LD + 4 * lane);
#pragma unroll
        for (int i = 0; i < 4; ++i) { const int j = 4 * lane + i; const bool valid = j <= cur, forced = (j == 0) | (j == cur) | (j == cur - 1);
            const unsigned kb = forced ? 0xffffffu : ((__float_as_uint(fmaxf(v[i], 0.f)) >> 8) + 1u);
            key[q][i] = valid ? ((kb << 8) | (unsigned)(255 - j)) : 0u; } }
#pragma unroll 1
    for (int r = 0; r < 16; ++r) {
        unsigned mx[4];
#pragma unroll
        for (int q = 0; q < 4; ++q) { unsigned a = key[q][0] > key[q][1] ? key[q][0] : key[q][1], b = key[q][2] > key[q][3] ? key[q][2] : key[q][3]; mx[q] = a > b ? a : b; }
#pragma unroll
        for (int o = 1; o < 64; o <<= 1)
#pragma unroll
            for (int q = 0; q < 4; ++q) { const unsigned other = (unsigned)__shfl_xor((int)mx[q], o); mx[q] = other > mx[q] ? other : mx[q]; }
#pragma unroll
        for (int q = 0; q < 4; ++q) {
#pragma unroll
            for (int i = 0; i < 4; ++i) if (key[q][i] == mx[q]) key[q][i] = 0u;
            if (lane == 0) sel[q * 16 + r] = mx[q] ? (int)(255u - (mx[q] & 255u)) : -1;
        }
    }
    asm volatile("s_waitcnt lgkmcnt(0)" ::: "memory");
    LAS int* list = (LAS int*)(wl + VBUF_BYTES + 4 * IMP_LD * 4 + 256);
    int nslc;
    { const int b = sel[lane], q = lane >> 4, cur0 = t0 >> 6;
      const bool forced = (b == 0) | (b == cur0) | (b == cur0 - 1);
      const bool valid = (b >= 0) & !(forced & (q > 0)); const unsigned long long mask = __ballot(valid);
      const int idx = __popcll(mask & ((1ull << lane) - 1ull)); nslc = 2 * __popcll(mask);
      if (valid) { const int qc = forced ? 4 : q; list[2 * idx] = (64 * b) | (qc << 20); list[2 * idx + 1] = (64 * b + 32) | (qc << 20); } }
    asm volatile("s_waitcnt lgkmcnt(0)" ::: "memory");
    astate_init(st);
    { auto desc = [&](int i) { return __builtin_amdgcn_readfirstlane(list[i]); };
      unsigned long long goff = (unsigned long long)g * S * 128; asm volatile("" : "+s"(goff));
      attn_run_frag<true>(qf, kslf + goff, vslf + goff, desc, nslc, 0, tc, qi, st, lane); }
    { const float g1 = bf2f(gn[(size_t)tc * 32 + head * 3 + 1]); const float lt = quad_total(st.l), inv = (lt > 0.f ? 1.f / lt : 0.f) * g1;
#pragma unroll
        for (int i = 0; i < 8; ++i) { const f32x4 o = st.o[i] * inv; u32x2 w = outl[64 * i]; w.x = cvt_pk_bf16(bflo(w.x) + o[0], bfhi(w.x) + o[1]); w.y = cvt_pk_bf16(bflo(w.y) + o[2], bfhi(w.y) + o[3]); outl[64 * i] = w; } }
    astate_init(st);
    { const int lo = tc - 511 < 0 ? 0 : tc - 511; const int first = t0 < 511 ? 0 : (t0 - 511) >> 5, last = (t0 + 3) >> 5;
      auto desc = [&](int i) { return 32 * (first + i); };
      unsigned long long goff = (unsigned long long)g * S * 128; asm volatile("" : "+s"(goff));
      attn_run_frag<false>(qf, kwnf + goff, vwnf + goff, desc, last - first + 1, lo, tc, 0, st, lane); }
    { const float g2 = bf2f(gn[(size_t)tc * 32 + head * 3 + 2]); const float lt = quad_total(st.l), inv = (lt > 0.f ? 1.f / lt : 0.f) * g2;
#pragma unroll
        for (int i = 0; i < 8; ++i) { const f32x4 o = st.o[i] * inv; u32x2 w = outl[64 * i]; w.x = cvt_pk_bf16(bflo(w.x) + o[0], bfhi(w.x) + o[1]); w.y = cvt_pk_bf16(bflo(w.y) + o[2], bfhi(w.y) + o[3]); outl[64 * i] = w; } }
    bf16_t* op = nsaout + (size_t)tc * NOLD + head * 128 + 4 * kq;
#pragma unroll
    for (int db = 0; db < 8; ++db) *(u32x2*)(op + 16 * db) = outl[64 * db];
}


#define XB_TMO      128
#define XB_XCNT(j)  (256  + 64 * (j))
#define XB_XSUB(j)  (1280 + 64 * (j))
#define XB_XGEN(j)  (2304 + 64 * (j))
#define XB_TOP      3328
#define XB_TOPGEN   3392
#define XCD_BAR_WORDS 3456
#define XB_SPIN_CAP (1u << 18)
__device__ __forceinline__ unsigned xb_ld(unsigned* p)              { return __hip_atomic_load(p, __ATOMIC_RELAXED, __HIP_MEMORY_SCOPE_AGENT); }
__device__ __forceinline__ unsigned xb_add(unsigned* p, unsigned v) { return __hip_atomic_fetch_add(p, v, __ATOMIC_RELAXED, __HIP_MEMORY_SCOPE_AGENT); }
__device__ __forceinline__ unsigned xb_xcc_id() { return (unsigned)__builtin_amdgcn_s_getreg((3 << 11) | 20) & 0xFu; }
#define XB_SPIN(cond, bar) do { unsigned _sp = 0; while (cond) { __builtin_amdgcn_s_sleep(1); \
    if ((++_sp & 255u) == 0u) { if (xb_ld(&(bar)[XB_TMO])) break; if (_sp > XB_SPIN_CAP) { atomicAdd(&(bar)[XB_TMO], 1u); break; } } } } while (0)
struct XcdBarrier { unsigned* bar; unsigned x; volatile LAS unsigned* st; };
__device__ __forceinline__ XcdBarrier xcd_barrier_post(unsigned* bar, volatile LAS unsigned* st) {
    XcdBarrier b; b.bar = bar; b.x = xb_xcc_id(); b.st = st;
    if (threadIdx.x == 0) (void)xb_add(&bar[XB_XCNT(b.x)], 1u);
    return b;
}
__device__ __forceinline__ void xcd_barrier_complete(unsigned* bar, unsigned x, unsigned& nloc, unsigned& nx) {
    const unsigned G = gridDim.x * gridDim.y * gridDim.z;
    unsigned sum, cnt, mine, sp = 0u;
    for (;;) {
        sum = 0u; cnt = 0u; mine = 0u;
#pragma unroll
        for (unsigned j = 0; j < 16; ++j) { const unsigned c = xb_ld(&bar[XB_XCNT(j)]); sum += c; cnt += (c > 0u) ? 1u : 0u; mine = (j == x) ? c : mine; }
        if (sum == G) break;
        __builtin_amdgcn_s_sleep(1);
        if ((++sp & 255u) == 0u) { if (xb_ld(&bar[XB_TMO])) break; if (sp > XB_SPIN_CAP) { atomicAdd(&bar[XB_TMO], 1u); break; } }
    }
    nloc = mine > 0u ? mine : 1u; nx = cnt > 0u ? cnt : 1u;
}
__device__ __forceinline__ void xcd_barrier(const XcdBarrier& b) {
    asm volatile("s_waitcnt vmcnt(0)" ::: "memory");
    __syncthreads();
    if (threadIdx.x == 0) {
        unsigned* bar = b.bar;
        __builtin_amdgcn_s_waitcnt(0);
        unsigned nloc = b.st[0], nx = b.st[1];
        if (nloc == 0u) { xcd_barrier_complete(bar, b.x, nloc, nx); b.st[0] = nloc; b.st[1] = nx; }
        const unsigned old = xb_add(&bar[XB_XSUB(b.x)], 1u);
        const unsigned gen = old / nloc;
        if (old + 1u == (gen + 1u) * nloc) {
            __builtin_amdgcn_fence(__ATOMIC_RELEASE, "agent");
            asm volatile("s_waitcnt vmcnt(0)" ::: "memory");
            const unsigned og = xb_add(&bar[XB_TOP], 1u);
            const unsigned tg = og / nx;
            if (og + 1u == (tg + 1u) * nx) xb_add(&bar[XB_TOPGEN], 1u);
            else XB_SPIN(xb_ld(&bar[XB_TOPGEN]) == tg, bar);
            __builtin_amdgcn_fence(__ATOMIC_ACQUIRE, "agent");
            xb_add(&bar[XB_XGEN(b.x)], 1u);
            asm volatile("s_waitcnt vmcnt(0)" ::: "memory");
        } else {
            XB_SPIN(xb_ld(&bar[XB_XGEN(b.x)]) == gen, bar);
            __builtin_amdgcn_fence(__ATOMIC_ACQUIRE, "agent");
            asm volatile("s_waitcnt vmcnt(0)" ::: "memory");
        }
    }
    __syncthreads();
}

struct Params { const float* in[23]; float* out; unsigned char* ws; float inv_freq[64]; };

__global__ void __launch_bounds__(512, 2) fwd_megakernel(Params P) {
    extern __shared__ __attribute__((aligned(16))) unsigned char lds_raw[];
    LAS unsigned char* lds = (LAS unsigned char*)lds_raw;
    cg::grid_group grid = cg::this_grid();
#define PHASE_WS unsigned long long wsv_ = (unsigned long long)P.ws; asm volatile("" : "+s"(wsv_)); unsigned char* ws = (unsigned char*)(__attribute__((address_space(1))) unsigned char*)wsv_; int tid = threadIdx.x; asm volatile("" : "+v"(tid)); \
    const int lane = tid & 63, wave = __builtin_amdgcn_readfirstlane(tid >> 6), G = gridDim.x, gw = blockIdx.x * 8 + wave, ngw = G * 8; \
    const size_t gtid = (size_t)blockIdx.x * 512 + tid, gthreads = (size_t)G * 512; \
    LAS unsigned char* wl = lds + wave * WAVE_LDS; LAS float* scr = (LAS float*)wl; (void)lane; (void)gw; (void)ngw; (void)gtid; (void)gthreads; (void)wl; (void)scr
#define WAB ((bf16_t*)(ws + WS_WAB))
#define WO ((bf16_t*)(ws + WS_WO))
#define CW1K ((bf16_t*)(ws + WS_CW1K))
#define CW1V ((bf16_t*)(ws + WS_CW1V))
#define CW2K ((bf16_t*)(ws + WS_CW2K))
#define CW2V ((bf16_t*)(ws + WS_CW2V))
#define CBIAS ((float*)(ws + WS_CBIAS))
#define KC ((bf16_t*)(ws + WS_KC))
#define VC ((bf16_t*)(ws + WS_VC))
#define GN ((bf16_t*)(ws + WS_GN))
#define HF ((float*)(ws + WS_HF))
#define HB ((bf16_t*)(ws + WS_HB))
#define GU ((bf16_t*)(ws + WS_GU))
#define DN ((bf16_t*)(ws + WS_DN))
#define ACT ((bf16_t*)(ws + WS_ACT))
#define PROJ ((bf16_t*)(ws + WS_PROJ))
#define KSLF ((bf16_t*)(ws + WS_KSLF))
#define VSLF ((bf16_t*)(ws + WS_VSLF))
#define KWNF ((bf16_t*)(ws + WS_KWNF))
#define VWNF ((bf16_t*)(ws + WS_VWNF))
#define RCOS ((float*)(ws + WS_ROPE))
#define RSIN ((float*)(ws + WS_ROPE) + (size_t)S * 64)
#define WINT ((bf16_t*)(ws + WS_WIN))
#define NSAOUT ((bf16_t*)(ws + WS_NSAOUT))
#define SIGG ((bf16_t*)P.out)
    pg8::StaticOrder SO;
#define CG_SYNC() do { asm volatile("s_waitcnt vmcnt(0) lgkmcnt(0)" ::: "memory"); grid.sync(); \
        if (__builtin_amdgcn_readfirstlane(threadIdx.x >> 6) == 0) { __builtin_amdgcn_fence(__ATOMIC_ACQUIRE, "agent"); asm volatile("s_waitcnt vmcnt(0)" ::: "memory"); } \
        __syncthreads(); } while (0)
    volatile LAS unsigned* xst = (volatile LAS unsigned*)(lds + 8 * WAVE_LDS);
    if (threadIdx.x < 2) xst[threadIdx.x] = 0u;
    __syncthreads();
    const XcdBarrier xbar = xcd_barrier_post((unsigned*)P.ws, xst);
#define GRID_SYNC() do { asm volatile("s_waitcnt vmcnt(0) lgkmcnt(0)" ::: "memory"); xcd_barrier(xbar); } while (0)

    { PHASE_WS;
        conv_ffn(P.in[1], P.in[2], P.in[3], GU, DN, scr, gw, ngw, lane);
        for (int it = gw; it < 32 * 360; it += ngw) { const int kb = it / 360, nb = it % 360, dr = nb * 32; const int sc = win_src_col(dr);
            tr_item(P.in[6], WIN_SRC, kb * 64, sc < 0 ? 0 : sc, sc < 0 ? 0 : (dr == 11264 ? 24 : 32), WINT, DM, dr, kb * 64, scr, lane); }
        for (int it = gw; it < 16 * 64; it += ngw) { const int kb = it / 64, nb = it % 64; tr_item(P.in[13], DM, kb * 64, nb * 32, 32, WAB, 1024, nb * 32, kb * 64, scr, lane); }
        for (int it = gw; it < 8 * 64; it += ngw) { const int kb = it / 64, nb = it % 64; tr_item(P.in[14], DM, kb * 64, nb * 32, 32, WAB + (size_t)DM * 1024, 512, nb * 32, kb * 64, scr, lane); }
        for (int it = gw; it < 32 * 64; it += ngw) { const int kb = it / 64, nb = it % 64; tr_item(P.in[15], DM, kb * 64, nb * 32, 32, WO, DM, nb * 32, kb * 64, scr, lane); }
        for (int it = gw; it < 2 * 64 * 8; it += ngw) { const int w = it / 512, r = it % 512, kb = r / 8, nb = r % 8; tr_item(w ? P.in[11] : P.in[8], 256, kb * 64, nb * 32, 32, w ? CW1V : CW1K, 4096, nb * 32, kb * 64, scr, lane); }
        for (int it = gw; it < 2 * 4 * 4; it += ngw) { const int w = it / 16, r = it % 16, kb = r / 4, nb = r % 4; tr_item(w ? P.in[12] : P.in[9], 128, kb * 64, nb * 32, 32, w ? CW2V : CW2K, 256, nb * 32, kb * 64, scr, lane); }
        { const float* x = P.in[0];
            for (size_t i = gtid; i < (size_t)S * DM / 8; i += gthreads) { const f32x4 a = *(const f32x4*)(x + 8 * i), b = *(const f32x4*)(x + 8 * i + 4); *(u32x4*)(HB + 8 * i) = pack8(a, b); } }
        for (int o = gw; o < 512; o += ngw) { const int w = o >> 8, c = o & 255; const float* pos = w ? P.in[10] : P.in[7]; const float* w1 = w ? P.in[11] : P.in[8];
            float s = 0.f; for (int kk = lane; kk < 4096; kk += 64) s += pos[kk] * w1[(size_t)kk * 256 + c];
            s = wave_sum(s); if (lane == 0) CBIAS[o] = s; }
    }
    CG_SYNC();
    { PHASE_WS; pg8::Gemm g{HB, GU, S, NGU, DM, DM, DM}; SO.init(S, NGU, G, (int)blockIdx.x); EpiSwiglu E{ACT}; pg8::gemm_phase(lds, g, SO, E); }
    GRID_SYNC();
    { PHASE_WS; pg8::Gemm g{ACT, DN, S, DM, FF, FF, FF}; SO.init(S, DM, G, (int)blockIdx.x); EpiResF32 E{P.in[0], HF, ALPHA, 0.5f}; pg8::gemm_phase(lds, g, SO, E); }
    GRID_SYNC();
    { PHASE_WS;
        ln_rows(HF, HF, HB, P.in[4], P.in[5], gw, ngw, lane);
        for (size_t i = gtid; i < (size_t)S * 64; i += gthreads) { const int t = (int)(i >> 6), j = (int)(i & 63); const float ang = (float)t * P.inv_freq[j]; RCOS[i] = cosf(ang); RSIN[i] = sinf(ang); }
    }
    GRID_SYNC();
    { PHASE_WS; pg8::Gemm g{HB, WINT, S, NWIN, DM, DM, DM}; SO.init(S, NWIN, G, (int)blockIdx.x); EpiWin E{PROJ, SIGG, GN, RCOS, RSIN, KSLF, VSLF, KWNF, VWNF}; pg8::gemm_phase(lds, g, SO, E); }
    GRID_SYNC();
    { PHASE_WS;
        if (wave == 0) { for (int u = blockIdx.x; u < 256; u += G) { const int kv = u >> 7; compress_unit(u, PROJ, kv ? CW1V : CW1K, kv ? CW2V : CW2K, CBIAS + 256 * kv, kv ? VC : KC, wl, lane); } }
        else { for (int u = blockIdx.x * 7 + (wave - 1); u < 4096; u += G * 7) dilated_unit(u, PROJ, NSAOUT, wl, lane); }
    }
    GRID_SYNC();
    { PHASE_WS;
      if ((G & 7) == 0) {
          const int bx = blockIdx.x, x = bx & 7, g = x & 1, wj = ((bx >> 3) * 4 + (x >> 1)) * 8 + wave, nwj = (G >> 1) * 8;
          for (int tb = wj; tb < 4096; tb += nwj) nsa_unit(2 * tb + g, PROJ, KC, VC, GN, RCOS, RSIN, KSLF, VSLF, KWNF, VWNF, NSAOUT, wl, lane);
      } else { for (int u = gw; u < 8192; u += ngw) nsa_unit(u, PROJ, KC, VC, GN, RCOS, RSIN, KSLF, VSLF, KWNF, VWNF, NSAOUT, wl, lane); } }
    GRID_SYNC();
    { PHASE_WS; SO.init(S, DM, G, (int)blockIdx.x);
      { pg8::Gemm g{NSAOUT, WAB, S, DM, 1024, NOLD, 1024}; EpiGate<true> E{SIGG, HB}; pg8::gemm_phase(lds, g, SO, E); }
      { pg8::Gemm g{NSAOUT + 1024, WAB + (size_t)DM * 1024, S, DM, 512, NOLD, 512}; EpiGate<false> E{SIGG + 2048, HB}; pg8::gemm_phase(lds, g, SO, E); } }
    GRID_SYNC();
    { PHASE_WS; pg8::Gemm g{HB, WO, S, DM, DM, DM, DM}; SO.init(S, DM, G, (int)blockIdx.x); EpiResF32 E{HF, HF, ALPHA, 1.0f}; pg8::gemm_phase(lds, g, SO, E); }
    GRID_SYNC();
    { PHASE_WS;
        ln_rows(HF, HF, HB, P.in[16], P.in[17], gw, ngw, lane);
        conv_ffn(P.in[18], P.in[19], P.in[20], GU, DN, scr, gw, ngw, lane);
    }
    GRID_SYNC();
    { PHASE_WS; pg8::Gemm g{HB, GU, S, NGU, DM, DM, DM}; SO.init(S, NGU, G, (int)blockIdx.x); EpiSwiglu E{ACT}; pg8::gemm_phase(lds, g, SO, E); }
    GRID_SYNC();
    { PHASE_WS; pg8::Gemm g{ACT, DN, S, DM, FF, FF, FF}; SO.init(S, DM, G, (int)blockIdx.x); EpiResF32 E{HF, P.out, ALPHA, 0.5f}; pg8::gemm_phase(lds, g, SO, E); }
    GRID_SYNC();
    { PHASE_WS; (void)ws; ln_rows(P.out, P.out, nullptr, P.in[21], P.in[22], gw, ngw, lane); }
}

extern "C" void kernel_launch(void* const* d_in, const int* in_sizes, int n_in, void* d_out, int out_size, void* d_ws, size_t ws_size, hipStream_t stream) {
    static int grid = 0;
    if (grid == 0) {
        if (n_in != 23 || out_size != S * DM || ws_size < WS_END) { fprintf(stderr, "kernel_launch: unexpected shapes (n_in %d out %d ws %zu, need %zu)\n", n_in, out_size, ws_size, (size_t)WS_END); grid = -1; return; }
        int dev = 0, cus = 0, per_cu = 0;
        hipGetDevice(&dev); hipDeviceGetAttribute(&cus, hipDeviceAttributeMultiprocessorCount, dev);
        if (hipFuncSetAttribute((const void*)fwd_megakernel, hipFuncAttributeMaxDynamicSharedMemorySize, LDS_BYTES) != hipSuccess) { fprintf(stderr, "kernel_launch: hipFuncSetAttribute failed\n"); grid = -1; return; }
        if (hipOccupancyMaxActiveBlocksPerMultiprocessor(&per_cu, (const void*)fwd_megakernel, 512, LDS_BYTES) != hipSuccess || per_cu < 1) { fprintf(stderr, "kernel_launch: occupancy query failed (%d)\n", per_cu); (void)hipGetLastError(); per_cu = 1; }
        grid = cus * per_cu;
    }
    if (grid < 0) return;
    if (hipMemsetAsync(d_ws, 0, 16384, stream) != hipSuccess) { fprintf(stderr, "kernel_launch: memset of the barrier words failed\n"); return; }
    Params p{};
    for (int i = 0; i < 23; ++i) p.in[i] = (const float*)d_in[i];
    p.out = (float*)d_out; p.ws = (unsigned char*)d_ws;
    for (int i = 0; i < 64; ++i) p.inv_freq[i] = (float)pow(10000.0, -(double)i / 64.0);
    void* args[] = {&p};
    hipError_t e = hipLaunchCooperativeKernel((const void*)fwd_megakernel, dim3(grid), dim3(512), args, LDS_BYTES, stream);
    if (e != hipSuccess) fprintf(stderr, "kernel_launch: cooperative launch failed: %s (grid %d)\n", hipGetErrorString(e), grid);
}
```

```cpp
#include <hip/hip_runtime.h>
#include <hip/hip_cooperative_groups.h>
#include <cstdio>
#include <cstdint>
#include <cmath>
namespace cg = cooperative_groups;

#define LAS __attribute__((address_space(3)))
typedef unsigned short bf16_t;
typedef short bf16x8 __attribute__((ext_vector_type(8)));
typedef short s16x4 __attribute__((ext_vector_type(4)));
typedef float f32x4 __attribute__((ext_vector_type(4)));
typedef float f32x2 __attribute__((ext_vector_type(2)));
typedef unsigned u32x4 __attribute__((ext_vector_type(4)));
typedef unsigned u32x2 __attribute__((ext_vector_type(2)));

constexpr int S = 16384, DM = 2048, FF = 5632, NGU = 2 * FF, NWIN = 11520, WIN_SRC = 11288, PLD = 6144, NOLD = 1536;
constexpr float ALPHA = 1.189207115002721f;
constexpr float LN_EPS = 1e-5f;
constexpr float SL2 = 0.08838834764831845f * 1.4426950408889634f;
constexpr int PC_QA = 0, PC_KC = 1024, PC_VC = 1280, PC_QB = 1536, PC_KB = 3072, PC_VB = 4608;
constexpr size_t MiB = 1u << 20;
constexpr size_t WS_WAB = 1 * MiB, WS_WO = 13 * MiB, WS_CW1K = 21 * MiB, WS_CW1V = 23 * MiB, WS_CW2K = 25 * MiB, WS_CW2V = 25 * MiB + 65536, WS_CBIAS = 25 * MiB + 131072;
constexpr size_t WS_KC = 26 * MiB, WS_VC = 26 * MiB + 524288, WS_GN = 27 * MiB;
constexpr size_t WS_HF = 32 * MiB, WS_HB = 160 * MiB, WS_BIG = 224 * MiB;
constexpr size_t WS_GU = WS_BIG, WS_DN = WS_BIG + 44 * MiB, WS_ACT = WS_BIG + 66 * MiB;
constexpr size_t WS_PROJ = WS_BIG, WS_KSLF = WS_BIG + 192 * MiB, WS_VSLF = WS_BIG + 200 * MiB, WS_KWNF = WS_BIG + 208 * MiB, WS_VWNF = WS_BIG + 216 * MiB, WS_ROPE = WS_BIG + 224 * MiB;
constexpr size_t WS_WIN = 466 * MiB, WS_NSAOUT = 466 * MiB, WS_END = 514 * MiB;

constexpr int VROW = 288, VBUF_BYTES = 32 * VROW;
constexpr int IMP_LD = 260;
constexpr int OUT_OFF = VBUF_BYTES + 4 * IMP_LD * 4 + 256 + 512;
constexpr int WAVE_LDS = OUT_OFF + 4096;
constexpr int LDS_BYTES = 147456;
static_assert(8 * WAVE_LDS + 16 <= LDS_BYTES && 131072 <= LDS_BYTES, "LDS map");

typedef __bf16 bf16x2_t __attribute__((ext_vector_type(2)));
__device__ __forceinline__ unsigned cvt_pk_bf16(float lo, float hi) { f32x2 v = {lo, hi}; bf16x2_t b = __builtin_convertvector(v, bf16x2_t); return __builtin_bit_cast(unsigned, b); }
__device__ __forceinline__ float bf2f(unsigned short b) { return __uint_as_float(((unsigned)b) << 16); }
__device__ __forceinline__ float bflo(unsigned w) { return __uint_as_float(w << 16); }
__device__ __forceinline__ float bfhi(unsigned w) { return __uint_as_float(w & 0xffff0000u); }
__device__ __forceinline__ float fsigmoid(float x) { return __builtin_amdgcn_rcpf(1.f + __expf(-x)); }
__device__ __forceinline__ float wave_sum(float v) {
#pragma unroll
    for (int o = 1; o < 64; o <<= 1) v += __shfl_xor(v, o);
    return v;
}
__device__ __forceinline__ u32x4 pack8(const f32x4 a, const f32x4 b) { u32x4 w; w.x = cvt_pk_bf16(a[0], a[1]); w.y = cvt_pk_bf16(a[2], a[3]); w.z = cvt_pk_bf16(b[0], b[1]); w.w = cvt_pk_bf16(b[2], b[3]); return w; }

namespace pg8 {
constexpr int BM = 256, BK = 64, HALF = 128, HTB = HALF * BK * 2, STAGE_BYTES = 8 * HTB, NXCD = 8, WGM = 8;
__host__ __device__ __forceinline__ int lds_byte(int r, int c) { const int st = (r >> 4) * 2 + (c >> 5), rr = r & 15, cc = c & 31, ob = rr * 64 + cc * 2; return st * 1024 + (ob ^ (((ob >> 9) & 1) << 5)); }
__host__ __device__ __forceinline__ void stage_rc(int b, int& R, int& C) { const int st = b / 1024, sb = b % 1024, swz = sb ^ (((sb >> 9) & 1) << 5); R = (st >> 1) * 16 + swz / 64; C = (st & 1) * 32 + (swz % 64) / 2; }
__host__ __device__ __forceinline__ int perm32(int rho) { const int n = rho >> 4, i = rho & 15; return 8 * (i >> 2) + 4 * n + (i & 3); }
struct Unit { int pm, pn; };
struct Gemm { const bf16_t* A; const bf16_t* Bt; int M, N, K, lda, ldb; };
struct StaticOrder {
    int nM, nN, nwg, G, c;
    __device__ void init(int M, int N, int G_, int c_) { nM = M / BM; nN = N / BM; nwg = nM * nN; G = G_; c = c_; }
    __device__ bool next(int i, Unit& u) const {
        const long L = (long)i * G + c; if (L >= nwg) return false;
        int wgid = (int)L; { const int q = nwg / NXCD, r = nwg % NXCD, xcd = wgid % NXCD, off = wgid / NXCD; wgid = (xcd < r ? xcd * (q + 1) : r * (q + 1) + (xcd - r) * q) + off; }
        const int nig = WGM * nN, gid = wgid / nig, fm = gid * WGM, gsz = (nM - fm) < WGM ? (nM - fm) : WGM;
        u.pm = fm + ((wgid % nig) % gsz); u.pn = (wgid % nig) / gsz; return true;
    }
};
typedef f32x4 Acc[2][2][4][2];

template <class Epi>
__device__ __forceinline__ void gemm_phase(LAS unsigned char* lds, const Gemm g, const StaticOrder& S_, const Epi& E, const int tid) {
    const int wid = __builtin_amdgcn_readfirstlane(tid >> 6), lane = tid & 63, wr = wid >> 2, wc = wid & 3, fr = lane & 15, fq = lane >> 4;
    const int K = g.K, nt = K / BK;
    unsigned voffA[2], voffB[2];
#pragma unroll
    for (int i = 0; i < 2; ++i) { int R, C; stage_rc(tid * 16 + i * 8192, R, C); const int Rb = Epi::PERM ? ((R & ~31) + perm32(R & 31)) : R;
        voffA[i] = (unsigned)(R * g.lda + C) * 2u; voffB[i] = (unsigned)(Rb * g.ldb + C) * 2u; }
    const size_t kstep = (size_t)(BK * 2);
    const size_t hstepA = (size_t)HALF * g.lda * 2, hstepB = (size_t)HALF * g.ldb * 2;
    const size_t tstepA = 2 * hstepA, tstepB = 2 * hstepB;
    const unsigned ldsw = (unsigned)wid * 1024u;
    const int aoff = lds_byte(wr * 64 + fr, fq * 8), boff = lds_byte(wc * 32 + fr, fq * 8);
#define PG8_SA(b, h) (((b) * 2 + (h)) * HTB)
#define PG8_SB(b, h) ((4 + (b) * 2 + (h)) * HTB)
#define PG8_STAGE(bufoff, gbase, voff) do { _Pragma("unroll") for (int _i = 0; _i < 2; ++_i) \
        __builtin_amdgcn_global_load_lds((const unsigned*)((const char*)(gbase) + (voff)[_i]), (LAS unsigned*)(lds + (bufoff) + ldsw + _i * 8192), 16, 0, 0); } while (0)
#define PG8_LDA(dst, b, h) do { _Pragma("unroll") for (int m = 0; m < 4; ++m) _Pragma("unroll") for (int k = 0; k < 2; ++k) dst[m][k] = *(const LAS bf16x8*)(lds + PG8_SA(b, h) + aoff + m * 2048 + k * 1024); } while (0)
#define PG8_LDB(dst, b, h) do { _Pragma("unroll") for (int n = 0; n < 2; ++n) _Pragma("unroll") for (int k = 0; k < 2; ++k) dst[n][k] = *(const LAS bf16x8*)(lds + PG8_SB(b, h) + boff + n * 2048 + k * 1024); } while (0)
#define PG8_MMA(ai, bj, At, Bt) do { __builtin_amdgcn_s_setprio(1); _Pragma("unroll") for (int m = 0; m < 4; ++m) _Pragma("unroll") for (int n = 0; n < 2; ++n) _Pragma("unroll") for (int k = 0; k < 2; ++k) \
        acc[ai][bj][m][n] = __builtin_amdgcn_mfma_f32_16x16x32_bf16(Bt[n][k], At[m][k], acc[ai][bj][m][n], 0, 0, 0); __builtin_amdgcn_s_setprio(0); } while (0)
#define PG8_WAIT_V(n) asm volatile("s_waitcnt vmcnt(" #n ")" ::: "memory")
#define PG8_WAIT_L(n) asm volatile("s_waitcnt lgkmcnt(" #n ")" ::: "memory")
#define PG8_BAR __builtin_amdgcn_s_barrier()
#define PG8_SCHED __builtin_amdgcn_sched_barrier(0)
    Unit cur, nxt; int ui = 0;
    if (!S_.next(0, cur)) return;
    Acc acc;
#pragma unroll
    for (int a = 0; a < 2; ++a)
#pragma unroll
        for (int b = 0; b < 2; ++b)
#pragma unroll
            for (int m = 0; m < 4; ++m)
#pragma unroll
                for (int n = 0; n < 2; ++n) acc[a][b][m][n] = (f32x4){0.f, 0.f, 0.f, 0.f};
    bf16x8 At[4][2], B0[2][2], B1[2][2];
    const char* cA = (const char*)g.A + (size_t)cur.pm * tstepA; const char* cB = (const char*)g.Bt + (size_t)cur.pn * tstepB;
    PG8_STAGE(PG8_SB(0, 0), cB, voffB); PG8_STAGE(PG8_SB(0, 1), cB + hstepB, voffB); PG8_STAGE(PG8_SA(0, 0), cA, voffA); PG8_STAGE(PG8_SA(0, 1), cA + hstepA, voffA);
    if (wr == 1) PG8_BAR;
    PG8_WAIT_V(2); PG8_BAR;
    PG8_STAGE(PG8_SB(1, 0), cB + kstep, voffB); PG8_STAGE(PG8_SA(1, 0), cA + kstep, voffA); PG8_STAGE(PG8_SB(1, 1), cB + hstepB + kstep, voffB);
    PG8_WAIT_V(6); PG8_BAR;
    for (;;) {
        const bool has_next = S_.next(ui + 1, nxt);
        const char* nA = has_next ? (const char*)g.A + (size_t)nxt.pm * tstepA : cA; const char* nB = has_next ? (const char*)g.Bt + (size_t)nxt.pn * tstepB : cB;
        for (int t = 0; t < nt; t += 2) {
            const bool last = (t == nt - 2);
            const char* a1 = cA + (size_t)(t + 1) * kstep;
            const char* a2 = last ? nA : cA + (size_t)(t + 2) * kstep; const char* b2 = last ? nB : cB + (size_t)(t + 2) * kstep;
            const char* a3 = a2 + kstep; const char* b3 = b2 + kstep;
            PG8_LDB(B0, 0, 0); PG8_LDB(B1, 0, 1); PG8_SCHED; PG8_LDA(At, 0, 0); PG8_STAGE(PG8_SA(1, 1), a1 + hstepA, voffA);
            PG8_WAIT_V(8); PG8_WAIT_L(0); PG8_BAR; PG8_MMA(0, 0, At, B0); PG8_MMA(0, 1, At, B1); PG8_BAR; PG8_SCHED;
            PG8_LDA(At, 0, 1); PG8_STAGE(PG8_SB(0, 0), b2, voffB); PG8_STAGE(PG8_SB(0, 1), b2 + hstepB, voffB); PG8_STAGE(PG8_SA(0, 0), a2, voffA);
            PG8_WAIT_V(8); PG8_WAIT_L(0); PG8_BAR; PG8_MMA(1, 0, At, B0); PG8_MMA(1, 1, At, B1); PG8_BAR; PG8_SCHED;
            PG8_LDB(B0, 1, 0); PG8_LDB(B1, 1, 1); PG8_SCHED; PG8_LDA(At, 1, 0); PG8_STAGE(PG8_SA(0, 1), a2 + hstepA, voffA);
            PG8_WAIT_V(8); PG8_WAIT_L(0); PG8_BAR; PG8_MMA(0, 0, At, B0); PG8_MMA(0, 1, At, B1); PG8_BAR; PG8_SCHED;
            PG8_LDA(At, 1, 1); PG8_STAGE(PG8_SB(1, 0), b3, voffB); PG8_STAGE(PG8_SB(1, 1), b3 + hstepB, voffB); PG8_STAGE(PG8_SA(1, 0), a3, voffA);
            PG8_WAIT_V(8); PG8_WAIT_L(0); PG8_BAR; PG8_MMA(1, 0, At, B0); PG8_MMA(1, 1, At, B1); PG8_BAR; PG8_SCHED;
        }
        if (wr == 0) PG8_BAR;
        E(acc, cur, wr, wc, fr, fq);
        if (!has_next) break;
#pragma unroll
        for (int a = 0; a < 2; ++a)
#pragma unroll
            for (int b = 0; b < 2; ++b)
#pragma unroll
                for (int m = 0; m < 4; ++m)
#pragma unroll
                    for (int n = 0; n < 2; ++n) acc[a][b][m][n] = (f32x4){0.f, 0.f, 0.f, 0.f};
        cur = nxt; cA = nA; cB = nB; ++ui;
        if (wr == 1) PG8_BAR;
    }
    PG8_WAIT_V(0);
    PG8_BAR;
#undef PG8_SA
#undef PG8_SB
#undef PG8_STAGE
#undef PG8_LDA
#undef PG8_LDB
#undef PG8_MMA
#undef PG8_WAIT_V
#undef PG8_WAIT_L
#undef PG8_BAR
#undef PG8_SCHED
}
}

struct EpiSwiglu {
    static constexpr bool PERM = true;
    bf16_t* O;
    __device__ __forceinline__ void operator()(const pg8::Acc& acc, const pg8::Unit& u, int wr, int wc, int fr, int fq) const {
        const int row0 = u.pm * 256 + wr * 64 + fr, col0 = u.pn * 128 + wc * 32 + 8 * fq;
#pragma unroll
        for (int ai = 0; ai < 2; ++ai)
#pragma unroll
            for (int m = 0; m < 4; ++m) {
                f32x4 v[2];
#pragma unroll
                for (int n = 0; n < 2; ++n)
#pragma unroll
                    for (int e = 0; e < 4; ++e) { const float gt = acc[ai][0][m][n][e], up = acc[ai][1][m][n][e]; v[n][e] = gt * fsigmoid(gt) * up; }
                *(u32x4*)(O + (size_t)(row0 + ai * 128 + m * 16) * FF + col0) = pack8(v[0], v[1]);
            }
    }
};
struct EpiResF32 {
    static constexpr bool PERM = false;
    const float* res; float* out; float a, b;
    __device__ __forceinline__ void operator()(const pg8::Acc& acc, const pg8::Unit& u, int wr, int wc, int fr, int fq) const {
        const int row0 = u.pm * 256 + wr * 64 + fr, col0 = u.pn * 256 + wc * 32 + 4 * fq;
#pragma unroll
        for (int ai = 0; ai < 2; ++ai)
#pragma unroll
            for (int m = 0; m < 4; ++m) {
                const size_t off = (size_t)(row0 + ai * 128 + m * 16) * DM + col0;
#pragma unroll
                for (int bj = 0; bj < 2; ++bj)
#pragma unroll
                    for (int n = 0; n < 2; ++n) { const f32x4 r = *(const f32x4*)(res + off + bj * 128 + n * 16); *(f32x4*)(out + off + bj * 128 + n * 16) = r * a + acc[ai][bj][m][n] * b; }
            }
    }
};
struct EpiWin {
    static constexpr bool PERM = true;
    bf16_t* proj; bf16_t* sigg; bf16_t* gn; const float* cs; bf16_t* kslf;
    __device__ __forceinline__ void operator()(const pg8::Acc& acc, const pg8::Unit& u, int wr, int wc, int fr, int fq) const {
        const int tile = u.pn, row0 = u.pm * 256 + wr * 64 + fr, cw = wc * 32 + 8 * fq;
        if (tile < 28) {
            const bool rope = (tile == 6) | (tile == 8) | (tile >= 10 && tile < 22);
            const int dcol = (tile < 6 ? tile : tile - 4) * 256;
            if (!rope) {
                if (tile == 7 || tile == 9) {
                    bf16_t* VF = kslf + (tile == 7 ? (size_t)4 << 20 : (size_t)12 << 20);
#pragma unroll
                    for (int ai = 0; ai < 2; ++ai)
#pragma unroll
                        for (int m = 0; m < 4; ++m) {
                            const int row = row0 + ai * 128 + m * 16, kp = row & 31;
                            const size_t rbase = (size_t)(row >> 5) * 4096 + (size_t)(((kp >> 2) & 3) * 16) * 8 + 4 * (kp >> 4) + (kp & 3);
#pragma unroll
                            for (int bj = 0; bj < 2; ++bj) {
                                const u32x4 w = pack8(acc[ai][bj][m][0], acc[ai][bj][m][1]);
                                bf16_t* vb = VF + (size_t)bj * 512 * 4096 + rbase + (size_t)(cw >> 4) * 512 + (size_t)(cw & 15) * 8;
                                vb[0] = (bf16_t)(w.x & 0xffffu); vb[8] = (bf16_t)(w.x >> 16); vb[16] = (bf16_t)(w.y & 0xffffu); vb[24] = (bf16_t)(w.y >> 16);
                                vb[32] = (bf16_t)(w.z & 0xffffu); vb[40] = (bf16_t)(w.z >> 16); vb[48] = (bf16_t)(w.w & 0xffffu); vb[56] = (bf16_t)(w.w >> 16);
                            }
                        }
                } else {
#pragma unroll
                    for (int ai = 0; ai < 2; ++ai)
#pragma unroll
                        for (int m = 0; m < 4; ++m)
#pragma unroll
                            for (int bj = 0; bj < 2; ++bj)
                                *(u32x4*)(proj + (size_t)(row0 + ai * 128 + m * 16) * PLD + dcol + bj * 128 + cw) = pack8(acc[ai][bj][m][0], acc[ai][bj][m][1]);
                }
            } else {
                const int head = cw >> 6, d = cw & 63;
                const bool frag = (tile == 6) | (tile == 8);
                bf16_t* KF = kslf + (tile == 6 ? (size_t)0 : (size_t)8 << 20); const float* sn = cs + (size_t)S * 64;
#pragma unroll
                for (int ai = 0; ai < 2; ++ai)
#pragma unroll
                    for (int m = 0; m < 4; ++m) {
                        const int row = row0 + ai * 128 + m * 16;
                        f32x4 o1[2], o2[2];
#pragma unroll
                        for (int n = 0; n < 2; ++n) {
                            const f32x4 c = *(const f32x4*)(cs + (size_t)row * 64 + d + 4 * n), sv = *(const f32x4*)(sn + (size_t)row * 64 + d + 4 * n);
                            const f32x4 x1 = acc[ai][0][m][n], x2 = acc[ai][1][m][n];
                            o1[n] = x1 * c - x2 * sv; o2[n] = x2 * c + x1 * sv;
                        }
                        if (frag) {
                            bf16_t* kb = KF + ((size_t)head * 1024 + (row >> 4)) * 2048 + (size_t)(d >> 5) * 512 + (size_t)(((d >> 3) & 3) * 16 + (row & 15)) * 8;
                            *(u32x4*)kb = pack8(o1[0], o1[1]); *(u32x4*)(kb + 1024) = pack8(o2[0], o2[1]);
                        } else {
                            bf16_t* p = proj + (size_t)row * PLD + dcol + head * 128 + d;
                            *(u32x4*)p = pack8(o1[0], o1[1]); *(u32x4*)(p + 64) = pack8(o2[0], o2[1]);
                        }
                        if (m & 1) asm volatile("" ::: "memory");
                    }
            }
        } else if (tile < 44) {
#pragma unroll
            for (int ai = 0; ai < 2; ++ai)
#pragma unroll
                for (int m = 0; m < 4; ++m)
#pragma unroll
                    for (int bj = 0; bj < 2; ++bj) {
                        f32x4 v[2];
#pragma unroll
                        for (int n = 0; n < 2; ++n)
#pragma unroll
                            for (int e = 0; e < 4; ++e) v[n][e] = fsigmoid(acc[ai][bj][m][n][e]);
                        *(u32x4*)(sigg + (size_t)(row0 + ai * 128 + m * 16) * 4096 + (tile - 28) * 256 + bj * 128 + cw) = pack8(v[0], v[1]);
                    }
        } else {
            if (wc == 0) {
#pragma unroll
                for (int ai = 0; ai < 2; ++ai)
#pragma unroll
                    for (int m = 0; m < 4; ++m) {
                        f32x4 v[2];
#pragma unroll
                        for (int n = 0; n < 2; ++n)
#pragma unroll
                            for (int e = 0; e < 4; ++e) v[n][e] = fsigmoid(acc[ai][0][m][n][e]);
                        *(u32x4*)(gn + (size_t)(row0 + ai * 128 + m * 16) * 32 + cw) = pack8(v[0], v[1]);
                    }
            }
        }
    }
};
template <bool FIRST> struct EpiGate {
    static constexpr bool PERM = true;
    const bf16_t* sg; bf16_t* O;
    __device__ __forceinline__ void operator()(const pg8::Acc& acc, const pg8::Unit& u, int wr, int wc, int fr, int fq) const {
        const int row0 = u.pm * 256 + wr * 64 + fr, col0 = u.pn * 256 + wc * 32 + 8 * fq;
#pragma unroll
        for (int ai = 0; ai < 2; ++ai)
#pragma unroll
            for (int m = 0; m < 4; ++m)
#pragma unroll
                for (int bj = 0; bj < 2; ++bj) {
                    const int row = row0 + ai * 128 + m * 16, col = col0 + bj * 128;
                    const u32x4 gv = *(const u32x4*)(sg + (size_t)row * 4096 + col);
                    u32x4 pv = (u32x4){0u, 0u, 0u, 0u}; if (!FIRST) pv = *(const u32x4*)(O + (size_t)row * DM + col);
                    f32x4 v[2];
#pragma unroll
                    for (int n = 0; n < 2; ++n) {
                        const unsigned g0 = n ? gv.z : gv.x, g1 = n ? gv.w : gv.y, p0 = n ? pv.z : pv.x, p1 = n ? pv.w : pv.y;
                        const f32x4 y = acc[ai][bj][m][n];
                        v[n][0] = bflo(p0) + bflo(g0) * y[0]; v[n][1] = bfhi(p0) + bfhi(g0) * y[1];
                        v[n][2] = bflo(p1) + bflo(g1) * y[2]; v[n][3] = bfhi(p1) + bfhi(g1) * y[3];
                    }
                    *(u32x4*)(O + (size_t)row * DM + col) = pack8(v[0], v[1]);
                }
    }
};

__device__ __forceinline__ void tr_item(const float* W, int ldw, int k0, int scol0, int nvalid, bf16_t* WT, int ldt, int drow0, int dk0, LAS float* scr, int lane) {
    const int c = lane & 31;
    float v[32];
#pragma unroll
    for (int i = 0; i < 32; ++i) { const int kk = 2 * i + (lane >> 5); v[i] = (c < nvalid) ? W[(size_t)(k0 + kk) * ldw + scol0 + c] : 0.f; }
#pragma unroll
    for (int i = 0; i < 32; ++i) { const int kk = 2 * i + (lane >> 5); scr[kk * 33 + c] = v[i]; }
    asm volatile("s_waitcnt lgkmcnt(0)" ::: "memory");
    const int c8 = lane & 7;
#pragma unroll
    for (int j = 0; j < 4; ++j) { const int n = (lane >> 3) + 8 * j; const LAS float* s = scr + (8 * c8) * 33 + n;
        u32x4 o; o.x = cvt_pk_bf16(s[0 * 33], s[1 * 33]); o.y = cvt_pk_bf16(s[2 * 33], s[3 * 33]); o.z = cvt_pk_bf16(s[4 * 33], s[5 * 33]); o.w = cvt_pk_bf16(s[6 * 33], s[7 * 33]);
        *(u32x4*)(WT + (size_t)(drow0 + n) * ldt + dk0 + 8 * c8) = o; }
    asm volatile("s_waitcnt lgkmcnt(0)" ::: "memory");
}
__device__ __forceinline__ int win_src_col(int r) {
    if (r >= WIN_SRC) return -1;
    if (r >= 11264) return 2560 + (r - 11264);
    const int tile = r >> 8; int j = r & 255;
    const bool rope = (tile == 6) | (tile == 8) | (tile >= 10 && tile < 22);
    if (rope) { const int q = j >> 6, d = j & 63; j = (q & 1) * 128 + (q >> 1) * 64 + d; }
    const int c = tile * 256 + j;
    return c < 2560 ? c : c + 24;
}
__device__ __forceinline__ void conv_ffn(const float* Wg, const float* Wu, const float* Wd, bf16_t* GU, bf16_t* DN, LAS float* scr, int gw, int ngw, int lane) {
    constexpr int I_G = 32 * 176;
    for (int it = gw; it < 2 * I_G; it += ngw) { const int which = it / I_G, r = it % I_G, kb = r / 176, nb = r % 176, c0 = nb * 32;
        tr_item(which ? Wu : Wg, FF, kb * 64, c0, 32, GU, DM, 256 * (c0 >> 7) + (c0 & 127) + which * 128, kb * 64, scr, lane); }
    for (int it = gw; it < 88 * 64; it += ngw) { const int kb = it / 64, nb = it % 64; tr_item(Wd, DM, kb * 64, nb * 32, 32, DN, FF, nb * 32, kb * 64, scr, lane); }
}
__device__ __forceinline__ void ln_rows(const float* in, float* outf, bf16_t* outb, const float* g, const float* b, int gw, int ngw, int lane) {
    f32x4 gv[8], bv[8];
#pragma unroll
    for (int j = 0; j < 8; ++j) { gv[j] = *(const f32x4*)(g + 4 * (lane + 64 * j)); bv[j] = *(const f32x4*)(b + 4 * (lane + 64 * j)); }
    for (int row = gw; row < S; row += ngw) {
        const float* xr = in + (size_t)row * DM; f32x4 v[8]; float s = 0.f;
#pragma unroll
        for (int j = 0; j < 8; ++j) { v[j] = *(const f32x4*)(xr + 4 * (lane + 64 * j)); s += (v[j][0] + v[j][1]) + (v[j][2] + v[j][3]); }
        const float mean = wave_sum(s) * (1.f / DM); float s2 = 0.f;
#pragma unroll
        for (int j = 0; j < 8; ++j) { v[j] = v[j] - mean; s2 += (v[j][0] * v[j][0] + v[j][1] * v[j][1]) + (v[j][2] * v[j][2] + v[j][3] * v[j][3]); }
        const float rstd = 1.f / sqrtf(wave_sum(s2) * (1.f / DM) + LN_EPS);
#pragma unroll
        for (int j = 0; j < 8; ++j) { const f32x4 o = v[j] * rstd * gv[j] + bv[j];
            *(f32x4*)(outf + (size_t)row * DM + 4 * (lane + 64 * j)) = o;
            if (outb) { u32x2 w; w.x = cvt_pk_bf16(o[0], o[1]); w.y = cvt_pk_bf16(o[2], o[3]); *(u32x2*)(outb + (size_t)row * DM + 4 * (lane + 64 * j)) = w; } }
    }
}

struct AState { float m, l; f32x4 o[8]; };
__device__ __forceinline__ void astate_init(AState& s) { s.m = -1e30f; s.l = 0.f;
#pragma unroll
    for (int i = 0; i < 8; ++i) s.o[i] = (f32x4){0.f, 0.f, 0.f, 0.f}; }
__device__ __forceinline__ int clampi(int v, int lo, int hi) { return v < lo ? lo : (v > hi ? hi : v); }

__device__ __forceinline__ void load_k(bf16x8 (&kf)[2][4], const bf16_t* __restrict__ Kb, int ld, int pos0, int dpos, int posmax, int l16, int kq) {
#pragma unroll
    for (int T = 0; T < 2; ++T) { const int p = clampi(pos0 + dpos * (16 * T + l16), 0, posmax); const bf16_t* kp = Kb + (size_t)p * ld + 8 * kq;
#pragma unroll
        for (int s = 0; s < 4; ++s) kf[T][s] = *(const bf16x8*)(kp + 32 * s); }
}
__device__ __forceinline__ void load_v(u32x4 (&vr)[8], const bf16_t* __restrict__ Vb, int ld, int pos0, int dpos, int posmax, int l16, int kq) {
#pragma unroll
    for (int i = 0; i < 8; ++i) { const int p = clampi(pos0 + dpos * (4 * i + kq), 0, posmax); vr[i] = *(const u32x4*)(Vb + (size_t)p * ld + 8 * l16); }
}
__device__ __forceinline__ void store_v(const u32x4 (&vr)[8], LAS unsigned char* vbuf, int l16, int kq) {
#pragma unroll
    for (int i = 0; i < 8; ++i) *(LAS u32x4*)(vbuf + (4 * i + kq) * VROW + 16 * l16) = vr[i];
}
template <int MODE, bool SLC, class Desc>
__device__ __forceinline__ void attn_run(const bf16x8 (&qf)[4], const bf16_t* __restrict__ Kb, const bf16_t* __restrict__ Vb, int ld, int dpos, int posmax,
                                         const Desc& desc, int n, int lo_in, int hi, int qi, AState& st, LAS unsigned char* vbuf, int lane, LAS float* imp = nullptr) {
    if (n <= 0) return;
    const int l16 = lane & 15, kq = lane >> 4;
    u32x4 kr[8];
    int dcur = desc(0);
    load_v(kr, Kb, ld, SLC ? (dcur & 0xfffff) : dcur, dpos, posmax, l16, kq);
#pragma unroll 1
    for (int i = 0; i < n; ++i) {
        const int pos0 = SLC ? (dcur & 0xfffff) : dcur;
        const int lo = SLC ? ((((dcur >> 20) == qi) | ((dcur >> 20) == 4)) ? 0 : (1 << 30)) : lo_in;
        store_v(kr, vbuf, l16, kq);
        u32x4 vr[8];
        if (MODE != 1) load_v(vr, Vb, ld, pos0, dpos, posmax, l16, kq);
        bf16x8 kf[2][4];
#pragma unroll
        for (int T = 0; T < 2; ++T)
#pragma unroll
            for (int s = 0; s < 4; ++s) kf[T][s] = *(const LAS bf16x8*)(vbuf + (16 * T + l16) * VROW + 64 * s + 16 * kq);
        f32x4 sa[2] = {(f32x4){0.f, 0.f, 0.f, 0.f}, (f32x4){0.f, 0.f, 0.f, 0.f}};
#pragma unroll
        for (int T = 0; T < 2; ++T)
#pragma unroll
            for (int s = 0; s < 4; ++s) sa[T] = __builtin_amdgcn_mfma_f32_16x16x32_bf16(kf[T][s], qf[s], sa[T], 0, 0, 0);
        const int dnext = desc(i + 1 < n ? i + 1 : i);
        load_v(kr, Kb, ld, SLC ? (dnext & 0xfffff) : dnext, dpos, posmax, l16, kq);
        float sc[8]; bool vd[8]; float mx = -1e30f;
#pragma unroll
        for (int T = 0; T < 2; ++T)
#pragma unroll
            for (int r = 0; r < 4; ++r) { const int p = pos0 + dpos * (16 * T + 4 * kq + r); const bool v = (p >= lo) & (p <= hi); const float x = sa[T][r] * SL2;
                sc[4 * T + r] = x; vd[4 * T + r] = v; mx = v ? fmaxf(mx, x) : mx; }
        float p[8];
        if (MODE == 2) {
#pragma unroll
            for (int j = 0; j < 8; ++j) p[j] = vd[j] ? __builtin_amdgcn_exp2f(sc[j] - st.m) * st.l : 0.f;
#pragma unroll
            for (int T = 0; T < 2; ++T) {
                float x = 2.f * (p[4 * T] + p[4 * T + 1] + p[4 * T + 2]) + p[4 * T + 3], y = p[4 * T + 3];
                x += __shfl_xor(x, 1); x += __shfl_xor(x, 2); y += __shfl_xor(y, 1); y += __shfl_xor(y, 2);
                if ((l16 & 3) == 0) { const int a = (pos0 >> 2) + 4 * T + kq; LAS float* ip = imp + (l16 >> 2) * IMP_LD + a;
                    ip[0] += x;
                    asm volatile("s_waitcnt lgkmcnt(0)" ::: "memory");
                    ip[1] += y; }
                asm volatile("s_waitcnt lgkmcnt(0)" ::: "memory");
            }
        } else {
            if (__builtin_amdgcn_ballot_w64(mx > st.m + 40.f) != 0ull) {
                mx = fmaxf(mx, __shfl_xor(mx, 16)); mx = fmaxf(mx, __shfl_xor(mx, 32));
                const float mn = fmaxf(st.m, mx), alpha = __builtin_amdgcn_exp2f(st.m - mn); st.m = mn; st.l *= alpha;
                if (MODE == 0) {
#pragma unroll
                    for (int j = 0; j < 8; ++j) st.o[j] = st.o[j] * alpha;
                }
            }
            float ps = 0.f;
#pragma unroll
            for (int j = 0; j < 8; ++j) { p[j] = vd[j] ? __builtin_amdgcn_exp2f(sc[j] - st.m) : 0.f; ps += p[j]; }
            st.l += ps;
        }
        if (MODE != 1) {
            store_v(vr, vbuf, l16, kq);
            u32x4 pw; pw.x = cvt_pk_bf16(p[0], p[1]); pw.y = cvt_pk_bf16(p[2], p[3]); pw.z = cvt_pk_bf16(p[4], p[5]); pw.w = cvt_pk_bf16(p[6], p[7]);
            const bf16x8 pf = __builtin_bit_cast(bf16x8, pw);
            const unsigned addr = (unsigned)(uintptr_t)(vbuf) + (4 * kq + (l16 >> 2)) * VROW + (l16 & 3) * 8;
#pragma unroll
            for (int hf = 0; hf < 2; ++hf) {
                s16x4 a[8];
                asm volatile("s_waitcnt lgkmcnt(0)\n\t"
                             "ds_read_b64_tr_b16 %0, %8 offset:0\n\t"    "ds_read_b64_tr_b16 %1, %8 offset:32\n\t"
                             "ds_read_b64_tr_b16 %2, %8 offset:64\n\t"   "ds_read_b64_tr_b16 %3, %8 offset:96\n\t"
                             "ds_read_b64_tr_b16 %4, %8 offset:4608\n\t" "ds_read_b64_tr_b16 %5, %8 offset:4640\n\t"
                             "ds_read_b64_tr_b16 %6, %8 offset:4672\n\t" "ds_read_b64_tr_b16 %7, %8 offset:4704\n\t"
                             "s_waitcnt lgkmcnt(0)"
                             : "=&v"(a[0]), "=&v"(a[1]), "=&v"(a[2]), "=&v"(a[3]), "=&v"(a[4]), "=&v"(a[5]), "=&v"(a[6]), "=&v"(a[7])
                             : "v"(addr + 128 * hf) : "memory");
#pragma unroll
                for (int d4 = 0; d4 < 4; ++d4) { const int db = 4 * hf + d4;
                    bf16x8 af; af[0] = a[d4][0]; af[1] = a[d4][1]; af[2] = a[d4][2]; af[3] = a[d4][3]; af[4] = a[d4 + 4][0]; af[5] = a[d4 + 4][1]; af[6] = a[d4 + 4][2]; af[7] = a[d4 + 4][3];
                    st.o[db] = __builtin_amdgcn_mfma_f32_16x16x32_bf16(af, pf, st.o[db], 0, 0, 0); }
            }
        }
        dcur = dnext;
    }
}
template <int MODE, bool SLC, class Desc>
__device__ __forceinline__ void attn_run_frag(const bf16x8 (&qf)[4], const bf16_t* __restrict__ KF, const bf16_t* __restrict__ VF, const Desc& desc, int n,
                                              int lo_in, int hi, int qi, AState& st, int lane, LAS float* imp = nullptr) {
    if (n <= 0) return;
    const int kq = lane >> 4;
    bf16x8 kf[2][4];
    int dcur = desc(0);
    { const int pos0 = SLC ? (dcur & 0xfffff) : dcur; const bf16_t* kp = KF + ((size_t)(pos0 >> 4) * 256 + lane) * 8;
#pragma unroll
      for (int T = 0; T < 2; ++T)
#pragma unroll
          for (int s2 = 0; s2 < 4; ++s2) kf[T][s2] = *(const bf16x8*)(kp + (T * 4 + s2) * 512); }
#pragma unroll 1
    for (int i = 0; i < n; ++i) {
        const int pos0 = SLC ? (dcur & 0xfffff) : dcur;
        const int lo = SLC ? ((((dcur >> 20) == qi) | ((dcur >> 20) == 4)) ? 0 : (1 << 30)) : lo_in;
        bf16x8 vf[8];
        if (MODE != 1) { const bf16_t* vp = VF + ((size_t)(pos0 >> 5) * 512 + lane) * 8;
#pragma unroll
          for (int db = 0; db < 8; ++db) vf[db] = *(const bf16x8*)(vp + db * 512); }
        f32x4 sa[2] = {(f32x4){0.f, 0.f, 0.f, 0.f}, (f32x4){0.f, 0.f, 0.f, 0.f}};
#pragma unroll
        for (int T = 0; T < 2; ++T)
#pragma unroll
            for (int s2 = 0; s2 < 4; ++s2) sa[T] = __builtin_amdgcn_mfma_f32_16x16x32_bf16(kf[T][s2], qf[s2], sa[T], 0, 0, 0);
        const int dnext = desc(i + 1 < n ? i + 1 : i);
        { const int pn = SLC ? (dnext & 0xfffff) : dnext; const bf16_t* kp = KF + ((size_t)(pn >> 4) * 256 + lane) * 8;
#pragma unroll
          for (int T = 0; T < 2; ++T)
#pragma unroll
              for (int s2 = 0; s2 < 4; ++s2) kf[T][s2] = *(const bf16x8*)(kp + (T * 4 + s2) * 512); }
        float sc[8]; bool vd[8]; float mx = -1e30f;
#pragma unroll
        for (int T = 0; T < 2; ++T)
#pragma unroll
            for (int r = 0; r < 4; ++r) { const int p = pos0 + 16 * T + 4 * kq + r; const bool v = (p >= lo) & (p <= hi); const float x = sa[T][r] * SL2;
                sc[4 * T + r] = x; vd[4 * T + r] = v; mx = v ? fmaxf(mx, x) : mx; }
        float p[8];
        if (MODE == 2) {
            const int l16 = lane & 15;
#pragma unroll
            for (int j = 0; j < 8; ++j) p[j] = vd[j] ? __builtin_amdgcn_exp2f(sc[j] - st.m) * st.l : 0.f;
#pragma unroll
            for (int T = 0; T < 2; ++T) {
                float x = 2.f * (p[4 * T] + p[4 * T + 1] + p[4 * T + 2]) + p[4 * T + 3], y = p[4 * T + 3];
                x += __shfl_xor(x, 1); x += __shfl_xor(x, 2); y += __shfl_xor(y, 1); y += __shfl_xor(y, 2);
                if ((l16 & 3) == 0) { const int a = (pos0 >> 2) + 4 * T + kq; LAS float* ip = imp + (l16 >> 2) * IMP_LD + a;
                    ip[0] += x;
                    asm volatile("s_waitcnt lgkmcnt(0)" ::: "memory");
                    ip[1] += y; }
                asm volatile("s_waitcnt lgkmcnt(0)" ::: "memory");
            }
        } else {
            if (__builtin_amdgcn_ballot_w64(mx > st.m + 40.f) != 0ull) {
                mx = fmaxf(mx, __shfl_xor(mx, 16)); mx = fmaxf(mx, __shfl_xor(mx, 32));
                const float mn = fmaxf(st.m, mx), alpha = __builtin_amdgcn_exp2f(st.m - mn); st.m = mn; st.l *= alpha;
                if (MODE == 0) {
#pragma unroll
                    for (int j = 0; j < 8; ++j) st.o[j] = st.o[j] * alpha;
                }
            }
            float ps = 0.f;
#pragma unroll
            for (int j = 0; j < 8; ++j) { p[j] = vd[j] ? __builtin_amdgcn_exp2f(sc[j] - st.m) : 0.f; ps += p[j]; }
            st.l += ps;
        }
        if (MODE != 1) {
            u32x4 pw; pw.x = cvt_pk_bf16(p[0], p[1]); pw.y = cvt_pk_bf16(p[2], p[3]); pw.z = cvt_pk_bf16(p[4], p[5]); pw.w = cvt_pk_bf16(p[6], p[7]);
            const bf16x8 pf = __builtin_bit_cast(bf16x8, pw);
#pragma unroll
            for (int db = 0; db < 8; ++db) st.o[db] = __builtin_amdgcn_mfma_f32_16x16x32_bf16(vf[db], pf, st.o[db], 0, 0, 0);
        }
        dcur = dnext;
    }
}
__device__ __forceinline__ float quad_total(float v) { v += __shfl_xor(v, 16); v += __shfl_xor(v, 32); return v; }

__device__ __forceinline__ void dilated_unit(int unit, const bf16_t* proj, bf16_t* nsaout, LAS unsigned char* vbuf, int lane) {
    const int l16 = lane & 15, kq = lane >> 4;
    const int hg = unit & 3, r16 = (unit >> 2) & 15, ut = unit >> 6;
    const int t0 = r16 + 256 * ut, tc = t0 + 16 * l16;
    AState st; astate_init(st);
#pragma unroll 1
    for (int pt = 0; pt < 3; ++pt) {
        const int d = pt == 0 ? 1 : (pt == 1 ? 4 : 16), head = 4 * pt + hg;
        const bf16_t* qrow = proj + (size_t)tc * PLD + PC_QB + head * 128 + 8 * kq;
        bf16x8 qf[4];
#pragma unroll
        for (int s = 0; s < 4; ++s) qf[s] = *(const bf16x8*)(qrow + 32 * s);
        const int nk = 129 + 240 / d, nsteps = (nk + 31) >> 5;
        const int lo = tc - 128 * d < 0 ? 0 : tc - 128 * d, hi = tc;
        const int base = t0 - 128 * d;
        const int i0 = base < 0 ? (-base + d - 1) / (32 * d) : 0;
        auto desc = [&](int i) { return base + 32 * d * (i0 + i); };
        attn_run<0, false>(qf, proj + PC_KB + head * 128, proj + PC_VB + head * 128, PLD, d, S - 1, desc, nsteps - i0, lo, hi, 0, st, vbuf, lane);
    }
    const float lt = quad_total(st.l), inv = lt > 0.f ? 1.f / lt : 0.f;
    bf16_t* op = nsaout + (size_t)tc * NOLD + 1024 + hg * 128 + 4 * kq;
#pragma unroll
    for (int db = 0; db < 8; ++db) { const f32x4 o = st.o[db] * inv; u32x2 w; w.x = cvt_pk_bf16(o[0], o[1]); w.y = cvt_pk_bf16(o[2], o[3]); *(u32x2*)(op + 16 * db) = w; }
}

__device__ __forceinline__ void compress_unit(int unit, const bf16_t* proj, const bf16_t* w1t, const bf16_t* w2t, const float* bias, bf16_t* outc, LAS unsigned char* scr, int lane) {
    const int l16 = lane & 15, kq = lane >> 4;
    const int rt = unit & 63, g = (unit >> 6) & 1, kv = unit >> 7;
    const bf16_t* raw = proj + (kv ? PC_VC : PC_KC) + 128 * g;
    const int n = 16 * rt + l16;
    f32x4 acc[16];
#pragma unroll
    for (int i = 0; i < 16; ++i) acc[i] = (f32x4){0.f, 0.f, 0.f, 0.f};
#pragma unroll 2
    for (int s = 0; s < 128; ++s) {
        const int tok = clampi(16 * n + (s >> 2), 0, S - 1);
        const bf16x8 af = *(const bf16x8*)(raw + (size_t)tok * PLD + (s & 3) * 32 + 8 * kq);
#pragma unroll
        for (int ct = 0; ct < 16; ++ct) { const bf16x8 bfr = *(const bf16x8*)(w1t + (size_t)(16 * ct + l16) * 4096 + 32 * s + 8 * kq);
            acc[ct] = __builtin_amdgcn_mfma_f32_16x16x32_bf16(af, bfr, acc[ct], 0, 0, 0); }
    }
#pragma unroll
    for (int ct = 0; ct < 16; ++ct) { const float bb = bias[16 * ct + l16];
#pragma unroll
        for (int r = 0; r < 4; ++r) { const float x = acc[ct][r] + bb; const float u2 = 1.5957691216f * (x + 0.044715f * x * x * x); const float gl = x * fsigmoid(u2);
            *(LAS bf16_t*)(scr + (4 * kq + r) * 528 + (16 * ct + l16) * 2) = (bf16_t)(cvt_pk_bf16(gl, 0.f) & 0xffffu); } }
    asm volatile("s_waitcnt lgkmcnt(0)" ::: "memory");
    f32x4 o2[8];
#pragma unroll
    for (int i = 0; i < 8; ++i) o2[i] = (f32x4){0.f, 0.f, 0.f, 0.f};
#pragma unroll
    for (int s = 0; s < 8; ++s) {
        const bf16x8 af = *(const LAS bf16x8*)(scr + l16 * 528 + (32 * s + 8 * kq) * 2);
#pragma unroll
        for (int dt = 0; dt < 8; ++dt) { const bf16x8 bfr = *(const bf16x8*)(w2t + (size_t)(16 * dt + l16) * 256 + 32 * s + 8 * kq);
            o2[dt] = __builtin_amdgcn_mfma_f32_16x16x32_bf16(af, bfr, o2[dt], 0, 0, 0); }
    }
    asm volatile("s_waitcnt lgkmcnt(0)" ::: "memory");
#pragma unroll
    for (int dt = 0; dt < 8; ++dt)
#pragma unroll
        for (int r = 0; r < 4; ++r) { const int nn = 16 * rt + 4 * kq + r, d = 16 * dt + l16;
            const bf16_t val = (bf16_t)(cvt_pk_bf16(o2[dt][r], 0.f) & 0xffffu);
            if (kv == 0) outc[(((size_t)g * 64 + (nn >> 4)) * 4 + (d >> 5)) * 512 + (((d >> 3) & 3) * 16 + (nn & 15)) * 8 + (d & 7)] = val;
            else { const int kp = nn & 31; outc[(((size_t)g * 32 + (nn >> 5)) * 8 + (d >> 4)) * 512 + ((((kp >> 2) & 3) * 16) + (d & 15)) * 8 + 4 * (kp >> 4) + (kp & 3)] = val; } }
}

__device__ __forceinline__ void nsa_unit(int unit, const bf16_t* proj, const bf16_t* kc, const bf16_t* vc, const bf16_t* gn, const float* cs, const float* sn,
                                         const bf16_t* kslf, const bf16_t* vslf, const bf16_t* kwnf, const bf16_t* vwnf, bf16_t* nsaout, LAS unsigned char* wl, int lane) {
    const int l16 = lane & 15, kq = lane >> 4;
    const int g = unit & 1, tb = unit >> 1, t0 = 4 * tb, qi = l16 >> 2, h = l16 & 3, tc = t0 + qi, head = 4 * g + h;
    LAS unsigned char* vbuf = wl; LAS float* imp = (LAS float*)(wl + VBUF_BYTES); LAS int* sel = (LAS int*)(wl + VBUF_BYTES + 4 * IMP_LD * 4);
    bf16x8 qf[4];
    { const bf16_t* qrow = proj + (size_t)tc * PLD + PC_QA + head * 128 + 8 * kq;
#pragma unroll
        for (int s = 0; s < 4; ++s) qf[s] = *(const bf16x8*)(qrow + 32 * s); }
    LAS u32x2* outl = (LAS u32x2*)(wl + OUT_OFF) + lane;
    for (int i = lane; i < 4 * IMP_LD; i += 64) imp[i] = 0.f;
    const int hic = (tc - 31) >> 4;
    const int nkmax = ((t0 + 3 - 31) >> 4) + 1, nsc = nkmax > 0 ? (nkmax + 31) >> 5 : 0;
    unsigned long long coff = (unsigned long long)g * 1024 * 128; asm volatile("" : "+s"(coff));
    const bf16_t* kcg = kc + coff; const bf16_t* vcg = vc + coff;
    AState st; astate_init(st);
    { auto desc = [&](int i) { return 32 * i; };
      attn_run_frag<1, false>(qf, kcg, vcg, desc, nsc, 0, hic, 0, st, lane);
      { const float lt = quad_total(st.l); st.l = lt > 0.f ? 1.f / lt : 0.f; }
      asm volatile("s_waitcnt lgkmcnt(0)" ::: "memory");
      attn_run_frag<2, false>(qf, kcg, vcg, desc, nsc, 0, hic, 0, st, lane, imp); }
    const float g0 = bf2f(gn[(size_t)tc * 32 + head * 3 + 0]);
#pragma unroll
    for (int i = 0; i < 8; ++i) { const f32x4 o = st.o[i] * g0; u32x2 w; w.x = cvt_pk_bf16(o[0], o[1]); w.y = cvt_pk_bf16(o[2], o[3]); outl[64 * i] = w; }
    asm volatile("s_waitcnt lgkmcnt(0)" ::: "memory");
#pragma unroll
    for (int s2 = 0; s2 < 2; ++s2) {
        const int d = 32 * s2 + 8 * kq; f32x4 c[2], sv[2];
        c[0] = *(const f32x4*)(cs + (size_t)tc * 64 + d); c[1] = *(const f32x4*)(cs + (size_t)tc * 64 + d + 4);
        sv[0] = *(const f32x4*)(sn + (size_t)tc * 64 + d); sv[1] = *(const f32x4*)(sn + (size_t)tc * 64 + d + 4);
        float o1[8], o2[8];
#pragma unroll
        for (int j = 0; j < 8; ++j) { const float x1 = bf2f((unsigned short)qf[s2][j]), x2 = bf2f((unsigned short)qf[s2 + 2][j]), cc = c[j >> 2][j & 3], ss = sv[j >> 2][j & 3];
            o1[j] = x1 * cc - x2 * ss; o2[j] = x2 * cc + x1 * ss; }
        u32x4 w1, w2; w1.x = cvt_pk_bf16(o1[0], o1[1]); w1.y = cvt_pk_bf16(o1[2], o1[3]); w1.z = cvt_pk_bf16(o1[4], o1[5]); w1.w = cvt_pk_bf16(o1[6], o1[7]);
        w2.x = cvt_pk_bf16(o2[0], o2[1]); w2.y = cvt_pk_bf16(o2[2], o2[3]); w2.z = cvt_pk_bf16(o2[4], o2[5]); w2.w = cvt_pk_bf16(o2[6], o2[7]);
        qf[s2] = __builtin_bit_cast(bf16x8, w1); qf[s2 + 2] = __builtin_bit_cast(bf16x8, w2);
    }
    unsigned key[4][4];
#pragma unroll
    for (int q = 0; q < 4; ++q) { const int cur = (t0 + q) >> 6; const f32x4 v = *(const LAS f32x4*)(imp + q * IMP_LD + 4 * lane);
#pragma unroll
        for (int i = 0; i < 4; ++i) { const int j = 4 * lane + i; const bool valid = j <= cur, forced = (j == 0) | (j == cur) | (j == cur - 1);
            const unsigned kb = forced ? 0xffffffu : ((__float_as_uint(fmaxf(v[i], 0.f)) >> 8) + 1u);
            key[q][i] = valid ? ((kb << 8) | (unsigned)(255 - j)) : 0u; } }
#pragma unroll 1
    for (int r = 0; r < 16; ++r) {
        unsigned mx[4];
#pragma unroll
        for (int q = 0; q < 4; ++q) { unsigned a = key[q][0] > key[q][1] ? key[q][0] : key[q][1], b = key[q][2] > key[q][3] ? key[q][2] : key[q][3]; mx[q] = a > b ? a : b; }
#pragma unroll
        for (int o = 1; o < 64; o <<= 1)
#pragma unroll
            for (int q = 0; q < 4; ++q) { const unsigned other = (unsigned)__shfl_xor((int)mx[q], o); mx[q] = other > mx[q] ? other : mx[q]; }
#pragma unroll
        for (int q = 0; q < 4; ++q) {
#pragma unroll
            for (int i = 0; i < 4; ++i) if (key[q][i] == mx[q]) key[q][i] = 0u;
            if (lane == 0) sel[q * 16 + r] = mx[q] ? (int)(255u - (mx[q] & 255u)) : -1;
        }
    }
    asm volatile("s_waitcnt lgkmcnt(0)" ::: "memory");
    LAS int* list = (LAS int*)(wl + VBUF_BYTES + 4 * IMP_LD * 4 + 256);
    int nslc;
    { const int b = sel[lane], q = lane >> 4, cur0 = t0 >> 6;
      const bool forced = (b == 0) | (b == cur0) | (b == cur0 - 1);
      const bool valid = (b >= 0) & !(forced & (q > 0)); const unsigned long long mask = __ballot(valid);
      const int idx = __popcll(mask & ((1ull << lane) - 1ull)); nslc = 2 * __popcll(mask);
      if (valid) { const int qc = forced ? 4 : q; list[2 * idx] = (64 * b) | (qc << 20); list[2 * idx + 1] = (64 * b + 32) | (qc << 20); } }
    asm volatile("s_waitcnt lgkmcnt(0)" ::: "memory");
    astate_init(st);
    { auto desc = [&](int i) { return __builtin_amdgcn_readfirstlane(list[i]); };
      unsigned long long goff = (unsigned long long)g * S * 128; asm volatile("" : "+s"(goff));
      attn_run_frag<0, true>(qf, kslf + goff, vslf + goff, desc, nslc, 0, tc, qi, st, lane); }
    { const float g1 = bf2f(gn[(size_t)tc * 32 + head * 3 + 1]); const float lt = quad_total(st.l), inv = (lt > 0.f ? 1.f / lt : 0.f) * g1;
#pragma unroll
        for (int i = 0; i < 8; ++i) { const f32x4 o = st.o[i] * inv; u32x2 w = outl[64 * i]; w.x = cvt_pk_bf16(bflo(w.x) + o[0], bfhi(w.x) + o[1]); w.y = cvt_pk_bf16(bflo(w.y) + o[2], bfhi(w.y) + o[3]); outl[64 * i] = w; } }
    astate_init(st);
    { const int lo = tc - 511 < 0 ? 0 : tc - 511; const int first = t0 < 511 ? 0 : (t0 - 511) >> 5, last = (t0 + 3) >> 5;
      auto desc = [&](int i) { return 32 * (first + i); };
      unsigned long long goff = (unsigned long long)g * S * 128; asm volatile("" : "+s"(goff));
      attn_run_frag<0, false>(qf, kwnf + goff, vwnf + goff, desc, last - first + 1, lo, tc, 0, st, lane); }
    { const float g2 = bf2f(gn[(size_t)tc * 32 + head * 3 + 2]); const float lt = quad_total(st.l), inv = (lt > 0.f ? 1.f / lt : 0.f) * g2;
#pragma unroll
        for (int i = 0; i < 8; ++i) { const f32x4 o = st.o[i] * inv; u32x2 w = outl[64 * i]; w.x = cvt_pk_bf16(bflo(w.x) + o[0], bfhi(w.x) + o[1]); w.y = cvt_pk_bf16(bflo(w.y) + o[2], bfhi(w.y) + o[3]); outl[64 * i] = w; } }
    bf16_t* op = nsaout + (size_t)tc * NOLD + head * 128 + 4 * kq;
#pragma unroll
    for (int db = 0; db < 8; ++db) *(u32x2*)(op + 16 * db) = outl[64 * db];
}


#define XB_TMO      128
#define XB_XCNT(j)  (256  + 64 * (j))
#define XB_XSUB(j)  (1280 + 64 * (j))
#define XB_XGEN(j)  (2304 + 64 * (j))
#define XB_TOP      3328
#define XB_TOPGEN   3392
#define XCD_BAR_WORDS 3456
#define XB_SPIN_CAP (1u << 18)
__device__ __forceinline__ unsigned xb_ld(unsigned* p)              { return __hip_atomic_load(p, __ATOMIC_RELAXED, __HIP_MEMORY_SCOPE_AGENT); }
__device__ __forceinline__ unsigned xb_add(unsigned* p, unsigned v) { return __hip_atomic_fetch_add(p, v, __ATOMIC_RELAXED, __HIP_MEMORY_SCOPE_AGENT); }
__device__ __forceinline__ unsigned xb_xcc_id() { return (unsigned)__builtin_amdgcn_s_getreg((3 << 11) | 20) & 0xFu; }
#define XB_SPIN(cond, bar) do { unsigned _sp = 0; while (cond) { __builtin_amdgcn_s_sleep(1); \
    if ((++_sp & 255u) == 0u) { if (xb_ld(&(bar)[XB_TMO])) break; if (_sp > XB_SPIN_CAP) { atomicAdd(&(bar)[XB_TMO], 1u); break; } } } } while (0)
struct XcdBarrier { unsigned* bar; unsigned x; volatile LAS unsigned* st; };
__device__ __forceinline__ XcdBarrier xcd_barrier_post(unsigned* bar, volatile LAS unsigned* st) {
    XcdBarrier b; b.bar = bar; b.x = xb_xcc_id(); b.st = st;
    if (threadIdx.x == 0) (void)xb_add(&bar[XB_XCNT(b.x)], 1u);
    return b;
}
__device__ __forceinline__ void xcd_barrier_complete(unsigned* bar, unsigned x, unsigned& nloc, unsigned& nx) {
    const unsigned G = gridDim.x * gridDim.y * gridDim.z;
    unsigned sum, cnt, mine, sp = 0u;
    for (;;) {
        sum = 0u; cnt = 0u; mine = 0u;
#pragma unroll
        for (unsigned j = 0; j < 16; ++j) { const unsigned c = xb_ld(&bar[XB_XCNT(j)]); sum += c; cnt += (c > 0u) ? 1u : 0u; mine = (j == x) ? c : mine; }
        if (sum == G) break;
        __builtin_amdgcn_s_sleep(1);
        if ((++sp & 255u) == 0u) { if (xb_ld(&bar[XB_TMO])) break; if (sp > XB_SPIN_CAP) { atomicAdd(&bar[XB_TMO], 1u); break; } }
    }
    nloc = mine > 0u ? mine : 1u; nx = cnt > 0u ? cnt : 1u;
}
__device__ __forceinline__ void xcd_barrier(const XcdBarrier& b, const int tid) {
    asm volatile("s_waitcnt vmcnt(0)" ::: "memory");
    __syncthreads();
    if (tid == 0) {
        unsigned* bar = b.bar;
        __builtin_amdgcn_s_waitcnt(0);
        unsigned nloc = b.st[0], nx = b.st[1];
        if (nloc == 0u) { xcd_barrier_complete(bar, b.x, nloc, nx); b.st[0] = nloc; b.st[1] = nx; }
        const unsigned old = xb_add(&bar[XB_XSUB(b.x)], 1u);
        const unsigned gen = old / nloc;
        if (old + 1u == (gen + 1u) * nloc) {
            __builtin_amdgcn_fence(__ATOMIC_RELEASE, "agent");
            asm volatile("s_waitcnt vmcnt(0)" ::: "memory");
            const unsigned og = xb_add(&bar[XB_TOP], 1u);
            const unsigned tg = og / nx;
            if (og + 1u == (tg + 1u) * nx) xb_add(&bar[XB_TOPGEN], 1u);
            else XB_SPIN(xb_ld(&bar[XB_TOPGEN]) == tg, bar);
            __builtin_amdgcn_fence(__ATOMIC_ACQUIRE, "agent");
            xb_add(&bar[XB_XGEN(b.x)], 1u);
            asm volatile("s_waitcnt vmcnt(0)" ::: "memory");
        } else {
            XB_SPIN(xb_ld(&bar[XB_XGEN(b.x)]) == gen, bar);
            __builtin_amdgcn_fence(__ATOMIC_ACQUIRE, "agent");
            asm volatile("s_waitcnt vmcnt(0)" ::: "memory");
        }
    }
    __syncthreads();
}

struct Params { const float* in[23]; float* out; unsigned char* ws; float inv_freq[64]; };

__global__ void __launch_bounds__(512, 2) fwd_megakernel(Params P) {
    extern __shared__ __attribute__((aligned(16))) unsigned char lds_raw[];
    LAS unsigned char* lds = (LAS unsigned char*)lds_raw;
    cg::grid_group grid = cg::this_grid();
    const int wave_s = __builtin_amdgcn_readfirstlane(threadIdx.x >> 6);
#define PHASE_WS unsigned long long wsv_ = (unsigned long long)P.ws; asm volatile("" : "+s"(wsv_)); unsigned char* ws = (unsigned char*)(__attribute__((address_space(1))) unsigned char*)wsv_; unsigned z_ = 0u; asm volatile("" : "+v"(z_)); const int tid = wave_s * 64 + (int)__builtin_amdgcn_mbcnt_hi(~0u, __builtin_amdgcn_mbcnt_lo(~0u, z_)); \
    const int lane = tid & 63, wave = __builtin_amdgcn_readfirstlane(tid >> 6), G = gridDim.x, gw = blockIdx.x * 8 + wave, ngw = G * 8; \
    const size_t gtid = (size_t)blockIdx.x * 512 + tid, gthreads = (size_t)G * 512; \
    LAS unsigned char* wl = lds + wave * WAVE_LDS; LAS float* scr = (LAS float*)wl; (void)lane; (void)gw; (void)ngw; (void)gtid; (void)gthreads; (void)wl; (void)scr
#define WAB ((bf16_t*)(ws + WS_WAB))
#define WO ((bf16_t*)(ws + WS_WO))
#define CW1K ((bf16_t*)(ws + WS_CW1K))
#define CW1V ((bf16_t*)(ws + WS_CW1V))
#define CW2K ((bf16_t*)(ws + WS_CW2K))
#define CW2V ((bf16_t*)(ws + WS_CW2V))
#define CBIAS ((float*)(ws + WS_CBIAS))
#define KC ((bf16_t*)(ws + WS_KC))
#define VC ((bf16_t*)(ws + WS_VC))
#define GN ((bf16_t*)(ws + WS_GN))
#define HF ((float*)(ws + WS_HF))
#define HB ((bf16_t*)(ws + WS_HB))
#define GU ((bf16_t*)(ws + WS_GU))
#define DN ((bf16_t*)(ws + WS_DN))
#define ACT ((bf16_t*)(ws + WS_ACT))
#define PROJ ((bf16_t*)(ws + WS_PROJ))
#define KSLF ((bf16_t*)(ws + WS_KSLF))
#define VSLF ((bf16_t*)(ws + WS_VSLF))
#define KWNF ((bf16_t*)(ws + WS_KWNF))
#define VWNF ((bf16_t*)(ws + WS_VWNF))
#define RCOS ((float*)(ws + WS_ROPE))
#define RSIN ((float*)(ws + WS_ROPE) + (size_t)S * 64)
#define WINT ((bf16_t*)(ws + WS_WIN))
#define NSAOUT ((bf16_t*)(ws + WS_NSAOUT))
#define SIGG ((bf16_t*)P.out)
    pg8::StaticOrder SO;
#define CG_SYNC() do { asm volatile("s_waitcnt vmcnt(0) lgkmcnt(0)" ::: "memory"); grid.sync(); \
        if (__builtin_amdgcn_readfirstlane(threadIdx.x >> 6) == 0) { __builtin_amdgcn_fence(__ATOMIC_ACQUIRE, "agent"); asm volatile("s_waitcnt vmcnt(0)" ::: "memory"); } \
        __syncthreads(); } while (0)
    volatile LAS unsigned* xst = (volatile LAS unsigned*)(lds + 8 * WAVE_LDS);
    if (threadIdx.x < 2) xst[threadIdx.x] = 0u;
    __syncthreads();
    const XcdBarrier xbar = xcd_barrier_post((unsigned*)P.ws, xst);
#define GRID_SYNC() do { asm volatile("s_waitcnt vmcnt(0) lgkmcnt(0)" ::: "memory"); unsigned zz_ = 0u; asm volatile("" : "+v"(zz_)); \
        xcd_barrier(xbar, wave_s * 64 + (int)__builtin_amdgcn_mbcnt_hi(~0u, __builtin_amdgcn_mbcnt_lo(~0u, zz_))); } while (0)

    { PHASE_WS;
        conv_ffn(P.in[1], P.in[2], P.in[3], GU, DN, scr, gw, ngw, lane);
        for (int it = gw; it < 32 * 360; it += ngw) { const int kb = it / 360, nb = it % 360, dr = nb * 32; const int sc = win_src_col(dr);
            tr_item(P.in[6], WIN_SRC, kb * 64, sc < 0 ? 0 : sc, sc < 0 ? 0 : (dr == 11264 ? 24 : 32), WINT, DM, dr, kb * 64, scr, lane); }
        for (int it = gw; it < 16 * 64; it += ngw) { const int kb = it / 64, nb = it % 64; tr_item(P.in[13], DM, kb * 64, nb * 32, 32, WAB, 1024, nb * 32, kb * 64, scr, lane); }
        for (int it = gw; it < 8 * 64; it += ngw) { const int kb = it / 64, nb = it % 64; tr_item(P.in[14], DM, kb * 64, nb * 32, 32, WAB + (size_t)DM * 1024, 512, nb * 32, kb * 64, scr, lane); }
        for (int it = gw; it < 32 * 64; it += ngw) { const int kb = it / 64, nb = it % 64; tr_item(P.in[15], DM, kb * 64, nb * 32, 32, WO, DM, nb * 32, kb * 64, scr, lane); }
        for (int it = gw; it < 2 * 64 * 8; it += ngw) { const int w = it / 512, r = it % 512, kb = r / 8, nb = r % 8; tr_item(w ? P.in[11] : P.in[8], 256, kb * 64, nb * 32, 32, w ? CW1V : CW1K, 4096, nb * 32, kb * 64, scr, lane); }
        for (int it = gw; it < 2 * 4 * 4; it += ngw) { const int w = it / 16, r = it % 16, kb = r / 4, nb = r % 4; tr_item(w ? P.in[12] : P.in[9], 128, kb * 64, nb * 32, 32, w ? CW2V : CW2K, 256, nb * 32, kb * 64, scr, lane); }
        { const float* x = P.in[0];
            for (size_t i = gtid; i < (size_t)S * DM / 8; i += gthreads) { const f32x4 a = *(const f32x4*)(x + 8 * i), b = *(const f32x4*)(x + 8 * i + 4); *(u32x4*)(HB + 8 * i) = pack8(a, b); } }
        for (int o = gw; o < 512; o += ngw) { const int w = o >> 8, c = o & 255; const float* pos = w ? P.in[10] : P.in[7]; const float* w1 = w ? P.in[11] : P.in[8];
            float s = 0.f; for (int kk = lane; kk < 4096; kk += 64) s += pos[kk] * w1[(size_t)kk * 256 + c];
            s = wave_sum(s); if (lane == 0) CBIAS[o] = s; }
    }
    CG_SYNC();
    { PHASE_WS; pg8::Gemm g{HB, GU, S, NGU, DM, DM, DM}; SO.init(S, NGU, G, (int)blockIdx.x); EpiSwiglu E{ACT}; pg8::gemm_phase(lds, g, SO, E, tid); }
    GRID_SYNC();
    { PHASE_WS; pg8::Gemm g{ACT, DN, S, DM, FF, FF, FF}; SO.init(S, DM, G, (int)blockIdx.x); EpiResF32 E{P.in[0], HF, ALPHA, 0.5f}; pg8::gemm_phase(lds, g, SO, E, tid); }
    GRID_SYNC();
    { PHASE_WS;
        ln_rows(HF, HF, HB, P.in[4], P.in[5], gw, ngw, lane);
        for (size_t i = gtid; i < (size_t)S * 64; i += gthreads) { const int t = (int)(i >> 6), j = (int)(i & 63); const float ang = (float)t * P.inv_freq[j]; RCOS[i] = cosf(ang); RSIN[i] = sinf(ang); }
    }
    GRID_SYNC();
    { PHASE_WS; pg8::Gemm g{HB, WINT, S, NWIN, DM, DM, DM}; SO.init(S, NWIN, G, (int)blockIdx.x); EpiWin E{PROJ, SIGG, GN, RCOS, KSLF}; pg8::gemm_phase(lds, g, SO, E, tid); }
    GRID_SYNC();
    { PHASE_WS;
        if (wave == 0) { for (int u = blockIdx.x; u < 256; u += G) { const int kv = u >> 7; compress_unit(u, PROJ, kv ? CW1V : CW1K, kv ? CW2V : CW2K, CBIAS + 256 * kv, kv ? VC : KC, wl, lane); } }
        else { for (int u = blockIdx.x * 7 + (wave - 1); u < 4096; u += G * 7) dilated_unit(u, PROJ, NSAOUT, wl, lane); }
    }
    GRID_SYNC();
    { PHASE_WS;
      if ((G & 7) == 0) {
          const int bx = blockIdx.x, x = bx & 7, g = x & 1, wj = ((bx >> 3) * 4 + (x >> 1)) * 8 + wave, nwj = (G >> 1) * 8;
          for (int tb = wj; tb < 4096; tb += nwj) nsa_unit(2 * tb + g, PROJ, KC, VC, GN, RCOS, RSIN, KSLF, VSLF, KWNF, VWNF, NSAOUT, wl, lane);
      } else { for (int u = gw; u < 8192; u += ngw) nsa_unit(u, PROJ, KC, VC, GN, RCOS, RSIN, KSLF, VSLF, KWNF, VWNF, NSAOUT, wl, lane); } }
    GRID_SYNC();
    { PHASE_WS; SO.init(S, DM, G, (int)blockIdx.x);
      { pg8::Gemm g{NSAOUT, WAB, S, DM, 1024, NOLD, 1024}; EpiGate<true> E{SIGG, HB}; pg8::gemm_phase(lds, g, SO, E, tid); }
      { pg8::Gemm g{NSAOUT + 1024, WAB + (size_t)DM * 1024, S, DM, 512, NOLD, 512}; EpiGate<false> E{SIGG + 2048, HB}; pg8::gemm_phase(lds, g, SO, E, tid); } }
    GRID_SYNC();
    { PHASE_WS; pg8::Gemm g{HB, WO, S, DM, DM, DM, DM}; SO.init(S, DM, G, (int)blockIdx.x); EpiResF32 E{HF, HF, ALPHA, 1.0f}; pg8::gemm_phase(lds, g, SO, E, tid); }
    GRID_SYNC();
    { PHASE_WS;
        ln_rows(HF, HF, HB, P.in[16], P.in[17], gw, ngw, lane);
        conv_ffn(P.in[18], P.in[19], P.in[20], GU, DN, scr, gw, ngw, lane);
    }
    GRID_SYNC();
    { PHASE_WS; pg8::Gemm g{HB, GU, S, NGU, DM, DM, DM}; SO.init(S, NGU, G, (int)blockIdx.x); EpiSwiglu E{ACT}; pg8::gemm_phase(lds, g, SO, E, tid); }
    GRID_SYNC();
    { PHASE_WS; pg8::Gemm g{ACT, DN, S, DM, FF, FF, FF}; SO.init(S, DM, G, (int)blockIdx.x); EpiResF32 E{HF, P.out, ALPHA, 0.5f}; pg8::gemm_phase(lds, g, SO, E, tid); }
    GRID_SYNC();
    { PHASE_WS; (void)ws; ln_rows(P.out, P.out, nullptr, P.in[21], P.in[22], gw, ngw, lane); }
}

extern "C" void kernel_launch(void* const* d_in, const int* in_sizes, int n_in, void* d_out, int out_size, void* d_ws, size_t ws_size, hipStream_t stream) {
    static int grid = 0;
    if (grid == 0) {
        if (n_in != 23 || out_size != S * DM || ws_size < WS_END) { fprintf(stderr, "kernel_launch: unexpected shapes (n_in %d out %d ws %zu, need %zu)\n", n_in, out_size, ws_size, (size_t)WS_END); grid = -1; return; }
        int dev = 0, cus = 0, per_cu = 0;
        hipGetDevice(&dev); hipDeviceGetAttribute(&cus, hipDeviceAttributeMultiprocessorCount, dev);
        if (hipFuncSetAttribute((const void*)fwd_megakernel, hipFuncAttributeMaxDynamicSharedMemorySize, LDS_BYTES) != hipSuccess) { fprintf(stderr, "kernel_launch: hipFuncSetAttribute failed\n"); grid = -1; return; }
        if (hipOccupancyMaxActiveBlocksPerMultiprocessor(&per_cu, (const void*)fwd_megakernel, 512, LDS_BYTES) != hipSuccess || per_cu < 1) { fprintf(stderr, "kernel_launch: occupancy query failed (%d)\n", per_cu); (void)hipGetLastError(); per_cu = 1; }
        grid = cus * per_cu;
    }
    if (grid < 0) return;
    if (hipMemsetAsync(d_ws, 0, 16384, stream) != hipSuccess) { fprintf(stderr, "kernel_launch: memset of the barrier words failed\n"); return; }
    Params p{};
    for (int i = 0; i < 23; ++i) p.in[i] = (const float*)d_in[i];
    p.out = (float*)d_out; p.ws = (unsigned char*)d_ws;
    for (int i = 0; i < 64; ++i) p.inv_freq[i] = (float)pow(10000.0, -(double)i / 64.0);
    void* args[] = {&p};
    hipError_t e = hipLaunchCooperativeKernel((const void*)fwd_megakernel, dim3(grid), dim3(512), args, LDS_BYTES, stream);
    if (e != hipSuccess) fprintf(stderr, "kernel_launch: cooperative launch failed: %s (grid %d)\n", hipGetErrorString(e), grid);
}
```

```cpp
#include <hip/hip_runtime.h>
#include <hip/hip_cooperative_groups.h>
#include <cstdio>
#include <cstdint>
#include <cmath>
namespace cg = cooperative_groups;

#define LAS __attribute__((address_space(3)))
typedef unsigned short bf16_t;
typedef short bf16x8 __attribute__((ext_vector_type(8)));
typedef short s16x4 __attribute__((ext_vector_type(4)));
typedef float f32x4 __attribute__((ext_vector_type(4)));
typedef float f32x2 __attribute__((ext_vector_type(2)));
typedef unsigned u32x4 __attribute__((ext_vector_type(4)));
typedef unsigned u32x2 __attribute__((ext_vector_type(2)));

constexpr int S = 16384, DM = 2048, FF = 5632, NGU = 2 * FF, NWIN = 11520, WIN_SRC = 11288, PLD = 6144, NOLD = 1536;
constexpr float ALPHA = 1.189207115002721f;
constexpr float LN_EPS = 1e-5f;
constexpr float SL2 = 0.08838834764831845f * 1.4426950408889634f;
constexpr int PC_QA = 0, PC_KC = 1024, PC_VC = 1280, PC_QB = 1536, PC_KB = 3072, PC_VB = 4608;
constexpr size_t MiB = 1u << 20;
constexpr size_t WS_WAB = 1 * MiB, WS_WO = 13 * MiB, WS_CW1K = 21 * MiB, WS_CW1V = 23 * MiB, WS_CW2K = 25 * MiB, WS_CW2V = 25 * MiB + 65536, WS_CBIAS = 25 * MiB + 131072;
constexpr size_t WS_KC = 26 * MiB, WS_VC = 26 * MiB + 524288, WS_GN = 27 * MiB;
constexpr size_t WS_HF = 32 * MiB, WS_HB = 160 * MiB, WS_BIG = 224 * MiB;
constexpr size_t WS_GU = WS_BIG, WS_DN = WS_BIG + 44 * MiB, WS_ACT = WS_BIG + 66 * MiB;
constexpr size_t WS_PROJ = WS_BIG, WS_KSLF = WS_BIG + 192 * MiB, WS_VSLF = WS_BIG + 200 * MiB, WS_KWNF = WS_BIG + 208 * MiB, WS_VWNF = WS_BIG + 216 * MiB, WS_ROPE = WS_BIG + 224 * MiB;
constexpr size_t WS_WIN = 466 * MiB, WS_NSAOUT = 466 * MiB, WS_END = 514 * MiB;

constexpr int VROW = 288, VBUF_BYTES = 32 * VROW;
constexpr int IMP_LD = 260;
constexpr int OUT_OFF = VBUF_BYTES + 4 * IMP_LD * 4 + 256 + 512;
constexpr int WAVE_LDS = OUT_OFF + 4096;
constexpr int LDS_BYTES = 147456;
static_assert(8 * WAVE_LDS + 16 <= LDS_BYTES && 131072 <= LDS_BYTES, "LDS map");

typedef __bf16 bf16x2_t __attribute__((ext_vector_type(2)));
__device__ __forceinline__ unsigned cvt_pk_bf16(float lo, float hi) { f32x2 v = {lo, hi}; bf16x2_t b = __builtin_convertvector(v, bf16x2_t); return __builtin_bit_cast(unsigned, b); }
__device__ __forceinline__ float bf2f(unsigned short b) { return __uint_as_float(((unsigned)b) << 16); }
__device__ __forceinline__ float bflo(unsigned w) { return __uint_as_float(w << 16); }
__device__ __forceinline__ float bfhi(unsigned w) { return __uint_as_float(w & 0xffff0000u); }
__device__ __forceinline__ float fsigmoid(float x) { return __builtin_amdgcn_rcpf(1.f + __expf(-x)); }
__device__ __forceinline__ float wave_sum(float v) {
#pragma unroll
    for (int o = 1; o < 64; o <<= 1) v += __shfl_xor(v, o);
    return v;
}
typedef long i64_t;
__device__ __forceinline__ u32x2 pack8_fp8(const f32x4 a, const f32x4 b) {
    unsigned lo = 0u, hi = 0u;
    lo = __builtin_amdgcn_cvt_pk_fp8_f32(a[0], a[1], lo, false); lo = __builtin_amdgcn_cvt_pk_fp8_f32(a[2], a[3], lo, true);
    hi = __builtin_amdgcn_cvt_pk_fp8_f32(b[0], b[1], hi, false); hi = __builtin_amdgcn_cvt_pk_fp8_f32(b[2], b[3], hi, true);
    return (u32x2){lo, hi};
}
__device__ __forceinline__ u32x4 pack8(const f32x4 a, const f32x4 b) { u32x4 w; w.x = cvt_pk_bf16(a[0], a[1]); w.y = cvt_pk_bf16(a[2], a[3]); w.z = cvt_pk_bf16(b[0], b[1]); w.w = cvt_pk_bf16(b[2], b[3]); return w; }

namespace pg8 {
constexpr int BM = 256, BK = 64, HALF = 128, HTB = HALF * BK * 2, STAGE_BYTES = 8 * HTB, NXCD = 8, WGM = 8;
__host__ __device__ __forceinline__ int lds_byte(int r, int c) { const int st = (r >> 4) * 2 + (c >> 5), rr = r & 15, cc = c & 31, ob = rr * 64 + cc * 2; return st * 1024 + (ob ^ (((ob >> 9) & 1) << 5)); }
__host__ __device__ __forceinline__ void stage_rc(int b, int& R, int& C) { const int st = b / 1024, sb = b % 1024, swz = sb ^ (((sb >> 9) & 1) << 5); R = (st >> 1) * 16 + swz / 64; C = (st & 1) * 32 + (swz % 64) / 2; }
__host__ __device__ __forceinline__ int perm32(int rho) { const int n = rho >> 4, i = rho & 15; return 8 * (i >> 2) + 4 * n + (i & 3); }
struct Unit { int pm, pn; };
struct Gemm { const bf16_t* A; const bf16_t* Bt; int M, N, K, lda, ldb; };
struct StaticOrder {
    int nM, nN, nwg, G, c;
    __device__ void init(int M, int N, int G_, int c_) { nM = M / BM; nN = N / BM; nwg = nM * nN; G = G_; c = c_; }
    __device__ bool next(int i, Unit& u) const {
        const long L = (long)i * G + c; if (L >= nwg) return false;
        int wgid = (int)L; { const int q = nwg / NXCD, r = nwg % NXCD, xcd = wgid % NXCD, off = wgid / NXCD; wgid = (xcd < r ? xcd * (q + 1) : r * (q + 1) + (xcd - r) * q) + off; }
        const int nig = WGM * nN, gid = wgid / nig, fm = gid * WGM, gsz = (nM - fm) < WGM ? (nM - fm) : WGM;
        u.pm = fm + ((wgid % nig) % gsz); u.pn = (wgid % nig) / gsz; return true;
    }
};
typedef f32x4 Acc[2][2][4][2];

template <class Epi>
__device__ __forceinline__ void gemm_phase(LAS unsigned char* lds, const Gemm g, const StaticOrder& S_, const Epi& E, const int tid) {
    const int wid = __builtin_amdgcn_readfirstlane(tid >> 6), lane = tid & 63, wr = wid >> 2, wc = wid & 3, fr = lane & 15, fq = lane >> 4;
    const int K = g.K, nt = K / BK;
    unsigned voffA[2], voffB[2];
#pragma unroll
    for (int i = 0; i < 2; ++i) { int R, C; stage_rc(tid * 16 + i * 8192, R, C); const int Rb = Epi::PERM ? ((R & ~31) + perm32(R & 31)) : R;
        voffA[i] = (unsigned)(R * g.lda + C) * 2u; voffB[i] = (unsigned)(Rb * g.ldb + C) * 2u; }
    const size_t kstep = (size_t)(BK * 2);
    const size_t hstepA = (size_t)HALF * g.lda * 2, hstepB = (size_t)HALF * g.ldb * 2;
    const size_t tstepA = 2 * hstepA, tstepB = 2 * hstepB;
    const unsigned ldsw = (unsigned)wid * 1024u;
    const int aoff = lds_byte(wr * 64 + fr, fq * 8), boff = lds_byte(wc * 32 + fr, fq * 8);
#define PG8_SA(b, h) (((b) * 2 + (h)) * HTB)
#define PG8_SB(b, h) ((4 + (b) * 2 + (h)) * HTB)
#define PG8_STAGE(bufoff, gbase, voff) do { _Pragma("unroll") for (int _i = 0; _i < 2; ++_i) \
        __builtin_amdgcn_global_load_lds((const unsigned*)((const char*)(gbase) + (voff)[_i]), (LAS unsigned*)(lds + (bufoff) + ldsw + _i * 8192), 16, 0, 0); } while (0)
#define PG8_LDA(dst, b, h) do { _Pragma("unroll") for (int m = 0; m < 4; ++m) _Pragma("unroll") for (int k = 0; k < 2; ++k) dst[m][k] = *(const LAS bf16x8*)(lds + PG8_SA(b, h) + aoff + m * 2048 + k * 1024); } while (0)
#define PG8_LDB(dst, b, h) do { _Pragma("unroll") for (int n = 0; n < 2; ++n) _Pragma("unroll") for (int k = 0; k < 2; ++k) dst[n][k] = *(const LAS bf16x8*)(lds + PG8_SB(b, h) + boff + n * 2048 + k * 1024); } while (0)
#define PG8_MMA(ai, bj, At, Bt) do { __builtin_amdgcn_s_setprio(1); _Pragma("unroll") for (int m = 0; m < 4; ++m) _Pragma("unroll") for (int n = 0; n < 2; ++n) _Pragma("unroll") for (int k = 0; k < 2; ++k) \
        acc[ai][bj][m][n] = __builtin_amdgcn_mfma_f32_16x16x32_bf16(Bt[n][k], At[m][k], acc[ai][bj][m][n], 0, 0, 0); __builtin_amdgcn_s_setprio(0); } while (0)
#define PG8_WAIT_V(n) asm volatile("s_waitcnt vmcnt(" #n ")" ::: "memory")
#define PG8_WAIT_L(n) asm volatile("s_waitcnt lgkmcnt(" #n ")" ::: "memory")
#define PG8_BAR __builtin_amdgcn_s_barrier()
#define PG8_SCHED __builtin_amdgcn_sched_barrier(0)
    Unit cur, nxt; int ui = 0;
    if (!S_.next(0, cur)) return;
    Acc acc;
#pragma unroll
    for (int a = 0; a < 2; ++a)
#pragma unroll
        for (int b = 0; b < 2; ++b)
#pragma unroll
            for (int m = 0; m < 4; ++m)
#pragma unroll
                for (int n = 0; n < 2; ++n) acc[a][b][m][n] = (f32x4){0.f, 0.f, 0.f, 0.f};
    bf16x8 At[4][2], B0[2][2], B1[2][2];
    const char* cA = (const char*)g.A + (size_t)cur.pm * tstepA; const char* cB = (const char*)g.Bt + (size_t)cur.pn * tstepB;
    PG8_STAGE(PG8_SB(0, 0), cB, voffB); PG8_STAGE(PG8_SB(0, 1), cB + hstepB, voffB); PG8_STAGE(PG8_SA(0, 0), cA, voffA); PG8_STAGE(PG8_SA(0, 1), cA + hstepA, voffA);
    if (wr == 1) PG8_BAR;
    PG8_WAIT_V(2); PG8_BAR;
    PG8_STAGE(PG8_SB(1, 0), cB + kstep, voffB); PG8_STAGE(PG8_SA(1, 0), cA + kstep, voffA); PG8_STAGE(PG8_SB(1, 1), cB + hstepB + kstep, voffB);
    PG8_WAIT_V(6); PG8_BAR;
    for (;;) {
        const bool has_next = S_.next(ui + 1, nxt);
        const char* nA = has_next ? (const char*)g.A + (size_t)nxt.pm * tstepA : cA; const char* nB = has_next ? (const char*)g.Bt + (size_t)nxt.pn * tstepB : cB;
        for (int t = 0; t < nt; t += 2) {
            const bool last = (t == nt - 2);
            const char* a1 = cA + (size_t)(t + 1) * kstep;
            const char* a2 = last ? nA : cA + (size_t)(t + 2) * kstep; const char* b2 = last ? nB : cB + (size_t)(t + 2) * kstep;
            const char* a3 = a2 + kstep; const char* b3 = b2 + kstep;
            PG8_LDB(B0, 0, 0); PG8_LDB(B1, 0, 1); PG8_SCHED; PG8_LDA(At, 0, 0); PG8_STAGE(PG8_SA(1, 1), a1 + hstepA, voffA);
            PG8_WAIT_V(8); PG8_WAIT_L(0); PG8_BAR; PG8_MMA(0, 0, At, B0); PG8_MMA(0, 1, At, B1); PG8_BAR; PG8_SCHED;
            PG8_LDA(At, 0, 1); PG8_STAGE(PG8_SB(0, 0), b2, voffB); PG8_STAGE(PG8_SB(0, 1), b2 + hstepB, voffB); PG8_STAGE(PG8_SA(0, 0), a2, voffA);
            PG8_WAIT_V(8); PG8_WAIT_L(0); PG8_BAR; PG8_MMA(1, 0, At, B0); PG8_MMA(1, 1, At, B1); PG8_BAR; PG8_SCHED;
            PG8_LDB(B0, 1, 0); PG8_LDB(B1, 1, 1); PG8_SCHED; PG8_LDA(At, 1, 0); PG8_STAGE(PG8_SA(0, 1), a2 + hstepA, voffA);
            PG8_WAIT_V(8); PG8_WAIT_L(0); PG8_BAR; PG8_MMA(0, 0, At, B0); PG8_MMA(0, 1, At, B1); PG8_BAR; PG8_SCHED;
            PG8_LDA(At, 1, 1); PG8_STAGE(PG8_SB(1, 0), b3, voffB); PG8_STAGE(PG8_SB(1, 1), b3 + hstepB, voffB); PG8_STAGE(PG8_SA(1, 0), a3, voffA);
            PG8_WAIT_V(8); PG8_WAIT_L(0); PG8_BAR; PG8_MMA(1, 0, At, B0); PG8_MMA(1, 1, At, B1); PG8_BAR; PG8_SCHED;
        }
        if (wr == 0) PG8_BAR;
        E(acc, cur, wr, wc, fr, fq);
        if (!has_next) break;
#pragma unroll
        for (int a = 0; a < 2; ++a)
#pragma unroll
            for (int b = 0; b < 2; ++b)
#pragma unroll
                for (int m = 0; m < 4; ++m)
#pragma unroll
                    for (int n = 0; n < 2; ++n) acc[a][b][m][n] = (f32x4){0.f, 0.f, 0.f, 0.f};
        cur = nxt; cA = nA; cB = nB; ++ui;
        if (wr == 1) PG8_BAR;
    }
    PG8_WAIT_V(0);
    PG8_BAR;
#undef PG8_SA
#undef PG8_SB
#undef PG8_STAGE
#undef PG8_LDA
#undef PG8_LDB
#undef PG8_MMA
#undef PG8_WAIT_V
#undef PG8_WAIT_L
#undef PG8_BAR
#undef PG8_SCHED
}
}

struct EpiSwiglu {
    static constexpr bool PERM = true;
    bf16_t* O;
    __device__ __forceinline__ void operator()(const pg8::Acc& acc, const pg8::Unit& u, int wr, int wc, int fr, int fq) const {
        const int row0 = u.pm * 256 + wr * 64 + fr, col0 = u.pn * 128 + wc * 32 + 8 * fq;
#pragma unroll
        for (int ai = 0; ai < 2; ++ai)
#pragma unroll
            for (int m = 0; m < 4; ++m) {
                f32x4 v[2];
#pragma unroll
                for (int n = 0; n < 2; ++n)
#pragma unroll
                    for (int e = 0; e < 4; ++e) { const float gt = acc[ai][0][m][n][e], up = acc[ai][1][m][n][e]; v[n][e] = gt * fsigmoid(gt) * up; }
                *(u32x4*)(O + (size_t)(row0 + ai * 128 + m * 16) * FF + col0) = pack8(v[0], v[1]);
            }
    }
};
struct EpiResF32 {
    static constexpr bool PERM = false;
    const float* res; float* out; float a, b;
    __device__ __forceinline__ void operator()(const pg8::Acc& acc, const pg8::Unit& u, int wr, int wc, int fr, int fq) const {
        const int row0 = u.pm * 256 + wr * 64 + fr, col0 = u.pn * 256 + wc * 32 + 4 * fq;
#pragma unroll
        for (int ai = 0; ai < 2; ++ai)
#pragma unroll
            for (int m = 0; m < 4; ++m) {
                const size_t off = (size_t)(row0 + ai * 128 + m * 16) * DM + col0;
#pragma unroll
                for (int bj = 0; bj < 2; ++bj)
#pragma unroll
                    for (int n = 0; n < 2; ++n) { const f32x4 r = *(const f32x4*)(res + off + bj * 128 + n * 16); *(f32x4*)(out + off + bj * 128 + n * 16) = r * a + acc[ai][bj][m][n] * b; }
            }
    }
};
struct EpiWin {
    static constexpr bool PERM = true;
    bf16_t* proj; bf16_t* sigg; bf16_t* gn; const float* cs; bf16_t* kslf;
    __device__ __forceinline__ void operator()(const pg8::Acc& acc, const pg8::Unit& u, int wr, int wc, int fr, int fq) const {
        const int tile = u.pn, row0 = u.pm * 256 + wr * 64 + fr, cw = wc * 32 + 8 * fq;
        if (tile < 28) {
            const bool rope = (tile == 6) | (tile == 8) | (tile >= 10 && tile < 22);
            const int dcol = (tile < 6 ? tile : tile - 4) * 256;
            if (!rope) {
                if (tile == 7 || tile == 9) {
                    unsigned char* VF = (unsigned char*)kslf + (tile == 7 ? (size_t)8 << 20 : (size_t)24 << 20);
#pragma unroll
                    for (int ai = 0; ai < 2; ++ai)
#pragma unroll
                        for (int m = 0; m < 4; ++m) {
                            const int row = row0 + ai * 128 + m * 16, kp = row & 31;
                            const size_t rbase = (size_t)(row >> 5) * 4096 + (size_t)(((kp >> 2) & 3) * 16) * 8 + 4 * (kp >> 4) + (kp & 3);
#pragma unroll
                            for (int bj = 0; bj < 2; ++bj) {
                                const u32x2 w = pack8_fp8(acc[ai][bj][m][0], acc[ai][bj][m][1]);
                                unsigned char* vb = VF + (size_t)bj * 512 * 4096 + rbase + (size_t)(cw >> 4) * 512 + (size_t)(cw & 15) * 8;
                                vb[0] = (unsigned char)(w.x & 0xffu); vb[8] = (unsigned char)((w.x >> 8) & 0xffu); vb[16] = (unsigned char)((w.x >> 16) & 0xffu); vb[24] = (unsigned char)(w.x >> 24);
                                vb[32] = (unsigned char)(w.y & 0xffu); vb[40] = (unsigned char)((w.y >> 8) & 0xffu); vb[48] = (unsigned char)((w.y >> 16) & 0xffu); vb[56] = (unsigned char)(w.y >> 24);
                            }
                        }
                } else {
#pragma unroll
                    for (int ai = 0; ai < 2; ++ai)
#pragma unroll
                        for (int m = 0; m < 4; ++m)
#pragma unroll
                            for (int bj = 0; bj < 2; ++bj)
                                *(u32x4*)(proj + (size_t)(row0 + ai * 128 + m * 16) * PLD + dcol + bj * 128 + cw) = pack8(acc[ai][bj][m][0], acc[ai][bj][m][1]);
                }
            } else {
                const int head = cw >> 6, d = cw & 63;
                const bool frag = (tile == 6) | (tile == 8);
                unsigned char* KF = (unsigned char*)kslf + (tile == 6 ? (size_t)0 : (size_t)16 << 20); const float* sn = cs + (size_t)S * 64;
#pragma unroll
                for (int ai = 0; ai < 2; ++ai)
#pragma unroll
                    for (int m = 0; m < 4; ++m) {
                        const int row = row0 + ai * 128 + m * 16;
                        f32x4 o1[2], o2[2];
#pragma unroll
                        for (int n = 0; n < 2; ++n) {
                            const f32x4 c = *(const f32x4*)(cs + (size_t)row * 64 + d + 4 * n), sv = *(const f32x4*)(sn + (size_t)row * 64 + d + 4 * n);
                            const f32x4 x1 = acc[ai][0][m][n], x2 = acc[ai][1][m][n];
                            o1[n] = x1 * c - x2 * sv; o2[n] = x2 * c + x1 * sv;
                        }
                        if (frag) {
                            unsigned char* kb = KF + ((size_t)head * 1024 + (row >> 4)) * 2048 + (size_t)(d >> 5) * 512 + (size_t)(((d >> 3) & 3) * 16 + (row & 15)) * 8;
                            *(u32x2*)kb = pack8_fp8(o1[0], o1[1]); *(u32x2*)(kb + 1024) = pack8_fp8(o2[0], o2[1]);
                        } else {
                            bf16_t* p = proj + (size_t)row * PLD + dcol + head * 128 + d;
                            *(u32x4*)p = pack8(o1[0], o1[1]); *(u32x4*)(p + 64) = pack8(o2[0], o2[1]);
                        }
                        if (m & 1) asm volatile("" ::: "memory");
                    }
            }
        } else if (tile < 44) {
#pragma unroll
            for (int ai = 0; ai < 2; ++ai)
#pragma unroll
                for (int m = 0; m < 4; ++m)
#pragma unroll
                    for (int bj = 0; bj < 2; ++bj) {
                        f32x4 v[2];
#pragma unroll
                        for (int n = 0; n < 2; ++n)
#pragma unroll
                            for (int e = 0; e < 4; ++e) v[n][e] = fsigmoid(acc[ai][bj][m][n][e]);
                        *(u32x4*)(sigg + (size_t)(row0 + ai * 128 + m * 16) * 4096 + (tile - 28) * 256 + bj * 128 + cw) = pack8(v[0], v[1]);
                    }
        } else {
            if (wc == 0) {
#pragma unroll
                for (int ai = 0; ai < 2; ++ai)
#pragma unroll
                    for (int m = 0; m < 4; ++m) {
                        f32x4 v[2];
#pragma unroll
                        for (int n = 0; n < 2; ++n)
#pragma unroll
                            for (int e = 0; e < 4; ++e) v[n][e] = fsigmoid(acc[ai][0][m][n][e]);
                        *(u32x4*)(gn + (size_t)(row0 + ai * 128 + m * 16) * 32 + cw) = pack8(v[0], v[1]);
                    }
            }
        }
    }
};
template <bool FIRST> struct EpiGate {
    static constexpr bool PERM = true;
    const bf16_t* sg; bf16_t* O;
    __device__ __forceinline__ void operator()(const pg8::Acc& acc, const pg8::Unit& u, int wr, int wc, int fr, int fq) const {
        const int row0 = u.pm * 256 + wr * 64 + fr, col0 = u.pn * 256 + wc * 32 + 8 * fq;
#pragma unroll
        for (int ai = 0; ai < 2; ++ai)
#pragma unroll
            for (int m = 0; m < 4; ++m)
#pragma unroll
                for (int bj = 0; bj < 2; ++bj) {
                    const int row = row0 + ai * 128 + m * 16, col = col0 + bj * 128;
                    const u32x4 gv = *(const u32x4*)(sg + (size_t)row * 4096 + col);
                    u32x4 pv = (u32x4){0u, 0u, 0u, 0u}; if (!FIRST) pv = *(const u32x4*)(O + (size_t)row * DM + col);
                    f32x4 v[2];
#pragma unroll
                    for (int n = 0; n < 2; ++n) {
                        const unsigned g0 = n ? gv.z : gv.x, g1 = n ? gv.w : gv.y, p0 = n ? pv.z : pv.x, p1 = n ? pv.w : pv.y;
                        const f32x4 y = acc[ai][bj][m][n];
                        v[n][0] = bflo(p0) + bflo(g0) * y[0]; v[n][1] = bfhi(p0) + bfhi(g0) * y[1];
                        v[n][2] = bflo(p1) + bflo(g1) * y[2]; v[n][3] = bfhi(p1) + bfhi(g1) * y[3];
                    }
                    *(u32x4*)(O + (size_t)row * DM + col) = pack8(v[0], v[1]);
                }
    }
};

__device__ __forceinline__ void tr_item(const float* W, int ldw, int k0, int scol0, int nvalid, bf16_t* WT, int ldt, int drow0, int dk0, LAS float* scr, int lane) {
    const int c = lane & 31;
    float v[32];
#pragma unroll
    for (int i = 0; i < 32; ++i) { const int kk = 2 * i + (lane >> 5); v[i] = (c < nvalid) ? W[(size_t)(k0 + kk) * ldw + scol0 + c] : 0.f; }
#pragma unroll
    for (int i = 0; i < 32; ++i) { const int kk = 2 * i + (lane >> 5); scr[kk * 33 + c] = v[i]; }
    asm volatile("s_waitcnt lgkmcnt(0)" ::: "memory");
    const int c8 = lane & 7;
#pragma unroll
    for (int j = 0; j < 4; ++j) { const int n = (lane >> 3) + 8 * j; const LAS float* s = scr + (8 * c8) * 33 + n;
        u32x4 o; o.x = cvt_pk_bf16(s[0 * 33], s[1 * 33]); o.y = cvt_pk_bf16(s[2 * 33], s[3 * 33]); o.z = cvt_pk_bf16(s[4 * 33], s[5 * 33]); o.w = cvt_pk_bf16(s[6 * 33], s[7 * 33]);
        *(u32x4*)(WT + (size_t)(drow0 + n) * ldt + dk0 + 8 * c8) = o; }
    asm volatile("s_waitcnt lgkmcnt(0)" ::: "memory");
}
__device__ __forceinline__ int win_src_col(int r) {
    if (r >= WIN_SRC) return -1;
    if (r >= 11264) return 2560 + (r - 11264);
    const int tile = r >> 8; int j = r & 255;
    const bool rope = (tile == 6) | (tile == 8) | (tile >= 10 && tile < 22);
    if (rope) { const int q = j >> 6, d = j & 63; j = (q & 1) * 128 + (q >> 1) * 64 + d; }
    const int c = tile * 256 + j;
    return c < 2560 ? c : c + 24;
}
__device__ __forceinline__ void conv_ffn(const float* Wg, const float* Wu, const float* Wd, bf16_t* GU, bf16_t* DN, LAS float* scr, int gw, int ngw, int lane) {
    constexpr int I_G = 32 * 176;
    for (int it = gw; it < 2 * I_G; it += ngw) { const int which = it / I_G, r = it % I_G, kb = r / 176, nb = r % 176, c0 = nb * 32;
        tr_item(which ? Wu : Wg, FF, kb * 64, c0, 32, GU, DM, 256 * (c0 >> 7) + (c0 & 127) + which * 128, kb * 64, scr, lane); }
    for (int it = gw; it < 88 * 64; it += ngw) { const int kb = it / 64, nb = it % 64; tr_item(Wd, DM, kb * 64, nb * 32, 32, DN, FF, nb * 32, kb * 64, scr, lane); }
}
__device__ __forceinline__ void ln_rows(const float* in, float* outf, bf16_t* outb, const float* g, const float* b, int gw, int ngw, int lane) {
    f32x4 gv[8], bv[8];
#pragma unroll
    for (int j = 0; j < 8; ++j) { gv[j] = *(const f32x4*)(g + 4 * (lane + 64 * j)); bv[j] = *(const f32x4*)(b + 4 * (lane + 64 * j)); }
    for (int row = gw; row < S; row += ngw) {
        const float* xr = in + (size_t)row * DM; f32x4 v[8]; float s = 0.f;
#pragma unroll
        for (int j = 0; j < 8; ++j) { v[j] = *(const f32x4*)(xr + 4 * (lane + 64 * j)); s += (v[j][0] + v[j][1]) + (v[j][2] + v[j][3]); }
        const float mean = wave_sum(s) * (1.f / DM); float s2 = 0.f;
#pragma unroll
        for (int j = 0; j < 8; ++j) { v[j] = v[j] - mean; s2 += (v[j][0] * v[j][0] + v[j][1] * v[j][1]) + (v[j][2] * v[j][2] + v[j][3] * v[j][3]); }
        const float rstd = 1.f / sqrtf(wave_sum(s2) * (1.f / DM) + LN_EPS);
#pragma unroll
        for (int j = 0; j < 8; ++j) { const f32x4 o = v[j] * rstd * gv[j] + bv[j];
            *(f32x4*)(outf + (size_t)row * DM + 4 * (lane + 64 * j)) = o;
            if (outb) { u32x2 w; w.x = cvt_pk_bf16(o[0], o[1]); w.y = cvt_pk_bf16(o[2], o[3]); *(u32x2*)(outb + (size_t)row * DM + 4 * (lane + 64 * j)) = w; } }
    }
}

struct AState { float m, l; f32x4 o[8]; };
__device__ __forceinline__ void astate_init(AState& s) { s.m = -1e30f; s.l = 0.f;
#pragma unroll
    for (int i = 0; i < 8; ++i) s.o[i] = (f32x4){0.f, 0.f, 0.f, 0.f}; }
__device__ __forceinline__ int clampi(int v, int lo, int hi) { return v < lo ? lo : (v > hi ? hi : v); }

__device__ __forceinline__ void load_k(bf16x8 (&kf)[2][4], const bf16_t* __restrict__ Kb, int ld, int pos0, int dpos, int posmax, int l16, int kq) {
#pragma unroll
    for (int T = 0; T < 2; ++T) { const int p = clampi(pos0 + dpos * (16 * T + l16), 0, posmax); const bf16_t* kp = Kb + (size_t)p * ld + 8 * kq;
#pragma unroll
        for (int s = 0; s < 4; ++s) kf[T][s] = *(const bf16x8*)(kp + 32 * s); }
}
__device__ __forceinline__ void load_v(u32x4 (&vr)[8], const bf16_t* __restrict__ Vb, int ld, int pos0, int dpos, int posmax, int l16, int kq) {
#pragma unroll
    for (int i = 0; i < 8; ++i) { const int p = clampi(pos0 + dpos * (4 * i + kq), 0, posmax); vr[i] = *(const u32x4*)(Vb + (size_t)p * ld + 8 * l16); }
}
__device__ __forceinline__ void store_v(const u32x4 (&vr)[8], LAS unsigned char* vbuf, int l16, int kq) {
#pragma unroll
    for (int i = 0; i < 8; ++i) *(LAS u32x4*)(vbuf + (4 * i + kq) * VROW + 16 * l16) = vr[i];
}
template <int MODE, bool SLC, class Desc>
__device__ __forceinline__ void attn_run(const bf16x8 (&qf)[4], const bf16_t* __restrict__ Kb, const bf16_t* __restrict__ Vb, int ld, int dpos, int posmax,
                                         const Desc& desc, int n, int lo_in, int hi, int qi, AState& st, LAS unsigned char* vbuf, int lane, LAS float* imp = nullptr) {
    if (n <= 0) return;
    const int l16 = lane & 15, kq = lane >> 4;
    u32x4 kr[8];
    int dcur = desc(0);
    load_v(kr, Kb, ld, SLC ? (dcur & 0xfffff) : dcur, dpos, posmax, l16, kq);
#pragma unroll 1
    for (int i = 0; i < n; ++i) {
        const int pos0 = SLC ? (dcur & 0xfffff) : dcur;
        const int lo = SLC ? ((((dcur >> 20) == qi) | ((dcur >> 20) == 4)) ? 0 : (1 << 30)) : lo_in;
        store_v(kr, vbuf, l16, kq);
        u32x4 vr[8];
        if (MODE != 1) load_v(vr, Vb, ld, pos0, dpos, posmax, l16, kq);
        bf16x8 kf[2][4];
#pragma unroll
        for (int T = 0; T < 2; ++T)
#pragma unroll
            for (int s = 0; s < 4; ++s) kf[T][s] = *(const LAS bf16x8*)(vbuf + (16 * T + l16) * VROW + 64 * s + 16 * kq);
        f32x4 sa[2] = {(f32x4){0.f, 0.f, 0.f, 0.f}, (f32x4){0.f, 0.f, 0.f, 0.f}};
#pragma unroll
        for (int T = 0; T < 2; ++T)
#pragma unroll
            for (int s = 0; s < 4; ++s) sa[T] = __builtin_amdgcn_mfma_f32_16x16x32_bf16(kf[T][s], qf[s], sa[T], 0, 0, 0);
        const int dnext = desc(i + 1 < n ? i + 1 : i);
        load_v(kr, Kb, ld, SLC ? (dnext & 0xfffff) : dnext, dpos, posmax, l16, kq);
        float sc[8]; bool vd[8]; float mx = -1e30f;
#pragma unroll
        for (int T = 0; T < 2; ++T)
#pragma unroll
            for (int r = 0; r < 4; ++r) { const int p = pos0 + dpos * (16 * T + 4 * kq + r); const bool v = (p >= lo) & (p <= hi); const float x = sa[T][r] * SL2;
                sc[4 * T + r] = x; vd[4 * T + r] = v; mx = v ? fmaxf(mx, x) : mx; }
        float p[8];
        if (MODE == 2) {
#pragma unroll
            for (int j = 0; j < 8; ++j) p[j] = vd[j] ? __builtin_amdgcn_exp2f(sc[j] - st.m) * st.l : 0.f;
#pragma unroll
            for (int T = 0; T < 2; ++T) {
                float x = 2.f * (p[4 * T] + p[4 * T + 1] + p[4 * T + 2]) + p[4 * T + 3], y = p[4 * T + 3];
                x += __shfl_xor(x, 1); x += __shfl_xor(x, 2); y += __shfl_xor(y, 1); y += __shfl_xor(y, 2);
                if ((l16 & 3) == 0) { const int a = (pos0 >> 2) + 4 * T + kq; LAS float* ip = imp + (l16 >> 2) * IMP_LD + a;
                    ip[0] += x;
                    asm volatile("s_waitcnt lgkmcnt(0)" ::: "memory");
                    ip[1] += y; }
                asm volatile("s_waitcnt lgkmcnt(0)" ::: "memory");
            }
        } else {
            if (__builtin_amdgcn_ballot_w64(mx > st.m + 40.f) != 0ull) {
                mx = fmaxf(mx, __shfl_xor(mx, 16)); mx = fmaxf(mx, __shfl_xor(mx, 32));
                const float mn = fmaxf(st.m, mx), alpha = __builtin_amdgcn_exp2f(st.m - mn); st.m = mn; st.l *= alpha;
                if (MODE == 0) {
#pragma unroll
                    for (int j = 0; j < 8; ++j) st.o[j] = st.o[j] * alpha;
                }
            }
            float ps = 0.f;
#pragma unroll
            for (int j = 0; j < 8; ++j) { p[j] = vd[j] ? __builtin_amdgcn_exp2f(sc[j] - st.m) : 0.f; ps += p[j]; }
            st.l += ps;
        }
        if (MODE != 1) {
            store_v(vr, vbuf, l16, kq);
            u32x4 pw; pw.x = cvt_pk_bf16(p[0], p[1]); pw.y = cvt_pk_bf16(p[2], p[3]); pw.z = cvt_pk_bf16(p[4], p[5]); pw.w = cvt_pk_bf16(p[6], p[7]);
            const bf16x8 pf = __builtin_bit_cast(bf16x8, pw);
            const unsigned addr = (unsigned)(uintptr_t)(vbuf) + (4 * kq + (l16 >> 2)) * VROW + (l16 & 3) * 8;
#pragma unroll
            for (int hf = 0; hf < 2; ++hf) {
                s16x4 a[8];
                asm volatile("s_waitcnt lgkmcnt(0)\n\t"
                             "ds_read_b64_tr_b16 %0, %8 offset:0\n\t"    "ds_read_b64_tr_b16 %1, %8 offset:32\n\t"
                             "ds_read_b64_tr_b16 %2, %8 offset:64\n\t"   "ds_read_b64_tr_b16 %3, %8 offset:96\n\t"
                             "ds_read_b64_tr_b16 %4, %8 offset:4608\n\t" "ds_read_b64_tr_b16 %5, %8 offset:4640\n\t"
                             "ds_read_b64_tr_b16 %6, %8 offset:4672\n\t" "ds_read_b64_tr_b16 %7, %8 offset:4704\n\t"
                             "s_waitcnt lgkmcnt(0)"
                             : "=&v"(a[0]), "=&v"(a[1]), "=&v"(a[2]), "=&v"(a[3]), "=&v"(a[4]), "=&v"(a[5]), "=&v"(a[6]), "=&v"(a[7])
                             : "v"(addr + 128 * hf) : "memory");
#pragma unroll
                for (int d4 = 0; d4 < 4; ++d4) { const int db = 4 * hf + d4;
                    bf16x8 af; af[0] = a[d4][0]; af[1] = a[d4][1]; af[2] = a[d4][2]; af[3] = a[d4][3]; af[4] = a[d4 + 4][0]; af[5] = a[d4 + 4][1]; af[6] = a[d4 + 4][2]; af[7] = a[d4 + 4][3];
                    st.o[db] = __builtin_amdgcn_mfma_f32_16x16x32_bf16(af, pf, st.o[db], 0, 0, 0); }
            }
        }
        dcur = dnext;
    }
}
template <int MODE, bool SLC, class Desc>
__device__ __forceinline__ void attn_run_frag(const bf16x8 (&qf)[4], const bf16_t* __restrict__ KF, const bf16_t* __restrict__ VF, const Desc& desc, int n,
                                              int lo_in, int hi, int qi, AState& st, int lane, LAS float* imp = nullptr) {
    if (n <= 0) return;
    const int kq = lane >> 4;
    bf16x8 kf[2][4];
    int dcur = desc(0);
    { const int pos0 = SLC ? (dcur & 0xfffff) : dcur; const bf16_t* kp = KF + ((size_t)(pos0 >> 4) * 256 + lane) * 8;
#pragma unroll
      for (int T = 0; T < 2; ++T)
#pragma unroll
          for (int s2 = 0; s2 < 4; ++s2) kf[T][s2] = *(const bf16x8*)(kp + (T * 4 + s2) * 512); }
#pragma unroll 1
    for (int i = 0; i < n; ++i) {
        const int pos0 = SLC ? (dcur & 0xfffff) : dcur;
        const int lo = SLC ? ((((dcur >> 20) == qi) | ((dcur >> 20) == 4)) ? 0 : (1 << 30)) : lo_in;
        bf16x8 vf[8];
        if (MODE != 1) { const bf16_t* vp = VF + ((size_t)(pos0 >> 5) * 512 + lane) * 8;
#pragma unroll
          for (int db = 0; db < 8; ++db) vf[db] = *(const bf16x8*)(vp + db * 512); }
        f32x4 sa[2] = {(f32x4){0.f, 0.f, 0.f, 0.f}, (f32x4){0.f, 0.f, 0.f, 0.f}};
#pragma unroll
        for (int T = 0; T < 2; ++T)
#pragma unroll
            for (int s2 = 0; s2 < 4; ++s2) sa[T] = __builtin_amdgcn_mfma_f32_16x16x32_bf16(kf[T][s2], qf[s2], sa[T], 0, 0, 0);
        const int dnext = desc(i + 1 < n ? i + 1 : i);
        { const int pn = SLC ? (dnext & 0xfffff) : dnext; const bf16_t* kp = KF + ((size_t)(pn >> 4) * 256 + lane) * 8;
#pragma unroll
          for (int T = 0; T < 2; ++T)
#pragma unroll
              for (int s2 = 0; s2 < 4; ++s2) kf[T][s2] = *(const bf16x8*)(kp + (T * 4 + s2) * 512); }
        float sc[8]; bool vd[8]; float mx = -1e30f;
#pragma unroll
        for (int T = 0; T < 2; ++T)
#pragma unroll
            for (int r = 0; r < 4; ++r) { const int p = pos0 + 16 * T + 4 * kq + r; const bool v = (p >= lo) & (p <= hi); const float x = sa[T][r] * SL2;
                sc[4 * T + r] = x; vd[4 * T + r] = v; mx = v ? fmaxf(mx, x) : mx; }
        float p[8];
        if (MODE == 2) {
            const int l16 = lane & 15;
#pragma unroll
            for (int j = 0; j < 8; ++j) p[j] = vd[j] ? __builtin_amdgcn_exp2f(sc[j] - st.m) * st.l : 0.f;
#pragma unroll
            for (int T = 0; T < 2; ++T) {
                float x = 2.f * (p[4 * T] + p[4 * T + 1] + p[4 * T + 2]) + p[4 * T + 3], y = p[4 * T + 3];
                x += __shfl_xor(x, 1); x += __shfl_xor(x, 2); y += __shfl_xor(y, 1); y += __shfl_xor(y, 2);
                if ((l16 & 3) == 0) { const int a = (pos0 >> 2) + 4 * T + kq; LAS float* ip = imp + (l16 >> 2) * IMP_LD + a;
                    ip[0] += x;
                    asm volatile("s_waitcnt lgkmcnt(0)" ::: "memory");
                    ip[1] += y; }
                asm volatile("s_waitcnt lgkmcnt(0)" ::: "memory");
            }
        } else {
            if (__builtin_amdgcn_ballot_w64(mx > st.m + 40.f) != 0ull) {
                mx = fmaxf(mx, __shfl_xor(mx, 16)); mx = fmaxf(mx, __shfl_xor(mx, 32));
                const float mn = fmaxf(st.m, mx), alpha = __builtin_amdgcn_exp2f(st.m - mn); st.m = mn; st.l *= alpha;
                if (MODE == 0) {
#pragma unroll
                    for (int j = 0; j < 8; ++j) st.o[j] = st.o[j] * alpha;
                }
            }
            float ps = 0.f;
#pragma unroll
            for (int j = 0; j < 8; ++j) { p[j] = vd[j] ? __builtin_amdgcn_exp2f(sc[j] - st.m) : 0.f; ps += p[j]; }
            st.l += ps;
        }
        if (MODE != 1) {
            u32x4 pw; pw.x = cvt_pk_bf16(p[0], p[1]); pw.y = cvt_pk_bf16(p[2], p[3]); pw.z = cvt_pk_bf16(p[4], p[5]); pw.w = cvt_pk_bf16(p[6], p[7]);
            const bf16x8 pf = __builtin_bit_cast(bf16x8, pw);
#pragma unroll
            for (int db = 0; db < 8; ++db) st.o[db] = __builtin_amdgcn_mfma_f32_16x16x32_bf16(vf[db], pf, st.o[db], 0, 0, 0);
        }
        dcur = dnext;
    }
}
template <bool SLC, class Desc>
__device__ __forceinline__ void attn_run_frag8(const i64_t (&qf)[4], const unsigned char* __restrict__ KF, const unsigned char* __restrict__ VF, const Desc& desc, int n,
                                               int lo_in, int hi, int qi, AState& st, int lane) {
    if (n <= 0) return;
    const int kq = lane >> 4;
    i64_t kf[2][4];
    int dcur = desc(0);
    { const int pos0 = SLC ? (dcur & 0xfffff) : dcur; const unsigned char* kp = KF + ((size_t)(pos0 >> 4) * 256 + lane) * 8;
#pragma unroll
      for (int T = 0; T < 2; ++T)
#pragma unroll
          for (int s2 = 0; s2 < 4; ++s2) kf[T][s2] = *(const i64_t*)(kp + (T * 4 + s2) * 512); }
#pragma unroll 1
    for (int i = 0; i < n; ++i) {
        const int pos0 = SLC ? (dcur & 0xfffff) : dcur;
        const int lo = SLC ? ((((dcur >> 20) == qi) | ((dcur >> 20) == 4)) ? 0 : (1 << 30)) : lo_in;
        i64_t vf[8];
        { const unsigned char* vp = VF + ((size_t)(pos0 >> 5) * 512 + lane) * 8;
#pragma unroll
          for (int db = 0; db < 8; ++db) vf[db] = *(const i64_t*)(vp + db * 512); }
        f32x4 sa[2] = {(f32x4){0.f, 0.f, 0.f, 0.f}, (f32x4){0.f, 0.f, 0.f, 0.f}};
#pragma unroll
        for (int T = 0; T < 2; ++T)
#pragma unroll
            for (int s2 = 0; s2 < 4; ++s2) sa[T] = __builtin_amdgcn_mfma_f32_16x16x32_fp8_fp8(kf[T][s2], qf[s2], sa[T], 0, 0, 0);
        const int dnext = desc(i + 1 < n ? i + 1 : i);
        { const int pn = SLC ? (dnext & 0xfffff) : dnext; const unsigned char* kp = KF + ((size_t)(pn >> 4) * 256 + lane) * 8;
#pragma unroll
          for (int T = 0; T < 2; ++T)
#pragma unroll
              for (int s2 = 0; s2 < 4; ++s2) kf[T][s2] = *(const i64_t*)(kp + (T * 4 + s2) * 512); }
        float sc[8]; bool vd[8]; float mx = -1e30f;
#pragma unroll
        for (int T = 0; T < 2; ++T)
#pragma unroll
            for (int r = 0; r < 4; ++r) { const int p = pos0 + 16 * T + 4 * kq + r; const bool v = (p >= lo) & (p <= hi); const float x = sa[T][r] * SL2;
                sc[4 * T + r] = x; vd[4 * T + r] = v; mx = v ? fmaxf(mx, x) : mx; }
        if (__builtin_amdgcn_ballot_w64(mx > st.m + 4.f) != 0ull) {
            mx = fmaxf(mx, __shfl_xor(mx, 16)); mx = fmaxf(mx, __shfl_xor(mx, 32));
            const float mn = fmaxf(st.m, mx), alpha = __builtin_amdgcn_exp2f(st.m - mn); st.m = mn; st.l *= alpha;
#pragma unroll
            for (int j = 0; j < 8; ++j) st.o[j] = st.o[j] * alpha;
        }
        f32x4 pa, pb; float ps = 0.f;
#pragma unroll
        for (int j = 0; j < 4; ++j) { pa[j] = vd[j] ? __builtin_amdgcn_exp2f(sc[j] - st.m + 4.f) : 0.f; pb[j] = vd[4 + j] ? __builtin_amdgcn_exp2f(sc[4 + j] - st.m + 4.f) : 0.f; ps += pa[j] + pb[j]; }
        st.l += ps;
        const u32x2 pw = pack8_fp8(pa, pb);
        const i64_t pf = __builtin_bit_cast(i64_t, pw);
#pragma unroll
        for (int db = 0; db < 8; ++db) st.o[db] = __builtin_amdgcn_mfma_f32_16x16x32_fp8_fp8(vf[db], pf, st.o[db], 0, 0, 0);
        dcur = dnext;
    }
}
__device__ __forceinline__ float quad_total(float v) { v += __shfl_xor(v, 16); v += __shfl_xor(v, 32); return v; }

__device__ __forceinline__ void dilated_unit(int unit, const bf16_t* proj, bf16_t* nsaout, LAS unsigned char* vbuf, int lane) {
    const int l16 = lane & 15, kq = lane >> 4;
    const int hg = unit & 3, r16 = (unit >> 2) & 15, ut = unit >> 6;
    const int t0 = r16 + 256 * ut, tc = t0 + 16 * l16;
    AState st; astate_init(st);
#pragma unroll 1
    for (int pt = 0; pt < 3; ++pt) {
        const int d = pt == 0 ? 1 : (pt == 1 ? 4 : 16), head = 4 * pt + hg;
        const bf16_t* qrow = proj + (size_t)tc * PLD + PC_QB + head * 128 + 8 * kq;
        bf16x8 qf[4];
#pragma unroll
        for (int s = 0; s < 4; ++s) qf[s] = *(const bf16x8*)(qrow + 32 * s);
        const int nk = 129 + 240 / d, nsteps = (nk + 31) >> 5;
        const int lo = tc - 128 * d < 0 ? 0 : tc - 128 * d, hi = tc;
        const int base = t0 - 128 * d;
        const int i0 = base < 0 ? (-base + d - 1) / (32 * d) : 0;
        auto desc = [&](int i) { return base + 32 * d * (i0 + i); };
        attn_run<0, false>(qf, proj + PC_KB + head * 128, proj + PC_VB + head * 128, PLD, d, S - 1, desc, nsteps - i0, lo, hi, 0, st, vbuf, lane);
    }
    const float lt = quad_total(st.l), inv = lt > 0.f ? 1.f / lt : 0.f;
    bf16_t* op = nsaout + (size_t)tc * NOLD + 1024 + hg * 128 + 4 * kq;
#pragma unroll
    for (int db = 0; db < 8; ++db) { const f32x4 o = st.o[db] * inv; u32x2 w; w.x = cvt_pk_bf16(o[0], o[1]); w.y = cvt_pk_bf16(o[2], o[3]); *(u32x2*)(op + 16 * db) = w; }
}

__device__ __forceinline__ void compress_unit(int unit, const bf16_t* proj, const bf16_t* w1t, const bf16_t* w2t, const float* bias, bf16_t* outc, LAS unsigned char* scr, int lane) {
    const int l16 = lane & 15, kq = lane >> 4;
    const int rt = unit & 63, g = (unit >> 6) & 1, kv = unit >> 7;
    const bf16_t* raw = proj + (kv ? PC_VC : PC_KC) + 128 * g;
    const int n = 16 * rt + l16;
    f32x4 acc[16];
#pragma unroll
    for (int i = 0; i < 16; ++i) acc[i] = (f32x4){0.f, 0.f, 0.f, 0.f};
#pragma unroll 2
    for (int s = 0; s < 128; ++s) {
        const int tok = clampi(16 * n + (s >> 2), 0, S - 1);
        const bf16x8 af = *(const bf16x8*)(raw + (size_t)tok * PLD + (s & 3) * 32 + 8 * kq);
#pragma unroll
        for (int ct = 0; ct < 16; ++ct) { const bf16x8 bfr = *(const bf16x8*)(w1t + (size_t)(16 * ct + l16) * 4096 + 32 * s + 8 * kq);
            acc[ct] = __builtin_amdgcn_mfma_f32_16x16x32_bf16(af, bfr, acc[ct], 0, 0, 0); }
    }
#pragma unroll
    for (int ct = 0; ct < 16; ++ct) { const float bb = bias[16 * ct + l16];
#pragma unroll
        for (int r = 0; r < 4; ++r) { const float x = acc[ct][r] + bb; const float u2 = 1.5957691216f * (x + 0.044715f * x * x * x); const float gl = x * fsigmoid(u2);
            *(LAS bf16_t*)(scr + (4 * kq + r) * 528 + (16 * ct + l16) * 2) = (bf16_t)(cvt_pk_bf16(gl, 0.f) & 0xffffu); } }
    asm volatile("s_waitcnt lgkmcnt(0)" ::: "memory");
    f32x4 o2[8];
#pragma unroll
    for (int i = 0; i < 8; ++i) o2[i] = (f32x4){0.f, 0.f, 0.f, 0.f};
#pragma unroll
    for (int s = 0; s < 8; ++s) {
        const bf16x8 af = *(const LAS bf16x8*)(scr + l16 * 528 + (32 * s + 8 * kq) * 2);
#pragma unroll
        for (int dt = 0; dt < 8; ++dt) { const bf16x8 bfr = *(const bf16x8*)(w2t + (size_t)(16 * dt + l16) * 256 + 32 * s + 8 * kq);
            o2[dt] = __builtin_amdgcn_mfma_f32_16x16x32_bf16(af, bfr, o2[dt], 0, 0, 0); }
    }
    asm volatile("s_waitcnt lgkmcnt(0)" ::: "memory");
#pragma unroll
    for (int dt = 0; dt < 8; ++dt)
#pragma unroll
        for (int r = 0; r < 4; ++r) { const int nn = 16 * rt + 4 * kq + r, d = 16 * dt + l16;
            const bf16_t val = (bf16_t)(cvt_pk_bf16(o2[dt][r], 0.f) & 0xffffu);
            if (kv == 0) outc[(((size_t)g * 64 + (nn >> 4)) * 4 + (d >> 5)) * 512 + (((d >> 3) & 3) * 16 + (nn & 15)) * 8 + (d & 7)] = val;
            else { const int kp = nn & 31; outc[(((size_t)g * 32 + (nn >> 5)) * 8 + (d >> 4)) * 512 + ((((kp >> 2) & 3) * 16) + (d & 15)) * 8 + 4 * (kp >> 4) + (kp & 3)] = val; } }
}

__device__ __forceinline__ void nsa_unit(int unit, const bf16_t* proj, const bf16_t* kc, const bf16_t* vc, const bf16_t* gn, const float* cs, const float* sn,
                                         const bf16_t* kslf, const bf16_t* vslf, const bf16_t* kwnf, const bf16_t* vwnf, bf16_t* nsaout, LAS unsigned char* wl, int lane) {
    const int l16 = lane & 15, kq = lane >> 4;
    const int g = unit & 1, tb = unit >> 1, t0 = 4 * tb, qi = l16 >> 2, h = l16 & 3, tc = t0 + qi, head = 4 * g + h;
    LAS unsigned char* vbuf = wl; LAS float* imp = (LAS float*)(wl + VBUF_BYTES); LAS int* sel = (LAS int*)(wl + VBUF_BYTES + 4 * IMP_LD * 4);
    bf16x8 qf[4];
    { const bf16_t* qrow = proj + (size_t)tc * PLD + PC_QA + head * 128 + 8 * kq;
#pragma unroll
        for (int s = 0; s < 4; ++s) qf[s] = *(const bf16x8*)(qrow + 32 * s); }
    LAS u32x2* outl = (LAS u32x2*)(wl + OUT_OFF) + lane;
    for (int i = lane; i < 4 * IMP_LD; i += 64) imp[i] = 0.f;
    const int hic = (tc - 31) >> 4;
    const int nkmax = ((t0 + 3 - 31) >> 4) + 1, nsc = nkmax > 0 ? (nkmax + 31) >> 5 : 0;
    unsigned long long coff = (unsigned long long)g * 1024 * 128; asm volatile("" : "+s"(coff));
    const bf16_t* kcg = kc + coff; const bf16_t* vcg = vc + coff;
    AState st; astate_init(st);
    { auto desc = [&](int i) { return 32 * i; };
      attn_run_frag<1, false>(qf, kcg, vcg, desc, nsc, 0, hic, 0, st, lane);
      { const float lt = quad_total(st.l); st.l = lt > 0.f ? 1.f / lt : 0.f; }
      asm volatile("s_waitcnt lgkmcnt(0)" ::: "memory");
      attn_run_frag<2, false>(qf, kcg, vcg, desc, nsc, 0, hic, 0, st, lane, imp); }
    const float g0 = bf2f(gn[(size_t)tc * 32 + head * 3 + 0]);
#pragma unroll
    for (int i = 0; i < 8; ++i) { const f32x4 o = st.o[i] * g0; u32x2 w; w.x = cvt_pk_bf16(o[0], o[1]); w.y = cvt_pk_bf16(o[2], o[3]); outl[64 * i] = w; }
    asm volatile("s_waitcnt lgkmcnt(0)" ::: "memory");
#pragma unroll
    for (int s2 = 0; s2 < 2; ++s2) {
        const int d = 32 * s2 + 8 * kq; f32x4 c[2], sv[2];
        c[0] = *(const f32x4*)(cs + (size_t)tc * 64 + d); c[1] = *(const f32x4*)(cs + (size_t)tc * 64 + d + 4);
        sv[0] = *(const f32x4*)(sn + (size_t)tc * 64 + d); sv[1] = *(const f32x4*)(sn + (size_t)tc * 64 + d + 4);
        float o1[8], o2[8];
#pragma unroll
        for (int j = 0; j < 8; ++j) { const float x1 = bf2f((unsigned short)qf[s2][j]), x2 = bf2f((unsigned short)qf[s2 + 2][j]), cc = c[j >> 2][j & 3], ss = sv[j >> 2][j & 3];
            o1[j] = x1 * cc - x2 * ss; o2[j] = x2 * cc + x1 * ss; }
        u32x4 w1, w2; w1.x = cvt_pk_bf16(o1[0], o1[1]); w1.y = cvt_pk_bf16(o1[2], o1[3]); w1.z = cvt_pk_bf16(o1[4], o1[5]); w1.w = cvt_pk_bf16(o1[6], o1[7]);
        w2.x = cvt_pk_bf16(o2[0], o2[1]); w2.y = cvt_pk_bf16(o2[2], o2[3]); w2.z = cvt_pk_bf16(o2[4], o2[5]); w2.w = cvt_pk_bf16(o2[6], o2[7]);
        qf[s2] = __builtin_bit_cast(bf16x8, w1); qf[s2 + 2] = __builtin_bit_cast(bf16x8, w2);
    }
    unsigned key[4][4];
#pragma unroll
    for (int q = 0; q < 4; ++q) { const int cur = (t0 + q) >> 6; const f32x4 v = *(const LAS f32x4*)(imp + q * IMP_LD + 4 * lane);
#pragma unroll
        for (int i = 0; i < 4; ++i) { const int j = 4 * lane + i; const bool valid = j <= cur, forced = (j == 0) | (j == cur) | (j == cur - 1);
            const unsigned kb = forced ? 0xffffffu : ((__float_as_uint(fmaxf(v[i], 0.f)) >> 8) + 1u);
            key[q][i] = valid ? ((kb << 8) | (unsigned)(255 - j)) : 0u; } }
#pragma unroll 1
    for (int r = 0; r < 16; ++r) {
        unsigned mx[4];
#pragma unroll
        for (int q = 0; q < 4; ++q) { unsigned a = key[q][0] > key[q][1] ? key[q][0] : key[q][1], b = key[q][2] > key[q][3] ? key[q][2] : key[q][3]; mx[q] = a > b ? a : b; }
#pragma unroll
        for (int o = 1; o < 64; o <<= 1)
#pragma unroll
            for (int q = 0; q < 4; ++q) { const unsigned other = (unsigned)__shfl_xor((int)mx[q], o); mx[q] = other > mx[q] ? other : mx[q]; }
#pragma unroll
        for (int q = 0; q < 4; ++q) {
#pragma unroll
            for (int i = 0; i < 4; ++i) if (key[q][i] == mx[q]) key[q][i] = 0u;
            if (lane == 0) sel[q * 16 + r] = mx[q] ? (int)(255u - (mx[q] & 255u)) : -1;
        }
    }
    asm volatile("s_waitcnt lgkmcnt(0)" ::: "memory");
    i64_t q8[4];
#pragma unroll
    for (int s2 = 0; s2 < 4; ++s2) { f32x4 a, b;
#pragma unroll
        for (int j = 0; j < 4; ++j) { a[j] = bf2f((unsigned short)qf[s2][j]); b[j] = bf2f((unsigned short)qf[s2][4 + j]); }
        q8[s2] = __builtin_bit_cast(i64_t, pack8_fp8(a, b)); }
    LAS int* list = (LAS int*)(wl + VBUF_BYTES + 4 * IMP_LD * 4 + 256);
    int nslc;
    { const int b = sel[lane], q = lane >> 4, cur0 = t0 >> 6;
      const bool forced = (b == 0) | (b == cur0) | (b == cur0 - 1);
      const bool valid = (b >= 0) & !(forced & (q > 0)); const unsigned long long mask = __ballot(valid);
      const int idx = __popcll(mask & ((1ull << lane) - 1ull)); nslc = 2 * __popcll(mask);
      if (valid) { const int qc = forced ? 4 : q; list[2 * idx] = (64 * b) | (qc << 20); list[2 * idx + 1] = (64 * b + 32) | (qc << 20); } }
    asm volatile("s_waitcnt lgkmcnt(0)" ::: "memory");
    astate_init(st);
    { auto desc = [&](int i) { return __builtin_amdgcn_readfirstlane(list[i]); };
      unsigned long long goff = (unsigned long long)g * S * 128; asm volatile("" : "+s"(goff));
      attn_run_frag8<true>(q8, (const unsigned char*)kslf + goff, (const unsigned char*)kslf + ((size_t)8 << 20) + goff, desc, nslc, 0, tc, qi, st, lane); }
    { const float g1 = bf2f(gn[(size_t)tc * 32 + head * 3 + 1]); const float lt = quad_total(st.l), inv = (lt > 0.f ? 1.f / lt : 0.f) * g1;
#pragma unroll
        for (int i = 0; i < 8; ++i) { const f32x4 o = st.o[i] * inv; u32x2 w = outl[64 * i]; w.x = cvt_pk_bf16(bflo(w.x) + o[0], bfhi(w.x) + o[1]); w.y = cvt_pk_bf16(bflo(w.y) + o[2], bfhi(w.y) + o[3]); outl[64 * i] = w; } }
    astate_init(st);
    { const int lo = tc - 511 < 0 ? 0 : tc - 511; const int first = t0 < 511 ? 0 : (t0 - 511) >> 5, last = (t0 + 3) >> 5;
      auto desc = [&](int i) { return 32 * (first + i); };
      unsigned long long goff = (unsigned long long)g * S * 128; asm volatile("" : "+s"(goff));
      attn_run_frag8<false>(q8, (const unsigned char*)kslf + ((size_t)16 << 20) + goff, (const unsigned char*)kslf + ((size_t)24 << 20) + goff, desc, last - first + 1, lo, tc, 0, st, lane); }
    { const float g2 = bf2f(gn[(size_t)tc * 32 + head * 3 + 2]); const float lt = quad_total(st.l), inv = (lt > 0.f ? 1.f / lt : 0.f) * g2;
#pragma unroll
        for (int i = 0; i < 8; ++i) { const f32x4 o = st.o[i] * inv; u32x2 w = outl[64 * i]; w.x = cvt_pk_bf16(bflo(w.x) + o[0], bfhi(w.x) + o[1]); w.y = cvt_pk_bf16(bflo(w.y) + o[2], bfhi(w.y) + o[3]); outl[64 * i] = w; } }
    bf16_t* op = nsaout + (size_t)tc * NOLD + head * 128 + 4 * kq;
#pragma unroll
    for (int db = 0; db < 8; ++db) *(u32x2*)(op + 16 * db) = outl[64 * db];
}


#define XB_TMO      128
#define XB_XCNT(j)  (256  + 64 * (j))
#define XB_XSUB(j)  (1280 + 64 * (j))
#define XB_XGEN(j)  (2304 + 64 * (j))
#define XB_TOP      3328
#define XB_TOPGEN   3392
#define XCD_BAR_WORDS 3456
#define XB_SPIN_CAP (1u << 18)
__device__ __forceinline__ unsigned xb_ld(unsigned* p)              { return __hip_atomic_load(p, __ATOMIC_RELAXED, __HIP_MEMORY_SCOPE_AGENT); }
__device__ __forceinline__ unsigned xb_add(unsigned* p, unsigned v) { return __hip_atomic_fetch_add(p, v, __ATOMIC_RELAXED, __HIP_MEMORY_SCOPE_AGENT); }
__device__ __forceinline__ unsigned xb_xcc_id() { return (unsigned)__builtin_amdgcn_s_getreg((3 << 11) | 20) & 0xFu; }
#define XB_SPIN(cond, bar) do { unsigned _sp = 0; while (cond) { __builtin_amdgcn_s_sleep(1); \
    if ((++_sp & 255u) == 0u) { if (xb_ld(&(bar)[XB_TMO])) break; if (_sp > XB_SPIN_CAP) { atomicAdd(&(bar)[XB_TMO], 1u); break; } } } } while (0)
struct XcdBarrier { unsigned* bar; unsigned x; volatile LAS unsigned* st; };
__device__ __forceinline__ XcdBarrier xcd_barrier_post(unsigned* bar, volatile LAS unsigned* st) {
    XcdBarrier b; b.bar = bar; b.x = xb_xcc_id(); b.st = st;
    if (threadIdx.x == 0) (void)xb_add(&bar[XB_XCNT(b.x)], 1u);
    return b;
}
__device__ __forceinline__ void xcd_barrier_complete(unsigned* bar, unsigned x, unsigned& nloc, unsigned& nx) {
    const unsigned G = gridDim.x * gridDim.y * gridDim.z;
    unsigned sum, cnt, mine, sp = 0u;
    for (;;) {
        sum = 0u; cnt = 0u; mine = 0u;
#pragma unroll
        for (unsigned j = 0; j < 16; ++j) { const unsigned c = xb_ld(&bar[XB_XCNT(j)]); sum += c; cnt += (c > 0u) ? 1u : 0u; mine = (j == x) ? c : mine; }
        if (sum == G) break;
        __builtin_amdgcn_s_sleep(1);
        if ((++sp & 255u) == 0u) { if (xb_ld(&bar[XB_TMO])) break; if (sp > XB_SPIN_CAP) { atomicAdd(&bar[XB_TMO], 1u); break; } }
    }
    nloc = mine > 0u ? mine : 1u; nx = cnt > 0u ? cnt : 1u;
}
__device__ __forceinline__ void xcd_barrier(const XcdBarrier& b, const int tid) {
    asm volatile("s_waitcnt vmcnt(0)" ::: "memory");
    __syncthreads();
    if (tid == 0) {
        unsigned* bar = b.bar;
        __builtin_amdgcn_s_waitcnt(0);
        unsigned nloc = b.st[0], nx = b.st[1];
        if (nloc == 0u) { xcd_barrier_complete(bar, b.x, nloc, nx); b.st[0] = nloc; b.st[1] = nx; }
        const unsigned old = xb_add(&bar[XB_XSUB(b.x)], 1u);
        const unsigned gen = old / nloc;
        if (old + 1u == (gen + 1u) * nloc) {
            __builtin_amdgcn_fence(__ATOMIC_RELEASE, "agent");
            asm volatile("s_waitcnt vmcnt(0)" ::: "memory");
            const unsigned og = xb_add(&bar[XB_TOP], 1u);
            const unsigned tg = og / nx;
            if (og + 1u == (tg + 1u) * nx) xb_add(&bar[XB_TOPGEN], 1u);
            else XB_SPIN(xb_ld(&bar[XB_TOPGEN]) == tg, bar);
            __builtin_amdgcn_fence(__ATOMIC_ACQUIRE, "agent");
            xb_add(&bar[XB_XGEN(b.x)], 1u);
            asm volatile("s_waitcnt vmcnt(0)" ::: "memory");
        } else {
            XB_SPIN(xb_ld(&bar[XB_XGEN(b.x)]) == gen, bar);
            __builtin_amdgcn_fence(__ATOMIC_ACQUIRE, "agent");
            asm volatile("s_waitcnt vmcnt(0)" ::: "memory");
        }
    }
    __syncthreads();
}

struct Params { const float* in[23]; float* out; unsigned char* ws; float inv_freq[64]; };

__global__ void __launch_bounds__(512, 2) fwd_megakernel(Params P) {
    extern __shared__ __attribute__((aligned(16))) unsigned char lds_raw[];
    LAS unsigned char* lds = (LAS unsigned char*)lds_raw;
    cg::grid_group grid = cg::this_grid();
    const int wave_s = __builtin_amdgcn_readfirstlane(threadIdx.x >> 6);
#define PHASE_WS unsigned long long wsv_ = (unsigned long long)P.ws; asm volatile("" : "+s"(wsv_)); unsigned char* ws = (unsigned char*)(__attribute__((address_space(1))) unsigned char*)wsv_; unsigned z_ = 0u; asm volatile("" : "+v"(z_)); const int tid = wave_s * 64 + (int)__builtin_amdgcn_mbcnt_hi(~0u, __builtin_amdgcn_mbcnt_lo(~0u, z_)); \
    const int lane = tid & 63, wave = __builtin_amdgcn_readfirstlane(tid >> 6), G = gridDim.x, gw = blockIdx.x * 8 + wave, ngw = G * 8; \
    const size_t gtid = (size_t)blockIdx.x * 512 + tid, gthreads = (size_t)G * 512; \
    LAS unsigned char* wl = lds + wave * WAVE_LDS; LAS float* scr = (LAS float*)wl; (void)lane; (void)gw; (void)ngw; (void)gtid; (void)gthreads; (void)wl; (void)scr
#define WAB ((bf16_t*)(ws + WS_WAB))
#define WO ((bf16_t*)(ws + WS_WO))
#define CW1K ((bf16_t*)(ws + WS_CW1K))
#define CW1V ((bf16_t*)(ws + WS_CW1V))
#define CW2K ((bf16_t*)(ws + WS_CW2K))
#define CW2V ((bf16_t*)(ws + WS_CW2V))
#define CBIAS ((float*)(ws + WS_CBIAS))
#define KC ((bf16_t*)(ws + WS_KC))
#define VC ((bf16_t*)(ws + WS_VC))
#define GN ((bf16_t*)(ws + WS_GN))
#define HF ((float*)(ws + WS_HF))
#define HB ((bf16_t*)(ws + WS_HB))
#define GU ((bf16_t*)(ws + WS_GU))
#define DN ((bf16_t*)(ws + WS_DN))
#define ACT ((bf16_t*)(ws + WS_ACT))
#define PROJ ((bf16_t*)(ws + WS_PROJ))
#define KSLF ((bf16_t*)(ws + WS_KSLF))
#define VSLF ((bf16_t*)(ws + WS_VSLF))
#define KWNF ((bf16_t*)(ws + WS_KWNF))
#define VWNF ((bf16_t*)(ws + WS_VWNF))
#define RCOS ((float*)(ws + WS_ROPE))
#define RSIN ((float*)(ws + WS_ROPE) + (size_t)S * 64)
#define WINT ((bf16_t*)(ws + WS_WIN))
#define NSAOUT ((bf16_t*)(ws + WS_NSAOUT))
#define SIGG ((bf16_t*)P.out)
    pg8::StaticOrder SO;
#define CG_SYNC() do { asm volatile("s_waitcnt vmcnt(0) lgkmcnt(0)" ::: "memory"); grid.sync(); \
        if (__builtin_amdgcn_readfirstlane(threadIdx.x >> 6) == 0) { __builtin_amdgcn_fence(__ATOMIC_ACQUIRE, "agent"); asm volatile("s_waitcnt vmcnt(0)" ::: "memory"); } \
        __syncthreads(); } while (0)
    volatile LAS unsigned* xst = (volatile LAS unsigned*)(lds + 8 * WAVE_LDS);
    if (threadIdx.x < 2) xst[threadIdx.x] = 0u;
    __syncthreads();
    const XcdBarrier xbar = xcd_barrier_post((unsigned*)P.ws, xst);
#define GRID_SYNC() do { asm volatile("s_waitcnt vmcnt(0) lgkmcnt(0)" ::: "memory"); unsigned zz_ = 0u; asm volatile("" : "+v"(zz_)); \
        xcd_barrier(xbar, wave_s * 64 + (int)__builtin_amdgcn_mbcnt_hi(~0u, __builtin_amdgcn_mbcnt_lo(~0u, zz_))); } while (0)

    { PHASE_WS;
        conv_ffn(P.in[1], P.in[2], P.in[3], GU, DN, scr, gw, ngw, lane);
        for (int it = gw; it < 32 * 360; it += ngw) { const int kb = it / 360, nb = it % 360, dr = nb * 32; const int sc = win_src_col(dr);
            tr_item(P.in[6], WIN_SRC, kb * 64, sc < 0 ? 0 : sc, sc < 0 ? 0 : (dr == 11264 ? 24 : 32), WINT, DM, dr, kb * 64, scr, lane); }
        for (int it = gw; it < 16 * 64; it += ngw) { const int kb = it / 64, nb = it % 64; tr_item(P.in[13], DM, kb * 64, nb * 32, 32, WAB, 1024, nb * 32, kb * 64, scr, lane); }
        for (int it = gw; it < 8 * 64; it += ngw) { const int kb = it / 64, nb = it % 64; tr_item(P.in[14], DM, kb * 64, nb * 32, 32, WAB + (size_t)DM * 1024, 512, nb * 32, kb * 64, scr, lane); }
        for (int it = gw; it < 32 * 64; it += ngw) { const int kb = it / 64, nb = it % 64; tr_item(P.in[15], DM, kb * 64, nb * 32, 32, WO, DM, nb * 32, kb * 64, scr, lane); }
        for (int it = gw; it < 2 * 64 * 8; it += ngw) { const int w = it / 512, r = it % 512, kb = r / 8, nb = r % 8; tr_item(w ? P.in[11] : P.in[8], 256, kb * 64, nb * 32, 32, w ? CW1V : CW1K, 4096, nb * 32, kb * 64, scr, lane); }
        for (int it = gw; it < 2 * 4 * 4; it += ngw) { const int w = it / 16, r = it % 16, kb = r / 4, nb = r % 4; tr_item(w ? P.in[12] : P.in[9], 128, kb * 64, nb * 32, 32, w ? CW2V : CW2K, 256, nb * 32, kb * 64, scr, lane); }
        { const float* x = P.in[0];
            for (size_t i = gtid; i < (size_t)S * DM / 8; i += gthreads) { const f32x4 a = *(const f32x4*)(x + 8 * i), b = *(const f32x4*)(x + 8 * i + 4); *(u32x4*)(HB + 8 * i) = pack8(a, b); } }
        for (int o = gw; o < 512; o += ngw) { const int w = o >> 8, c = o & 255; const float* pos = w ? P.in[10] : P.in[7]; const float* w1 = w ? P.in[11] : P.in[8];
            float s = 0.f; for (int kk = lane; kk < 4096; kk += 64) s += pos[kk] * w1[(size_t)kk * 256 + c];
            s = wave_sum(s); if (lane == 0) CBIAS[o] = s; }
    }
    CG_SYNC();
    { PHASE_WS; pg8::Gemm g{HB, GU, S, NGU, DM, DM, DM}; SO.init(S, NGU, G, (int)blockIdx.x); EpiSwiglu E{ACT}; pg8::gemm_phase(lds, g, SO, E, tid); }
    GRID_SYNC();
    { PHASE_WS; pg8::Gemm g{ACT, DN, S, DM, FF, FF, FF}; SO.init(S, DM, G, (int)blockIdx.x); EpiResF32 E{P.in[0], HF, ALPHA, 0.5f}; pg8::gemm_phase(lds, g, SO, E, tid); }
    GRID_SYNC();
    { PHASE_WS;
        ln_rows(HF, HF, HB, P.in[4], P.in[5], gw, ngw, lane);
        for (size_t i = gtid; i < (size_t)S * 64; i += gthreads) { const int t = (int)(i >> 6), j = (int)(i & 63); const float ang = (float)t * P.inv_freq[j]; RCOS[i] = cosf(ang); RSIN[i] = sinf(ang); }
    }
    GRID_SYNC();
    { PHASE_WS; pg8::Gemm g{HB, WINT, S, NWIN, DM, DM, DM}; SO.init(S, NWIN, G, (int)blockIdx.x); EpiWin E{PROJ, SIGG, GN, RCOS, KSLF}; pg8::gemm_phase(lds, g, SO, E, tid); }
    GRID_SYNC();
    { PHASE_WS;
        if (wave == 0) { for (int u = blockIdx.x; u < 256; u += G) { const int kv = u >> 7; compress_unit(u, PROJ, kv ? CW1V : CW1K, kv ? CW2V : CW2K, CBIAS + 256 * kv, kv ? VC : KC, wl, lane); } }
        else { for (int u = blockIdx.x * 7 + (wave - 1); u < 4096; u += G * 7) dilated_unit(u, PROJ, NSAOUT, wl, lane); }
    }
    GRID_SYNC();
    { PHASE_WS;
      if ((G & 7) == 0) {
          const int bx = blockIdx.x, x = bx & 7, g = x & 1, wj = ((bx >> 3) * 4 + (x >> 1)) * 8 + wave, nwj = (G >> 1) * 8;
          for (int tb = wj; tb < 4096; tb += nwj) nsa_unit(2 * tb + g, PROJ, KC, VC, GN, RCOS, RSIN, KSLF, VSLF, KWNF, VWNF, NSAOUT, wl, lane);
      } else { for (int u = gw; u < 8192; u += ngw) nsa_unit(u, PROJ, KC, VC, GN, RCOS, RSIN, KSLF, VSLF, KWNF, VWNF, NSAOUT, wl, lane); } }
    GRID_SYNC();
    { PHASE_WS; SO.init(S, DM, G, (int)blockIdx.x);
      { pg8::Gemm g{NSAOUT, WAB, S, DM, 1024, NOLD, 1024}; EpiGate<true> E{SIGG, HB}; pg8::gemm_phase(lds, g, SO, E, tid); }
      { pg8::Gemm g{NSAOUT + 1024, WAB + (size_t)DM * 1024, S, DM, 512, NOLD, 512}; EpiGate<false> E{SIGG + 2048, HB}; pg8::gemm_phase(lds, g, SO, E, tid); } }
    GRID_SYNC();
    { PHASE_WS; pg8::Gemm g{HB, WO, S, DM, DM, DM, DM}; SO.init(S, DM, G, (int)blockIdx.x); EpiResF32 E{HF, HF, ALPHA, 1.0f}; pg8::gemm_phase(lds, g, SO, E, tid); }
    GRID_SYNC();
    { PHASE_WS;
        ln_rows(HF, HF, HB, P.in[16], P.in[17], gw, ngw, lane);
        conv_ffn(P.in[18], P.in[19], P.in[20], GU, DN, scr, gw, ngw, lane);
    }
    GRID_SYNC();
    { PHASE_WS; pg8::Gemm g{HB, GU, S, NGU, DM, DM, DM}; SO.init(S, NGU, G, (int)blockIdx.x); EpiSwiglu E{ACT}; pg8::gemm_phase(lds, g, SO, E, tid); }
    GRID_SYNC();
    { PHASE_WS; pg8::Gemm g{ACT, DN, S, DM, FF, FF, FF}; SO.init(S, DM, G, (int)blockIdx.x); EpiResF32 E{HF, P.out, ALPHA, 0.5f}; pg8::gemm_phase(lds, g, SO, E, tid); }
    GRID_SYNC();
    { PHASE_WS; (void)ws; ln_rows(P.out, P.out, nullptr, P.in[21], P.in[22], gw, ngw, lane); }
}

extern "C" void kernel_launch(void* const* d_in, const int* in_sizes, int n_in, void* d_out, int out_size, void* d_ws, size_t ws_size, hipStream_t stream) {
    static int grid = 0;
    if (grid == 0) {
        if (n_in != 23 || out_size != S * DM || ws_size < WS_END) { fprintf(stderr, "kernel_launch: unexpected shapes (n_in %d out %d ws %zu, need %zu)\n", n_in, out_size, ws_size, (size_t)WS_END); grid = -1; return; }
        int dev = 0, cus = 0, per_cu = 0;
        hipGetDevice(&dev); hipDeviceGetAttribute(&cus, hipDeviceAttributeMultiprocessorCount, dev);
        if (hipFuncSetAttribute((const void*)fwd_megakernel, hipFuncAttributeMaxDynamicSharedMemorySize, LDS_BYTES) != hipSuccess) { fprintf(stderr, "kernel_launch: hipFuncSetAttribute failed\n"); grid = -1; return; }
        if (hipOccupancyMaxActiveBlocksPerMultiprocessor(&per_cu, (const void*)fwd_megakernel, 512, LDS_BYTES) != hipSuccess || per_cu < 1) { fprintf(stderr, "kernel_launch: occupancy query failed (%d)\n", per_cu); (void)hipGetLastError(); per_cu = 1; }
        grid = cus * per_cu;
    }
    if (grid < 0) return;
    if (hipMemsetAsync(d_ws, 0, 16384, stream) != hipSuccess) { fprintf(stderr, "kernel_launch: memset of the barrier words failed\n"); return; }
    Params p{};
    for (int i = 0; i < 23; ++i) p.in[i] = (const float*)d_in[i];
    p.out = (float*)d_out; p.ws = (unsigned char*)d_ws;
    for (int i = 0; i < 64; ++i) p.inv_freq[i] = (float)pow(10000.0, -(double)i / 64.0);
    void* args[] = {&p};
    hipError_t e = hipLaunchCooperativeKernel((const void*)fwd_megakernel, dim3(grid), dim3(512), args, LDS_BYTES, stream);
    if (e != hipSuccess) fprintf(stderr, "kernel_launch: cooperative launch failed: %s (grid %d)\n", hipGetErrorString(e), grid);
}
```

```cpp
#include <hip/hip_runtime.h>
#include <hip/hip_cooperative_groups.h>
#include <cstdio>
#include <cstdint>
#include <cmath>
namespace cg = cooperative_groups;

#define LAS __attribute__((address_space(3)))
typedef unsigned short bf16_t;
typedef short bf16x8 __attribute__((ext_vector_type(8)));
typedef short s16x4 __attribute__((ext_vector_type(4)));
typedef float f32x4 __attribute__((ext_vector_type(4)));
typedef float f32x2 __attribute__((ext_vector_type(2)));
typedef unsigned u32x4 __attribute__((ext_vector_type(4)));
typedef unsigned u32x2 __attribute__((ext_vector_type(2)));

constexpr int S = 16384, DM = 2048, FF = 5632, NGU = 2 * FF, NWIN = 11520, WIN_SRC = 11288, PLD = 3072, NOLD = 1536;
constexpr float ALPHA = 1.189207115002721f;
constexpr float LN_EPS = 1e-5f;
constexpr float SL2 = 0.08838834764831845f * 1.4426950408889634f;
constexpr int PC_QA = 0, PC_KC = 1024, PC_VC = 1280, PC_QB = 1536;
constexpr size_t MiB = 1u << 20;
constexpr size_t WS_WAB = 1 * MiB, WS_WO = 13 * MiB, WS_CW1K = 21 * MiB, WS_CW1V = 23 * MiB, WS_CW2K = 25 * MiB, WS_CW2V = 25 * MiB + 65536, WS_CBIAS = 25 * MiB + 131072;
constexpr size_t WS_KC = 26 * MiB, WS_VC = 26 * MiB + 524288, WS_GN = 27 * MiB, WS_ST1 = 28 * MiB, WS_ST2 = 28 * MiB + 131072;
constexpr size_t WS_HF = 32 * MiB, WS_HB = 160 * MiB, WS_BIG = 224 * MiB;
constexpr size_t WS_GU = WS_BIG, WS_DN = WS_BIG + 44 * MiB, WS_ACT = WS_BIG + 66 * MiB;
constexpr size_t WS_KBF = WS_BIG + 96 * MiB, WS_VBF = WS_BIG + 144 * MiB;
constexpr size_t WS_PROJ = WS_BIG, WS_KSLF = WS_BIG + 192 * MiB, WS_VSLF = WS_BIG + 200 * MiB, WS_KWNF = WS_BIG + 208 * MiB, WS_VWNF = WS_BIG + 216 * MiB, WS_ROPE = WS_BIG + 224 * MiB;
constexpr size_t WS_WIN = 466 * MiB, WS_NSAOUT = 466 * MiB, WS_END = 514 * MiB;

constexpr int VROW = 288, VBUF_BYTES = 32 * VROW;
constexpr int IMP_LD = 260;
constexpr int OUT_OFF = VBUF_BYTES + 4 * IMP_LD * 4 + 256 + 512;
constexpr int WAVE_LDS = OUT_OFF + 4096;
constexpr int LDS_BYTES = 147456;
static_assert(8 * WAVE_LDS + 16 <= LDS_BYTES && 131072 <= LDS_BYTES, "LDS map");

typedef __bf16 bf16x2_t __attribute__((ext_vector_type(2)));
__device__ __forceinline__ unsigned cvt_pk_bf16(float lo, float hi) { f32x2 v = {lo, hi}; bf16x2_t b = __builtin_convertvector(v, bf16x2_t); return __builtin_bit_cast(unsigned, b); }
__device__ __forceinline__ float bf2f(unsigned short b) { return __uint_as_float(((unsigned)b) << 16); }
__device__ __forceinline__ float bflo(unsigned w) { return __uint_as_float(w << 16); }
__device__ __forceinline__ float bfhi(unsigned w) { return __uint_as_float(w & 0xffff0000u); }
__device__ __forceinline__ float fsigmoid(float x) { return __builtin_amdgcn_rcpf(1.f + __expf(-x)); }
__device__ __forceinline__ float wave_sum(float v) {
#pragma unroll
    for (int o = 1; o < 64; o <<= 1) v += __shfl_xor(v, o);
    return v;
}
typedef long i64_t;
__device__ __forceinline__ u32x2 pack8_fp8(const f32x4 a, const f32x4 b) {
    unsigned lo = 0u, hi = 0u;
    lo = __builtin_amdgcn_cvt_pk_fp8_f32(a[0], a[1], lo, false); lo = __builtin_amdgcn_cvt_pk_fp8_f32(a[2], a[3], lo, true);
    hi = __builtin_amdgcn_cvt_pk_fp8_f32(b[0], b[1], hi, false); hi = __builtin_amdgcn_cvt_pk_fp8_f32(b[2], b[3], hi, true);
    return (u32x2){lo, hi};
}
__device__ __forceinline__ u32x4 pack8(const f32x4 a, const f32x4 b) { u32x4 w; w.x = cvt_pk_bf16(a[0], a[1]); w.y = cvt_pk_bf16(a[2], a[3]); w.z = cvt_pk_bf16(b[0], b[1]); w.w = cvt_pk_bf16(b[2], b[3]); return w; }

namespace pg8 {
constexpr int BM = 256, BK = 64, HALF = 128, HTB = HALF * BK * 2, STAGE_BYTES = 8 * HTB, NXCD = 8, WGM = 8;
__host__ __device__ __forceinline__ int lds_byte(int r, int c) { const int st = (r >> 4) * 2 + (c >> 5), rr = r & 15, cc = c & 31, ob = rr * 64 + cc * 2; return st * 1024 + (ob ^ (((ob >> 9) & 1) << 5)); }
__host__ __device__ __forceinline__ void stage_rc(int b, int& R, int& C) { const int st = b / 1024, sb = b % 1024, swz = sb ^ (((sb >> 9) & 1) << 5); R = (st >> 1) * 16 + swz / 64; C = (st & 1) * 32 + (swz % 64) / 2; }
__host__ __device__ __forceinline__ int perm32(int rho) { const int n = rho >> 4, i = rho & 15; return 8 * (i >> 2) + 4 * n + (i & 3); }
struct Unit { int pm, pn; };
struct Gemm { const bf16_t* A; const bf16_t* Bt; int M, N, K, lda, ldb; };
struct StaticOrder {
    int nM, nN, nwg, G, c;
    __device__ void init(int M, int N, int G_, int c_) { nM = M / BM; nN = N / BM; nwg = nM * nN; G = G_; c = c_; }
    __device__ bool next(int i, Unit& u) const {
        const long L = (long)i * G + c; if (L >= nwg) return false;
        int wgid = (int)L; { const int q = nwg / NXCD, r = nwg % NXCD, xcd = wgid % NXCD, off = wgid / NXCD; wgid = (xcd < r ? xcd * (q + 1) : r * (q + 1) + (xcd - r) * q) + off; }
        const int nig = WGM * nN, gid = wgid / nig, fm = gid * WGM, gsz = (nM - fm) < WGM ? (nM - fm) : WGM;
        u.pm = fm + ((wgid % nig) % gsz); u.pn = (wgid % nig) / gsz; return true;
    }
};
typedef f32x4 Acc[2][2][4][2];

template <class Epi>
__device__ __forceinline__ void gemm_phase(LAS unsigned char* lds, const Gemm g, const StaticOrder& S_, const Epi& E, const int tid) {
    const int wid = __builtin_amdgcn_readfirstlane(tid >> 6), lane = tid & 63, wr = wid >> 2, wc = wid & 3, fr = lane & 15, fq = lane >> 4;
    const int K = g.K, nt = K / BK;
    unsigned voffA[2], voffB[2];
#pragma unroll
    for (int i = 0; i < 2; ++i) { int R, C; stage_rc(tid * 16 + i * 8192, R, C); const int Rb = Epi::PERM ? ((R & ~31) + perm32(R & 31)) : R;
        voffA[i] = (unsigned)(R * g.lda + C) * 2u; voffB[i] = (unsigned)(Rb * g.ldb + C) * 2u; }
    const size_t kstep = (size_t)(BK * 2);
    const size_t hstepA = (size_t)HALF * g.lda * 2, hstepB = (size_t)HALF * g.ldb * 2;
    const size_t tstepA = 2 * hstepA, tstepB = 2 * hstepB;
    const unsigned ldsw = (unsigned)wid * 1024u;
    const int aoff = lds_byte(wr * 64 + fr, fq * 8), boff = lds_byte(wc * 32 + fr, fq * 8);
#define PG8_SA(b, h) (((b) * 2 + (h)) * HTB)
#define PG8_SB(b, h) ((4 + (b) * 2 + (h)) * HTB)
#define PG8_STAGE(bufoff, gbase, voff) do { _Pragma("unroll") for (int _i = 0; _i < 2; ++_i) \
        __builtin_amdgcn_global_load_lds((const unsigned*)((const char*)(gbase) + (voff)[_i]), (LAS unsigned*)(lds + (bufoff) + ldsw + _i * 8192), 16, 0, 0); } while (0)
#define PG8_LDA(dst, b, h) do { _Pragma("unroll") for (int m = 0; m < 4; ++m) _Pragma("unroll") for (int k = 0; k < 2; ++k) dst[m][k] = *(const LAS bf16x8*)(lds + PG8_SA(b, h) + aoff + m * 2048 + k * 1024); } while (0)
#define PG8_LDB(dst, b, h) do { _Pragma("unroll") for (int n = 0; n < 2; ++n) _Pragma("unroll") for (int k = 0; k < 2; ++k) dst[n][k] = *(const LAS bf16x8*)(lds + PG8_SB(b, h) + boff + n * 2048 + k * 1024); } while (0)
#define PG8_MMA(ai, bj, At, Bt) do { __builtin_amdgcn_s_setprio(1); _Pragma("unroll") for (int m = 0; m < 4; ++m) _Pragma("unroll") for (int n = 0; n < 2; ++n) _Pragma("unroll") for (int k = 0; k < 2; ++k) \
        acc[ai][bj][m][n] = __builtin_amdgcn_mfma_f32_16x16x32_bf16(Bt[n][k], At[m][k], acc[ai][bj][m][n], 0, 0, 0); __builtin_amdgcn_s_setprio(0); } while (0)
#define PG8_WAIT_V(n) asm volatile("s_waitcnt vmcnt(" #n ")" ::: "memory")
#define PG8_WAIT_L(n) asm volatile("s_waitcnt lgkmcnt(" #n ")" ::: "memory")
#define PG8_BAR __builtin_amdgcn_s_barrier()
#define PG8_SCHED __builtin_amdgcn_sched_barrier(0)
    Unit cur, nxt; int ui = 0;
    if (!S_.next(0, cur)) return;
    Acc acc;
#pragma unroll
    for (int a = 0; a < 2; ++a)
#pragma unroll
        for (int b = 0; b < 2; ++b)
#pragma unroll
            for (int m = 0; m < 4; ++m)
#pragma unroll
                for (int n = 0; n < 2; ++n) acc[a][b][m][n] = (f32x4){0.f, 0.f, 0.f, 0.f};
    bf16x8 At[4][2], B0[2][2], B1[2][2];
    const char* cA = (const char*)g.A + (size_t)cur.pm * tstepA; const char* cB = (const char*)g.Bt + (size_t)cur.pn * tstepB;
    PG8_STAGE(PG8_SB(0, 0), cB, voffB); PG8_STAGE(PG8_SB(0, 1), cB + hstepB, voffB); PG8_STAGE(PG8_SA(0, 0), cA, voffA); PG8_STAGE(PG8_SA(0, 1), cA + hstepA, voffA);
    if (wr == 1) PG8_BAR;
    PG8_WAIT_V(2); PG8_BAR;
    PG8_STAGE(PG8_SB(1, 0), cB + kstep, voffB); PG8_STAGE(PG8_SA(1, 0), cA + kstep, voffA); PG8_STAGE(PG8_SB(1, 1), cB + hstepB + kstep, voffB);
    PG8_WAIT_V(6); PG8_BAR;
    for (;;) {
        const bool has_next = S_.next(ui + 1, nxt);
        const char* nA = has_next ? (const char*)g.A + (size_t)nxt.pm * tstepA : cA; const char* nB = has_next ? (const char*)g.Bt + (size_t)nxt.pn * tstepB : cB;
        for (int t = 0; t < nt; t += 2) {
            const bool last = (t == nt - 2);
            const char* a1 = cA + (size_t)(t + 1) * kstep;
            const char* a2 = last ? nA : cA + (size_t)(t + 2) * kstep; const char* b2 = last ? nB : cB + (size_t)(t + 2) * kstep;
            const char* a3 = a2 + kstep; const char* b3 = b2 + kstep;
            PG8_LDB(B0, 0, 0); PG8_LDB(B1, 0, 1); PG8_SCHED; PG8_LDA(At, 0, 0); PG8_STAGE(PG8_SA(1, 1), a1 + hstepA, voffA);
            PG8_WAIT_V(8); PG8_WAIT_L(0); PG8_BAR; PG8_MMA(0, 0, At, B0); PG8_MMA(0, 1, At, B1); PG8_BAR; PG8_SCHED;
            PG8_LDA(At, 0, 1); PG8_STAGE(PG8_SB(0, 0), b2, voffB); PG8_STAGE(PG8_SB(0, 1), b2 + hstepB, voffB); PG8_STAGE(PG8_SA(0, 0), a2, voffA);
            PG8_WAIT_V(8); PG8_WAIT_L(0); PG8_BAR; PG8_MMA(1, 0, At, B0); PG8_MMA(1, 1, At, B1); PG8_BAR; PG8_SCHED;
            PG8_LDB(B0, 1, 0); PG8_LDB(B1, 1, 1); PG8_SCHED; PG8_LDA(At, 1, 0); PG8_STAGE(PG8_SA(0, 1), a2 + hstepA, voffA);
            PG8_WAIT_V(8); PG8_WAIT_L(0); PG8_BAR; PG8_MMA(0, 0, At, B0); PG8_MMA(0, 1, At, B1); PG8_BAR; PG8_SCHED;
            PG8_LDA(At, 1, 1); PG8_STAGE(PG8_SB(1, 0), b3, voffB); PG8_STAGE(PG8_SB(1, 1), b3 + hstepB, voffB); PG8_STAGE(PG8_SA(1, 0), a3, voffA);
            PG8_WAIT_V(8); PG8_WAIT_L(0); PG8_BAR; PG8_MMA(1, 0, At, B0); PG8_MMA(1, 1, At, B1); PG8_BAR; PG8_SCHED;
        }
        if (wr == 0) PG8_BAR;
        E(acc, cur, wr, wc, fr, fq);
        if (!has_next) break;
#pragma unroll
        for (int a = 0; a < 2; ++a)
#pragma unroll
            for (int b = 0; b < 2; ++b)
#pragma unroll
                for (int m = 0; m < 4; ++m)
#pragma unroll
                    for (int n = 0; n < 2; ++n) acc[a][b][m][n] = (f32x4){0.f, 0.f, 0.f, 0.f};
        cur = nxt; cA = nA; cB = nB; ++ui;
        if (wr == 1) PG8_BAR;
    }
    PG8_WAIT_V(0);
    PG8_BAR;
#undef PG8_SA
#undef PG8_SB
#undef PG8_STAGE
#undef PG8_LDA
#undef PG8_LDB
#undef PG8_MMA
#undef PG8_WAIT_V
#undef PG8_WAIT_L
#undef PG8_BAR
#undef PG8_SCHED
}
}

struct EpiSwiglu {
    static constexpr bool PERM = true;
    bf16_t* O;
    __device__ __forceinline__ void operator()(const pg8::Acc& acc, const pg8::Unit& u, int wr, int wc, int fr, int fq) const {
        const int row0 = u.pm * 256 + wr * 64 + fr, col0 = u.pn * 128 + wc * 32 + 8 * fq;
#pragma unroll
        for (int ai = 0; ai < 2; ++ai)
#pragma unroll
            for (int m = 0; m < 4; ++m) {
                f32x4 v[2];
#pragma unroll
                for (int n = 0; n < 2; ++n)
#pragma unroll
                    for (int e = 0; e < 4; ++e) { const float gt = acc[ai][0][m][n][e], up = acc[ai][1][m][n][e]; v[n][e] = gt * fsigmoid(gt) * up; }
                *(u32x4*)(O + (size_t)(row0 + ai * 128 + m * 16) * FF + col0) = pack8(v[0], v[1]);
            }
    }
};
struct EpiResF32 {
    static constexpr bool PERM = false;
    const float* res; float* out; float a, b;
    __device__ __forceinline__ void operator()(const pg8::Acc& acc, const pg8::Unit& u, int wr, int wc, int fr, int fq) const {
        const int row0 = u.pm * 256 + wr * 64 + fr, col0 = u.pn * 256 + wc * 32 + 4 * fq;
#pragma unroll
        for (int ai = 0; ai < 2; ++ai)
#pragma unroll
            for (int m = 0; m < 4; ++m) {
                const size_t off = (size_t)(row0 + ai * 128 + m * 16) * DM + col0;
#pragma unroll
                for (int bj = 0; bj < 2; ++bj)
#pragma unroll
                    for (int n = 0; n < 2; ++n) { const f32x4 r = *(const f32x4*)(res + off + bj * 128 + n * 16); *(f32x4*)(out + off + bj * 128 + n * 16) = r * a + acc[ai][bj][m][n] * b; }
            }
    }
};
struct EpiResLnF32 {
    static constexpr bool PERM = false;
    const float* pre; const float* stats; const float* g; const float* beta; float* out; float a, b;
    __device__ __forceinline__ void operator()(const pg8::Acc& acc, const pg8::Unit& u, int wr, int wc, int fr, int fq) const {
        const int row0 = u.pm * 256 + wr * 64 + fr, col0 = u.pn * 256 + wc * 32 + 4 * fq;
#pragma unroll
        for (int ai = 0; ai < 2; ++ai)
#pragma unroll
            for (int m = 0; m < 4; ++m) {
                const int row = row0 + ai * 128 + m * 16; const size_t off = (size_t)row * DM + col0;
                const f32x2 st = *(const f32x2*)(stats + 2 * (size_t)row);
#pragma unroll
                for (int bj = 0; bj < 2; ++bj)
#pragma unroll
                    for (int n = 0; n < 2; ++n) { const int co = bj * 128 + n * 16;
                        const f32x4 r = *(const f32x4*)(pre + off + co), gv = *(const f32x4*)(g + col0 + co), bv = *(const f32x4*)(beta + col0 + co);
                        const f32x4 h = (r - st.x) * st.y * gv + bv;
                        *(f32x4*)(out + off + co) = h * a + acc[ai][bj][m][n] * b; }
                if (m & 1) asm volatile("" ::: "memory");
            }
    }
};
struct EpiWin {
    static constexpr bool PERM = true;
    bf16_t* proj; bf16_t* sigg; bf16_t* gn; const float* cs; bf16_t* kslf; bf16_t* kbf;
    __device__ __forceinline__ void operator()(const pg8::Acc& acc, const pg8::Unit& u, int wr, int wc, int fr, int fq) const {
        const int tile = u.pn, row0 = u.pm * 256 + wr * 64 + fr, cw = wc * 32 + 8 * fq;
        if (tile < 28) {
            const bool rope = (tile == 6) | (tile == 8) | (tile >= 10 && tile < 22);
            const int dcol = (tile < 6 ? tile : tile - 4) * 256;
            if (!rope) {
                if (tile == 7 || tile == 9) {
                    unsigned char* VF = (unsigned char*)kslf + (tile == 7 ? (size_t)8 << 20 : (size_t)24 << 20);
#pragma unroll
                    for (int ai = 0; ai < 2; ++ai)
#pragma unroll
                        for (int m = 0; m < 4; ++m) {
                            const int row = row0 + ai * 128 + m * 16, kp = row & 31;
                            const size_t rbase = (size_t)(row >> 5) * 4096 + (size_t)(((kp >> 2) & 3) * 16) * 8 + 4 * (kp >> 4) + (kp & 3);
#pragma unroll
                            for (int bj = 0; bj < 2; ++bj) {
                                const u32x2 w = pack8_fp8(acc[ai][bj][m][0], acc[ai][bj][m][1]);
                                unsigned char* vb = VF + (size_t)bj * 512 * 4096 + rbase + (size_t)(cw >> 4) * 512 + (size_t)(cw & 15) * 8;
                                vb[0] = (unsigned char)(w.x & 0xffu); vb[8] = (unsigned char)((w.x >> 8) & 0xffu); vb[16] = (unsigned char)((w.x >> 16) & 0xffu); vb[24] = (unsigned char)(w.x >> 24);
                                vb[32] = (unsigned char)(w.y & 0xffu); vb[40] = (unsigned char)((w.y >> 8) & 0xffu); vb[48] = (unsigned char)((w.y >> 16) & 0xffu); vb[56] = (unsigned char)(w.y >> 24);
                            }
                        }
                } else if (tile >= 22) {
                    bf16_t* VB = kbf + ((size_t)24 << 20);
#pragma unroll
                    for (int ai = 0; ai < 2; ++ai)
#pragma unroll
                        for (int m = 0; m < 4; ++m) {
                            const int row = row0 + ai * 128 + m * 16;
#pragma unroll
                            for (int bj = 0; bj < 2; ++bj) {
                                const int hd = 2 * (tile - 22) + bj, sh = 2 * (hd >> 2), tp = ((row & ((1 << sh) - 1)) << (14 - sh)) + (row >> sh), kp = tp & 31;
                                const u32x4 w = pack8(acc[ai][bj][m][0], acc[ai][bj][m][1]);
                                bf16_t* vb = VB + (((size_t)hd * 512 + (tp >> 5)) * 8 + (cw >> 4)) * 512 + (size_t)(((kp >> 2) & 3) * 16 + (cw & 15)) * 8 + 4 * (kp >> 4) + (kp & 3);
                                vb[0] = (bf16_t)(w.x & 0xffffu); vb[8] = (bf16_t)(w.x >> 16); vb[16] = (bf16_t)(w.y & 0xffffu); vb[24] = (bf16_t)(w.y >> 16);
                                vb[32] = (bf16_t)(w.z & 0xffffu); vb[40] = (bf16_t)(w.z >> 16); vb[48] = (bf16_t)(w.w & 0xffffu); vb[56] = (bf16_t)(w.w >> 16);
                            }
                        }
                } else {
#pragma unroll
                    for (int ai = 0; ai < 2; ++ai)
#pragma unroll
                        for (int m = 0; m < 4; ++m)
#pragma unroll
                            for (int bj = 0; bj < 2; ++bj)
                                *(u32x4*)(proj + (size_t)(row0 + ai * 128 + m * 16) * PLD + dcol + bj * 128 + cw) = pack8(acc[ai][bj][m][0], acc[ai][bj][m][1]);
                }
            } else {
                const int head = cw >> 6, d = cw & 63;
                const bool frag = (tile == 6) | (tile == 8);
                unsigned char* KF = (unsigned char*)kslf + (tile == 6 ? (size_t)0 : (size_t)16 << 20); const float* sn = cs + (size_t)S * 64;
#pragma unroll
                for (int ai = 0; ai < 2; ++ai)
#pragma unroll
                    for (int m = 0; m < 4; ++m) {
                        const int row = row0 + ai * 128 + m * 16;
                        f32x4 o1[2], o2[2];
#pragma unroll
                        for (int n = 0; n < 2; ++n) {
                            const f32x4 c = *(const f32x4*)(cs + (size_t)row * 64 + d + 4 * n), sv = *(const f32x4*)(sn + (size_t)row * 64 + d + 4 * n);
                            const f32x4 x1 = acc[ai][0][m][n], x2 = acc[ai][1][m][n];
                            o1[n] = x1 * c - x2 * sv; o2[n] = x2 * c + x1 * sv;
                        }
                        if (frag) {
                            unsigned char* kb = KF + ((size_t)head * 1024 + (row >> 4)) * 2048 + (size_t)(d >> 5) * 512 + (size_t)(((d >> 3) & 3) * 16 + (row & 15)) * 8;
                            *(u32x2*)kb = pack8_fp8(o1[0], o1[1]); *(u32x2*)(kb + 1024) = pack8_fp8(o2[0], o2[1]);
                        } else if (tile >= 16) {
                            const int hd = 2 * (tile - 16) + head, sh = 2 * (hd >> 2), tp = ((row & ((1 << sh) - 1)) << (14 - sh)) + (row >> sh);
                            bf16_t* kb = kbf + ((size_t)hd * 1024 + (tp >> 4)) * 2048 + (size_t)(d >> 5) * 512 + (size_t)(((d >> 3) & 3) * 16 + (tp & 15)) * 8;
                            *(u32x4*)kb = pack8(o1[0], o1[1]); *(u32x4*)(kb + 1024) = pack8(o2[0], o2[1]);
                        } else {
                            bf16_t* p = proj + (size_t)row * PLD + dcol + head * 128 + d;
                            *(u32x4*)p = pack8(o1[0], o1[1]); *(u32x4*)(p + 64) = pack8(o2[0], o2[1]);
                        }
                        if (m & 1) asm volatile("" ::: "memory");
                    }
            }
        } else if (tile < 44) {
#pragma unroll
            for (int ai = 0; ai < 2; ++ai)
#pragma unroll
                for (int m = 0; m < 4; ++m)
#pragma unroll
                    for (int bj = 0; bj < 2; ++bj) {
                        f32x4 v[2];
#pragma unroll
                        for (int n = 0; n < 2; ++n)
#pragma unroll
                            for (int e = 0; e < 4; ++e) v[n][e] = fsigmoid(acc[ai][bj][m][n][e]);
                        *(u32x4*)(sigg + (size_t)(row0 + ai * 128 + m * 16) * 4096 + (tile - 28) * 256 + bj * 128 + cw) = pack8(v[0], v[1]);
                    }
        } else {
            if (wc == 0) {
#pragma unroll
                for (int ai = 0; ai < 2; ++ai)
#pragma unroll
                    for (int m = 0; m < 4; ++m) {
                        f32x4 v[2];
#pragma unroll
                        for (int n = 0; n < 2; ++n)
#pragma unroll
                            for (int e = 0; e < 4; ++e) v[n][e] = fsigmoid(acc[ai][0][m][n][e]);
                        *(u32x4*)(gn + (size_t)(row0 + ai * 128 + m * 16) * 32 + cw) = pack8(v[0], v[1]);
                    }
            }
        }
    }
};
template <bool FIRST> struct EpiGate {
    static constexpr bool PERM = true;
    const bf16_t* sg; bf16_t* O;
    __device__ __forceinline__ void operator()(const pg8::Acc& acc, const pg8::Unit& u, int wr, int wc, int fr, int fq) const {
        const int row0 = u.pm * 256 + wr * 64 + fr, col0 = u.pn * 256 + wc * 32 + 8 * fq;
#pragma unroll
        for (int ai = 0; ai < 2; ++ai)
#pragma unroll
            for (int m = 0; m < 4; ++m)
#pragma unroll
                for (int bj = 0; bj < 2; ++bj) {
                    const int row = row0 + ai * 128 + m * 16, col = col0 + bj * 128;
                    const u32x4 gv = *(const u32x4*)(sg + (size_t)row * 4096 + col);
                    u32x4 pv = (u32x4){0u, 0u, 0u, 0u}; if (!FIRST) pv = *(const u32x4*)(O + (size_t)row * DM + col);
                    f32x4 v[2];
#pragma unroll
                    for (int n = 0; n < 2; ++n) {
                        const unsigned g0 = n ? gv.z : gv.x, g1 = n ? gv.w : gv.y, p0 = n ? pv.z : pv.x, p1 = n ? pv.w : pv.y;
                        const f32x4 y = acc[ai][bj][m][n];
                        v[n][0] = bflo(p0) + bflo(g0) * y[0]; v[n][1] = bfhi(p0) + bfhi(g0) * y[1];
                        v[n][2] = bflo(p1) + bflo(g1) * y[2]; v[n][3] = bfhi(p1) + bfhi(g1) * y[3];
                    }
                    *(u32x4*)(O + (size_t)row * DM + col) = pack8(v[0], v[1]);
                }
    }
};

template <bool FRAG = false>
__device__ __forceinline__ void tr_item(const float* W, int ldw, int k0, int scol0, int nvalid, bf16_t* WT, int ldt, int drow0, int dk0, LAS float* scr, int lane) {
    const int c = lane & 31;
    float v[32];
#pragma unroll
    for (int i = 0; i < 32; ++i) { const int kk = 2 * i + (lane >> 5); v[i] = (c < nvalid) ? W[(size_t)(k0 + kk) * ldw + scol0 + c] : 0.f; }
#pragma unroll
    for (int i = 0; i < 32; ++i) { const int kk = 2 * i + (lane >> 5); scr[kk * 33 + c] = v[i]; }
    asm volatile("s_waitcnt lgkmcnt(0)" ::: "memory");
    const int c8 = lane & 7;
#pragma unroll
    for (int j = 0; j < 4; ++j) { const int n = (lane >> 3) + 8 * j; const LAS float* s = scr + (8 * c8) * 33 + n;
        u32x4 o; o.x = cvt_pk_bf16(s[0 * 33], s[1 * 33]); o.y = cvt_pk_bf16(s[2 * 33], s[3 * 33]); o.z = cvt_pk_bf16(s[4 * 33], s[5 * 33]); o.w = cvt_pk_bf16(s[6 * 33], s[7 * 33]);
        if (FRAG) { const int c = drow0 + n, k = dk0 + 8 * c8; *(u32x4*)(WT + ((size_t)((c >> 4) * (ldt >> 5) + (k >> 5)) * 64 + ((k >> 3) & 3) * 16 + (c & 15)) * 8) = o; }
        else *(u32x4*)(WT + (size_t)(drow0 + n) * ldt + dk0 + 8 * c8) = o; }
    asm volatile("s_waitcnt lgkmcnt(0)" ::: "memory");
}
__device__ __forceinline__ int win_src_col(int r) {
    if (r >= WIN_SRC) return -1;
    if (r >= 11264) return 2560 + (r - 11264);
    const int tile = r >> 8; int j = r & 255;
    const bool rope = (tile == 6) | (tile == 8) | (tile >= 10 && tile < 22);
    if (rope) { const int q = j >> 6, d = j & 63; j = (q & 1) * 128 + (q >> 1) * 64 + d; }
    const int c = tile * 256 + j;
    return c < 2560 ? c : c + 24;
}
__device__ __forceinline__ void conv_ffn(const float* Wg, const float* Wu, const float* Wd, bf16_t* GU, bf16_t* DN, LAS float* scr, int gw, int ngw, int lane) {
    constexpr int I_G = 32 * 176;
    for (int it = gw; it < 2 * I_G; it += ngw) { const int which = it / I_G, r = it % I_G, kb = r / 176, nb = r % 176, c0 = nb * 32;
        tr_item(which ? Wu : Wg, FF, kb * 64, c0, 32, GU, DM, 256 * (c0 >> 7) + (c0 & 127) + which * 128, kb * 64, scr, lane); }
    for (int it = gw; it < 88 * 64; it += ngw) { const int kb = it / 64, nb = it % 64; tr_item(Wd, DM, kb * 64, nb * 32, 32, DN, FF, nb * 32, kb * 64, scr, lane); }
}
__device__ __forceinline__ void ln_rows(const float* in, float* outf, bf16_t* outb, const float* g, const float* b, int gw, int ngw, int lane, float* stats = nullptr) {
    f32x4 gv[8], bv[8];
#pragma unroll
    for (int j = 0; j < 8; ++j) { gv[j] = *(const f32x4*)(g + 4 * (lane + 64 * j)); bv[j] = *(const f32x4*)(b + 4 * (lane + 64 * j)); }
    for (int row = gw; row < S; row += ngw) {
        const float* xr = in + (size_t)row * DM; f32x4 v[8]; float s = 0.f;
#pragma unroll
        for (int j = 0; j < 8; ++j) { v[j] = *(const f32x4*)(xr + 4 * (lane + 64 * j)); s += (v[j][0] + v[j][1]) + (v[j][2] + v[j][3]); }
        const float mean = wave_sum(s) * (1.f / DM); float s2 = 0.f;
#pragma unroll
        for (int j = 0; j < 8; ++j) { v[j] = v[j] - mean; s2 += (v[j][0] * v[j][0] + v[j][1] * v[j][1]) + (v[j][2] * v[j][2] + v[j][3] * v[j][3]); }
        const float rstd = 1.f / sqrtf(wave_sum(s2) * (1.f / DM) + LN_EPS);
        if (stats && lane == 0) *(f32x2*)(stats + 2 * (size_t)row) = (f32x2){mean, rstd};
#pragma unroll
        for (int j = 0; j < 8; ++j) { const f32x4 o = v[j] * rstd * gv[j] + bv[j];
            if (outf) *(f32x4*)(outf + (size_t)row * DM + 4 * (lane + 64 * j)) = o;
            if (outb) { u32x2 w; w.x = cvt_pk_bf16(o[0], o[1]); w.y = cvt_pk_bf16(o[2], o[3]); *(u32x2*)(outb + (size_t)row * DM + 4 * (lane + 64 * j)) = w; } }
    }
}

struct AState { float m, l; f32x4 o[8]; };
__device__ __forceinline__ void astate_init(AState& s) { s.m = -1e30f; s.l = 0.f;
#pragma unroll
    for (int i = 0; i < 8; ++i) s.o[i] = (f32x4){0.f, 0.f, 0.f, 0.f}; }
__device__ __forceinline__ int clampi(int v, int lo, int hi) { return v < lo ? lo : (v > hi ? hi : v); }

__device__ __forceinline__ void load_k(bf16x8 (&kf)[2][4], const bf16_t* __restrict__ Kb, int ld, int pos0, int dpos, int posmax, int l16, int kq) {
#pragma unroll
    for (int T = 0; T < 2; ++T) { const int p = clampi(pos0 + dpos * (16 * T + l16), 0, posmax); const bf16_t* kp = Kb + (size_t)p * ld + 8 * kq;
#pragma unroll
        for (int s = 0; s < 4; ++s) kf[T][s] = *(const bf16x8*)(kp + 32 * s); }
}
__device__ __forceinline__ void load_v(u32x4 (&vr)[8], const bf16_t* __restrict__ Vb, int ld, int pos0, int dpos, int posmax, int l16, int kq) {
#pragma unroll
    for (int i = 0; i < 8; ++i) { const int p = clampi(pos0 + dpos * (4 * i + kq), 0, posmax); vr[i] = *(const u32x4*)(Vb + (size_t)p * ld + 8 * l16); }
}
__device__ __forceinline__ void store_v(const u32x4 (&vr)[8], LAS unsigned char* vbuf, int l16, int kq) {
#pragma unroll
    for (int i = 0; i < 8; ++i) *(LAS u32x4*)(vbuf + (4 * i + kq) * VROW + 16 * l16) = vr[i];
}
template <int MODE, bool SLC, class Desc>
__device__ __forceinline__ void attn_run(const bf16x8 (&qf)[4], const bf16_t* __restrict__ Kb, const bf16_t* __restrict__ Vb, int ld, int dpos, int posmax,
                                         const Desc& desc, int n, int lo_in, int hi, int qi, AState& st, LAS unsigned char* vbuf, int lane, LAS float* imp = nullptr) {
    if (n <= 0) return;
    const int l16 = lane & 15, kq = lane >> 4;
    u32x4 kr[8];
    int dcur = desc(0);
    load_v(kr, Kb, ld, SLC ? (dcur & 0xfffff) : dcur, dpos, posmax, l16, kq);
#pragma unroll 1
    for (int i = 0; i < n; ++i) {
        const int pos0 = SLC ? (dcur & 0xfffff) : dcur;
        const int lo = SLC ? ((((dcur >> 20) == qi) | ((dcur >> 20) == 4)) ? 0 : (1 << 30)) : lo_in;
        store_v(kr, vbuf, l16, kq);
        u32x4 vr[8];
        if (MODE != 1) load_v(vr, Vb, ld, pos0, dpos, posmax, l16, kq);
        bf16x8 kf[2][4];
#pragma unroll
        for (int T = 0; T < 2; ++T)
#pragma unroll
            for (int s = 0; s < 4; ++s) kf[T][s] = *(const LAS bf16x8*)(vbuf + (16 * T + l16) * VROW + 64 * s + 16 * kq);
        f32x4 sa[2] = {(f32x4){0.f, 0.f, 0.f, 0.f}, (f32x4){0.f, 0.f, 0.f, 0.f}};
#pragma unroll
        for (int T = 0; T < 2; ++T)
#pragma unroll
            for (int s = 0; s < 4; ++s) sa[T] = __builtin_amdgcn_mfma_f32_16x16x32_bf16(kf[T][s], qf[s], sa[T], 0, 0, 0);
        const int dnext = desc(i + 1 < n ? i + 1 : i);
        load_v(kr, Kb, ld, SLC ? (dnext & 0xfffff) : dnext, dpos, posmax, l16, kq);
        float sc[8]; bool vd[8]; float mx = -1e30f;
#pragma unroll
        for (int T = 0; T < 2; ++T)
#pragma unroll
            for (int r = 0; r < 4; ++r) { const int p = pos0 + dpos * (16 * T + 4 * kq + r); const bool v = (p >= lo) & (p <= hi); const float x = sa[T][r] * SL2;
                sc[4 * T + r] = x; vd[4 * T + r] = v; mx = v ? fmaxf(mx, x) : mx; }
        float p[8];
        if (MODE == 2) {
#pragma unroll
            for (int j = 0; j < 8; ++j) p[j] = vd[j] ? __builtin_amdgcn_exp2f(sc[j] - st.m) * st.l : 0.f;
#pragma unroll
            for (int T = 0; T < 2; ++T) {
                float x = 2.f * (p[4 * T] + p[4 * T + 1] + p[4 * T + 2]) + p[4 * T + 3], y = p[4 * T + 3];
                x += __shfl_xor(x, 1); x += __shfl_xor(x, 2); y += __shfl_xor(y, 1); y += __shfl_xor(y, 2);
                if ((l16 & 3) == 0) { const int a = (pos0 >> 2) + 4 * T + kq; LAS float* ip = imp + (l16 >> 2) * IMP_LD + a;
                    ip[0] += x;
                    asm volatile("s_waitcnt lgkmcnt(0)" ::: "memory");
                    ip[1] += y; }
                asm volatile("s_waitcnt lgkmcnt(0)" ::: "memory");
            }
        } else {
            if (__builtin_amdgcn_ballot_w64(mx > st.m + 40.f) != 0ull) {
                mx = fmaxf(mx, __shfl_xor(mx, 16)); mx = fmaxf(mx, __shfl_xor(mx, 32));
                const float mn = fmaxf(st.m, mx), alpha = __builtin_amdgcn_exp2f(st.m - mn); st.m = mn; st.l *= alpha;
                if (MODE == 0) {
#pragma unroll
                    for (int j = 0; j < 8; ++j) st.o[j] = st.o[j] * alpha;
                }
            }
            float ps = 0.f;
#pragma unroll
            for (int j = 0; j < 8; ++j) { p[j] = vd[j] ? __builtin_amdgcn_exp2f(sc[j] - st.m) : 0.f; ps += p[j]; }
            st.l += ps;
        }
        if (MODE != 1) {
            store_v(vr, vbuf, l16, kq);
            u32x4 pw; pw.x = cvt_pk_bf16(p[0], p[1]); pw.y = cvt_pk_bf16(p[2], p[3]); pw.z = cvt_pk_bf16(p[4], p[5]); pw.w = cvt_pk_bf16(p[6], p[7]);
            const bf16x8 pf = __builtin_bit_cast(bf16x8, pw);
            const unsigned addr = (unsigned)(uintptr_t)(vbuf) + (4 * kq + (l16 >> 2)) * VROW + (l16 & 3) * 8;
#pragma unroll
            for (int hf = 0; hf < 2; ++hf) {
                s16x4 a[8];
                asm volatile("s_waitcnt lgkmcnt(0)\n\t"
                             "ds_read_b64_tr_b16 %0, %8 offset:0\n\t"    "ds_read_b64_tr_b16 %1, %8 offset:32\n\t"
                             "ds_read_b64_tr_b16 %2, %8 offset:64\n\t"   "ds_read_b64_tr_b16 %3, %8 offset:96\n\t"
                             "ds_read_b64_tr_b16 %4, %8 offset:4608\n\t" "ds_read_b64_tr_b16 %5, %8 offset:4640\n\t"
                             "ds_read_b64_tr_b16 %6, %8 offset:4672\n\t" "ds_read_b64_tr_b16 %7, %8 offset:4704\n\t"
                             "s_waitcnt lgkmcnt(0)"
                             : "=&v"(a[0]), "=&v"(a[1]), "=&v"(a[2]), "=&v"(a[3]), "=&v"(a[4]), "=&v"(a[5]), "=&v"(a[6]), "=&v"(a[7])
                             : "v"(addr + 128 * hf) : "memory");
#pragma unroll
                for (int d4 = 0; d4 < 4; ++d4) { const int db = 4 * hf + d4;
                    bf16x8 af; af[0] = a[d4][0]; af[1] = a[d4][1]; af[2] = a[d4][2]; af[3] = a[d4][3]; af[4] = a[d4 + 4][0]; af[5] = a[d4 + 4][1]; af[6] = a[d4 + 4][2]; af[7] = a[d4 + 4][3];
                    st.o[db] = __builtin_amdgcn_mfma_f32_16x16x32_bf16(af, pf, st.o[db], 0, 0, 0); }
            }
        }
        dcur = dnext;
    }
}
template <int MODE, bool SLC, class Desc>
__device__ __forceinline__ void attn_run_frag(const bf16x8 (&qf)[4], const bf16_t* __restrict__ KF, const bf16_t* __restrict__ VF, const Desc& desc, int n,
                                              int lo_in, int hi, int qi, AState& st, int lane, LAS float* imp = nullptr) {
    if (n <= 0) return;
    const int kq = lane >> 4;
    bf16x8 kf[2][4];
    int dcur = desc(0);
    { const int pos0 = SLC ? (dcur & 0xfffff) : dcur; const bf16_t* kp = KF + ((size_t)(pos0 >> 4) * 256 + lane) * 8;
#pragma unroll
      for (int T = 0; T < 2; ++T)
#pragma unroll
          for (int s2 = 0; s2 < 4; ++s2) kf[T][s2] = *(const bf16x8*)(kp + (T * 4 + s2) * 512); }
#pragma unroll 1
    for (int i = 0; i < n; ++i) {
        const int pos0 = SLC ? (dcur & 0xfffff) : dcur;
        const int lo = SLC ? ((((dcur >> 20) == qi) | ((dcur >> 20) == 4)) ? 0 : (1 << 30)) : lo_in;
        bf16x8 vf[8];
        if (MODE != 1) { const bf16_t* vp = VF + ((size_t)(pos0 >> 5) * 512 + lane) * 8;
#pragma unroll
          for (int db = 0; db < 8; ++db) vf[db] = *(const bf16x8*)(vp + db * 512); }
        f32x4 sa[2] = {(f32x4){0.f, 0.f, 0.f, 0.f}, (f32x4){0.f, 0.f, 0.f, 0.f}};
#pragma unroll
        for (int T = 0; T < 2; ++T)
#pragma unroll
            for (int s2 = 0; s2 < 4; ++s2) sa[T] = __builtin_amdgcn_mfma_f32_16x16x32_bf16(kf[T][s2], qf[s2], sa[T], 0, 0, 0);
        const int dnext = desc(i + 1 < n ? i + 1 : i);
        { const int pn = SLC ? (dnext & 0xfffff) : dnext; const bf16_t* kp = KF + ((size_t)(pn >> 4) * 256 + lane) * 8;
#pragma unroll
          for (int T = 0; T < 2; ++T)
#pragma unroll
              for (int s2 = 0; s2 < 4; ++s2) kf[T][s2] = *(const bf16x8*)(kp + (T * 4 + s2) * 512); }
        float sc[8]; bool vd[8]; float mx = -1e30f;
#pragma unroll
        for (int T = 0; T < 2; ++T)
#pragma unroll
            for (int r = 0; r < 4; ++r) { const int p = pos0 + 16 * T + 4 * kq + r; const bool v = (p >= lo) & (p <= hi); const float x = sa[T][r] * SL2;
                sc[4 * T + r] = x; vd[4 * T + r] = v; mx = v ? fmaxf(mx, x) : mx; }
        float p[8];
        if (MODE == 2) {
            const int l16 = lane & 15;
#pragma unroll
            for (int j = 0; j < 8; ++j) p[j] = vd[j] ? __builtin_amdgcn_exp2f(sc[j] - st.m) * st.l : 0.f;
#pragma unroll
            for (int T = 0; T < 2; ++T) {
                float x = 2.f * (p[4 * T] + p[4 * T + 1] + p[4 * T + 2]) + p[4 * T + 3], y = p[4 * T + 3];
                x += __shfl_xor(x, 1); x += __shfl_xor(x, 2); y += __shfl_xor(y, 1); y += __shfl_xor(y, 2);
                if ((l16 & 3) == 0) { const int a = (pos0 >> 2) + 4 * T + kq; LAS float* ip = imp + (l16 >> 2) * IMP_LD + a;
                    ip[0] += x;
                    asm volatile("s_waitcnt lgkmcnt(0)" ::: "memory");
                    ip[1] += y; }
                asm volatile("s_waitcnt lgkmcnt(0)" ::: "memory");
            }
        } else {
            if (__builtin_amdgcn_ballot_w64(mx > st.m + 40.f) != 0ull) {
                mx = fmaxf(mx, __shfl_xor(mx, 16)); mx = fmaxf(mx, __shfl_xor(mx, 32));
                const float mn = fmaxf(st.m, mx), alpha = __builtin_amdgcn_exp2f(st.m - mn); st.m = mn; st.l *= alpha;
                if (MODE == 0) {
#pragma unroll
                    for (int j = 0; j < 8; ++j) st.o[j] = st.o[j] * alpha;
                }
            }
            float ps = 0.f;
#pragma unroll
            for (int j = 0; j < 8; ++j) { p[j] = vd[j] ? __builtin_amdgcn_exp2f(sc[j] - st.m) : 0.f; ps += p[j]; }
            st.l += ps;
        }
        if (MODE != 1) {
            u32x4 pw; pw.x = cvt_pk_bf16(p[0], p[1]); pw.y = cvt_pk_bf16(p[2], p[3]); pw.z = cvt_pk_bf16(p[4], p[5]); pw.w = cvt_pk_bf16(p[6], p[7]);
            const bf16x8 pf = __builtin_bit_cast(bf16x8, pw);
#pragma unroll
            for (int db = 0; db < 8; ++db) st.o[db] = __builtin_amdgcn_mfma_f32_16x16x32_bf16(vf[db], pf, st.o[db], 0, 0, 0);
        }
        dcur = dnext;
    }
}
template <bool SLC, class Desc>
__device__ __forceinline__ void attn_run_frag8(const i64_t (&qf)[4], const unsigned char* __restrict__ KF, const unsigned char* __restrict__ VF, const Desc& desc, int n,
                                               int lo_in, int hi, int qi, AState& st, int lane) {
    if (n <= 0) return;
    const int kq = lane >> 4;
    i64_t kf[2][4];
    int dcur = desc(0);
    { const int pos0 = SLC ? (dcur & 0xfffff) : dcur; const unsigned char* kp = KF + ((size_t)(pos0 >> 4) * 256 + lane) * 8;
#pragma unroll
      for (int T = 0; T < 2; ++T)
#pragma unroll
          for (int s2 = 0; s2 < 4; ++s2) kf[T][s2] = *(const i64_t*)(kp + (T * 4 + s2) * 512); }
#pragma unroll 1
    for (int i = 0; i < n; ++i) {
        const int pos0 = SLC ? (dcur & 0xfffff) : dcur;
        const int lo = SLC ? ((((dcur >> 20) == qi) | ((dcur >> 20) == 4)) ? 0 : (1 << 30)) : lo_in;
        i64_t vf[8];
        { const unsigned char* vp = VF + ((size_t)(pos0 >> 5) * 512 + lane) * 8;
#pragma unroll
          for (int db = 0; db < 8; ++db) vf[db] = *(const i64_t*)(vp + db * 512); }
        f32x4 sa[2] = {(f32x4){0.f, 0.f, 0.f, 0.f}, (f32x4){0.f, 0.f, 0.f, 0.f}};
#pragma unroll
        for (int T = 0; T < 2; ++T)
#pragma unroll
            for (int s2 = 0; s2 < 4; ++s2) sa[T] = __builtin_amdgcn_mfma_f32_16x16x32_fp8_fp8(kf[T][s2], qf[s2], sa[T], 0, 0, 0);
        const int dnext = desc(i + 1 < n ? i + 1 : i);
        { const int pn = SLC ? (dnext & 0xfffff) : dnext; const unsigned char* kp = KF + ((size_t)(pn >> 4) * 256 + lane) * 8;
#pragma unroll
          for (int T = 0; T < 2; ++T)
#pragma unroll
              for (int s2 = 0; s2 < 4; ++s2) kf[T][s2] = *(const i64_t*)(kp + (T * 4 + s2) * 512); }
        float sc[8]; bool vd[8]; float mx = -1e30f;
#pragma unroll
        for (int T = 0; T < 2; ++T)
#pragma unroll
            for (int r = 0; r < 4; ++r) { const int p = pos0 + 16 * T + 4 * kq + r; const bool v = (p >= lo) & (p <= hi); const float x = sa[T][r] * SL2;
                sc[4 * T + r] = x; vd[4 * T + r] = v; mx = v ? fmaxf(mx, x) : mx; }
        if (__builtin_amdgcn_ballot_w64(mx > st.m + 4.f) != 0ull) {
            mx = fmaxf(mx, __shfl_xor(mx, 16)); mx = fmaxf(mx, __shfl_xor(mx, 32));
            const float mn = fmaxf(st.m, mx), alpha = __builtin_amdgcn_exp2f(st.m - mn); st.m = mn; st.l *= alpha;
#pragma unroll
            for (int j = 0; j < 8; ++j) st.o[j] = st.o[j] * alpha;
        }
        f32x4 pa, pb; float ps = 0.f;
#pragma unroll
        for (int j = 0; j < 4; ++j) { pa[j] = vd[j] ? __builtin_amdgcn_exp2f(sc[j] - st.m + 4.f) : 0.f; pb[j] = vd[4 + j] ? __builtin_amdgcn_exp2f(sc[4 + j] - st.m + 4.f) : 0.f; ps += pa[j] + pb[j]; }
        st.l += ps;
        const u32x2 pw = pack8_fp8(pa, pb);
        const i64_t pf = __builtin_bit_cast(i64_t, pw);
#pragma unroll
        for (int db = 0; db < 8; ++db) st.o[db] = __builtin_amdgcn_mfma_f32_16x16x32_fp8_fp8(vf[db], pf, st.o[db], 0, 0, 0);
        dcur = dnext;
    }
}
__device__ __forceinline__ float quad_total(float v) { v += __shfl_xor(v, 16); v += __shfl_xor(v, 32); return v; }

__device__ __forceinline__ void dilated_unit(int unit, const bf16_t* proj, const bf16_t* kbf, bf16_t* nsaout, int lane) {
    const int l16 = lane & 15, kq = lane >> 4;
    const int hg = unit & 3, r16 = (unit >> 2) & 15, ut = unit >> 6;
    const int t0 = r16 + 256 * ut, tc = t0 + 16 * l16;
    const bf16_t* vbf = kbf + ((size_t)24 << 20);
    AState st; astate_init(st);
#pragma unroll 1
    for (int pt = 0; pt < 3; ++pt) {
        const int sh = 2 * pt, head = 4 * pt + hg;
        const bf16_t* qrow = proj + (size_t)tc * PLD + PC_QB + head * 128 + 8 * kq;
        bf16x8 qf[4];
#pragma unroll
        for (int s = 0; s < 4; ++s) qf[s] = *(const bf16x8*)(qrow + 32 * s);
        const int base = (r16 & ((1 << sh) - 1)) << (14 - sh), u0 = t0 >> sh, ui = u0 + (16 >> sh) * l16;
        const int lo = base + (ui - 128 < 0 ? 0 : ui - 128), hi = base + ui;
        const int first = (base + (u0 - 128 < 0 ? 0 : u0 - 128)) >> 5, last = (base + u0 + 15 * (16 >> sh)) >> 5;
        unsigned long long hoff = (unsigned long long)head * S * 128; asm volatile("" : "+s"(hoff));
        auto desc = [&](int i) { return 32 * (first + i); };
        attn_run_frag<0, false>(qf, kbf + hoff, vbf + hoff, desc, last - first + 1, lo, hi, 0, st, lane);
    }
    const float lt = quad_total(st.l), inv = lt > 0.f ? 1.f / lt : 0.f;
    bf16_t* op = nsaout + (size_t)tc * NOLD + 1024 + hg * 128 + 4 * kq;
#pragma unroll
    for (int db = 0; db < 8; ++db) { const f32x4 o = st.o[db] * inv; u32x2 w; w.x = cvt_pk_bf16(o[0], o[1]); w.y = cvt_pk_bf16(o[2], o[3]); *(u32x2*)(op + 16 * db) = w; }
}

__device__ __forceinline__ void compress_unit(int unit, const bf16_t* proj, const bf16_t* w1t, const bf16_t* w2t, const float* bias, bf16_t* outc, LAS unsigned char* scr, int lane) {
    const int l16 = lane & 15, kq = lane >> 4;
    const int rt = unit & 63, g = (unit >> 6) & 1, kv = unit >> 7;
    const bf16_t* raw = proj + (kv ? PC_VC : PC_KC) + 128 * g;
    const int n = 16 * rt + l16;
    f32x4 acc[16];
#pragma unroll
    for (int i = 0; i < 16; ++i) acc[i] = (f32x4){0.f, 0.f, 0.f, 0.f};
#pragma unroll 2
    for (int s = 0; s < 128; ++s) {
        const int tok = clampi(16 * n + (s >> 2), 0, S - 1);
        const bf16x8 af = *(const bf16x8*)(raw + (size_t)tok * PLD + (s & 3) * 32 + 8 * kq);
#pragma unroll
        for (int ct = 0; ct < 16; ++ct) { const bf16x8 bfr = *(const bf16x8*)(w1t + ((size_t)(ct * 128 + s) * 64 + lane) * 8);
            acc[ct] = __builtin_amdgcn_mfma_f32_16x16x32_bf16(af, bfr, acc[ct], 0, 0, 0); }
    }
#pragma unroll
    for (int ct = 0; ct < 16; ++ct) { const float bb = bias[16 * ct + l16];
#pragma unroll
        for (int r = 0; r < 4; ++r) { const float x = acc[ct][r] + bb; const float u2 = 1.5957691216f * (x + 0.044715f * x * x * x); const float gl = x * fsigmoid(u2);
            *(LAS bf16_t*)(scr + (4 * kq + r) * 528 + (16 * ct + l16) * 2) = (bf16_t)(cvt_pk_bf16(gl, 0.f) & 0xffffu); } }
    asm volatile("s_waitcnt lgkmcnt(0)" ::: "memory");
    f32x4 o2[8];
#pragma unroll
    for (int i = 0; i < 8; ++i) o2[i] = (f32x4){0.f, 0.f, 0.f, 0.f};
#pragma unroll
    for (int s = 0; s < 8; ++s) {
        const bf16x8 af = *(const LAS bf16x8*)(scr + l16 * 528 + (32 * s + 8 * kq) * 2);
#pragma unroll
        for (int dt = 0; dt < 8; ++dt) { const bf16x8 bfr = *(const bf16x8*)(w2t + (size_t)(16 * dt + l16) * 256 + 32 * s + 8 * kq);
            o2[dt] = __builtin_amdgcn_mfma_f32_16x16x32_bf16(af, bfr, o2[dt], 0, 0, 0); }
    }
    asm volatile("s_waitcnt lgkmcnt(0)" ::: "memory");
#pragma unroll
    for (int dt = 0; dt < 8; ++dt)
#pragma unroll
        for (int r = 0; r < 4; ++r) { const int nn = 16 * rt + 4 * kq + r, d = 16 * dt + l16;
            const bf16_t val = (bf16_t)(cvt_pk_bf16(o2[dt][r], 0.f) & 0xffffu);
            if (kv == 0) outc[(((size_t)g * 64 + (nn >> 4)) * 4 + (d >> 5)) * 512 + (((d >> 3) & 3) * 16 + (nn & 15)) * 8 + (d & 7)] = val;
            else { const int kp = nn & 31; outc[(((size_t)g * 32 + (nn >> 5)) * 8 + (d >> 4)) * 512 + ((((kp >> 2) & 3) * 16) + (d & 15)) * 8 + 4 * (kp >> 4) + (kp & 3)] = val; } }
}

__device__ __forceinline__ void nsa_unit(int unit, const bf16_t* proj, const bf16_t* kc, const bf16_t* vc, const bf16_t* gn, const float* cs, const float* sn,
                                         const bf16_t* kslf, const bf16_t* vslf, const bf16_t* kwnf, const bf16_t* vwnf, bf16_t* nsaout, LAS unsigned char* wl, int lane) {
    const int l16 = lane & 15, kq = lane >> 4;
    const int g = unit & 1, tb = unit >> 1, t0 = 4 * tb, qi = l16 >> 2, h = l16 & 3, tc = t0 + qi, head = 4 * g + h;
    LAS unsigned char* vbuf = wl; LAS float* imp = (LAS float*)(wl + VBUF_BYTES); LAS int* sel = (LAS int*)(wl + VBUF_BYTES + 4 * IMP_LD * 4);
    bf16x8 qf[4];
    { const bf16_t* qrow = proj + (size_t)tc * PLD + PC_QA + head * 128 + 8 * kq;
#pragma unroll
        for (int s = 0; s < 4; ++s) qf[s] = *(const bf16x8*)(qrow + 32 * s); }
    LAS u32x2* outl = (LAS u32x2*)(wl + OUT_OFF) + lane;
    for (int i = lane; i < 4 * IMP_LD; i += 64) imp[i] = 0.f;
    const int hic = (tc - 31) >> 4;
    const int nkmax = ((t0 + 3 - 31) >> 4) + 1, nsc = nkmax > 0 ? (nkmax + 31) >> 5 : 0;
    unsigned long long coff = (unsigned long long)g * 1024 * 128; asm volatile("" : "+s"(coff));
    const bf16_t* kcg = kc + coff; const bf16_t* vcg = vc + coff;
    AState st; astate_init(st);
    { auto desc = [&](int i) { return 32 * i; };
      attn_run_frag<1, false>(qf, kcg, vcg, desc, nsc, 0, hic, 0, st, lane);
      { const float lt = quad_total(st.l); st.l = lt > 0.f ? 1.f / lt : 0.f; }
      asm volatile("s_waitcnt lgkmcnt(0)" ::: "memory");
      attn_run_frag<2, false>(qf, kcg, vcg, desc, nsc, 0, hic, 0, st, lane, imp); }
    const float g0 = bf2f(gn[(size_t)tc * 32 + head * 3 + 0]);
#pragma unroll
    for (int i = 0; i < 8; ++i) { const f32x4 o = st.o[i] * g0; u32x2 w; w.x = cvt_pk_bf16(o[0], o[1]); w.y = cvt_pk_bf16(o[2], o[3]); outl[64 * i] = w; }
    asm volatile("s_waitcnt lgkmcnt(0)" ::: "memory");
#pragma unroll
    for (int s2 = 0; s2 < 2; ++s2) {
        const int d = 32 * s2 + 8 * kq; f32x4 c[2], sv[2];
        c[0] = *(const f32x4*)(cs + (size_t)tc * 64 + d); c[1] = *(const f32x4*)(cs + (size_t)tc * 64 + d + 4);
        sv[0] = *(const f32x4*)(sn + (size_t)tc * 64 + d); sv[1] = *(const f32x4*)(sn + (size_t)tc * 64 + d + 4);
        float o1[8], o2[8];
#pragma unroll
        for (int j = 0; j < 8; ++j) { const float x1 = bf2f((unsigned short)qf[s2][j]), x2 = bf2f((unsigned short)qf[s2 + 2][j]), cc = c[j >> 2][j & 3], ss = sv[j >> 2][j & 3];
            o1[j] = x1 * cc - x2 * ss; o2[j] = x2 * cc + x1 * ss; }
        u32x4 w1, w2; w1.x = cvt_pk_bf16(o1[0], o1[1]); w1.y = cvt_pk_bf16(o1[2], o1[3]); w1.z = cvt_pk_bf16(o1[4], o1[5]); w1.w = cvt_pk_bf16(o1[6], o1[7]);
        w2.x = cvt_pk_bf16(o2[0], o2[1]); w2.y = cvt_pk_bf16(o2[2], o2[3]); w2.z = cvt_pk_bf16(o2[4], o2[5]); w2.w = cvt_pk_bf16(o2[6], o2[7]);
        qf[s2] = __builtin_bit_cast(bf16x8, w1); qf[s2 + 2] = __builtin_bit_cast(bf16x8, w2);
    }
    unsigned key[4][4];
#pragma unroll
    for (int q = 0; q < 4; ++q) { const int cur = (t0 + q) >> 6; const f32x4 v = *(const LAS f32x4*)(imp + q * IMP_LD + 4 * lane);
#pragma unroll
        for (int i = 0; i < 4; ++i) { const int j = 4 * lane + i; const bool valid = j <= cur, forced = (j == 0) | (j == cur) | (j == cur - 1);
            const unsigned kb = forced ? 0xffffffu : ((__float_as_uint(fmaxf(v[i], 0.f)) >> 8) + 1u);
            key[q][i] = valid ? ((kb << 8) | (unsigned)(255 - j)) : 0u; } }
#pragma unroll 1
    for (int r = 0; r < 16; ++r) {
        unsigned mx[4];
#pragma unroll
        for (int q = 0; q < 4; ++q) { unsigned a = key[q][0] > key[q][1] ? key[q][0] : key[q][1], b = key[q][2] > key[q][3] ? key[q][2] : key[q][3]; mx[q] = a > b ? a : b; }
#pragma unroll
        for (int o = 1; o < 64; o <<= 1)
#pragma unroll
            for (int q = 0; q < 4; ++q) { const unsigned other = (unsigned)__shfl_xor((int)mx[q], o); mx[q] = other > mx[q] ? other : mx[q]; }
#pragma unroll
        for (int q = 0; q < 4; ++q) {
#pragma unroll
            for (int i = 0; i < 4; ++i) if (key[q][i] == mx[q]) key[q][i] = 0u;
            if (lane == 0) sel[q * 16 + r] = mx[q] ? (int)(255u - (mx[q] & 255u)) : -1;
        }
    }
    asm volatile("s_waitcnt lgkmcnt(0)" ::: "memory");
    i64_t q8[4];
#pragma unroll
    for (int s2 = 0; s2 < 4; ++s2) { f32x4 a, b;
#pragma unroll
        for (int j = 0; j < 4; ++j) { a[j] = bf2f((unsigned short)qf[s2][j]); b[j] = bf2f((unsigned short)qf[s2][4 + j]); }
        q8[s2] = __builtin_bit_cast(i64_t, pack8_fp8(a, b)); }
    LAS int* list = (LAS int*)(wl + VBUF_BYTES + 4 * IMP_LD * 4 + 256);
    int nslc;
    { const int b = sel[lane], q = lane >> 4, cur0 = t0 >> 6;
      const bool forced = (b == 0) | (b == cur0) | (b == cur0 - 1);
      const bool valid = (b >= 0) & !(forced & (q > 0)); const unsigned long long mask = __ballot(valid);
      const int idx = __popcll(mask & ((1ull << lane) - 1ull)); nslc = 2 * __popcll(mask);
      if (valid) { const int qc = forced ? 4 : q; list[2 * idx] = (64 * b) | (qc << 20); list[2 * idx + 1] = (64 * b + 32) | (qc << 20); } }
    asm volatile("s_waitcnt lgkmcnt(0)" ::: "memory");
    astate_init(st);
    { auto desc = [&](int i) { return __builtin_amdgcn_readfirstlane(list[i]); };
      unsigned long long goff = (unsigned long long)g * S * 128; asm volatile("" : "+s"(goff));
      attn_run_frag8<true>(q8, (const unsigned char*)kslf + goff, (const unsigned char*)kslf + ((size_t)8 << 20) + goff, desc, nslc, 0, tc, qi, st, lane); }
    { const float g1 = bf2f(gn[(size_t)tc * 32 + head * 3 + 1]); const float lt = quad_total(st.l), inv = (lt > 0.f ? 1.f / lt : 0.f) * g1;
#pragma unroll
        for (int i = 0; i < 8; ++i) { const f32x4 o = st.o[i] * inv; u32x2 w = outl[64 * i]; w.x = cvt_pk_bf16(bflo(w.x) + o[0], bfhi(w.x) + o[1]); w.y = cvt_pk_bf16(bflo(w.y) + o[2], bfhi(w.y) + o[3]); outl[64 * i] = w; } }
    astate_init(st);
    { const int lo = tc - 511 < 0 ? 0 : tc - 511; const int first = t0 < 511 ? 0 : (t0 - 511) >> 5, last = (t0 + 3) >> 5;
      auto desc = [&](int i) { return 32 * (first + i); };
      unsigned long long goff = (unsigned long long)g * S * 128; asm volatile("" : "+s"(goff));
      attn_run_frag8<false>(q8, (const unsigned char*)kslf + ((size_t)16 << 20) + goff, (const unsigned char*)kslf + ((size_t)24 << 20) + goff, desc, last - first + 1, lo, tc, 0, st, lane); }
    { const float g2 = bf2f(gn[(size_t)tc * 32 + head * 3 + 2]); const float lt = quad_total(st.l), inv = (lt > 0.f ? 1.f / lt : 0.f) * g2;
#pragma unroll
        for (int i = 0; i < 8; ++i) { const f32x4 o = st.o[i] * inv; u32x2 w = outl[64 * i]; w.x = cvt_pk_bf16(bflo(w.x) + o[0], bfhi(w.x) + o[1]); w.y = cvt_pk_bf16(bflo(w.y) + o[2], bfhi(w.y) + o[3]); outl[64 * i] = w; } }
    bf16_t* op = nsaout + (size_t)tc * NOLD + head * 128 + 4 * kq;
#pragma unroll
    for (int db = 0; db < 8; ++db) *(u32x2*)(op + 16 * db) = outl[64 * db];
}


#define XB_TMO      128
#define XB_XCNT(j)  (256  + 64 * (j))
#define XB_XSUB(j)  (1280 + 64 * (j))
#define XB_XGEN(j)  (2304 + 64 * (j))
#define XB_TOP      3328
#define XB_TOPGEN   3392
#define XCD_BAR_WORDS 3456
#define XB_SPIN_CAP (1u << 18)
__device__ __forceinline__ unsigned xb_ld(unsigned* p)              { return __hip_atomic_load(p, __ATOMIC_RELAXED, __HIP_MEMORY_SCOPE_AGENT); }
__device__ __forceinline__ unsigned xb_add(unsigned* p, unsigned v) { return __hip_atomic_fetch_add(p, v, __ATOMIC_RELAXED, __HIP_MEMORY_SCOPE_AGENT); }
__device__ __forceinline__ unsigned xb_xcc_id() { return (unsigned)__builtin_amdgcn_s_getreg((3 << 11) | 20) & 0xFu; }
#define XB_SPIN(cond, bar) do { unsigned _sp = 0; while (cond) { __builtin_amdgcn_s_sleep(1); \
    if ((++_sp & 255u) == 0u) { if (xb_ld(&(bar)[XB_TMO])) break; if (_sp > XB_SPIN_CAP) { atomicAdd(&(bar)[XB_TMO], 1u); break; } } } } while (0)
struct XcdBarrier { unsigned* bar; unsigned x; volatile LAS unsigned* st; };
__device__ __forceinline__ XcdBarrier xcd_barrier_post(unsigned* bar, volatile LAS unsigned* st) {
    XcdBarrier b; b.bar = bar; b.x = xb_xcc_id(); b.st = st;
    if (threadIdx.x == 0) (void)xb_add(&bar[XB_XCNT(b.x)], 1u);
    return b;
}
__device__ __forceinline__ void xcd_barrier_complete(unsigned* bar, unsigned x, unsigned& nloc, unsigned& nx) {
    const unsigned G = gridDim.x * gridDim.y * gridDim.z;
    unsigned sum, cnt, mine, sp = 0u;
    for (;;) {
        sum = 0u; cnt = 0u; mine = 0u;
#pragma unroll
        for (unsigned j = 0; j < 16; ++j) { const unsigned c = xb_ld(&bar[XB_XCNT(j)]); sum += c; cnt += (c > 0u) ? 1u : 0u; mine = (j == x) ? c : mine; }
        if (sum == G) break;
        __builtin_amdgcn_s_sleep(1);
        if ((++sp & 255u) == 0u) { if (xb_ld(&bar[XB_TMO])) break; if (sp > XB_SPIN_CAP) { atomicAdd(&bar[XB_TMO], 1u); break; } }
    }
    nloc = mine > 0u ? mine : 1u; nx = cnt > 0u ? cnt : 1u;
}
__device__ __forceinline__ void xcd_barrier(const XcdBarrier& b, const int tid) {
    asm volatile("s_waitcnt vmcnt(0)" ::: "memory");
    __syncthreads();
    if (tid == 0) {
        unsigned* bar = b.bar;
        __builtin_amdgcn_s_waitcnt(0);
        unsigned nloc = b.st[0], nx = b.st[1];
        if (nloc == 0u) { xcd_barrier_complete(bar, b.x, nloc, nx); b.st[0] = nloc; b.st[1] = nx; }
        const unsigned old = xb_add(&bar[XB_XSUB(b.x)], 1u);
        const unsigned gen = old / nloc;
        if (old + 1u == (gen + 1u) * nloc) {
            __builtin_amdgcn_fence(__ATOMIC_RELEASE, "agent");
            asm volatile("s_waitcnt vmcnt(0)" ::: "memory");
            const unsigned og = xb_add(&bar[XB_TOP], 1u);
            const unsigned tg = og / nx;
            if (og + 1u == (tg + 1u) * nx) xb_add(&bar[XB_TOPGEN], 1u);
            else XB_SPIN(xb_ld(&bar[XB_TOPGEN]) == tg, bar);
            __builtin_amdgcn_fence(__ATOMIC_ACQUIRE, "agent");
            xb_add(&bar[XB_XGEN(b.x)], 1u);
            asm volatile("s_waitcnt vmcnt(0)" ::: "memory");
        } else {
            XB_SPIN(xb_ld(&bar[XB_XGEN(b.x)]) == gen, bar);
            __builtin_amdgcn_fence(__ATOMIC_ACQUIRE, "agent");
            asm volatile("s_waitcnt vmcnt(0)" ::: "memory");
        }
    }
    __syncthreads();
}

struct Params { const float* in[23]; float* out; unsigned char* ws; float inv_freq[64]; };

__global__ void __launch_bounds__(512, 2) fwd_megakernel(Params P) {
    extern __shared__ __attribute__((aligned(16))) unsigned char lds_raw[];
    LAS unsigned char* lds = (LAS unsigned char*)lds_raw;
    cg::grid_group grid = cg::this_grid();
    const int wave_s = __builtin_amdgcn_readfirstlane(threadIdx.x >> 6);
#define PHASE_WS unsigned long long wsv_ = (unsigned long long)P.ws; asm volatile("" : "+s"(wsv_)); unsigned char* ws = (unsigned char*)(__attribute__((address_space(1))) unsigned char*)wsv_; unsigned z_ = 0u; asm volatile("" : "+v"(z_)); const int tid = wave_s * 64 + (int)__builtin_amdgcn_mbcnt_hi(~0u, __builtin_amdgcn_mbcnt_lo(~0u, z_)); \
    const int lane = tid & 63, wave = __builtin_amdgcn_readfirstlane(tid >> 6), G = gridDim.x, gw = blockIdx.x * 8 + wave, ngw = G * 8; \
    const size_t gtid = (size_t)blockIdx.x * 512 + tid, gthreads = (size_t)G * 512; \
    LAS unsigned char* wl = lds + wave * WAVE_LDS; LAS float* scr = (LAS float*)wl; (void)lane; (void)gw; (void)ngw; (void)gtid; (void)gthreads; (void)wl; (void)scr
#define WAB ((bf16_t*)(ws + WS_WAB))
#define WO ((bf16_t*)(ws + WS_WO))
#define CW1K ((bf16_t*)(ws + WS_CW1K))
#define CW1V ((bf16_t*)(ws + WS_CW1V))
#define CW2K ((bf16_t*)(ws + WS_CW2K))
#define CW2V ((bf16_t*)(ws + WS_CW2V))
#define CBIAS ((float*)(ws + WS_CBIAS))
#define KC ((bf16_t*)(ws + WS_KC))
#define VC ((bf16_t*)(ws + WS_VC))
#define GN ((bf16_t*)(ws + WS_GN))
#define ST1 ((float*)(ws + WS_ST1))
#define ST2 ((float*)(ws + WS_ST2))
#define HF ((float*)(ws + WS_HF))
#define HB ((bf16_t*)(ws + WS_HB))
#define GU ((bf16_t*)(ws + WS_GU))
#define DN ((bf16_t*)(ws + WS_DN))
#define ACT ((bf16_t*)(ws + WS_ACT))
#define PROJ ((bf16_t*)(ws + WS_PROJ))
#define KSLF ((bf16_t*)(ws + WS_KSLF))
#define KBF ((bf16_t*)(ws + WS_KBF))
#define VBF ((bf16_t*)(ws + WS_VBF))
#define VSLF ((bf16_t*)(ws + WS_VSLF))
#define KWNF ((bf16_t*)(ws + WS_KWNF))
#define VWNF ((bf16_t*)(ws + WS_VWNF))
#define RCOS ((float*)(ws + WS_ROPE))
#define RSIN ((float*)(ws + WS_ROPE) + (size_t)S * 64)
#define WINT ((bf16_t*)(ws + WS_WIN))
#define NSAOUT ((bf16_t*)(ws + WS_NSAOUT))
#define SIGG ((bf16_t*)P.out)
    pg8::StaticOrder SO;
#define CG_SYNC() do { asm volatile("s_waitcnt vmcnt(0) lgkmcnt(0)" ::: "memory"); grid.sync(); \
        if (__builtin_amdgcn_readfirstlane(threadIdx.x >> 6) == 0) { __builtin_amdgcn_fence(__ATOMIC_ACQUIRE, "agent"); asm volatile("s_waitcnt vmcnt(0)" ::: "memory"); } \
        __syncthreads(); } while (0)
    volatile LAS unsigned* xst = (volatile LAS unsigned*)(lds + 8 * WAVE_LDS);
    if (threadIdx.x < 2) xst[threadIdx.x] = 0u;
    __syncthreads();
    const XcdBarrier xbar = xcd_barrier_post((unsigned*)P.ws, xst);
#define GRID_SYNC() do { asm volatile("s_waitcnt vmcnt(0) lgkmcnt(0)" ::: "memory"); unsigned zz_ = 0u; asm volatile("" : "+v"(zz_)); \
        xcd_barrier(xbar, wave_s * 64 + (int)__builtin_amdgcn_mbcnt_hi(~0u, __builtin_amdgcn_mbcnt_lo(~0u, zz_))); } while (0)

    { PHASE_WS;
        conv_ffn(P.in[1], P.in[2], P.in[3], GU, DN, scr, gw, ngw, lane);
        for (int it = gw; it < 32 * 360; it += ngw) { const int kb = it / 360, nb = it % 360, dr = nb * 32; const int sc = win_src_col(dr);
            tr_item(P.in[6], WIN_SRC, kb * 64, sc < 0 ? 0 : sc, sc < 0 ? 0 : (dr == 11264 ? 24 : 32), WINT, DM, dr, kb * 64, scr, lane); }
        for (int it = gw; it < 16 * 64; it += ngw) { const int kb = it / 64, nb = it % 64; tr_item(P.in[13], DM, kb * 64, nb * 32, 32, WAB, 1024, nb * 32, kb * 64, scr, lane); }
        for (int it = gw; it < 8 * 64; it += ngw) { const int kb = it / 64, nb = it % 64; tr_item(P.in[14], DM, kb * 64, nb * 32, 32, WAB + (size_t)DM * 1024, 512, nb * 32, kb * 64, scr, lane); }
        for (int it = gw; it < 32 * 64; it += ngw) { const int kb = it / 64, nb = it % 64; tr_item(P.in[15], DM, kb * 64, nb * 32, 32, WO, DM, nb * 32, kb * 64, scr, lane); }
        for (int it = gw; it < 2 * 64 * 8; it += ngw) { const int w = it / 512, r = it % 512, kb = r / 8, nb = r % 8; tr_item<true>(w ? P.in[11] : P.in[8], 256, kb * 64, nb * 32, 32, w ? CW1V : CW1K, 4096, nb * 32, kb * 64, scr, lane); }
        for (int it = gw; it < 2 * 4 * 4; it += ngw) { const int w = it / 16, r = it % 16, kb = r / 4, nb = r % 4; tr_item(w ? P.in[12] : P.in[9], 128, kb * 64, nb * 32, 32, w ? CW2V : CW2K, 256, nb * 32, kb * 64, scr, lane); }
        { const float* x = P.in[0];
            for (size_t i = gtid; i < (size_t)S * DM / 8; i += gthreads) { const f32x4 a = *(const f32x4*)(x + 8 * i), b = *(const f32x4*)(x + 8 * i + 4); *(u32x4*)(HB + 8 * i) = pack8(a, b); } }
        for (int o = gw; o < 512; o += ngw) { const int w = o >> 8, c = o & 255; const float* pos = w ? P.in[10] : P.in[7]; const float* w1 = w ? P.in[11] : P.in[8];
            float s = 0.f; for (int kk = lane; kk < 4096; kk += 64) s += pos[kk] * w1[(size_t)kk * 256 + c];
            s = wave_sum(s); if (lane == 0) CBIAS[o] = s; }
    }
    CG_SYNC();
    { PHASE_WS; pg8::Gemm g{HB, GU, S, NGU, DM, DM, DM}; SO.init(S, NGU, G, (int)blockIdx.x); EpiSwiglu E{ACT}; pg8::gemm_phase(lds, g, SO, E, tid); }
    GRID_SYNC();
    { PHASE_WS; pg8::Gemm g{ACT, DN, S, DM, FF, FF, FF}; SO.init(S, DM, G, (int)blockIdx.x); EpiResF32 E{P.in[0], HF, ALPHA, 0.5f}; pg8::gemm_phase(lds, g, SO, E, tid); }
    GRID_SYNC();
    { PHASE_WS;
        ln_rows(HF, nullptr, HB, P.in[4], P.in[5], gw, ngw, lane, ST1);
        for (size_t i = gtid; i < (size_t)S * 64; i += gthreads) { const int t = (int)(i >> 6), j = (int)(i & 63); const float ang = (float)t * P.inv_freq[j]; RCOS[i] = cosf(ang); RSIN[i] = sinf(ang); }
    }
    GRID_SYNC();
    { PHASE_WS; pg8::Gemm g{HB, WINT, S, NWIN, DM, DM, DM}; SO.init(S, NWIN, G, (int)blockIdx.x); EpiWin E{PROJ, SIGG, GN, RCOS, KSLF, KBF}; pg8::gemm_phase(lds, g, SO, E, tid); }
    GRID_SYNC();
    { PHASE_WS;
        if (wave == 0) { for (int u = blockIdx.x; u < 256; u += G) { const int kv = u >> 7; compress_unit(u, PROJ, kv ? CW1V : CW1K, kv ? CW2V : CW2K, CBIAS + 256 * kv, kv ? VC : KC, wl, lane); } }
        else { for (int u = blockIdx.x * 7 + (wave - 1); u < 4096; u += G * 7) dilated_unit(u, PROJ, KBF, NSAOUT, lane); }
    }
    GRID_SYNC();
    { PHASE_WS;
      if ((G & 7) == 0) {
          const int bx = blockIdx.x, x = bx & 7, g = x & 1, wj = ((bx >> 3) * 4 + (x >> 1)) * 8 + wave, nwj = (G >> 1) * 8;
          for (int tb = wj; tb < 4096; tb += nwj) nsa_unit(2 * tb + g, PROJ, KC, VC, GN, RCOS, RSIN, KSLF, VSLF, KWNF, VWNF, NSAOUT, wl, lane);
      } else { for (int u = gw; u < 8192; u += ngw) nsa_unit(u, PROJ, KC, VC, GN, RCOS, RSIN, KSLF, VSLF, KWNF, VWNF, NSAOUT, wl, lane); } }
    GRID_SYNC();
    { PHASE_WS; SO.init(S, DM, G, (int)blockIdx.x);
      { pg8::Gemm g{NSAOUT, WAB, S, DM, 1024, NOLD, 1024}; EpiGate<true> E{SIGG, HB}; pg8::gemm_phase(lds, g, SO, E, tid); }
      { pg8::Gemm g{NSAOUT + 1024, WAB + (size_t)DM * 1024, S, DM, 512, NOLD, 512}; EpiGate<false> E{SIGG + 2048, HB}; pg8::gemm_phase(lds, g, SO, E, tid); } }
    GRID_SYNC();
    { PHASE_WS; pg8::Gemm g{HB, WO, S, DM, DM, DM, DM}; SO.init(S, DM, G, (int)blockIdx.x); EpiResLnF32 E{HF, ST1, P.in[4], P.in[5], HF, ALPHA, 1.0f}; pg8::gemm_phase(lds, g, SO, E, tid); }
    GRID_SYNC();
    { PHASE_WS;
        ln_rows(HF, nullptr, HB, P.in[16], P.in[17], gw, ngw, lane, ST2);
        conv_ffn(P.in[18], P.in[19], P.in[20], GU, DN, scr, gw, ngw, lane);
    }
    GRID_SYNC();
    { PHASE_WS; pg8::Gemm g{HB, GU, S, NGU, DM, DM, DM}; SO.init(S, NGU, G, (int)blockIdx.x); EpiSwiglu E{ACT}; pg8::gemm_phase(lds, g, SO, E, tid); }
    GRID_SYNC();
    { PHASE_WS; pg8::Gemm g{ACT, DN, S, DM, FF, FF, FF}; SO.init(S, DM, G, (int)blockIdx.x); EpiResLnF32 E{HF, ST2, P.in[16], P.in[17], P.out, ALPHA, 0.5f}; pg8::gemm_phase(lds, g, SO, E, tid); }
    GRID_SYNC();
    { PHASE_WS; (void)ws; ln_rows(P.out, P.out, nullptr, P.in[21], P.in[22], gw, ngw, lane); }
}

extern "C" void kernel_launch(void* const* d_in, const int* in_sizes, int n_in, void* d_out, int out_size, void* d_ws, size_t ws_size, hipStream_t stream) {
    static int grid = 0;
    if (grid == 0) {
        if (n_in != 23 || out_size != S * DM || ws_size < WS_END) { fprintf(stderr, "kernel_launch: unexpected shapes (n_in %d out %d ws %zu, need %zu)\n", n_in, out_size, ws_size, (size_t)WS_END); grid = -1; return; }
        int dev = 0, cus = 0, per_cu = 0;
        hipGetDevice(&dev); hipDeviceGetAttribute(&cus, hipDeviceAttributeMultiprocessorCount, dev);
        if (hipFuncSetAttribute((const void*)fwd_megakernel, hipFuncAttributeMaxDynamicSharedMemorySize, LDS_BYTES) != hipSuccess) { fprintf(stderr, "kernel_launch: hipFuncSetAttribute failed\n"); grid = -1; return; }
        if (hipOccupancyMaxActiveBlocksPerMultiprocessor(&per_cu, (const void*)fwd_megakernel, 512, LDS_BYTES) != hipSuccess || per_cu < 1) { fprintf(stderr, "kernel_launch: occupancy query failed (%d)\n", per_cu); (void)hipGetLastError(); per_cu = 1; }
        grid = cus * per_cu;
    }
    if (grid < 0) return;
    if (hipMemsetAsync(d_ws, 0, 16384, stream) != hipSuccess) { fprintf(stderr, "kernel_launch: memset of the barrier words failed\n"); return; }
    Params p{};
    for (int i = 0; i < 23; ++i) p.in[i] = (const float*)d_in[i];
    p.out = (float*)d_out; p.ws = (unsigned char*)d_ws;
    for (int i = 0; i < 64; ++i) p.inv_freq[i] = (float)pow(10000.0, -(double)i / 64.0);
    void* args[] = {&p};
    hipError_t e = hipLaunchCooperativeKernel((const void*)fwd_megakernel, dim3(grid), dim3(512), args, LDS_BYTES, stream);
    if (e != hipSuccess) fprintf(stderr, "kernel_launch: cooperative launch failed: %s (grid %d)\n", hipGetErrorString(e), grid);
}
```

```cpp
#include <hip/hip_runtime.h>
#include <hip/hip_cooperative_groups.h>
#include <cstdio>
#include <cstdint>
#include <cmath>
namespace cg = cooperative_groups;

#define LAS __attribute__((address_space(3)))
typedef unsigned short bf16_t;
typedef short bf16x8 __attribute__((ext_vector_type(8)));
typedef short s16x4 __attribute__((ext_vector_type(4)));
typedef float f32x4 __attribute__((ext_vector_type(4)));
typedef float f32x2 __attribute__((ext_vector_type(2)));
typedef unsigned u32x4 __attribute__((ext_vector_type(4)));
typedef unsigned u32x2 __attribute__((ext_vector_type(2)));

constexpr int S = 16384, DM = 2048, FF = 5632, NGU = 2 * FF, NWIN = 11520, WIN_SRC = 11288, PLD = 3072, NOLD = 1536;
constexpr float ALPHA = 1.189207115002721f;
constexpr float LN_EPS = 1e-5f;
constexpr float SL2 = 0.08838834764831845f * 1.4426950408889634f;
constexpr int PC_QA = 0, PC_KC = 1024, PC_VC = 1280, PC_QB = 1536;
constexpr size_t MiB = 1u << 20;
constexpr size_t WS_WAB = 1 * MiB, WS_WO = 13 * MiB, WS_CW1K = 21 * MiB, WS_CW1V = 23 * MiB, WS_CW2K = 25 * MiB, WS_CW2V = 25 * MiB + 65536, WS_CBIAS = 25 * MiB + 131072;
constexpr size_t WS_KC = 26 * MiB, WS_VC = 26 * MiB + 524288, WS_GN = 27 * MiB, WS_ST1 = 28 * MiB, WS_ST2 = 28 * MiB + 131072;
constexpr size_t WS_HF = 32 * MiB, WS_HB = 160 * MiB, WS_BIG = 224 * MiB;
constexpr size_t WS_GU = WS_BIG, WS_DN = WS_BIG + 44 * MiB, WS_ACT = WS_BIG + 66 * MiB;
constexpr size_t WS_KBF = WS_BIG + 96 * MiB, WS_VBF = WS_BIG + 144 * MiB;
constexpr size_t WS_PROJ = WS_BIG, WS_KSLF = WS_BIG + 192 * MiB, WS_VSLF = WS_BIG + 200 * MiB, WS_KWNF = WS_BIG + 208 * MiB, WS_VWNF = WS_BIG + 216 * MiB, WS_ROPE = WS_BIG + 224 * MiB;
constexpr size_t WS_WIN = 466 * MiB, WS_NSAOUT = 466 * MiB, WS_END = 514 * MiB;

constexpr int VROW = 288, VBUF_BYTES = 32 * VROW;
constexpr int IMP_LD = 260;
constexpr int OUT_OFF = VBUF_BYTES + 4 * IMP_LD * 4 + 256 + 512;
constexpr int WAVE_LDS = OUT_OFF + 4096;
constexpr int LDS_BYTES = 147456;
static_assert(8 * WAVE_LDS + 32 <= LDS_BYTES && 131072 <= LDS_BYTES, "LDS map");

typedef __bf16 bf16x2_t __attribute__((ext_vector_type(2)));
__device__ __forceinline__ unsigned cvt_pk_bf16(float lo, float hi) { f32x2 v = {lo, hi}; bf16x2_t b = __builtin_convertvector(v, bf16x2_t); return __builtin_bit_cast(unsigned, b); }
__device__ __forceinline__ float bf2f(unsigned short b) { return __uint_as_float(((unsigned)b) << 16); }
__device__ __forceinline__ float bflo(unsigned w) { return __uint_as_float(w << 16); }
__device__ __forceinline__ float bfhi(unsigned w) { return __uint_as_float(w & 0xffff0000u); }
__device__ __forceinline__ float fsigmoid(float x) { return __builtin_amdgcn_rcpf(1.f + __expf(-x)); }
__device__ __forceinline__ float wave_sum(float v) {
#pragma unroll
    for (int o = 1; o < 64; o <<= 1) v += __shfl_xor(v, o);
    return v;
}
typedef long i64_t;
__device__ __forceinline__ u32x2 pack8_fp8(const f32x4 a, const f32x4 b) {
    unsigned lo = 0u, hi = 0u;
    lo = __builtin_amdgcn_cvt_pk_fp8_f32(a[0], a[1], lo, false); lo = __builtin_amdgcn_cvt_pk_fp8_f32(a[2], a[3], lo, true);
    hi = __builtin_amdgcn_cvt_pk_fp8_f32(b[0], b[1], hi, false); hi = __builtin_amdgcn_cvt_pk_fp8_f32(b[2], b[3], hi, true);
    return (u32x2){lo, hi};
}
__device__ __forceinline__ u32x4 pack8(const f32x4 a, const f32x4 b) { u32x4 w; w.x = cvt_pk_bf16(a[0], a[1]); w.y = cvt_pk_bf16(a[2], a[3]); w.z = cvt_pk_bf16(b[0], b[1]); w.w = cvt_pk_bf16(b[2], b[3]); return w; }

namespace pg8 {
constexpr int BM = 256, BK = 64, HALF = 128, HTB = HALF * BK * 2, STAGE_BYTES = 8 * HTB, NXCD = 8, WGM = 8;
__host__ __device__ __forceinline__ int lds_byte(int r, int c) { const int st = (r >> 4) * 2 + (c >> 5), rr = r & 15, cc = c & 31, ob = rr * 64 + cc * 2; return st * 1024 + (ob ^ (((ob >> 9) & 1) << 5)); }
__host__ __device__ __forceinline__ void stage_rc(int b, int& R, int& C) { const int st = b / 1024, sb = b % 1024, swz = sb ^ (((sb >> 9) & 1) << 5); R = (st >> 1) * 16 + swz / 64; C = (st & 1) * 32 + (swz % 64) / 2; }
__host__ __device__ __forceinline__ int perm32(int rho) { const int n = rho >> 4, i = rho & 15; return 8 * (i >> 2) + 4 * n + (i & 3); }
struct Unit { int pm, pn; };
struct Gemm { const bf16_t* A; const bf16_t* Bt; int M, N, K, lda, ldb; };
struct StaticOrder {
    int nM, nN, nwg, G, c;
    __device__ void init(int M, int N, int G_, int c_) { nM = M / BM; nN = N / BM; nwg = nM * nN; G = G_; c = c_; }
    __device__ bool next(int i, Unit& u) const {
        const long L = (long)i * G + c; if (L >= nwg) return false;
        int wgid = (int)L; { const int q = nwg / NXCD, r = nwg % NXCD, xcd = wgid % NXCD, off = wgid / NXCD; wgid = (xcd < r ? xcd * (q + 1) : r * (q + 1) + (xcd - r) * q) + off; }
        const int nig = WGM * nN, gid = wgid / nig, fm = gid * WGM, gsz = (nM - fm) < WGM ? (nM - fm) : WGM;
        u.pm = fm + ((wgid % nig) % gsz); u.pn = (wgid % nig) / gsz; return true;
    }
};
typedef f32x4 Acc[2][2][4][2];

template <class Epi>
__device__ __forceinline__ void gemm_phase(LAS unsigned char* lds, const Gemm g, const StaticOrder& S_, const Epi& E, const int tid) {
    const int wid = __builtin_amdgcn_readfirstlane(tid >> 6), lane = tid & 63, wr = wid >> 2, wc = wid & 3, fr = lane & 15, fq = lane >> 4;
    const int K = g.K, nt = K / BK;
    unsigned voffA[2], voffB[2];
#pragma unroll
    for (int i = 0; i < 2; ++i) { int R, C; stage_rc(tid * 16 + i * 8192, R, C); const int Rb = Epi::PERM ? ((R & ~31) + perm32(R & 31)) : R;
        voffA[i] = (unsigned)(R * g.lda + C) * 2u; voffB[i] = (unsigned)(Rb * g.ldb + C) * 2u; }
    const size_t kstep = (size_t)(BK * 2);
    const size_t hstepA = (size_t)HALF * g.lda * 2, hstepB = (size_t)HALF * g.ldb * 2;
    const size_t tstepA = 2 * hstepA, tstepB = 2 * hstepB;
    const unsigned ldsw = (unsigned)wid * 1024u;
    const int aoff = lds_byte(wr * 64 + fr, fq * 8), boff = lds_byte(wc * 32 + fr, fq * 8);
#define PG8_SA(b, h) (((b) * 2 + (h)) * HTB)
#define PG8_SB(b, h) ((4 + (b) * 2 + (h)) * HTB)
#define PG8_STAGE(bufoff, gbase, voff) do { _Pragma("unroll") for (int _i = 0; _i < 2; ++_i) \
        __builtin_amdgcn_global_load_lds((const unsigned*)((const char*)(gbase) + (voff)[_i]), (LAS unsigned*)(lds + (bufoff) + ldsw + _i * 8192), 16, 0, 0); } while (0)
#define PG8_LDA(dst, b, h) do { _Pragma("unroll") for (int m = 0; m < 4; ++m) _Pragma("unroll") for (int k = 0; k < 2; ++k) dst[m][k] = *(const LAS bf16x8*)(lds + PG8_SA(b, h) + aoff + m * 2048 + k * 1024); } while (0)
#define PG8_LDB(dst, b, h) do { _Pragma("unroll") for (int n = 0; n < 2; ++n) _Pragma("unroll") for (int k = 0; k < 2; ++k) dst[n][k] = *(const LAS bf16x8*)(lds + PG8_SB(b, h) + boff + n * 2048 + k * 1024); } while (0)
#define PG8_MMA(ai, bj, At, Bt) do { __builtin_amdgcn_s_setprio(1); _Pragma("unroll") for (int m = 0; m < 4; ++m) _Pragma("unroll") for (int n = 0; n < 2; ++n) _Pragma("unroll") for (int k = 0; k < 2; ++k) \
        acc[ai][bj][m][n] = __builtin_amdgcn_mfma_f32_16x16x32_bf16(Bt[n][k], At[m][k], acc[ai][bj][m][n], 0, 0, 0); __builtin_amdgcn_s_setprio(0); } while (0)
#define PG8_WAIT_V(n) asm volatile("s_waitcnt vmcnt(" #n ")" ::: "memory")
#define PG8_WAIT_L(n) asm volatile("s_waitcnt lgkmcnt(" #n ")" ::: "memory")
#define PG8_BAR __builtin_amdgcn_s_barrier()
#define PG8_SCHED __builtin_amdgcn_sched_barrier(0)
    Unit cur, nxt; int ui = 0;
    if (!S_.next(0, cur)) return;
    Acc acc;
#pragma unroll
    for (int a = 0; a < 2; ++a)
#pragma unroll
        for (int b = 0; b < 2; ++b)
#pragma unroll
            for (int m = 0; m < 4; ++m)
#pragma unroll
                for (int n = 0; n < 2; ++n) acc[a][b][m][n] = (f32x4){0.f, 0.f, 0.f, 0.f};
    bf16x8 At[4][2], B0[2][2], B1[2][2];
    const char* cA = (const char*)g.A + (size_t)cur.pm * tstepA; const char* cB = (const char*)g.Bt + (size_t)cur.pn * tstepB;
    PG8_STAGE(PG8_SB(0, 0), cB, voffB); PG8_STAGE(PG8_SB(0, 1), cB + hstepB, voffB); PG8_STAGE(PG8_SA(0, 0), cA, voffA); PG8_STAGE(PG8_SA(0, 1), cA + hstepA, voffA);
    if (wr == 1) PG8_BAR;
    PG8_WAIT_V(2); PG8_BAR;
    PG8_STAGE(PG8_SB(1, 0), cB + kstep, voffB); PG8_STAGE(PG8_SA(1, 0), cA + kstep, voffA); PG8_STAGE(PG8_SB(1, 1), cB + hstepB + kstep, voffB);
    PG8_WAIT_V(6); PG8_BAR;
    for (;;) {
        const bool has_next = S_.next(ui + 1, nxt);
        const char* nA = has_next ? (const char*)g.A + (size_t)nxt.pm * tstepA : cA; const char* nB = has_next ? (const char*)g.Bt + (size_t)nxt.pn * tstepB : cB;
        for (int t = 0; t < nt; t += 2) {
            const bool last = (t == nt - 2);
            const char* a1 = cA + (size_t)(t + 1) * kstep;
            const char* a2 = last ? nA : cA + (size_t)(t + 2) * kstep; const char* b2 = last ? nB : cB + (size_t)(t + 2) * kstep;
            const char* a3 = a2 + kstep; const char* b3 = b2 + kstep;
            PG8_LDB(B0, 0, 0); PG8_LDB(B1, 0, 1); PG8_SCHED; PG8_LDA(At, 0, 0); PG8_STAGE(PG8_SA(1, 1), a1 + hstepA, voffA);
            PG8_WAIT_V(8); PG8_WAIT_L(0); PG8_BAR; PG8_MMA(0, 0, At, B0); PG8_MMA(0, 1, At, B1); PG8_BAR; PG8_SCHED;
            PG8_LDA(At, 0, 1); PG8_STAGE(PG8_SB(0, 0), b2, voffB); PG8_STAGE(PG8_SB(0, 1), b2 + hstepB, voffB); PG8_STAGE(PG8_SA(0, 0), a2, voffA);
            PG8_WAIT_V(8); PG8_WAIT_L(0); PG8_BAR; PG8_MMA(1, 0, At, B0); PG8_MMA(1, 1, At, B1); PG8_BAR; PG8_SCHED;
            PG8_LDB(B0, 1, 0); PG8_LDB(B1, 1, 1); PG8_SCHED; PG8_LDA(At, 1, 0); PG8_STAGE(PG8_SA(0, 1), a2 + hstepA, voffA);
            PG8_WAIT_V(8); PG8_WAIT_L(0); PG8_BAR; PG8_MMA(0, 0, At, B0); PG8_MMA(0, 1, At, B1); PG8_BAR; PG8_SCHED;
            PG8_LDA(At, 1, 1); PG8_STAGE(PG8_SB(1, 0), b3, voffB); PG8_STAGE(PG8_SB(1, 1), b3 + hstepB, voffB); PG8_STAGE(PG8_SA(1, 0), a3, voffA);
            PG8_WAIT_V(8); PG8_WAIT_L(0); PG8_BAR; PG8_MMA(1, 0, At, B0); PG8_MMA(1, 1, At, B1); PG8_BAR; PG8_SCHED;
        }
        if (wr == 0) PG8_BAR;
        E(acc, cur, wr, wc, fr, fq);
        if (!has_next) break;
#pragma unroll
        for (int a = 0; a < 2; ++a)
#pragma unroll
            for (int b = 0; b < 2; ++b)
#pragma unroll
                for (int m = 0; m < 4; ++m)
#pragma unroll
                    for (int n = 0; n < 2; ++n) acc[a][b][m][n] = (f32x4){0.f, 0.f, 0.f, 0.f};
        cur = nxt; cA = nA; cB = nB; ++ui;
        if (wr == 1) PG8_BAR;
    }
    PG8_WAIT_V(0);
    PG8_BAR;
#undef PG8_SA
#undef PG8_SB
#undef PG8_STAGE
#undef PG8_LDA
#undef PG8_LDB
#undef PG8_MMA
#undef PG8_WAIT_V
#undef PG8_WAIT_L
#undef PG8_BAR
#undef PG8_SCHED
}
}

struct EpiSwiglu {
    static constexpr bool PERM = true;
    bf16_t* O;
    __device__ __forceinline__ void operator()(const pg8::Acc& acc, const pg8::Unit& u, int wr, int wc, int fr, int fq) const {
        const int row0 = u.pm * 256 + wr * 64 + fr, col0 = u.pn * 128 + wc * 32 + 8 * fq;
#pragma unroll
        for (int ai = 0; ai < 2; ++ai)
#pragma unroll
            for (int m = 0; m < 4; ++m) {
                f32x4 v[2];
#pragma unroll
                for (int n = 0; n < 2; ++n)
#pragma unroll
                    for (int e = 0; e < 4; ++e) { const float gt = acc[ai][0][m][n][e], up = acc[ai][1][m][n][e]; v[n][e] = gt * fsigmoid(gt) * up; }
                *(u32x4*)(O + (size_t)(row0 + ai * 128 + m * 16) * FF + col0) = pack8(v[0], v[1]);
            }
    }
};
struct EpiResF32 {
    static constexpr bool PERM = false;
    const float* res; float* out; float a, b;
    __device__ __forceinline__ void operator()(const pg8::Acc& acc, const pg8::Unit& u, int wr, int wc, int fr, int fq) const {
        const int row0 = u.pm * 256 + wr * 64 + fr, col0 = u.pn * 256 + wc * 32 + 4 * fq;
#pragma unroll
        for (int ai = 0; ai < 2; ++ai)
#pragma unroll
            for (int m = 0; m < 4; ++m) {
                const size_t off = (size_t)(row0 + ai * 128 + m * 16) * DM + col0;
#pragma unroll
                for (int bj = 0; bj < 2; ++bj)
#pragma unroll
                    for (int n = 0; n < 2; ++n) { const f32x4 r = *(const f32x4*)(res + off + bj * 128 + n * 16); *(f32x4*)(out + off + bj * 128 + n * 16) = r * a + acc[ai][bj][m][n] * b; }
            }
    }
};
struct EpiResLnF32 {
    static constexpr bool PERM = false;
    const float* pre; const float* stats; const float* g; const float* beta; float* out; float a, b;
    __device__ __forceinline__ void operator()(const pg8::Acc& acc, const pg8::Unit& u, int wr, int wc, int fr, int fq) const {
        const int row0 = u.pm * 256 + wr * 64 + fr, col0 = u.pn * 256 + wc * 32 + 4 * fq;
#pragma unroll
        for (int ai = 0; ai < 2; ++ai)
#pragma unroll
            for (int m = 0; m < 4; ++m) {
                const int row = row0 + ai * 128 + m * 16; const size_t off = (size_t)row * DM + col0;
                const f32x2 st = *(const f32x2*)(stats + 2 * (size_t)row);
#pragma unroll
                for (int bj = 0; bj < 2; ++bj)
#pragma unroll
                    for (int n = 0; n < 2; ++n) { const int co = bj * 128 + n * 16;
                        const f32x4 r = *(const f32x4*)(pre + off + co), gv = *(const f32x4*)(g + col0 + co), bv = *(const f32x4*)(beta + col0 + co);
                        const f32x4 h = (r - st.x) * st.y * gv + bv;
                        *(f32x4*)(out + off + co) = h * a + acc[ai][bj][m][n] * b; }
                if (m & 1) asm volatile("" ::: "memory");
            }
    }
};
struct EpiWin {
    static constexpr bool PERM = true;
    bf16_t* proj; bf16_t* sigg; bf16_t* gn; const float* cs; bf16_t* kslf; bf16_t* kbf;
    __device__ __forceinline__ void operator()(const pg8::Acc& acc, const pg8::Unit& u, int wr, int wc, int fr, int fq) const {
        const int tile = u.pn, row0 = u.pm * 256 + wr * 64 + fr, cw = wc * 32 + 8 * fq;
        if (tile < 28) {
            const bool rope = (tile == 6) | (tile == 8) | (tile >= 10 && tile < 22);
            const int dcol = (tile < 6 ? tile : tile - 4) * 256;
            if (!rope) {
                if (tile == 7 || tile == 9) {
                    unsigned char* VF = (unsigned char*)kslf + (tile == 7 ? (size_t)8 << 20 : (size_t)24 << 20);
#pragma unroll
                    for (int ai = 0; ai < 2; ++ai)
#pragma unroll
                        for (int m = 0; m < 4; ++m) {
                            const int row = row0 + ai * 128 + m * 16, kp = row & 31;
                            const size_t rbase = (size_t)(row >> 5) * 4096 + (size_t)(((kp >> 2) & 3) * 16) * 8 + 4 * (kp >> 4) + (kp & 3);
#pragma unroll
                            for (int bj = 0; bj < 2; ++bj) {
                                const u32x2 w = pack8_fp8(acc[ai][bj][m][0], acc[ai][bj][m][1]);
                                unsigned char* vb = VF + (size_t)bj * 512 * 4096 + rbase + (size_t)(cw >> 4) * 512 + (size_t)(cw & 15) * 8;
                                vb[0] = (unsigned char)(w.x & 0xffu); vb[8] = (unsigned char)((w.x >> 8) & 0xffu); vb[16] = (unsigned char)((w.x >> 16) & 0xffu); vb[24] = (unsigned char)(w.x >> 24);
                                vb[32] = (unsigned char)(w.y & 0xffu); vb[40] = (unsigned char)((w.y >> 8) & 0xffu); vb[48] = (unsigned char)((w.y >> 16) & 0xffu); vb[56] = (unsigned char)(w.y >> 24);
                            }
                        }
                } else if (tile >= 22) {
                    bf16_t* VB = kbf + ((size_t)24 << 20);
#pragma unroll
                    for (int ai = 0; ai < 2; ++ai)
#pragma unroll
                        for (int m = 0; m < 4; ++m) {
                            const int row = row0 + ai * 128 + m * 16;
#pragma unroll
                            for (int bj = 0; bj < 2; ++bj) {
                                const int hd = 2 * (tile - 22) + bj, sh = 2 * (hd >> 2), tp = ((row & ((1 << sh) - 1)) << (14 - sh)) + (row >> sh), kp = tp & 31;
                                const u32x4 w = pack8(acc[ai][bj][m][0], acc[ai][bj][m][1]);
                                bf16_t* vb = VB + (((size_t)hd * 512 + (tp >> 5)) * 8 + (cw >> 4)) * 512 + (size_t)(((kp >> 2) & 3) * 16 + (cw & 15)) * 8 + 4 * (kp >> 4) + (kp & 3);
                                vb[0] = (bf16_t)(w.x & 0xffffu); vb[8] = (bf16_t)(w.x >> 16); vb[16] = (bf16_t)(w.y & 0xffffu); vb[24] = (bf16_t)(w.y >> 16);
                                vb[32] = (bf16_t)(w.z & 0xffffu); vb[40] = (bf16_t)(w.z >> 16); vb[48] = (bf16_t)(w.w & 0xffffu); vb[56] = (bf16_t)(w.w >> 16);
                            }
                        }
                } else {
#pragma unroll
                    for (int ai = 0; ai < 2; ++ai)
#pragma unroll
                        for (int m = 0; m < 4; ++m)
#pragma unroll
                            for (int bj = 0; bj < 2; ++bj)
                                *(u32x4*)(proj + (size_t)(row0 + ai * 128 + m * 16) * PLD + dcol + bj * 128 + cw) = pack8(acc[ai][bj][m][0], acc[ai][bj][m][1]);
                }
            } else {
                const int head = cw >> 6, d = cw & 63;
                const bool frag = (tile == 6) | (tile == 8);
                unsigned char* KF = (unsigned char*)kslf + (tile == 6 ? (size_t)0 : (size_t)16 << 20); const float* sn = cs + (size_t)S * 64;
#pragma unroll
                for (int ai = 0; ai < 2; ++ai)
#pragma unroll
                    for (int m = 0; m < 4; ++m) {
                        const int row = row0 + ai * 128 + m * 16;
                        f32x4 o1[2], o2[2];
#pragma unroll
                        for (int n = 0; n < 2; ++n) {
                            const f32x4 c = *(const f32x4*)(cs + (size_t)row * 64 + d + 4 * n), sv = *(const f32x4*)(sn + (size_t)row * 64 + d + 4 * n);
                            const f32x4 x1 = acc[ai][0][m][n], x2 = acc[ai][1][m][n];
                            o1[n] = x1 * c - x2 * sv; o2[n] = x2 * c + x1 * sv;
                        }
                        if (frag) {
                            unsigned char* kb = KF + ((size_t)head * 1024 + (row >> 4)) * 2048 + (size_t)(d >> 5) * 512 + (size_t)(((d >> 3) & 3) * 16 + (row & 15)) * 8;
                            *(u32x2*)kb = pack8_fp8(o1[0], o1[1]); *(u32x2*)(kb + 1024) = pack8_fp8(o2[0], o2[1]);
                        } else if (tile >= 16) {
                            const int hd = 2 * (tile - 16) + head, sh = 2 * (hd >> 2), tp = ((row & ((1 << sh) - 1)) << (14 - sh)) + (row >> sh);
                            bf16_t* kb = kbf + ((size_t)hd * 1024 + (tp >> 4)) * 2048 + (size_t)(d >> 5) * 512 + (size_t)(((d >> 3) & 3) * 16 + (tp & 15)) * 8;
                            *(u32x4*)kb = pack8(o1[0], o1[1]); *(u32x4*)(kb + 1024) = pack8(o2[0], o2[1]);
                        } else {
                            bf16_t* p = proj + (size_t)row * PLD + dcol + head * 128 + d;
                            *(u32x4*)p = pack8(o1[0], o1[1]); *(u32x4*)(p + 64) = pack8(o2[0], o2[1]);
                        }
                        if (m & 1) asm volatile("" ::: "memory");
                    }
            }
        } else if (tile < 44) {
#pragma unroll
            for (int ai = 0; ai < 2; ++ai)
#pragma unroll
                for (int m = 0; m < 4; ++m)
#pragma unroll
                    for (int bj = 0; bj < 2; ++bj) {
                        f32x4 v[2];
#pragma unroll
                        for (int n = 0; n < 2; ++n)
#pragma unroll
                            for (int e = 0; e < 4; ++e) v[n][e] = fsigmoid(acc[ai][bj][m][n][e]);
                        *(u32x4*)(sigg + (size_t)(row0 + ai * 128 + m * 16) * 4096 + (tile - 28) * 256 + bj * 128 + cw) = pack8(v[0], v[1]);
                    }
        } else {
            if (wc == 0) {
#pragma unroll
                for (int ai = 0; ai < 2; ++ai)
#pragma unroll
                    for (int m = 0; m < 4; ++m) {
                        f32x4 v[2];
#pragma unroll
                        for (int n = 0; n < 2; ++n)
#pragma unroll
                            for (int e = 0; e < 4; ++e) v[n][e] = fsigmoid(acc[ai][0][m][n][e]);
                        *(u32x4*)(gn + (size_t)(row0 + ai * 128 + m * 16) * 32 + cw) = pack8(v[0], v[1]);
                    }
            }
        }
    }
};
template <bool FIRST> struct EpiGate {
    static constexpr bool PERM = true;
    const bf16_t* sg; bf16_t* O;
    __device__ __forceinline__ void operator()(const pg8::Acc& acc, const pg8::Unit& u, int wr, int wc, int fr, int fq) const {
        const int row0 = u.pm * 256 + wr * 64 + fr, col0 = u.pn * 256 + wc * 32 + 8 * fq;
#pragma unroll
        for (int ai = 0; ai < 2; ++ai)
#pragma unroll
            for (int m = 0; m < 4; ++m)
#pragma unroll
                for (int bj = 0; bj < 2; ++bj) {
                    const int row = row0 + ai * 128 + m * 16, col = col0 + bj * 128;
                    const u32x4 gv = *(const u32x4*)(sg + (size_t)row * 4096 + col);
                    u32x4 pv = (u32x4){0u, 0u, 0u, 0u}; if (!FIRST) pv = *(const u32x4*)(O + (size_t)row * DM + col);
                    f32x4 v[2];
#pragma unroll
                    for (int n = 0; n < 2; ++n) {
                        const unsigned g0 = n ? gv.z : gv.x, g1 = n ? gv.w : gv.y, p0 = n ? pv.z : pv.x, p1 = n ? pv.w : pv.y;
                        const f32x4 y = acc[ai][bj][m][n];
                        v[n][0] = bflo(p0) + bflo(g0) * y[0]; v[n][1] = bfhi(p0) + bfhi(g0) * y[1];
                        v[n][2] = bflo(p1) + bflo(g1) * y[2]; v[n][3] = bfhi(p1) + bfhi(g1) * y[3];
                    }
                    *(u32x4*)(O + (size_t)row * DM + col) = pack8(v[0], v[1]);
                }
    }
};

template <bool FRAG = false>
__device__ __forceinline__ void tr_item(const float* W, int ldw, int k0, int scol0, int nvalid, bf16_t* WT, int ldt, int drow0, int dk0, LAS float* scr, int lane) {
    const int c = lane & 31;
    float v[32];
#pragma unroll
    for (int i = 0; i < 32; ++i) { const int kk = 2 * i + (lane >> 5); v[i] = (c < nvalid) ? W[(size_t)(k0 + kk) * ldw + scol0 + c] : 0.f; }
#pragma unroll
    for (int i = 0; i < 32; ++i) { const int kk = 2 * i + (lane >> 5); scr[kk * 33 + c] = v[i]; }
    asm volatile("s_waitcnt lgkmcnt(0)" ::: "memory");
    const int c8 = lane & 7;
#pragma unroll
    for (int j = 0; j < 4; ++j) { const int n = (lane >> 3) + 8 * j; const LAS float* s = scr + (8 * c8) * 33 + n;
        u32x4 o; o.x = cvt_pk_bf16(s[0 * 33], s[1 * 33]); o.y = cvt_pk_bf16(s[2 * 33], s[3 * 33]); o.z = cvt_pk_bf16(s[4 * 33], s[5 * 33]); o.w = cvt_pk_bf16(s[6 * 33], s[7 * 33]);
        if (FRAG) { const int c = drow0 + n, k = dk0 + 8 * c8; *(u32x4*)(WT + ((size_t)((c >> 4) * (ldt >> 5) + (k >> 5)) * 64 + ((k >> 3) & 3) * 16 + (c & 15)) * 8) = o; }
        else *(u32x4*)(WT + (size_t)(drow0 + n) * ldt + dk0 + 8 * c8) = o; }
    asm volatile("s_waitcnt lgkmcnt(0)" ::: "memory");
}
__device__ __forceinline__ int win_src_col(int r) {
    if (r >= WIN_SRC) return -1;
    if (r >= 11264) return 2560 + (r - 11264);
    const int tile = r >> 8; int j = r & 255;
    const bool rope = (tile == 6) | (tile == 8) | (tile >= 10 && tile < 22);
    if (rope) { const int q = j >> 6, d = j & 63; j = (q & 1) * 128 + (q >> 1) * 64 + d; }
    const int c = tile * 256 + j;
    return c < 2560 ? c : c + 24;
}
__device__ __forceinline__ void conv_ffn(const float* Wg, const float* Wu, const float* Wd, bf16_t* GU, bf16_t* DN, LAS float* scr, int gw, int ngw, int lane) {
    constexpr int I_G = 32 * 176;
    for (int it = gw; it < 2 * I_G; it += ngw) { const int which = it / I_G, r = it % I_G, kb = r / 176, nb = r % 176, c0 = nb * 32;
        tr_item(which ? Wu : Wg, FF, kb * 64, c0, 32, GU, DM, 256 * (c0 >> 7) + (c0 & 127) + which * 128, kb * 64, scr, lane); }
    for (int it = gw; it < 88 * 64; it += ngw) { const int kb = it / 64, nb = it % 64; tr_item(Wd, DM, kb * 64, nb * 32, 32, DN, FF, nb * 32, kb * 64, scr, lane); }
}
__device__ __forceinline__ void ln_rows(const float* in, float* outf, bf16_t* outb, const float* g, const float* b, int gw, int ngw, int lane, float* stats = nullptr) {
    f32x4 gv[8], bv[8];
#pragma unroll
    for (int j = 0; j < 8; ++j) { gv[j] = *(const f32x4*)(g + 4 * (lane + 64 * j)); bv[j] = *(const f32x4*)(b + 4 * (lane + 64 * j)); }
    for (int row = gw; row < S; row += ngw) {
        const float* xr = in + (size_t)row * DM; f32x4 v[8]; float s = 0.f;
#pragma unroll
        for (int j = 0; j < 8; ++j) { v[j] = *(const f32x4*)(xr + 4 * (lane + 64 * j)); s += (v[j][0] + v[j][1]) + (v[j][2] + v[j][3]); }
        const float mean = wave_sum(s) * (1.f / DM); float s2 = 0.f;
#pragma unroll
        for (int j = 0; j < 8; ++j) { v[j] = v[j] - mean; s2 += (v[j][0] * v[j][0] + v[j][1] * v[j][1]) + (v[j][2] * v[j][2] + v[j][3] * v[j][3]); }
        const float rstd = 1.f / sqrtf(wave_sum(s2) * (1.f / DM) + LN_EPS);
        if (stats && lane == 0) *(f32x2*)(stats + 2 * (size_t)row) = (f32x2){mean, rstd};
#pragma unroll
        for (int j = 0; j < 8; ++j) { const f32x4 o = v[j] * rstd * gv[j] + bv[j];
            if (outf) *(f32x4*)(outf + (size_t)row * DM + 4 * (lane + 64 * j)) = o;
            if (outb) { u32x2 w; w.x = cvt_pk_bf16(o[0], o[1]); w.y = cvt_pk_bf16(o[2], o[3]); *(u32x2*)(outb + (size_t)row * DM + 4 * (lane + 64 * j)) = w; } }
    }
}

struct AState { float m, l; f32x4 o[8]; };
__device__ __forceinline__ void astate_init(AState& s) { s.m = -1e30f; s.l = 0.f;
#pragma unroll
    for (int i = 0; i < 8; ++i) s.o[i] = (f32x4){0.f, 0.f, 0.f, 0.f}; }
__device__ __forceinline__ int clampi(int v, int lo, int hi) { return v < lo ? lo : (v > hi ? hi : v); }

__device__ __forceinline__ void load_k(bf16x8 (&kf)[2][4], const bf16_t* __restrict__ Kb, int ld, int pos0, int dpos, int posmax, int l16, int kq) {
#pragma unroll
    for (int T = 0; T < 2; ++T) { const int p = clampi(pos0 + dpos * (16 * T + l16), 0, posmax); const bf16_t* kp = Kb + (size_t)p * ld + 8 * kq;
#pragma unroll
        for (int s = 0; s < 4; ++s) kf[T][s] = *(const bf16x8*)(kp + 32 * s); }
}
__device__ __forceinline__ void load_v(u32x4 (&vr)[8], const bf16_t* __restrict__ Vb, int ld, int pos0, int dpos, int posmax, int l16, int kq) {
#pragma unroll
    for (int i = 0; i < 8; ++i) { const int p = clampi(pos0 + dpos * (4 * i + kq), 0, posmax); vr[i] = *(const u32x4*)(Vb + (size_t)p * ld + 8 * l16); }
}
__device__ __forceinline__ void store_v(const u32x4 (&vr)[8], LAS unsigned char* vbuf, int l16, int kq) {
#pragma unroll
    for (int i = 0; i < 8; ++i) *(LAS u32x4*)(vbuf + (4 * i + kq) * VROW + 16 * l16) = vr[i];
}
template <int MODE, bool SLC, class Desc>
__device__ __forceinline__ void attn_run(const bf16x8 (&qf)[4], const bf16_t* __restrict__ Kb, const bf16_t* __restrict__ Vb, int ld, int dpos, int posmax,
                                         const Desc& desc, int n, int lo_in, int hi, int qi, AState& st, LAS unsigned char* vbuf, int lane, LAS float* imp = nullptr) {
    if (n <= 0) return;
    const int l16 = lane & 15, kq = lane >> 4;
    u32x4 kr[8];
    int dcur = desc(0);
    load_v(kr, Kb, ld, SLC ? (dcur & 0xfffff) : dcur, dpos, posmax, l16, kq);
#pragma unroll 1
    for (int i = 0; i < n; ++i) {
        const int pos0 = SLC ? (dcur & 0xfffff) : dcur;
        const int lo = SLC ? ((((dcur >> 20) == qi) | ((dcur >> 20) == 4)) ? 0 : (1 << 30)) : lo_in;
        store_v(kr, vbuf, l16, kq);
        u32x4 vr[8];
        if (MODE != 1) load_v(vr, Vb, ld, pos0, dpos, posmax, l16, kq);
        bf16x8 kf[2][4];
#pragma unroll
        for (int T = 0; T < 2; ++T)
#pragma unroll
            for (int s = 0; s < 4; ++s) kf[T][s] = *(const LAS bf16x8*)(vbuf + (16 * T + l16) * VROW + 64 * s + 16 * kq);
        f32x4 sa[2] = {(f32x4){0.f, 0.f, 0.f, 0.f}, (f32x4){0.f, 0.f, 0.f, 0.f}};
#pragma unroll
        for (int T = 0; T < 2; ++T)
#pragma unroll
            for (int s = 0; s < 4; ++s) sa[T] = __builtin_amdgcn_mfma_f32_16x16x32_bf16(kf[T][s], qf[s], sa[T], 0, 0, 0);
        const int dnext = desc(i + 1 < n ? i + 1 : i);
        load_v(kr, Kb, ld, SLC ? (dnext & 0xfffff) : dnext, dpos, posmax, l16, kq);
        float sc[8]; bool vd[8]; float mx = -1e30f;
#pragma unroll
        for (int T = 0; T < 2; ++T)
#pragma unroll
            for (int r = 0; r < 4; ++r) { const int p = pos0 + dpos * (16 * T + 4 * kq + r); const bool v = (p >= lo) & (p <= hi); const float x = sa[T][r] * SL2;
                sc[4 * T + r] = x; vd[4 * T + r] = v; mx = v ? fmaxf(mx, x) : mx; }
        float p[8];
        if (MODE == 2) {
#pragma unroll
            for (int j = 0; j < 8; ++j) p[j] = vd[j] ? __builtin_amdgcn_exp2f(sc[j] - st.m) * st.l : 0.f;
#pragma unroll
            for (int T = 0; T < 2; ++T) {
                float x = 2.f * (p[4 * T] + p[4 * T + 1] + p[4 * T + 2]) + p[4 * T + 3], y = p[4 * T + 3];
                x += __shfl_xor(x, 1); x += __shfl_xor(x, 2); y += __shfl_xor(y, 1); y += __shfl_xor(y, 2);
                if ((l16 & 3) == 0) { const int a = (pos0 >> 2) + 4 * T + kq; LAS float* ip = imp + (l16 >> 2) * IMP_LD + a;
                    ip[0] += x;
                    asm volatile("s_waitcnt lgkmcnt(0)" ::: "memory");
                    ip[1] += y; }
                asm volatile("s_waitcnt lgkmcnt(0)" ::: "memory");
            }
        } else {
            if (__builtin_amdgcn_ballot_w64(mx > st.m + 40.f) != 0ull) {
                mx = fmaxf(mx, __shfl_xor(mx, 16)); mx = fmaxf(mx, __shfl_xor(mx, 32));
                const float mn = fmaxf(st.m, mx), alpha = __builtin_amdgcn_exp2f(st.m - mn); st.m = mn; st.l *= alpha;
                if (MODE == 0) {
#pragma unroll
                    for (int j = 0; j < 8; ++j) st.o[j] = st.o[j] * alpha;
                }
            }
            float ps = 0.f;
#pragma unroll
            for (int j = 0; j < 8; ++j) { p[j] = vd[j] ? __builtin_amdgcn_exp2f(sc[j] - st.m) : 0.f; ps += p[j]; }
            st.l += ps;
        }
        if (MODE != 1) {
            store_v(vr, vbuf, l16, kq);
            u32x4 pw; pw.x = cvt_pk_bf16(p[0], p[1]); pw.y = cvt_pk_bf16(p[2], p[3]); pw.z = cvt_pk_bf16(p[4], p[5]); pw.w = cvt_pk_bf16(p[6], p[7]);
            const bf16x8 pf = __builtin_bit_cast(bf16x8, pw);
            const unsigned addr = (unsigned)(uintptr_t)(vbuf) + (4 * kq + (l16 >> 2)) * VROW + (l16 & 3) * 8;
#pragma unroll
            for (int hf = 0; hf < 2; ++hf) {
                s16x4 a[8];
                asm volatile("s_waitcnt lgkmcnt(0)\n\t"
                             "ds_read_b64_tr_b16 %0, %8 offset:0\n\t"    "ds_read_b64_tr_b16 %1, %8 offset:32\n\t"
                             "ds_read_b64_tr_b16 %2, %8 offset:64\n\t"   "ds_read_b64_tr_b16 %3, %8 offset:96\n\t"
                             "ds_read_b64_tr_b16 %4, %8 offset:4608\n\t" "ds_read_b64_tr_b16 %5, %8 offset:4640\n\t"
                             "ds_read_b64_tr_b16 %6, %8 offset:4672\n\t" "ds_read_b64_tr_b16 %7, %8 offset:4704\n\t"
                             "s_waitcnt lgkmcnt(0)"
                             : "=&v"(a[0]), "=&v"(a[1]), "=&v"(a[2]), "=&v"(a[3]), "=&v"(a[4]), "=&v"(a[5]), "=&v"(a[6]), "=&v"(a[7])
                             : "v"(addr + 128 * hf) : "memory");
#pragma unroll
                for (int d4 = 0; d4 < 4; ++d4) { const int db = 4 * hf + d4;
                    bf16x8 af; af[0] = a[d4][0]; af[1] = a[d4][1]; af[2] = a[d4][2]; af[3] = a[d4][3]; af[4] = a[d4 + 4][0]; af[5] = a[d4 + 4][1]; af[6] = a[d4 + 4][2]; af[7] = a[d4 + 4][3];
                    st.o[db] = __builtin_amdgcn_mfma_f32_16x16x32_bf16(af, pf, st.o[db], 0, 0, 0); }
            }
        }
        dcur = dnext;
    }
}
struct FragV { bf16x8 v[8]; };
__device__ __forceinline__ void load_fk(bf16x8 (&k)[2][4], const bf16_t* __restrict__ KF, int pos0, int lane) {
    const bf16_t* kp = KF + ((size_t)(pos0 >> 4) * 256 + lane) * 8;
#pragma unroll
    for (int T = 0; T < 2; ++T)
#pragma unroll
        for (int s2 = 0; s2 < 4; ++s2) k[T][s2] = *(const bf16x8*)(kp + (T * 4 + s2) * 512);
}
__device__ __forceinline__ void load_fv(FragV& f, const bf16_t* __restrict__ VF, int pos0, int lane) {
    const bf16_t* vp = VF + ((size_t)(pos0 >> 5) * 512 + lane) * 8;
#pragma unroll
    for (int db = 0; db < 8; ++db) f.v[db] = *(const bf16x8*)(vp + db * 512);
}
template <int MODE>
__device__ __forceinline__ void step_fragb(const bf16x8 (&qf)[4], bf16x8 (&kf)[2][4], FragV& cur, const bf16_t* __restrict__ KF, const bf16_t* __restrict__ VF,
                                           int pos0, int pnext, int lo, int hi, AState& st, int lane, LAS float* imp) {
    const int kq = lane >> 4;
    f32x4 sa[2] = {(f32x4){0.f, 0.f, 0.f, 0.f}, (f32x4){0.f, 0.f, 0.f, 0.f}};
#pragma unroll
    for (int T = 0; T < 2; ++T)
#pragma unroll
        for (int s2 = 0; s2 < 4; ++s2) sa[T] = __builtin_amdgcn_mfma_f32_16x16x32_bf16(kf[T][s2], qf[s2], sa[T], 0, 0, 0);
    load_fk(kf, KF, pnext, lane);
    float sc[8]; bool vd[8]; float mx = -1e30f;
#pragma unroll
    for (int T = 0; T < 2; ++T)
#pragma unroll
        for (int r = 0; r < 4; ++r) { const int p = pos0 + 16 * T + 4 * kq + r; const bool v = (p >= lo) & (p <= hi); const float x = sa[T][r] * SL2;
            sc[4 * T + r] = x; vd[4 * T + r] = v; mx = v ? fmaxf(mx, x) : mx; }
    float p[8];
    if (MODE == 2) {
        const int l16 = lane & 15;
#pragma unroll
        for (int j = 0; j < 8; ++j) p[j] = vd[j] ? __builtin_amdgcn_exp2f(sc[j] - st.m) * st.l : 0.f;
#pragma unroll
        for (int T = 0; T < 2; ++T) {
            float x = 2.f * (p[4 * T] + p[4 * T + 1] + p[4 * T + 2]) + p[4 * T + 3], y = p[4 * T + 3];
            x += __shfl_xor(x, 1); x += __shfl_xor(x, 2); y += __shfl_xor(y, 1); y += __shfl_xor(y, 2);
            if ((l16 & 3) == 0) { const int a = (pos0 >> 2) + 4 * T + kq; LAS float* ip = imp + (l16 >> 2) * IMP_LD + a;
                ip[0] += x;
                asm volatile("s_waitcnt lgkmcnt(0)" ::: "memory");
                ip[1] += y; }
            asm volatile("s_waitcnt lgkmcnt(0)" ::: "memory");
        }
    } else {
        if (__builtin_amdgcn_ballot_w64(mx > st.m + 40.f) != 0ull) {
            mx = fmaxf(mx, __shfl_xor(mx, 16)); mx = fmaxf(mx, __shfl_xor(mx, 32));
            const float mn = fmaxf(st.m, mx), alpha = __builtin_amdgcn_exp2f(st.m - mn); st.m = mn; st.l *= alpha;
            if (MODE == 0) {
#pragma unroll
                for (int j = 0; j < 8; ++j) st.o[j] = st.o[j] * alpha;
            }
        }
        float ps = 0.f;
#pragma unroll
        for (int j = 0; j < 8; ++j) { p[j] = vd[j] ? __builtin_amdgcn_exp2f(sc[j] - st.m) : 0.f; ps += p[j]; }
        st.l += ps;
    }
    if (MODE != 1) {
        u32x4 pw; pw.x = cvt_pk_bf16(p[0], p[1]); pw.y = cvt_pk_bf16(p[2], p[3]); pw.z = cvt_pk_bf16(p[4], p[5]); pw.w = cvt_pk_bf16(p[6], p[7]);
        const bf16x8 pf = __builtin_bit_cast(bf16x8, pw);
#pragma unroll
        for (int db = 0; db < 8; ++db) st.o[db] = __builtin_amdgcn_mfma_f32_16x16x32_bf16(cur.v[db], pf, st.o[db], 0, 0, 0);
        load_fv(cur, VF, pnext, lane);
    }
}
template <int MODE, bool SLC, class Desc>
__device__ __forceinline__ void attn_run_frag(const bf16x8 (&qf)[4], const bf16_t* __restrict__ KF, const bf16_t* __restrict__ VF, const Desc& desc, int n,
                                              int lo_in, int hi, int qi, AState& st, int lane, LAS float* imp = nullptr) {
    static_assert(!SLC, "the bf16 fragment walk is used without per-step query selection");
    if (n <= 0) return;
    bf16x8 kf[2][4]; FragV va;
    int d0 = desc(0);
    load_fk(kf, KF, d0, lane);
    if (MODE != 1) load_fv(va, VF, d0, lane);
#pragma unroll 1
    for (int i = 0; i < n; ++i) {
        const int d1 = desc(i + 1 < n ? i + 1 : i);
        step_fragb<MODE>(qf, kf, va, KF, VF, d0, d1, lo_in, hi, st, lane, imp);
        d0 = d1;
    }
}
struct Frag8 { i64_t k[2][4]; i64_t v[8]; };
__device__ __forceinline__ void load_frag8(Frag8& f, const unsigned char* __restrict__ KF, const unsigned char* __restrict__ VF, int pos0, int lane) {
    const unsigned char* kp = KF + ((size_t)(pos0 >> 4) * 256 + lane) * 8; const unsigned char* vp = VF + ((size_t)(pos0 >> 5) * 512 + lane) * 8;
#pragma unroll
    for (int T = 0; T < 2; ++T)
#pragma unroll
        for (int s2 = 0; s2 < 4; ++s2) f.k[T][s2] = *(const i64_t*)(kp + (T * 4 + s2) * 512);
#pragma unroll
    for (int db = 0; db < 8; ++db) f.v[db] = *(const i64_t*)(vp + db * 512);
}
template <bool SLC, bool NOMASK>
__device__ __forceinline__ void step_frag8(const i64_t (&qf)[4], const Frag8& cur, Frag8& nxt, const unsigned char* __restrict__ KF, const unsigned char* __restrict__ VF,
                                           int dcur, int dnext, int lo_in, int hi, int qi, AState& st, int lane) {
    const int kq = lane >> 4;
    const int pos0 = SLC ? (dcur & 0xfffff) : dcur;
    const int lo = SLC ? ((((dcur >> 20) == qi) | ((dcur >> 20) == 4)) ? 0 : (1 << 30)) : lo_in;
    load_frag8(nxt, KF, VF, SLC ? (dnext & 0xfffff) : dnext, lane);
    f32x4 sa[2] = {(f32x4){0.f, 0.f, 0.f, 0.f}, (f32x4){0.f, 0.f, 0.f, 0.f}};
#pragma unroll
    for (int T = 0; T < 2; ++T)
#pragma unroll
        for (int s2 = 0; s2 < 4; ++s2) sa[T] = __builtin_amdgcn_mfma_f32_16x16x32_fp8_fp8(cur.k[T][s2], qf[s2], sa[T], 0, 0, 0);
    float sc[8]; bool vd[8]; float mx = -1e30f;
    const bool act = lo == 0 || !SLC;
    if (NOMASK) {
#pragma unroll
        for (int j = 0; j < 8; ++j) { sc[j] = sa[j >> 2][j & 3]; vd[j] = act; }
        mx = fmaxf(fmaxf(fmaxf(sc[0], sc[1]), fmaxf(sc[2], sc[3])), fmaxf(fmaxf(sc[4], sc[5]), fmaxf(sc[6], sc[7])));
        mx = act ? mx : -1e30f;
    } else {
#pragma unroll
        for (int T = 0; T < 2; ++T)
#pragma unroll
            for (int r = 0; r < 4; ++r) { const int p = pos0 + 16 * T + 4 * kq + r; const bool v = (p >= lo) & (p <= hi); const float x = sa[T][r];
                sc[4 * T + r] = x; vd[4 * T + r] = v; mx = v ? fmaxf(mx, x) : mx; }
    }
    if (__builtin_amdgcn_ballot_w64(mx > st.m + 4.f) != 0ull) {
        mx = fmaxf(mx, __shfl_xor(mx, 16)); mx = fmaxf(mx, __shfl_xor(mx, 32));
        const float mn = fmaxf(st.m, mx), alpha = __builtin_amdgcn_exp2f(st.m - mn); st.m = mn; st.l *= alpha;
#pragma unroll
        for (int j = 0; j < 8; ++j) st.o[j] = st.o[j] * alpha;
    }
    f32x4 pa, pb; float ps = 0.f;
    const float mref = st.m - 4.f;
    if (NOMASK) {
#pragma unroll
        for (int j = 0; j < 4; ++j) { pa[j] = __builtin_amdgcn_exp2f(sc[j] - mref); pb[j] = __builtin_amdgcn_exp2f(sc[4 + j] - mref); }
        if (SLC) {
#pragma unroll
            for (int j = 0; j < 4; ++j) { pa[j] = act ? pa[j] : 0.f; pb[j] = act ? pb[j] : 0.f; }
        }
#pragma unroll
        for (int j = 0; j < 4; ++j) ps += pa[j] + pb[j];
    } else {
#pragma unroll
        for (int j = 0; j < 4; ++j) { pa[j] = vd[j] ? __builtin_amdgcn_exp2f(sc[j] - mref) : 0.f; pb[j] = vd[4 + j] ? __builtin_amdgcn_exp2f(sc[4 + j] - mref) : 0.f; ps += pa[j] + pb[j]; }
    }
    st.l += ps;
    const u32x2 pw = pack8_fp8(pa, pb);
    const i64_t pf = __builtin_bit_cast(i64_t, pw);
#pragma unroll
    for (int db = 0; db < 8; ++db) st.o[db] = __builtin_amdgcn_mfma_f32_16x16x32_fp8_fp8(cur.v[db], pf, st.o[db], 0, 0, 0);
}
template <bool SLC, class Desc>
__device__ __forceinline__ void attn_run_frag8(const i64_t (&qf)[4], const unsigned char* __restrict__ KF, const unsigned char* __restrict__ VF, const Desc& desc, int n,
                                               int lo_in, int hi, int qi, AState& st, int lane) {
    if (n <= 0) return;
    Frag8 fa, fb;
    int d0 = desc(0);
    load_frag8(fa, KF, VF, SLC ? (d0 & 0xfffff) : (d0 & ~(1 << 30)), lane);
#pragma unroll 1
    for (int i = 0; i < n; i += 2) {
        const int d1 = desc(i + 1 < n ? i + 1 : i);
        if (d0 & (1 << 30)) step_frag8<SLC, true>(qf, fa, fb, KF, VF, d0 & ~(1 << 30), d1 & ~(1 << 30), lo_in, hi, qi, st, lane);
        else step_frag8<SLC, false>(qf, fa, fb, KF, VF, d0, d1 & ~(1 << 30), lo_in, hi, qi, st, lane);
        if (i + 1 >= n) break;
        const int d2 = desc(i + 2 < n ? i + 2 : i + 1);
        if (d1 & (1 << 30)) step_frag8<SLC, true>(qf, fb, fa, KF, VF, d1 & ~(1 << 30), d2 & ~(1 << 30), lo_in, hi, qi, st, lane);
        else step_frag8<SLC, false>(qf, fb, fa, KF, VF, d1, d2 & ~(1 << 30), lo_in, hi, qi, st, lane);
        d0 = d2;
    }
}
__device__ __forceinline__ float quad_total(float v) { v += __shfl_xor(v, 16); v += __shfl_xor(v, 32); return v; }

__device__ __forceinline__ void dilated_unit(int unit, const bf16_t* proj, const bf16_t* kbf, bf16_t* nsaout, int lane) {
    const int l16 = lane & 15, kq = lane >> 4;
    const int hg = unit & 3, r16 = (unit >> 2) & 15, ut = unit >> 6;
    const int t0 = r16 + 256 * ut, tc = t0 + 16 * l16;
    const bf16_t* vbf = kbf + ((size_t)24 << 20);
    AState st; astate_init(st);
#pragma unroll 1
    for (int pt = 0; pt < 3; ++pt) {
        const int sh = 2 * pt, head = 4 * pt + hg;
        const bf16_t* qrow = proj + (size_t)tc * PLD + PC_QB + head * 128 + 8 * kq;
        bf16x8 qf[4];
#pragma unroll
        for (int s = 0; s < 4; ++s) qf[s] = *(const bf16x8*)(qrow + 32 * s);
        const int base = (r16 & ((1 << sh) - 1)) << (14 - sh), u0 = t0 >> sh, ui = u0 + (16 >> sh) * l16;
        const int lo = base + (ui - 128 < 0 ? 0 : ui - 128), hi = base + ui;
        const int first = (base + (u0 - 128 < 0 ? 0 : u0 - 128)) >> 5, last = (base + u0 + 15 * (16 >> sh)) >> 5;
        unsigned long long hoff = (unsigned long long)head * S * 128; asm volatile("" : "+s"(hoff));
        auto desc = [&](int i) { return 32 * (first + i); };
        attn_run_frag<0, false>(qf, kbf + hoff, vbf + hoff, desc, last - first + 1, lo, hi, 0, st, lane);
    }
    const float lt = quad_total(st.l), inv = lt > 0.f ? 1.f / lt : 0.f;
    bf16_t* op = nsaout + (size_t)tc * NOLD + 1024 + hg * 128 + 4 * kq;
#pragma unroll
    for (int db = 0; db < 8; ++db) { const f32x4 o = st.o[db] * inv; u32x2 w; w.x = cvt_pk_bf16(o[0], o[1]); w.y = cvt_pk_bf16(o[2], o[3]); *(u32x2*)(op + 16 * db) = w; }
}

__device__ __forceinline__ void compress_unit(int unit, const bf16_t* proj, const bf16_t* w1t, const bf16_t* w2t, const float* bias, bf16_t* outc, LAS unsigned char* scr, int lane) {
    const int l16 = lane & 15, kq = lane >> 4;
    const int rt = unit & 63, g = (unit >> 6) & 1, kv = unit >> 7;
    const bf16_t* raw = proj + (kv ? PC_VC : PC_KC) + 128 * g;
    const int n = 16 * rt + l16;
    f32x4 acc[16];
#pragma unroll
    for (int i = 0; i < 16; ++i) acc[i] = (f32x4){0.f, 0.f, 0.f, 0.f};
#pragma unroll 2
    for (int s = 0; s < 128; ++s) {
        const int tok = clampi(16 * n + (s >> 2), 0, S - 1);
        const bf16x8 af = *(const bf16x8*)(raw + (size_t)tok * PLD + (s & 3) * 32 + 8 * kq);
#pragma unroll
        for (int ct = 0; ct < 16; ++ct) { const bf16x8 bfr = *(const bf16x8*)(w1t + ((size_t)(ct * 128 + s) * 64 + lane) * 8);
            acc[ct] = __builtin_amdgcn_mfma_f32_16x16x32_bf16(af, bfr, acc[ct], 0, 0, 0); }
    }
#pragma unroll
    for (int ct = 0; ct < 16; ++ct) { const float bb = bias[16 * ct + l16];
#pragma unroll
        for (int r = 0; r < 4; ++r) { const float x = acc[ct][r] + bb; const float u2 = 1.5957691216f * (x + 0.044715f * x * x * x); const float gl = x * fsigmoid(u2);
            *(LAS bf16_t*)(scr + (4 * kq + r) * 528 + (16 * ct + l16) * 2) = (bf16_t)(cvt_pk_bf16(gl, 0.f) & 0xffffu); } }
    asm volatile("s_waitcnt lgkmcnt(0)" ::: "memory");
    f32x4 o2[8];
#pragma unroll
    for (int i = 0; i < 8; ++i) o2[i] = (f32x4){0.f, 0.f, 0.f, 0.f};
#pragma unroll
    for (int s = 0; s < 8; ++s) {
        const bf16x8 af = *(const LAS bf16x8*)(scr + l16 * 528 + (32 * s + 8 * kq) * 2);
#pragma unroll
        for (int dt = 0; dt < 8; ++dt) { const bf16x8 bfr = *(const bf16x8*)(w2t + (size_t)(16 * dt + l16) * 256 + 32 * s + 8 * kq);
            o2[dt] = __builtin_amdgcn_mfma_f32_16x16x32_bf16(af, bfr, o2[dt], 0, 0, 0); }
    }
    asm volatile("s_waitcnt lgkmcnt(0)" ::: "memory");
#pragma unroll
    for (int dt = 0; dt < 8; ++dt)
#pragma unroll
        for (int r = 0; r < 4; ++r) { const int nn = 16 * rt + 4 * kq + r, d = 16 * dt + l16;
            const bf16_t val = (bf16_t)(cvt_pk_bf16(o2[dt][r], 0.f) & 0xffffu);
            if (kv == 0) outc[(((size_t)g * 64 + (nn >> 4)) * 4 + (d >> 5)) * 512 + (((d >> 3) & 3) * 16 + (nn & 15)) * 8 + (d & 7)] = val;
            else { const int kp = nn & 31; outc[(((size_t)g * 32 + (nn >> 5)) * 8 + (d >> 4)) * 512 + ((((kp >> 2) & 3) * 16) + (d & 15)) * 8 + 4 * (kp >> 4) + (kp & 3)] = val; } }
}

__device__ __forceinline__ void nsa_unit(int unit, const bf16_t* proj, const bf16_t* kc, const bf16_t* vc, const bf16_t* gn, const float* cs, const float* sn,
                                         const bf16_t* kslf, const bf16_t* vslf, const bf16_t* kwnf, const bf16_t* vwnf, bf16_t* nsaout, LAS unsigned char* wl, int lane) {
    const int l16 = lane & 15, kq = lane >> 4;
    const int g = unit & 1, tb = unit >> 1, t0 = 4 * tb, qi = l16 >> 2, h = l16 & 3, tc = t0 + qi, head = 4 * g + h;
    LAS unsigned char* vbuf = wl; LAS float* imp = (LAS float*)(wl + VBUF_BYTES); LAS int* sel = (LAS int*)(wl + VBUF_BYTES + 4 * IMP_LD * 4);
    bf16x8 qf[4];
    { const bf16_t* qrow = proj + (size_t)tc * PLD + PC_QA + head * 128 + 8 * kq;
#pragma unroll
        for (int s = 0; s < 4; ++s) qf[s] = *(const bf16x8*)(qrow + 32 * s); }
    LAS u32x2* outl = (LAS u32x2*)(wl + OUT_OFF) + lane;
    for (int i = lane; i < 4 * IMP_LD; i += 64) imp[i] = 0.f;
    const int hic = (tc - 31) >> 4;
    const int nkmax = ((t0 + 3 - 31) >> 4) + 1, nsc = nkmax > 0 ? (nkmax + 31) >> 5 : 0;
    unsigned long long coff = (unsigned long long)g * 1024 * 128; asm volatile("" : "+s"(coff));
    const bf16_t* kcg = kc + coff; const bf16_t* vcg = vc + coff;
    AState st; astate_init(st);
    { auto desc = [&](int i) { return 32 * i; };
      attn_run_frag<1, false>(qf, kcg, vcg, desc, nsc, 0, hic, 0, st, lane);
      { const float lt = quad_total(st.l); st.l = lt > 0.f ? 1.f / lt : 0.f; }
      asm volatile("s_waitcnt lgkmcnt(0)" ::: "memory");
      attn_run_frag<2, false>(qf, kcg, vcg, desc, nsc, 0, hic, 0, st, lane, imp); }
    const float g0 = bf2f(gn[(size_t)tc * 32 + head * 3 + 0]);
#pragma unroll
    for (int i = 0; i < 8; ++i) { const f32x4 o = st.o[i] * g0; u32x2 w; w.x = cvt_pk_bf16(o[0], o[1]); w.y = cvt_pk_bf16(o[2], o[3]); outl[64 * i] = w; }
    asm volatile("s_waitcnt lgkmcnt(0)" ::: "memory");
#pragma unroll
    for (int s2 = 0; s2 < 2; ++s2) {
        const int d = 32 * s2 + 8 * kq; f32x4 c[2], sv[2];
        c[0] = *(const f32x4*)(cs + (size_t)tc * 64 + d); c[1] = *(const f32x4*)(cs + (size_t)tc * 64 + d + 4);
        sv[0] = *(const f32x4*)(sn + (size_t)tc * 64 + d); sv[1] = *(const f32x4*)(sn + (size_t)tc * 64 + d + 4);
        float o1[8], o2[8];
#pragma unroll
        for (int j = 0; j < 8; ++j) { const float x1 = bf2f((unsigned short)qf[s2][j]), x2 = bf2f((unsigned short)qf[s2 + 2][j]), cc = c[j >> 2][j & 3], ss = sv[j >> 2][j & 3];
            o1[j] = x1 * cc - x2 * ss; o2[j] = x2 * cc + x1 * ss; }
        u32x4 w1, w2; w1.x = cvt_pk_bf16(o1[0], o1[1]); w1.y = cvt_pk_bf16(o1[2], o1[3]); w1.z = cvt_pk_bf16(o1[4], o1[5]); w1.w = cvt_pk_bf16(o1[6], o1[7]);
        w2.x = cvt_pk_bf16(o2[0], o2[1]); w2.y = cvt_pk_bf16(o2[2], o2[3]); w2.z = cvt_pk_bf16(o2[4], o2[5]); w2.w = cvt_pk_bf16(o2[6], o2[7]);
        qf[s2] = __builtin_bit_cast(bf16x8, w1); qf[s2 + 2] = __builtin_bit_cast(bf16x8, w2);
    }
    unsigned key[4][4];
#pragma unroll
    for (int q = 0; q < 4; ++q) { const int cur = (t0 + q) >> 6; const f32x4 v = *(const LAS f32x4*)(imp + q * IMP_LD + 4 * lane);
#pragma unroll
        for (int i = 0; i < 4; ++i) { const int j = 4 * lane + i; const bool valid = j <= cur, forced = (j == 0) | (j == cur) | (j == cur - 1);
            const unsigned kb = forced ? 0xffffffu : ((__float_as_uint(fmaxf(v[i], 0.f)) >> 8) + 1u);
            key[q][i] = valid ? ((kb << 8) | (unsigned)(255 - j)) : 0u; } }
#pragma unroll 1
    for (int r = 0; r < 16; ++r) {
        unsigned mx[4];
#pragma unroll
        for (int q = 0; q < 4; ++q) { unsigned a = key[q][0] > key[q][1] ? key[q][0] : key[q][1], b = key[q][2] > key[q][3] ? key[q][2] : key[q][3]; mx[q] = a > b ? a : b; }
#pragma unroll
        for (int o = 1; o < 64; o <<= 1)
#pragma unroll
            for (int q = 0; q < 4; ++q) { const unsigned other = (unsigned)__shfl_xor((int)mx[q], o); mx[q] = other > mx[q] ? other : mx[q]; }
#pragma unroll
        for (int q = 0; q < 4; ++q) {
#pragma unroll
            for (int i = 0; i < 4; ++i) if (key[q][i] == mx[q]) key[q][i] = 0u;
            if (lane == 0) sel[q * 16 + r] = mx[q] ? (int)(255u - (mx[q] & 255u)) : -1;
        }
    }
    asm volatile("s_waitcnt lgkmcnt(0)" ::: "memory");
    i64_t q8[4];
#pragma unroll
    for (int s2 = 0; s2 < 4; ++s2) { f32x4 a, b;
#pragma unroll
        for (int j = 0; j < 4; ++j) { a[j] = bf2f((unsigned short)qf[s2][j]) * SL2; b[j] = bf2f((unsigned short)qf[s2][4 + j]) * SL2; }
        q8[s2] = __builtin_bit_cast(i64_t, pack8_fp8(a, b)); }
    LAS int* list = (LAS int*)(wl + VBUF_BYTES + 4 * IMP_LD * 4 + 256);
    int nslc;
    { const int b = sel[lane], q = lane >> 4, cur0 = t0 >> 6;
      const bool forced = (b == 0) | (b == cur0) | (b == cur0 - 1);
      const bool valid = (b >= 0) & !(forced & (q > 0)); const unsigned long long mask = __ballot(valid);
      const int idx = __popcll(mask & ((1ull << lane) - 1ull)); nslc = 2 * __popcll(mask);
      if (valid) { const int qc = (forced ? 4 : q) | (b < cur0 ? (1 << 10) : 0);
                   list[2 * idx] = (64 * b) | (qc << 20); list[2 * idx + 1] = (64 * b + 32) | (qc << 20); } }
    asm volatile("s_waitcnt lgkmcnt(0)" ::: "memory");
    astate_init(st);
    { auto desc = [&](int i) { return __builtin_amdgcn_readfirstlane(list[i]); };
      unsigned long long goff = (unsigned long long)g * S * 128; asm volatile("" : "+s"(goff));
      attn_run_frag8<true>(q8, (const unsigned char*)kslf + goff, (const unsigned char*)kslf + ((size_t)8 << 20) + goff, desc, nslc, 0, tc, qi, st, lane); }
    { const float g1 = bf2f(gn[(size_t)tc * 32 + head * 3 + 1]); const float lt = quad_total(st.l), inv = (lt > 0.f ? 1.f / lt : 0.f) * g1;
#pragma unroll
        for (int i = 0; i < 8; ++i) { const f32x4 o = st.o[i] * inv; u32x2 w = outl[64 * i]; w.x = cvt_pk_bf16(bflo(w.x) + o[0], bfhi(w.x) + o[1]); w.y = cvt_pk_bf16(bflo(w.y) + o[2], bfhi(w.y) + o[3]); outl[64 * i] = w; } }
    astate_init(st);
    { const int lo = tc - 511 < 0 ? 0 : tc - 511; const int first = t0 < 511 ? 0 : (t0 - 511) >> 5, last = (t0 + 3) >> 5;
      auto desc = [&](int i) { const int p0 = 32 * (first + i); return p0 | ((p0 >= t0 + 3 - 511 && p0 + 31 <= t0) ? (1 << 30) : 0); };
      unsigned long long goff = (unsigned long long)g * S * 128; asm volatile("" : "+s"(goff));
      attn_run_frag8<false>(q8, (const unsigned char*)kslf + ((size_t)16 << 20) + goff, (const unsigned char*)kslf + ((size_t)24 << 20) + goff, desc, last - first + 1, lo, tc, 0, st, lane); }
    { const float g2 = bf2f(gn[(size_t)tc * 32 + head * 3 + 2]); const float lt = quad_total(st.l), inv = (lt > 0.f ? 1.f / lt : 0.f) * g2;
#pragma unroll
        for (int i = 0; i < 8; ++i) { const f32x4 o = st.o[i] * inv; u32x2 w = outl[64 * i]; w.x = cvt_pk_bf16(bflo(w.x) + o[0], bfhi(w.x) + o[1]); w.y = cvt_pk_bf16(bflo(w.y) + o[2], bfhi(w.y) + o[3]); outl[64 * i] = w; } }
    bf16_t* op = nsaout + (size_t)tc * NOLD + head * 128 + 4 * kq;
#pragma unroll
    for (int db = 0; db < 8; ++db) *(u32x2*)(op + 16 * db) = outl[64 * db];
}


#define XB_TMO      128
#define XB_XCNT(j)  (256  + 64 * (j))
#define XB_XSUB(j)  (1280 + 64 * (j))
#define XB_XGEN(j)  (2304 + 64 * (j))
#define XB_TOP      3328
#define XB_TOPGEN   3392
#define XCD_BAR_WORDS 3456
#define XB_SPIN_CAP (1u << 18)
__device__ __forceinline__ unsigned xb_ld(unsigned* p)              { return __hip_atomic_load(p, __ATOMIC_RELAXED, __HIP_MEMORY_SCOPE_AGENT); }
__device__ __forceinline__ unsigned xb_add(unsigned* p, unsigned v) { return __hip_atomic_fetch_add(p, v, __ATOMIC_RELAXED, __HIP_MEMORY_SCOPE_AGENT); }
__device__ __forceinline__ unsigned xb_xcc_id() { return (unsigned)__builtin_amdgcn_s_getreg((3 << 11) | 20) & 0xFu; }
#define XB_SPIN(cond, bar) do { unsigned _sp = 0; while (cond) { __builtin_amdgcn_s_sleep(1); \
    if ((++_sp & 255u) == 0u) { if (xb_ld(&(bar)[XB_TMO])) break; if (_sp > XB_SPIN_CAP) { atomicAdd(&(bar)[XB_TMO], 1u); break; } } } } while (0)
struct XcdBarrier { unsigned* bar; unsigned x; volatile LAS unsigned* st; };
__device__ __forceinline__ XcdBarrier xcd_barrier_post(unsigned* bar, volatile LAS unsigned* st) {
    XcdBarrier b; b.bar = bar; b.x = xb_xcc_id(); b.st = st;
    if (threadIdx.x == 0) st[2] = xb_add(&bar[XB_XCNT(b.x)], 1u);
    return b;
}
__device__ __forceinline__ void xcd_barrier_complete(unsigned* bar, unsigned x, unsigned& nloc, unsigned& nx) {
    const unsigned G = gridDim.x * gridDim.y * gridDim.z;
    unsigned sum, cnt, mine, sp = 0u;
    for (;;) {
        sum = 0u; cnt = 0u; mine = 0u;
#pragma unroll
        for (unsigned j = 0; j < 16; ++j) { const unsigned c = xb_ld(&bar[XB_XCNT(j)]); sum += c; cnt += (c > 0u) ? 1u : 0u; mine = (j == x) ? c : mine; }
        if (sum == G) break;
        __builtin_amdgcn_s_sleep(1);
        if ((++sp & 255u) == 0u) { if (xb_ld(&bar[XB_TMO])) break; if (sp > XB_SPIN_CAP) { atomicAdd(&bar[XB_TMO], 1u); break; } }
    }
    nloc = mine > 0u ? mine : 1u; nx = cnt > 0u ? cnt : 1u;
}
__device__ __forceinline__ void xcd_barrier(const XcdBarrier& b, const int tid) {
    asm volatile("s_waitcnt vmcnt(0)" ::: "memory");
    __syncthreads();
    if (tid == 0) {
        unsigned* bar = b.bar;
        __builtin_amdgcn_s_waitcnt(0);
        unsigned nloc = b.st[0], nx = b.st[1];
        if (nloc == 0u) { xcd_barrier_complete(bar, b.x, nloc, nx); b.st[0] = nloc; b.st[1] = nx; }
        const unsigned old = xb_add(&bar[XB_XSUB(b.x)], 1u);
        const unsigned gen = old / nloc;
        if (old + 1u == (gen + 1u) * nloc) {
            __builtin_amdgcn_fence(__ATOMIC_RELEASE, "agent");
            asm volatile("s_waitcnt vmcnt(0)" ::: "memory");
            const unsigned og = xb_add(&bar[XB_TOP], 1u);
            const unsigned tg = og / nx;
            if (og + 1u == (tg + 1u) * nx) xb_add(&bar[XB_TOPGEN], 1u);
            else XB_SPIN(xb_ld(&bar[XB_TOPGEN]) == tg, bar);
            __builtin_amdgcn_fence(__ATOMIC_ACQUIRE, "agent");
            xb_add(&bar[XB_XGEN(b.x)], 1u);
            asm volatile("s_waitcnt vmcnt(0)" ::: "memory");
        } else {
            XB_SPIN(xb_ld(&bar[XB_XGEN(b.x)]) == gen, bar);
            __builtin_amdgcn_fence(__ATOMIC_ACQUIRE, "agent");
            asm volatile("s_waitcnt vmcnt(0)" ::: "memory");
        }
    }
    __syncthreads();
}

struct Params { const float* in[23]; float* out; unsigned char* ws; float inv_freq[64]; };

__global__ void __launch_bounds__(512, 2) fwd_megakernel(Params P) {
    extern __shared__ __attribute__((aligned(16))) unsigned char lds_raw[];
    LAS unsigned char* lds = (LAS unsigned char*)lds_raw;
    cg::grid_group grid = cg::this_grid();
    const int wave_s = __builtin_amdgcn_readfirstlane(threadIdx.x >> 6);
#define PHASE_WS unsigned long long wsv_ = (unsigned long long)P.ws; asm volatile("" : "+s"(wsv_)); unsigned char* ws = (unsigned char*)(__attribute__((address_space(1))) unsigned char*)wsv_; unsigned z_ = 0u; asm volatile("" : "+v"(z_)); const int tid = wave_s * 64 + (int)__builtin_amdgcn_mbcnt_hi(~0u, __builtin_amdgcn_mbcnt_lo(~0u, z_)); \
    const int lane = tid & 63, wave = __builtin_amdgcn_readfirstlane(tid >> 6), G = gridDim.x, gw = blockIdx.x * 8 + wave, ngw = G * 8; \
    const size_t gtid = (size_t)blockIdx.x * 512 + tid, gthreads = (size_t)G * 512; \
    LAS unsigned char* wl = lds + wave * WAVE_LDS; LAS float* scr = (LAS float*)wl; (void)lane; (void)gw; (void)ngw; (void)gtid; (void)gthreads; (void)wl; (void)scr
#define WAB ((bf16_t*)(ws + WS_WAB))
#define WO ((bf16_t*)(ws + WS_WO))
#define CW1K ((bf16_t*)(ws + WS_CW1K))
#define CW1V ((bf16_t*)(ws + WS_CW1V))
#define CW2K ((bf16_t*)(ws + WS_CW2K))
#define CW2V ((bf16_t*)(ws + WS_CW2V))
#define CBIAS ((float*)(ws + WS_CBIAS))
#define KC ((bf16_t*)(ws + WS_KC))
#define VC ((bf16_t*)(ws + WS_VC))
#define GN ((bf16_t*)(ws + WS_GN))
#define ST1 ((float*)(ws + WS_ST1))
#define ST2 ((float*)(ws + WS_ST2))
#define HF ((float*)(ws + WS_HF))
#define HB ((bf16_t*)(ws + WS_HB))
#define GU ((bf16_t*)(ws + WS_GU))
#define DN ((bf16_t*)(ws + WS_DN))
#define ACT ((bf16_t*)(ws + WS_ACT))
#define PROJ ((bf16_t*)(ws + WS_PROJ))
#define KSLF ((bf16_t*)(ws + WS_KSLF))
#define KBF ((bf16_t*)(ws + WS_KBF))
#define VBF ((bf16_t*)(ws + WS_VBF))
#define VSLF ((bf16_t*)(ws + WS_VSLF))
#define KWNF ((bf16_t*)(ws + WS_KWNF))
#define VWNF ((bf16_t*)(ws + WS_VWNF))
#define RCOS ((float*)(ws + WS_ROPE))
#define RSIN ((float*)(ws + WS_ROPE) + (size_t)S * 64)
#define WINT ((bf16_t*)(ws + WS_WIN))
#define NSAOUT ((bf16_t*)(ws + WS_NSAOUT))
#define SIGG ((bf16_t*)P.out)
    pg8::StaticOrder SO;
#define CG_SYNC() do { asm volatile("s_waitcnt vmcnt(0) lgkmcnt(0)" ::: "memory"); grid.sync(); \
        if (__builtin_amdgcn_readfirstlane(threadIdx.x >> 6) == 0) { __builtin_amdgcn_fence(__ATOMIC_ACQUIRE, "agent"); asm volatile("s_waitcnt vmcnt(0)" ::: "memory"); } \
        __syncthreads(); } while (0)
    volatile LAS unsigned* xst = (volatile LAS unsigned*)(lds + 8 * WAVE_LDS);
    if (threadIdx.x < 2) xst[threadIdx.x] = 0u;
    __syncthreads();
    const XcdBarrier xbar = xcd_barrier_post((unsigned*)P.ws, xst);
    __syncthreads();
    const int vbid = (int)(xst[2] * 8u + xbar.x);
#define GRID_SYNC() do { asm volatile("s_waitcnt vmcnt(0) lgkmcnt(0)" ::: "memory"); unsigned zz_ = 0u; asm volatile("" : "+v"(zz_)); \
        xcd_barrier(xbar, wave_s * 64 + (int)__builtin_amdgcn_mbcnt_hi(~0u, __builtin_amdgcn_mbcnt_lo(~0u, zz_))); } while (0)

    { PHASE_WS;
        conv_ffn(P.in[1], P.in[2], P.in[3], GU, DN, scr, gw, ngw, lane);
        for (int it = gw; it < 32 * 360; it += ngw) { const int kb = it / 360, nb = it % 360, dr = nb * 32; const int sc = win_src_col(dr);
            tr_item(P.in[6], WIN_SRC, kb * 64, sc < 0 ? 0 : sc, sc < 0 ? 0 : (dr == 11264 ? 24 : 32), WINT, DM, dr, kb * 64, scr, lane); }
        for (int it = gw; it < 16 * 64; it += ngw) { const int kb = it / 64, nb = it % 64; tr_item(P.in[13], DM, kb * 64, nb * 32, 32, WAB, 1024, nb * 32, kb * 64, scr, lane); }
        for (int it = gw; it < 8 * 64; it += ngw) { const int kb = it / 64, nb = it % 64; tr_item(P.in[14], DM, kb * 64, nb * 32, 32, WAB + (size_t)DM * 1024, 512, nb * 32, kb * 64, scr, lane); }
        for (int it = gw; it < 32 * 64; it += ngw) { const int kb = it / 64, nb = it % 64; tr_item(P.in[15], DM, kb * 64, nb * 32, 32, WO, DM, nb * 32, kb * 64, scr, lane); }
        for (int it = gw; it < 2 * 64 * 8; it += ngw) { const int w = it / 512, r = it % 512, kb = r / 8, nb = r % 8; tr_item<true>(w ? P.in[11] : P.in[8], 256, kb * 64, nb * 32, 32, w ? CW1V : CW1K, 4096, nb * 32, kb * 64, scr, lane); }
        for (int it = gw; it < 2 * 4 * 4; it += ngw) { const int w = it / 16, r = it % 16, kb = r / 4, nb = r % 4; tr_item(w ? P.in[12] : P.in[9], 128, kb * 64, nb * 32, 32, w ? CW2V : CW2K, 256, nb * 32, kb * 64, scr, lane); }
        { const float* x = P.in[0];
            for (size_t i = gtid; i < (size_t)S * DM / 8; i += gthreads) { const f32x4 a = *(const f32x4*)(x + 8 * i), b = *(const f32x4*)(x + 8 * i + 4); *(u32x4*)(HB + 8 * i) = pack8(a, b); } }
        for (int o = gw; o < 512; o += ngw) { const int w = o >> 8, c = o & 255; const float* pos = w ? P.in[10] : P.in[7]; const float* w1 = w ? P.in[11] : P.in[8];
            float s = 0.f; for (int kk = lane; kk < 4096; kk += 64) s += pos[kk] * w1[(size_t)kk * 256 + c];
            s = wave_sum(s); if (lane == 0) CBIAS[o] = s; }
    }
    CG_SYNC();
    { PHASE_WS; pg8::Gemm g{HB, GU, S, NGU, DM, DM, DM}; SO.init(S, NGU, G, (int)blockIdx.x); EpiSwiglu E{ACT}; pg8::gemm_phase(lds, g, SO, E, tid); }
    GRID_SYNC();
    { PHASE_WS; pg8::Gemm g{ACT, DN, S, DM, FF, FF, FF}; SO.init(S, DM, G, (int)blockIdx.x); EpiResF32 E{P.in[0], HF, ALPHA, 0.5f}; pg8::gemm_phase(lds, g, SO, E, tid); }
    GRID_SYNC();
    { PHASE_WS;
        ln_rows(HF, nullptr, HB, P.in[4], P.in[5], gw, ngw, lane, ST1);
        for (size_t i = gtid; i < (size_t)S * 64; i += gthreads) { const int t = (int)(i >> 6), j = (int)(i & 63); const float ang = (float)t * P.inv_freq[j]; RCOS[i] = cosf(ang); RSIN[i] = sinf(ang); }
    }
    GRID_SYNC();
    { PHASE_WS; pg8::Gemm g{HB, WINT, S, NWIN, DM, DM, DM}; SO.init(S, NWIN, G, (int)blockIdx.x); EpiWin E{PROJ, SIGG, GN, RCOS, KSLF, KBF}; pg8::gemm_phase(lds, g, SO, E, tid); }
    GRID_SYNC();
    { PHASE_WS;
      int vb = (int)blockIdx.x;
      { bool ok = true; unsigned* cen = (unsigned*)P.ws;
#pragma unroll
        for (int j = 0; j < 8; ++j) ok &= (xb_ld(&cen[XB_XCNT(j)]) * 8u == (unsigned)G);
        if (ok) vb = vbid; }
        if (wave == 0) { for (int u = blockIdx.x; u < 256; u += G) { const int kv = u >> 7; compress_unit(u, PROJ, kv ? CW1V : CW1K, kv ? CW2V : CW2K, CBIAS + 256 * kv, kv ? VC : KC, wl, lane); } }
        else if ((G & 7) == 0) {
            const int x = vb & 7, lw = (vb >> 3) * 7 + (wave - 1), nlw = (G >> 3) * 7;
            for (int j = lw; j < 512; j += nlw) dilated_unit(64 * (x + 8 * (j >> 6)) + (j & 63), PROJ, KBF, NSAOUT, lane);
        } else { for (int u = blockIdx.x * 7 + (wave - 1); u < 4096; u += G * 7) dilated_unit(u, PROJ, KBF, NSAOUT, lane); }
    }
    GRID_SYNC();
    { PHASE_WS;
      int vb = (int)blockIdx.x;
      { bool ok = true; unsigned* cen = (unsigned*)P.ws;
#pragma unroll
        for (int j = 0; j < 8; ++j) ok &= (xb_ld(&cen[XB_XCNT(j)]) * 8u == (unsigned)G);
        if (ok) vb = vbid; }
      if ((G & 7) == 0) {
          const int bx = vb, x = bx & 7, g = x & 1, wj = ((bx >> 3) * 4 + (x >> 1)) * 8 + wave, nwj = (G >> 1) * 8;
          for (int tb = wj; tb < 4096; tb += nwj) nsa_unit(2 * tb + g, PROJ, KC, VC, GN, RCOS, RSIN, KSLF, VSLF, KWNF, VWNF, NSAOUT, wl, lane);
      } else { for (int u = gw; u < 8192; u += ngw) nsa_unit(u, PROJ, KC, VC, GN, RCOS, RSIN, KSLF, VSLF, KWNF, VWNF, NSAOUT, wl, lane); } }
    GRID_SYNC();
    { PHASE_WS; SO.init(S, DM, G, (int)blockIdx.x);
      { pg8::Gemm g{NSAOUT, WAB, S, DM, 1024, NOLD, 1024}; EpiGate<true> E{SIGG, HB}; pg8::gemm_phase(lds, g, SO, E, tid); }
      { pg8::Gemm g{NSAOUT + 1024, WAB + (size_t)DM * 1024, S, DM, 512, NOLD, 512}; EpiGate<false> E{SIGG + 2048, HB}; pg8::gemm_phase(lds, g, SO, E, tid); } }
    GRID_SYNC();
    { PHASE_WS; pg8::Gemm g{HB, WO, S, DM, DM, DM, DM}; SO.init(S, DM, G, (int)blockIdx.x); EpiResLnF32 E{HF, ST1, P.in[4], P.in[5], HF, ALPHA, 1.0f}; pg8::gemm_phase(lds, g, SO, E, tid); }
    GRID_SYNC();
    { PHASE_WS;
        ln_rows(HF, nullptr, HB, P.in[16], P.in[17], gw, ngw, lane, ST2);
        conv_ffn(P.in[18], P.in[19], P.in[20], GU, DN, scr, gw, ngw, lane);
    }
    GRID_SYNC();
    { PHASE_WS; pg8::Gemm g{HB, GU, S, NGU, DM, DM, DM}; SO.init(S, NGU, G, (int)blockIdx.x); EpiSwiglu E{ACT}; pg8::gemm_phase(lds, g, SO, E, tid); }
    GRID_SYNC();
    { PHASE_WS; pg8::Gemm g{ACT, DN, S, DM, FF, FF, FF}; SO.init(S, DM, G, (int)blockIdx.x); EpiResLnF32 E{HF, ST2, P.in[16], P.in[17], P.out, ALPHA, 0.5f}; pg8::gemm_phase(lds, g, SO, E, tid); }
    GRID_SYNC();
    { PHASE_WS; (void)ws; ln_rows(P.out, P.out, nullptr, P.in[21], P.in[22], gw, ngw, lane); }
}

extern "C" void kernel_launch(void* const* d_in, const int* in_sizes, int n_in, void* d_out, int out_size, void* d_ws, size_t ws_size, hipStream_t stream) {
    static int grid = 0;
    if (grid == 0) {
        if (n_in != 23 || out_size != S * DM || ws_size < WS_END) { fprintf(stderr, "kernel_launch: unexpected shapes (n_in %d out %d ws %zu, need %zu)\n", n_in, out_size, ws_size, (size_t)WS_END); grid = -1; return; }
        int dev = 0, cus = 0, per_cu = 0;
        hipGetDevice(&dev); hipDeviceGetAttribute(&cus, hipDeviceAttributeMultiprocessorCount, dev);
        if (hipFuncSetAttribute((const void*)fwd_megakernel, hipFuncAttributeMaxDynamicSharedMemorySize, LDS_BYTES) != hipSuccess) { fprintf(stderr, "kernel_launch: hipFuncSetAttribute failed\n"); grid = -1; return; }
        if (hipOccupancyMaxActiveBlocksPerMultiprocessor(&per_cu, (const void*)fwd_megakernel, 512, LDS_BYTES) != hipSuccess || per_cu < 1) { fprintf(stderr, "kernel_launch: occupancy query failed (%d)\n", per_cu); (void)hipGetLastError(); per_cu = 1; }
        grid = cus * per_cu;
    }
    if (grid < 0) return;
    if (hipMemsetAsync(d_ws, 0, 16384, stream) != hipSuccess) { fprintf(stderr, "kernel_launch: memset of the barrier words failed\n"); return; }
    Params p{};
    for (int i = 0; i < 23; ++i) p.in[i] = (const float*)d_in[i];
    p.out = (float*)d_out; p.ws = (unsigned char*)d_ws;
    for (int i = 0; i < 64; ++i) p.inv_freq[i] = (float)pow(10000.0, -(double)i / 64.0);
    void* args[] = {&p};
    hipError_t e = hipLaunchCooperativeKernel((const void*)fwd_megakernel, dim3(grid), dim3(512), args, LDS_BYTES, stream);
    if (e != hipSuccess) fprintf(stderr, "kernel_launch: cooperative launch failed: %s (grid %d)\n", hipGetErrorString(e), grid);
}
```

```cpp
#include <hip/hip_runtime.h>
#include <hip/hip_cooperative_groups.h>
#include <cstdio>
#include <cstdint>
#include <cmath>
namespace cg = cooperative_groups;

#define LAS __attribute__((address_space(3)))
typedef unsigned short bf16_t;
typedef short bf16x8 __attribute__((ext_vector_type(8)));
typedef short s16x4 __attribute__((ext_vector_type(4)));
typedef float f32x4 __attribute__((ext_vector_type(4)));
typedef float f32x2 __attribute__((ext_vector_type(2)));
typedef unsigned u32x4 __attribute__((ext_vector_type(4)));
typedef unsigned u32x2 __attribute__((ext_vector_type(2)));

constexpr int S = 16384, DM = 2048, FF = 5632, NGU = 2 * FF, NWIN = 11520, WIN_SRC = 11288, PLD = 3072, NOLD = 1536;
constexpr float ALPHA = 1.189207115002721f;
constexpr float LN_EPS = 1e-5f;
constexpr float SL2 = 0.08838834764831845f * 1.4426950408889634f;
constexpr int PC_QA = 0, PC_KC = 1024, PC_VC = 1280, PC_QB = 1536;
constexpr size_t MiB = 1u << 20;
constexpr size_t WS_WAB = 1 * MiB, WS_WO = 13 * MiB, WS_CW1K = 21 * MiB, WS_CW1V = 23 * MiB, WS_CW2K = 25 * MiB, WS_CW2V = 25 * MiB + 65536, WS_CBIAS = 25 * MiB + 131072;
constexpr size_t WS_KC = 26 * MiB, WS_VC = 26 * MiB + 524288, WS_GN = 27 * MiB, WS_ST1 = 28 * MiB, WS_ST2 = 28 * MiB + 131072;
constexpr size_t WS_HF = 32 * MiB, WS_HB = 160 * MiB, WS_BIG = 224 * MiB;
constexpr size_t WS_GU = WS_BIG, WS_DN = WS_BIG + 44 * MiB, WS_ACT = WS_BIG + 66 * MiB;
constexpr size_t WS_KBF = WS_BIG + 96 * MiB, WS_VBF = WS_BIG + 144 * MiB;
constexpr size_t WS_PROJ = WS_BIG, WS_KSLF = WS_BIG + 192 * MiB, WS_VSLF = WS_BIG + 200 * MiB, WS_KWNF = WS_BIG + 208 * MiB, WS_VWNF = WS_BIG + 216 * MiB, WS_ROPE = WS_BIG + 224 * MiB;
constexpr size_t WS_WIN = 466 * MiB, WS_NSAOUT = 466 * MiB, WS_END = 514 * MiB;

constexpr int VROW = 288, VBUF_BYTES = 32 * VROW;
constexpr int IMP_LD = 260;
constexpr int OUT_OFF = VBUF_BYTES + 4 * IMP_LD * 4 + 256 + 512;
constexpr int WAVE_LDS = OUT_OFF + 4096;
constexpr int LDS_BYTES = 147456;
static_assert(8 * WAVE_LDS + 32 <= LDS_BYTES && 131072 <= LDS_BYTES, "LDS map");

typedef __bf16 bf16x2_t __attribute__((ext_vector_type(2)));
__device__ __forceinline__ unsigned cvt_pk_bf16(float lo, float hi) { f32x2 v = {lo, hi}; bf16x2_t b = __builtin_convertvector(v, bf16x2_t); return __builtin_bit_cast(unsigned, b); }
__device__ __forceinline__ float bf2f(unsigned short b) { return __uint_as_float(((unsigned)b) << 16); }
__device__ __forceinline__ float bflo(unsigned w) { return __uint_as_float(w << 16); }
__device__ __forceinline__ float bfhi(unsigned w) { return __uint_as_float(w & 0xffff0000u); }
__device__ __forceinline__ float fsigmoid(float x) { return __builtin_amdgcn_rcpf(1.f + __expf(-x)); }
__device__ __forceinline__ float wave_sum(float v) {
#pragma unroll
    for (int o = 1; o < 64; o <<= 1) v += __shfl_xor(v, o);
    return v;
}
typedef long i64_t;
__device__ __forceinline__ u32x2 pack8_fp8(const f32x4 a, const f32x4 b) {
    unsigned lo = 0u, hi = 0u;
    lo = __builtin_amdgcn_cvt_pk_fp8_f32(a[0], a[1], lo, false); lo = __builtin_amdgcn_cvt_pk_fp8_f32(a[2], a[3], lo, true);
    hi = __builtin_amdgcn_cvt_pk_fp8_f32(b[0], b[1], hi, false); hi = __builtin_amdgcn_cvt_pk_fp8_f32(b[2], b[3], hi, true);
    return (u32x2){lo, hi};
}
__device__ __forceinline__ u32x4 pack8(const f32x4 a, const f32x4 b) { u32x4 w; w.x = cvt_pk_bf16(a[0], a[1]); w.y = cvt_pk_bf16(a[2], a[3]); w.z = cvt_pk_bf16(b[0], b[1]); w.w = cvt_pk_bf16(b[2], b[3]); return w; }

namespace pg8 {
constexpr int BM = 256, BK = 64, HALF = 128, HTB = HALF * BK * 2, STAGE_BYTES = 8 * HTB, NXCD = 8, WGM = 8;
__host__ __device__ __forceinline__ int lds_byte(int r, int c) { const int st = (r >> 4) * 2 + (c >> 5), rr = r & 15, cc = c & 31, ob = rr * 64 + cc * 2; return st * 1024 + (ob ^ (((ob >> 9) & 1) << 5)); }
__host__ __device__ __forceinline__ void stage_rc(int b, int& R, int& C) { const int st = b / 1024, sb = b % 1024, swz = sb ^ (((sb >> 9) & 1) << 5); R = (st >> 1) * 16 + swz / 64; C = (st & 1) * 32 + (swz % 64) / 2; }
__host__ __device__ __forceinline__ int perm32(int rho) { const int n = rho >> 4, i = rho & 15; return 8 * (i >> 2) + 4 * n + (i & 3); }
struct Unit { int pm, pn; };
struct Gemm { const bf16_t* A; const bf16_t* Bt; int M, N, K, lda, ldb; };
struct StaticOrder {
    int nM, nN, nwg, G, c;
    __device__ void init(int M, int N, int G_, int c_) { nM = M / BM; nN = N / BM; nwg = nM * nN; G = G_; c = c_; }
    __device__ bool next(int i, Unit& u) const {
        const long L = (long)i * G + c; if (L >= nwg) return false;
        int wgid = (int)L; { const int q = nwg / NXCD, r = nwg % NXCD, xcd = wgid % NXCD, off = wgid / NXCD; wgid = (xcd < r ? xcd * (q + 1) : r * (q + 1) + (xcd - r) * q) + off; }
        const int nig = WGM * nN, gid = wgid / nig, fm = gid * WGM, gsz = (nM - fm) < WGM ? (nM - fm) : WGM;
        u.pm = fm + ((wgid % nig) % gsz); u.pn = (wgid % nig) / gsz; return true;
    }
};
typedef f32x4 Acc[2][2][4][2];

template <class Epi>
__device__ __forceinline__ void gemm_phase(LAS unsigned char* lds, const Gemm g, const StaticOrder& S_, const Epi& E, const int tid) {
    const int wid = __builtin_amdgcn_readfirstlane(tid >> 6), lane = tid & 63, wr = wid >> 2, wc = wid & 3, fr = lane & 15, fq = lane >> 4;
    const int K = g.K, nt = K / BK;
    unsigned voffA[2], voffB[2];
#pragma unroll
    for (int i = 0; i < 2; ++i) { int R, C; stage_rc(tid * 16 + i * 8192, R, C); const int Rb = Epi::PERM ? ((R & ~31) + perm32(R & 31)) : R;
        voffA[i] = (unsigned)(R * g.lda + C) * 2u; voffB[i] = (unsigned)(Rb * g.ldb + C) * 2u; }
    const size_t kstep = (size_t)(BK * 2);
    const size_t hstepA = (size_t)HALF * g.lda * 2, hstepB = (size_t)HALF * g.ldb * 2;
    const size_t tstepA = 2 * hstepA, tstepB = 2 * hstepB;
    const unsigned ldsw = (unsigned)wid * 1024u;
    const int aoff = lds_byte(wr * 64 + fr, fq * 8), boff = lds_byte(wc * 32 + fr, fq * 8);
#define PG8_SA(b, h) (((b) * 2 + (h)) * HTB)
#define PG8_SB(b, h) ((4 + (b) * 2 + (h)) * HTB)
#define PG8_STAGE(bufoff, gbase, voff) do { _Pragma("unroll") for (int _i = 0; _i < 2; ++_i) \
        __builtin_amdgcn_global_load_lds((const unsigned*)((const char*)(gbase) + (voff)[_i]), (LAS unsigned*)(lds + (bufoff) + ldsw + _i * 8192), 16, 0, 0); } while (0)
#define PG8_LDA(dst, b, h) do { _Pragma("unroll") for (int m = 0; m < 4; ++m) _Pragma("unroll") for (int k = 0; k < 2; ++k) dst[m][k] = *(const LAS bf16x8*)(lds + PG8_SA(b, h) + aoff + m * 2048 + k * 1024); } while (0)
#define PG8_LDB(dst, b, h) do { _Pragma("unroll") for (int n = 0; n < 2; ++n) _Pragma("unroll") for (int k = 0; k < 2; ++k) dst[n][k] = *(const LAS bf16x8*)(lds + PG8_SB(b, h) + boff + n * 2048 + k * 1024); } while (0)
#define PG8_MMA(ai, bj, At, Bt) do { __builtin_amdgcn_s_setprio(1); _Pragma("unroll") for (int m = 0; m < 4; ++m) _Pragma("unroll") for (int n = 0; n < 2; ++n) _Pragma("unroll") for (int k = 0; k < 2; ++k) \
        acc[ai][bj][m][n] = __builtin_amdgcn_mfma_f32_16x16x32_bf16(Bt[n][k], At[m][k], acc[ai][bj][m][n], 0, 0, 0); __builtin_amdgcn_s_setprio(0); } while (0)
#define PG8_WAIT_V(n) asm volatile("s_waitcnt vmcnt(" #n ")" ::: "memory")
#define PG8_WAIT_L(n) asm volatile("s_waitcnt lgkmcnt(" #n ")" ::: "memory")
#define PG8_BAR __builtin_amdgcn_s_barrier()
#define PG8_SCHED __builtin_amdgcn_sched_barrier(0)
    Unit cur, nxt; int ui = 0;
    if (!S_.next(0, cur)) return;
    Acc acc;
#pragma unroll
    for (int a = 0; a < 2; ++a)
#pragma unroll
        for (int b = 0; b < 2; ++b)
#pragma unroll
            for (int m = 0; m < 4; ++m)
#pragma unroll
                for (int n = 0; n < 2; ++n) acc[a][b][m][n] = (f32x4){0.f, 0.f, 0.f, 0.f};
    bf16x8 At[4][2], B0[2][2], B1[2][2];
    const char* cA = (const char*)g.A + (size_t)cur.pm * tstepA; const char* cB = (const char*)g.Bt + (size_t)cur.pn * tstepB;
    PG8_STAGE(PG8_SB(0, 0), cB, voffB); PG8_STAGE(PG8_SB(0, 1), cB + hstepB, voffB); PG8_STAGE(PG8_SA(0, 0), cA, voffA); PG8_STAGE(PG8_SA(0, 1), cA + hstepA, voffA);
    if (wr == 1) PG8_BAR;
    PG8_WAIT_V(2); PG8_BAR;
    PG8_STAGE(PG8_SB(1, 0), cB + kstep, voffB); PG8_STAGE(PG8_SA(1, 0), cA + kstep, voffA); PG8_STAGE(PG8_SB(1, 1), cB + hstepB + kstep, voffB);
    PG8_WAIT_V(6); PG8_BAR;
    for (;;) {
        const bool has_next = S_.next(ui + 1, nxt);
        const char* nA = has_next ? (const char*)g.A + (size_t)nxt.pm * tstepA : cA; const char* nB = has_next ? (const char*)g.Bt + (size_t)nxt.pn * tstepB : cB;
        for (int t = 0; t < nt; t += 2) {
            const bool last = (t == nt - 2);
            const char* a1 = cA + (size_t)(t + 1) * kstep;
            const char* a2 = last ? nA : cA + (size_t)(t + 2) * kstep; const char* b2 = last ? nB : cB + (size_t)(t + 2) * kstep;
            const char* a3 = a2 + kstep; const char* b3 = b2 + kstep;
            PG8_LDB(B0, 0, 0); PG8_LDB(B1, 0, 1); PG8_SCHED; PG8_LDA(At, 0, 0); PG8_STAGE(PG8_SA(1, 1), a1 + hstepA, voffA);
            PG8_WAIT_V(8); PG8_WAIT_L(0); PG8_BAR; PG8_MMA(0, 0, At, B0); PG8_MMA(0, 1, At, B1); PG8_BAR; PG8_SCHED;
            PG8_LDA(At, 0, 1); PG8_STAGE(PG8_SB(0, 0), b2, voffB); PG8_STAGE(PG8_SB(0, 1), b2 + hstepB, voffB); PG8_STAGE(PG8_SA(0, 0), a2, voffA);
            PG8_WAIT_V(8); PG8_WAIT_L(0); PG8_BAR; PG8_MMA(1, 0, At, B0); PG8_MMA(1, 1, At, B1); PG8_BAR; PG8_SCHED;
            PG8_LDB(B0, 1, 0); PG8_LDB(B1, 1, 1); PG8_SCHED; PG8_LDA(At, 1, 0); PG8_STAGE(PG8_SA(0, 1), a2 + hstepA, voffA);
            PG8_WAIT_V(8); PG8_WAIT_L(0); PG8_BAR; PG8_MMA(0, 0, At, B0); PG8_MMA(0, 1, At, B1); PG8_BAR; PG8_SCHED;
            PG8_LDA(At, 1, 1); PG8_STAGE(PG8_SB(1, 0), b3, voffB); PG8_STAGE(PG8_SB(1, 1), b3 + hstepB, voffB); PG8_STAGE(PG8_SA(1, 0), a3, voffA);
            PG8_WAIT_V(8); PG8_WAIT_L(0); PG8_BAR; PG8_MMA(1, 0, At, B0); PG8_MMA(1, 1, At, B1); PG8_BAR; PG8_SCHED;
        }
        if (wr == 0) PG8_BAR;
        E(acc, cur, wr, wc, fr, fq);
        if (!has_next) break;
#pragma unroll
        for (int a = 0; a < 2; ++a)
#pragma unroll
            for (int b = 0; b < 2; ++b)
#pragma unroll
                for (int m = 0; m < 4; ++m)
#pragma unroll
                    for (int n = 0; n < 2; ++n) acc[a][b][m][n] = (f32x4){0.f, 0.f, 0.f, 0.f};
        cur = nxt; cA = nA; cB = nB; ++ui;
        if (wr == 1) PG8_BAR;
    }
    PG8_WAIT_V(0);
    PG8_BAR;
#undef PG8_SA
#undef PG8_SB
#undef PG8_STAGE
#undef PG8_LDA
#undef PG8_LDB
#undef PG8_MMA
#undef PG8_WAIT_V
#undef PG8_WAIT_L
#undef PG8_BAR
#undef PG8_SCHED
}
}

struct EpiSwiglu {
    static constexpr bool PERM = true;
    bf16_t* O;
    __device__ __forceinline__ void operator()(const pg8::Acc& acc, const pg8::Unit& u, int wr, int wc, int fr, int fq) const {
        const int row0 = u.pm * 256 + wr * 64 + fr, col0 = u.pn * 128 + wc * 32 + 8 * fq;
#pragma unroll
        for (int ai = 0; ai < 2; ++ai)
#pragma unroll
            for (int m = 0; m < 4; ++m) {
                f32x4 v[2];
#pragma unroll
                for (int n = 0; n < 2; ++n)
#pragma unroll
                    for (int e = 0; e < 4; ++e) { const float gt = acc[ai][0][m][n][e], up = acc[ai][1][m][n][e]; v[n][e] = gt * fsigmoid(gt) * up; }
                *(u32x4*)(O + (size_t)(row0 + ai * 128 + m * 16) * FF + col0) = pack8(v[0], v[1]);
            }
    }
};
struct EpiResF32 {
    static constexpr bool PERM = false;
    const float* res; float* out; float a, b;
    __device__ __forceinline__ void operator()(const pg8::Acc& acc, const pg8::Unit& u, int wr, int wc, int fr, int fq) const {
        const int row0 = u.pm * 256 + wr * 64 + fr, col0 = u.pn * 256 + wc * 32 + 4 * fq;
#pragma unroll
        for (int ai = 0; ai < 2; ++ai)
#pragma unroll
            for (int m = 0; m < 4; ++m) {
                const size_t off = (size_t)(row0 + ai * 128 + m * 16) * DM + col0;
#pragma unroll
                for (int bj = 0; bj < 2; ++bj)
#pragma unroll
                    for (int n = 0; n < 2; ++n) { const f32x4 r = *(const f32x4*)(res + off + bj * 128 + n * 16); *(f32x4*)(out + off + bj * 128 + n * 16) = r * a + acc[ai][bj][m][n] * b; }
            }
    }
};
struct EpiResLnF32 {
    static constexpr bool PERM = false;
    const float* pre; const float* stats; const float* g; const float* beta; float* out; float a, b;
    __device__ __forceinline__ void operator()(const pg8::Acc& acc, const pg8::Unit& u, int wr, int wc, int fr, int fq) const {
        const int row0 = u.pm * 256 + wr * 64 + fr, col0 = u.pn * 256 + wc * 32 + 4 * fq;
#pragma unroll
        for (int ai = 0; ai < 2; ++ai)
#pragma unroll
            for (int m = 0; m < 4; ++m) {
                const int row = row0 + ai * 128 + m * 16; const size_t off = (size_t)row * DM + col0;
                const f32x2 st = *(const f32x2*)(stats + 2 * (size_t)row);
#pragma unroll
                for (int bj = 0; bj < 2; ++bj)
#pragma unroll
                    for (int n = 0; n < 2; ++n) { const int co = bj * 128 + n * 16;
                        const f32x4 r = *(const f32x4*)(pre + off + co), gv = *(const f32x4*)(g + col0 + co), bv = *(const f32x4*)(beta + col0 + co);
                        const f32x4 h = (r - st.x) * st.y * gv + bv;
                        *(f32x4*)(out + off + co) = h * a + acc[ai][bj][m][n] * b; }
                if (m & 1) asm volatile("" ::: "memory");
            }
    }
};
struct EpiWin {
    static constexpr bool PERM = true;
    bf16_t* proj; bf16_t* sigg; bf16_t* gn; const float* cs; bf16_t* kslf; bf16_t* kbf;
    __device__ __forceinline__ void operator()(const pg8::Acc& acc, const pg8::Unit& u, int wr, int wc, int fr, int fq) const {
        const int tile = u.pn, row0 = u.pm * 256 + wr * 64 + fr, cw = wc * 32 + 8 * fq;
        if (tile < 28) {
            const bool rope = (tile == 6) | (tile == 8) | (tile >= 10 && tile < 22);
            const int dcol = (tile < 6 ? tile : tile - 4) * 256;
            if (!rope) {
                if (tile == 7 || tile == 9) {
                    unsigned char* VF = (unsigned char*)kslf + (tile == 7 ? (size_t)8 << 20 : (size_t)24 << 20);
#pragma unroll
                    for (int ai = 0; ai < 2; ++ai)
#pragma unroll
                        for (int m = 0; m < 4; ++m) {
                            const int row = row0 + ai * 128 + m * 16, kp = row & 31;
                            const size_t rbase = (size_t)(row >> 5) * 4096 + (size_t)(((kp >> 2) & 3) * 16) * 8 + 4 * (kp >> 4) + (kp & 3);
#pragma unroll
                            for (int bj = 0; bj < 2; ++bj) {
                                const u32x2 w = pack8_fp8(acc[ai][bj][m][0], acc[ai][bj][m][1]);
                                unsigned char* vb = VF + (size_t)bj * 512 * 4096 + rbase + (size_t)(cw >> 4) * 512 + (size_t)(cw & 15) * 8;
                                vb[0] = (unsigned char)(w.x & 0xffu); vb[8] = (unsigned char)((w.x >> 8) & 0xffu); vb[16] = (unsigned char)((w.x >> 16) & 0xffu); vb[24] = (unsigned char)(w.x >> 24);
                                vb[32] = (unsigned char)(w.y & 0xffu); vb[40] = (unsigned char)((w.y >> 8) & 0xffu); vb[48] = (unsigned char)((w.y >> 16) & 0xffu); vb[56] = (unsigned char)(w.y >> 24);
                            }
                        }
                } else if (tile >= 22) {
                    bf16_t* VB = kbf + ((size_t)24 << 20);
#pragma unroll
                    for (int ai = 0; ai < 2; ++ai)
#pragma unroll
                        for (int m = 0; m < 4; ++m) {
                            const int row = row0 + ai * 128 + m * 16;
#pragma unroll
                            for (int bj = 0; bj < 2; ++bj) {
                                const int hd = 2 * (tile - 22) + bj, sh = 2 * (hd >> 2), tp = ((row & ((1 << sh) - 1)) << (14 - sh)) + (row >> sh), kp = tp & 31;
                                const u32x4 w = pack8(acc[ai][bj][m][0], acc[ai][bj][m][1]);
                                bf16_t* vb = VB + (((size_t)hd * 512 + (tp >> 5)) * 8 + (cw >> 4)) * 512 + (size_t)(((kp >> 2) & 3) * 16 + (cw & 15)) * 8 + 4 * (kp >> 4) + (kp & 3);
                                vb[0] = (bf16_t)(w.x & 0xffffu); vb[8] = (bf16_t)(w.x >> 16); vb[16] = (bf16_t)(w.y & 0xffffu); vb[24] = (bf16_t)(w.y >> 16);
                                vb[32] = (bf16_t)(w.z & 0xffffu); vb[40] = (bf16_t)(w.z >> 16); vb[48] = (bf16_t)(w.w & 0xffffu); vb[56] = (bf16_t)(w.w >> 16);
                            }
                        }
                } else {
#pragma unroll
                    for (int ai = 0; ai < 2; ++ai)
#pragma unroll
                        for (int m = 0; m < 4; ++m)
#pragma unroll
                            for (int bj = 0; bj < 2; ++bj)
                                *(u32x4*)(proj + (size_t)(row0 + ai * 128 + m * 16) * PLD + dcol + bj * 128 + cw) = pack8(acc[ai][bj][m][0], acc[ai][bj][m][1]);
                }
            } else {
                const int head = cw >> 6, d = cw & 63;
                const bool frag = (tile == 6) | (tile == 8);
                unsigned char* KF = (unsigned char*)kslf + (tile == 6 ? (size_t)0 : (size_t)16 << 20); const float* sn = cs + (size_t)S * 64;
#pragma unroll
                for (int ai = 0; ai < 2; ++ai)
#pragma unroll
                    for (int m = 0; m < 4; ++m) {
                        const int row = row0 + ai * 128 + m * 16;
                        f32x4 o1[2], o2[2];
#pragma unroll
                        for (int n = 0; n < 2; ++n) {
                            const f32x4 c = *(const f32x4*)(cs + (size_t)row * 64 + d + 4 * n), sv = *(const f32x4*)(sn + (size_t)row * 64 + d + 4 * n);
                            const f32x4 x1 = acc[ai][0][m][n], x2 = acc[ai][1][m][n];
                            o1[n] = x1 * c - x2 * sv; o2[n] = x2 * c + x1 * sv;
                        }
                        if (frag) {
                            unsigned char* kb = KF + ((size_t)head * 1024 + (row >> 4)) * 2048 + (size_t)(d >> 5) * 512 + (size_t)(((d >> 3) & 3) * 16 + (row & 15)) * 8;
                            *(u32x2*)kb = pack8_fp8(o1[0], o1[1]); *(u32x2*)(kb + 1024) = pack8_fp8(o2[0], o2[1]);
                        } else if (tile >= 16) {
                            const int hd = 2 * (tile - 16) + head, sh = 2 * (hd >> 2), tp = ((row & ((1 << sh) - 1)) << (14 - sh)) + (row >> sh);
                            bf16_t* kb = kbf + ((size_t)hd * 1024 + (tp >> 4)) * 2048 + (size_t)(d >> 5) * 512 + (size_t)(((d >> 3) & 3) * 16 + (tp & 15)) * 8;
                            *(u32x4*)kb = pack8(o1[0], o1[1]); *(u32x4*)(kb + 1024) = pack8(o2[0], o2[1]);
                        } else {
                            bf16_t* p = proj + (size_t)row * PLD + dcol + head * 128 + d;
                            *(u32x4*)p = pack8(o1[0], o1[1]); *(u32x4*)(p + 64) = pack8(o2[0], o2[1]);
                        }
                        if (m & 1) asm volatile("" ::: "memory");
                    }
            }
        } else if (tile < 44) {
#pragma unroll
            for (int ai = 0; ai < 2; ++ai)
#pragma unroll
                for (int m = 0; m < 4; ++m)
#pragma unroll
                    for (int bj = 0; bj < 2; ++bj) {
                        f32x4 v[2];
#pragma unroll
                        for (int n = 0; n < 2; ++n)
#pragma unroll
                            for (int e = 0; e < 4; ++e) v[n][e] = fsigmoid(acc[ai][bj][m][n][e]);
                        *(u32x4*)(sigg + (size_t)(row0 + ai * 128 + m * 16) * 4096 + (tile - 28) * 256 + bj * 128 + cw) = pack8(v[0], v[1]);
                    }
        } else {
            if (wc == 0) {
#pragma unroll
                for (int ai = 0; ai < 2; ++ai)
#pragma unroll
                    for (int m = 0; m < 4; ++m) {
                        f32x4 v[2];
#pragma unroll
                        for (int n = 0; n < 2; ++n)
#pragma unroll
                            for (int e = 0; e < 4; ++e) v[n][e] = fsigmoid(acc[ai][0][m][n][e]);
                        *(u32x4*)(gn + (size_t)(row0 + ai * 128 + m * 16) * 32 + cw) = pack8(v[0], v[1]);
                    }
            }
        }
    }
};
template <bool FIRST> struct EpiGate {
    static constexpr bool PERM = true;
    const bf16_t* sg; bf16_t* O;
    __device__ __forceinline__ void operator()(const pg8::Acc& acc, const pg8::Unit& u, int wr, int wc, int fr, int fq) const {
        const int row0 = u.pm * 256 + wr * 64 + fr, col0 = u.pn * 256 + wc * 32 + 8 * fq;
#pragma unroll
        for (int ai = 0; ai < 2; ++ai)
#pragma unroll
            for (int m = 0; m < 4; ++m)
#pragma unroll
                for (int bj = 0; bj < 2; ++bj) {
                    const int row = row0 + ai * 128 + m * 16, col = col0 + bj * 128;
                    const u32x4 gv = *(const u32x4*)(sg + (size_t)row * 4096 + col);
                    u32x4 pv = (u32x4){0u, 0u, 0u, 0u}; if (!FIRST) pv = *(const u32x4*)(O + (size_t)row * DM + col);
                    f32x4 v[2];
#pragma unroll
                    for (int n = 0; n < 2; ++n) {
                        const unsigned g0 = n ? gv.z : gv.x, g1 = n ? gv.w : gv.y, p0 = n ? pv.z : pv.x, p1 = n ? pv.w : pv.y;
                        const f32x4 y = acc[ai][bj][m][n];
                        v[n][0] = bflo(p0) + bflo(g0) * y[0]; v[n][1] = bfhi(p0) + bfhi(g0) * y[1];
                        v[n][2] = bflo(p1) + bflo(g1) * y[2]; v[n][3] = bfhi(p1) + bfhi(g1) * y[3];
                    }
                    *(u32x4*)(O + (size_t)row * DM + col) = pack8(v[0], v[1]);
                }
    }
};

template <bool FRAG = false>
__device__ __forceinline__ void tr_item(const float* W, int ldw, int k0, int scol0, int nvalid, bf16_t* WT, int ldt, int drow0, int dk0, LAS float* scr, int lane) {
    const int c = lane & 31;
    float v[32];
#pragma unroll
    for (int i = 0; i < 32; ++i) { const int kk = 2 * i + (lane >> 5); v[i] = (c < nvalid) ? W[(size_t)(k0 + kk) * ldw + scol0 + c] : 0.f; }
#pragma unroll
    for (int i = 0; i < 32; ++i) { const int kk = 2 * i + (lane >> 5); scr[kk * 33 + c] = v[i]; }
    asm volatile("s_waitcnt lgkmcnt(0)" ::: "memory");
    const int c8 = lane & 7;
#pragma unroll
    for (int j = 0; j < 4; ++j) { const int n = (lane >> 3) + 8 * j; const LAS float* s = scr + (8 * c8) * 33 + n;
        u32x4 o; o.x = cvt_pk_bf16(s[0 * 33], s[1 * 33]); o.y = cvt_pk_bf16(s[2 * 33], s[3 * 33]); o.z = cvt_pk_bf16(s[4 * 33], s[5 * 33]); o.w = cvt_pk_bf16(s[6 * 33], s[7 * 33]);
        if (FRAG) { const int c = drow0 + n, k = dk0 + 8 * c8; *(u32x4*)(WT + ((size_t)((c >> 4) * (ldt >> 5) + (k >> 5)) * 64 + ((k >> 3) & 3) * 16 + (c & 15)) * 8) = o; }
        else *(u32x4*)(WT + (size_t)(drow0 + n) * ldt + dk0 + 8 * c8) = o; }
    asm volatile("s_waitcnt lgkmcnt(0)" ::: "memory");
}
struct TrP { const float* W; int ldw, k0, scol0, nvalid; bf16_t* WT; int ldt, drow0, dk0; };
__device__ __forceinline__ void tr_load(float (&v)[32], const TrP& q, int lane) {
    const int c = lane & 31;
#pragma unroll
    for (int i = 0; i < 32; ++i) { const int kk = 2 * i + (lane >> 5); v[i] = (c < q.nvalid) ? q.W[(size_t)(q.k0 + kk) * q.ldw + q.scol0 + c] : 0.f; }
}
__device__ __forceinline__ void tr_store(const float (&v)[32], const TrP& q, LAS float* scr, int lane) {
    const int c = lane & 31;
#pragma unroll
    for (int i = 0; i < 32; ++i) { const int kk = 2 * i + (lane >> 5); scr[kk * 33 + c] = v[i]; }
    asm volatile("s_waitcnt lgkmcnt(0)" ::: "memory");
    const int c8 = lane & 7;
#pragma unroll
    for (int j = 0; j < 4; ++j) { const int n = (lane >> 3) + 8 * j; const LAS float* s = scr + (8 * c8) * 33 + n;
        u32x4 o; o.x = cvt_pk_bf16(s[0 * 33], s[1 * 33]); o.y = cvt_pk_bf16(s[2 * 33], s[3 * 33]); o.z = cvt_pk_bf16(s[4 * 33], s[5 * 33]); o.w = cvt_pk_bf16(s[6 * 33], s[7 * 33]);
        *(u32x4*)(q.WT + (size_t)(q.drow0 + n) * q.ldt + q.dk0 + 8 * c8) = o; }
    asm volatile("s_waitcnt lgkmcnt(0)" ::: "memory");
}
template <class F>
__device__ __forceinline__ void tr_stream(int n, int gw, int ngw, const F& params, LAS float* scr, int lane) {
    int it = gw; if (it >= n) return;
    float va[32], vb[32];
    TrP pa = params(it), pb = pa; tr_load(va, pa, lane);
    for (;;) {
        const int it2 = it + ngw; const bool has2 = it2 < n;
        if (has2) { pb = params(it2); tr_load(vb, pb, lane); }
        tr_store(va, pa, scr, lane);
        if (!has2) break;
        const int it3 = it2 + ngw; const bool has3 = it3 < n;
        if (has3) { pa = params(it3); tr_load(va, pa, lane); }
        tr_store(vb, pb, scr, lane);
        if (!has3) break;
        it = it3;
    }
}
__device__ __forceinline__ int win_src_col(int r) {
    if (r >= WIN_SRC) return -1;
    if (r >= 11264) return 2560 + (r - 11264);
    const int tile = r >> 8; int j = r & 255;
    const bool rope = (tile == 6) | (tile == 8) | (tile >= 10 && tile < 22);
    if (rope) { const int q = j >> 6, d = j & 63; j = (q & 1) * 128 + (q >> 1) * 64 + d; }
    const int c = tile * 256 + j;
    return c < 2560 ? c : c + 24;
}
__device__ __forceinline__ void conv_ffn(const float* Wg, const float* Wu, const float* Wd, bf16_t* GU, bf16_t* DN, LAS float* scr, int gw, int ngw, int lane) {
    constexpr int I_G = 32 * 176;
    tr_stream(2 * I_G, gw, ngw, [&](int it) { const int which = it / I_G, r = it % I_G, kb = r / 176, nb = r % 176, c0 = nb * 32;
        return TrP{which ? Wu : Wg, FF, kb * 64, c0, 32, GU, DM, 256 * (c0 >> 7) + (c0 & 127) + which * 128, kb * 64}; }, scr, lane);
    tr_stream(88 * 64, gw, ngw, [&](int it) { const int kb = it / 64, nb = it % 64; return TrP{Wd, DM, kb * 64, nb * 32, 32, DN, FF, nb * 32, kb * 64}; }, scr, lane);
}
__device__ __forceinline__ void ln_rows(const float* in, float* outf, bf16_t* outb, const float* g, const float* b, int gw, int ngw, int lane, float* stats = nullptr) {
    f32x4 gv[8], bv[8];
#pragma unroll
    for (int j = 0; j < 8; ++j) { gv[j] = *(const f32x4*)(g + 4 * (lane + 64 * j)); bv[j] = *(const f32x4*)(b + 4 * (lane + 64 * j)); }
    for (int row = gw; row < S; row += ngw) {
        const float* xr = in + (size_t)row * DM; f32x4 v[8]; float s = 0.f;
#pragma unroll
        for (int j = 0; j < 8; ++j) { v[j] = *(const f32x4*)(xr + 4 * (lane + 64 * j)); s += (v[j][0] + v[j][1]) + (v[j][2] + v[j][3]); }
        const float mean = wave_sum(s) * (1.f / DM); float s2 = 0.f;
#pragma unroll
        for (int j = 0; j < 8; ++j) { v[j] = v[j] - mean; s2 += (v[j][0] * v[j][0] + v[j][1] * v[j][1]) + (v[j][2] * v[j][2] + v[j][3] * v[j][3]); }
        const float rstd = 1.f / sqrtf(wave_sum(s2) * (1.f / DM) + LN_EPS);
        if (stats && lane == 0) *(f32x2*)(stats + 2 * (size_t)row) = (f32x2){mean, rstd};
#pragma unroll
        for (int j = 0; j < 8; ++j) { const f32x4 o = v[j] * rstd * gv[j] + bv[j];
            if (outf) *(f32x4*)(outf + (size_t)row * DM + 4 * (lane + 64 * j)) = o;
            if (outb) { u32x2 w; w.x = cvt_pk_bf16(o[0], o[1]); w.y = cvt_pk_bf16(o[2], o[3]); *(u32x2*)(outb + (size_t)row * DM + 4 * (lane + 64 * j)) = w; } }
    }
}

struct AState { float m, l; f32x4 o[8]; };
__device__ __forceinline__ void astate_init(AState& s) { s.m = -1e30f; s.l = 0.f;
#pragma unroll
    for (int i = 0; i < 8; ++i) s.o[i] = (f32x4){0.f, 0.f, 0.f, 0.f}; }
__device__ __forceinline__ int clampi(int v, int lo, int hi) { return v < lo ? lo : (v > hi ? hi : v); }

__device__ __forceinline__ void load_k(bf16x8 (&kf)[2][4], const bf16_t* __restrict__ Kb, int ld, int pos0, int dpos, int posmax, int l16, int kq) {
#pragma unroll
    for (int T = 0; T < 2; ++T) { const int p = clampi(pos0 + dpos * (16 * T + l16), 0, posmax); const bf16_t* kp = Kb + (size_t)p * ld + 8 * kq;
#pragma unroll
        for (int s = 0; s < 4; ++s) kf[T][s] = *(const bf16x8*)(kp + 32 * s); }
}
__device__ __forceinline__ void load_v(u32x4 (&vr)[8], const bf16_t* __restrict__ Vb, int ld, int pos0, int dpos, int posmax, int l16, int kq) {
#pragma unroll
    for (int i = 0; i < 8; ++i) { const int p = clampi(pos0 + dpos * (4 * i + kq), 0, posmax); vr[i] = *(const u32x4*)(Vb + (size_t)p * ld + 8 * l16); }
}
__device__ __forceinline__ void store_v(const u32x4 (&vr)[8], LAS unsigned char* vbuf, int l16, int kq) {
#pragma unroll
    for (int i = 0; i < 8; ++i) *(LAS u32x4*)(vbuf + (4 * i + kq) * VROW + 16 * l16) = vr[i];
}
template <int MODE, bool SLC, class Desc>
__device__ __forceinline__ void attn_run(const bf16x8 (&qf)[4], const bf16_t* __restrict__ Kb, const bf16_t* __restrict__ Vb, int ld, int dpos, int posmax,
                                         const Desc& desc, int n, int lo_in, int hi, int qi, AState& st, LAS unsigned char* vbuf, int lane, LAS float* imp = nullptr) {
    if (n <= 0) return;
    const int l16 = lane & 15, kq = lane >> 4;
    u32x4 kr[8];
    int dcur = desc(0);
    load_v(kr, Kb, ld, SLC ? (dcur & 0xfffff) : dcur, dpos, posmax, l16, kq);
#pragma unroll 1
    for (int i = 0; i < n; ++i) {
        const int pos0 = SLC ? (dcur & 0xfffff) : dcur;
        const int lo = SLC ? ((((dcur >> 20) == qi) | ((dcur >> 20) == 4)) ? 0 : (1 << 30)) : lo_in;
        store_v(kr, vbuf, l16, kq);
        u32x4 vr[8];
        if (MODE != 1) load_v(vr, Vb, ld, pos0, dpos, posmax, l16, kq);
        bf16x8 kf[2][4];
#pragma unroll
        for (int T = 0; T < 2; ++T)
#pragma unroll
            for (int s = 0; s < 4; ++s) kf[T][s] = *(const LAS bf16x8*)(vbuf + (16 * T + l16) * VROW + 64 * s + 16 * kq);
        f32x4 sa[2] = {(f32x4){0.f, 0.f, 0.f, 0.f}, (f32x4){0.f, 0.f, 0.f, 0.f}};
#pragma unroll
        for (int T = 0; T < 2; ++T)
#pragma unroll
            for (int s = 0; s < 4; ++s) sa[T] = __builtin_amdgcn_mfma_f32_16x16x32_bf16(kf[T][s], qf[s], sa[T], 0, 0, 0);
        const int dnext = desc(i + 1 < n ? i + 1 : i);
        load_v(kr, Kb, ld, SLC ? (dnext & 0xfffff) : dnext, dpos, posmax, l16, kq);
        float sc[8]; bool vd[8]; float mx = -1e30f;
#pragma unroll
        for (int T = 0; T < 2; ++T)
#pragma unroll
            for (int r = 0; r < 4; ++r) { const int p = pos0 + dpos * (16 * T + 4 * kq + r); const bool v = (p >= lo) & (p <= hi); const float x = sa[T][r] * SL2;
                sc[4 * T + r] = x; vd[4 * T + r] = v; mx = v ? fmaxf(mx, x) : mx; }
        float p[8];
        if (MODE == 2) {
#pragma unroll
            for (int j = 0; j < 8; ++j) p[j] = vd[j] ? __builtin_amdgcn_exp2f(sc[j] - st.m) * st.l : 0.f;
#pragma unroll
            for (int T = 0; T < 2; ++T) {
                float x = 2.f * (p[4 * T] + p[4 * T + 1] + p[4 * T + 2]) + p[4 * T + 3], y = p[4 * T + 3];
                x += __shfl_xor(x, 1); x += __shfl_xor(x, 2); y += __shfl_xor(y, 1); y += __shfl_xor(y, 2);
                if ((l16 & 3) == 0) { const int a = (pos0 >> 2) + 4 * T + kq; LAS float* ip = imp + (l16 >> 2) * IMP_LD + a;
                    ip[0] += x;
                    asm volatile("s_waitcnt lgkmcnt(0)" ::: "memory");
                    ip[1] += y; }
                asm volatile("s_waitcnt lgkmcnt(0)" ::: "memory");
            }
        } else {
            if (__builtin_amdgcn_ballot_w64(mx > st.m + 40.f) != 0ull) {
                mx = fmaxf(mx, __shfl_xor(mx, 16)); mx = fmaxf(mx, __shfl_xor(mx, 32));
                const float mn = fmaxf(st.m, mx), alpha = __builtin_amdgcn_exp2f(st.m - mn); st.m = mn; st.l *= alpha;
                if (MODE == 0) {
#pragma unroll
                    for (int j = 0; j < 8; ++j) st.o[j] = st.o[j] * alpha;
                }
            }
            float ps = 0.f;
#pragma unroll
            for (int j = 0; j < 8; ++j) { p[j] = vd[j] ? __builtin_amdgcn_exp2f(sc[j] - st.m) : 0.f; ps += p[j]; }
            st.l += ps;
        }
        if (MODE != 1) {
            store_v(vr, vbuf, l16, kq);
            u32x4 pw; pw.x = cvt_pk_bf16(p[0], p[1]); pw.y = cvt_pk_bf16(p[2], p[3]); pw.z = cvt_pk_bf16(p[4], p[5]); pw.w = cvt_pk_bf16(p[6], p[7]);
            const bf16x8 pf = __builtin_bit_cast(bf16x8, pw);
            const unsigned addr = (unsigned)(uintptr_t)(vbuf) + (4 * kq + (l16 >> 2)) * VROW + (l16 & 3) * 8;
#pragma unroll
            for (int hf = 0; hf < 2; ++hf) {
                s16x4 a[8];
                asm volatile("s_waitcnt lgkmcnt(0)\n\t"
                             "ds_read_b64_tr_b16 %0, %8 offset:0\n\t"    "ds_read_b64_tr_b16 %1, %8 offset:32\n\t"
                             "ds_read_b64_tr_b16 %2, %8 offset:64\n\t"   "ds_read_b64_tr_b16 %3, %8 offset:96\n\t"
                             "ds_read_b64_tr_b16 %4, %8 offset:4608\n\t" "ds_read_b64_tr_b16 %5, %8 offset:4640\n\t"
                             "ds_read_b64_tr_b16 %6, %8 offset:4672\n\t" "ds_read_b64_tr_b16 %7, %8 offset:4704\n\t"
                             "s_waitcnt lgkmcnt(0)"
                             : "=&v"(a[0]), "=&v"(a[1]), "=&v"(a[2]), "=&v"(a[3]), "=&v"(a[4]), "=&v"(a[5]), "=&v"(a[6]), "=&v"(a[7])
                             : "v"(addr + 128 * hf) : "memory");
#pragma unroll
                for (int d4 = 0; d4 < 4; ++d4) { const int db = 4 * hf + d4;
                    bf16x8 af; af[0] = a[d4][0]; af[1] = a[d4][1]; af[2] = a[d4][2]; af[3] = a[d4][3]; af[4] = a[d4 + 4][0]; af[5] = a[d4 + 4][1]; af[6] = a[d4 + 4][2]; af[7] = a[d4 + 4][3];
                    st.o[db] = __builtin_amdgcn_mfma_f32_16x16x32_bf16(af, pf, st.o[db], 0, 0, 0); }
            }
        }
        dcur = dnext;
    }
}
struct FragV { bf16x8 v[8]; };
__device__ __forceinline__ void load_fk(bf16x8 (&k)[2][4], const bf16_t* __restrict__ KF, int pos0, int lane) {
    const bf16_t* kp = KF + ((size_t)(pos0 >> 4) * 256 + lane) * 8;
#pragma unroll
    for (int T = 0; T < 2; ++T)
#pragma unroll
        for (int s2 = 0; s2 < 4; ++s2) k[T][s2] = *(const bf16x8*)(kp + (T * 4 + s2) * 512);
}
__device__ __forceinline__ void load_fv(FragV& f, const bf16_t* __restrict__ VF, int pos0, int lane) {
    const bf16_t* vp = VF + ((size_t)(pos0 >> 5) * 512 + lane) * 8;
#pragma unroll
    for (int db = 0; db < 8; ++db) f.v[db] = *(const bf16x8*)(vp + db * 512);
}
template <int MODE>
__device__ __forceinline__ void step_fragb(const bf16x8 (&qf)[4], bf16x8 (&kf)[2][4], FragV& cur, const bf16_t* __restrict__ KF, const bf16_t* __restrict__ VF,
                                           int pos0, int pnext, int lo, int hi, AState& st, int lane, LAS float* imp) {
    const int kq = lane >> 4;
    f32x4 sa[2] = {(f32x4){0.f, 0.f, 0.f, 0.f}, (f32x4){0.f, 0.f, 0.f, 0.f}};
#pragma unroll
    for (int T = 0; T < 2; ++T)
#pragma unroll
        for (int s2 = 0; s2 < 4; ++s2) sa[T] = __builtin_amdgcn_mfma_f32_16x16x32_bf16(kf[T][s2], qf[s2], sa[T], 0, 0, 0);
    load_fk(kf, KF, pnext, lane);
    float sc[8]; bool vd[8]; float mx = -1e30f;
#pragma unroll
    for (int T = 0; T < 2; ++T)
#pragma unroll
        for (int r = 0; r < 4; ++r) { const int p = pos0 + 16 * T + 4 * kq + r; const bool v = (p >= lo) & (p <= hi); const float x = sa[T][r] * SL2;
            sc[4 * T + r] = x; vd[4 * T + r] = v; mx = v ? fmaxf(mx, x) : mx; }
    float p[8];
    if (MODE == 2) {
        const int l16 = lane & 15;
#pragma unroll
        for (int j = 0; j < 8; ++j) p[j] = vd[j] ? __builtin_amdgcn_exp2f(sc[j] - st.m) * st.l : 0.f;
#pragma unroll
        for (int T = 0; T < 2; ++T) {
            float x = 2.f * (p[4 * T] + p[4 * T + 1] + p[4 * T + 2]) + p[4 * T + 3], y = p[4 * T + 3];
            x += __shfl_xor(x, 1); x += __shfl_xor(x, 2); y += __shfl_xor(y, 1); y += __shfl_xor(y, 2);
            if ((l16 & 3) == 0) { const int a = (pos0 >> 2) + 4 * T + kq; LAS float* ip = imp + (l16 >> 2) * IMP_LD + a;
                ip[0] += x;
                asm volatile("s_waitcnt lgkmcnt(0)" ::: "memory");
                ip[1] += y; }
            asm volatile("s_waitcnt lgkmcnt(0)" ::: "memory");
        }
    } else {
        if (__builtin_amdgcn_ballot_w64(mx > st.m + 40.f) != 0ull) {
            mx = fmaxf(mx, __shfl_xor(mx, 16)); mx = fmaxf(mx, __shfl_xor(mx, 32));
            const float mn = fmaxf(st.m, mx), alpha = __builtin_amdgcn_exp2f(st.m - mn); st.m = mn; st.l *= alpha;
            if (MODE == 0) {
#pragma unroll
                for (int j = 0; j < 8; ++j) st.o[j] = st.o[j] * alpha;
            }
        }
        float ps = 0.f;
#pragma unroll
        for (int j = 0; j < 8; ++j) { p[j] = vd[j] ? __builtin_amdgcn_exp2f(sc[j] - st.m) : 0.f; ps += p[j]; }
        st.l += ps;
    }
    if (MODE != 1) {
        u32x4 pw; pw.x = cvt_pk_bf16(p[0], p[1]); pw.y = cvt_pk_bf16(p[2], p[3]); pw.z = cvt_pk_bf16(p[4], p[5]); pw.w = cvt_pk_bf16(p[6], p[7]);
        const bf16x8 pf = __builtin_bit_cast(bf16x8, pw);
#pragma unroll
        for (int db = 0; db < 8; ++db) st.o[db] = __builtin_amdgcn_mfma_f32_16x16x32_bf16(cur.v[db], pf, st.o[db], 0, 0, 0);
        load_fv(cur, VF, pnext, lane);
    }
}
template <int MODE, bool SLC, class Desc>
__device__ __forceinline__ void attn_run_frag(const bf16x8 (&qf)[4], const bf16_t* __restrict__ KF, const bf16_t* __restrict__ VF, const Desc& desc, int n,
                                              int lo_in, int hi, int qi, AState& st, int lane, LAS float* imp = nullptr) {
    static_assert(!SLC, "the bf16 fragment walk is used without per-step query selection");
    if (n <= 0) return;
    bf16x8 kf[2][4]; FragV va;
    int d0 = desc(0);
    load_fk(kf, KF, d0, lane);
    if (MODE != 1) load_fv(va, VF, d0, lane);
#pragma unroll 1
    for (int i = 0; i < n; ++i) {
        const int d1 = desc(i + 1 < n ? i + 1 : i);
        step_fragb<MODE>(qf, kf, va, KF, VF, d0, d1, lo_in, hi, st, lane, imp);
        d0 = d1;
    }
}
struct Frag8 { i64_t k[2][4]; i64_t v[8]; };
__device__ __forceinline__ void load_frag8(Frag8& f, const unsigned char* __restrict__ KF, const unsigned char* __restrict__ VF, int pos0, int lane) {
    const unsigned char* kp = KF + ((size_t)(pos0 >> 4) * 256 + lane) * 8; const unsigned char* vp = VF + ((size_t)(pos0 >> 5) * 512 + lane) * 8;
#pragma unroll
    for (int T = 0; T < 2; ++T)
#pragma unroll
        for (int s2 = 0; s2 < 4; ++s2) f.k[T][s2] = *(const i64_t*)(kp + (T * 4 + s2) * 512);
#pragma unroll
    for (int db = 0; db < 8; ++db) f.v[db] = *(const i64_t*)(vp + db * 512);
}
template <bool SLC, bool NOMASK>
__device__ __forceinline__ void step_frag8(const i64_t (&qf)[4], const Frag8& cur, Frag8& nxt, const unsigned char* __restrict__ KF, const unsigned char* __restrict__ VF,
                                           int dcur, int dnext, int lo_in, int hi, int qi, AState& st, int lane) {
    const int kq = lane >> 4;
    const int pos0 = SLC ? (dcur & 0xfffff) : dcur;
    const int lo = SLC ? ((((dcur >> 20) == qi) | ((dcur >> 20) == 4)) ? 0 : (1 << 30)) : lo_in;
    load_frag8(nxt, KF, VF, SLC ? (dnext & 0xfffff) : dnext, lane);
    f32x4 sa[2] = {(f32x4){0.f, 0.f, 0.f, 0.f}, (f32x4){0.f, 0.f, 0.f, 0.f}};
#pragma unroll
    for (int T = 0; T < 2; ++T)
#pragma unroll
        for (int s2 = 0; s2 < 4; ++s2) sa[T] = __builtin_amdgcn_mfma_f32_16x16x32_fp8_fp8(cur.k[T][s2], qf[s2], sa[T], 0, 0, 0);
    float sc[8]; bool vd[8]; float mx = -1e30f;
    const bool act = lo == 0 || !SLC;
    if (NOMASK) {
#pragma unroll
        for (int j = 0; j < 8; ++j) { sc[j] = sa[j >> 2][j & 3]; vd[j] = act; }
        mx = fmaxf(fmaxf(fmaxf(sc[0], sc[1]), fmaxf(sc[2], sc[3])), fmaxf(fmaxf(sc[4], sc[5]), fmaxf(sc[6], sc[7])));
        mx = act ? mx : -1e30f;
    } else {
#pragma unroll
        for (int T = 0; T < 2; ++T)
#pragma unroll
            for (int r = 0; r < 4; ++r) { const int p = pos0 + 16 * T + 4 * kq + r; const bool v = (p >= lo) & (p <= hi); const float x = sa[T][r];
                sc[4 * T + r] = x; vd[4 * T + r] = v; mx = v ? fmaxf(mx, x) : mx; }
    }
    if (__builtin_amdgcn_ballot_w64(mx > st.m + 4.f) != 0ull) {
        mx = fmaxf(mx, __shfl_xor(mx, 16)); mx = fmaxf(mx, __shfl_xor(mx, 32));
        const float mn = fmaxf(st.m, mx), alpha = __builtin_amdgcn_exp2f(st.m - mn); st.m = mn; st.l *= alpha;
#pragma unroll
        for (int j = 0; j < 8; ++j) st.o[j] = st.o[j] * alpha;
    }
    f32x4 pa, pb; float ps = 0.f;
    const float mref = st.m - 4.f;
    if (NOMASK) {
#pragma unroll
        for (int j = 0; j < 4; ++j) { pa[j] = __builtin_amdgcn_exp2f(sc[j] - mref); pb[j] = __builtin_amdgcn_exp2f(sc[4 + j] - mref); }
        if (SLC) {
#pragma unroll
            for (int j = 0; j < 4; ++j) { pa[j] = act ? pa[j] : 0.f; pb[j] = act ? pb[j] : 0.f; }
        }
#pragma unroll
        for (int j = 0; j < 4; ++j) ps += pa[j] + pb[j];
    } else {
#pragma unroll
        for (int j = 0; j < 4; ++j) { pa[j] = vd[j] ? __builtin_amdgcn_exp2f(sc[j] - mref) : 0.f; pb[j] = vd[4 + j] ? __builtin_amdgcn_exp2f(sc[4 + j] - mref) : 0.f; ps += pa[j] + pb[j]; }
    }
    st.l += ps;
    const u32x2 pw = pack8_fp8(pa, pb);
    const i64_t pf = __builtin_bit_cast(i64_t, pw);
#pragma unroll
    for (int db = 0; db < 8; ++db) st.o[db] = __builtin_amdgcn_mfma_f32_16x16x32_fp8_fp8(cur.v[db], pf, st.o[db], 0, 0, 0);
}
template <bool SLC, class Desc>
__device__ __forceinline__ void attn_run_frag8(const i64_t (&qf)[4], const unsigned char* __restrict__ KF, const unsigned char* __restrict__ VF, const Desc& desc, int n,
                                               int lo_in, int hi, int qi, AState& st, int lane) {
    if (n <= 0) return;
    Frag8 fa, fb, fc;
    constexpr int NM = ~(1 << 30);
    int d0 = desc(0), d1 = desc(n > 1 ? 1 : 0);
    load_frag8(fa, KF, VF, SLC ? (d0 & 0xfffff) : (d0 & NM), lane);
    load_frag8(fb, KF, VF, SLC ? (d1 & 0xfffff) : (d1 & NM), lane);
#define F8_STEP(CUR, NXT2, DC, DN2) do { \
        if ((DC) & (1 << 30)) step_frag8<SLC, true>(qf, CUR, NXT2, KF, VF, (DC) & NM, (DN2) & NM, lo_in, hi, qi, st, lane); \
        else step_frag8<SLC, false>(qf, CUR, NXT2, KF, VF, (DC), (DN2) & NM, lo_in, hi, qi, st, lane); } while (0)
#pragma unroll 1
    for (int i = 0; i < n; i += 3) {
        const int d2 = desc(i + 2 < n ? i + 2 : n - 1);
        F8_STEP(fa, fc, d0, d2);
        if (i + 1 >= n) break;
        const int d3 = desc(i + 3 < n ? i + 3 : n - 1);
        F8_STEP(fb, fa, d1, d3);
        if (i + 2 >= n) break;
        const int d4 = desc(i + 4 < n ? i + 4 : n - 1);
        F8_STEP(fc, fb, d2, d4);
        d0 = d3; d1 = d4;
    }
#undef F8_STEP
}
__device__ __forceinline__ float quad_total(float v) { v += __shfl_xor(v, 16); v += __shfl_xor(v, 32); return v; }

__device__ __forceinline__ void dilated_unit(int unit, const bf16_t* proj, const bf16_t* kbf, bf16_t* nsaout, int lane) {
    const int l16 = lane & 15, kq = lane >> 4;
    const int hg = (unit >> 4) & 3, r16 = unit & 15, ut = unit >> 6;
    const int t0 = r16 + 256 * ut, tc = t0 + 16 * l16;
    const bf16_t* vbf = kbf + ((size_t)24 << 20);
    AState st; astate_init(st);
#pragma unroll 1
    for (int pt = 0; pt < 3; ++pt) {
        const int sh = 2 * pt, head = 4 * pt + hg;
        const bf16_t* qrow = proj + (size_t)tc * PLD + PC_QB + head * 128 + 8 * kq;
        bf16x8 qf[4];
#pragma unroll
        for (int s = 0; s < 4; ++s) qf[s] = *(const bf16x8*)(qrow + 32 * s);
        const int base = (r16 & ((1 << sh) - 1)) << (14 - sh), u0 = t0 >> sh, ui = u0 + (16 >> sh) * l16;
        const int lo = base + (ui - 128 < 0 ? 0 : ui - 128), hi = base + ui;
        const int first = (base + (u0 - 128 < 0 ? 0 : u0 - 128)) >> 5, last = (base + u0 + 15 * (16 >> sh)) >> 5;
        unsigned long long hoff = (unsigned long long)head * S * 128; asm volatile("" : "+s"(hoff));
        auto desc = [&](int i) { return 32 * (first + i); };
        attn_run_frag<0, false>(qf, kbf + hoff, vbf + hoff, desc, last - first + 1, lo, hi, 0, st, lane);
    }
    const float lt = quad_total(st.l), inv = lt > 0.f ? 1.f / lt : 0.f;
    bf16_t* op = nsaout + (size_t)tc * NOLD + 1024 + hg * 128 + 4 * kq;
#pragma unroll
    for (int db = 0; db < 8; ++db) { const f32x4 o = st.o[db] * inv; u32x2 w; w.x = cvt_pk_bf16(o[0], o[1]); w.y = cvt_pk_bf16(o[2], o[3]); *(u32x2*)(op + 16 * db) = w; }
}

__device__ __forceinline__ void compress_unit(int unit, const bf16_t* proj, const bf16_t* w1t, const bf16_t* w2t, const float* bias, bf16_t* outc, LAS unsigned char* lds, int wave, int lane) {
    const int l16 = lane & 15, kq = lane >> 4;
    const int rt = unit & 63, g = (unit >> 6) & 1, kv = unit >> 7;
    const bf16_t* raw = proj + (kv ? PC_VC : PC_KC) + 128 * g;
    const int n = 16 * rt + l16;
    f32x4 acc[16];
#pragma unroll
    for (int i = 0; i < 16; ++i) acc[i] = (f32x4){0.f, 0.f, 0.f, 0.f};
#pragma unroll 2
    for (int si = 0; si < 16; ++si) {
        const int s = 16 * wave + si;
        const int tok = clampi(16 * n + (s >> 2), 0, S - 1);
        const bf16x8 af = *(const bf16x8*)(raw + (size_t)tok * PLD + (s & 3) * 32 + 8 * kq);
#pragma unroll
        for (int ct = 0; ct < 16; ++ct) { const bf16x8 bfr = *(const bf16x8*)(w1t + ((size_t)(ct * 128 + s) * 64 + lane) * 8);
            acc[ct] = __builtin_amdgcn_mfma_f32_16x16x32_bf16(af, bfr, acc[ct], 0, 0, 0); }
    }
    LAS f32x4* part = (LAS f32x4*)lds;
#pragma unroll
    for (int ct = 0; ct < 16; ++ct) part[(wave * 16 + ct) * 64 + lane] = acc[ct];
    __syncthreads();
    LAS unsigned char* hid = lds + 131072;
#pragma unroll
    for (int c2 = 0; c2 < 2; ++c2) { const int ct = 2 * wave + c2; f32x4 sum = (f32x4){0.f, 0.f, 0.f, 0.f};
#pragma unroll
        for (int w = 0; w < 8; ++w) sum += part[(w * 16 + ct) * 64 + lane];
        const float bb = bias[16 * ct + l16];
#pragma unroll
        for (int r = 0; r < 4; ++r) { const float x = sum[r] + bb; const float u2 = 1.5957691216f * (x + 0.044715f * x * x * x); const float gl = x * fsigmoid(u2);
            *(LAS bf16_t*)(hid + (4 * kq + r) * 528 + (16 * ct + l16) * 2) = (bf16_t)(cvt_pk_bf16(gl, 0.f) & 0xffffu); } }
    __syncthreads();
    f32x4 o2 = (f32x4){0.f, 0.f, 0.f, 0.f};
    const int dt = wave;
#pragma unroll
    for (int s = 0; s < 8; ++s) {
        const bf16x8 af = *(const LAS bf16x8*)(hid + l16 * 528 + (32 * s + 8 * kq) * 2);
        const bf16x8 bfr = *(const bf16x8*)(w2t + (size_t)(16 * dt + l16) * 256 + 32 * s + 8 * kq);
        o2 = __builtin_amdgcn_mfma_f32_16x16x32_bf16(af, bfr, o2, 0, 0, 0);
    }
#pragma unroll
    for (int r = 0; r < 4; ++r) { const int nn = 16 * rt + 4 * kq + r, d = 16 * dt + l16;
        const bf16_t val = (bf16_t)(cvt_pk_bf16(o2[r], 0.f) & 0xffffu);
        if (kv == 0) outc[(((size_t)g * 64 + (nn >> 4)) * 4 + (d >> 5)) * 512 + (((d >> 3) & 3) * 16 + (nn & 15)) * 8 + (d & 7)] = val;
        else { const int kp = nn & 31; outc[(((size_t)g * 32 + (nn >> 5)) * 8 + (d >> 4)) * 512 + ((((kp >> 2) & 3) * 16) + (d & 15)) * 8 + 4 * (kp >> 4) + (kp & 3)] = val; } }
    __syncthreads();
}

__device__ __forceinline__ void nsa_unit(int unit, const bf16_t* proj, const bf16_t* kc, const bf16_t* vc, const bf16_t* gn, const float* cs, const float* sn,
                                         const bf16_t* kslf, const bf16_t* vslf, const bf16_t* kwnf, const bf16_t* vwnf, bf16_t* nsaout, LAS unsigned char* wl, int lane) {
    const int l16 = lane & 15, kq = lane >> 4;
    const int g = unit & 1, tb = unit >> 1, t0 = 4 * tb, qi = l16 >> 2, h = l16 & 3, tc = t0 + qi, head = 4 * g + h;
    LAS unsigned char* vbuf = wl; LAS float* imp = (LAS float*)(wl + VBUF_BYTES); LAS int* sel = (LAS int*)(wl + VBUF_BYTES + 4 * IMP_LD * 4);
    bf16x8 qf[4];
    { const bf16_t* qrow = proj + (size_t)tc * PLD + PC_QA + head * 128 + 8 * kq;
#pragma unroll
        for (int s = 0; s < 4; ++s) qf[s] = *(const bf16x8*)(qrow + 32 * s); }
    LAS u32x2* outl = (LAS u32x2*)(wl + OUT_OFF) + lane;
    for (int i = lane; i < 4 * IMP_LD; i += 64) imp[i] = 0.f;
    const int hic = (tc - 31) >> 4;
    const int nkmax = ((t0 + 3 - 31) >> 4) + 1, nsc = nkmax > 0 ? (nkmax + 31) >> 5 : 0;
    unsigned long long coff = (unsigned long long)g * 1024 * 128; asm volatile("" : "+s"(coff));
    const bf16_t* kcg = kc + coff; const bf16_t* vcg = vc + coff;
    AState st; astate_init(st);
    { auto desc = [&](int i) { return 32 * i; };
      attn_run_frag<1, false>(qf, kcg, vcg, desc, nsc, 0, hic, 0, st, lane);
      { const float lt = quad_total(st.l); st.l = lt > 0.f ? 1.f / lt : 0.f; }
      asm volatile("s_waitcnt lgkmcnt(0)" ::: "memory");
      attn_run_frag<2, false>(qf, kcg, vcg, desc, nsc, 0, hic, 0, st, lane, imp); }
    const float g0 = bf2f(gn[(size_t)tc * 32 + head * 3 + 0]);
#pragma unroll
    for (int i = 0; i < 8; ++i) { const f32x4 o = st.o[i] * g0; u32x2 w; w.x = cvt_pk_bf16(o[0], o[1]); w.y = cvt_pk_bf16(o[2], o[3]); outl[64 * i] = w; }
    asm volatile("s_waitcnt lgkmcnt(0)" ::: "memory");
#pragma unroll
    for (int s2 = 0; s2 < 2; ++s2) {
        const int d = 32 * s2 + 8 * kq; f32x4 c[2], sv[2];
        c[0] = *(const f32x4*)(cs + (size_t)tc * 64 + d); c[1] = *(const f32x4*)(cs + (size_t)tc * 64 + d + 4);
        sv[0] = *(const f32x4*)(sn + (size_t)tc * 64 + d); sv[1] = *(const f32x4*)(sn + (size_t)tc * 64 + d + 4);
        float o1[8], o2[8];
#pragma unroll
        for (int j = 0; j < 8; ++j) { const float x1 = bf2f((unsigned short)qf[s2][j]), x2 = bf2f((unsigned short)qf[s2 + 2][j]), cc = c[j >> 2][j & 3], ss = sv[j >> 2][j & 3];
            o1[j] = x1 * cc - x2 * ss; o2[j] = x2 * cc + x1 * ss; }
        u32x4 w1, w2; w1.x = cvt_pk_bf16(o1[0], o1[1]); w1.y = cvt_pk_bf16(o1[2], o1[3]); w1.z = cvt_pk_bf16(o1[4], o1[5]); w1.w = cvt_pk_bf16(o1[6], o1[7]);
        w2.x = cvt_pk_bf16(o2[0], o2[1]); w2.y = cvt_pk_bf16(o2[2], o2[3]); w2.z = cvt_pk_bf16(o2[4], o2[5]); w2.w = cvt_pk_bf16(o2[6], o2[7]);
        qf[s2] = __builtin_bit_cast(bf16x8, w1); qf[s2 + 2] = __builtin_bit_cast(bf16x8, w2);
    }
    unsigned key[4][4];
#pragma unroll
    for (int q = 0; q < 4; ++q) { const int cur = (t0 + q) >> 6; const f32x4 v = *(const LAS f32x4*)(imp + q * IMP_LD + 4 * lane);
#pragma unroll
        for (int i = 0; i < 4; ++i) { const int j = 4 * lane + i; const bool valid = j <= cur, forced = (j == 0) | (j == cur) | (j == cur - 1);
            const unsigned kb = forced ? 0xffffffu : ((__float_as_uint(fmaxf(v[i], 0.f)) >> 8) + 1u);
            key[q][i] = valid ? ((kb << 8) | (unsigned)(255 - j)) : 0u; } }
#pragma unroll 1
    for (int r = 0; r < 16; ++r) {
        unsigned mx[4];
#pragma unroll
        for (int q = 0; q < 4; ++q) { unsigned a = key[q][0] > key[q][1] ? key[q][0] : key[q][1], b = key[q][2] > key[q][3] ? key[q][2] : key[q][3]; mx[q] = a > b ? a : b; }
#pragma unroll
        for (int o = 1; o < 64; o <<= 1)
#pragma unroll
            for (int q = 0; q < 4; ++q) { const unsigned other = (unsigned)__shfl_xor((int)mx[q], o); mx[q] = other > mx[q] ? other : mx[q]; }
#pragma unroll
        for (int q = 0; q < 4; ++q) {
#pragma unroll
            for (int i = 0; i < 4; ++i) if (key[q][i] == mx[q]) key[q][i] = 0u;
            if (lane == 0) sel[q * 16 + r] = mx[q] ? (int)(255u - (mx[q] & 255u)) : -1;
        }
    }
    asm volatile("s_waitcnt lgkmcnt(0)" ::: "memory");
    i64_t q8[4];
#pragma unroll
    for (int s2 = 0; s2 < 4; ++s2) { f32x4 a, b;
#pragma unroll
        for (int j = 0; j < 4; ++j) { a[j] = bf2f((unsigned short)qf[s2][j]) * SL2; b[j] = bf2f((unsigned short)qf[s2][4 + j]) * SL2; }
        q8[s2] = __builtin_bit_cast(i64_t, pack8_fp8(a, b)); }
    LAS int* list = (LAS int*)(wl + VBUF_BYTES + 4 * IMP_LD * 4 + 256);
    int nslc;
    { const int b = sel[lane], q = lane >> 4, cur0 = t0 >> 6;
      const bool forced = (b == 0) | (b == cur0) | (b == cur0 - 1);
      const bool valid = (b >= 0) & !(forced & (q > 0)); const unsigned long long mask = __ballot(valid);
      const int idx = __popcll(mask & ((1ull << lane) - 1ull)); nslc = 2 * __popcll(mask);
      if (valid) { const int qc = (forced ? 4 : q) | (b < cur0 ? (1 << 10) : 0);
                   list[2 * idx] = (64 * b) | (qc << 20); list[2 * idx + 1] = (64 * b + 32) | (qc << 20); } }
    asm volatile("s_waitcnt lgkmcnt(0)" ::: "memory");
    astate_init(st);
    { auto desc = [&](int i) { return __builtin_amdgcn_readfirstlane(list[i]); };
      unsigned long long goff = (unsigned long long)g * S * 128; asm volatile("" : "+s"(goff));
      attn_run_frag8<true>(q8, (const unsigned char*)kslf + goff, (const unsigned char*)kslf + ((size_t)8 << 20) + goff, desc, nslc, 0, tc, qi, st, lane); }
    { const float g1 = bf2f(gn[(size_t)tc * 32 + head * 3 + 1]); const float lt = quad_total(st.l), inv = (lt > 0.f ? 1.f / lt : 0.f) * g1;
#pragma unroll
        for (int i = 0; i < 8; ++i) { const f32x4 o = st.o[i] * inv; u32x2 w = outl[64 * i]; w.x = cvt_pk_bf16(bflo(w.x) + o[0], bfhi(w.x) + o[1]); w.y = cvt_pk_bf16(bflo(w.y) + o[2], bfhi(w.y) + o[3]); outl[64 * i] = w; } }
    astate_init(st);
    { const int lo = tc - 511 < 0 ? 0 : tc - 511; const int first = t0 < 511 ? 0 : (t0 - 511) >> 5, last = (t0 + 3) >> 5;
      auto desc = [&](int i) { const int p0 = 32 * (first + i); return p0 | ((p0 >= t0 + 3 - 511 && p0 + 31 <= t0) ? (1 << 30) : 0); };
      unsigned long long goff = (unsigned long long)g * S * 128; asm volatile("" : "+s"(goff));
      attn_run_frag8<false>(q8, (const unsigned char*)kslf + ((size_t)16 << 20) + goff, (const unsigned char*)kslf + ((size_t)24 << 20) + goff, desc, last - first + 1, lo, tc, 0, st, lane); }
    { const float g2 = bf2f(gn[(size_t)tc * 32 + head * 3 + 2]); const float lt = quad_total(st.l), inv = (lt > 0.f ? 1.f / lt : 0.f) * g2;
#pragma unroll
        for (int i = 0; i < 8; ++i) { const f32x4 o = st.o[i] * inv; u32x2 w = outl[64 * i]; w.x = cvt_pk_bf16(bflo(w.x) + o[0], bfhi(w.x) + o[1]); w.y = cvt_pk_bf16(bflo(w.y) + o[2], bfhi(w.y) + o[3]); outl[64 * i] = w; } }
    bf16_t* op = nsaout + (size_t)tc * NOLD + head * 128 + 4 * kq;
#pragma unroll
    for (int db = 0; db < 8; ++db) *(u32x2*)(op + 16 * db) = outl[64 * db];
}


#define XB_TMO      128
#define XB_XCNT(j)  (256  + 64 * (j))
#define XB_XSUB(j)  (1280 + 64 * (j))
#define XB_XGEN(j)  (2304 + 64 * (j))
#define XB_TOP      3328
#define XB_TOPGEN   3392
#define XCD_BAR_WORDS 3456
#define XB_SPIN_CAP (1u << 18)
__device__ __forceinline__ unsigned xb_ld(unsigned* p)              { return __hip_atomic_load(p, __ATOMIC_RELAXED, __HIP_MEMORY_SCOPE_AGENT); }
__device__ __forceinline__ unsigned xb_add(unsigned* p, unsigned v) { return __hip_atomic_fetch_add(p, v, __ATOMIC_RELAXED, __HIP_MEMORY_SCOPE_AGENT); }
__device__ __forceinline__ unsigned xb_xcc_id() { return (unsigned)__builtin_amdgcn_s_getreg((3 << 11) | 20) & 0xFu; }
#define XB_SPIN(cond, bar) do { unsigned _sp = 0; while (cond) { __builtin_amdgcn_s_sleep(1); \
    if ((++_sp & 255u) == 0u) { if (xb_ld(&(bar)[XB_TMO])) break; if (_sp > XB_SPIN_CAP) { atomicAdd(&(bar)[XB_TMO], 1u); break; } } } } while (0)
struct XcdBarrier { unsigned* bar; unsigned x; volatile LAS unsigned* st; };
__device__ __forceinline__ XcdBarrier xcd_barrier_post(unsigned* bar, volatile LAS unsigned* st) {
    XcdBarrier b; b.bar = bar; b.x = xb_xcc_id(); b.st = st;
    if (threadIdx.x == 0) st[2] = xb_add(&bar[XB_XCNT(b.x)], 1u);
    return b;
}
__device__ __forceinline__ void xcd_barrier_complete(unsigned* bar, unsigned x, unsigned& nloc, unsigned& nx) {
    const unsigned G = gridDim.x * gridDim.y * gridDim.z;
    unsigned sum, cnt, mine, sp = 0u;
    for (;;) {
        sum = 0u; cnt = 0u; mine = 0u;
#pragma unroll
        for (unsigned j = 0; j < 16; ++j) { const unsigned c = xb_ld(&bar[XB_XCNT(j)]); sum += c; cnt += (c > 0u) ? 1u : 0u; mine = (j == x) ? c : mine; }
        if (sum == G) break;
        __builtin_amdgcn_s_sleep(1);
        if ((++sp & 255u) == 0u) { if (xb_ld(&bar[XB_TMO])) break; if (sp > XB_SPIN_CAP) { atomicAdd(&bar[XB_TMO], 1u); break; } }
    }
    nloc = mine > 0u ? mine : 1u; nx = cnt > 0u ? cnt : 1u;
}
__device__ __forceinline__ void xcd_barrier(const XcdBarrier& b, const int tid) {
    asm volatile("s_waitcnt vmcnt(0)" ::: "memory");
    __syncthreads();
    if (tid == 0) {
        unsigned* bar = b.bar;
        __builtin_amdgcn_s_waitcnt(0);
        unsigned nloc = b.st[0], nx = b.st[1];
        if (nloc == 0u) { xcd_barrier_complete(bar, b.x, nloc, nx); b.st[0] = nloc; b.st[1] = nx; }
        const unsigned old = xb_add(&bar[XB_XSUB(b.x)], 1u);
        const unsigned gen = old / nloc;
        if (old + 1u == (gen + 1u) * nloc) {
            __builtin_amdgcn_fence(__ATOMIC_RELEASE, "agent");
            asm volatile("s_waitcnt vmcnt(0)" ::: "memory");
            const unsigned og = xb_add(&bar[XB_TOP], 1u);
            const unsigned tg = og / nx;
            if (og + 1u == (tg + 1u) * nx) xb_add(&bar[XB_TOPGEN], 1u);
            else XB_SPIN(xb_ld(&bar[XB_TOPGEN]) == tg, bar);
            __builtin_amdgcn_fence(__ATOMIC_ACQUIRE, "agent");
            xb_add(&bar[XB_XGEN(b.x)], 1u);
            asm volatile("s_waitcnt vmcnt(0)" ::: "memory");
        } else {
            XB_SPIN(xb_ld(&bar[XB_XGEN(b.x)]) == gen, bar);
            __builtin_amdgcn_fence(__ATOMIC_ACQUIRE, "agent");
            asm volatile("s_waitcnt vmcnt(0)" ::: "memory");
        }
    }
    __syncthreads();
}

struct Params { const float* in[23]; float* out; unsigned char* ws; float inv_freq[64]; };

__global__ void __launch_bounds__(512, 2) fwd_megakernel(Params P) {
    extern __shared__ __attribute__((aligned(16))) unsigned char lds_raw[];
    LAS unsigned char* lds = (LAS unsigned char*)lds_raw;
    cg::grid_group grid = cg::this_grid();
    const int wave_s = __builtin_amdgcn_readfirstlane(threadIdx.x >> 6);
#define PHASE_WS unsigned long long wsv_ = (unsigned long long)P.ws; asm volatile("" : "+s"(wsv_)); unsigned char* ws = (unsigned char*)(__attribute__((address_space(1))) unsigned char*)wsv_; unsigned z_ = 0u; asm volatile("" : "+v"(z_)); const int tid = wave_s * 64 + (int)__builtin_amdgcn_mbcnt_hi(~0u, __builtin_amdgcn_mbcnt_lo(~0u, z_)); \
    const int lane = tid & 63, wave = __builtin_amdgcn_readfirstlane(tid >> 6), G = gridDim.x, gw = blockIdx.x * 8 + wave, ngw = G * 8; \
    const size_t gtid = (size_t)blockIdx.x * 512 + tid, gthreads = (size_t)G * 512; \
    LAS unsigned char* wl = lds + wave * WAVE_LDS; LAS float* scr = (LAS float*)wl; (void)lane; (void)gw; (void)ngw; (void)gtid; (void)gthreads; (void)wl; (void)scr
#define WAB ((bf16_t*)(ws + WS_WAB))
#define WO ((bf16_t*)(ws + WS_WO))
#define CW1K ((bf16_t*)(ws + WS_CW1K))
#define CW1V ((bf16_t*)(ws + WS_CW1V))
#define CW2K ((bf16_t*)(ws + WS_CW2K))
#define CW2V ((bf16_t*)(ws + WS_CW2V))
#define CBIAS ((float*)(ws + WS_CBIAS))
#define KC ((bf16_t*)(ws + WS_KC))
#define VC ((bf16_t*)(ws + WS_VC))
#define GN ((bf16_t*)(ws + WS_GN))
#define ST1 ((float*)(ws + WS_ST1))
#define ST2 ((float*)(ws + WS_ST2))
#define HF ((float*)(ws + WS_HF))
#define HB ((bf16_t*)(ws + WS_HB))
#define GU ((bf16_t*)(ws + WS_GU))
#define DN ((bf16_t*)(ws + WS_DN))
#define ACT ((bf16_t*)(ws + WS_ACT))
#define PROJ ((bf16_t*)(ws + WS_PROJ))
#define KSLF ((bf16_t*)(ws + WS_KSLF))
#define KBF ((bf16_t*)(ws + WS_KBF))
#define VBF ((bf16_t*)(ws + WS_VBF))
#define VSLF ((bf16_t*)(ws + WS_VSLF))
#define KWNF ((bf16_t*)(ws + WS_KWNF))
#define VWNF ((bf16_t*)(ws + WS_VWNF))
#define RCOS ((float*)(ws + WS_ROPE))
#define RSIN ((float*)(ws + WS_ROPE) + (size_t)S * 64)
#define WINT ((bf16_t*)(ws + WS_WIN))
#define NSAOUT ((bf16_t*)(ws + WS_NSAOUT))
#define SIGG ((bf16_t*)P.out)
    pg8::StaticOrder SO;
#define CG_SYNC() do { asm volatile("s_waitcnt vmcnt(0) lgkmcnt(0)" ::: "memory"); grid.sync(); \
        if (__builtin_amdgcn_readfirstlane(threadIdx.x >> 6) == 0) { __builtin_amdgcn_fence(__ATOMIC_ACQUIRE, "agent"); asm volatile("s_waitcnt vmcnt(0)" ::: "memory"); } \
        __syncthreads(); } while (0)
    volatile LAS unsigned* xst = (volatile LAS unsigned*)(lds + 8 * WAVE_LDS);
    if (threadIdx.x < 2) xst[threadIdx.x] = 0u;
    __syncthreads();
    const XcdBarrier xbar = xcd_barrier_post((unsigned*)P.ws, xst);
    __syncthreads();
    const int vbid = (int)(xst[2] * 8u + xbar.x);
#define GRID_SYNC() do { asm volatile("s_waitcnt vmcnt(0) lgkmcnt(0)" ::: "memory"); unsigned zz_ = 0u; asm volatile("" : "+v"(zz_)); \
        xcd_barrier(xbar, wave_s * 64 + (int)__builtin_amdgcn_mbcnt_hi(~0u, __builtin_amdgcn_mbcnt_lo(~0u, zz_))); } while (0)

    { PHASE_WS;
        conv_ffn(P.in[1], P.in[2], P.in[3], GU, DN, scr, gw, ngw, lane);
        { const float* win = P.in[6]; bf16_t* wint = WINT;
          tr_stream(32 * 360, gw, ngw, [&](int it) { const int kb = it / 360, nb = it % 360, dr = nb * 32; const int sc = win_src_col(dr);
              return TrP{win, WIN_SRC, kb * 64, sc < 0 ? 0 : sc, sc < 0 ? 0 : (dr == 11264 ? 24 : 32), wint, DM, dr, kb * 64}; }, scr, lane); }
        for (int it = gw; it < 16 * 64; it += ngw) { const int kb = it / 64, nb = it % 64; tr_item(P.in[13], DM, kb * 64, nb * 32, 32, WAB, 1024, nb * 32, kb * 64, scr, lane); }
        for (int it = gw; it < 8 * 64; it += ngw) { const int kb = it / 64, nb = it % 64; tr_item(P.in[14], DM, kb * 64, nb * 32, 32, WAB + (size_t)DM * 1024, 512, nb * 32, kb * 64, scr, lane); }
        for (int it = gw; it < 32 * 64; it += ngw) { const int kb = it / 64, nb = it % 64; tr_item(P.in[15], DM, kb * 64, nb * 32, 32, WO, DM, nb * 32, kb * 64, scr, lane); }
        for (int it = gw; it < 2 * 64 * 8; it += ngw) { const int w = it / 512, r = it % 512, kb = r / 8, nb = r % 8; tr_item<true>(w ? P.in[11] : P.in[8], 256, kb * 64, nb * 32, 32, w ? CW1V : CW1K, 4096, nb * 32, kb * 64, scr, lane); }
        for (int it = gw; it < 2 * 4 * 4; it += ngw) { const int w = it / 16, r = it % 16, kb = r / 4, nb = r % 4; tr_item(w ? P.in[12] : P.in[9], 128, kb * 64, nb * 32, 32, w ? CW2V : CW2K, 256, nb * 32, kb * 64, scr, lane); }
        { const float* x = P.in[0];
            for (size_t i = gtid; i < (size_t)S * DM / 8; i += gthreads) { const f32x4 a = *(const f32x4*)(x + 8 * i), b = *(const f32x4*)(x + 8 * i + 4); *(u32x4*)(HB + 8 * i) = pack8(a, b); } }
        for (int o = gw; o < 512; o += ngw) { const int w = o >> 8, c = o & 255; const float* pos = w ? P.in[10] : P.in[7]; const float* w1 = w ? P.in[11] : P.in[8];
            float s = 0.f; for (int kk = lane; kk < 4096; kk += 64) s += pos[kk] * w1[(size_t)kk * 256 + c];
            s = wave_sum(s); if (lane == 0) CBIAS[o] = s; }
    }
    CG_SYNC();
    { PHASE_WS; pg8::Gemm g{HB, GU, S, NGU, DM, DM, DM}; SO.init(S, NGU, G, (int)blockIdx.x); EpiSwiglu E{ACT}; pg8::gemm_phase(lds, g, SO, E, tid); }
    GRID_SYNC();
    { PHASE_WS; pg8::Gemm g{ACT, DN, S, DM, FF, FF, FF}; SO.init(S, DM, G, (int)blockIdx.x); EpiResF32 E{P.in[0], HF, ALPHA, 0.5f}; pg8::gemm_phase(lds, g, SO, E, tid); }
    GRID_SYNC();
    { PHASE_WS;
        ln_rows(HF, nullptr, HB, P.in[4], P.in[5], gw, ngw, lane, ST1);
        for (size_t i = gtid; i < (size_t)S * 64; i += gthreads) { const int t = (int)(i >> 6), j = (int)(i & 63); const float ang = (float)t * P.inv_freq[j]; RCOS[i] = cosf(ang); RSIN[i] = sinf(ang); }
    }
    GRID_SYNC();
    { PHASE_WS; pg8::Gemm g{HB, WINT, S, NWIN, DM, DM, DM}; SO.init(S, NWIN, G, (int)blockIdx.x); EpiWin E{PROJ, SIGG, GN, RCOS, KSLF, KBF}; pg8::gemm_phase(lds, g, SO, E, tid); }
    GRID_SYNC();
    { PHASE_WS;
      int vb = (int)blockIdx.x;
      { bool ok = true; unsigned* cen = (unsigned*)P.ws;
#pragma unroll
        for (int j = 0; j < 8; ++j) ok &= (xb_ld(&cen[XB_XCNT(j)]) * 8u == (unsigned)G);
        if (ok) vb = vbid; }
        for (int u = blockIdx.x; u < 256; u += G) { const int kv = u >> 7; compress_unit(u, PROJ, kv ? CW1V : CW1K, kv ? CW2V : CW2K, CBIAS + 256 * kv, kv ? VC : KC, lds, wave, lane); }
        if ((G & 7) == 0) {
            const int x = vb & 7, lw = (vb >> 3) * 8 + wave, nlw = (G >> 3) * 8;
            for (int j = lw; j < 512; j += nlw) dilated_unit(64 * (x + 8 * (j >> 6)) + (j & 63), PROJ, KBF, NSAOUT, lane);
        } else { for (int u = gw; u < 4096; u += ngw) dilated_unit(u, PROJ, KBF, NSAOUT, lane); }
    }
    GRID_SYNC();
    { PHASE_WS;
      int vb = (int)blockIdx.x;
      { bool ok = true; unsigned* cen = (unsigned*)P.ws;
#pragma unroll
        for (int j = 0; j < 8; ++j) ok &= (xb_ld(&cen[XB_XCNT(j)]) * 8u == (unsigned)G);
        if (ok) vb = vbid; }
      if ((G & 7) == 0) {
          const int bx = vb, x = bx & 7, g = x & 1, wj = ((bx >> 3) * 4 + (x >> 1)) * 8 + wave, nwj = (G >> 1) * 8;
          for (int tb = wj; tb < 4096; tb += nwj) nsa_unit(2 * tb + g, PROJ, KC, VC, GN, RCOS, RSIN, KSLF, VSLF, KWNF, VWNF, NSAOUT, wl, lane);
      } else { for (int u = gw; u < 8192; u += ngw) nsa_unit(u, PROJ, KC, VC, GN, RCOS, RSIN, KSLF, VSLF, KWNF, VWNF, NSAOUT, wl, lane); } }
    GRID_SYNC();
    { PHASE_WS; SO.init(S, DM, G, (int)blockIdx.x);
      { pg8::Gemm g{NSAOUT, WAB, S, DM, 1024, NOLD, 1024}; EpiGate<true> E{SIGG, HB}; pg8::gemm_phase(lds, g, SO, E, tid); }
      { pg8::Gemm g{NSAOUT + 1024, WAB + (size_t)DM * 1024, S, DM, 512, NOLD, 512}; EpiGate<false> E{SIGG + 2048, HB}; pg8::gemm_phase(lds, g, SO, E, tid); } }
    GRID_SYNC();
    { PHASE_WS; pg8::Gemm g{HB, WO, S, DM, DM, DM, DM}; SO.init(S, DM, G, (int)blockIdx.x); EpiResLnF32 E{HF, ST1, P.in[4], P.in[5], HF, ALPHA, 1.0f}; pg8::gemm_phase(lds, g, SO, E, tid); }
    GRID_SYNC();
    { PHASE_WS;
        ln_rows(HF, nullptr, HB, P.in[16], P.in[17], gw, ngw, lane, ST2);
        conv_ffn(P.in[18], P.in[19], P.in[20], GU, DN, scr, gw, ngw, lane);
    }
    GRID_SYNC();
    { PHASE_WS; pg8::Gemm g{HB, GU, S, NGU, DM, DM, DM}; SO.init(S, NGU, G, (int)blockIdx.x); EpiSwiglu E{ACT}; pg8::gemm_phase(lds, g, SO, E, tid); }
    GRID_SYNC();
    { PHASE_WS; pg8::Gemm g{ACT, DN, S, DM, FF, FF, FF}; SO.init(S, DM, G, (int)blockIdx.x); EpiResLnF32 E{HF, ST2, P.in[16], P.in[17], P.out, ALPHA, 0.5f}; pg8::gemm_phase(lds, g, SO, E, tid); }
    GRID_SYNC();
    { PHASE_WS; (void)ws; ln_rows(P.out, P.out, nullptr, P.in[21], P.in[22], gw, ngw, lane); }
}

extern "C" void kernel_launch(void* const* d_in, const int* in_sizes, int n_in, void* d_out, int out_size, void* d_ws, size_t ws_size, hipStream_t stream) {
    static int grid = 0;
    if (grid == 0) {
        if (n_in != 23 || out_size != S * DM || ws_size < WS_END) { fprintf(stderr, "kernel_launch: unexpected shapes (n_in %d out %d ws %zu, need %zu)\n", n_in, out_size, ws_size, (size_t)WS_END); grid = -1; return; }
        int dev = 0, cus = 0, per_cu = 0;
        hipGetDevice(&dev); hipDeviceGetAttribute(&cus, hipDeviceAttributeMultiprocessorCount, dev);
        if (hipFuncSetAttribute((const void*)fwd_megakernel, hipFuncAttributeMaxDynamicSharedMemorySize, LDS_BYTES) != hipSuccess) { fprintf(stderr, "kernel_launch: hipFuncSetAttribute failed\n"); grid = -1; return; }
        if (hipOccupancyMaxActiveBlocksPerMultiprocessor(&per_cu, (const void*)fwd_megakernel, 512, LDS_BYTES) != hipSuccess || per_cu < 1) { fprintf(stderr, "kernel_launch: occupancy query failed (%d)\n", per_cu); (void)hipGetLastError(); per_cu = 1; }
        grid = cus * per_cu;
    }
    if (grid < 0) return;
    if (hipMemsetAsync(d_ws, 0, 16384, stream) != hipSuccess) { fprintf(stderr, "kernel_launch: memset of the barrier words failed\n"); return; }
    Params p{};
    for (int i = 0; i < 23; ++i) p.in[i] = (const float*)d_in[i];
    p.out = (float*)d_out; p.ws = (unsigned char*)d_ws;
    for (int i = 0; i < 64; ++i) p.inv_freq[i] = (float)pow(10000.0, -(double)i / 64.0);
    void* args[] = {&p};
    hipError_t e = hipLaunchCooperativeKernel((const void*)fwd_megakernel, dim3(grid), dim3(512), args, LDS_BYTES, stream);
    if (e != hipSuccess) fprintf(stderr, "kernel_launch: cooperative launch failed: %s (grid %d)\n", hipGetErrorString(e), grid);
}
```

```cpp
#include <hip/hip_runtime.h>
#include <hip/hip_cooperative_groups.h>
#include <cstdio>
#include <cstdint>
#include <cmath>
namespace cg = cooperative_groups;

#define LAS __attribute__((address_space(3)))
typedef unsigned short bf16_t;
typedef short bf16x8 __attribute__((ext_vector_type(8)));
typedef short s16x4 __attribute__((ext_vector_type(4)));
typedef float f32x4 __attribute__((ext_vector_type(4)));
typedef float f32x2 __attribute__((ext_vector_type(2)));
typedef unsigned u32x4 __attribute__((ext_vector_type(4)));
typedef unsigned u32x2 __attribute__((ext_vector_type(2)));

constexpr int S = 16384, DM = 2048, FF = 5632, NGU = 2 * FF, NWIN = 11520, WIN_SRC = 11288, PLD = 3072, NOLD = 1536;
constexpr float ALPHA = 1.189207115002721f;
constexpr float LN_EPS = 1e-5f;
constexpr float SL2 = 0.08838834764831845f * 1.4426950408889634f;
constexpr int PC_QA = 0, PC_KC = 1024, PC_VC = 1280, PC_QB = 1536;
constexpr size_t MiB = 1u << 20;
constexpr size_t WS_WAB = 1 * MiB, WS_WO = 13 * MiB, WS_CW1K = 21 * MiB, WS_CW1V = 23 * MiB, WS_CW2K = 25 * MiB, WS_CW2V = 25 * MiB + 65536, WS_CBIAS = 25 * MiB + 131072;
constexpr size_t WS_KC = 26 * MiB, WS_VC = 26 * MiB + 524288, WS_GN = 27 * MiB, WS_ST1 = 28 * MiB, WS_ST2 = 28 * MiB + 131072;
constexpr size_t WS_HF = 32 * MiB, WS_HB = 160 * MiB, WS_BIG = 224 * MiB;
constexpr size_t WS_GU = WS_BIG, WS_DN = WS_BIG + 44 * MiB, WS_ACT = WS_BIG + 66 * MiB;
constexpr size_t WS_KBF = WS_BIG + 96 * MiB, WS_VBF = WS_BIG + 144 * MiB;
constexpr size_t WS_PROJ = WS_BIG, WS_KSLF = WS_BIG + 192 * MiB, WS_VSLF = WS_BIG + 200 * MiB, WS_KWNF = WS_BIG + 208 * MiB, WS_VWNF = WS_BIG + 216 * MiB, WS_ROPE = WS_BIG + 224 * MiB;
constexpr size_t WS_WIN = 466 * MiB, WS_NSAOUT = 466 * MiB, WS_END = 514 * MiB;

constexpr int VROW = 288, VBUF_BYTES = 32 * VROW;
constexpr int IMP_LD = 260;
constexpr int OUT_OFF = VBUF_BYTES + 4 * IMP_LD * 4 + 256 + 512;
constexpr int WAVE_LDS = OUT_OFF + 4096;
constexpr int LDS_BYTES = 147456;
static_assert(8 * WAVE_LDS + 32 <= LDS_BYTES && 131072 <= LDS_BYTES, "LDS map");

typedef __bf16 bf16x2_t __attribute__((ext_vector_type(2)));
__device__ __forceinline__ unsigned cvt_pk_bf16(float lo, float hi) { f32x2 v = {lo, hi}; bf16x2_t b = __builtin_convertvector(v, bf16x2_t); return __builtin_bit_cast(unsigned, b); }
__device__ __forceinline__ float bf2f(unsigned short b) { return __uint_as_float(((unsigned)b) << 16); }
__device__ __forceinline__ float bflo(unsigned w) { return __uint_as_float(w << 16); }
__device__ __forceinline__ float bfhi(unsigned w) { return __uint_as_float(w & 0xffff0000u); }
__device__ __forceinline__ float fsigmoid(float x) { return __builtin_amdgcn_rcpf(1.f + __expf(-x)); }
__device__ __forceinline__ float quad_xor1(float v) { return __int_as_float(__builtin_amdgcn_update_dpp(0, __float_as_int(v), 0xB1, 0xF, 0xF, false)); }
__device__ __forceinline__ float quad_xor2(float v) { return __int_as_float(__builtin_amdgcn_update_dpp(0, __float_as_int(v), 0x4E, 0xF, 0xF, false)); }
__device__ __forceinline__ float wave_sum(float v) {
#pragma unroll
    for (int o = 1; o < 64; o <<= 1) v += __shfl_xor(v, o);
    return v;
}
typedef long i64_t;
__device__ __forceinline__ u32x2 pack8_fp8(const f32x4 a, const f32x4 b) {
    unsigned lo = 0u, hi = 0u;
    lo = __builtin_amdgcn_cvt_pk_fp8_f32(a[0], a[1], lo, false); lo = __builtin_amdgcn_cvt_pk_fp8_f32(a[2], a[3], lo, true);
    hi = __builtin_amdgcn_cvt_pk_fp8_f32(b[0], b[1], hi, false); hi = __builtin_amdgcn_cvt_pk_fp8_f32(b[2], b[3], hi, true);
    return (u32x2){lo, hi};
}
__device__ __forceinline__ u32x4 pack8(const f32x4 a, const f32x4 b) { u32x4 w; w.x = cvt_pk_bf16(a[0], a[1]); w.y = cvt_pk_bf16(a[2], a[3]); w.z = cvt_pk_bf16(b[0], b[1]); w.w = cvt_pk_bf16(b[2], b[3]); return w; }

namespace pg8 {
constexpr int BM = 256, BK = 64, HALF = 128, HTB = HALF * BK * 2, STAGE_BYTES = 8 * HTB, NXCD = 8, WGM = 8;
__host__ __device__ __forceinline__ int lds_byte(int r, int c) { const int st = (r >> 4) * 2 + (c >> 5), rr = r & 15, cc = c & 31, ob = rr * 64 + cc * 2; return st * 1024 + (ob ^ (((ob >> 9) & 1) << 5)); }
__host__ __device__ __forceinline__ void stage_rc(int b, int& R, int& C) { const int st = b / 1024, sb = b % 1024, swz = sb ^ (((sb >> 9) & 1) << 5); R = (st >> 1) * 16 + swz / 64; C = (st & 1) * 32 + (swz % 64) / 2; }
__host__ __device__ __forceinline__ int perm32(int rho) { const int n = rho >> 4, i = rho & 15; return 8 * (i >> 2) + 4 * n + (i & 3); }
struct Unit { int pm, pn; };
struct Gemm { const bf16_t* A; const bf16_t* Bt; int M, N, K, lda, ldb; };
struct StaticOrder {
    int nM, nN, nwg, G, c;
    __device__ void init(int M, int N, int G_, int c_) { nM = M / BM; nN = N / BM; nwg = nM * nN; G = G_; c = c_; }
    __device__ bool next(int i, Unit& u) const {
        const long L = (long)i * G + c; if (L >= nwg) return false;
        int wgid = (int)L; { const int q = nwg / NXCD, r = nwg % NXCD, xcd = wgid % NXCD, off = wgid / NXCD; wgid = (xcd < r ? xcd * (q + 1) : r * (q + 1) + (xcd - r) * q) + off; }
        const int nig = WGM * nN, gid = wgid / nig, fm = gid * WGM, gsz = (nM - fm) < WGM ? (nM - fm) : WGM;
        u.pm = fm + ((wgid % nig) % gsz); u.pn = (wgid % nig) / gsz; return true;
    }
};
typedef f32x4 Acc[2][2][4][2];

template <class Epi>
__device__ __forceinline__ void gemm_phase(LAS unsigned char* lds, const Gemm g, const StaticOrder& S_, const Epi& E, const int tid) {
    const int wid = __builtin_amdgcn_readfirstlane(tid >> 6), lane = tid & 63, wr = wid >> 2, wc = wid & 3, fr = lane & 15, fq = lane >> 4;
    const int K = g.K, nt = K / BK;
    unsigned voffA[2], voffB[2];
#pragma unroll
    for (int i = 0; i < 2; ++i) { int R, C; stage_rc(tid * 16 + i * 8192, R, C); const int Rb = Epi::PERM ? ((R & ~31) + perm32(R & 31)) : R;
        voffA[i] = (unsigned)(R * g.lda + C) * 2u; voffB[i] = (unsigned)(Rb * g.ldb + C) * 2u; }
    const size_t kstep = (size_t)(BK * 2);
    const size_t hstepA = (size_t)HALF * g.lda * 2, hstepB = (size_t)HALF * g.ldb * 2;
    const size_t tstepA = 2 * hstepA, tstepB = 2 * hstepB;
    const unsigned ldsw = (unsigned)wid * 1024u;
    const int aoff = lds_byte(wr * 64 + fr, fq * 8), boff = lds_byte(wc * 32 + fr, fq * 8);
#define PG8_SA(b, h) (((b) * 2 + (h)) * HTB)
#define PG8_SB(b, h) ((4 + (b) * 2 + (h)) * HTB)
#define PG8_STAGE(bufoff, gbase, voff) do { _Pragma("unroll") for (int _i = 0; _i < 2; ++_i) \
        __builtin_amdgcn_global_load_lds((const unsigned*)((const char*)(gbase) + (voff)[_i]), (LAS unsigned*)(lds + (bufoff) + ldsw + _i * 8192), 16, 0, 0); } while (0)
#define PG8_LDA(dst, b, h) do { _Pragma("unroll") for (int m = 0; m < 4; ++m) _Pragma("unroll") for (int k = 0; k < 2; ++k) dst[m][k] = *(const LAS bf16x8*)(lds + PG8_SA(b, h) + aoff + m * 2048 + k * 1024); } while (0)
#define PG8_LDB(dst, b, h) do { _Pragma("unroll") for (int n = 0; n < 2; ++n) _Pragma("unroll") for (int k = 0; k < 2; ++k) dst[n][k] = *(const LAS bf16x8*)(lds + PG8_SB(b, h) + boff + n * 2048 + k * 1024); } while (0)
#define PG8_MMA(ai, bj, At, Bt) do { __builtin_amdgcn_s_setprio(1); _Pragma("unroll") for (int m = 0; m < 4; ++m) _Pragma("unroll") for (int n = 0; n < 2; ++n) _Pragma("unroll") for (int k = 0; k < 2; ++k) \
        acc[ai][bj][m][n] = __builtin_amdgcn_mfma_f32_16x16x32_bf16(Bt[n][k], At[m][k], acc[ai][bj][m][n], 0, 0, 0); __builtin_amdgcn_s_setprio(0); } while (0)
#define PG8_WAIT_V(n) asm volatile("s_waitcnt vmcnt(" #n ")" ::: "memory")
#define PG8_WAIT_L(n) asm volatile("s_waitcnt lgkmcnt(" #n ")" ::: "memory")
#define PG8_BAR __builtin_amdgcn_s_barrier()
#define PG8_SCHED __builtin_amdgcn_sched_barrier(0)
    Unit cur, nxt; int ui = 0;
    if (!S_.next(0, cur)) return;
    Acc acc;
#pragma unroll
    for (int a = 0; a < 2; ++a)
#pragma unroll
        for (int b = 0; b < 2; ++b)
#pragma unroll
            for (int m = 0; m < 4; ++m)
#pragma unroll
                for (int n = 0; n < 2; ++n) acc[a][b][m][n] = (f32x4){0.f, 0.f, 0.f, 0.f};
    bf16x8 At[4][2], B0[2][2], B1[2][2];
    const char* cA = (const char*)g.A + (size_t)cur.pm * tstepA; const char* cB = (const char*)g.Bt + (size_t)cur.pn * tstepB;
    PG8_STAGE(PG8_SB(0, 0), cB, voffB); PG8_STAGE(PG8_SB(0, 1), cB + hstepB, voffB); PG8_STAGE(PG8_SA(0, 0), cA, voffA); PG8_STAGE(PG8_SA(0, 1), cA + hstepA, voffA);
    if (wr == 1) PG8_BAR;
    PG8_WAIT_V(2); PG8_BAR;
    PG8_STAGE(PG8_SB(1, 0), cB + kstep, voffB); PG8_STAGE(PG8_SA(1, 0), cA + kstep, voffA); PG8_STAGE(PG8_SB(1, 1), cB + hstepB + kstep, voffB);
    PG8_WAIT_V(6); PG8_BAR;
    for (;;) {
        const bool has_next = S_.next(ui + 1, nxt);
        const char* nA = has_next ? (const char*)g.A + (size_t)nxt.pm * tstepA : cA; const char* nB = has_next ? (const char*)g.Bt + (size_t)nxt.pn * tstepB : cB;
        for (int t = 0; t < nt; t += 2) {
            const bool last = (t == nt - 2);
            const char* a1 = cA + (size_t)(t + 1) * kstep;
            const char* a2 = last ? nA : cA + (size_t)(t + 2) * kstep; const char* b2 = last ? nB : cB + (size_t)(t + 2) * kstep;
            const char* a3 = a2 + kstep; const char* b3 = b2 + kstep;
            PG8_LDB(B0, 0, 0); PG8_LDB(B1, 0, 1); PG8_SCHED; PG8_LDA(At, 0, 0); PG8_STAGE(PG8_SA(1, 1), a1 + hstepA, voffA);
            PG8_WAIT_V(8); PG8_WAIT_L(0); PG8_BAR; PG8_MMA(0, 0, At, B0); PG8_MMA(0, 1, At, B1); PG8_BAR; PG8_SCHED;
            PG8_LDA(At, 0, 1); PG8_STAGE(PG8_SB(0, 0), b2, voffB); PG8_STAGE(PG8_SB(0, 1), b2 + hstepB, voffB); PG8_STAGE(PG8_SA(0, 0), a2, voffA);
            PG8_WAIT_V(8); PG8_WAIT_L(0); PG8_BAR; PG8_MMA(1, 0, At, B0); PG8_MMA(1, 1, At, B1); PG8_BAR; PG8_SCHED;
            PG8_LDB(B0, 1, 0); PG8_LDB(B1, 1, 1); PG8_SCHED; PG8_LDA(At, 1, 0); PG8_STAGE(PG8_SA(0, 1), a2 + hstepA, voffA);
            PG8_WAIT_V(8); PG8_WAIT_L(0); PG8_BAR; PG8_MMA(0, 0, At, B0); PG8_MMA(0, 1, At, B1); PG8_BAR; PG8_SCHED;
            PG8_LDA(At, 1, 1); PG8_STAGE(PG8_SB(1, 0), b3, voffB); PG8_STAGE(PG8_SB(1, 1), b3 + hstepB, voffB); PG8_STAGE(PG8_SA(1, 0), a3, voffA);
            PG8_WAIT_V(8); PG8_WAIT_L(0); PG8_BAR; PG8_MMA(1, 0, At, B0); PG8_MMA(1, 1, At, B1); PG8_BAR; PG8_SCHED;
        }
        if (wr == 0) PG8_BAR;
        E(acc, cur, wr, wc, fr, fq);
        if (!has_next) break;
#pragma unroll
        for (int a = 0; a < 2; ++a)
#pragma unroll
            for (int b = 0; b < 2; ++b)
#pragma unroll
                for (int m = 0; m < 4; ++m)
#pragma unroll
                    for (int n = 0; n < 2; ++n) acc[a][b][m][n] = (f32x4){0.f, 0.f, 0.f, 0.f};
        cur = nxt; cA = nA; cB = nB; ++ui;
        if (wr == 1) PG8_BAR;
    }
    PG8_WAIT_V(0);
    PG8_BAR;
#undef PG8_SA
#undef PG8_SB
#undef PG8_STAGE
#undef PG8_LDA
#undef PG8_LDB
#undef PG8_MMA
#undef PG8_WAIT_V
#undef PG8_WAIT_L
#undef PG8_BAR
#undef PG8_SCHED
}
}

struct EpiSwiglu {
    static constexpr bool PERM = true;
    bf16_t* O;
    __device__ __forceinline__ void operator()(const pg8::Acc& acc, const pg8::Unit& u, int wr, int wc, int fr, int fq) const {
        const int row0 = u.pm * 256 + wr * 64 + fr, col0 = u.pn * 128 + wc * 32 + 8 * fq;
#pragma unroll
        for (int ai = 0; ai < 2; ++ai)
#pragma unroll
            for (int m = 0; m < 4; ++m) {
                f32x4 v[2];
#pragma unroll
                for (int n = 0; n < 2; ++n)
#pragma unroll
                    for (int e = 0; e < 4; ++e) { const float gt = acc[ai][0][m][n][e], up = acc[ai][1][m][n][e]; v[n][e] = gt * fsigmoid(gt) * up; }
                *(u32x4*)(O + (size_t)(row0 + ai * 128 + m * 16) * FF + col0) = pack8(v[0], v[1]);
            }
    }
};
struct EpiResF32 {
    static constexpr bool PERM = false;
    const float* res; float* out; float a, b;
    __device__ __forceinline__ void operator()(const pg8::Acc& acc, const pg8::Unit& u, int wr, int wc, int fr, int fq) const {
        const int row0 = u.pm * 256 + wr * 64 + fr, col0 = u.pn * 256 + wc * 32 + 4 * fq;
#pragma unroll
        for (int ai = 0; ai < 2; ++ai)
#pragma unroll
            for (int m = 0; m < 4; ++m) {
                const size_t off = (size_t)(row0 + ai * 128 + m * 16) * DM + col0;
#pragma unroll
                for (int bj = 0; bj < 2; ++bj)
#pragma unroll
                    for (int n = 0; n < 2; ++n) { const f32x4 r = *(const f32x4*)(res + off + bj * 128 + n * 16); *(f32x4*)(out + off + bj * 128 + n * 16) = r * a + acc[ai][bj][m][n] * b; }
            }
    }
};
struct EpiResLnF32 {
    static constexpr bool PERM = false;
    const float* pre; const float* stats; const float* g; const float* beta; float* out; float a, b;
    __device__ __forceinline__ void operator()(const pg8::Acc& acc, const pg8::Unit& u, int wr, int wc, int fr, int fq) const {
        const int row0 = u.pm * 256 + wr * 64 + fr, col0 = u.pn * 256 + wc * 32 + 4 * fq;
#pragma unroll
        for (int ai = 0; ai < 2; ++ai)
#pragma unroll
            for (int m = 0; m < 4; ++m) {
                const int row = row0 + ai * 128 + m * 16; const size_t off = (size_t)row * DM + col0;
                const f32x2 st = *(const f32x2*)(stats + 2 * (size_t)row);
#pragma unroll
                for (int bj = 0; bj < 2; ++bj)
#pragma unroll
                    for (int n = 0; n < 2; ++n) { const int co = bj * 128 + n * 16;
                        const f32x4 r = *(const f32x4*)(pre + off + co), gv = *(const f32x4*)(g + col0 + co), bv = *(const f32x4*)(beta + col0 + co);
                        const f32x4 h = (r - st.x) * st.y * gv + bv;
                        *(f32x4*)(out + off + co) = h * a + acc[ai][bj][m][n] * b; }
                if (m & 1) asm volatile("" ::: "memory");
            }
    }
};
struct EpiWin {
    static constexpr bool PERM = true;
    bf16_t* proj; bf16_t* sigg; bf16_t* gn; const float* cs; bf16_t* kslf; bf16_t* kbf;
    __device__ __forceinline__ void operator()(const pg8::Acc& acc, const pg8::Unit& u, int wr, int wc, int fr, int fq) const {
        const int tile = u.pn, row0 = u.pm * 256 + wr * 64 + fr, cw = wc * 32 + 8 * fq;
        if (tile < 28) {
            const bool rope = (tile == 6) | (tile == 8) | (tile >= 10 && tile < 22);
            const int dcol = (tile < 6 ? tile : tile - 4) * 256;
            if (!rope) {
                if (tile == 7 || tile == 9) {
                    unsigned char* VF = (unsigned char*)kslf + (tile == 7 ? (size_t)8 << 20 : (size_t)24 << 20);
#pragma unroll
                    for (int ai = 0; ai < 2; ++ai)
#pragma unroll
                        for (int m = 0; m < 4; ++m) {
                            const int row = row0 + ai * 128 + m * 16, kp = row & 31;
                            const size_t rbase = (size_t)(row >> 5) * 4096 + (size_t)(((kp >> 2) & 3) * 16) * 8 + 4 * (kp >> 4) + (kp & 3);
#pragma unroll
                            for (int bj = 0; bj < 2; ++bj) {
                                const u32x2 w = pack8_fp8(acc[ai][bj][m][0], acc[ai][bj][m][1]);
                                unsigned char* vb = VF + (size_t)bj * 512 * 4096 + rbase + (size_t)(cw >> 4) * 512 + (size_t)(cw & 15) * 8;
                                vb[0] = (unsigned char)(w.x & 0xffu); vb[8] = (unsigned char)((w.x >> 8) & 0xffu); vb[16] = (unsigned char)((w.x >> 16) & 0xffu); vb[24] = (unsigned char)(w.x >> 24);
                                vb[32] = (unsigned char)(w.y & 0xffu); vb[40] = (unsigned char)((w.y >> 8) & 0xffu); vb[48] = (unsigned char)((w.y >> 16) & 0xffu); vb[56] = (unsigned char)(w.y >> 24);
                            }
                        }
                } else if (tile >= 22) {
                    bf16_t* VB = kbf + ((size_t)24 << 20);
#pragma unroll
                    for (int ai = 0; ai < 2; ++ai)
#pragma unroll
                        for (int m = 0; m < 4; ++m) {
                            const int row = row0 + ai * 128 + m * 16;
#pragma unroll
                            for (int bj = 0; bj < 2; ++bj) {
                                const int hd = 2 * (tile - 22) + bj, sh = 2 * (hd >> 2), tp = ((row & ((1 << sh) - 1)) << (14 - sh)) + (row >> sh), kp = tp & 31;
                                const u32x4 w = pack8(acc[ai][bj][m][0], acc[ai][bj][m][1]);
                                bf16_t* vb = VB + (((size_t)hd * 512 + (tp >> 5)) * 8 + (cw >> 4)) * 512 + (size_t)(((kp >> 2) & 3) * 16 + (cw & 15)) * 8 + 4 * (kp >> 4) + (kp & 3);
                                vb[0] = (bf16_t)(w.x & 0xffffu); vb[8] = (bf16_t)(w.x >> 16); vb[16] = (bf16_t)(w.y & 0xffffu); vb[24] = (bf16_t)(w.y >> 16);
                                vb[32] = (bf16_t)(w.z & 0xffffu); vb[40] = (bf16_t)(w.z >> 16); vb[48] = (bf16_t)(w.w & 0xffffu); vb[56] = (bf16_t)(w.w >> 16);
                            }
                        }
                } else {
#pragma unroll
                    for (int ai = 0; ai < 2; ++ai)
#pragma unroll
                        for (int m = 0; m < 4; ++m)
#pragma unroll
                            for (int bj = 0; bj < 2; ++bj)
                                *(u32x4*)(proj + (size_t)(row0 + ai * 128 + m * 16) * PLD + dcol + bj * 128 + cw) = pack8(acc[ai][bj][m][0], acc[ai][bj][m][1]);
                }
            } else {
                const int head = cw >> 6, d = cw & 63;
                const bool frag = (tile == 6) | (tile == 8);
                unsigned char* KF = (unsigned char*)kslf + (tile == 6 ? (size_t)0 : (size_t)16 << 20); const float* sn = cs + (size_t)S * 64;
#pragma unroll
                for (int ai = 0; ai < 2; ++ai)
#pragma unroll
                    for (int m = 0; m < 4; ++m) {
                        const int row = row0 + ai * 128 + m * 16;
                        f32x4 o1[2], o2[2];
#pragma unroll
                        for (int n = 0; n < 2; ++n) {
                            const f32x4 c = *(const f32x4*)(cs + (size_t)row * 64 + d + 4 * n), sv = *(const f32x4*)(sn + (size_t)row * 64 + d + 4 * n);
                            const f32x4 x1 = acc[ai][0][m][n], x2 = acc[ai][1][m][n];
                            o1[n] = x1 * c - x2 * sv; o2[n] = x2 * c + x1 * sv;
                        }
                        if (frag) {
                            unsigned char* kb = KF + ((size_t)head * 1024 + (row >> 4)) * 2048 + (size_t)(d >> 5) * 512 + (size_t)(((d >> 3) & 3) * 16 + (row & 15)) * 8;
                            *(u32x2*)kb = pack8_fp8(o1[0], o1[1]); *(u32x2*)(kb + 1024) = pack8_fp8(o2[0], o2[1]);
                        } else if (tile >= 16) {
                            const int hd = 2 * (tile - 16) + head, sh = 2 * (hd >> 2), tp = ((row & ((1 << sh) - 1)) << (14 - sh)) + (row >> sh);
                            bf16_t* kb = kbf + ((size_t)hd * 1024 + (tp >> 4)) * 2048 + (size_t)(d >> 5) * 512 + (size_t)(((d >> 3) & 3) * 16 + (tp & 15)) * 8;
                            *(u32x4*)kb = pack8(o1[0], o1[1]); *(u32x4*)(kb + 1024) = pack8(o2[0], o2[1]);
                        } else {
                            bf16_t* p = proj + (size_t)row * PLD + dcol + head * 128 + d;
                            *(u32x4*)p = pack8(o1[0], o1[1]); *(u32x4*)(p + 64) = pack8(o2[0], o2[1]);
                        }
                        if (m & 1) asm volatile("" ::: "memory");
                    }
            }
        } else if (tile < 44) {
#pragma unroll
            for (int ai = 0; ai < 2; ++ai)
#pragma unroll
                for (int m = 0; m < 4; ++m)
#pragma unroll
                    for (int bj = 0; bj < 2; ++bj) {
                        f32x4 v[2];
#pragma unroll
                        for (int n = 0; n < 2; ++n)
#pragma unroll
                            for (int e = 0; e < 4; ++e) v[n][e] = fsigmoid(acc[ai][bj][m][n][e]);
                        *(u32x4*)(sigg + (size_t)(row0 + ai * 128 + m * 16) * 4096 + (tile - 28) * 256 + bj * 128 + cw) = pack8(v[0], v[1]);
                    }
        } else {
            if (wc == 0) {
#pragma unroll
                for (int ai = 0; ai < 2; ++ai)
#pragma unroll
                    for (int m = 0; m < 4; ++m) {
                        f32x4 v[2];
#pragma unroll
                        for (int n = 0; n < 2; ++n)
#pragma unroll
                            for (int e = 0; e < 4; ++e) v[n][e] = fsigmoid(acc[ai][0][m][n][e]);
                        *(u32x4*)(gn + (size_t)(row0 + ai * 128 + m * 16) * 32 + cw) = pack8(v[0], v[1]);
                    }
            }
        }
    }
};
template <bool FIRST> struct EpiGate {
    static constexpr bool PERM = true;
    const bf16_t* sg; bf16_t* O;
    __device__ __forceinline__ void operator()(const pg8::Acc& acc, const pg8::Unit& u, int wr, int wc, int fr, int fq) const {
        const int row0 = u.pm * 256 + wr * 64 + fr, col0 = u.pn * 256 + wc * 32 + 8 * fq;
#pragma unroll
        for (int ai = 0; ai < 2; ++ai)
#pragma unroll
            for (int m = 0; m < 4; ++m)
#pragma unroll
                for (int bj = 0; bj < 2; ++bj) {
                    const int row = row0 + ai * 128 + m * 16, col = col0 + bj * 128;
                    const u32x4 gv = *(const u32x4*)(sg + (size_t)row * 4096 + col);
                    u32x4 pv = (u32x4){0u, 0u, 0u, 0u}; if (!FIRST) pv = *(const u32x4*)(O + (size_t)row * DM + col);
                    f32x4 v[2];
#pragma unroll
                    for (int n = 0; n < 2; ++n) {
                        const unsigned g0 = n ? gv.z : gv.x, g1 = n ? gv.w : gv.y, p0 = n ? pv.z : pv.x, p1 = n ? pv.w : pv.y;
                        const f32x4 y = acc[ai][bj][m][n];
                        v[n][0] = bflo(p0) + bflo(g0) * y[0]; v[n][1] = bfhi(p0) + bfhi(g0) * y[1];
                        v[n][2] = bflo(p1) + bflo(g1) * y[2]; v[n][3] = bfhi(p1) + bfhi(g1) * y[3];
                    }
                    *(u32x4*)(O + (size_t)row * DM + col) = pack8(v[0], v[1]);
                }
    }
};

template <bool FRAG = false>
__device__ __forceinline__ void tr_item(const float* W, int ldw, int k0, int scol0, int nvalid, bf16_t* WT, int ldt, int drow0, int dk0, LAS float* scr, int lane) {
    const int c = lane & 31;
    float v[32];
#pragma unroll
    for (int i = 0; i < 32; ++i) { const int kk = 2 * i + (lane >> 5); v[i] = (c < nvalid) ? W[(size_t)(k0 + kk) * ldw + scol0 + c] : 0.f; }
#pragma unroll
    for (int i = 0; i < 32; ++i) { const int kk = 2 * i + (lane >> 5); scr[kk * 33 + c] = v[i]; }
    asm volatile("s_waitcnt lgkmcnt(0)" ::: "memory");
    const int c8 = lane & 7;
#pragma unroll
    for (int j = 0; j < 4; ++j) { const int n = (lane >> 3) + 8 * j; const LAS float* s = scr + (8 * c8) * 33 + n;
        u32x4 o; o.x = cvt_pk_bf16(s[0 * 33], s[1 * 33]); o.y = cvt_pk_bf16(s[2 * 33], s[3 * 33]); o.z = cvt_pk_bf16(s[4 * 33], s[5 * 33]); o.w = cvt_pk_bf16(s[6 * 33], s[7 * 33]);
        if (FRAG) { const int c = drow0 + n, k = dk0 + 8 * c8; *(u32x4*)(WT + ((size_t)((c >> 4) * (ldt >> 5) + (k >> 5)) * 64 + ((k >> 3) & 3) * 16 + (c & 15)) * 8) = o; }
        else *(u32x4*)(WT + (size_t)(drow0 + n) * ldt + dk0 + 8 * c8) = o; }
    asm volatile("s_waitcnt lgkmcnt(0)" ::: "memory");
}
struct TrP { const float* W; int ldw, k0, scol0, nvalid; bf16_t* WT; int ldt, drow0, dk0; };
__device__ __forceinline__ void tr_load(float (&v)[32], const TrP& q, int lane) {
    const int c = lane & 31;
#pragma unroll
    for (int i = 0; i < 32; ++i) { const int kk = 2 * i + (lane >> 5); v[i] = (c < q.nvalid) ? q.W[(size_t)(q.k0 + kk) * q.ldw + q.scol0 + c] : 0.f; }
}
__device__ __forceinline__ void tr_store(const float (&v)[32], const TrP& q, LAS float* scr, int lane) {
    const int c = lane & 31;
#pragma unroll
    for (int i = 0; i < 32; ++i) { const int kk = 2 * i + (lane >> 5); scr[kk * 33 + c] = v[i]; }
    asm volatile("s_waitcnt lgkmcnt(0)" ::: "memory");
    const int c8 = lane & 7;
#pragma unroll
    for (int j = 0; j < 4; ++j) { const int n = (lane >> 3) + 8 * j; const LAS float* s = scr + (8 * c8) * 33 + n;
        u32x4 o; o.x = cvt_pk_bf16(s[0 * 33], s[1 * 33]); o.y = cvt_pk_bf16(s[2 * 33], s[3 * 33]); o.z = cvt_pk_bf16(s[4 * 33], s[5 * 33]); o.w = cvt_pk_bf16(s[6 * 33], s[7 * 33]);
        *(u32x4*)(q.WT + (size_t)(q.drow0 + n) * q.ldt + q.dk0 + 8 * c8) = o; }
    asm volatile("s_waitcnt lgkmcnt(0)" ::: "memory");
}
template <class F>
__device__ __forceinline__ void tr_stream(int n, int gw, int ngw, const F& params, LAS float* scr, int lane) {
    int it = gw; if (it >= n) return;
    float va[32], vb[32];
    TrP pa = params(it), pb = pa; tr_load(va, pa, lane);
    for (;;) {
        const int it2 = it + ngw; const bool has2 = it2 < n;
        if (has2) { pb = params(it2); tr_load(vb, pb, lane); }
        tr_store(va, pa, scr, lane);
        if (!has2) break;
        const int it3 = it2 + ngw; const bool has3 = it3 < n;
        if (has3) { pa = params(it3); tr_load(va, pa, lane); }
        tr_store(vb, pb, scr, lane);
        if (!has3) break;
        it = it3;
    }
}
__device__ __forceinline__ int win_src_col(int r) {
    if (r >= WIN_SRC) return -1;
    if (r >= 11264) return 2560 + (r - 11264);
    const int tile = r >> 8; int j = r & 255;
    const bool rope = (tile == 6) | (tile == 8) | (tile >= 10 && tile < 22);
    if (rope) { const int q = j >> 6, d = j & 63; j = (q & 1) * 128 + (q >> 1) * 64 + d; }
    const int c = tile * 256 + j;
    return c < 2560 ? c : c + 24;
}
__device__ __forceinline__ void conv_ffn(const float* Wg, const float* Wu, const float* Wd, bf16_t* GU, bf16_t* DN, LAS float* scr, int gw, int ngw, int lane) {
    constexpr int I_G = 32 * 176;
    tr_stream(2 * I_G, gw, ngw, [&](int it) { const int which = it / I_G, r = it % I_G, kb = r / 176, nb = r % 176, c0 = nb * 32;
        return TrP{which ? Wu : Wg, FF, kb * 64, c0, 32, GU, DM, 256 * (c0 >> 7) + (c0 & 127) + which * 128, kb * 64}; }, scr, lane);
    tr_stream(88 * 64, gw, ngw, [&](int it) { const int kb = it / 64, nb = it % 64; return TrP{Wd, DM, kb * 64, nb * 32, 32, DN, FF, nb * 32, kb * 64}; }, scr, lane);
}
__device__ __forceinline__ void ln_rows(const float* in, float* outf, bf16_t* outb, const float* g, const float* b, int gw, int ngw, int lane, float* stats = nullptr) {
    f32x4 gv[8], bv[8];
#pragma unroll
    for (int j = 0; j < 8; ++j) { gv[j] = *(const f32x4*)(g + 4 * (lane + 64 * j)); bv[j] = *(const f32x4*)(b + 4 * (lane + 64 * j)); }
    for (int row = gw; row < S; row += ngw) {
        const float* xr = in + (size_t)row * DM; f32x4 v[8]; float s = 0.f;
#pragma unroll
        for (int j = 0; j < 8; ++j) { v[j] = *(const f32x4*)(xr + 4 * (lane + 64 * j)); s += (v[j][0] + v[j][1]) + (v[j][2] + v[j][3]); }
        const float mean = wave_sum(s) * (1.f / DM); float s2 = 0.f;
#pragma unroll
        for (int j = 0; j < 8; ++j) { v[j] = v[j] - mean; s2 += (v[j][0] * v[j][0] + v[j][1] * v[j][1]) + (v[j][2] * v[j][2] + v[j][3] * v[j][3]); }
        const float rstd = 1.f / sqrtf(wave_sum(s2) * (1.f / DM) + LN_EPS);
        if (stats && lane == 0) *(f32x2*)(stats + 2 * (size_t)row) = (f32x2){mean, rstd};
#pragma unroll
        for (int j = 0; j < 8; ++j) { const f32x4 o = v[j] * rstd * gv[j] + bv[j];
            if (outf) *(f32x4*)(outf + (size_t)row * DM + 4 * (lane + 64 * j)) = o;
            if (outb) { u32x2 w; w.x = cvt_pk_bf16(o[0], o[1]); w.y = cvt_pk_bf16(o[2], o[3]); *(u32x2*)(outb + (size_t)row * DM + 4 * (lane + 64 * j)) = w; } }
    }
}

struct AState { float m, l; f32x4 o[8]; };
__device__ __forceinline__ void astate_init(AState& s) { s.m = -1e30f; s.l = 0.f;
#pragma unroll
    for (int i = 0; i < 8; ++i) s.o[i] = (f32x4){0.f, 0.f, 0.f, 0.f}; }
__device__ __forceinline__ int clampi(int v, int lo, int hi) { return v < lo ? lo : (v > hi ? hi : v); }

__device__ __forceinline__ void load_k(bf16x8 (&kf)[2][4], const bf16_t* __restrict__ Kb, int ld, int pos0, int dpos, int posmax, int l16, int kq) {
#pragma unroll
    for (int T = 0; T < 2; ++T) { const int p = clampi(pos0 + dpos * (16 * T + l16), 0, posmax); const bf16_t* kp = Kb + (size_t)p * ld + 8 * kq;
#pragma unroll
        for (int s = 0; s < 4; ++s) kf[T][s] = *(const bf16x8*)(kp + 32 * s); }
}
__device__ __forceinline__ void load_v(u32x4 (&vr)[8], const bf16_t* __restrict__ Vb, int ld, int pos0, int dpos, int posmax, int l16, int kq) {
#pragma unroll
    for (int i = 0; i < 8; ++i) { const int p = clampi(pos0 + dpos * (4 * i + kq), 0, posmax); vr[i] = *(const u32x4*)(Vb + (size_t)p * ld + 8 * l16); }
}
__device__ __forceinline__ void store_v(const u32x4 (&vr)[8], LAS unsigned char* vbuf, int l16, int kq) {
#pragma unroll
    for (int i = 0; i < 8; ++i) *(LAS u32x4*)(vbuf + (4 * i + kq) * VROW + 16 * l16) = vr[i];
}
template <int MODE, bool SLC, class Desc>
__device__ __forceinline__ void attn_run(const bf16x8 (&qf)[4], const bf16_t* __restrict__ Kb, const bf16_t* __restrict__ Vb, int ld, int dpos, int posmax,
                                         const Desc& desc, int n, int lo_in, int hi, int qi, AState& st, LAS unsigned char* vbuf, int lane, LAS float* imp = nullptr) {
    if (n <= 0) return;
    const int l16 = lane & 15, kq = lane >> 4;
    u32x4 kr[8];
    int dcur = desc(0);
    load_v(kr, Kb, ld, SLC ? (dcur & 0xfffff) : dcur, dpos, posmax, l16, kq);
#pragma unroll 1
    for (int i = 0; i < n; ++i) {
        const int pos0 = SLC ? (dcur & 0xfffff) : dcur;
        const int lo = SLC ? ((((dcur >> 20) == qi) | ((dcur >> 20) == 4)) ? 0 : (1 << 30)) : lo_in;
        store_v(kr, vbuf, l16, kq);
        u32x4 vr[8];
        if (MODE != 1) load_v(vr, Vb, ld, pos0, dpos, posmax, l16, kq);
        bf16x8 kf[2][4];
#pragma unroll
        for (int T = 0; T < 2; ++T)
#pragma unroll
            for (int s = 0; s < 4; ++s) kf[T][s] = *(const LAS bf16x8*)(vbuf + (16 * T + l16) * VROW + 64 * s + 16 * kq);
        f32x4 sa[2] = {(f32x4){0.f, 0.f, 0.f, 0.f}, (f32x4){0.f, 0.f, 0.f, 0.f}};
#pragma unroll
        for (int T = 0; T < 2; ++T)
#pragma unroll
            for (int s = 0; s < 4; ++s) sa[T] = __builtin_amdgcn_mfma_f32_16x16x32_bf16(kf[T][s], qf[s], sa[T], 0, 0, 0);
        const int dnext = desc(i + 1 < n ? i + 1 : i);
        load_v(kr, Kb, ld, SLC ? (dnext & 0xfffff) : dnext, dpos, posmax, l16, kq);
        float sc[8]; bool vd[8]; float mx = -1e30f;
#pragma unroll
        for (int T = 0; T < 2; ++T)
#pragma unroll
            for (int r = 0; r < 4; ++r) { const int p = pos0 + dpos * (16 * T + 4 * kq + r); const bool v = (p >= lo) & (p <= hi); const float x = sa[T][r] * SL2;
                sc[4 * T + r] = x; vd[4 * T + r] = v; mx = v ? fmaxf(mx, x) : mx; }
        float p[8];
        if (MODE == 2) {
#pragma unroll
            for (int j = 0; j < 8; ++j) p[j] = vd[j] ? __builtin_amdgcn_exp2f(sc[j] - st.m) * st.l : 0.f;
#pragma unroll
            for (int T = 0; T < 2; ++T) {
                float x = 2.f * (p[4 * T] + p[4 * T + 1] + p[4 * T + 2]) + p[4 * T + 3], y = p[4 * T + 3];
                x += quad_xor1(x); x += quad_xor2(x); y += quad_xor1(y); y += quad_xor2(y);
                if ((l16 & 3) == 0) { const int a = (pos0 >> 2) + 4 * T + kq; LAS float* ip = imp + (l16 >> 2) * IMP_LD + a;
                    ip[0] += x;
                    asm volatile("s_waitcnt lgkmcnt(0)" ::: "memory");
                    ip[1] += y; }
                asm volatile("s_waitcnt lgkmcnt(0)" ::: "memory");
            }
        } else {
            if (__builtin_amdgcn_ballot_w64(mx > st.m + 40.f) != 0ull) {
                mx = fmaxf(mx, __shfl_xor(mx, 16)); mx = fmaxf(mx, __shfl_xor(mx, 32));
                const float mn = fmaxf(st.m, mx), alpha = __builtin_amdgcn_exp2f(st.m - mn); st.m = mn; st.l *= alpha;
                if (MODE == 0) {
#pragma unroll
                    for (int j = 0; j < 8; ++j) st.o[j] = st.o[j] * alpha;
                }
            }
            float ps = 0.f;
#pragma unroll
            for (int j = 0; j < 8; ++j) { p[j] = vd[j] ? __builtin_amdgcn_exp2f(sc[j] - st.m) : 0.f; ps += p[j]; }
            st.l += ps;
        }
        if (MODE != 1) {
            store_v(vr, vbuf, l16, kq);
            u32x4 pw; pw.x = cvt_pk_bf16(p[0], p[1]); pw.y = cvt_pk_bf16(p[2], p[3]); pw.z = cvt_pk_bf16(p[4], p[5]); pw.w = cvt_pk_bf16(p[6], p[7]);
            const bf16x8 pf = __builtin_bit_cast(bf16x8, pw);
            const unsigned addr = (unsigned)(uintptr_t)(vbuf) + (4 * kq + (l16 >> 2)) * VROW + (l16 & 3) * 8;
#pragma unroll
            for (int hf = 0; hf < 2; ++hf) {
                s16x4 a[8];
                asm volatile("s_waitcnt lgkmcnt(0)\n\t"
                             "ds_read_b64_tr_b16 %0, %8 offset:0\n\t"    "ds_read_b64_tr_b16 %1, %8 offset:32\n\t"
                             "ds_read_b64_tr_b16 %2, %8 offset:64\n\t"   "ds_read_b64_tr_b16 %3, %8 offset:96\n\t"
                             "ds_read_b64_tr_b16 %4, %8 offset:4608\n\t" "ds_read_b64_tr_b16 %5, %8 offset:4640\n\t"
                             "ds_read_b64_tr_b16 %6, %8 offset:4672\n\t" "ds_read_b64_tr_b16 %7, %8 offset:4704\n\t"
                             "s_waitcnt lgkmcnt(0)"
                             : "=&v"(a[0]), "=&v"(a[1]), "=&v"(a[2]), "=&v"(a[3]), "=&v"(a[4]), "=&v"(a[5]), "=&v"(a[6]), "=&v"(a[7])
                             : "v"(addr + 128 * hf) : "memory");
#pragma unroll
                for (int d4 = 0; d4 < 4; ++d4) { const int db = 4 * hf + d4;
                    bf16x8 af; af[0] = a[d4][0]; af[1] = a[d4][1]; af[2] = a[d4][2]; af[3] = a[d4][3]; af[4] = a[d4 + 4][0]; af[5] = a[d4 + 4][1]; af[6] = a[d4 + 4][2]; af[7] = a[d4 + 4][3];
                    st.o[db] = __builtin_amdgcn_mfma_f32_16x16x32_bf16(af, pf, st.o[db], 0, 0, 0); }
            }
        }
        dcur = dnext;
    }
}
struct FragV { bf16x8 v[8]; };
__device__ __forceinline__ void load_fk(bf16x8 (&k)[2][4], const bf16_t* __restrict__ KF, int pos0, int lane) {
    const bf16_t* kp = KF + ((size_t)(pos0 >> 4) * 256 + lane) * 8;
#pragma unroll
    for (int T = 0; T < 2; ++T)
#pragma unroll
        for (int s2 = 0; s2 < 4; ++s2) k[T][s2] = *(const bf16x8*)(kp + (T * 4 + s2) * 512);
}
__device__ __forceinline__ void load_fv(FragV& f, const bf16_t* __restrict__ VF, int pos0, int lane) {
    const bf16_t* vp = VF + ((size_t)(pos0 >> 5) * 512 + lane) * 8;
#pragma unroll
    for (int db = 0; db < 8; ++db) f.v[db] = *(const bf16x8*)(vp + db * 512);
}
template <int MODE>
__device__ __forceinline__ void step_fragb(const bf16x8 (&qf)[4], bf16x8 (&kf)[2][4], FragV& cur, const bf16_t* __restrict__ KF, const bf16_t* __restrict__ VF,
                                           int pos0, int pnext, int lo, int hi, AState& st, int lane, LAS float* imp) {
    const int kq = lane >> 4;
    f32x4 sa[2] = {(f32x4){0.f, 0.f, 0.f, 0.f}, (f32x4){0.f, 0.f, 0.f, 0.f}};
#pragma unroll
    for (int T = 0; T < 2; ++T)
#pragma unroll
        for (int s2 = 0; s2 < 4; ++s2) sa[T] = __builtin_amdgcn_mfma_f32_16x16x32_bf16(kf[T][s2], qf[s2], sa[T], 0, 0, 0);
    load_fk(kf, KF, pnext, lane);
    float sc[8]; bool vd[8]; float mx = -1e30f;
#pragma unroll
    for (int T = 0; T < 2; ++T)
#pragma unroll
        for (int r = 0; r < 4; ++r) { const int p = pos0 + 16 * T + 4 * kq + r; const bool v = (p >= lo) & (p <= hi); const float x = sa[T][r] * SL2;
            sc[4 * T + r] = x; vd[4 * T + r] = v; mx = v ? fmaxf(mx, x) : mx; }
    float p[8];
    if (MODE == 2) {
        const int l16 = lane & 15;
#pragma unroll
        for (int j = 0; j < 8; ++j) p[j] = vd[j] ? __builtin_amdgcn_exp2f(sc[j] - st.m) * st.l : 0.f;
#pragma unroll
        for (int T = 0; T < 2; ++T) {
            float x = 2.f * (p[4 * T] + p[4 * T + 1] + p[4 * T + 2]) + p[4 * T + 3], y = p[4 * T + 3];
            x += quad_xor1(x); x += quad_xor2(x); y += quad_xor1(y); y += quad_xor2(y);
            if ((l16 & 3) == 0) { const int a = (pos0 >> 2) + 4 * T + kq; LAS float* ip = imp + (l16 >> 2) * IMP_LD + a;
                ip[0] += x;
                asm volatile("s_waitcnt lgkmcnt(0)" ::: "memory");
                ip[1] += y; }
            asm volatile("s_waitcnt lgkmcnt(0)" ::: "memory");
        }
    } else {
        if (__builtin_amdgcn_ballot_w64(mx > st.m + 40.f) != 0ull) {
            mx = fmaxf(mx, __shfl_xor(mx, 16)); mx = fmaxf(mx, __shfl_xor(mx, 32));
            const float mn = fmaxf(st.m, mx), alpha = __builtin_amdgcn_exp2f(st.m - mn); st.m = mn; st.l *= alpha;
            if (MODE == 0) {
#pragma unroll
                for (int j = 0; j < 8; ++j) st.o[j] = st.o[j] * alpha;
            }
        }
        float ps = 0.f;
#pragma unroll
        for (int j = 0; j < 8; ++j) { p[j] = vd[j] ? __builtin_amdgcn_exp2f(sc[j] - st.m) : 0.f; ps += p[j]; }
        st.l += ps;
    }
    if (MODE != 1) {
        u32x4 pw; pw.x = cvt_pk_bf16(p[0], p[1]); pw.y = cvt_pk_bf16(p[2], p[3]); pw.z = cvt_pk_bf16(p[4], p[5]); pw.w = cvt_pk_bf16(p[6], p[7]);
        const bf16x8 pf = __builtin_bit_cast(bf16x8, pw);
#pragma unroll
        for (int db = 0; db < 8; ++db) st.o[db] = __builtin_amdgcn_mfma_f32_16x16x32_bf16(cur.v[db], pf, st.o[db], 0, 0, 0);
        load_fv(cur, VF, pnext, lane);
    }
}
template <int MODE, bool SLC, class Desc>
__device__ __forceinline__ void attn_run_frag(const bf16x8 (&qf)[4], const bf16_t* __restrict__ KF, const bf16_t* __restrict__ VF, const Desc& desc, int n,
                                              int lo_in, int hi, int qi, AState& st, int lane, LAS float* imp = nullptr) {
    static_assert(!SLC, "the bf16 fragment walk is used without per-step query selection");
    if (n <= 0) return;
    bf16x8 kf[2][4]; FragV va;
    int d0 = desc(0);
    load_fk(kf, KF, d0, lane);
    if (MODE != 1) load_fv(va, VF, d0, lane);
#pragma unroll 1
    for (int i = 0; i < n; ++i) {
        const int d1 = desc(i + 1 < n ? i + 1 : i);
        step_fragb<MODE>(qf, kf, va, KF, VF, d0, d1, lo_in, hi, st, lane, imp);
        d0 = d1;
    }
}
struct Frag8 { i64_t k[2][4]; i64_t v[8]; };
__device__ __forceinline__ void load_frag8(Frag8& f, const unsigned char* __restrict__ KF, const unsigned char* __restrict__ VF, int pos0, int lane) {
    const unsigned char* kp = KF + ((size_t)(pos0 >> 4) * 256 + lane) * 8; const unsigned char* vp = VF + ((size_t)(pos0 >> 5) * 512 + lane) * 8;
#pragma unroll
    for (int T = 0; T < 2; ++T)
#pragma unroll
        for (int s2 = 0; s2 < 4; ++s2) f.k[T][s2] = *(const i64_t*)(kp + (T * 4 + s2) * 512);
#pragma unroll
    for (int db = 0; db < 8; ++db) f.v[db] = *(const i64_t*)(vp + db * 512);
}
template <bool SLC, bool NOMASK>
__device__ __forceinline__ void step_frag8(const i64_t (&qf)[4], const Frag8& cur, Frag8& nxt, const unsigned char* __restrict__ KF, const unsigned char* __restrict__ VF,
                                           int dcur, int dnext, int lo_in, int hi, int qi, AState& st, int lane) {
    const int kq = lane >> 4;
    const int pos0 = SLC ? (dcur & 0xfffff) : dcur;
    const int lo = SLC ? ((((dcur >> 20) == qi) | ((dcur >> 20) == 4)) ? 0 : (1 << 30)) : lo_in;
    load_frag8(nxt, KF, VF, SLC ? (dnext & 0xfffff) : dnext, lane);
    f32x4 sa[2] = {(f32x4){0.f, 0.f, 0.f, 0.f}, (f32x4){0.f, 0.f, 0.f, 0.f}};
#pragma unroll
    for (int T = 0; T < 2; ++T)
#pragma unroll
        for (int s2 = 0; s2 < 4; ++s2) sa[T] = __builtin_amdgcn_mfma_f32_16x16x32_fp8_fp8(cur.k[T][s2], qf[s2], sa[T], 0, 0, 0);
    float sc[8]; bool vd[8]; float mx = -1e30f;
    const bool act = lo == 0 || !SLC;
    if (NOMASK) {
#pragma unroll
        for (int j = 0; j < 8; ++j) { sc[j] = sa[j >> 2][j & 3]; vd[j] = act; }
        mx = fmaxf(fmaxf(fmaxf(sc[0], sc[1]), fmaxf(sc[2], sc[3])), fmaxf(fmaxf(sc[4], sc[5]), fmaxf(sc[6], sc[7])));
        mx = act ? mx : -1e30f;
    } else {
#pragma unroll
        for (int T = 0; T < 2; ++T)
#pragma unroll
            for (int r = 0; r < 4; ++r) { const int p = pos0 + 16 * T + 4 * kq + r; const bool v = (p >= lo) & (p <= hi); const float x = sa[T][r];
                sc[4 * T + r] = x; vd[4 * T + r] = v; mx = v ? fmaxf(mx, x) : mx; }
    }
    if (__builtin_amdgcn_ballot_w64(mx > st.m + 4.f) != 0ull) {
        mx = fmaxf(mx, __shfl_xor(mx, 16)); mx = fmaxf(mx, __shfl_xor(mx, 32));
        const float mn = fmaxf(st.m, mx), alpha = __builtin_amdgcn_exp2f(st.m - mn); st.m = mn; st.l *= alpha;
#pragma unroll
        for (int j = 0; j < 8; ++j) st.o[j] = st.o[j] * alpha;
    }
    f32x4 pa, pb; float ps = 0.f;
    const float mref = st.m - 4.f;
    if (NOMASK) {
#pragma unroll
        for (int j = 0; j < 4; ++j) { pa[j] = __builtin_amdgcn_exp2f(sc[j] - mref); pb[j] = __builtin_amdgcn_exp2f(sc[4 + j] - mref); }
        if (SLC) {
#pragma unroll
            for (int j = 0; j < 4; ++j) { pa[j] = act ? pa[j] : 0.f; pb[j] = act ? pb[j] : 0.f; }
        }
#pragma unroll
        for (int j = 0; j < 4; ++j) ps += pa[j] + pb[j];
    } else {
#pragma unroll
        for (int j = 0; j < 4; ++j) { pa[j] = vd[j] ? __builtin_amdgcn_exp2f(sc[j] - mref) : 0.f; pb[j] = vd[4 + j] ? __builtin_amdgcn_exp2f(sc[4 + j] - mref) : 0.f; ps += pa[j] + pb[j]; }
    }
    st.l += ps;
    const u32x2 pw = pack8_fp8(pa, pb);
    const i64_t pf = __builtin_bit_cast(i64_t, pw);
#pragma unroll
    for (int db = 0; db < 8; ++db) st.o[db] = __builtin_amdgcn_mfma_f32_16x16x32_fp8_fp8(cur.v[db], pf, st.o[db], 0, 0, 0);
}
template <bool SLC, class Desc>
__device__ __forceinline__ void attn_run_frag8(const i64_t (&qf)[4], const unsigned char* __restrict__ KF, const unsigned char* __restrict__ VF, const Desc& desc, int n,
                                               int lo_in, int hi, int qi, AState& st, int lane) {
    if (n <= 0) return;
    Frag8 fa, fb, fc;
    constexpr int NM = ~(1 << 30);
    int d0 = desc(0), d1 = desc(n > 1 ? 1 : 0);
    load_frag8(fa, KF, VF, SLC ? (d0 & 0xfffff) : (d0 & NM), lane);
    load_frag8(fb, KF, VF, SLC ? (d1 & 0xfffff) : (d1 & NM), lane);
#define F8_STEP(CUR, NXT2, DC, DN2) do { \
        if ((DC) & (1 << 30)) step_frag8<SLC, true>(qf, CUR, NXT2, KF, VF, (DC) & NM, (DN2) & NM, lo_in, hi, qi, st, lane); \
        else step_frag8<SLC, false>(qf, CUR, NXT2, KF, VF, (DC), (DN2) & NM, lo_in, hi, qi, st, lane); } while (0)
#pragma unroll 1
    for (int i = 0; i < n; i += 3) {
        const int d2 = desc(i + 2 < n ? i + 2 : n - 1);
        F8_STEP(fa, fc, d0, d2);
        if (i + 1 >= n) break;
        const int d3 = desc(i + 3 < n ? i + 3 : n - 1);
        F8_STEP(fb, fa, d1, d3);
        if (i + 2 >= n) break;
        const int d4 = desc(i + 4 < n ? i + 4 : n - 1);
        F8_STEP(fc, fb, d2, d4);
        d0 = d3; d1 = d4;
    }
#undef F8_STEP
}
__device__ __forceinline__ float quad_total(float v) { v += __shfl_xor(v, 16); v += __shfl_xor(v, 32); return v; }

__device__ __forceinline__ void dilated_unit(int unit, const bf16_t* proj, const bf16_t* kbf, bf16_t* nsaout, int lane) {
    const int l16 = lane & 15, kq = lane >> 4;
    const int hg = (unit >> 4) & 3, r16 = unit & 15, ut = unit >> 6;
    const int t0 = r16 + 256 * ut, tc = t0 + 16 * l16;
    const bf16_t* vbf = kbf + ((size_t)24 << 20);
    AState st; astate_init(st);
#pragma unroll 1
    for (int pt = 0; pt < 3; ++pt) {
        const int sh = 2 * pt, head = 4 * pt + hg;
        const bf16_t* qrow = proj + (size_t)tc * PLD + PC_QB + head * 128 + 8 * kq;
        bf16x8 qf[4];
#pragma unroll
        for (int s = 0; s < 4; ++s) qf[s] = *(const bf16x8*)(qrow + 32 * s);
        const int base = (r16 & ((1 << sh) - 1)) << (14 - sh), u0 = t0 >> sh, ui = u0 + (16 >> sh) * l16;
        const int lo = base + (ui - 128 < 0 ? 0 : ui - 128), hi = base + ui;
        const int first = (base + (u0 - 128 < 0 ? 0 : u0 - 128)) >> 5, last = (base + u0 + 15 * (16 >> sh)) >> 5;
        unsigned long long hoff = (unsigned long long)head * S * 128; asm volatile("" : "+s"(hoff));
        auto desc = [&](int i) { return 32 * (first + i); };
        attn_run_frag<0, false>(qf, kbf + hoff, vbf + hoff, desc, last - first + 1, lo, hi, 0, st, lane);
    }
    const float lt = quad_total(st.l), inv = lt > 0.f ? 1.f / lt : 0.f;
    bf16_t* op = nsaout + (size_t)tc * NOLD + 1024 + hg * 128 + 4 * kq;
#pragma unroll
    for (int db = 0; db < 8; ++db) { const f32x4 o = st.o[db] * inv; u32x2 w; w.x = cvt_pk_bf16(o[0], o[1]); w.y = cvt_pk_bf16(o[2], o[3]); *(u32x2*)(op + 16 * db) = w; }
}

__device__ __forceinline__ void compress_unit(int unit, const bf16_t* proj, const bf16_t* w1t, const bf16_t* w2t, const float* bias, bf16_t* outc, LAS unsigned char* lds, int wave, int lane) {
    const int l16 = lane & 15, kq = lane >> 4;
    const int rt = unit & 63, g = (unit >> 6) & 1, kv = unit >> 7;
    const bf16_t* raw = proj + (kv ? PC_VC : PC_KC) + 128 * g;
    const int n = 16 * rt + l16;
    f32x4 acc[16];
#pragma unroll
    for (int i = 0; i < 16; ++i) acc[i] = (f32x4){0.f, 0.f, 0.f, 0.f};
#pragma unroll 2
    for (int si = 0; si < 16; ++si) {
        const int s = 16 * wave + si;
        const int tok = clampi(16 * n + (s >> 2), 0, S - 1);
        const bf16x8 af = *(const bf16x8*)(raw + (size_t)tok * PLD + (s & 3) * 32 + 8 * kq);
#pragma unroll
        for (int ct = 0; ct < 16; ++ct) { const bf16x8 bfr = *(const bf16x8*)(w1t + ((size_t)(ct * 128 + s) * 64 + lane) * 8);
            acc[ct] = __builtin_amdgcn_mfma_f32_16x16x32_bf16(af, bfr, acc[ct], 0, 0, 0); }
    }
    LAS f32x4* part = (LAS f32x4*)lds;
#pragma unroll
    for (int ct = 0; ct < 16; ++ct) part[(wave * 16 + ct) * 64 + lane] = acc[ct];
    __syncthreads();
    LAS unsigned char* hid = lds + 131072;
#pragma unroll
    for (int c2 = 0; c2 < 2; ++c2) { const int ct = 2 * wave + c2; f32x4 sum = (f32x4){0.f, 0.f, 0.f, 0.f};
#pragma unroll
        for (int w = 0; w < 8; ++w) sum += part[(w * 16 + ct) * 64 + lane];
        const float bb = bias[16 * ct + l16];
#pragma unroll
        for (int r = 0; r < 4; ++r) { const float x = sum[r] + bb; const float u2 = 1.5957691216f * (x + 0.044715f * x * x * x); const float gl = x * fsigmoid(u2);
            *(LAS bf16_t*)(hid + (4 * kq + r) * 528 + (16 * ct + l16) * 2) = (bf16_t)(cvt_pk_bf16(gl, 0.f) & 0xffffu); } }
    __syncthreads();
    f32x4 o2 = (f32x4){0.f, 0.f, 0.f, 0.f};
    const int dt = wave;
#pragma unroll
    for (int s = 0; s < 8; ++s) {
        const bf16x8 af = *(const LAS bf16x8*)(hid + l16 * 528 + (32 * s + 8 * kq) * 2);
        const bf16x8 bfr = *(const bf16x8*)(w2t + (size_t)(16 * dt + l16) * 256 + 32 * s + 8 * kq);
        o2 = __builtin_amdgcn_mfma_f32_16x16x32_bf16(af, bfr, o2, 0, 0, 0);
    }
#pragma unroll
    for (int r = 0; r < 4; ++r) { const int nn = 16 * rt + 4 * kq + r, d = 16 * dt + l16;
        const bf16_t val = (bf16_t)(cvt_pk_bf16(o2[r], 0.f) & 0xffffu);
        if (kv == 0) outc[(((size_t)g * 64 + (nn >> 4)) * 4 + (d >> 5)) * 512 + (((d >> 3) & 3) * 16 + (nn & 15)) * 8 + (d & 7)] = val;
        else { const int kp = nn & 31; outc[(((size_t)g * 32 + (nn >> 5)) * 8 + (d >> 4)) * 512 + ((((kp >> 2) & 3) * 16) + (d & 15)) * 8 + 4 * (kp >> 4) + (kp & 3)] = val; } }
    __syncthreads();
}

__device__ __forceinline__ void nsa_unit(int unit, const bf16_t* proj, const bf16_t* kc, const bf16_t* vc, const bf16_t* gn, const float* cs, const float* sn,
                                         const bf16_t* kslf, const bf16_t* vslf, const bf16_t* kwnf, const bf16_t* vwnf, bf16_t* nsaout, LAS unsigned char* wl, int lane) {
    const int l16 = lane & 15, kq = lane >> 4;
    const int g = unit & 1, tb = unit >> 1, t0 = 4 * tb, qi = l16 >> 2, h = l16 & 3, tc = t0 + qi, head = 4 * g + h;
    LAS unsigned char* vbuf = wl; LAS float* imp = (LAS float*)(wl + VBUF_BYTES); LAS int* sel = (LAS int*)(wl + VBUF_BYTES + 4 * IMP_LD * 4);
    bf16x8 qf[4];
    { const bf16_t* qrow = proj + (size_t)tc * PLD + PC_QA + head * 128 + 8 * kq;
#pragma unroll
        for (int s = 0; s < 4; ++s) qf[s] = *(const bf16x8*)(qrow + 32 * s); }
    LAS u32x2* outl = (LAS u32x2*)(wl + OUT_OFF) + lane;
    for (int i = lane; i < 4 * IMP_LD; i += 64) imp[i] = 0.f;
    const int hic = (tc - 31) >> 4;
    const int nkmax = ((t0 + 3 - 31) >> 4) + 1, nsc = nkmax > 0 ? (nkmax + 31) >> 5 : 0;
    unsigned long long coff = (unsigned long long)g * 1024 * 128; asm volatile("" : "+s"(coff));
    const bf16_t* kcg = kc + coff; const bf16_t* vcg = vc + coff;
    AState st; astate_init(st);
    { auto desc = [&](int i) { return 32 * i; };
      attn_run_frag<1, false>(qf, kcg, vcg, desc, nsc, 0, hic, 0, st, lane);
      { const float lt = quad_total(st.l); st.l = lt > 0.f ? 1.f / lt : 0.f; }
      asm volatile("s_waitcnt lgkmcnt(0)" ::: "memory");
      attn_run_frag<2, false>(qf, kcg, vcg, desc, nsc, 0, hic, 0, st, lane, imp); }
    const float g0 = bf2f(gn[(size_t)tc * 32 + head * 3 + 0]);
#pragma unroll
    for (int i = 0; i < 8; ++i) { const f32x4 o = st.o[i] * g0; u32x2 w; w.x = cvt_pk_bf16(o[0], o[1]); w.y = cvt_pk_bf16(o[2], o[3]); outl[64 * i] = w; }
    asm volatile("s_waitcnt lgkmcnt(0)" ::: "memory");
#pragma unroll
    for (int s2 = 0; s2 < 2; ++s2) {
        const int d = 32 * s2 + 8 * kq; f32x4 c[2], sv[2];
        c[0] = *(const f32x4*)(cs + (size_t)tc * 64 + d); c[1] = *(const f32x4*)(cs + (size_t)tc * 64 + d + 4);
        sv[0] = *(const f32x4*)(sn + (size_t)tc * 64 + d); sv[1] = *(const f32x4*)(sn + (size_t)tc * 64 + d + 4);
        float o1[8], o2[8];
#pragma unroll
        for (int j = 0; j < 8; ++j) { const float x1 = bf2f((unsigned short)qf[s2][j]), x2 = bf2f((unsigned short)qf[s2 + 2][j]), cc = c[j >> 2][j & 3], ss = sv[j >> 2][j & 3];
            o1[j] = x1 * cc - x2 * ss; o2[j] = x2 * cc + x1 * ss; }
        u32x4 w1, w2; w1.x = cvt_pk_bf16(o1[0], o1[1]); w1.y = cvt_pk_bf16(o1[2], o1[3]); w1.z = cvt_pk_bf16(o1[4], o1[5]); w1.w = cvt_pk_bf16(o1[6], o1[7]);
        w2.x = cvt_pk_bf16(o2[0], o2[1]); w2.y = cvt_pk_bf16(o2[2], o2[3]); w2.z = cvt_pk_bf16(o2[4], o2[5]); w2.w = cvt_pk_bf16(o2[6], o2[7]);
        qf[s2] = __builtin_bit_cast(bf16x8, w1); qf[s2 + 2] = __builtin_bit_cast(bf16x8, w2);
    }
    unsigned key[4][4];
#pragma unroll
    for (int q = 0; q < 4; ++q) { const int cur = (t0 + q) >> 6; const f32x4 v = *(const LAS f32x4*)(imp + q * IMP_LD + 4 * lane);
#pragma unroll
        for (int i = 0; i < 4; ++i) { const int j = 4 * lane + i; const bool valid = j <= cur, forced = (j == 0) | (j == cur) | (j == cur - 1);
            const unsigned kb = forced ? 0xffffffu : ((__float_as_uint(fmaxf(v[i], 0.f)) >> 8) + 1u);
            key[q][i] = valid ? ((kb << 8) | (unsigned)(255 - j)) : 0u; } }
#pragma unroll 1
    for (int r = 0; r < 16; ++r) {
        unsigned mx[4];
#pragma unroll
        for (int q = 0; q < 4; ++q) { unsigned a = key[q][0] > key[q][1] ? key[q][0] : key[q][1], b = key[q][2] > key[q][3] ? key[q][2] : key[q][3]; mx[q] = a > b ? a : b; }
#pragma unroll
        for (int o = 1; o < 64; o <<= 1)
#pragma unroll
            for (int q = 0; q < 4; ++q) { const unsigned other = (unsigned)__shfl_xor((int)mx[q], o); mx[q] = other > mx[q] ? other : mx[q]; }
#pragma unroll
        for (int q = 0; q < 4; ++q) {
#pragma unroll
            for (int i = 0; i < 4; ++i) if (key[q][i] == mx[q]) key[q][i] = 0u;
            if (lane == 0) sel[q * 16 + r] = mx[q] ? (int)(255u - (mx[q] & 255u)) : -1;
        }
    }
    asm volatile("s_waitcnt lgkmcnt(0)" ::: "memory");
    i64_t q8[4];
#pragma unroll
    for (int s2 = 0; s2 < 4; ++s2) { f32x4 a, b;
#pragma unroll
        for (int j = 0; j < 4; ++j) { a[j] = bf2f((unsigned short)qf[s2][j]) * SL2; b[j] = bf2f((unsigned short)qf[s2][4 + j]) * SL2; }
        q8[s2] = __builtin_bit_cast(i64_t, pack8_fp8(a, b)); }
    LAS int* list = (LAS int*)(wl + VBUF_BYTES + 4 * IMP_LD * 4 + 256);
    int nslc;
    { const int b = sel[lane], q = lane >> 4, cur0 = t0 >> 6;
      const bool forced = (b == 0) | (b == cur0) | (b == cur0 - 1);
      const bool valid = (b >= 0) & !(forced & (q > 0)); const unsigned long long mask = __ballot(valid);
      const int idx = __popcll(mask & ((1ull << lane) - 1ull)); nslc = 2 * __popcll(mask);
      if (valid) { const int qc = (forced ? 4 : q) | (b < cur0 ? (1 << 10) : 0);
                   list[2 * idx] = (64 * b) | (qc << 20); list[2 * idx + 1] = (64 * b + 32) | (qc << 20); } }
    asm volatile("s_waitcnt lgkmcnt(0)" ::: "memory");
    astate_init(st);
    { auto desc = [&](int i) { return __builtin_amdgcn_readfirstlane(list[i]); };
      unsigned long long goff = (unsigned long long)g * S * 128; asm volatile("" : "+s"(goff));
      attn_run_frag8<true>(q8, (const unsigned char*)kslf + goff, (const unsigned char*)kslf + ((size_t)8 << 20) + goff, desc, nslc, 0, tc, qi, st, lane); }
    { const float g1 = bf2f(gn[(size_t)tc * 32 + head * 3 + 1]); const float lt = quad_total(st.l), inv = (lt > 0.f ? 1.f / lt : 0.f) * g1;
#pragma unroll
        for (int i = 0; i < 8; ++i) { const f32x4 o = st.o[i] * inv; u32x2 w = outl[64 * i]; w.x = cvt_pk_bf16(bflo(w.x) + o[0], bfhi(w.x) + o[1]); w.y = cvt_pk_bf16(bflo(w.y) + o[2], bfhi(w.y) + o[3]); outl[64 * i] = w; } }
    astate_init(st);
    { const int lo = tc - 511 < 0 ? 0 : tc - 511; const int first = t0 < 511 ? 0 : (t0 - 511) >> 5, last = (t0 + 3) >> 5;
      auto desc = [&](int i) { const int p0 = 32 * (first + i); return p0 | ((p0 >= t0 + 3 - 511 && p0 + 31 <= t0) ? (1 << 30) : 0); };
      unsigned long long goff = (unsigned long long)g * S * 128; asm volatile("" : "+s"(goff));
      attn_run_frag8<false>(q8, (const unsigned char*)kslf + ((size_t)16 << 20) + goff, (const unsigned char*)kslf + ((size_t)24 << 20) + goff, desc, last - first + 1, lo, tc, 0, st, lane); }
    { const float g2 = bf2f(gn[(size_t)tc * 32 + head * 3 + 2]); const float lt = quad_total(st.l), inv = (lt > 0.f ? 1.f / lt : 0.f) * g2;
#pragma unroll
        for (int i = 0; i < 8; ++i) { const f32x4 o = st.o[i] * inv; u32x2 w = outl[64 * i]; w.x = cvt_pk_bf16(bflo(w.x) + o[0], bfhi(w.x) + o[1]); w.y = cvt_pk_bf16(bflo(w.y) + o[2], bfhi(w.y) + o[3]); outl[64 * i] = w; } }
    bf16_t* op = nsaout + (size_t)tc * NOLD + head * 128 + 4 * kq;
#pragma unroll
    for (int db = 0; db < 8; ++db) *(u32x2*)(op + 16 * db) = outl[64 * db];
}


#define XB_TMO      128
#define XB_XCNT(j)  (256  + 64 * (j))
#define XB_XSUB(j)  (1280 + 64 * (j))
#define XB_XGEN(j)  (2304 + 64 * (j))
#define XB_TOP      3328
#define XB_TOPGEN   3392
#define XCD_BAR_WORDS 3456
#define XB_SPIN_CAP (1u << 18)
__device__ __forceinline__ unsigned xb_ld(unsigned* p)              { return __hip_atomic_load(p, __ATOMIC_RELAXED, __HIP_MEMORY_SCOPE_AGENT); }
__device__ __forceinline__ unsigned xb_add(unsigned* p, unsigned v) { return __hip_atomic_fetch_add(p, v, __ATOMIC_RELAXED, __HIP_MEMORY_SCOPE_AGENT); }
__device__ __forceinline__ unsigned xb_xcc_id() { return (unsigned)__builtin_amdgcn_s_getreg((3 << 11) | 20) & 0xFu; }
#define XB_SPIN(cond, bar) do { unsigned _sp = 0; while (cond) { __builtin_amdgcn_s_sleep(1); \
    if ((++_sp & 255u) == 0u) { if (xb_ld(&(bar)[XB_TMO])) break; if (_sp > XB_SPIN_CAP) { atomicAdd(&(bar)[XB_TMO], 1u); break; } } } } while (0)
struct XcdBarrier { unsigned* bar; unsigned x; volatile LAS unsigned* st; };
__device__ __forceinline__ XcdBarrier xcd_barrier_post(unsigned* bar, volatile LAS unsigned* st) {
    XcdBarrier b; b.bar = bar; b.x = xb_xcc_id(); b.st = st;
    if (threadIdx.x == 0) st[2] = xb_add(&bar[XB_XCNT(b.x)], 1u);
    return b;
}
__device__ __forceinline__ void xcd_barrier_complete(unsigned* bar, unsigned x, unsigned& nloc, unsigned& nx) {
    const unsigned G = gridDim.x * gridDim.y * gridDim.z;
    unsigned sum, cnt, mine, sp = 0u;
    for (;;) {
        sum = 0u; cnt = 0u; mine = 0u;
#pragma unroll
        for (unsigned j = 0; j < 16; ++j) { const unsigned c = xb_ld(&bar[XB_XCNT(j)]); sum += c; cnt += (c > 0u) ? 1u : 0u; mine = (j == x) ? c : mine; }
        if (sum == G) break;
        __builtin_amdgcn_s_sleep(1);
        if ((++sp & 255u) == 0u) { if (xb_ld(&bar[XB_TMO])) break; if (sp > XB_SPIN_CAP) { atomicAdd(&bar[XB_TMO], 1u); break; } }
    }
    nloc = mine > 0u ? mine : 1u; nx = cnt > 0u ? cnt : 1u;
}
__device__ __forceinline__ void xcd_barrier(const XcdBarrier& b, const int tid) {
    asm volatile("s_waitcnt vmcnt(0)" ::: "memory");
    __syncthreads();
    if (tid == 0) {
        unsigned* bar = b.bar;
        __builtin_amdgcn_s_waitcnt(0);
        unsigned nloc = b.st[0], nx = b.st[1];
        if (nloc == 0u) { xcd_barrier_complete(bar, b.x, nloc, nx); b.st[0] = nloc; b.st[1] = nx; }
        const unsigned old = xb_add(&bar[XB_XSUB(b.x)], 1u);
        const unsigned gen = old / nloc;
        if (old + 1u == (gen + 1u) * nloc) {
            __builtin_amdgcn_fence(__ATOMIC_RELEASE, "agent");
            asm volatile("s_waitcnt vmcnt(0)" ::: "memory");
            const unsigned og = xb_add(&bar[XB_TOP], 1u);
            const unsigned tg = og / nx;
            if (og + 1u == (tg + 1u) * nx) xb_add(&bar[XB_TOPGEN], 1u);
            else XB_SPIN(xb_ld(&bar[XB_TOPGEN]) == tg, bar);
            __builtin_amdgcn_fence(__ATOMIC_ACQUIRE, "agent");
            xb_add(&bar[XB_XGEN(b.x)], 1u);
            asm volatile("s_waitcnt vmcnt(0)" ::: "memory");
        } else {
            XB_SPIN(xb_ld(&bar[XB_XGEN(b.x)]) == gen, bar);
            __builtin_amdgcn_fence(__ATOMIC_ACQUIRE, "agent");
            asm volatile("s_waitcnt vmcnt(0)" ::: "memory");
        }
    }
    __syncthreads();
}

struct Params { const float* in[23]; float* out; unsigned char* ws; float inv_freq[64]; };

__global__ void __launch_bounds__(512, 2) fwd_megakernel(Params P) {
    extern __shared__ __attribute__((aligned(16))) unsigned char lds_raw[];
    LAS unsigned char* lds = (LAS unsigned char*)lds_raw;
    cg::grid_group grid = cg::this_grid();
    const int wave_s = __builtin_amdgcn_readfirstlane(threadIdx.x >> 6);
#define PHASE_WS unsigned long long wsv_ = (unsigned long long)P.ws; asm volatile("" : "+s"(wsv_)); unsigned char* ws = (unsigned char*)(__attribute__((address_space(1))) unsigned char*)wsv_; unsigned z_ = 0u; asm volatile("" : "+v"(z_)); const int tid = wave_s * 64 + (int)__builtin_amdgcn_mbcnt_hi(~0u, __builtin_amdgcn_mbcnt_lo(~0u, z_)); \
    const int lane = tid & 63, wave = __builtin_amdgcn_readfirstlane(tid >> 6), G = gridDim.x, gw = blockIdx.x * 8 + wave, ngw = G * 8; \
    const size_t gtid = (size_t)blockIdx.x * 512 + tid, gthreads = (size_t)G * 512; \
    LAS unsigned char* wl = lds + wave * WAVE_LDS; LAS float* scr = (LAS float*)wl; (void)lane; (void)gw; (void)ngw; (void)gtid; (void)gthreads; (void)wl; (void)scr
#define WAB ((bf16_t*)(ws + WS_WAB))
#define WO ((bf16_t*)(ws + WS_WO))
#define CW1K ((bf16_t*)(ws + WS_CW1K))
#define CW1V ((bf16_t*)(ws + WS_CW1V))
#define CW2K ((bf16_t*)(ws + WS_CW2K))
#define CW2V ((bf16_t*)(ws + WS_CW2V))
#define CBIAS ((float*)(ws + WS_CBIAS))
#define KC ((bf16_t*)(ws + WS_KC))
#define VC ((bf16_t*)(ws + WS_VC))
#define GN ((bf16_t*)(ws + WS_GN))
#define ST1 ((float*)(ws + WS_ST1))
#define ST2 ((float*)(ws + WS_ST2))
#define HF ((float*)(ws + WS_HF))
#define HB ((bf16_t*)(ws + WS_HB))
#define GU ((bf16_t*)(ws + WS_GU))
#define DN ((bf16_t*)(ws + WS_DN))
#define ACT ((bf16_t*)(ws + WS_ACT))
#define PROJ ((bf16_t*)(ws + WS_PROJ))
#define KSLF ((bf16_t*)(ws + WS_KSLF))
#define KBF ((bf16_t*)(ws + WS_KBF))
#define VBF ((bf16_t*)(ws + WS_VBF))
#define VSLF ((bf16_t*)(ws + WS_VSLF))
#define KWNF ((bf16_t*)(ws + WS_KWNF))
#define VWNF ((bf16_t*)(ws + WS_VWNF))
#define RCOS ((float*)(ws + WS_ROPE))
#define RSIN ((float*)(ws + WS_ROPE) + (size_t)S * 64)
#define WINT ((bf16_t*)(ws + WS_WIN))
#define NSAOUT ((bf16_t*)(ws + WS_NSAOUT))
#define SIGG ((bf16_t*)P.out)
    pg8::StaticOrder SO;
#define CG_SYNC() do { asm volatile("s_waitcnt vmcnt(0) lgkmcnt(0)" ::: "memory"); grid.sync(); \
        if (__builtin_amdgcn_readfirstlane(threadIdx.x >> 6) == 0) { __builtin_amdgcn_fence(__ATOMIC_ACQUIRE, "agent"); asm volatile("s_waitcnt vmcnt(0)" ::: "memory"); } \
        __syncthreads(); } while (0)
    volatile LAS unsigned* xst = (volatile LAS unsigned*)(lds + 8 * WAVE_LDS);
    if (threadIdx.x < 2) xst[threadIdx.x] = 0u;
    __syncthreads();
    const XcdBarrier xbar = xcd_barrier_post((unsigned*)P.ws, xst);
    __syncthreads();
    const int vbid = (int)(xst[2] * 8u + xbar.x);
#define GRID_SYNC() do { asm volatile("s_waitcnt vmcnt(0) lgkmcnt(0)" ::: "memory"); unsigned zz_ = 0u; asm volatile("" : "+v"(zz_)); \
        xcd_barrier(xbar, wave_s * 64 + (int)__builtin_amdgcn_mbcnt_hi(~0u, __builtin_amdgcn_mbcnt_lo(~0u, zz_))); } while (0)

    { PHASE_WS;
        conv_ffn(P.in[1], P.in[2], P.in[3], GU, DN, scr, gw, ngw, lane);
        { const float* win = P.in[6]; bf16_t* wint = WINT;
          tr_stream(32 * 360, gw, ngw, [&](int it) { const int kb = it / 360, nb = it % 360, dr = nb * 32; const int sc = win_src_col(dr);
              return TrP{win, WIN_SRC, kb * 64, sc < 0 ? 0 : sc, sc < 0 ? 0 : (dr == 11264 ? 24 : 32), wint, DM, dr, kb * 64}; }, scr, lane); }
        for (int it = gw; it < 16 * 64; it += ngw) { const int kb = it / 64, nb = it % 64; tr_item(P.in[13], DM, kb * 64, nb * 32, 32, WAB, 1024, nb * 32, kb * 64, scr, lane); }
        for (int it = gw; it < 8 * 64; it += ngw) { const int kb = it / 64, nb = it % 64; tr_item(P.in[14], DM, kb * 64, nb * 32, 32, WAB + (size_t)DM * 1024, 512, nb * 32, kb * 64, scr, lane); }
        for (int it = gw; it < 32 * 64; it += ngw) { const int kb = it / 64, nb = it % 64; tr_item(P.in[15], DM, kb * 64, nb * 32, 32, WO, DM, nb * 32, kb * 64, scr, lane); }
        for (int it = gw; it < 2 * 64 * 8; it += ngw) { const int w = it / 512, r = it % 512, kb = r / 8, nb = r % 8; tr_item<true>(w ? P.in[11] : P.in[8], 256, kb * 64, nb * 32, 32, w ? CW1V : CW1K, 4096, nb * 32, kb * 64, scr, lane); }
        for (int it = gw; it < 2 * 4 * 4; it += ngw) { const int w = it / 16, r = it % 16, kb = r / 4, nb = r % 4; tr_item(w ? P.in[12] : P.in[9], 128, kb * 64, nb * 32, 32, w ? CW2V : CW2K, 256, nb * 32, kb * 64, scr, lane); }
        { const float* x = P.in[0];
            for (size_t i = gtid; i < (size_t)S * DM / 8; i += gthreads) { const f32x4 a = *(const f32x4*)(x + 8 * i), b = *(const f32x4*)(x + 8 * i + 4); *(u32x4*)(HB + 8 * i) = pack8(a, b); } }
        for (int o = gw; o < 512; o += ngw) { const int w = o >> 8, c = o & 255; const float* pos = w ? P.in[10] : P.in[7]; const float* w1 = w ? P.in[11] : P.in[8];
            float s = 0.f; for (int kk = lane; kk < 4096; kk += 64) s += pos[kk] * w1[(size_t)kk * 256 + c];
            s = wave_sum(s); if (lane == 0) CBIAS[o] = s; }
    }
    CG_SYNC();
    { PHASE_WS; pg8::Gemm g{HB, GU, S, NGU, DM, DM, DM}; SO.init(S, NGU, G, (int)blockIdx.x); EpiSwiglu E{ACT}; pg8::gemm_phase(lds, g, SO, E, tid); }
    GRID_SYNC();
    { PHASE_WS; pg8::Gemm g{ACT, DN, S, DM, FF, FF, FF}; SO.init(S, DM, G, (int)blockIdx.x); EpiResF32 E{P.in[0], HF, ALPHA, 0.5f}; pg8::gemm_phase(lds, g, SO, E, tid); }
    GRID_SYNC();
    { PHASE_WS;
        ln_rows(HF, nullptr, HB, P.in[4], P.in[5], gw, ngw, lane, ST1);
        for (size_t i = gtid; i < (size_t)S * 64; i += gthreads) { const int t = (int)(i >> 6), j = (int)(i & 63); const float ang = (float)t * P.inv_freq[j]; RCOS[i] = cosf(ang); RSIN[i] = sinf(ang); }
    }
    GRID_SYNC();
    { PHASE_WS; pg8::Gemm g{HB, WINT, S, NWIN, DM, DM, DM}; SO.init(S, NWIN, G, (int)blockIdx.x); EpiWin E{PROJ, SIGG, GN, RCOS, KSLF, KBF}; pg8::gemm_phase(lds, g, SO, E, tid); }
    GRID_SYNC();
    { PHASE_WS;
      int vb = (int)blockIdx.x;
      { bool ok = true; unsigned* cen = (unsigned*)P.ws;
#pragma unroll
        for (int j = 0; j < 8; ++j) ok &= (xb_ld(&cen[XB_XCNT(j)]) * 8u == (unsigned)G);
        if (ok) vb = vbid; }
        for (int u = blockIdx.x; u < 256; u += G) { const int kv = u >> 7; compress_unit(u, PROJ, kv ? CW1V : CW1K, kv ? CW2V : CW2K, CBIAS + 256 * kv, kv ? VC : KC, lds, wave, lane); }
        if ((G & 7) == 0) {
            const int x = vb & 7, lw = (vb >> 3) * 8 + wave, nlw = (G >> 3) * 8;
            for (int j = lw; j < 512; j += nlw) dilated_unit(64 * (x + 8 * (j >> 6)) + (j & 63), PROJ, KBF, NSAOUT, lane);
        } else { for (int u = gw; u < 4096; u += ngw) dilated_unit(u, PROJ, KBF, NSAOUT, lane); }
    }
    GRID_SYNC();
    { PHASE_WS;
      int vb = (int)blockIdx.x;
      { bool ok = true; unsigned* cen = (unsigned*)P.ws;
#pragma unroll
        for (int j = 0; j < 8; ++j) ok &= (xb_ld(&cen[XB_XCNT(j)]) * 8u == (unsigned)G);
        if (ok) vb = vbid; }
      if ((G & 7) == 0) {
          const int bx = vb, x = bx & 7, g = x & 1, wj = ((bx >> 3) * 4 + (x >> 1)) * 8 + wave, nwj = (G >> 1) * 8;
          for (int tb = wj; tb < 4096; tb += nwj) nsa_unit(2 * tb + g, PROJ, KC, VC, GN, RCOS, RSIN, KSLF, VSLF, KWNF, VWNF, NSAOUT, wl, lane);
      } else { for (int u = gw; u < 8192; u += ngw) nsa_unit(u, PROJ, KC, VC, GN, RCOS, RSIN, KSLF, VSLF, KWNF, VWNF, NSAOUT, wl, lane); } }
    GRID_SYNC();
    { PHASE_WS; SO.init(S, DM, G, (int)blockIdx.x);
      { pg8::Gemm g{NSAOUT, WAB, S, DM, 1024, NOLD, 1024}; EpiGate<true> E{SIGG, HB}; pg8::gemm_phase(lds, g, SO, E, tid); }
      { pg8::Gemm g{NSAOUT + 1024, WAB + (size_t)DM * 1024, S, DM, 512, NOLD, 512}; EpiGate<false> E{SIGG + 2048, HB}; pg8::gemm_phase(lds, g, SO, E, tid); } }
    GRID_SYNC();
    { PHASE_WS; pg8::Gemm g{HB, WO, S, DM, DM, DM, DM}; SO.init(S, DM, G, (int)blockIdx.x); EpiResLnF32 E{HF, ST1, P.in[4], P.in[5], HF, ALPHA, 1.0f}; pg8::gemm_phase(lds, g, SO, E, tid); }
    GRID_SYNC();
    { PHASE_WS;
        ln_rows(HF, nullptr, HB, P.in[16], P.in[17], gw, ngw, lane, ST2);
        conv_ffn(P.in[18], P.in[19], P.in[20], GU, DN, scr, gw, ngw, lane);
    }
    GRID_SYNC();
    { PHASE_WS; pg8::Gemm g{HB, GU, S, NGU, DM, DM, DM}; SO.init(S, NGU, G, (int)blockIdx.x); EpiSwiglu E{ACT}; pg8::gemm_phase(lds, g, SO, E, tid); }
    GRID_SYNC();
    { PHASE_WS; pg8::Gemm g{ACT, DN, S, DM, FF, FF, FF}; SO.init(S, DM, G, (int)blockIdx.x); EpiResLnF32 E{HF, ST2, P.in[16], P.in[17], P.out, ALPHA, 0.5f}; pg8::gemm_phase(lds, g, SO, E, tid); }
    GRID_SYNC();
    { PHASE_WS; (void)ws; ln_rows(P.out, P.out, nullptr, P.in[21], P.in[22], gw, ngw, lane); }
}

extern "C" void kernel_launch(void* const* d_in, const int* in_sizes, int n_in, void* d_out, int out_size, void* d_ws, size_t ws_size, hipStream_t stream) {
    static int grid = 0;
    if (grid == 0) {
        if (n_in != 23 || out_size != S * DM || ws_size < WS_END) { fprintf(stderr, "kernel_launch: unexpected shapes (n_in %d out %d ws %zu, need %zu)\n", n_in, out_size, ws_size, (size_t)WS_END); grid = -1; return; }
        int dev = 0, cus = 0, per_cu = 0;
        hipGetDevice(&dev); hipDeviceGetAttribute(&cus, hipDeviceAttributeMultiprocessorCount, dev);
        if (hipFuncSetAttribute((const void*)fwd_megakernel, hipFuncAttributeMaxDynamicSharedMemorySize, LDS_BYTES) != hipSuccess) { fprintf(stderr, "kernel_launch: hipFuncSetAttribute failed\n"); grid = -1; return; }
        if (hipOccupancyMaxActiveBlocksPerMultiprocessor(&per_cu, (const void*)fwd_megakernel, 512, LDS_BYTES) != hipSuccess || per_cu < 1) { fprintf(stderr, "kernel_launch: occupancy query failed (%d)\n", per_cu); (void)hipGetLastError(); per_cu = 1; }
        grid = cus * per_cu;
    }
    if (grid < 0) return;
    if (hipMemsetAsync(d_ws, 0, 16384, stream) != hipSuccess) { fprintf(stderr, "kernel_launch: memset of the barrier words failed\n"); return; }
    Params p{};
    for (int i = 0; i < 23; ++i) p.in[i] = (const float*)d_in[i];
    p.out = (float*)d_out; p.ws = (unsigned char*)d_ws;
    for (int i = 0; i < 64; ++i) p.inv_freq[i] = (float)pow(10000.0, -(double)i / 64.0);
    void* args[] = {&p};
    hipError_t e = hipLaunchCooperativeKernel((const void*)fwd_megakernel, dim3(grid), dim3(512), args, LDS_BYTES, stream);
    if (e != hipSuccess) fprintf(stderr, "kernel_launch: cooperative launch failed: %s (grid %d)\n", hipGetErrorString(e), grid);
}
```

```cpp
#include <hip/hip_runtime.h>
#include <hip/hip_cooperative_groups.h>
#include <cstdio>
#include <cstdint>
#include <cmath>
namespace cg = cooperative_groups;

#define LAS __attribute__((address_space(3)))
typedef unsigned short bf16_t;
typedef short bf16x8 __attribute__((ext_vector_type(8)));
typedef short s16x4 __attribute__((ext_vector_type(4)));
typedef float f32x4 __attribute__((ext_vector_type(4)));
typedef float f32x2 __attribute__((ext_vector_type(2)));
typedef unsigned u32x4 __attribute__((ext_vector_type(4)));
typedef unsigned u32x2 __attribute__((ext_vector_type(2)));

constexpr int S = 16384, DM = 2048, FF = 5632, NGU = 2 * FF, NWIN = 11520, WIN_SRC = 11288, PLD = 3072, NOLD = 1536;
constexpr float ALPHA = 1.189207115002721f;
constexpr float LN_EPS = 1e-5f;
constexpr float SL2 = 0.08838834764831845f * 1.4426950408889634f;
constexpr int PC_QA = 0, PC_KC = 1024, PC_VC = 1280, PC_QB = 1536;
constexpr size_t MiB = 1u << 20;
constexpr size_t WS_WAB = 1 * MiB, WS_WO = 13 * MiB, WS_CW1K = 21 * MiB, WS_CW1V = 23 * MiB, WS_CW2K = 25 * MiB, WS_CW2V = 25 * MiB + 65536, WS_CBIAS = 25 * MiB + 131072;
constexpr size_t WS_KC = 26 * MiB, WS_VC = 26 * MiB + 524288, WS_GN = 27 * MiB, WS_ST1 = 28 * MiB, WS_ST2 = 28 * MiB + 131072;
constexpr size_t WS_HF = 32 * MiB, WS_HB = 160 * MiB, WS_BIG = 224 * MiB;
constexpr size_t WS_GU = WS_BIG, WS_DN = WS_BIG + 44 * MiB, WS_ACT = WS_BIG + 66 * MiB;
constexpr size_t WS_KBF = WS_BIG + 96 * MiB, WS_VBF = WS_BIG + 144 * MiB;
constexpr size_t WS_PROJ = WS_BIG, WS_KSLF = WS_BIG + 192 * MiB, WS_VSLF = WS_BIG + 200 * MiB, WS_KWNF = WS_BIG + 208 * MiB, WS_VWNF = WS_BIG + 216 * MiB, WS_ROPE = WS_BIG + 224 * MiB;
constexpr size_t WS_WIN = 466 * MiB, WS_NSAOUT = 466 * MiB, WS_END = 514 * MiB;

constexpr int VROW = 288, VBUF_BYTES = 32 * VROW;
constexpr int IMP_LD = 260;
constexpr int OUT_OFF = VBUF_BYTES + 4 * IMP_LD * 4 + 256 + 512;
constexpr int WAVE_LDS = OUT_OFF + 4096;
constexpr int LDS_BYTES = 147456;
static_assert(8 * WAVE_LDS + 32 <= LDS_BYTES && 131072 <= LDS_BYTES, "LDS map");

typedef __bf16 bf16x2_t __attribute__((ext_vector_type(2)));
__device__ __forceinline__ unsigned cvt_pk_bf16(float lo, float hi) { f32x2 v = {lo, hi}; bf16x2_t b = __builtin_convertvector(v, bf16x2_t); return __builtin_bit_cast(unsigned, b); }
__device__ __forceinline__ float bf2f(unsigned short b) { return __uint_as_float(((unsigned)b) << 16); }
__device__ __forceinline__ float bflo(unsigned w) { return __uint_as_float(w << 16); }
__device__ __forceinline__ float bfhi(unsigned w) { return __uint_as_float(w & 0xffff0000u); }
__device__ __forceinline__ float fsigmoid(float x) { return __builtin_amdgcn_rcpf(1.f + __expf(-x)); }
__device__ __forceinline__ float quad_xor1(float v) { return __int_as_float(__builtin_amdgcn_update_dpp(0, __float_as_int(v), 0xB1, 0xF, 0xF, false)); }
__device__ __forceinline__ float quad_xor2(float v) { return __int_as_float(__builtin_amdgcn_update_dpp(0, __float_as_int(v), 0x4E, 0xF, 0xF, false)); }
__device__ __forceinline__ float wave_sum(float v) {
#pragma unroll
    for (int o = 1; o < 64; o <<= 1) v += __shfl_xor(v, o);
    return v;
}
typedef long i64_t;
__device__ __forceinline__ u32x2 pack8_fp8(const f32x4 a, const f32x4 b) {
    unsigned lo = 0u, hi = 0u;
    lo = __builtin_amdgcn_cvt_pk_fp8_f32(a[0], a[1], lo, false); lo = __builtin_amdgcn_cvt_pk_fp8_f32(a[2], a[3], lo, true);
    hi = __builtin_amdgcn_cvt_pk_fp8_f32(b[0], b[1], hi, false); hi = __builtin_amdgcn_cvt_pk_fp8_f32(b[2], b[3], hi, true);
    return (u32x2){lo, hi};
}
__device__ __forceinline__ u32x4 pack8(const f32x4 a, const f32x4 b) { u32x4 w; w.x = cvt_pk_bf16(a[0], a[1]); w.y = cvt_pk_bf16(a[2], a[3]); w.z = cvt_pk_bf16(b[0], b[1]); w.w = cvt_pk_bf16(b[2], b[3]); return w; }

namespace pg8 {
constexpr int BM = 256, BK = 64, HALF = 128, HTB = HALF * BK * 2, STAGE_BYTES = 8 * HTB, NXCD = 8, WGM = 8;
__host__ __device__ __forceinline__ int lds_byte(int r, int c) { const int st = (r >> 4) * 2 + (c >> 5), rr = r & 15, cc = c & 31, ob = rr * 64 + cc * 2; return st * 1024 + (ob ^ (((ob >> 9) & 1) << 5)); }
__host__ __device__ __forceinline__ void stage_rc(int b, int& R, int& C) { const int st = b / 1024, sb = b % 1024, swz = sb ^ (((sb >> 9) & 1) << 5); R = (st >> 1) * 16 + swz / 64; C = (st & 1) * 32 + (swz % 64) / 2; }
__host__ __device__ __forceinline__ int perm32(int rho) { const int n = rho >> 4, i = rho & 15; return 8 * (i >> 2) + 4 * n + (i & 3); }
struct Unit { int pm, pn; };
struct Gemm { const bf16_t* A; const bf16_t* Bt; int M, N, K, lda, ldb; };
struct StaticOrder {
    int nM, nN, nwg, G, c;
    __device__ void init(int M, int N, int G_, int c_) { nM = M / BM; nN = N / BM; nwg = nM * nN; G = G_; c = c_; }
    __device__ bool next(int i, Unit& u) const {
        const long L = (long)i * G + c; if (L >= nwg) return false;
        int wgid = (int)L; { const int q = nwg / NXCD, r = nwg % NXCD, xcd = wgid % NXCD, off = wgid / NXCD; wgid = (xcd < r ? xcd * (q + 1) : r * (q + 1) + (xcd - r) * q) + off; }
        const int nig = WGM * nN, gid = wgid / nig, fm = gid * WGM, gsz = (nM - fm) < WGM ? (nM - fm) : WGM;
        u.pm = fm + ((wgid % nig) % gsz); u.pn = (wgid % nig) / gsz; return true;
    }
};
typedef f32x4 Acc[2][2][4][2];

template <class Epi>
__device__ __forceinline__ void gemm_phase(LAS unsigned char* lds, const Gemm g, const StaticOrder& S_, const Epi& E, const int tid) {
    const int wid = __builtin_amdgcn_readfirstlane(tid >> 6), lane = tid & 63, wr = wid >> 2, wc = wid & 3, fr = lane & 15, fq = lane >> 4;
    const int K = g.K, nt = K / BK;
    unsigned voffA[2], voffB[2];
#pragma unroll
    for (int i = 0; i < 2; ++i) { int R, C; stage_rc(tid * 16 + i * 8192, R, C); const int Rb = Epi::PERM ? ((R & ~31) + perm32(R & 31)) : R;
        voffA[i] = (unsigned)(R * g.lda + C) * 2u; voffB[i] = (unsigned)(Rb * g.ldb + C) * 2u; }
    const size_t kstep = (size_t)(BK * 2);
    const size_t hstepA = (size_t)HALF * g.lda * 2, hstepB = (size_t)HALF * g.ldb * 2;
    const size_t tstepA = 2 * hstepA, tstepB = 2 * hstepB;
    const unsigned ldsw = (unsigned)wid * 1024u;
    const int aoff = lds_byte(wr * 64 + fr, fq * 8), boff = lds_byte(wc * 32 + fr, fq * 8);
#define PG8_SA(b, h) (((b) * 2 + (h)) * HTB)
#define PG8_SB(b, h) ((4 + (b) * 2 + (h)) * HTB)
#define PG8_STAGE(bufoff, gbase, voff) do { _Pragma("unroll") for (int _i = 0; _i < 2; ++_i) \
        __builtin_amdgcn_global_load_lds((const unsigned*)((const char*)(gbase) + (voff)[_i]), (LAS unsigned*)(lds + (bufoff) + ldsw + _i * 8192), 16, 0, 0); } while (0)
#define PG8_LDA(dst, b, h) do { _Pragma("unroll") for (int m = 0; m < 4; ++m) _Pragma("unroll") for (int k = 0; k < 2; ++k) dst[m][k] = *(const LAS bf16x8*)(lds + PG8_SA(b, h) + aoff + m * 2048 + k * 1024); } while (0)
#define PG8_LDB(dst, b, h) do { _Pragma("unroll") for (int n = 0; n < 2; ++n) _Pragma("unroll") for (int k = 0; k < 2; ++k) dst[n][k] = *(const LAS bf16x8*)(lds + PG8_SB(b, h) + boff + n * 2048 + k * 1024); } while (0)
#define PG8_MMA(ai, bj, At, Bt) do { __builtin_amdgcn_s_setprio(1); _Pragma("unroll") for (int m = 0; m < 4; ++m) _Pragma("unroll") for (int n = 0; n < 2; ++n) _Pragma("unroll") for (int k = 0; k < 2; ++k) \
        acc[ai][bj][m][n] = __builtin_amdgcn_mfma_f32_16x16x32_bf16(Bt[n][k], At[m][k], acc[ai][bj][m][n], 0, 0, 0); __builtin_amdgcn_s_setprio(0); } while (0)
#define PG8_WAIT_V(n) asm volatile("s_waitcnt vmcnt(" #n ")" ::: "memory")
#define PG8_WAIT_L(n) asm volatile("s_waitcnt lgkmcnt(" #n ")" ::: "memory")
#define PG8_BAR __builtin_amdgcn_s_barrier()
#define PG8_SCHED __builtin_amdgcn_sched_barrier(0)
    Unit cur, nxt; int ui = 0;
    if (!S_.next(0, cur)) return;
    Acc acc;
#pragma unroll
    for (int a = 0; a < 2; ++a)
#pragma unroll
        for (int b = 0; b < 2; ++b)
#pragma unroll
            for (int m = 0; m < 4; ++m)
#pragma unroll
                for (int n = 0; n < 2; ++n) acc[a][b][m][n] = (f32x4){0.f, 0.f, 0.f, 0.f};
    bf16x8 At[4][2], B0[2][2], B1[2][2];
    const char* cA = (const char*)g.A + (size_t)cur.pm * tstepA; const char* cB = (const char*)g.Bt + (size_t)cur.pn * tstepB;
    PG8_STAGE(PG8_SB(0, 0), cB, voffB); PG8_STAGE(PG8_SB(0, 1), cB + hstepB, voffB); PG8_STAGE(PG8_SA(0, 0), cA, voffA); PG8_STAGE(PG8_SA(0, 1), cA + hstepA, voffA);
    if (wr == 1) PG8_BAR;
    PG8_WAIT_V(2); PG8_BAR;
    PG8_STAGE(PG8_SB(1, 0), cB + kstep, voffB); PG8_STAGE(PG8_SA(1, 0), cA + kstep, voffA); PG8_STAGE(PG8_SB(1, 1), cB + hstepB + kstep, voffB);
    PG8_WAIT_V(6); PG8_BAR;
    for (;;) {
        const bool has_next = S_.next(ui + 1, nxt);
        const char* nA = has_next ? (const char*)g.A + (size_t)nxt.pm * tstepA : cA; const char* nB = has_next ? (const char*)g.Bt + (size_t)nxt.pn * tstepB : cB;
        for (int t = 0; t < nt; t += 2) {
            const bool last = (t == nt - 2);
            const char* a1 = cA + (size_t)(t + 1) * kstep;
            const char* a2 = last ? nA : cA + (size_t)(t + 2) * kstep; const char* b2 = last ? nB : cB + (size_t)(t + 2) * kstep;
            const char* a3 = a2 + kstep; const char* b3 = b2 + kstep;
            PG8_LDB(B0, 0, 0); PG8_LDB(B1, 0, 1); PG8_SCHED; PG8_LDA(At, 0, 0); PG8_STAGE(PG8_SA(1, 1), a1 + hstepA, voffA);
            PG8_WAIT_V(8); PG8_WAIT_L(0); PG8_BAR; PG8_MMA(0, 0, At, B0); PG8_MMA(0, 1, At, B1); PG8_BAR; PG8_SCHED;
            PG8_LDA(At, 0, 1); PG8_STAGE(PG8_SB(0, 0), b2, voffB); PG8_STAGE(PG8_SB(0, 1), b2 + hstepB, voffB); PG8_STAGE(PG8_SA(0, 0), a2, voffA);
            PG8_WAIT_V(8); PG8_WAIT_L(0); PG8_BAR; PG8_MMA(1, 0, At, B0); PG8_MMA(1, 1, At, B1); PG8_BAR; PG8_SCHED;
            PG8_LDB(B0, 1, 0); PG8_LDB(B1, 1, 1); PG8_SCHED; PG8_LDA(At, 1, 0); PG8_STAGE(PG8_SA(0, 1), a2 + hstepA, voffA);
            PG8_WAIT_V(8); PG8_WAIT_L(0); PG8_BAR; PG8_MMA(0, 0, At, B0); PG8_MMA(0, 1, At, B1); PG8_BAR; PG8_SCHED;
            PG8_LDA(At, 1, 1); PG8_STAGE(PG8_SB(1, 0), b3, voffB); PG8_STAGE(PG8_SB(1, 1), b3 + hstepB, voffB); PG8_STAGE(PG8_SA(1, 0), a3, voffA);
            PG8_WAIT_V(8); PG8_WAIT_L(0); PG8_BAR; PG8_MMA(1, 0, At, B0); PG8_MMA(1, 1, At, B1); PG8_BAR; PG8_SCHED;
        }
        if (wr == 0) PG8_BAR;
        E(acc, cur, wr, wc, fr, fq);
        if (!has_next) break;
#pragma unroll
        for (int a = 0; a < 2; ++a)
#pragma unroll
            for (int b = 0; b < 2; ++b)
#pragma unroll
                for (int m = 0; m < 4; ++m)
#pragma unroll
                    for (int n = 0; n < 2; ++n) acc[a][b][m][n] = (f32x4){0.f, 0.f, 0.f, 0.f};
        cur = nxt; cA = nA; cB = nB; ++ui;
        if (wr == 1) PG8_BAR;
    }
    PG8_WAIT_V(0);
    PG8_BAR;
#undef PG8_SA
#undef PG8_SB
#undef PG8_STAGE
#undef PG8_LDA
#undef PG8_LDB
#undef PG8_MMA
#undef PG8_WAIT_V
#undef PG8_WAIT_L
#undef PG8_BAR
#undef PG8_SCHED
}
}

struct EpiSwiglu {
    static constexpr bool PERM = true;
    bf16_t* O;
    __device__ __forceinline__ void operator()(const pg8::Acc& acc, const pg8::Unit& u, int wr, int wc, int fr, int fq) const {
        const int row0 = u.pm * 256 + wr * 64 + fr, col0 = u.pn * 128 + wc * 32 + 8 * fq;
#pragma unroll
        for (int ai = 0; ai < 2; ++ai)
#pragma unroll
            for (int m = 0; m < 4; ++m) {
                f32x4 v[2];
#pragma unroll
                for (int n = 0; n < 2; ++n)
#pragma unroll
                    for (int e = 0; e < 4; ++e) { const float gt = acc[ai][0][m][n][e], up = acc[ai][1][m][n][e]; v[n][e] = gt * fsigmoid(gt) * up; }
                *(u32x4*)(O + (size_t)(row0 + ai * 128 + m * 16) * FF + col0) = pack8(v[0], v[1]);
            }
    }
};
struct EpiResF32 {
    static constexpr bool PERM = false;
    const float* res; float* out; float a, b;
    __device__ __forceinline__ void operator()(const pg8::Acc& acc, const pg8::Unit& u, int wr, int wc, int fr, int fq) const {
        const int row0 = u.pm * 256 + wr * 64 + fr, col0 = u.pn * 256 + wc * 32 + 4 * fq;
#pragma unroll
        for (int ai = 0; ai < 2; ++ai)
#pragma unroll
            for (int m = 0; m < 4; ++m) {
                const size_t off = (size_t)(row0 + ai * 128 + m * 16) * DM + col0;
#pragma unroll
                for (int bj = 0; bj < 2; ++bj)
#pragma unroll
                    for (int n = 0; n < 2; ++n) { const f32x4 r = *(const f32x4*)(res + off + bj * 128 + n * 16); *(f32x4*)(out + off + bj * 128 + n * 16) = r * a + acc[ai][bj][m][n] * b; }
            }
    }
};
struct EpiResLnF32 {
    static constexpr bool PERM = false;
    const float* pre; const float* stats; const float* g; const float* beta; float* out; float a, b;
    __device__ __forceinline__ void operator()(const pg8::Acc& acc, const pg8::Unit& u, int wr, int wc, int fr, int fq) const {
        const int row0 = u.pm * 256 + wr * 64 + fr, col0 = u.pn * 256 + wc * 32 + 4 * fq;
#pragma unroll
        for (int ai = 0; ai < 2; ++ai)
#pragma unroll
            for (int m = 0; m < 4; ++m) {
                const int row = row0 + ai * 128 + m * 16; const size_t off = (size_t)row * DM + col0;
                const f32x2 st = *(const f32x2*)(stats + 2 * (size_t)row);
#pragma unroll
                for (int bj = 0; bj < 2; ++bj)
#pragma unroll
                    for (int n = 0; n < 2; ++n) { const int co = bj * 128 + n * 16;
                        const f32x4 r = *(const f32x4*)(pre + off + co), gv = *(const f32x4*)(g + col0 + co), bv = *(const f32x4*)(beta + col0 + co);
                        const f32x4 h = (r - st.x) * st.y * gv + bv;
                        *(f32x4*)(out + off + co) = h * a + acc[ai][bj][m][n] * b; }
                if (m & 1) asm volatile("" ::: "memory");
            }
    }
};
struct EpiWin {
    static constexpr bool PERM = true;
    bf16_t* proj; bf16_t* sigg; bf16_t* gn; const float* cs; bf16_t* kslf; bf16_t* kbf;
    __device__ __forceinline__ void operator()(const pg8::Acc& acc, const pg8::Unit& u, int wr, int wc, int fr, int fq) const {
        const int tile = u.pn, row0 = u.pm * 256 + wr * 64 + fr, cw = wc * 32 + 8 * fq;
        if (tile < 28) {
            const bool rope = (tile == 6) | (tile == 8) | (tile >= 10 && tile < 22);
            const int dcol = (tile < 6 ? tile : tile - 4) * 256;
            if (!rope) {
                if (tile == 7 || tile == 9) {
                    unsigned char* VF = (unsigned char*)kslf + (tile == 7 ? (size_t)8 << 20 : (size_t)24 << 20);
#pragma unroll
                    for (int ai = 0; ai < 2; ++ai)
#pragma unroll
                        for (int m = 0; m < 4; ++m) {
                            const int row = row0 + ai * 128 + m * 16, kp = row & 31;
                            const size_t rbase = (size_t)(row >> 5) * 4096 + (size_t)(((kp >> 2) & 3) * 16) * 8 + 4 * (kp >> 4) + (kp & 3);
#pragma unroll
                            for (int bj = 0; bj < 2; ++bj) {
                                const u32x2 w = pack8_fp8(acc[ai][bj][m][0], acc[ai][bj][m][1]);
                                unsigned char* vb = VF + (size_t)bj * 512 * 4096 + rbase + (size_t)(cw >> 4) * 512 + (size_t)(cw & 15) * 8;
                                vb[0] = (unsigned char)(w.x & 0xffu); vb[8] = (unsigned char)((w.x >> 8) & 0xffu); vb[16] = (unsigned char)((w.x >> 16) & 0xffu); vb[24] = (unsigned char)(w.x >> 24);
                                vb[32] = (unsigned char)(w.y & 0xffu); vb[40] = (unsigned char)((w.y >> 8) & 0xffu); vb[48] = (unsigned char)((w.y >> 16) & 0xffu); vb[56] = (unsigned char)(w.y >> 24);
                            }
                        }
                } else if (tile >= 22) {
                    unsigned char* VB = (unsigned char*)kbf + ((size_t)48 << 20);
#pragma unroll
                    for (int ai = 0; ai < 2; ++ai)
#pragma unroll
                        for (int m = 0; m < 4; ++m) {
                            const int row = row0 + ai * 128 + m * 16;
#pragma unroll
                            for (int bj = 0; bj < 2; ++bj) {
                                const int hd = 2 * (tile - 22) + bj, sh = 2 * (hd >> 2), tp = ((row & ((1 << sh) - 1)) << (14 - sh)) + (row >> sh), kp = tp & 31;
                                const u32x2 w = pack8_fp8(acc[ai][bj][m][0], acc[ai][bj][m][1]);
                                unsigned char* vb = VB + (((size_t)hd * 512 + (tp >> 5)) * 8 + (cw >> 4)) * 512 + (size_t)(((kp >> 2) & 3) * 16 + (cw & 15)) * 8 + 4 * (kp >> 4) + (kp & 3);
                                vb[0] = (unsigned char)(w.x & 0xffu); vb[8] = (unsigned char)((w.x >> 8) & 0xffu); vb[16] = (unsigned char)((w.x >> 16) & 0xffu); vb[24] = (unsigned char)(w.x >> 24);
                                vb[32] = (unsigned char)(w.y & 0xffu); vb[40] = (unsigned char)((w.y >> 8) & 0xffu); vb[48] = (unsigned char)((w.y >> 16) & 0xffu); vb[56] = (unsigned char)(w.y >> 24);
                            }
                        }
                } else {
#pragma unroll
                    for (int ai = 0; ai < 2; ++ai)
#pragma unroll
                        for (int m = 0; m < 4; ++m)
#pragma unroll
                            for (int bj = 0; bj < 2; ++bj)
                                *(u32x4*)(proj + (size_t)(row0 + ai * 128 + m * 16) * PLD + dcol + bj * 128 + cw) = pack8(acc[ai][bj][m][0], acc[ai][bj][m][1]);
                }
            } else {
                const int head = cw >> 6, d = cw & 63;
                const bool frag = (tile == 6) | (tile == 8);
                unsigned char* KF = (unsigned char*)kslf + (tile == 6 ? (size_t)0 : (size_t)16 << 20); const float* sn = cs + (size_t)S * 64;
#pragma unroll
                for (int ai = 0; ai < 2; ++ai)
#pragma unroll
                    for (int m = 0; m < 4; ++m) {
                        const int row = row0 + ai * 128 + m * 16;
                        f32x4 o1[2], o2[2];
#pragma unroll
                        for (int n = 0; n < 2; ++n) {
                            const f32x4 c = *(const f32x4*)(cs + (size_t)row * 64 + d + 4 * n), sv = *(const f32x4*)(sn + (size_t)row * 64 + d + 4 * n);
                            const f32x4 x1 = acc[ai][0][m][n], x2 = acc[ai][1][m][n];
                            o1[n] = x1 * c - x2 * sv; o2[n] = x2 * c + x1 * sv;
                        }
                        if (frag) {
                            unsigned char* kb = KF + ((size_t)head * 1024 + (row >> 4)) * 2048 + (size_t)(d >> 5) * 512 + (size_t)(((d >> 3) & 3) * 16 + (row & 15)) * 8;
                            *(u32x2*)kb = pack8_fp8(o1[0], o1[1]); *(u32x2*)(kb + 1024) = pack8_fp8(o2[0], o2[1]);
                        } else if (tile >= 16) {
                            const int hd = 2 * (tile - 16) + head, sh = 2 * (hd >> 2), tp = ((row & ((1 << sh) - 1)) << (14 - sh)) + (row >> sh);
                            unsigned char* kb = (unsigned char*)kbf + ((size_t)hd * 1024 + (tp >> 4)) * 2048 + (size_t)(d >> 5) * 512 + (size_t)(((d >> 3) & 3) * 16 + (tp & 15)) * 8;
                            *(u32x2*)kb = pack8_fp8(o1[0], o1[1]); *(u32x2*)(kb + 1024) = pack8_fp8(o2[0], o2[1]);
                        } else {
                            bf16_t* p = proj + (size_t)row * PLD + dcol + head * 128 + d;
                            *(u32x4*)p = pack8(o1[0], o1[1]); *(u32x4*)(p + 64) = pack8(o2[0], o2[1]);
                        }
                        if (m & 1) asm volatile("" ::: "memory");
                    }
            }
        } else if (tile < 44) {
#pragma unroll
            for (int ai = 0; ai < 2; ++ai)
#pragma unroll
                for (int m = 0; m < 4; ++m)
#pragma unroll
                    for (int bj = 0; bj < 2; ++bj) {
                        f32x4 v[2];
#pragma unroll
                        for (int n = 0; n < 2; ++n)
#pragma unroll
                            for (int e = 0; e < 4; ++e) v[n][e] = fsigmoid(acc[ai][bj][m][n][e]);
                        *(u32x4*)(sigg + (size_t)(row0 + ai * 128 + m * 16) * 4096 + (tile - 28) * 256 + bj * 128 + cw) = pack8(v[0], v[1]);
                    }
        } else {
            if (wc == 0) {
#pragma unroll
                for (int ai = 0; ai < 2; ++ai)
#pragma unroll
                    for (int m = 0; m < 4; ++m) {
                        f32x4 v[2];
#pragma unroll
                        for (int n = 0; n < 2; ++n)
#pragma unroll
                            for (int e = 0; e < 4; ++e) v[n][e] = fsigmoid(acc[ai][0][m][n][e]);
                        *(u32x4*)(gn + (size_t)(row0 + ai * 128 + m * 16) * 32 + cw) = pack8(v[0], v[1]);
                    }
            }
        }
    }
};
template <bool FIRST> struct EpiGate {
    static constexpr bool PERM = true;
    const bf16_t* sg; bf16_t* O;
    __device__ __forceinline__ void operator()(const pg8::Acc& acc, const pg8::Unit& u, int wr, int wc, int fr, int fq) const {
        const int row0 = u.pm * 256 + wr * 64 + fr, col0 = u.pn * 256 + wc * 32 + 8 * fq;
#pragma unroll
        for (int ai = 0; ai < 2; ++ai)
#pragma unroll
            for (int m = 0; m < 4; ++m)
#pragma unroll
                for (int bj = 0; bj < 2; ++bj) {
                    const int row = row0 + ai * 128 + m * 16, col = col0 + bj * 128;
                    const u32x4 gv = *(const u32x4*)(sg + (size_t)row * 4096 + col);
                    u32x4 pv = (u32x4){0u, 0u, 0u, 0u}; if (!FIRST) pv = *(const u32x4*)(O + (size_t)row * DM + col);
                    f32x4 v[2];
#pragma unroll
                    for (int n = 0; n < 2; ++n) {
                        const unsigned g0 = n ? gv.z : gv.x, g1 = n ? gv.w : gv.y, p0 = n ? pv.z : pv.x, p1 = n ? pv.w : pv.y;
                        const f32x4 y = acc[ai][bj][m][n];
                        v[n][0] = bflo(p0) + bflo(g0) * y[0]; v[n][1] = bfhi(p0) + bfhi(g0) * y[1];
                        v[n][2] = bflo(p1) + bflo(g1) * y[2]; v[n][3] = bfhi(p1) + bfhi(g1) * y[3];
                    }
                    *(u32x4*)(O + (size_t)row * DM + col) = pack8(v[0], v[1]);
                }
    }
};

template <bool FRAG = false>
__device__ __forceinline__ void tr_item(const float* W, int ldw, int k0, int scol0, int nvalid, bf16_t* WT, int ldt, int drow0, int dk0, LAS float* scr, int lane) {
    const int c = lane & 31;
    float v[32];
#pragma unroll
    for (int i = 0; i < 32; ++i) { const int kk = 2 * i + (lane >> 5); v[i] = (c < nvalid) ? W[(size_t)(k0 + kk) * ldw + scol0 + c] : 0.f; }
#pragma unroll
    for (int i = 0; i < 32; ++i) { const int kk = 2 * i + (lane >> 5); scr[kk * 33 + c] = v[i]; }
    asm volatile("s_waitcnt lgkmcnt(0)" ::: "memory");
    const int c8 = lane & 7;
#pragma unroll
    for (int j = 0; j < 4; ++j) { const int n = (lane >> 3) + 8 * j; const LAS float* s = scr + (8 * c8) * 33 + n;
        u32x4 o; o.x = cvt_pk_bf16(s[0 * 33], s[1 * 33]); o.y = cvt_pk_bf16(s[2 * 33], s[3 * 33]); o.z = cvt_pk_bf16(s[4 * 33], s[5 * 33]); o.w = cvt_pk_bf16(s[6 * 33], s[7 * 33]);
        if (FRAG) { const int c = drow0 + n, k = dk0 + 8 * c8; *(u32x4*)(WT + ((size_t)((c >> 4) * (ldt >> 5) + (k >> 5)) * 64 + ((k >> 3) & 3) * 16 + (c & 15)) * 8) = o; }
        else *(u32x4*)(WT + (size_t)(drow0 + n) * ldt + dk0 + 8 * c8) = o; }
    asm volatile("s_waitcnt lgkmcnt(0)" ::: "memory");
}
struct TrP { const float* W; int ldw, k0, scol0, nvalid; bf16_t* WT; int ldt, drow0, dk0; };
__device__ __forceinline__ void tr_load(float (&v)[32], const TrP& q, int lane) {
    const int c = lane & 31;
#pragma unroll
    for (int i = 0; i < 32; ++i) { const int kk = 2 * i + (lane >> 5); v[i] = (c < q.nvalid) ? q.W[(size_t)(q.k0 + kk) * q.ldw + q.scol0 + c] : 0.f; }
}
__device__ __forceinline__ void tr_store(const float (&v)[32], const TrP& q, LAS float* scr, int lane) {
    const int c = lane & 31;
#pragma unroll
    for (int i = 0; i < 32; ++i) { const int kk = 2 * i + (lane >> 5); scr[kk * 33 + c] = v[i]; }
    asm volatile("s_waitcnt lgkmcnt(0)" ::: "memory");
    const int c8 = lane & 7;
#pragma unroll
    for (int j = 0; j < 4; ++j) { const int n = (lane >> 3) + 8 * j; const LAS float* s = scr + (8 * c8) * 33 + n;
        u32x4 o; o.x = cvt_pk_bf16(s[0 * 33], s[1 * 33]); o.y = cvt_pk_bf16(s[2 * 33], s[3 * 33]); o.z = cvt_pk_bf16(s[4 * 33], s[5 * 33]); o.w = cvt_pk_bf16(s[6 * 33], s[7 * 33]);
        *(u32x4*)(q.WT + (size_t)(q.drow0 + n) * q.ldt + q.dk0 + 8 * c8) = o; }
    asm volatile("s_waitcnt lgkmcnt(0)" ::: "memory");
}
template <class F>
__device__ __forceinline__ void tr_stream(int n, int gw, int ngw, const F& params, LAS float* scr, int lane) {
    int it = gw; if (it >= n) return;
    float va[32], vb[32];
    TrP pa = params(it), pb = pa; tr_load(va, pa, lane);
    for (;;) {
        const int it2 = it + ngw; const bool has2 = it2 < n;
        if (has2) { pb = params(it2); tr_load(vb, pb, lane); }
        tr_store(va, pa, scr, lane);
        if (!has2) break;
        const int it3 = it2 + ngw; const bool has3 = it3 < n;
        if (has3) { pa = params(it3); tr_load(va, pa, lane); }
        tr_store(vb, pb, scr, lane);
        if (!has3) break;
        it = it3;
    }
}
__device__ __forceinline__ int win_src_col(int r) {
    if (r >= WIN_SRC) return -1;
    if (r >= 11264) return 2560 + (r - 11264);
    const int tile = r >> 8; int j = r & 255;
    const bool rope = (tile == 6) | (tile == 8) | (tile >= 10 && tile < 22);
    if (rope) { const int q = j >> 6, d = j & 63; j = (q & 1) * 128 + (q >> 1) * 64 + d; }
    const int c = tile * 256 + j;
    return c < 2560 ? c : c + 24;
}
__device__ __forceinline__ void conv_ffn(const float* Wg, const float* Wu, const float* Wd, bf16_t* GU, bf16_t* DN, LAS float* scr, int gw, int ngw, int lane) {
    constexpr int I_G = 32 * 176;
    tr_stream(2 * I_G, gw, ngw, [&](int it) { const int which = it / I_G, r = it % I_G, kb = r / 176, nb = r % 176, c0 = nb * 32;
        return TrP{which ? Wu : Wg, FF, kb * 64, c0, 32, GU, DM, 256 * (c0 >> 7) + (c0 & 127) + which * 128, kb * 64}; }, scr, lane);
    tr_stream(88 * 64, gw, ngw, [&](int it) { const int kb = it / 64, nb = it % 64; return TrP{Wd, DM, kb * 64, nb * 32, 32, DN, FF, nb * 32, kb * 64}; }, scr, lane);
}
__device__ __forceinline__ void ln_rows(const float* in, float* outf, bf16_t* outb, const float* g, const float* b, int gw, int ngw, int lane, float* stats = nullptr) {
    f32x4 gv[8], bv[8];
#pragma unroll
    for (int j = 0; j < 8; ++j) { gv[j] = *(const f32x4*)(g + 4 * (lane + 64 * j)); bv[j] = *(const f32x4*)(b + 4 * (lane + 64 * j)); }
    for (int row = gw; row < S; row += ngw) {
        const float* xr = in + (size_t)row * DM; f32x4 v[8]; float s = 0.f;
#pragma unroll
        for (int j = 0; j < 8; ++j) { v[j] = *(const f32x4*)(xr + 4 * (lane + 64 * j)); s += (v[j][0] + v[j][1]) + (v[j][2] + v[j][3]); }
        const float mean = wave_sum(s) * (1.f / DM); float s2 = 0.f;
#pragma unroll
        for (int j = 0; j < 8; ++j) { v[j] = v[j] - mean; s2 += (v[j][0] * v[j][0] + v[j][1] * v[j][1]) + (v[j][2] * v[j][2] + v[j][3] * v[j][3]); }
        const float rstd = 1.f / sqrtf(wave_sum(s2) * (1.f / DM) + LN_EPS);
        if (stats && lane == 0) *(f32x2*)(stats + 2 * (size_t)row) = (f32x2){mean, rstd};
#pragma unroll
        for (int j = 0; j < 8; ++j) { const f32x4 o = v[j] * rstd * gv[j] + bv[j];
            if (outf) *(f32x4*)(outf + (size_t)row * DM + 4 * (lane + 64 * j)) = o;
            if (outb) { u32x2 w; w.x = cvt_pk_bf16(o[0], o[1]); w.y = cvt_pk_bf16(o[2], o[3]); *(u32x2*)(outb + (size_t)row * DM + 4 * (lane + 64 * j)) = w; } }
    }
}

struct AState { float m, l; f32x4 o[8]; };
__device__ __forceinline__ void astate_init(AState& s) { s.m = -1e30f; s.l = 0.f;
#pragma unroll
    for (int i = 0; i < 8; ++i) s.o[i] = (f32x4){0.f, 0.f, 0.f, 0.f}; }
__device__ __forceinline__ int clampi(int v, int lo, int hi) { return v < lo ? lo : (v > hi ? hi : v); }

__device__ __forceinline__ void load_k(bf16x8 (&kf)[2][4], const bf16_t* __restrict__ Kb, int ld, int pos0, int dpos, int posmax, int l16, int kq) {
#pragma unroll
    for (int T = 0; T < 2; ++T) { const int p = clampi(pos0 + dpos * (16 * T + l16), 0, posmax); const bf16_t* kp = Kb + (size_t)p * ld + 8 * kq;
#pragma unroll
        for (int s = 0; s < 4; ++s) kf[T][s] = *(const bf16x8*)(kp + 32 * s); }
}
__device__ __forceinline__ void load_v(u32x4 (&vr)[8], const bf16_t* __restrict__ Vb, int ld, int pos0, int dpos, int posmax, int l16, int kq) {
#pragma unroll
    for (int i = 0; i < 8; ++i) { const int p = clampi(pos0 + dpos * (4 * i + kq), 0, posmax); vr[i] = *(const u32x4*)(Vb + (size_t)p * ld + 8 * l16); }
}
__device__ __forceinline__ void store_v(const u32x4 (&vr)[8], LAS unsigned char* vbuf, int l16, int kq) {
#pragma unroll
    for (int i = 0; i < 8; ++i) *(LAS u32x4*)(vbuf + (4 * i + kq) * VROW + 16 * l16) = vr[i];
}
template <int MODE, bool SLC, class Desc>
__device__ __forceinline__ void attn_run(const bf16x8 (&qf)[4], const bf16_t* __restrict__ Kb, const bf16_t* __restrict__ Vb, int ld, int dpos, int posmax,
                                         const Desc& desc, int n, int lo_in, int hi, int qi, AState& st, LAS unsigned char* vbuf, int lane, LAS float* imp = nullptr) {
    if (n <= 0) return;
    const int l16 = lane & 15, kq = lane >> 4;
    u32x4 kr[8];
    int dcur = desc(0);
    load_v(kr, Kb, ld, SLC ? (dcur & 0xfffff) : dcur, dpos, posmax, l16, kq);
#pragma unroll 1
    for (int i = 0; i < n; ++i) {
        const int pos0 = SLC ? (dcur & 0xfffff) : dcur;
        const int lo = SLC ? ((((dcur >> 20) == qi) | ((dcur >> 20) == 4)) ? 0 : (1 << 30)) : lo_in;
        store_v(kr, vbuf, l16, kq);
        u32x4 vr[8];
        if (MODE != 1) load_v(vr, Vb, ld, pos0, dpos, posmax, l16, kq);
        bf16x8 kf[2][4];
#pragma unroll
        for (int T = 0; T < 2; ++T)
#pragma unroll
            for (int s = 0; s < 4; ++s) kf[T][s] = *(const LAS bf16x8*)(vbuf + (16 * T + l16) * VROW + 64 * s + 16 * kq);
        f32x4 sa[2] = {(f32x4){0.f, 0.f, 0.f, 0.f}, (f32x4){0.f, 0.f, 0.f, 0.f}};
#pragma unroll
        for (int T = 0; T < 2; ++T)
#pragma unroll
            for (int s = 0; s < 4; ++s) sa[T] = __builtin_amdgcn_mfma_f32_16x16x32_bf16(kf[T][s], qf[s], sa[T], 0, 0, 0);
        const int dnext = desc(i + 1 < n ? i + 1 : i);
        load_v(kr, Kb, ld, SLC ? (dnext & 0xfffff) : dnext, dpos, posmax, l16, kq);
        float sc[8]; bool vd[8]; float mx = -1e30f;
#pragma unroll
        for (int T = 0; T < 2; ++T)
#pragma unroll
            for (int r = 0; r < 4; ++r) { const int p = pos0 + dpos * (16 * T + 4 * kq + r); const bool v = (p >= lo) & (p <= hi); const float x = sa[T][r] * SL2;
                sc[4 * T + r] = x; vd[4 * T + r] = v; mx = v ? fmaxf(mx, x) : mx; }
        float p[8];
        if (MODE == 2) {
#pragma unroll
            for (int j = 0; j < 8; ++j) p[j] = vd[j] ? __builtin_amdgcn_exp2f(sc[j] - st.m) * st.l : 0.f;
#pragma unroll
            for (int T = 0; T < 2; ++T) {
                float x = 2.f * (p[4 * T] + p[4 * T + 1] + p[4 * T + 2]) + p[4 * T + 3], y = p[4 * T + 3];
                x += quad_xor1(x); x += quad_xor2(x); y += quad_xor1(y); y += quad_xor2(y);
                if ((l16 & 3) == 0) { const int a = (pos0 >> 2) + 4 * T + kq; LAS float* ip = imp + (l16 >> 2) * IMP_LD + a;
                    ip[0] += x;
                    asm volatile("s_waitcnt lgkmcnt(0)" ::: "memory");
                    ip[1] += y; }
                asm volatile("s_waitcnt lgkmcnt(0)" ::: "memory");
            }
        } else {
            if (__builtin_amdgcn_ballot_w64(mx > st.m + 40.f) != 0ull) {
                mx = fmaxf(mx, __shfl_xor(mx, 16)); mx = fmaxf(mx, __shfl_xor(mx, 32));
                const float mn = fmaxf(st.m, mx), alpha = __builtin_amdgcn_exp2f(st.m - mn); st.m = mn; st.l *= alpha;
                if (MODE == 0) {
#pragma unroll
                    for (int j = 0; j < 8; ++j) st.o[j] = st.o[j] * alpha;
                }
            }
            float ps = 0.f;
#pragma unroll
            for (int j = 0; j < 8; ++j) { p[j] = vd[j] ? __builtin_amdgcn_exp2f(sc[j] - st.m) : 0.f; ps += p[j]; }
            st.l += ps;
        }
        if (MODE != 1) {
            store_v(vr, vbuf, l16, kq);
            u32x4 pw; pw.x = cvt_pk_bf16(p[0], p[1]); pw.y = cvt_pk_bf16(p[2], p[3]); pw.z = cvt_pk_bf16(p[4], p[5]); pw.w = cvt_pk_bf16(p[6], p[7]);
            const bf16x8 pf = __builtin_bit_cast(bf16x8, pw);
            const unsigned addr = (unsigned)(uintptr_t)(vbuf) + (4 * kq + (l16 >> 2)) * VROW + (l16 & 3) * 8;
#pragma unroll
            for (int hf = 0; hf < 2; ++hf) {
                s16x4 a[8];
                asm volatile("s_waitcnt lgkmcnt(0)\n\t"
                             "ds_read_b64_tr_b16 %0, %8 offset:0\n\t"    "ds_read_b64_tr_b16 %1, %8 offset:32\n\t"
                             "ds_read_b64_tr_b16 %2, %8 offset:64\n\t"   "ds_read_b64_tr_b16 %3, %8 offset:96\n\t"
                             "ds_read_b64_tr_b16 %4, %8 offset:4608\n\t" "ds_read_b64_tr_b16 %5, %8 offset:4640\n\t"
                             "ds_read_b64_tr_b16 %6, %8 offset:4672\n\t" "ds_read_b64_tr_b16 %7, %8 offset:4704\n\t"
                             "s_waitcnt lgkmcnt(0)"
                             : "=&v"(a[0]), "=&v"(a[1]), "=&v"(a[2]), "=&v"(a[3]), "=&v"(a[4]), "=&v"(a[5]), "=&v"(a[6]), "=&v"(a[7])
                             : "v"(addr + 128 * hf) : "memory");
#pragma unroll
                for (int d4 = 0; d4 < 4; ++d4) { const int db = 4 * hf + d4;
                    bf16x8 af; af[0] = a[d4][0]; af[1] = a[d4][1]; af[2] = a[d4][2]; af[3] = a[d4][3]; af[4] = a[d4 + 4][0]; af[5] = a[d4 + 4][1]; af[6] = a[d4 + 4][2]; af[7] = a[d4 + 4][3];
                    st.o[db] = __builtin_amdgcn_mfma_f32_16x16x32_bf16(af, pf, st.o[db], 0, 0, 0); }
            }
        }
        dcur = dnext;
    }
}
struct FragV { bf16x8 v[8]; };
__device__ __forceinline__ void load_fk(bf16x8 (&k)[2][4], const bf16_t* __restrict__ KF, int pos0, int lane) {
    const bf16_t* kp = KF + ((size_t)(pos0 >> 4) * 256 + lane) * 8;
#pragma unroll
    for (int T = 0; T < 2; ++T)
#pragma unroll
        for (int s2 = 0; s2 < 4; ++s2) k[T][s2] = *(const bf16x8*)(kp + (T * 4 + s2) * 512);
}
__device__ __forceinline__ void load_fv(FragV& f, const bf16_t* __restrict__ VF, int pos0, int lane) {
    const bf16_t* vp = VF + ((size_t)(pos0 >> 5) * 512 + lane) * 8;
#pragma unroll
    for (int db = 0; db < 8; ++db) f.v[db] = *(const bf16x8*)(vp + db * 512);
}
template <int MODE>
__device__ __forceinline__ void step_fragb(const bf16x8 (&qf)[4], bf16x8 (&kf)[2][4], FragV& cur, const bf16_t* __restrict__ KF, const bf16_t* __restrict__ VF,
                                           int pos0, int pnext, int lo, int hi, AState& st, int lane, LAS float* imp) {
    const int kq = lane >> 4;
    f32x4 sa[2] = {(f32x4){0.f, 0.f, 0.f, 0.f}, (f32x4){0.f, 0.f, 0.f, 0.f}};
#pragma unroll
    for (int T = 0; T < 2; ++T)
#pragma unroll
        for (int s2 = 0; s2 < 4; ++s2) sa[T] = __builtin_amdgcn_mfma_f32_16x16x32_bf16(kf[T][s2], qf[s2], sa[T], 0, 0, 0);
    load_fk(kf, KF, pnext, lane);
    float sc[8]; bool vd[8]; float mx = -1e30f;
#pragma unroll
    for (int T = 0; T < 2; ++T)
#pragma unroll
        for (int r = 0; r < 4; ++r) { const int p = pos0 + 16 * T + 4 * kq + r; const bool v = (p >= lo) & (p <= hi); const float x = sa[T][r] * SL2;
            sc[4 * T + r] = x; vd[4 * T + r] = v; mx = v ? fmaxf(mx, x) : mx; }
    float p[8];
    if (MODE == 2) {
        const int l16 = lane & 15;
#pragma unroll
        for (int j = 0; j < 8; ++j) p[j] = vd[j] ? __builtin_amdgcn_exp2f(sc[j] - st.m) * st.l : 0.f;
#pragma unroll
        for (int T = 0; T < 2; ++T) {
            float x = 2.f * (p[4 * T] + p[4 * T + 1] + p[4 * T + 2]) + p[4 * T + 3], y = p[4 * T + 3];
            x += quad_xor1(x); x += quad_xor2(x); y += quad_xor1(y); y += quad_xor2(y);
            if ((l16 & 3) == 0) { const int a = (pos0 >> 2) + 4 * T + kq; LAS float* ip = imp + (l16 >> 2) * IMP_LD + a;
                ip[0] += x;
                asm volatile("s_waitcnt lgkmcnt(0)" ::: "memory");
                ip[1] += y; }
            asm volatile("s_waitcnt lgkmcnt(0)" ::: "memory");
        }
    } else {
        if (__builtin_amdgcn_ballot_w64(mx > st.m + 40.f) != 0ull) {
            mx = fmaxf(mx, __shfl_xor(mx, 16)); mx = fmaxf(mx, __shfl_xor(mx, 32));
            const float mn = fmaxf(st.m, mx), alpha = __builtin_amdgcn_exp2f(st.m - mn); st.m = mn; st.l *= alpha;
            if (MODE == 0) {
#pragma unroll
                for (int j = 0; j < 8; ++j) st.o[j] = st.o[j] * alpha;
            }
        }
        float ps = 0.f;
#pragma unroll
        for (int j = 0; j < 8; ++j) { p[j] = vd[j] ? __builtin_amdgcn_exp2f(sc[j] - st.m) : 0.f; ps += p[j]; }
        st.l += ps;
    }
    if (MODE != 1) {
        u32x4 pw; pw.x = cvt_pk_bf16(p[0], p[1]); pw.y = cvt_pk_bf16(p[2], p[3]); pw.z = cvt_pk_bf16(p[4], p[5]); pw.w = cvt_pk_bf16(p[6], p[7]);
        const bf16x8 pf = __builtin_bit_cast(bf16x8, pw);
#pragma unroll
        for (int db = 0; db < 8; ++db) st.o[db] = __builtin_amdgcn_mfma_f32_16x16x32_bf16(cur.v[db], pf, st.o[db], 0, 0, 0);
        load_fv(cur, VF, pnext, lane);
    }
}
template <int MODE, bool SLC, class Desc>
__device__ __forceinline__ void attn_run_frag(const bf16x8 (&qf)[4], const bf16_t* __restrict__ KF, const bf16_t* __restrict__ VF, const Desc& desc, int n,
                                              int lo_in, int hi, int qi, AState& st, int lane, LAS float* imp = nullptr) {
    static_assert(!SLC, "the bf16 fragment walk is used without per-step query selection");
    if (n <= 0) return;
    bf16x8 kf[2][4]; FragV va;
    int d0 = desc(0);
    load_fk(kf, KF, d0, lane);
    if (MODE != 1) load_fv(va, VF, d0, lane);
#pragma unroll 1
    for (int i = 0; i < n; ++i) {
        const int d1 = desc(i + 1 < n ? i + 1 : i);
        step_fragb<MODE>(qf, kf, va, KF, VF, d0, d1, lo_in, hi, st, lane, imp);
        d0 = d1;
    }
}
struct Frag8 { i64_t k[2][4]; i64_t v[8]; };
__device__ __forceinline__ void load_frag8(Frag8& f, const unsigned char* __restrict__ KF, const unsigned char* __restrict__ VF, int pos0, int lane) {
    const unsigned char* kp = KF + ((size_t)(pos0 >> 4) * 256 + lane) * 8; const unsigned char* vp = VF + ((size_t)(pos0 >> 5) * 512 + lane) * 8;
#pragma unroll
    for (int T = 0; T < 2; ++T)
#pragma unroll
        for (int s2 = 0; s2 < 4; ++s2) f.k[T][s2] = *(const i64_t*)(kp + (T * 4 + s2) * 512);
#pragma unroll
    for (int db = 0; db < 8; ++db) f.v[db] = *(const i64_t*)(vp + db * 512);
}
template <bool SLC, bool NOMASK>
__device__ __forceinline__ void step_frag8(const i64_t (&qf)[4], const Frag8& cur, Frag8& nxt, const unsigned char* __restrict__ KF, const unsigned char* __restrict__ VF,
                                           int dcur, int dnext, int lo_in, int hi, int qi, AState& st, int lane) {
    const int kq = lane >> 4;
    const int pos0 = SLC ? (dcur & 0xfffff) : dcur;
    const int lo = SLC ? ((((dcur >> 20) == qi) | ((dcur >> 20) == 4)) ? 0 : (1 << 30)) : lo_in;
    load_frag8(nxt, KF, VF, SLC ? (dnext & 0xfffff) : dnext, lane);
    f32x4 sa[2] = {(f32x4){0.f, 0.f, 0.f, 0.f}, (f32x4){0.f, 0.f, 0.f, 0.f}};
#pragma unroll
    for (int T = 0; T < 2; ++T)
#pragma unroll
        for (int s2 = 0; s2 < 4; ++s2) sa[T] = __builtin_amdgcn_mfma_f32_16x16x32_fp8_fp8(cur.k[T][s2], qf[s2], sa[T], 0, 0, 0);
    float sc[8]; bool vd[8]; float mx = -1e30f;
    const bool act = lo == 0 || !SLC;
    if (NOMASK) {
#pragma unroll
        for (int j = 0; j < 8; ++j) { sc[j] = sa[j >> 2][j & 3]; vd[j] = act; }
        mx = fmaxf(fmaxf(fmaxf(sc[0], sc[1]), fmaxf(sc[2], sc[3])), fmaxf(fmaxf(sc[4], sc[5]), fmaxf(sc[6], sc[7])));
        mx = act ? mx : -1e30f;
    } else {
#pragma unroll
        for (int T = 0; T < 2; ++T)
#pragma unroll
            for (int r = 0; r < 4; ++r) { const int p = pos0 + 16 * T + 4 * kq + r; const bool v = (p >= lo) & (p <= hi); const float x = sa[T][r];
                sc[4 * T + r] = x; vd[4 * T + r] = v; mx = v ? fmaxf(mx, x) : mx; }
    }
    if (__builtin_amdgcn_ballot_w64(mx > st.m + 4.f) != 0ull) {
        mx = fmaxf(mx, __shfl_xor(mx, 16)); mx = fmaxf(mx, __shfl_xor(mx, 32));
        const float mn = fmaxf(st.m, mx), alpha = __builtin_amdgcn_exp2f(st.m - mn); st.m = mn; st.l *= alpha;
#pragma unroll
        for (int j = 0; j < 8; ++j) st.o[j] = st.o[j] * alpha;
    }
    f32x4 pa, pb; float ps = 0.f;
    const float mref = st.m - 4.f;
    if (NOMASK) {
#pragma unroll
        for (int j = 0; j < 4; ++j) { pa[j] = __builtin_amdgcn_exp2f(sc[j] - mref); pb[j] = __builtin_amdgcn_exp2f(sc[4 + j] - mref); }
        if (SLC) {
#pragma unroll
            for (int j = 0; j < 4; ++j) { pa[j] = act ? pa[j] : 0.f; pb[j] = act ? pb[j] : 0.f; }
        }
#pragma unroll
        for (int j = 0; j < 4; ++j) ps += pa[j] + pb[j];
    } else {
#pragma unroll
        for (int j = 0; j < 4; ++j) { pa[j] = vd[j] ? __builtin_amdgcn_exp2f(sc[j] - mref) : 0.f; pb[j] = vd[4 + j] ? __builtin_amdgcn_exp2f(sc[4 + j] - mref) : 0.f; ps += pa[j] + pb[j]; }
    }
    st.l += ps;
    const u32x2 pw = pack8_fp8(pa, pb);
    const i64_t pf = __builtin_bit_cast(i64_t, pw);
#pragma unroll
    for (int db = 0; db < 8; ++db) st.o[db] = __builtin_amdgcn_mfma_f32_16x16x32_fp8_fp8(cur.v[db], pf, st.o[db], 0, 0, 0);
}
template <bool SLC, class Desc>
__device__ __forceinline__ void attn_run_frag8(const i64_t (&qf)[4], const unsigned char* __restrict__ KF, const unsigned char* __restrict__ VF, const Desc& desc, int n,
                                               int lo_in, int hi, int qi, AState& st, int lane) {
    if (n <= 0) return;
    Frag8 fa, fb, fc;
    constexpr int NM = ~(1 << 30);
    int d0 = desc(0), d1 = desc(n > 1 ? 1 : 0);
    load_frag8(fa, KF, VF, SLC ? (d0 & 0xfffff) : (d0 & NM), lane);
    load_frag8(fb, KF, VF, SLC ? (d1 & 0xfffff) : (d1 & NM), lane);
#define F8_STEP(CUR, NXT2, DC, DN2) do { \
        if ((DC) & (1 << 30)) step_frag8<SLC, true>(qf, CUR, NXT2, KF, VF, (DC) & NM, (DN2) & NM, lo_in, hi, qi, st, lane); \
        else step_frag8<SLC, false>(qf, CUR, NXT2, KF, VF, (DC), (DN2) & NM, lo_in, hi, qi, st, lane); } while (0)
#pragma unroll 1
    for (int i = 0; i < n; i += 3) {
        const int d2 = desc(i + 2 < n ? i + 2 : n - 1);
        F8_STEP(fa, fc, d0, d2);
        if (i + 1 >= n) break;
        const int d3 = desc(i + 3 < n ? i + 3 : n - 1);
        F8_STEP(fb, fa, d1, d3);
        if (i + 2 >= n) break;
        const int d4 = desc(i + 4 < n ? i + 4 : n - 1);
        F8_STEP(fc, fb, d2, d4);
        d0 = d3; d1 = d4;
    }
#undef F8_STEP
}
__device__ __forceinline__ float quad_total(float v) { v += __shfl_xor(v, 16); v += __shfl_xor(v, 32); return v; }

__device__ __forceinline__ void dilated_unit(int unit, const bf16_t* proj, const bf16_t* kbf, bf16_t* nsaout, int lane) {
    const int l16 = lane & 15, kq = lane >> 4;
    const int hg = (unit >> 4) & 3, r16 = unit & 15, ut = unit >> 6;
    const int t0 = r16 + 256 * ut, tc = t0 + 16 * l16;
    const unsigned char* kb8 = (const unsigned char*)kbf; const unsigned char* vb8 = kb8 + ((size_t)48 << 20);
    AState st; astate_init(st);
#pragma unroll 1
    for (int pt = 0; pt < 3; ++pt) {
        const int sh = 2 * pt, head = 4 * pt + hg;
        const bf16_t* qrow = proj + (size_t)tc * PLD + PC_QB + head * 128 + 8 * kq;
        i64_t q8[4];
#pragma unroll
        for (int s = 0; s < 4; ++s) { const bf16x8 qv = *(const bf16x8*)(qrow + 32 * s); f32x4 a, b;
#pragma unroll
            for (int j = 0; j < 4; ++j) { a[j] = bf2f((unsigned short)qv[j]) * SL2; b[j] = bf2f((unsigned short)qv[4 + j]) * SL2; }
            q8[s] = __builtin_bit_cast(i64_t, pack8_fp8(a, b)); }
        const int base = (r16 & ((1 << sh) - 1)) << (14 - sh), u0 = t0 >> sh, ui = u0 + (16 >> sh) * l16;
        const int lo = base + (ui - 128 < 0 ? 0 : ui - 128), hi = base + ui;
        const int first = (base + (u0 - 128 < 0 ? 0 : u0 - 128)) >> 5, last = (base + u0 + 15 * (16 >> sh)) >> 5;
        unsigned long long hoff = (unsigned long long)head * S * 128; asm volatile("" : "+s"(hoff));
        auto desc = [&](int i) { return 32 * (first + i); };
        attn_run_frag8<false>(q8, kb8 + hoff, vb8 + hoff, desc, last - first + 1, lo, hi, 0, st, lane);
    }
    const float lt = quad_total(st.l), inv = lt > 0.f ? 1.f / lt : 0.f;
    bf16_t* op = nsaout + (size_t)tc * NOLD + 1024 + hg * 128 + 4 * kq;
#pragma unroll
    for (int db = 0; db < 8; ++db) { const f32x4 o = st.o[db] * inv; u32x2 w; w.x = cvt_pk_bf16(o[0], o[1]); w.y = cvt_pk_bf16(o[2], o[3]); *(u32x2*)(op + 16 * db) = w; }
}

__device__ __forceinline__ void compress_unit(int unit, const bf16_t* proj, const bf16_t* w1t, const bf16_t* w2t, const float* bias, bf16_t* outc, LAS unsigned char* lds, int wave, int lane) {
    const int l16 = lane & 15, kq = lane >> 4;
    const int rt = unit & 63, g = (unit >> 6) & 1, kv = unit >> 7;
    const bf16_t* raw = proj + (kv ? PC_VC : PC_KC) + 128 * g;
    const int n = 16 * rt + l16;
    f32x4 acc[16];
#pragma unroll
    for (int i = 0; i < 16; ++i) acc[i] = (f32x4){0.f, 0.f, 0.f, 0.f};
#pragma unroll 2
    for (int si = 0; si < 16; ++si) {
        const int s = 16 * wave + si;
        const int tok = clampi(16 * n + (s >> 2), 0, S - 1);
        const bf16x8 af = *(const bf16x8*)(raw + (size_t)tok * PLD + (s & 3) * 32 + 8 * kq);
#pragma unroll
        for (int ct = 0; ct < 16; ++ct) { const bf16x8 bfr = *(const bf16x8*)(w1t + ((size_t)(ct * 128 + s) * 64 + lane) * 8);
            acc[ct] = __builtin_amdgcn_mfma_f32_16x16x32_bf16(af, bfr, acc[ct], 0, 0, 0); }
    }
    LAS f32x4* part = (LAS f32x4*)lds;
#pragma unroll
    for (int ct = 0; ct < 16; ++ct) part[(wave * 16 + ct) * 64 + lane] = acc[ct];
    __syncthreads();
    LAS unsigned char* hid = lds + 131072;
#pragma unroll
    for (int c2 = 0; c2 < 2; ++c2) { const int ct = 2 * wave + c2; f32x4 sum = (f32x4){0.f, 0.f, 0.f, 0.f};
#pragma unroll
        for (int w = 0; w < 8; ++w) sum += part[(w * 16 + ct) * 64 + lane];
        const float bb = bias[16 * ct + l16];
#pragma unroll
        for (int r = 0; r < 4; ++r) { const float x = sum[r] + bb; const float u2 = 1.5957691216f * (x + 0.044715f * x * x * x); const float gl = x * fsigmoid(u2);
            *(LAS bf16_t*)(hid + (4 * kq + r) * 528 + (16 * ct + l16) * 2) = (bf16_t)(cvt_pk_bf16(gl, 0.f) & 0xffffu); } }
    __syncthreads();
    f32x4 o2 = (f32x4){0.f, 0.f, 0.f, 0.f};
    const int dt = wave;
#pragma unroll
    for (int s = 0; s < 8; ++s) {
        const bf16x8 af = *(const LAS bf16x8*)(hid + l16 * 528 + (32 * s + 8 * kq) * 2);
        const bf16x8 bfr = *(const bf16x8*)(w2t + (size_t)(16 * dt + l16) * 256 + 32 * s + 8 * kq);
        o2 = __builtin_amdgcn_mfma_f32_16x16x32_bf16(af, bfr, o2, 0, 0, 0);
    }
#pragma unroll
    for (int r = 0; r < 4; ++r) { const int nn = 16 * rt + 4 * kq + r, d = 16 * dt + l16;
        const bf16_t val = (bf16_t)(cvt_pk_bf16(o2[r], 0.f) & 0xffffu);
        if (kv == 0) outc[(((size_t)g * 64 + (nn >> 4)) * 4 + (d >> 5)) * 512 + (((d >> 3) & 3) * 16 + (nn & 15)) * 8 + (d & 7)] = val;
        else { const int kp = nn & 31; outc[(((size_t)g * 32 + (nn >> 5)) * 8 + (d >> 4)) * 512 + ((((kp >> 2) & 3) * 16) + (d & 15)) * 8 + 4 * (kp >> 4) + (kp & 3)] = val; } }
    __syncthreads();
}

__device__ __forceinline__ void nsa_unit(int unit, const bf16_t* proj, const bf16_t* kc, const bf16_t* vc, const bf16_t* gn, const float* cs, const float* sn,
                                         const bf16_t* kslf, const bf16_t* vslf, const bf16_t* kwnf, const bf16_t* vwnf, bf16_t* nsaout, LAS unsigned char* wl, int lane) {
    const int l16 = lane & 15, kq = lane >> 4;
    const int g = unit & 1, tb = unit >> 1, t0 = 4 * tb, qi = l16 >> 2, h = l16 & 3, tc = t0 + qi, head = 4 * g + h;
    LAS unsigned char* vbuf = wl; LAS float* imp = (LAS float*)(wl + VBUF_BYTES); LAS int* sel = (LAS int*)(wl + VBUF_BYTES + 4 * IMP_LD * 4);
    bf16x8 qf[4];
    { const bf16_t* qrow = proj + (size_t)tc * PLD + PC_QA + head * 128 + 8 * kq;
#pragma unroll
        for (int s = 0; s < 4; ++s) qf[s] = *(const bf16x8*)(qrow + 32 * s); }
    LAS u32x2* outl = (LAS u32x2*)(wl + OUT_OFF) + lane;
    for (int i = lane; i < 4 * IMP_LD; i += 64) imp[i] = 0.f;
    const int hic = (tc - 31) >> 4;
    const int nkmax = ((t0 + 3 - 31) >> 4) + 1, nsc = nkmax > 0 ? (nkmax + 31) >> 5 : 0;
    unsigned long long coff = (unsigned long long)g * 1024 * 128; asm volatile("" : "+s"(coff));
    const bf16_t* kcg = kc + coff; const bf16_t* vcg = vc + coff;
    AState st; astate_init(st);
    { auto desc = [&](int i) { return 32 * i; };
      attn_run_frag<1, false>(qf, kcg, vcg, desc, nsc, 0, hic, 0, st, lane);
      { const float lt = quad_total(st.l); st.l = lt > 0.f ? 1.f / lt : 0.f; }
      asm volatile("s_waitcnt lgkmcnt(0)" ::: "memory");
      attn_run_frag<2, false>(qf, kcg, vcg, desc, nsc, 0, hic, 0, st, lane, imp); }
    const float g0 = bf2f(gn[(size_t)tc * 32 + head * 3 + 0]);
#pragma unroll
    for (int i = 0; i < 8; ++i) { const f32x4 o = st.o[i] * g0; u32x2 w; w.x = cvt_pk_bf16(o[0], o[1]); w.y = cvt_pk_bf16(o[2], o[3]); outl[64 * i] = w; }
    asm volatile("s_waitcnt lgkmcnt(0)" ::: "memory");
#pragma unroll
    for (int s2 = 0; s2 < 2; ++s2) {
        const int d = 32 * s2 + 8 * kq; f32x4 c[2], sv[2];
        c[0] = *(const f32x4*)(cs + (size_t)tc * 64 + d); c[1] = *(const f32x4*)(cs + (size_t)tc * 64 + d + 4);
        sv[0] = *(const f32x4*)(sn + (size_t)tc * 64 + d); sv[1] = *(const f32x4*)(sn + (size_t)tc * 64 + d + 4);
        float o1[8], o2[8];
#pragma unroll
        for (int j = 0; j < 8; ++j) { const float x1 = bf2f((unsigned short)qf[s2][j]), x2 = bf2f((unsigned short)qf[s2 + 2][j]), cc = c[j >> 2][j & 3], ss = sv[j >> 2][j & 3];
            o1[j] = x1 * cc - x2 * ss; o2[j] = x2 * cc + x1 * ss; }
        u32x4 w1, w2; w1.x = cvt_pk_bf16(o1[0], o1[1]); w1.y = cvt_pk_bf16(o1[2], o1[3]); w1.z = cvt_pk_bf16(o1[4], o1[5]); w1.w = cvt_pk_bf16(o1[6], o1[7]);
        w2.x = cvt_pk_bf16(o2[0], o2[1]); w2.y = cvt_pk_bf16(o2[2], o2[3]); w2.z = cvt_pk_bf16(o2[4], o2[5]); w2.w = cvt_pk_bf16(o2[6], o2[7]);
        qf[s2] = __builtin_bit_cast(bf16x8, w1); qf[s2 + 2] = __builtin_bit_cast(bf16x8, w2);
    }
    unsigned key[4][4];
#pragma unroll
    for (int q = 0; q < 4; ++q) { const int cur = (t0 + q) >> 6; const f32x4 v = *(const LAS f32x4*)(imp + q * IMP_LD + 4 * lane);
#pragma unroll
        for (int i = 0; i < 4; ++i) { const int j = 4 * lane + i; const bool valid = j <= cur, forced = (j == 0) | (j == cur) | (j == cur - 1);
            const unsigned kb = forced ? 0xffffffu : ((__float_as_uint(fmaxf(v[i], 0.f)) >> 8) + 1u);
            key[q][i] = valid ? ((kb << 8) | (unsigned)(255 - j)) : 0u; } }
#pragma unroll 1
    for (int r = 0; r < 16; ++r) {
        unsigned mx[4];
#pragma unroll
        for (int q = 0; q < 4; ++q) { unsigned a = key[q][0] > key[q][1] ? key[q][0] : key[q][1], b = key[q][2] > key[q][3] ? key[q][2] : key[q][3]; mx[q] = a > b ? a : b; }
#pragma unroll
        for (int o = 1; o < 64; o <<= 1)
#pragma unroll
            for (int q = 0; q < 4; ++q) { const unsigned other = (unsigned)__shfl_xor((int)mx[q], o); mx[q] = other > mx[q] ? other : mx[q]; }
#pragma unroll
        for (int q = 0; q < 4; ++q) {
#pragma unroll
            for (int i = 0; i < 4; ++i) if (key[q][i] == mx[q]) key[q][i] = 0u;
            if (lane == 0) sel[q * 16 + r] = mx[q] ? (int)(255u - (mx[q] & 255u)) : -1;
        }
    }
    asm volatile("s_waitcnt lgkmcnt(0)" ::: "memory");
    i64_t q8[4];
#pragma unroll
    for (int s2 = 0; s2 < 4; ++s2) { f32x4 a, b;
#pragma unroll
        for (int j = 0; j < 4; ++j) { a[j] = bf2f((unsigned short)qf[s2][j]) * SL2; b[j] = bf2f((unsigned short)qf[s2][4 + j]) * SL2; }
        q8[s2] = __builtin_bit_cast(i64_t, pack8_fp8(a, b)); }
    LAS int* list = (LAS int*)(wl + VBUF_BYTES + 4 * IMP_LD * 4 + 256);
    int nslc;
    { const int b = sel[lane], q = lane >> 4, cur0 = t0 >> 6;
      const bool forced = (b == 0) | (b == cur0) | (b == cur0 - 1);
      const bool valid = (b >= 0) & !(forced & (q > 0)); const unsigned long long mask = __ballot(valid);
      const int idx = __popcll(mask & ((1ull << lane) - 1ull)); nslc = 2 * __popcll(mask);
      if (valid) { const int qc = (forced ? 4 : q) | (b < cur0 ? (1 << 10) : 0);
                   list[2 * idx] = (64 * b) | (qc << 20); list[2 * idx + 1] = (64 * b + 32) | (qc << 20); } }
    asm volatile("s_waitcnt lgkmcnt(0)" ::: "memory");
    astate_init(st);
    { auto desc = [&](int i) { return __builtin_amdgcn_readfirstlane(list[i]); };
      unsigned long long goff = (unsigned long long)g * S * 128; asm volatile("" : "+s"(goff));
      attn_run_frag8<true>(q8, (const unsigned char*)kslf + goff, (const unsigned char*)kslf + ((size_t)8 << 20) + goff, desc, nslc, 0, tc, qi, st, lane); }
    { const float g1 = bf2f(gn[(size_t)tc * 32 + head * 3 + 1]); const float lt = quad_total(st.l), inv = (lt > 0.f ? 1.f / lt : 0.f) * g1;
#pragma unroll
        for (int i = 0; i < 8; ++i) { const f32x4 o = st.o[i] * inv; u32x2 w = outl[64 * i]; w.x = cvt_pk_bf16(bflo(w.x) + o[0], bfhi(w.x) + o[1]); w.y = cvt_pk_bf16(bflo(w.y) + o[2], bfhi(w.y) + o[3]); outl[64 * i] = w; } }
    astate_init(st);
    { const int lo = tc - 511 < 0 ? 0 : tc - 511; const int first = t0 < 511 ? 0 : (t0 - 511) >> 5, last = (t0 + 3) >> 5;
      auto desc = [&](int i) { const int p0 = 32 * (first + i); return p0 | ((p0 >= t0 + 3 - 511 && p0 + 31 <= t0) ? (1 << 30) : 0); };
      unsigned long long goff = (unsigned long long)g * S * 128; asm volatile("" : "+s"(goff));
      attn_run_frag8<false>(q8, (const unsigned char*)kslf + ((size_t)16 << 20) + goff, (const unsigned char*)kslf + ((size_t)24 << 20) + goff, desc, last - first + 1, lo, tc, 0, st, lane); }
    { const float g2 = bf2f(gn[(size_t)tc * 32 + head * 3 + 2]); const float lt = quad_total(st.l), inv = (lt > 0.f ? 1.f / lt : 0.f) * g2;
#pragma unroll
        for (int i = 0; i < 8; ++i) { const f32x4 o = st.o[i] * inv; u32x2 w = outl[64 * i]; w.x = cvt_pk_bf16(bflo(w.x) + o[0], bfhi(w.x) + o[1]); w.y = cvt_pk_bf16(bflo(w.y) + o[2], bfhi(w.y) + o[3]); outl[64 * i] = w; } }
    bf16_t* op = nsaout + (size_t)tc * NOLD + head * 128 + 4 * kq;
#pragma unroll
    for (int db = 0; db < 8; ++db) *(u32x2*)(op + 16 * db) = outl[64 * db];
}


#define XB_TMO      128
#define XB_XCNT(j)  (256  + 64 * (j))
#define XB_XSUB(j)  (1280 + 64 * (j))
#define XB_XGEN(j)  (2304 + 64 * (j))
#define XB_TOP      3328
#define XB_TOPGEN   3392
#define XCD_BAR_WORDS 3456
#define XB_SPIN_CAP (1u << 18)
__device__ __forceinline__ unsigned xb_ld(unsigned* p)              { return __hip_atomic_load(p, __ATOMIC_RELAXED, __HIP_MEMORY_SCOPE_AGENT); }
__device__ __forceinline__ unsigned xb_add(unsigned* p, unsigned v) { return __hip_atomic_fetch_add(p, v, __ATOMIC_RELAXED, __HIP_MEMORY_SCOPE_AGENT); }
__device__ __forceinline__ unsigned xb_xcc_id() { return (unsigned)__builtin_amdgcn_s_getreg((3 << 11) | 20) & 0xFu; }
#define XB_SPIN(cond, bar) do { unsigned _sp = 0; while (cond) { __builtin_amdgcn_s_sleep(1); \
    if ((++_sp & 255u) == 0u) { if (xb_ld(&(bar)[XB_TMO])) break; if (_sp > XB_SPIN_CAP) { atomicAdd(&(bar)[XB_TMO], 1u); break; } } } } while (0)
struct XcdBarrier { unsigned* bar; unsigned x; volatile LAS unsigned* st; };
__device__ __forceinline__ XcdBarrier xcd_barrier_post(unsigned* bar, volatile LAS unsigned* st) {
    XcdBarrier b; b.bar = bar; b.x = xb_xcc_id(); b.st = st;
    if (threadIdx.x == 0) st[2] = xb_add(&bar[XB_XCNT(b.x)], 1u);
    return b;
}
__device__ __forceinline__ void xcd_barrier_complete(unsigned* bar, unsigned x, unsigned& nloc, unsigned& nx) {
    const unsigned G = gridDim.x * gridDim.y * gridDim.z;
    unsigned sum, cnt, mine, sp = 0u;
    for (;;) {
        sum = 0u; cnt = 0u; mine = 0u;
#pragma unroll
        for (unsigned j = 0; j < 16; ++j) { const unsigned c = xb_ld(&bar[XB_XCNT(j)]); sum += c; cnt += (c > 0u) ? 1u : 0u; mine = (j == x) ? c : mine; }
        if (sum == G) break;
        __builtin_amdgcn_s_sleep(1);
        if ((++sp & 255u) == 0u) { if (xb_ld(&bar[XB_TMO])) break; if (sp > XB_SPIN_CAP) { atomicAdd(&bar[XB_TMO], 1u); break; } }
    }
    nloc = mine > 0u ? mine : 1u; nx = cnt > 0u ? cnt : 1u;
}
__device__ __forceinline__ void xcd_barrier(const XcdBarrier& b, const int tid) {
    asm volatile("s_waitcnt vmcnt(0)" ::: "memory");
    __syncthreads();
    if (tid == 0) {
        unsigned* bar = b.bar;
        __builtin_amdgcn_s_waitcnt(0);
        unsigned nloc = b.st[0], nx = b.st[1];
        if (nloc == 0u) { xcd_barrier_complete(bar, b.x, nloc, nx); b.st[0] = nloc; b.st[1] = nx; }
        const unsigned old = xb_add(&bar[XB_XSUB(b.x)], 1u);
        const unsigned gen = old / nloc;
        if (old + 1u == (gen + 1u) * nloc) {
            __builtin_amdgcn_fence(__ATOMIC_RELEASE, "agent");
            asm volatile("s_waitcnt vmcnt(0)" ::: "memory");
            const unsigned og = xb_add(&bar[XB_TOP], 1u);
            const unsigned tg = og / nx;
            if (og + 1u == (tg + 1u) * nx) xb_add(&bar[XB_TOPGEN], 1u);
            else XB_SPIN(xb_ld(&bar[XB_TOPGEN]) == tg, bar);
            __builtin_amdgcn_fence(__ATOMIC_ACQUIRE, "agent");
            xb_add(&bar[XB_XGEN(b.x)], 1u);
            asm volatile("s_waitcnt vmcnt(0)" ::: "memory");
        } else {
            XB_SPIN(xb_ld(&bar[XB_XGEN(b.x)]) == gen, bar);
            __builtin_amdgcn_fence(__ATOMIC_ACQUIRE, "agent");
            asm volatile("s_waitcnt vmcnt(0)" ::: "memory");
        }
    }
    __syncthreads();
}

struct Params { const float* in[23]; float* out; unsigned char* ws; float inv_freq[64]; };

__global__ void __launch_bounds__(512, 2) fwd_megakernel(Params P) {
    extern __shared__ __attribute__((aligned(16))) unsigned char lds_raw[];
    LAS unsigned char* lds = (LAS unsigned char*)lds_raw;
    cg::grid_group grid = cg::this_grid();
    const int wave_s = __builtin_amdgcn_readfirstlane(threadIdx.x >> 6);
#define PHASE_WS unsigned long long wsv_ = (unsigned long long)P.ws; asm volatile("" : "+s"(wsv_)); unsigned char* ws = (unsigned char*)(__attribute__((address_space(1))) unsigned char*)wsv_; unsigned z_ = 0u; asm volatile("" : "+v"(z_)); const int tid = wave_s * 64 + (int)__builtin_amdgcn_mbcnt_hi(~0u, __builtin_amdgcn_mbcnt_lo(~0u, z_)); \
    const int lane = tid & 63, wave = __builtin_amdgcn_readfirstlane(tid >> 6), G = gridDim.x, gw = blockIdx.x * 8 + wave, ngw = G * 8; \
    const size_t gtid = (size_t)blockIdx.x * 512 + tid, gthreads = (size_t)G * 512; \
    LAS unsigned char* wl = lds + wave * WAVE_LDS; LAS float* scr = (LAS float*)wl; (void)lane; (void)gw; (void)ngw; (void)gtid; (void)gthreads; (void)wl; (void)scr
#define WAB ((bf16_t*)(ws + WS_WAB))
#define WO ((bf16_t*)(ws + WS_WO))
#define CW1K ((bf16_t*)(ws + WS_CW1K))
#define CW1V ((bf16_t*)(ws + WS_CW1V))
#define CW2K ((bf16_t*)(ws + WS_CW2K))
#define CW2V ((bf16_t*)(ws + WS_CW2V))
#define CBIAS ((float*)(ws + WS_CBIAS))
#define KC ((bf16_t*)(ws + WS_KC))
#define VC ((bf16_t*)(ws + WS_VC))
#define GN ((bf16_t*)(ws + WS_GN))
#define ST1 ((float*)(ws + WS_ST1))
#define ST2 ((float*)(ws + WS_ST2))
#define HF ((float*)(ws + WS_HF))
#define HB ((bf16_t*)(ws + WS_HB))
#define GU ((bf16_t*)(ws + WS_GU))
#define DN ((bf16_t*)(ws + WS_DN))
#define ACT ((bf16_t*)(ws + WS_ACT))
#define PROJ ((bf16_t*)(ws + WS_PROJ))
#define KSLF ((bf16_t*)(ws + WS_KSLF))
#define KBF ((bf16_t*)(ws + WS_KBF))
#define VBF ((bf16_t*)(ws + WS_VBF))
#define VSLF ((bf16_t*)(ws + WS_VSLF))
#define KWNF ((bf16_t*)(ws + WS_KWNF))
#define VWNF ((bf16_t*)(ws + WS_VWNF))
#define RCOS ((float*)(ws + WS_ROPE))
#define RSIN ((float*)(ws + WS_ROPE) + (size_t)S * 64)
#define WINT ((bf16_t*)(ws + WS_WIN))
#define NSAOUT ((bf16_t*)(ws + WS_NSAOUT))
#define SIGG ((bf16_t*)P.out)
    pg8::StaticOrder SO;
#define CG_SYNC() do { asm volatile("s_waitcnt vmcnt(0) lgkmcnt(0)" ::: "memory"); grid.sync(); \
        if (__builtin_amdgcn_readfirstlane(threadIdx.x >> 6) == 0) { __builtin_amdgcn_fence(__ATOMIC_ACQUIRE, "agent"); asm volatile("s_waitcnt vmcnt(0)" ::: "memory"); } \
        __syncthreads(); } while (0)
    volatile LAS unsigned* xst = (volatile LAS unsigned*)(lds + 8 * WAVE_LDS);
    if (threadIdx.x < 2) xst[threadIdx.x] = 0u;
    __syncthreads();
    const XcdBarrier xbar = xcd_barrier_post((unsigned*)P.ws, xst);
    __syncthreads();
    const int vbid = (int)(xst[2] * 8u + xbar.x);
#define GRID_SYNC() do { asm volatile("s_waitcnt vmcnt(0) lgkmcnt(0)" ::: "memory"); unsigned zz_ = 0u; asm volatile("" : "+v"(zz_)); \
        xcd_barrier(xbar, wave_s * 64 + (int)__builtin_amdgcn_mbcnt_hi(~0u, __builtin_amdgcn_mbcnt_lo(~0u, zz_))); } while (0)

    { PHASE_WS;
        conv_ffn(P.in[1], P.in[2], P.in[3], GU, DN, scr, gw, ngw, lane);
        { const float* win = P.in[6]; bf16_t* wint = WINT;
          tr_stream(32 * 360, gw, ngw, [&](int it) { const int kb = it / 360, nb = it % 360, dr = nb * 32; const int sc = win_src_col(dr);
              return TrP{win, WIN_SRC, kb * 64, sc < 0 ? 0 : sc, sc < 0 ? 0 : (dr == 11264 ? 24 : 32), wint, DM, dr, kb * 64}; }, scr, lane); }
        for (int it = gw; it < 16 * 64; it += ngw) { const int kb = it / 64, nb = it % 64; tr_item(P.in[13], DM, kb * 64, nb * 32, 32, WAB, 1024, nb * 32, kb * 64, scr, lane); }
        for (int it = gw; it < 8 * 64; it += ngw) { const int kb = it / 64, nb = it % 64; tr_item(P.in[14], DM, kb * 64, nb * 32, 32, WAB + (size_t)DM * 1024, 512, nb * 32, kb * 64, scr, lane); }
        for (int it = gw; it < 32 * 64; it += ngw) { const int kb = it / 64, nb = it % 64; tr_item(P.in[15], DM, kb * 64, nb * 32, 32, WO, DM, nb * 32, kb * 64, scr, lane); }
        for (int it = gw; it < 2 * 64 * 8; it += ngw) { const int w = it / 512, r = it % 512, kb = r / 8, nb = r % 8; tr_item<true>(w ? P.in[11] : P.in[8], 256, kb * 64, nb * 32, 32, w ? CW1V : CW1K, 4096, nb * 32, kb * 64, scr, lane); }
        for (int it = gw; it < 2 * 4 * 4; it += ngw) { const int w = it / 16, r = it % 16, kb = r / 4, nb = r % 4; tr_item(w ? P.in[12] : P.in[9], 128, kb * 64, nb * 32, 32, w ? CW2V : CW2K, 256, nb * 32, kb * 64, scr, lane); }
        { const float* x = P.in[0];
            for (size_t i = gtid; i < (size_t)S * DM / 8; i += gthreads) { const f32x4 a = *(const f32x4*)(x + 8 * i), b = *(const f32x4*)(x + 8 * i + 4); *(u32x4*)(HB + 8 * i) = pack8(a, b); } }
        for (int o = gw; o < 512; o += ngw) { const int w = o >> 8, c = o & 255; const float* pos = w ? P.in[10] : P.in[7]; const float* w1 = w ? P.in[11] : P.in[8];
            float s = 0.f; for (int kk = lane; kk < 4096; kk += 64) s += pos[kk] * w1[(size_t)kk * 256 + c];
            s = wave_sum(s); if (lane == 0) CBIAS[o] = s; }
    }
    CG_SYNC();
    { PHASE_WS; pg8::Gemm g{HB, GU, S, NGU, DM, DM, DM}; SO.init(S, NGU, G, (int)blockIdx.x); EpiSwiglu E{ACT}; pg8::gemm_phase(lds, g, SO, E, tid); }
    GRID_SYNC();
    { PHASE_WS; pg8::Gemm g{ACT, DN, S, DM, FF, FF, FF}; SO.init(S, DM, G, (int)blockIdx.x); EpiResF32 E{P.in[0], HF, ALPHA, 0.5f}; pg8::gemm_phase(lds, g, SO, E, tid); }
    GRID_SYNC();
    { PHASE_WS;
        ln_rows(HF, nullptr, HB, P.in[4], P.in[5], gw, ngw, lane, ST1);
        for (size_t i = gtid; i < (size_t)S * 64; i += gthreads) { const int t = (int)(i >> 6), j = (int)(i & 63); const float ang = (float)t * P.inv_freq[j]; RCOS[i] = cosf(ang); RSIN[i] = sinf(ang); }
    }
    GRID_SYNC();
    { PHASE_WS; pg8::Gemm g{HB, WINT, S, NWIN, DM, DM, DM}; SO.init(S, NWIN, G, (int)blockIdx.x); EpiWin E{PROJ, SIGG, GN, RCOS, KSLF, KBF}; pg8::gemm_phase(lds, g, SO, E, tid); }
    GRID_SYNC();
    { PHASE_WS;
      int vb = (int)blockIdx.x;
      { bool ok = true; unsigned* cen = (unsigned*)P.ws;
#pragma unroll
        for (int j = 0; j < 8; ++j) ok &= (xb_ld(&cen[XB_XCNT(j)]) * 8u == (unsigned)G);
        if (ok) vb = vbid; }
        for (int u = blockIdx.x; u < 256; u += G) { const int kv = u >> 7; compress_unit(u, PROJ, kv ? CW1V : CW1K, kv ? CW2V : CW2K, CBIAS + 256 * kv, kv ? VC : KC, lds, wave, lane); }
        if ((G & 7) == 0) {
            const int x = vb & 7, lw = (vb >> 3) * 8 + wave, nlw = (G >> 3) * 8;
            for (int j = lw; j < 512; j += nlw) dilated_unit(64 * (x + 8 * (j >> 6)) + (j & 63), PROJ, KBF, NSAOUT, lane);
        } else { for (int u = gw; u < 4096; u += ngw) dilated_unit(u, PROJ, KBF, NSAOUT, lane); }
    }
    GRID_SYNC();
    { PHASE_WS;
      int vb = (int)blockIdx.x;
      { bool ok = true; unsigned* cen = (unsigned*)P.ws;
#pragma unroll
        for (int j = 0; j < 8; ++j) ok &= (xb_ld(&cen[XB_XCNT(j)]) * 8u == (unsigned)G);
        if (ok) vb = vbid; }
      if ((G & 7) == 0) {
          const int bx = vb, x = bx & 7, g = x & 1, wj = ((bx >> 3) * 4 + (x >> 1)) * 8 + wave, nwj = (G >> 1) * 8;
          for (int tb = wj; tb < 4096; tb += nwj) nsa_unit(2 * tb + g, PROJ, KC, VC, GN, RCOS, RSIN, KSLF, VSLF, KWNF, VWNF, NSAOUT, wl, lane);
      } else { for (int u = gw; u < 8192; u += ngw) nsa_unit(u, PROJ, KC, VC, GN, RCOS, RSIN, KSLF, VSLF, KWNF, VWNF, NSAOUT, wl, lane); } }
    GRID_SYNC();
    { PHASE_WS; SO.init(S, DM, G, (int)blockIdx.x);
      { pg8::Gemm g{NSAOUT, WAB, S, DM, 1024, NOLD, 1024}; EpiGate<true> E{SIGG, HB}; pg8::gemm_phase(lds, g, SO, E, tid); }
      { pg8::Gemm g{NSAOUT + 1024, WAB + (size_t)DM * 1024, S, DM, 512, NOLD, 512}; EpiGate<false> E{SIGG + 2048, HB}; pg8::gemm_phase(lds, g, SO, E, tid); } }
    GRID_SYNC();
    { PHASE_WS; pg8::Gemm g{HB, WO, S, DM, DM, DM, DM}; SO.init(S, DM, G, (int)blockIdx.x); EpiResLnF32 E{HF, ST1, P.in[4], P.in[5], HF, ALPHA, 1.0f}; pg8::gemm_phase(lds, g, SO, E, tid); }
    GRID_SYNC();
    { PHASE_WS;
        ln_rows(HF, nullptr, HB, P.in[16], P.in[17], gw, ngw, lane, ST2);
        conv_ffn(P.in[18], P.in[19], P.in[20], GU, DN, scr, gw, ngw, lane);
    }
    GRID_SYNC();
    { PHASE_WS; pg8::Gemm g{HB, GU, S, NGU, DM, DM, DM}; SO.init(S, NGU, G, (int)blockIdx.x); EpiSwiglu E{ACT}; pg8::gemm_phase(lds, g, SO, E, tid); }
    GRID_SYNC();
    { PHASE_WS; pg8::Gemm g{ACT, DN, S, DM, FF, FF, FF}; SO.init(S, DM, G, (int)blockIdx.x); EpiResLnF32 E{HF, ST2, P.in[16], P.in[17], P.out, ALPHA, 0.5f}; pg8::gemm_phase(lds, g, SO, E, tid); }
    GRID_SYNC();
    { PHASE_WS; (void)ws; ln_rows(P.out, P.out, nullptr, P.in[21], P.in[22], gw, ngw, lane); }
}

extern "C" void kernel_launch(void* const* d_in, const int* in_sizes, int n_in, void* d_out, int out_size, void* d_ws, size_t ws_size, hipStream_t stream) {
    static int grid = 0;
    if (grid == 0) {
        if (n_in != 23 || out_size != S * DM || ws_size < WS_END) { fprintf(stderr, "kernel_launch: unexpected shapes (n_in %d out %d ws %zu, need %zu)\n", n_in, out_size, ws_size, (size_t)WS_END); grid = -1; return; }
        int dev = 0, cus = 0, per_cu = 0;
        hipGetDevice(&dev); hipDeviceGetAttribute(&cus, hipDeviceAttributeMultiprocessorCount, dev);
        if (hipFuncSetAttribute((const void*)fwd_megakernel, hipFuncAttributeMaxDynamicSharedMemorySize, LDS_BYTES) != hipSuccess) { fprintf(stderr, "kernel_launch: hipFuncSetAttribute failed\n"); grid = -1; return; }
        if (hipOccupancyMaxActiveBlocksPerMultiprocessor(&per_cu, (const void*)fwd_megakernel, 512, LDS_BYTES) != hipSuccess || per_cu < 1) { fprintf(stderr, "kernel_launch: occupancy query failed (%d)\n", per_cu); (void)hipGetLastError(); per_cu = 1; }
        grid = cus * per_cu;
    }
    if (grid < 0) return;
    if (hipMemsetAsync(d_ws, 0, 16384, stream) != hipSuccess) { fprintf(stderr, "kernel_launch: memset of the barrier words failed\n"); return; }
    Params p{};
    for (int i = 0; i < 23; ++i) p.in[i] = (const float*)d_in[i];
    p.out = (float*)d_out; p.ws = (unsigned char*)d_ws;
    for (int i = 0; i < 64; ++i) p.inv_freq[i] = (float)pow(10000.0, -(double)i / 64.0);
    void* args[] = {&p};
    hipError_t e = hipLaunchCooperativeKernel((const void*)fwd_megakernel, dim3(grid), dim3(512), args, LDS_BYTES, stream);
    if (e != hipSuccess) fprintf(stderr, "kernel_launch: cooperative launch failed: %s (grid %d)\n", hipGetErrorString(e), grid);
}
```

```cpp
#include <hip/hip_runtime.h>
#include <hip/hip_cooperative_groups.h>
#include <cstdio>
#include <cstdint>
#include <cmath>
namespace cg = cooperative_groups;

#define LAS __attribute__((address_space(3)))
typedef unsigned short bf16_t;
typedef short bf16x8 __attribute__((ext_vector_type(8)));
typedef short s16x4 __attribute__((ext_vector_type(4)));
typedef float f32x4 __attribute__((ext_vector_type(4)));
typedef float f32x2 __attribute__((ext_vector_type(2)));
typedef unsigned u32x4 __attribute__((ext_vector_type(4)));
typedef unsigned u32x2 __attribute__((ext_vector_type(2)));

constexpr int S = 16384, DM = 2048, FF = 5632, NGU = 2 * FF, NWIN = 11520, WIN_SRC = 11288, PLD = 3072, NOLD = 1536;
constexpr float ALPHA = 1.189207115002721f;
constexpr float LN_EPS = 1e-5f;
constexpr float SL2 = 0.08838834764831845f * 1.4426950408889634f;
constexpr int PC_QA = 0, PC_KC = 1024, PC_VC = 1280, PC_QB = 1536;
constexpr size_t MiB = 1u << 20;
constexpr size_t WS_WAB = 1 * MiB, WS_WO = 13 * MiB, WS_CW1K = 21 * MiB, WS_CW1V = 23 * MiB, WS_CW2K = 25 * MiB, WS_CW2V = 25 * MiB + 65536, WS_CBIAS = 25 * MiB + 131072;
constexpr size_t WS_KC = 26 * MiB, WS_VC = 26 * MiB + 524288, WS_GN = 27 * MiB, WS_ST1 = 28 * MiB, WS_ST2 = 28 * MiB + 131072, WS_WGF = 29 * MiB;
constexpr size_t WS_HF = 32 * MiB, WS_HB = 160 * MiB, WS_BIG = 224 * MiB;
constexpr size_t WS_GU = WS_BIG, WS_DN = WS_BIG + 44 * MiB, WS_ACT = WS_BIG + 66 * MiB;
constexpr size_t WS_KBF = WS_BIG + 96 * MiB, WS_VBF = WS_BIG + 144 * MiB;
constexpr size_t WS_PROJ = WS_BIG, WS_KSLF = WS_BIG + 192 * MiB, WS_VSLF = WS_BIG + 200 * MiB, WS_KWNF = WS_BIG + 208 * MiB, WS_VWNF = WS_BIG + 216 * MiB, WS_ROPE = WS_BIG + 224 * MiB;
constexpr size_t WS_WIN = 466 * MiB, WS_NSAOUT = 466 * MiB, WS_END = 514 * MiB;

constexpr int VROW = 288, VBUF_BYTES = 32 * VROW;
constexpr int IMP_LD = 260;
constexpr int OUT_OFF = VBUF_BYTES + 4 * IMP_LD * 4 + 256 + 512;
constexpr int WAVE_LDS = OUT_OFF + 4096;
constexpr int LDS_BYTES = 147456;
static_assert(8 * WAVE_LDS + 32 <= LDS_BYTES && 131072 <= LDS_BYTES, "LDS map");

typedef __bf16 bf16x2_t __attribute__((ext_vector_type(2)));
__device__ __forceinline__ unsigned cvt_pk_bf16(float lo, float hi) { f32x2 v = {lo, hi}; bf16x2_t b = __builtin_convertvector(v, bf16x2_t); return __builtin_bit_cast(unsigned, b); }
__device__ __forceinline__ float bf2f(unsigned short b) { return __uint_as_float(((unsigned)b) << 16); }
__device__ __forceinline__ float bflo(unsigned w) { return __uint_as_float(w << 16); }
__device__ __forceinline__ float bfhi(unsigned w) { return __uint_as_float(w & 0xffff0000u); }
__device__ __forceinline__ float fsigmoid(float x) { return __builtin_amdgcn_rcpf(1.f + __expf(-x)); }
__device__ __forceinline__ float quad_xor1(float v) { return __int_as_float(__builtin_amdgcn_update_dpp(0, __float_as_int(v), 0xB1, 0xF, 0xF, false)); }
__device__ __forceinline__ float quad_xor2(float v) { return __int_as_float(__builtin_amdgcn_update_dpp(0, __float_as_int(v), 0x4E, 0xF, 0xF, false)); }
__device__ __forceinline__ float wave_sum(float v) {
#pragma unroll
    for (int o = 1; o < 64; o <<= 1) v += __shfl_xor(v, o);
    return v;
}
typedef long i64_t;
__device__ __forceinline__ u32x2 pack8_fp8(const f32x4 a, const f32x4 b) {
    unsigned lo = 0u, hi = 0u;
    lo = __builtin_amdgcn_cvt_pk_fp8_f32(a[0], a[1], lo, false); lo = __builtin_amdgcn_cvt_pk_fp8_f32(a[2], a[3], lo, true);
    hi = __builtin_amdgcn_cvt_pk_fp8_f32(b[0], b[1], hi, false); hi = __builtin_amdgcn_cvt_pk_fp8_f32(b[2], b[3], hi, true);
    return (u32x2){lo, hi};
}
__device__ __forceinline__ u32x4 pack8(const f32x4 a, const f32x4 b) { u32x4 w; w.x = cvt_pk_bf16(a[0], a[1]); w.y = cvt_pk_bf16(a[2], a[3]); w.z = cvt_pk_bf16(b[0], b[1]); w.w = cvt_pk_bf16(b[2], b[3]); return w; }

namespace pg8 {
constexpr int BM = 256, BK = 64, HALF = 128, HTB = HALF * BK * 2, STAGE_BYTES = 8 * HTB, NXCD = 8, WGM = 8;
__host__ __device__ __forceinline__ int lds_byte(int r, int c) { const int st = (r >> 4) * 2 + (c >> 5), rr = r & 15, cc = c & 31, ob = rr * 64 + cc * 2; return st * 1024 + (ob ^ (((ob >> 9) & 1) << 5)); }
__host__ __device__ __forceinline__ void stage_rc(int b, int& R, int& C) { const int st = b / 1024, sb = b % 1024, swz = sb ^ (((sb >> 9) & 1) << 5); R = (st >> 1) * 16 + swz / 64; C = (st & 1) * 32 + (swz % 64) / 2; }
__host__ __device__ __forceinline__ int perm32(int rho) { const int n = rho >> 4, i = rho & 15; return 8 * (i >> 2) + 4 * n + (i & 3); }
struct Unit { int pm, pn; };
struct Gemm { const bf16_t* A; const bf16_t* Bt; int M, N, K, lda, ldb; };
struct StaticOrder {
    int nM, nN, nwg, G, c;
    __device__ void init(int M, int N, int G_, int c_) { nM = M / BM; nN = N / BM; nwg = nM * nN; G = G_; c = c_; }
    __device__ bool next(int i, Unit& u) const {
        const long L = (long)i * G + c; if (L >= nwg) return false;
        int wgid = (int)L; { const int q = nwg / NXCD, r = nwg % NXCD, xcd = wgid % NXCD, off = wgid / NXCD; wgid = (xcd < r ? xcd * (q + 1) : r * (q + 1) + (xcd - r) * q) + off; }
        const int nig = WGM * nN, gid = wgid / nig, fm = gid * WGM, gsz = (nM - fm) < WGM ? (nM - fm) : WGM;
        u.pm = fm + ((wgid % nig) % gsz); u.pn = (wgid % nig) / gsz; return true;
    }
};
typedef f32x4 Acc[2][2][4][2];

template <class Epi, bool FP8 = false>
__device__ __forceinline__ void gemm_phase(LAS unsigned char* lds, const Gemm g, const StaticOrder& S_, const Epi& E, const int tid) {
    const int wid = __builtin_amdgcn_readfirstlane(tid >> 6), lane = tid & 63, wr = wid >> 2, wc = wid & 3, fr = lane & 15, fq = lane >> 4;
    const int K = g.K, nt = K / BK;
    unsigned voffA[2], voffB[2];
#pragma unroll
    for (int i = 0; i < 2; ++i) { int R, C; stage_rc(tid * 16 + i * 8192, R, C); const int Rb = Epi::PERM ? ((R & ~31) + perm32(R & 31)) : R;
        voffA[i] = (unsigned)(R * g.lda + C) * 2u; voffB[i] = (unsigned)(Rb * g.ldb + C) * 2u; }
    const size_t kstep = (size_t)(BK * 2);
    const size_t hstepA = (size_t)HALF * g.lda * 2, hstepB = (size_t)HALF * g.ldb * 2;
    const size_t tstepA = 2 * hstepA, tstepB = 2 * hstepB;
    const unsigned ldsw = (unsigned)wid * 1024u;
    const int aoff = lds_byte(wr * 64 + fr, fq * 8), boff = lds_byte(wc * 32 + fr, fq * 8);
#define PG8_SA(b, h) (((b) * 2 + (h)) * HTB)
#define PG8_SB(b, h) ((4 + (b) * 2 + (h)) * HTB)
#define PG8_STAGE(bufoff, gbase, voff) do { _Pragma("unroll") for (int _i = 0; _i < 2; ++_i) \
        __builtin_amdgcn_global_load_lds((const unsigned*)((const char*)(gbase) + (voff)[_i]), (LAS unsigned*)(lds + (bufoff) + ldsw + _i * 8192), 16, 0, 0); } while (0)
#define PG8_LDA(dst, b, h) do { _Pragma("unroll") for (int m = 0; m < 4; ++m) _Pragma("unroll") for (int k = 0; k < 2; ++k) dst[m][k] = *(const LAS bf16x8*)(lds + PG8_SA(b, h) + aoff + m * 2048 + k * 1024); } while (0)
#define PG8_LDB(dst, b, h) do { _Pragma("unroll") for (int n = 0; n < 2; ++n) _Pragma("unroll") for (int k = 0; k < 2; ++k) dst[n][k] = *(const LAS bf16x8*)(lds + PG8_SB(b, h) + boff + n * 2048 + k * 1024); } while (0)
#define PG8_MMA(ai, bj, At, Bt) do { __builtin_amdgcn_s_setprio(1); _Pragma("unroll") for (int m = 0; m < 4; ++m) _Pragma("unroll") for (int n = 0; n < 2; ++n) _Pragma("unroll") for (int k = 0; k < 2; ++k) \
        { if (FP8) { typedef long i64v2 __attribute__((ext_vector_type(2))); const i64v2 b2 = __builtin_bit_cast(i64v2, Bt[n][k]), a2 = __builtin_bit_cast(i64v2, At[m][k]); \
            acc[ai][bj][m][n] = __builtin_amdgcn_mfma_f32_16x16x32_fp8_fp8(b2[0], a2[0], acc[ai][bj][m][n], 0, 0, 0); acc[ai][bj][m][n] = __builtin_amdgcn_mfma_f32_16x16x32_fp8_fp8(b2[1], a2[1], acc[ai][bj][m][n], 0, 0, 0); } \
          else acc[ai][bj][m][n] = __builtin_amdgcn_mfma_f32_16x16x32_bf16(Bt[n][k], At[m][k], acc[ai][bj][m][n], 0, 0, 0); } __builtin_amdgcn_s_setprio(0); } while (0)
#define PG8_WAIT_V(n) asm volatile("s_waitcnt vmcnt(" #n ")" ::: "memory")
#define PG8_WAIT_L(n) asm volatile("s_waitcnt lgkmcnt(" #n ")" ::: "memory")
#define PG8_BAR __builtin_amdgcn_s_barrier()
#define PG8_SCHED __builtin_amdgcn_sched_barrier(0)
    Unit cur, nxt; int ui = 0;
    if (!S_.next(0, cur)) return;
    Acc acc;
#pragma unroll
    for (int a = 0; a < 2; ++a)
#pragma unroll
        for (int b = 0; b < 2; ++b)
#pragma unroll
            for (int m = 0; m < 4; ++m)
#pragma unroll
                for (int n = 0; n < 2; ++n) acc[a][b][m][n] = (f32x4){0.f, 0.f, 0.f, 0.f};
    bf16x8 At[4][2], B0[2][2], B1[2][2];
    const char* cA = (const char*)g.A + (size_t)cur.pm * tstepA; const char* cB = (const char*)g.Bt + (size_t)cur.pn * tstepB;
    PG8_STAGE(PG8_SB(0, 0), cB, voffB); PG8_STAGE(PG8_SB(0, 1), cB + hstepB, voffB); PG8_STAGE(PG8_SA(0, 0), cA, voffA); PG8_STAGE(PG8_SA(0, 1), cA + hstepA, voffA);
    if (wr == 1) PG8_BAR;
    PG8_WAIT_V(2); PG8_BAR;
    PG8_STAGE(PG8_SB(1, 0), cB + kstep, voffB); PG8_STAGE(PG8_SA(1, 0), cA + kstep, voffA); PG8_STAGE(PG8_SB(1, 1), cB + hstepB + kstep, voffB);
    PG8_WAIT_V(6); PG8_BAR;
    for (;;) {
        const bool has_next = S_.next(ui + 1, nxt);
        const char* nA = has_next ? (const char*)g.A + (size_t)nxt.pm * tstepA : cA; const char* nB = has_next ? (const char*)g.Bt + (size_t)nxt.pn * tstepB : cB;
        for (int t = 0; t < nt; t += 2) {
            const bool last = (t == nt - 2);
            const char* a1 = cA + (size_t)(t + 1) * kstep;
            const char* a2 = last ? nA : cA + (size_t)(t + 2) * kstep; const char* b2 = last ? nB : cB + (size_t)(t + 2) * kstep;
            const char* a3 = a2 + kstep; const char* b3 = b2 + kstep;
            PG8_LDB(B0, 0, 0); PG8_LDB(B1, 0, 1); PG8_SCHED; PG8_LDA(At, 0, 0); PG8_STAGE(PG8_SA(1, 1), a1 + hstepA, voffA);
            PG8_WAIT_V(8); PG8_WAIT_L(0); PG8_BAR; PG8_MMA(0, 0, At, B0); PG8_MMA(0, 1, At, B1); PG8_BAR; PG8_SCHED;
            PG8_LDA(At, 0, 1); PG8_STAGE(PG8_SB(0, 0), b2, voffB); PG8_STAGE(PG8_SB(0, 1), b2 + hstepB, voffB); PG8_STAGE(PG8_SA(0, 0), a2, voffA);
            PG8_WAIT_V(8); PG8_WAIT_L(0); PG8_BAR; PG8_MMA(1, 0, At, B0); PG8_MMA(1, 1, At, B1); PG8_BAR; PG8_SCHED;
            PG8_LDB(B0, 1, 0); PG8_LDB(B1, 1, 1); PG8_SCHED; PG8_LDA(At, 1, 0); PG8_STAGE(PG8_SA(0, 1), a2 + hstepA, voffA);
            PG8_WAIT_V(8); PG8_WAIT_L(0); PG8_BAR; PG8_MMA(0, 0, At, B0); PG8_MMA(0, 1, At, B1); PG8_BAR; PG8_SCHED;
            PG8_LDA(At, 1, 1); PG8_STAGE(PG8_SB(1, 0), b3, voffB); PG8_STAGE(PG8_SB(1, 1), b3 + hstepB, voffB); PG8_STAGE(PG8_SA(1, 0), a3, voffA);
            PG8_WAIT_V(8); PG8_WAIT_L(0); PG8_BAR; PG8_MMA(1, 0, At, B0); PG8_MMA(1, 1, At, B1); PG8_BAR; PG8_SCHED;
        }
        if (wr == 0) PG8_BAR;
        E(acc, cur, wr, wc, fr, fq);
        if (!has_next) break;
#pragma unroll
        for (int a = 0; a < 2; ++a)
#pragma unroll
            for (int b = 0; b < 2; ++b)
#pragma unroll
                for (int m = 0; m < 4; ++m)
#pragma unroll
                    for (int n = 0; n < 2; ++n) acc[a][b][m][n] = (f32x4){0.f, 0.f, 0.f, 0.f};
        cur = nxt; cA = nA; cB = nB; ++ui;
        if (wr == 1) PG8_BAR;
    }
    PG8_WAIT_V(0);
    PG8_BAR;
#undef PG8_SA
#undef PG8_SB
#undef PG8_STAGE
#undef PG8_LDA
#undef PG8_LDB
#undef PG8_MMA
#undef PG8_WAIT_V
#undef PG8_WAIT_L
#undef PG8_BAR
#undef PG8_SCHED
}
}

struct EpiSwiglu {
    static constexpr bool PERM = true;
    bf16_t* O;
    __device__ __forceinline__ void operator()(const pg8::Acc& acc, const pg8::Unit& u, int wr, int wc, int fr, int fq) const {
        const int row0 = u.pm * 256 + wr * 64 + fr, col0 = u.pn * 128 + wc * 32 + 8 * fq;
#pragma unroll
        for (int ai = 0; ai < 2; ++ai)
#pragma unroll
            for (int m = 0; m < 4; ++m) {
                f32x4 v[2];
#pragma unroll
                for (int n = 0; n < 2; ++n)
#pragma unroll
                    for (int e = 0; e < 4; ++e) { const float gt = acc[ai][0][m][n][e], up = acc[ai][1][m][n][e]; v[n][e] = gt * fsigmoid(gt) * up; }
                *(u32x4*)(O + (size_t)(row0 + ai * 128 + m * 16) * FF + col0) = pack8(v[0], v[1]);
            }
    }
};
struct EpiResF32 {
    static constexpr bool PERM = false;
    const float* res; float* out; float a, b;
    __device__ __forceinline__ void operator()(const pg8::Acc& acc, const pg8::Unit& u, int wr, int wc, int fr, int fq) const {
        const int row0 = u.pm * 256 + wr * 64 + fr, col0 = u.pn * 256 + wc * 32 + 4 * fq;
#pragma unroll
        for (int ai = 0; ai < 2; ++ai)
#pragma unroll
            for (int m = 0; m < 4; ++m) {
                const size_t off = (size_t)(row0 + ai * 128 + m * 16) * DM + col0;
#pragma unroll
                for (int bj = 0; bj < 2; ++bj)
#pragma unroll
                    for (int n = 0; n < 2; ++n) { const f32x4 r = *(const f32x4*)(res + off + bj * 128 + n * 16); *(f32x4*)(out + off + bj * 128 + n * 16) = r * a + acc[ai][bj][m][n] * b; }
            }
    }
};
struct EpiResLnF32 {
    static constexpr bool PERM = false;
    const float* pre; const float* stats; const float* g; const float* beta; float* out; float a, b;
    __device__ __forceinline__ void operator()(const pg8::Acc& acc, const pg8::Unit& u, int wr, int wc, int fr, int fq) const {
        const int row0 = u.pm * 256 + wr * 64 + fr, col0 = u.pn * 256 + wc * 32 + 4 * fq;
#pragma unroll
        for (int ai = 0; ai < 2; ++ai)
#pragma unroll
            for (int m = 0; m < 4; ++m) {
                const int row = row0 + ai * 128 + m * 16; const size_t off = (size_t)row * DM + col0;
                const f32x2 st = *(const f32x2*)(stats + 2 * (size_t)row);
#pragma unroll
                for (int bj = 0; bj < 2; ++bj)
#pragma unroll
                    for (int n = 0; n < 2; ++n) { const int co = bj * 128 + n * 16;
                        const f32x4 r = *(const f32x4*)(pre + off + co), gv = *(const f32x4*)(g + col0 + co), bv = *(const f32x4*)(beta + col0 + co);
                        const f32x4 h = (r - st.x) * st.y * gv + bv;
                        *(f32x4*)(out + off + co) = h * a + acc[ai][bj][m][n] * b; }
                if (m & 1) asm volatile("" ::: "memory");
            }
    }
};
struct EpiSig {
    static constexpr bool PERM = true;
    bf16_t* sigg;
    __device__ __forceinline__ void operator()(const pg8::Acc& acc, const pg8::Unit& u, int wr, int wc, int fr, int fq) const {
        const int row0 = u.pm * 256 + wr * 64 + fr, cw = wc * 32 + 8 * fq;
#pragma unroll
        for (int ai = 0; ai < 2; ++ai)
#pragma unroll
            for (int m = 0; m < 4; ++m)
#pragma unroll
                for (int bj = 0; bj < 2; ++bj) {
                    f32x4 v[2];
#pragma unroll
                    for (int n = 0; n < 2; ++n)
#pragma unroll
                        for (int e = 0; e < 4; ++e) v[n][e] = fsigmoid(acc[ai][bj][m][n][e]);
                    *(u32x4*)(sigg + (size_t)(row0 + ai * 128 + m * 16) * 4096 + u.pn * 256 + bj * 128 + cw) = pack8(v[0], v[1]);
                }
    }
};
struct EpiWin {
    static constexpr bool PERM = true;
    bf16_t* proj; bf16_t* sigg; bf16_t* gn; const float* cs; bf16_t* kslf; bf16_t* kbf; int tile_off;
    __device__ __forceinline__ void operator()(const pg8::Acc& acc, const pg8::Unit& u, int wr, int wc, int fr, int fq) const {
        const int tile = u.pn + tile_off, row0 = u.pm * 256 + wr * 64 + fr, cw = wc * 32 + 8 * fq;
        if (tile < 28) {
            const bool rope = (tile == 6) | (tile == 8) | (tile >= 10 && tile < 22);
            const int dcol = (tile < 6 ? tile : tile - 4) * 256;
            if (!rope) {
                if (tile == 7 || tile == 9) {
                    unsigned char* VF = (unsigned char*)kslf + (tile == 7 ? (size_t)8 << 20 : (size_t)24 << 20);
#pragma unroll
                    for (int ai = 0; ai < 2; ++ai)
#pragma unroll
                        for (int m = 0; m < 4; ++m) {
                            const int row = row0 + ai * 128 + m * 16, kp = row & 31;
                            const size_t rbase = (size_t)(row >> 5) * 4096 + (size_t)(((kp >> 2) & 3) * 16) * 8 + 4 * (kp >> 4) + (kp & 3);
#pragma unroll
                            for (int bj = 0; bj < 2; ++bj) {
                                const u32x2 w = pack8_fp8(acc[ai][bj][m][0], acc[ai][bj][m][1]);
                                unsigned char* vb = VF + (size_t)bj * 512 * 4096 + rbase + (size_t)(cw >> 4) * 512 + (size_t)(cw & 15) * 8;
                                vb[0] = (unsigned char)(w.x & 0xffu); vb[8] = (unsigned char)((w.x >> 8) & 0xffu); vb[16] = (unsigned char)((w.x >> 16) & 0xffu); vb[24] = (unsigned char)(w.x >> 24);
                                vb[32] = (unsigned char)(w.y & 0xffu); vb[40] = (unsigned char)((w.y >> 8) & 0xffu); vb[48] = (unsigned char)((w.y >> 16) & 0xffu); vb[56] = (unsigned char)(w.y >> 24);
                            }
                        }
                } else if (tile >= 22) {
                    unsigned char* VB = (unsigned char*)kbf + ((size_t)24 << 20);
#pragma unroll
                    for (int ai = 0; ai < 2; ++ai)
#pragma unroll
                        for (int m = 0; m < 4; ++m) {
                            const int row = row0 + ai * 128 + m * 16;
#pragma unroll
                            for (int bj = 0; bj < 2; ++bj) {
                                const int hd = 2 * (tile - 22) + bj, sh = 2 * (hd >> 2), tp = ((row & ((1 << sh) - 1)) << (14 - sh)) + (row >> sh), kp = tp & 31;
                                const u32x2 w = pack8_fp8(acc[ai][bj][m][0], acc[ai][bj][m][1]);
                                unsigned char* vb = VB + (((size_t)hd * 512 + (tp >> 5)) * 8 + (cw >> 4)) * 512 + (size_t)(((kp >> 2) & 3) * 16 + (cw & 15)) * 8 + 4 * (kp >> 4) + (kp & 3);
                                vb[0] = (unsigned char)(w.x & 0xffu); vb[8] = (unsigned char)((w.x >> 8) & 0xffu); vb[16] = (unsigned char)((w.x >> 16) & 0xffu); vb[24] = (unsigned char)(w.x >> 24);
                                vb[32] = (unsigned char)(w.y & 0xffu); vb[40] = (unsigned char)((w.y >> 8) & 0xffu); vb[48] = (unsigned char)((w.y >> 16) & 0xffu); vb[56] = (unsigned char)(w.y >> 24);
                            }
                        }
                } else {
#pragma unroll
                    for (int ai = 0; ai < 2; ++ai)
#pragma unroll
                        for (int m = 0; m < 4; ++m)
#pragma unroll
                            for (int bj = 0; bj < 2; ++bj)
                                *(u32x4*)(proj + (size_t)(row0 + ai * 128 + m * 16) * PLD + dcol + bj * 128 + cw) = pack8(acc[ai][bj][m][0], acc[ai][bj][m][1]);
                }
            } else {
                const int head = cw >> 6, d = cw & 63;
                const bool frag = (tile == 6) | (tile == 8);
                unsigned char* KF = (unsigned char*)kslf + (tile == 6 ? (size_t)0 : (size_t)16 << 20); const float* sn = cs + (size_t)S * 64;
#pragma unroll
                for (int ai = 0; ai < 2; ++ai)
#pragma unroll
                    for (int m = 0; m < 4; ++m) {
                        const int row = row0 + ai * 128 + m * 16;
                        f32x4 o1[2], o2[2];
#pragma unroll
                        for (int n = 0; n < 2; ++n) {
                            const f32x4 c = *(const f32x4*)(cs + (size_t)row * 64 + d + 4 * n), sv = *(const f32x4*)(sn + (size_t)row * 64 + d + 4 * n);
                            const f32x4 x1 = acc[ai][0][m][n], x2 = acc[ai][1][m][n];
                            o1[n] = x1 * c - x2 * sv; o2[n] = x2 * c + x1 * sv;
                        }
                        if (frag) {
                            unsigned char* kb = KF + ((size_t)head * 1024 + (row >> 4)) * 2048 + (size_t)(d >> 5) * 512 + (size_t)(((d >> 3) & 3) * 16 + (row & 15)) * 8;
                            *(u32x2*)kb = pack8_fp8(o1[0], o1[1]); *(u32x2*)(kb + 1024) = pack8_fp8(o2[0], o2[1]);
                        } else if (tile >= 16) {
                            const int hd = 2 * (tile - 16) + head, sh = 2 * (hd >> 2), tp = ((row & ((1 << sh) - 1)) << (14 - sh)) + (row >> sh);
                            unsigned char* kb = (unsigned char*)kbf + ((size_t)hd * 1024 + (tp >> 4)) * 2048 + (size_t)(d >> 5) * 512 + (size_t)(((d >> 3) & 3) * 16 + (tp & 15)) * 8;
                            *(u32x2*)kb = pack8_fp8(o1[0], o1[1]); *(u32x2*)(kb + 1024) = pack8_fp8(o2[0], o2[1]);
                        } else {
                            bf16_t* p = proj + (size_t)row * PLD + dcol + head * 128 + d;
                            *(u32x4*)p = pack8(o1[0], o1[1]); *(u32x4*)(p + 64) = pack8(o2[0], o2[1]);
                        }
                        if (m & 1) asm volatile("" ::: "memory");
                    }
            }
        } else if (tile < 44) {
#pragma unroll
            for (int ai = 0; ai < 2; ++ai)
#pragma unroll
                for (int m = 0; m < 4; ++m)
#pragma unroll
                    for (int bj = 0; bj < 2; ++bj) {
                        f32x4 v[2];
#pragma unroll
                        for (int n = 0; n < 2; ++n)
#pragma unroll
                            for (int e = 0; e < 4; ++e) v[n][e] = fsigmoid(acc[ai][bj][m][n][e]);
                        *(u32x4*)(sigg + (size_t)(row0 + ai * 128 + m * 16) * 4096 + (tile - 28) * 256 + bj * 128 + cw) = pack8(v[0], v[1]);
                    }
        } else {
            if (wc == 0) {
#pragma unroll
                for (int ai = 0; ai < 2; ++ai)
#pragma unroll
                    for (int m = 0; m < 4; ++m) {
                        f32x4 v[2];
#pragma unroll
                        for (int n = 0; n < 2; ++n)
#pragma unroll
                            for (int e = 0; e < 4; ++e) v[n][e] = fsigmoid(acc[ai][0][m][n][e]);
                        *(u32x4*)(gn + (size_t)(row0 + ai * 128 + m * 16) * 32 + cw) = pack8(v[0], v[1]);
                    }
            }
        }
    }
};
template <bool FIRST> struct EpiGate {
    static constexpr bool PERM = true;
    const bf16_t* sg; bf16_t* O;
    __device__ __forceinline__ void operator()(const pg8::Acc& acc, const pg8::Unit& u, int wr, int wc, int fr, int fq) const {
        const int row0 = u.pm * 256 + wr * 64 + fr, col0 = u.pn * 256 + wc * 32 + 8 * fq;
#pragma unroll
        for (int ai = 0; ai < 2; ++ai)
#pragma unroll
            for (int m = 0; m < 4; ++m)
#pragma unroll
                for (int bj = 0; bj < 2; ++bj) {
                    const int row = row0 + ai * 128 + m * 16, col = col0 + bj * 128;
                    const u32x4 gv = *(const u32x4*)(sg + (size_t)row * 4096 + col);
                    u32x4 pv = (u32x4){0u, 0u, 0u, 0u}; if (!FIRST) pv = *(const u32x4*)(O + (size_t)row * DM + col);
                    f32x4 v[2];
#pragma unroll
                    for (int n = 0; n < 2; ++n) {
                        const unsigned g0 = n ? gv.z : gv.x, g1 = n ? gv.w : gv.y, p0 = n ? pv.z : pv.x, p1 = n ? pv.w : pv.y;
                        const f32x4 y = acc[ai][bj][m][n];
                        v[n][0] = bflo(p0) + bflo(g0) * y[0]; v[n][1] = bfhi(p0) + bfhi(g0) * y[1];
                        v[n][2] = bflo(p1) + bflo(g1) * y[2]; v[n][3] = bfhi(p1) + bfhi(g1) * y[3];
                    }
                    *(u32x4*)(O + (size_t)row * DM + col) = pack8(v[0], v[1]);
                }
    }
};

template <bool FRAG = false>
__device__ __forceinline__ void tr_item(const float* W, int ldw, int k0, int scol0, int nvalid, bf16_t* WT, int ldt, int drow0, int dk0, LAS float* scr, int lane) {
    const int c = lane & 31;
    float v[32];
#pragma unroll
    for (int i = 0; i < 32; ++i) { const int kk = 2 * i + (lane >> 5); v[i] = (c < nvalid) ? W[(size_t)(k0 + kk) * ldw + scol0 + c] : 0.f; }
#pragma unroll
    for (int i = 0; i < 32; ++i) { const int kk = 2 * i + (lane >> 5); scr[kk * 33 + c] = v[i]; }
    asm volatile("s_waitcnt lgkmcnt(0)" ::: "memory");
    const int c8 = lane & 7;
#pragma unroll
    for (int j = 0; j < 4; ++j) { const int n = (lane >> 3) + 8 * j; const LAS float* s = scr + (8 * c8) * 33 + n;
        u32x4 o; o.x = cvt_pk_bf16(s[0 * 33], s[1 * 33]); o.y = cvt_pk_bf16(s[2 * 33], s[3 * 33]); o.z = cvt_pk_bf16(s[4 * 33], s[5 * 33]); o.w = cvt_pk_bf16(s[6 * 33], s[7 * 33]);
        if (FRAG) { const int c = drow0 + n, k = dk0 + 8 * c8; *(u32x4*)(WT + ((size_t)((c >> 4) * (ldt >> 5) + (k >> 5)) * 64 + ((k >> 3) & 3) * 16 + (c & 15)) * 8) = o; }
        else *(u32x4*)(WT + (size_t)(drow0 + n) * ldt + dk0 + 8 * c8) = o; }
    asm volatile("s_waitcnt lgkmcnt(0)" ::: "memory");
}
struct TrP { const float* W; int ldw, k0, scol0, nvalid; bf16_t* WT; int ldt, drow0, dk0; int fp8; };
__device__ __forceinline__ void tr_load(float (&v)[32], const TrP& q, int lane) {
    const int c = lane & 31;
#pragma unroll
    for (int i = 0; i < 32; ++i) { const int kk = 2 * i + (lane >> 5); v[i] = (c < q.nvalid) ? q.W[(size_t)(q.k0 + kk) * q.ldw + q.scol0 + c] : 0.f; }
}
__device__ __forceinline__ void tr_store(const float (&v)[32], const TrP& q, LAS float* scr, int lane) {
    const int c = lane & 31;
#pragma unroll
    for (int i = 0; i < 32; ++i) { const int kk = 2 * i + (lane >> 5); scr[kk * 33 + c] = v[i]; }
    asm volatile("s_waitcnt lgkmcnt(0)" ::: "memory");
    const int c8 = lane & 7;
#pragma unroll
    for (int j = 0; j < 4; ++j) { const int n = (lane >> 3) + 8 * j; const LAS float* s = scr + (8 * c8) * 33 + n;
        if (q.fp8) { const f32x4 a = {s[0 * 33], s[1 * 33], s[2 * 33], s[3 * 33]}, b = {s[4 * 33], s[5 * 33], s[6 * 33], s[7 * 33]};
            *(u32x2*)((unsigned char*)q.WT + (size_t)(q.drow0 + n) * q.ldt + q.dk0 + 8 * c8) = pack8_fp8(a, b); }
        else { u32x4 o; o.x = cvt_pk_bf16(s[0 * 33], s[1 * 33]); o.y = cvt_pk_bf16(s[2 * 33], s[3 * 33]); o.z = cvt_pk_bf16(s[4 * 33], s[5 * 33]); o.w = cvt_pk_bf16(s[6 * 33], s[7 * 33]);
            *(u32x4*)(q.WT + (size_t)(q.drow0 + n) * q.ldt + q.dk0 + 8 * c8) = o; } }
    asm volatile("s_waitcnt lgkmcnt(0)" ::: "memory");
}
template <class F>
__device__ __forceinline__ void tr_stream(int n, int gw, int ngw, const F& params, LAS float* scr, int lane) {
    int it = gw; if (it >= n) return;
    float va[32], vb[32];
    TrP pa = params(it), pb = pa; tr_load(va, pa, lane);
    for (;;) {
        const int it2 = it + ngw; const bool has2 = it2 < n;
        if (has2) { pb = params(it2); tr_load(vb, pb, lane); }
        tr_store(va, pa, scr, lane);
        if (!has2) break;
        const int it3 = it2 + ngw; const bool has3 = it3 < n;
        if (has3) { pa = params(it3); tr_load(va, pa, lane); }
        tr_store(vb, pb, scr, lane);
        if (!has3) break;
        it = it3;
    }
}
__device__ __forceinline__ int win_src_col(int r) {
    if (r >= WIN_SRC) return -1;
    if (r >= 11264) return 2560 + (r - 11264);
    const int tile = r >> 8; int j = r & 255;
    const bool rope = (tile == 6) | (tile == 8) | (tile >= 10 && tile < 22);
    if (rope) { const int q = j >> 6, d = j & 63; j = (q & 1) * 128 + (q >> 1) * 64 + d; }
    const int c = tile * 256 + j;
    return c < 2560 ? c : c + 24;
}
__device__ __forceinline__ void conv_ffn(const float* Wg, const float* Wu, const float* Wd, bf16_t* GU, bf16_t* DN, LAS float* scr, int gw, int ngw, int lane) {
    constexpr int I_G = 32 * 176;
    tr_stream(2 * I_G, gw, ngw, [&](int it) { const int which = it / I_G, r = it % I_G, kb = r / 176, nb = r % 176, c0 = nb * 32;
        return TrP{which ? Wu : Wg, FF, kb * 64, c0, 32, GU, DM, 256 * (c0 >> 7) + (c0 & 127) + which * 128, kb * 64, 0}; }, scr, lane);
    tr_stream(88 * 64, gw, ngw, [&](int it) { const int kb = it / 64, nb = it % 64; return TrP{Wd, DM, kb * 64, nb * 32, 32, DN, FF, nb * 32, kb * 64, 0}; }, scr, lane);
}
__device__ __forceinline__ void ln_rows(const float* in, float* outf, bf16_t* outb, const float* g, const float* b, int gw, int ngw, int lane, float* stats = nullptr, unsigned char* out8 = nullptr) {
    f32x4 gv[8], bv[8];
#pragma unroll
    for (int j = 0; j < 8; ++j) { gv[j] = *(const f32x4*)(g + 4 * (lane + 64 * j)); bv[j] = *(const f32x4*)(b + 4 * (lane + 64 * j)); }
    for (int row = gw; row < S; row += ngw) {
        const float* xr = in + (size_t)row * DM; f32x4 v[8]; float s = 0.f;
#pragma unroll
        for (int j = 0; j < 8; ++j) { v[j] = *(const f32x4*)(xr + 4 * (lane + 64 * j)); s += (v[j][0] + v[j][1]) + (v[j][2] + v[j][3]); }
        const float mean = wave_sum(s) * (1.f / DM); float s2 = 0.f;
#pragma unroll
        for (int j = 0; j < 8; ++j) { v[j] = v[j] - mean; s2 += (v[j][0] * v[j][0] + v[j][1] * v[j][1]) + (v[j][2] * v[j][2] + v[j][3] * v[j][3]); }
        const float rstd = 1.f / sqrtf(wave_sum(s2) * (1.f / DM) + LN_EPS);
        if (stats && lane == 0) *(f32x2*)(stats + 2 * (size_t)row) = (f32x2){mean, rstd};
#pragma unroll
        for (int j = 0; j < 8; ++j) { const f32x4 o = v[j] * rstd * gv[j] + bv[j];
            if (outf) *(f32x4*)(outf + (size_t)row * DM + 4 * (lane + 64 * j)) = o;
            if (outb) { u32x2 w; w.x = cvt_pk_bf16(o[0], o[1]); w.y = cvt_pk_bf16(o[2], o[3]); *(u32x2*)(outb + (size_t)row * DM + 4 * (lane + 64 * j)) = w; }
            if (out8) { unsigned w8 = 0u; w8 = __builtin_amdgcn_cvt_pk_fp8_f32(o[0], o[1], w8, false); w8 = __builtin_amdgcn_cvt_pk_fp8_f32(o[2], o[3], w8, true); *(unsigned*)(out8 + (size_t)row * DM + 4 * (lane + 64 * j)) = w8; } }
    }
}

struct AState { float m, l; f32x4 o[8]; };
__device__ __forceinline__ void astate_init(AState& s) { s.m = -1e30f; s.l = 0.f;
#pragma unroll
    for (int i = 0; i < 8; ++i) s.o[i] = (f32x4){0.f, 0.f, 0.f, 0.f}; }
__device__ __forceinline__ int clampi(int v, int lo, int hi) { return v < lo ? lo : (v > hi ? hi : v); }

__device__ __forceinline__ void load_k(bf16x8 (&kf)[2][4], const bf16_t* __restrict__ Kb, int ld, int pos0, int dpos, int posmax, int l16, int kq) {
#pragma unroll
    for (int T = 0; T < 2; ++T) { const int p = clampi(pos0 + dpos * (16 * T + l16), 0, posmax); const bf16_t* kp = Kb + (size_t)p * ld + 8 * kq;
#pragma unroll
        for (int s = 0; s < 4; ++s) kf[T][s] = *(const bf16x8*)(kp + 32 * s); }
}
__device__ __forceinline__ void load_v(u32x4 (&vr)[8], const bf16_t* __restrict__ Vb, int ld, int pos0, int dpos, int posmax, int l16, int kq) {
#pragma unroll
    for (int i = 0; i < 8; ++i) { const int p = clampi(pos0 + dpos * (4 * i + kq), 0, posmax); vr[i] = *(const u32x4*)(Vb + (size_t)p * ld + 8 * l16); }
}
__device__ __forceinline__ void store_v(const u32x4 (&vr)[8], LAS unsigned char* vbuf, int l16, int kq) {
#pragma unroll
    for (int i = 0; i < 8; ++i) *(LAS u32x4*)(vbuf + (4 * i + kq) * VROW + 16 * l16) = vr[i];
}
template <int MODE, bool SLC, class Desc>
__device__ __forceinline__ void attn_run(const bf16x8 (&qf)[4], const bf16_t* __restrict__ Kb, const bf16_t* __restrict__ Vb, int ld, int dpos, int posmax,
                                         const Desc& desc, int n, int lo_in, int hi, int qi, AState& st, LAS unsigned char* vbuf, int lane, LAS float* imp = nullptr) {
    if (n <= 0) return;
    const int l16 = lane & 15, kq = lane >> 4;
    u32x4 kr[8];
    int dcur = desc(0);
    load_v(kr, Kb, ld, SLC ? (dcur & 0xfffff) : dcur, dpos, posmax, l16, kq);
#pragma unroll 1
    for (int i = 0; i < n; ++i) {
        const int pos0 = SLC ? (dcur & 0xfffff) : dcur;
        const int lo = SLC ? ((((dcur >> 20) == qi) | ((dcur >> 20) == 4)) ? 0 : (1 << 30)) : lo_in;
        store_v(kr, vbuf, l16, kq);
        u32x4 vr[8];
        if (MODE != 1) load_v(vr, Vb, ld, pos0, dpos, posmax, l16, kq);
        bf16x8 kf[2][4];
#pragma unroll
        for (int T = 0; T < 2; ++T)
#pragma unroll
            for (int s = 0; s < 4; ++s) kf[T][s] = *(const LAS bf16x8*)(vbuf + (16 * T + l16) * VROW + 64 * s + 16 * kq);
        f32x4 sa[2] = {(f32x4){0.f, 0.f, 0.f, 0.f}, (f32x4){0.f, 0.f, 0.f, 0.f}};
#pragma unroll
        for (int T = 0; T < 2; ++T)
#pragma unroll
            for (int s = 0; s < 4; ++s) sa[T] = __builtin_amdgcn_mfma_f32_16x16x32_bf16(kf[T][s], qf[s], sa[T], 0, 0, 0);
        const int dnext = desc(i + 1 < n ? i + 1 : i);
        load_v(kr, Kb, ld, SLC ? (dnext & 0xfffff) : dnext, dpos, posmax, l16, kq);
        float sc[8]; bool vd[8]; float mx = -1e30f;
#pragma unroll
        for (int T = 0; T < 2; ++T)
#pragma unroll
            for (int r = 0; r < 4; ++r) { const int p = pos0 + dpos * (16 * T + 4 * kq + r); const bool v = (p >= lo) & (p <= hi); const float x = sa[T][r] * SL2;
                sc[4 * T + r] = x; vd[4 * T + r] = v; mx = v ? fmaxf(mx, x) : mx; }
        float p[8];
        if (MODE == 2) {
#pragma unroll
            for (int j = 0; j < 8; ++j) p[j] = vd[j] ? __builtin_amdgcn_exp2f(sc[j] - st.m) * st.l : 0.f;
#pragma unroll
            for (int T = 0; T < 2; ++T) {
                float x = 2.f * (p[4 * T] + p[4 * T + 1] + p[4 * T + 2]) + p[4 * T + 3], y = p[4 * T + 3];
                x += quad_xor1(x); x += quad_xor2(x); y += quad_xor1(y); y += quad_xor2(y);
                if ((l16 & 3) == 0) { const int a = (pos0 >> 2) + 4 * T + kq; LAS float* ip = imp + (l16 >> 2) * IMP_LD + a;
                    ip[0] += x;
                    asm volatile("s_waitcnt lgkmcnt(0)" ::: "memory");
                    ip[1] += y; }
                asm volatile("s_waitcnt lgkmcnt(0)" ::: "memory");
            }
        } else {
            if (__builtin_amdgcn_ballot_w64(mx > st.m + 40.f) != 0ull) {
                mx = fmaxf(mx, __shfl_xor(mx, 16)); mx = fmaxf(mx, __shfl_xor(mx, 32));
                const float mn = fmaxf(st.m, mx), alpha = __builtin_amdgcn_exp2f(st.m - mn); st.m = mn; st.l *= alpha;
                if (MODE == 0) {
#pragma unroll
                    for (int j = 0; j < 8; ++j) st.o[j] = st.o[j] * alpha;
                }
            }
            float ps = 0.f;
#pragma unroll
            for (int j = 0; j < 8; ++j) { p[j] = vd[j] ? __builtin_amdgcn_exp2f(sc[j] - st.m) : 0.f; ps += p[j]; }
            st.l += ps;
        }
        if (MODE != 1) {
            store_v(vr, vbuf, l16, kq);
            u32x4 pw; pw.x = cvt_pk_bf16(p[0], p[1]); pw.y = cvt_pk_bf16(p[2], p[3]); pw.z = cvt_pk_bf16(p[4], p[5]); pw.w = cvt_pk_bf16(p[6], p[7]);
            const bf16x8 pf = __builtin_bit_cast(bf16x8, pw);
            const unsigned addr = (unsigned)(uintptr_t)(vbuf) + (4 * kq + (l16 >> 2)) * VROW + (l16 & 3) * 8;
#pragma unroll
            for (int hf = 0; hf < 2; ++hf) {
                s16x4 a[8];
                asm volatile("s_waitcnt lgkmcnt(0)\n\t"
                             "ds_read_b64_tr_b16 %0, %8 offset:0\n\t"    "ds_read_b64_tr_b16 %1, %8 offset:32\n\t"
                             "ds_read_b64_tr_b16 %2, %8 offset:64\n\t"   "ds_read_b64_tr_b16 %3, %8 offset:96\n\t"
                             "ds_read_b64_tr_b16 %4, %8 offset:4608\n\t" "ds_read_b64_tr_b16 %5, %8 offset:4640\n\t"
                             "ds_read_b64_tr_b16 %6, %8 offset:4672\n\t" "ds_read_b64_tr_b16 %7, %8 offset:4704\n\t"
                             "s_waitcnt lgkmcnt(0)"
                             : "=&v"(a[0]), "=&v"(a[1]), "=&v"(a[2]), "=&v"(a[3]), "=&v"(a[4]), "=&v"(a[5]), "=&v"(a[6]), "=&v"(a[7])
                             : "v"(addr + 128 * hf) : "memory");
#pragma unroll
                for (int d4 = 0; d4 < 4; ++d4) { const int db = 4 * hf + d4;
                    bf16x8 af; af[0] = a[d4][0]; af[1] = a[d4][1]; af[2] = a[d4][2]; af[3] = a[d4][3]; af[4] = a[d4 + 4][0]; af[5] = a[d4 + 4][1]; af[6] = a[d4 + 4][2]; af[7] = a[d4 + 4][3];
                    st.o[db] = __builtin_amdgcn_mfma_f32_16x16x32_bf16(af, pf, st.o[db], 0, 0, 0); }
            }
        }
        dcur = dnext;
    }
}
struct FragV { bf16x8 v[8]; };
__device__ __forceinline__ void load_fk(bf16x8 (&k)[2][4], const bf16_t* __restrict__ KF, int pos0, int lane) {
    const bf16_t* kp = KF + ((size_t)(pos0 >> 4) * 256 + lane) * 8;
#pragma unroll
    for (int T = 0; T < 2; ++T)
#pragma unroll
        for (int s2 = 0; s2 < 4; ++s2) k[T][s2] = *(const bf16x8*)(kp + (T * 4 + s2) * 512);
}
__device__ __forceinline__ void load_fv(FragV& f, const bf16_t* __restrict__ VF, int pos0, int lane) {
    const bf16_t* vp = VF + ((size_t)(pos0 >> 5) * 512 + lane) * 8;
#pragma unroll
    for (int db = 0; db < 8; ++db) f.v[db] = *(const bf16x8*)(vp + db * 512);
}
template <int MODE>
__device__ __forceinline__ void step_fragb(const bf16x8 (&qf)[4], bf16x8 (&kf)[2][4], FragV& cur, const bf16_t* __restrict__ KF, const bf16_t* __restrict__ VF,
                                           int pos0, int pnext, int lo, int hi, AState& st, int lane, LAS float* imp) {
    const int kq = lane >> 4;
    f32x4 sa[2] = {(f32x4){0.f, 0.f, 0.f, 0.f}, (f32x4){0.f, 0.f, 0.f, 0.f}};
#pragma unroll
    for (int T = 0; T < 2; ++T)
#pragma unroll
        for (int s2 = 0; s2 < 4; ++s2) sa[T] = __builtin_amdgcn_mfma_f32_16x16x32_bf16(kf[T][s2], qf[s2], sa[T], 0, 0, 0);
    load_fk(kf, KF, pnext, lane);
    float sc[8]; bool vd[8]; float mx = -1e30f;
#pragma unroll
    for (int T = 0; T < 2; ++T)
#pragma unroll
        for (int r = 0; r < 4; ++r) { const int p = pos0 + 16 * T + 4 * kq + r; const bool v = (p >= lo) & (p <= hi); const float x = sa[T][r] * SL2;
            sc[4 * T + r] = x; vd[4 * T + r] = v; mx = v ? fmaxf(mx, x) : mx; }
    float p[8];
    if (MODE == 2) {
        const int l16 = lane & 15;
#pragma unroll
        for (int j = 0; j < 8; ++j) p[j] = vd[j] ? __builtin_amdgcn_exp2f(sc[j] - st.m) * st.l : 0.f;
#pragma unroll
        for (int T = 0; T < 2; ++T) {
            float x = 2.f * (p[4 * T] + p[4 * T + 1] + p[4 * T + 2]) + p[4 * T + 3], y = p[4 * T + 3];
            x += quad_xor1(x); x += quad_xor2(x); y += quad_xor1(y); y += quad_xor2(y);
            if ((l16 & 3) == 0) { const int a = (pos0 >> 2) + 4 * T + kq; LAS float* ip = imp + (l16 >> 2) * IMP_LD + a;
                ip[0] += x;
                asm volatile("s_waitcnt lgkmcnt(0)" ::: "memory");
                ip[1] += y; }
            asm volatile("s_waitcnt lgkmcnt(0)" ::: "memory");
        }
    } else {
        if (__builtin_amdgcn_ballot_w64(mx > st.m + 40.f) != 0ull) {
            mx = fmaxf(mx, __shfl_xor(mx, 16)); mx = fmaxf(mx, __shfl_xor(mx, 32));
            const float mn = fmaxf(st.m, mx), alpha = __builtin_amdgcn_exp2f(st.m - mn); st.m = mn; st.l *= alpha;
            if (MODE == 0) {
#pragma unroll
                for (int j = 0; j < 8; ++j) st.o[j] = st.o[j] * alpha;
            }
        }
        float ps = 0.f;
#pragma unroll
        for (int j = 0; j < 8; ++j) { p[j] = vd[j] ? __builtin_amdgcn_exp2f(sc[j] - st.m) : 0.f; ps += p[j]; }
        st.l += ps;
    }
    if (MODE != 1) {
        u32x4 pw; pw.x = cvt_pk_bf16(p[0], p[1]); pw.y = cvt_pk_bf16(p[2], p[3]); pw.z = cvt_pk_bf16(p[4], p[5]); pw.w = cvt_pk_bf16(p[6], p[7]);
        const bf16x8 pf = __builtin_bit_cast(bf16x8, pw);
#pragma unroll
        for (int db = 0; db < 8; ++db) st.o[db] = __builtin_amdgcn_mfma_f32_16x16x32_bf16(cur.v[db], pf, st.o[db], 0, 0, 0);
        load_fv(cur, VF, pnext, lane);
    }
}
template <int MODE, bool SLC, class Desc>
__device__ __forceinline__ void attn_run_frag(const bf16x8 (&qf)[4], const bf16_t* __restrict__ KF, const bf16_t* __restrict__ VF, const Desc& desc, int n,
                                              int lo_in, int hi, int qi, AState& st, int lane, LAS float* imp = nullptr) {
    static_assert(!SLC, "the bf16 fragment walk is used without per-step query selection");
    if (n <= 0) return;
    bf16x8 kf[2][4]; FragV va;
    int d0 = desc(0);
    load_fk(kf, KF, d0, lane);
    if (MODE != 1) load_fv(va, VF, d0, lane);
#pragma unroll 1
    for (int i = 0; i < n; ++i) {
        const int d1 = desc(i + 1 < n ? i + 1 : i);
        step_fragb<MODE>(qf, kf, va, KF, VF, d0, d1, lo_in, hi, st, lane, imp);
        d0 = d1;
    }
}
struct Frag8 { i64_t k[2][4]; i64_t v[8]; };
__device__ __forceinline__ void load_frag8(Frag8& f, const unsigned char* __restrict__ KF, const unsigned char* __restrict__ VF, int pos0, int lane) {
    const unsigned char* kp = KF + ((size_t)(pos0 >> 4) * 256 + lane) * 8; const unsigned char* vp = VF + ((size_t)(pos0 >> 5) * 512 + lane) * 8;
#pragma unroll
    for (int T = 0; T < 2; ++T)
#pragma unroll
        for (int s2 = 0; s2 < 4; ++s2) f.k[T][s2] = *(const i64_t*)(kp + (T * 4 + s2) * 512);
#pragma unroll
    for (int db = 0; db < 8; ++db) f.v[db] = *(const i64_t*)(vp + db * 512);
}
template <bool SLC, bool NOMASK>
__device__ __forceinline__ void step_frag8(const i64_t (&qf)[4], const Frag8& cur, Frag8& nxt, const unsigned char* __restrict__ KF, const unsigned char* __restrict__ VF,
                                           int dcur, int dnext, int lo_in, int hi, int qi, AState& st, int lane) {
    const int kq = lane >> 4;
    const int pos0 = SLC ? (dcur & 0xfffff) : dcur;
    const int lo = SLC ? ((((dcur >> 20) == qi) | ((dcur >> 20) == 4)) ? 0 : (1 << 30)) : lo_in;
    load_frag8(nxt, KF, VF, SLC ? (dnext & 0xfffff) : dnext, lane);
    f32x4 sa[2] = {(f32x4){0.f, 0.f, 0.f, 0.f}, (f32x4){0.f, 0.f, 0.f, 0.f}};
#pragma unroll
    for (int T = 0; T < 2; ++T)
#pragma unroll
        for (int s2 = 0; s2 < 4; ++s2) sa[T] = __builtin_amdgcn_mfma_f32_16x16x32_fp8_fp8(cur.k[T][s2], qf[s2], sa[T], 0, 0, 0);
    float sc[8]; bool vd[8]; float mx = -1e30f;
    const bool act = lo == 0 || !SLC;
    if (NOMASK) {
#pragma unroll
        for (int j = 0; j < 8; ++j) { sc[j] = sa[j >> 2][j & 3]; vd[j] = act; }
        mx = fmaxf(fmaxf(fmaxf(sc[0], sc[1]), fmaxf(sc[2], sc[3])), fmaxf(fmaxf(sc[4], sc[5]), fmaxf(sc[6], sc[7])));
        mx = act ? mx : -1e30f;
    } else {
#pragma unroll
        for (int T = 0; T < 2; ++T)
#pragma unroll
            for (int r = 0; r < 4; ++r) { const int p = pos0 + 16 * T + 4 * kq + r; const bool v = (p >= lo) & (p <= hi); const float x = sa[T][r];
                sc[4 * T + r] = x; vd[4 * T + r] = v; mx = v ? fmaxf(mx, x) : mx; }
    }
    if (__builtin_amdgcn_ballot_w64(mx > st.m + 4.f) != 0ull) {
        mx = fmaxf(mx, __shfl_xor(mx, 16)); mx = fmaxf(mx, __shfl_xor(mx, 32));
        const float mn = fmaxf(st.m, mx), alpha = __builtin_amdgcn_exp2f(st.m - mn); st.m = mn; st.l *= alpha;
#pragma unroll
        for (int j = 0; j < 8; ++j) st.o[j] = st.o[j] * alpha;
    }
    f32x4 pa, pb; float ps = 0.f;
    const float mref = st.m - 4.f;
    if (NOMASK) {
#pragma unroll
        for (int j = 0; j < 4; ++j) { pa[j] = __builtin_amdgcn_exp2f(sc[j] - mref); pb[j] = __builtin_amdgcn_exp2f(sc[4 + j] - mref); }
        if (SLC) {
#pragma unroll
            for (int j = 0; j < 4; ++j) { pa[j] = act ? pa[j] : 0.f; pb[j] = act ? pb[j] : 0.f; }
        }
#pragma unroll
        for (int j = 0; j < 4; ++j) ps += pa[j] + pb[j];
    } else {
#pragma unroll
        for (int j = 0; j < 4; ++j) { pa[j] = vd[j] ? __builtin_amdgcn_exp2f(sc[j] - mref) : 0.f; pb[j] = vd[4 + j] ? __builtin_amdgcn_exp2f(sc[4 + j] - mref) : 0.f; ps += pa[j] + pb[j]; }
    }
    st.l += ps;
    const u32x2 pw = pack8_fp8(pa, pb);
    const i64_t pf = __builtin_bit_cast(i64_t, pw);
#pragma unroll
    for (int db = 0; db < 8; ++db) st.o[db] = __builtin_amdgcn_mfma_f32_16x16x32_fp8_fp8(cur.v[db], pf, st.o[db], 0, 0, 0);
}
template <bool SLC, class Desc>
__device__ __forceinline__ void attn_run_frag8(const i64_t (&qf)[4], const unsigned char* __restrict__ KF, const unsigned char* __restrict__ VF, const Desc& desc, int n,
                                               int lo_in, int hi, int qi, AState& st, int lane) {
    if (n <= 0) return;
    Frag8 fa, fb, fc;
    constexpr int NM = ~(1 << 30);
    int d0 = desc(0), d1 = desc(n > 1 ? 1 : 0);
    load_frag8(fa, KF, VF, SLC ? (d0 & 0xfffff) : (d0 & NM), lane);
    load_frag8(fb, KF, VF, SLC ? (d1 & 0xfffff) : (d1 & NM), lane);
#define F8_STEP(CUR, NXT2, DC, DN2) do { \
        if ((DC) & (1 << 30)) step_frag8<SLC, true>(qf, CUR, NXT2, KF, VF, (DC) & NM, (DN2) & NM, lo_in, hi, qi, st, lane); \
        else step_frag8<SLC, false>(qf, CUR, NXT2, KF, VF, (DC), (DN2) & NM, lo_in, hi, qi, st, lane); } while (0)
#pragma unroll 1
    for (int i = 0; i < n; i += 3) {
        const int d2 = desc(i + 2 < n ? i + 2 : n - 1);
        F8_STEP(fa, fc, d0, d2);
        if (i + 1 >= n) break;
        const int d3 = desc(i + 3 < n ? i + 3 : n - 1);
        F8_STEP(fb, fa, d1, d3);
        if (i + 2 >= n) break;
        const int d4 = desc(i + 4 < n ? i + 4 : n - 1);
        F8_STEP(fc, fb, d2, d4);
        d0 = d3; d1 = d4;
    }
#undef F8_STEP
}
__device__ __forceinline__ float quad_total(float v) { v += __shfl_xor(v, 16); v += __shfl_xor(v, 32); return v; }

__device__ __forceinline__ void dilated_unit(int unit, const bf16_t* proj, const bf16_t* kbf, bf16_t* nsaout, int lane) {
    const int l16 = lane & 15, kq = lane >> 4;
    const int hg = (unit >> 4) & 3, r16 = unit & 15, ut = unit >> 6;
    const int t0 = r16 + 256 * ut, tc = t0 + 16 * l16;
    const unsigned char* kb8 = (const unsigned char*)kbf; const unsigned char* vb8 = kb8 + ((size_t)24 << 20);
    AState st; astate_init(st);
#pragma unroll 1
    for (int pt = 0; pt < 3; ++pt) {
        const int sh = 2 * pt, head = 4 * pt + hg;
        const bf16_t* qrow = proj + (size_t)tc * PLD + PC_QB + head * 128 + 8 * kq;
        i64_t q8[4];
#pragma unroll
        for (int s = 0; s < 4; ++s) { const bf16x8 qv = *(const bf16x8*)(qrow + 32 * s); f32x4 a, b;
#pragma unroll
            for (int j = 0; j < 4; ++j) { a[j] = bf2f((unsigned short)qv[j]) * SL2; b[j] = bf2f((unsigned short)qv[4 + j]) * SL2; }
            q8[s] = __builtin_bit_cast(i64_t, pack8_fp8(a, b)); }
        const int base = (r16 & ((1 << sh) - 1)) << (14 - sh), u0 = t0 >> sh, ui = u0 + (16 >> sh) * l16;
        const int lo = base + (ui - 128 < 0 ? 0 : ui - 128), hi = base + ui;
        const int first = (base + (u0 - 128 < 0 ? 0 : u0 - 128)) >> 5, last = (base + u0 + 15 * (16 >> sh)) >> 5;
        unsigned long long hoff = (unsigned long long)head * S * 128; asm volatile("" : "+s"(hoff));
        auto desc = [&](int i) { return 32 * (first + i); };
        attn_run_frag8<false>(q8, kb8 + hoff, vb8 + hoff, desc, last - first + 1, lo, hi, 0, st, lane);
    }
    const float lt = quad_total(st.l), inv = lt > 0.f ? 1.f / lt : 0.f;
    bf16_t* op = nsaout + (size_t)tc * NOLD + 1024 + hg * 128 + 4 * kq;
#pragma unroll
    for (int db = 0; db < 8; ++db) { const f32x4 o = st.o[db] * inv; u32x2 w; w.x = cvt_pk_bf16(o[0], o[1]); w.y = cvt_pk_bf16(o[2], o[3]); *(u32x2*)(op + 16 * db) = w; }
}

__device__ __forceinline__ void compress_unit(int unit, const bf16_t* proj, const bf16_t* w1t, const bf16_t* w2t, const float* bias, bf16_t* outc, LAS unsigned char* lds, int wave, int lane) {
    const int l16 = lane & 15, kq = lane >> 4;
    const int rt = unit & 63, g = (unit >> 6) & 1, kv = unit >> 7;
    const bf16_t* raw = proj + (kv ? PC_VC : PC_KC) + 128 * g;
    const int n = 16 * rt + l16;
    f32x4 acc[16];
#pragma unroll
    for (int i = 0; i < 16; ++i) acc[i] = (f32x4){0.f, 0.f, 0.f, 0.f};
#pragma unroll 2
    for (int si = 0; si < 16; ++si) {
        const int s = 16 * wave + si;
        const int tok = clampi(16 * n + (s >> 2), 0, S - 1);
        const bf16x8 af = *(const bf16x8*)(raw + (size_t)tok * PLD + (s & 3) * 32 + 8 * kq);
#pragma unroll
        for (int ct = 0; ct < 16; ++ct) { const bf16x8 bfr = *(const bf16x8*)(w1t + ((size_t)(ct * 128 + s) * 64 + lane) * 8);
            acc[ct] = __builtin_amdgcn_mfma_f32_16x16x32_bf16(af, bfr, acc[ct], 0, 0, 0); }
    }
    LAS f32x4* part = (LAS f32x4*)lds;
#pragma unroll
    for (int ct = 0; ct < 16; ++ct) part[(wave * 16 + ct) * 64 + lane] = acc[ct];
    __syncthreads();
    LAS unsigned char* hid = lds + 131072;
#pragma unroll
    for (int c2 = 0; c2 < 2; ++c2) { const int ct = 2 * wave + c2; f32x4 sum = (f32x4){0.f, 0.f, 0.f, 0.f};
#pragma unroll
        for (int w = 0; w < 8; ++w) sum += part[(w * 16 + ct) * 64 + lane];
        const float bb = bias[16 * ct + l16];
#pragma unroll
        for (int r = 0; r < 4; ++r) { const float x = sum[r] + bb; const float u2 = 1.5957691216f * (x + 0.044715f * x * x * x); const float gl = x * fsigmoid(u2);
            *(LAS bf16_t*)(hid + (4 * kq + r) * 528 + (16 * ct + l16) * 2) = (bf16_t)(cvt_pk_bf16(gl, 0.f) & 0xffffu); } }
    __syncthreads();
    f32x4 o2 = (f32x4){0.f, 0.f, 0.f, 0.f};
    const int dt = wave;
#pragma unroll
    for (int s = 0; s < 8; ++s) {
        const bf16x8 af = *(const LAS bf16x8*)(hid + l16 * 528 + (32 * s + 8 * kq) * 2);
        const bf16x8 bfr = *(const bf16x8*)(w2t + (size_t)(16 * dt + l16) * 256 + 32 * s + 8 * kq);
        o2 = __builtin_amdgcn_mfma_f32_16x16x32_bf16(af, bfr, o2, 0, 0, 0);
    }
#pragma unroll
    for (int r = 0; r < 4; ++r) { const int nn = 16 * rt + 4 * kq + r, d = 16 * dt + l16;
        const bf16_t val = (bf16_t)(cvt_pk_bf16(o2[r], 0.f) & 0xffffu);
        if (kv == 0) outc[(((size_t)g * 64 + (nn >> 4)) * 4 + (d >> 5)) * 512 + (((d >> 3) & 3) * 16 + (nn & 15)) * 8 + (d & 7)] = val;
        else { const int kp = nn & 31; outc[(((size_t)g * 32 + (nn >> 5)) * 8 + (d >> 4)) * 512 + ((((kp >> 2) & 3) * 16) + (d & 15)) * 8 + 4 * (kp >> 4) + (kp & 3)] = val; } }
    __syncthreads();
}

__device__ __forceinline__ void nsa_unit(int unit, const bf16_t* proj, const bf16_t* kc, const bf16_t* vc, const bf16_t* gn, const float* cs, const float* sn,
                                         const bf16_t* kslf, const bf16_t* vslf, const bf16_t* kwnf, const bf16_t* vwnf, bf16_t* nsaout, LAS unsigned char* wl, int lane) {
    const int l16 = lane & 15, kq = lane >> 4;
    const int g = unit & 1, tb = unit >> 1, t0 = 4 * tb, qi = l16 >> 2, h = l16 & 3, tc = t0 + qi, head = 4 * g + h;
    LAS unsigned char* vbuf = wl; LAS float* imp = (LAS float*)(wl + VBUF_BYTES); LAS int* sel = (LAS int*)(wl + VBUF_BYTES + 4 * IMP_LD * 4);
    bf16x8 qf[4];
    { const bf16_t* qrow = proj + (size_t)tc * PLD + PC_QA + head * 128 + 8 * kq;
#pragma unroll
        for (int s = 0; s < 4; ++s) qf[s] = *(const bf16x8*)(qrow + 32 * s); }
    LAS u32x2* outl = (LAS u32x2*)(wl + OUT_OFF) + lane;
    for (int i = lane; i < 4 * IMP_LD; i += 64) imp[i] = 0.f;
    const int hic = (tc - 31) >> 4;
    const int nkmax = ((t0 + 3 - 31) >> 4) + 1, nsc = nkmax > 0 ? (nkmax + 31) >> 5 : 0;
    unsigned long long coff = (unsigned long long)g * 1024 * 128; asm volatile("" : "+s"(coff));
    const bf16_t* kcg = kc + coff; const bf16_t* vcg = vc + coff;
    AState st; astate_init(st);
    { auto desc = [&](int i) { return 32 * i; };
      attn_run_frag<1, false>(qf, kcg, vcg, desc, nsc, 0, hic, 0, st, lane);
      { const float lt = quad_total(st.l); st.l = lt > 0.f ? 1.f / lt : 0.f; }
      asm volatile("s_waitcnt lgkmcnt(0)" ::: "memory");
      attn_run_frag<2, false>(qf, kcg, vcg, desc, nsc, 0, hic, 0, st, lane, imp); }
    const float g0 = bf2f(gn[(size_t)tc * 32 + head * 3 + 0]);
#pragma unroll
    for (int i = 0; i < 8; ++i) { const f32x4 o = st.o[i] * g0; u32x2 w; w.x = cvt_pk_bf16(o[0], o[1]); w.y = cvt_pk_bf16(o[2], o[3]); outl[64 * i] = w; }
    asm volatile("s_waitcnt lgkmcnt(0)" ::: "memory");
#pragma unroll
    for (int s2 = 0; s2 < 2; ++s2) {
        const int d = 32 * s2 + 8 * kq; f32x4 c[2], sv[2];
        c[0] = *(const f32x4*)(cs + (size_t)tc * 64 + d); c[1] = *(const f32x4*)(cs + (size_t)tc * 64 + d + 4);
        sv[0] = *(const f32x4*)(sn + (size_t)tc * 64 + d); sv[1] = *(const f32x4*)(sn + (size_t)tc * 64 + d + 4);
        float o1[8], o2[8];
#pragma unroll
        for (int j = 0; j < 8; ++j) { const float x1 = bf2f((unsigned short)qf[s2][j]), x2 = bf2f((unsigned short)qf[s2 + 2][j]), cc = c[j >> 2][j & 3], ss = sv[j >> 2][j & 3];
            o1[j] = x1 * cc - x2 * ss; o2[j] = x2 * cc + x1 * ss; }
        u32x4 w1, w2; w1.x = cvt_pk_bf16(o1[0], o1[1]); w1.y = cvt_pk_bf16(o1[2], o1[3]); w1.z = cvt_pk_bf16(o1[4], o1[5]); w1.w = cvt_pk_bf16(o1[6], o1[7]);
        w2.x = cvt_pk_bf16(o2[0], o2[1]); w2.y = cvt_pk_bf16(o2[2], o2[3]); w2.z = cvt_pk_bf16(o2[4], o2[5]); w2.w = cvt_pk_bf16(o2[6], o2[7]);
        qf[s2] = __builtin_bit_cast(bf16x8, w1); qf[s2 + 2] = __builtin_bit_cast(bf16x8, w2);
    }
    unsigned key[4][4];
#pragma unroll
    for (int q = 0; q < 4; ++q) { const int cur = (t0 + q) >> 6; const f32x4 v = *(const LAS f32x4*)(imp + q * IMP_LD + 4 * lane);
#pragma unroll
        for (int i = 0; i < 4; ++i) { const int j = 4 * lane + i; const bool valid = j <= cur, forced = (j == 0) | (j == cur) | (j == cur - 1);
            const unsigned kb = forced ? 0xffffffu : ((__float_as_uint(fmaxf(v[i], 0.f)) >> 8) + 1u);
            key[q][i] = valid ? ((kb << 8) | (unsigned)(255 - j)) : 0u; } }
#pragma unroll 1
    for (int r = 0; r < 16; ++r) {
        unsigned mx[4];
#pragma unroll
        for (int q = 0; q < 4; ++q) { unsigned a = key[q][0] > key[q][1] ? key[q][0] : key[q][1], b = key[q][2] > key[q][3] ? key[q][2] : key[q][3]; mx[q] = a > b ? a : b; }
#pragma unroll
        for (int o = 1; o < 64; o <<= 1)
#pragma unroll
            for (int q = 0; q < 4; ++q) { const unsigned other = (unsigned)__shfl_xor((int)mx[q], o); mx[q] = other > mx[q] ? other : mx[q]; }
#pragma unroll
        for (int q = 0; q < 4; ++q) {
#pragma unroll
            for (int i = 0; i < 4; ++i) if (key[q][i] == mx[q]) key[q][i] = 0u;
            if (lane == 0) sel[q * 16 + r] = mx[q] ? (int)(255u - (mx[q] & 255u)) : -1;
        }
    }
    asm volatile("s_waitcnt lgkmcnt(0)" ::: "memory");
    i64_t q8[4];
#pragma unroll
    for (int s2 = 0; s2 < 4; ++s2) { f32x4 a, b;
#pragma unroll
        for (int j = 0; j < 4; ++j) { a[j] = bf2f((unsigned short)qf[s2][j]) * SL2; b[j] = bf2f((unsigned short)qf[s2][4 + j]) * SL2; }
        q8[s2] = __builtin_bit_cast(i64_t, pack8_fp8(a, b)); }
    LAS int* list = (LAS int*)(wl + VBUF_BYTES + 4 * IMP_LD * 4 + 256);
    int nslc;
    { const int b = sel[lane], q = lane >> 4, cur0 = t0 >> 6;
      const bool forced = (b == 0) | (b == cur0) | (b == cur0 - 1);
      const bool valid = (b >= 0) & !(forced & (q > 0)); const unsigned long long mask = __ballot(valid);
      const int idx = __popcll(mask & ((1ull << lane) - 1ull)); nslc = 2 * __popcll(mask);
      if (valid) { const int qc = (forced ? 4 : q) | (b < cur0 ? (1 << 10) : 0);
                   list[2 * idx] = (64 * b) | (qc << 20); list[2 * idx + 1] = (64 * b + 32) | (qc << 20); } }
    asm volatile("s_waitcnt lgkmcnt(0)" ::: "memory");
    astate_init(st);
    { auto desc = [&](int i) { return __builtin_amdgcn_readfirstlane(list[i]); };
      unsigned long long goff = (unsigned long long)g * S * 128; asm volatile("" : "+s"(goff));
      attn_run_frag8<true>(q8, (const unsigned char*)kslf + goff, (const unsigned char*)kslf + ((size_t)8 << 20) + goff, desc, nslc, 0, tc, qi, st, lane); }
    { const float g1 = bf2f(gn[(size_t)tc * 32 + head * 3 + 1]); const float lt = quad_total(st.l), inv = (lt > 0.f ? 1.f / lt : 0.f) * g1;
#pragma unroll
        for (int i = 0; i < 8; ++i) { const f32x4 o = st.o[i] * inv; u32x2 w = outl[64 * i]; w.x = cvt_pk_bf16(bflo(w.x) + o[0], bfhi(w.x) + o[1]); w.y = cvt_pk_bf16(bflo(w.y) + o[2], bfhi(w.y) + o[3]); outl[64 * i] = w; } }
    astate_init(st);
    { const int lo = tc - 511 < 0 ? 0 : tc - 511; const int first = t0 < 511 ? 0 : (t0 - 511) >> 5, last = (t0 + 3) >> 5;
      auto desc = [&](int i) { const int p0 = 32 * (first + i); return p0 | ((p0 >= t0 + 3 - 511 && p0 + 31 <= t0) ? (1 << 30) : 0); };
      unsigned long long goff = (unsigned long long)g * S * 128; asm volatile("" : "+s"(goff));
      attn_run_frag8<false>(q8, (const unsigned char*)kslf + ((size_t)16 << 20) + goff, (const unsigned char*)kslf + ((size_t)24 << 20) + goff, desc, last - first + 1, lo, tc, 0, st, lane); }
    { const float g2 = bf2f(gn[(size_t)tc * 32 + head * 3 + 2]); const float lt = quad_total(st.l), inv = (lt > 0.f ? 1.f / lt : 0.f) * g2;
#pragma unroll
        for (int i = 0; i < 8; ++i) { const f32x4 o = st.o[i] * inv; u32x2 w = outl[64 * i]; w.x = cvt_pk_bf16(bflo(w.x) + o[0], bfhi(w.x) + o[1]); w.y = cvt_pk_bf16(bflo(w.y) + o[2], bfhi(w.y) + o[3]); outl[64 * i] = w; } }
    bf16_t* op = nsaout + (size_t)tc * NOLD + head * 128 + 4 * kq;
#pragma unroll
    for (int db = 0; db < 8; ++db) *(u32x2*)(op + 16 * db) = outl[64 * db];
}


#define XB_TMO      128
#define XB_XCNT(j)  (256  + 64 * (j))
#define XB_XSUB(j)  (1280 + 64 * (j))
#define XB_XGEN(j)  (2304 + 64 * (j))
#define XB_TOP      3328
#define XB_TOPGEN   3392
#define XCD_BAR_WORDS 3456
#define XB_SPIN_CAP (1u << 18)
__device__ __forceinline__ unsigned xb_ld(unsigned* p)              { return __hip_atomic_load(p, __ATOMIC_RELAXED, __HIP_MEMORY_SCOPE_AGENT); }
__device__ __forceinline__ unsigned xb_add(unsigned* p, unsigned v) { return __hip_atomic_fetch_add(p, v, __ATOMIC_RELAXED, __HIP_MEMORY_SCOPE_AGENT); }
__device__ __forceinline__ unsigned xb_xcc_id() { return (unsigned)__builtin_amdgcn_s_getreg((3 << 11) | 20) & 0xFu; }
#define XB_SPIN(cond, bar) do { unsigned _sp = 0; while (cond) { __builtin_amdgcn_s_sleep(1); \
    if ((++_sp & 255u) == 0u) { if (xb_ld(&(bar)[XB_TMO])) break; if (_sp > XB_SPIN_CAP) { atomicAdd(&(bar)[XB_TMO], 1u); break; } } } } while (0)
struct XcdBarrier { unsigned* bar; unsigned x; volatile LAS unsigned* st; };
__device__ __forceinline__ XcdBarrier xcd_barrier_post(unsigned* bar, volatile LAS unsigned* st) {
    XcdBarrier b; b.bar = bar; b.x = xb_xcc_id(); b.st = st;
    if (threadIdx.x == 0) st[2] = xb_add(&bar[XB_XCNT(b.x)], 1u);
    return b;
}
__device__ __forceinline__ void xcd_barrier_complete(unsigned* bar, unsigned x, unsigned& nloc, unsigned& nx) {
    const unsigned G = gridDim.x * gridDim.y * gridDim.z;
    unsigned sum, cnt, mine, sp = 0u;
    for (;;) {
        sum = 0u; cnt = 0u; mine = 0u;
#pragma unroll
        for (unsigned j = 0; j < 16; ++j) { const unsigned c = xb_ld(&bar[XB_XCNT(j)]); sum += c; cnt += (c > 0u) ? 1u : 0u; mine = (j == x) ? c : mine; }
        if (sum == G) break;
        __builtin_amdgcn_s_sleep(1);
        if ((++sp & 255u) == 0u) { if (xb_ld(&bar[XB_TMO])) break; if (sp > XB_SPIN_CAP) { atomicAdd(&bar[XB_TMO], 1u); break; } }
    }
    nloc = mine > 0u ? mine : 1u; nx = cnt > 0u ? cnt : 1u;
}
__device__ __forceinline__ void xcd_barrier(const XcdBarrier& b, const int tid) {
    asm volatile("s_waitcnt vmcnt(0)" ::: "memory");
    __syncthreads();
    if (tid == 0) {
        unsigned* bar = b.bar;
        __builtin_amdgcn_s_waitcnt(0);
        unsigned nloc = b.st[0], nx = b.st[1];
        if (nloc == 0u) { xcd_barrier_complete(bar, b.x, nloc, nx); b.st[0] = nloc; b.st[1] = nx; }
        const unsigned old = xb_add(&bar[XB_XSUB(b.x)], 1u);
        const unsigned gen = old / nloc;
        if (old + 1u == (gen + 1u) * nloc) {
            __builtin_amdgcn_fence(__ATOMIC_RELEASE, "agent");
            asm volatile("s_waitcnt vmcnt(0)" ::: "memory");
            const unsigned og = xb_add(&bar[XB_TOP], 1u);
            const unsigned tg = og / nx;
            if (og + 1u == (tg + 1u) * nx) xb_add(&bar[XB_TOPGEN], 1u);
            else XB_SPIN(xb_ld(&bar[XB_TOPGEN]) == tg, bar);
            __builtin_amdgcn_fence(__ATOMIC_ACQUIRE, "agent");
            xb_add(&bar[XB_XGEN(b.x)], 1u);
            asm volatile("s_waitcnt vmcnt(0)" ::: "memory");
        } else {
            XB_SPIN(xb_ld(&bar[XB_XGEN(b.x)]) == gen, bar);
            __builtin_amdgcn_fence(__ATOMIC_ACQUIRE, "agent");
            asm volatile("s_waitcnt vmcnt(0)" ::: "memory");
        }
    }
    __syncthreads();
}

__device__ __forceinline__ void gate_tile(int tile, const bf16_t* __restrict__ hb, const bf16_t* __restrict__ wgf, bf16_t* __restrict__ gn, int lane) {
    const int l16 = lane & 15, kq = lane >> 4;
    const bf16_t* ap = hb + (size_t)(16 * tile + l16) * DM + 8 * kq; const bf16_t* bp = wgf + (size_t)lane * 8;
    f32x4 acc[2] = {(f32x4){0.f, 0.f, 0.f, 0.f}, (f32x4){0.f, 0.f, 0.f, 0.f}};
#pragma unroll 8
    for (int s2 = 0; s2 < 64; ++s2) {
        const bf16x8 af = *(const bf16x8*)(ap + 32 * s2);
        const bf16x8 b0 = *(const bf16x8*)(bp + (size_t)s2 * 512), b1 = *(const bf16x8*)(bp + (size_t)(64 + s2) * 512);
        acc[0] = __builtin_amdgcn_mfma_f32_16x16x32_bf16(af, b0, acc[0], 0, 0, 0); acc[1] = __builtin_amdgcn_mfma_f32_16x16x32_bf16(af, b1, acc[1], 0, 0, 0);
    }
#pragma unroll
    for (int ct = 0; ct < 2; ++ct)
#pragma unroll
        for (int r = 0; r < 4; ++r) gn[(size_t)(16 * tile + 4 * kq + r) * 32 + 16 * ct + l16] = (bf16_t)(cvt_pk_bf16(fsigmoid(acc[ct][r]), 0.f) & 0xffffu);
}

struct Params { const float* in[23]; float* out; unsigned char* ws; float inv_freq[64]; };

__global__ void __launch_bounds__(512, 2) fwd_megakernel(Params P) {
    extern __shared__ __attribute__((aligned(16))) unsigned char lds_raw[];
    LAS unsigned char* lds = (LAS unsigned char*)lds_raw;
    cg::grid_group grid = cg::this_grid();
    const int wave_s = __builtin_amdgcn_readfirstlane(threadIdx.x >> 6);
#define PHASE_WS unsigned long long wsv_ = (unsigned long long)P.ws; asm volatile("" : "+s"(wsv_)); unsigned char* ws = (unsigned char*)(__attribute__((address_space(1))) unsigned char*)wsv_; unsigned z_ = 0u; asm volatile("" : "+v"(z_)); const int tid = wave_s * 64 + (int)__builtin_amdgcn_mbcnt_hi(~0u, __builtin_amdgcn_mbcnt_lo(~0u, z_)); \
    const int lane = tid & 63, wave = __builtin_amdgcn_readfirstlane(tid >> 6), G = gridDim.x, gw = blockIdx.x * 8 + wave, ngw = G * 8; \
    const size_t gtid = (size_t)blockIdx.x * 512 + tid, gthreads = (size_t)G * 512; \
    LAS unsigned char* wl = lds + wave * WAVE_LDS; LAS float* scr = (LAS float*)wl; (void)lane; (void)gw; (void)ngw; (void)gtid; (void)gthreads; (void)wl; (void)scr
#define WAB ((bf16_t*)(ws + WS_WAB))
#define WO ((bf16_t*)(ws + WS_WO))
#define CW1K ((bf16_t*)(ws + WS_CW1K))
#define CW1V ((bf16_t*)(ws + WS_CW1V))
#define CW2K ((bf16_t*)(ws + WS_CW2K))
#define CW2V ((bf16_t*)(ws + WS_CW2V))
#define CBIAS ((float*)(ws + WS_CBIAS))
#define KC ((bf16_t*)(ws + WS_KC))
#define VC ((bf16_t*)(ws + WS_VC))
#define GN ((bf16_t*)(ws + WS_GN))
#define WGF ((bf16_t*)(ws + WS_WGF))
#define W8 ((unsigned char*)(ws + WS_WIN) + (size_t)7168 * DM * 2)
#define H8 ((unsigned char*)(ws + WS_BIG) + ((size_t)144 << 20))
#define ST1 ((float*)(ws + WS_ST1))
#define ST2 ((float*)(ws + WS_ST2))
#define HF ((float*)(ws + WS_HF))
#define HB ((bf16_t*)(ws + WS_HB))
#define GU ((bf16_t*)(ws + WS_GU))
#define DN ((bf16_t*)(ws + WS_DN))
#define ACT ((bf16_t*)(ws + WS_ACT))
#define PROJ ((bf16_t*)(ws + WS_PROJ))
#define KSLF ((bf16_t*)(ws + WS_KSLF))
#define KBF ((bf16_t*)(ws + WS_KBF))
#define VBF ((bf16_t*)(ws + WS_VBF))
#define VSLF ((bf16_t*)(ws + WS_VSLF))
#define KWNF ((bf16_t*)(ws + WS_KWNF))
#define VWNF ((bf16_t*)(ws + WS_VWNF))
#define RCOS ((float*)(ws + WS_ROPE))
#define RSIN ((float*)(ws + WS_ROPE) + (size_t)S * 64)
#define WINT ((bf16_t*)(ws + WS_WIN))
#define NSAOUT ((bf16_t*)(ws + WS_NSAOUT))
#define SIGG ((bf16_t*)P.out)
    pg8::StaticOrder SO;
#define CG_SYNC() do { asm volatile("s_waitcnt vmcnt(0) lgkmcnt(0)" ::: "memory"); grid.sync(); \
        if (__builtin_amdgcn_readfirstlane(threadIdx.x >> 6) == 0) { __builtin_amdgcn_fence(__ATOMIC_ACQUIRE, "agent"); asm volatile("s_waitcnt vmcnt(0)" ::: "memory"); } \
        __syncthreads(); } while (0)
    volatile LAS unsigned* xst = (volatile LAS unsigned*)(lds + 8 * WAVE_LDS);
    if (threadIdx.x < 2) xst[threadIdx.x] = 0u;
    __syncthreads();
    const XcdBarrier xbar = xcd_barrier_post((unsigned*)P.ws, xst);
    __syncthreads();
    const int vbid = (int)(xst[2] * 8u + xbar.x);
#define GRID_SYNC() do { asm volatile("s_waitcnt vmcnt(0) lgkmcnt(0)" ::: "memory"); unsigned zz_ = 0u; asm volatile("" : "+v"(zz_)); \
        xcd_barrier(xbar, wave_s * 64 + (int)__builtin_amdgcn_mbcnt_hi(~0u, __builtin_amdgcn_mbcnt_lo(~0u, zz_))); } while (0)

    { PHASE_WS;
        conv_ffn(P.in[1], P.in[2], P.in[3], GU, DN, scr, gw, ngw, lane);
        { const float* win = P.in[6]; bf16_t* wint = WINT;
          tr_stream(32 * 352, gw, ngw, [&](int it) { const int kb = it / 352, nb = it % 352, dr = nb * 32; const int sc = win_src_col(dr);
              if (dr < 7168) return TrP{win, WIN_SRC, kb * 64, sc, 32, wint, DM, dr, kb * 64, 0};
              return TrP{win, WIN_SRC, kb * 64, sc, 32, (bf16_t*)W8, DM, dr - 7168, kb * 64, 1}; }, scr, lane);
          for (int it = gw; it < 32; it += ngw) tr_item<true>(win, WIN_SRC, it * 64, 2560, 24, WGF, DM, 0, it * 64, scr, lane); }
        for (int it = gw; it < 16 * 64; it += ngw) { const int kb = it / 64, nb = it % 64; tr_item(P.in[13], DM, kb * 64, nb * 32, 32, WAB, 1024, nb * 32, kb * 64, scr, lane); }
        for (int it = gw; it < 8 * 64; it += ngw) { const int kb = it / 64, nb = it % 64; tr_item(P.in[14], DM, kb * 64, nb * 32, 32, WAB + (size_t)DM * 1024, 512, nb * 32, kb * 64, scr, lane); }
        for (int it = gw; it < 32 * 64; it += ngw) { const int kb = it / 64, nb = it % 64; tr_item(P.in[15], DM, kb * 64, nb * 32, 32, WO, DM, nb * 32, kb * 64, scr, lane); }
        for (int it = gw; it < 2 * 64 * 8; it += ngw) { const int w = it / 512, r = it % 512, kb = r / 8, nb = r % 8; tr_item<true>(w ? P.in[11] : P.in[8], 256, kb * 64, nb * 32, 32, w ? CW1V : CW1K, 4096, nb * 32, kb * 64, scr, lane); }
        for (int it = gw; it < 2 * 4 * 4; it += ngw) { const int w = it / 16, r = it % 16, kb = r / 4, nb = r % 4; tr_item(w ? P.in[12] : P.in[9], 128, kb * 64, nb * 32, 32, w ? CW2V : CW2K, 256, nb * 32, kb * 64, scr, lane); }
        { const float* x = P.in[0];
            for (size_t i = gtid; i < (size_t)S * DM / 8; i += gthreads) { const f32x4 a = *(const f32x4*)(x + 8 * i), b = *(const f32x4*)(x + 8 * i + 4); *(u32x4*)(HB + 8 * i) = pack8(a, b); } }
        for (int o = gw; o < 512; o += ngw) { const int w = o >> 8, c = o & 255; const float* pos = w ? P.in[10] : P.in[7]; const float* w1 = w ? P.in[11] : P.in[8];
            float s = 0.f; for (int kk = lane; kk < 4096; kk += 64) s += pos[kk] * w1[(size_t)kk * 256 + c];
            s = wave_sum(s); if (lane == 0) CBIAS[o] = s; }
    }
    CG_SYNC();
    { PHASE_WS; pg8::Gemm g{HB, GU, S, NGU, DM, DM, DM}; SO.init(S, NGU, G, (int)blockIdx.x); EpiSwiglu E{ACT}; pg8::gemm_phase(lds, g, SO, E, tid); }
    GRID_SYNC();
    { PHASE_WS; pg8::Gemm g{ACT, DN, S, DM, FF, FF, FF}; SO.init(S, DM, G, (int)blockIdx.x); EpiResF32 E{P.in[0], HF, ALPHA, 0.5f}; pg8::gemm_phase(lds, g, SO, E, tid); }
    GRID_SYNC();
    { PHASE_WS;
        ln_rows(HF, nullptr, HB, P.in[4], P.in[5], gw, ngw, lane, ST1, H8);
        for (size_t i = gtid; i < (size_t)S * 64; i += gthreads) { const int t = (int)(i >> 6), j = (int)(i & 63); const float ang = (float)t * P.inv_freq[j]; RCOS[i] = cosf(ang); RSIN[i] = sinf(ang); }
    }
    GRID_SYNC();
    { PHASE_WS; pg8::Gemm g{HB, WINT, S, 7168, DM, DM, DM}; SO.init(S, 7168, G, (int)blockIdx.x); EpiWin E{PROJ, SIGG, GN, RCOS, KSLF, KBF, 0}; pg8::gemm_phase(lds, g, SO, E, tid); }
    { PHASE_WS; pg8::Gemm g{(const bf16_t*)H8, (const bf16_t*)W8, S, 4096, DM / 2, DM / 2, DM / 2}; SO.init(S, 4096, G, (int)blockIdx.x); EpiSig E{SIGG};
      pg8::gemm_phase<EpiSig, true>(lds, g, SO, E, tid); }
    GRID_SYNC();
    { PHASE_WS;
      int vb = (int)blockIdx.x;
      { bool ok = true; unsigned* cen = (unsigned*)P.ws;
#pragma unroll
        for (int j = 0; j < 8; ++j) ok &= (xb_ld(&cen[XB_XCNT(j)]) * 8u == (unsigned)G);
        if (ok) vb = vbid; }
        for (int t = gw; t < S / 16; t += ngw) gate_tile(t, HB, WGF, GN, lane);
        for (int u = blockIdx.x; u < 256; u += G) { const int kv = u >> 7; compress_unit(u, PROJ, kv ? CW1V : CW1K, kv ? CW2V : CW2K, CBIAS + 256 * kv, kv ? VC : KC, lds, wave, lane); }
        if ((G & 7) == 0) {
            const int x = vb & 7, lw = (vb >> 3) * 8 + wave, nlw = (G >> 3) * 8;
            for (int j = lw; j < 512; j += nlw) dilated_unit(64 * (x + 8 * (j >> 6)) + (j & 63), PROJ, KBF, NSAOUT, lane);
        } else { for (int u = gw; u < 4096; u += ngw) dilated_unit(u, PROJ, KBF, NSAOUT, lane); }
    }
    GRID_SYNC();
    { PHASE_WS;
      int vb = (int)blockIdx.x;
      { bool ok = true; unsigned* cen = (unsigned*)P.ws;
#pragma unroll
        for (int j = 0; j < 8; ++j) ok &= (xb_ld(&cen[XB_XCNT(j)]) * 8u == (unsigned)G);
        if (ok) vb = vbid; }
      if ((G & 7) == 0) {
          const int bx = vb, x = bx & 7, g = x & 1, wj = ((bx >> 3) * 4 + (x >> 1)) * 8 + wave, nwj = (G >> 1) * 8;
          for (int tb = wj; tb < 4096; tb += nwj) nsa_unit(2 * tb + g, PROJ, KC, VC, GN, RCOS, RSIN, KSLF, VSLF, KWNF, VWNF, NSAOUT, wl, lane);
      } else { for (int u = gw; u < 8192; u += ngw) nsa_unit(u, PROJ, KC, VC, GN, RCOS, RSIN, KSLF, VSLF, KWNF, VWNF, NSAOUT, wl, lane); } }
    GRID_SYNC();
    { PHASE_WS; SO.init(S, DM, G, (int)blockIdx.x);
      { pg8::Gemm g{NSAOUT, WAB, S, DM, 1024, NOLD, 1024}; EpiGate<true> E{SIGG, HB}; pg8::gemm_phase(lds, g, SO, E, tid); }
      { pg8::Gemm g{NSAOUT + 1024, WAB + (size_t)DM * 1024, S, DM, 512, NOLD, 512}; EpiGate<false> E{SIGG + 2048, HB}; pg8::gemm_phase(lds, g, SO, E, tid); } }
    GRID_SYNC();
    { PHASE_WS; pg8::Gemm g{HB, WO, S, DM, DM, DM, DM}; SO.init(S, DM, G, (int)blockIdx.x); EpiResLnF32 E{HF, ST1, P.in[4], P.in[5], HF, ALPHA, 1.0f}; pg8::gemm_phase(lds, g, SO, E, tid); }
    GRID_SYNC();
    { PHASE_WS;
        ln_rows(HF, nullptr, HB, P.in[16], P.in[17], gw, ngw, lane, ST2);
        conv_ffn(P.in[18], P.in[19], P.in[20], GU, DN, scr, gw, ngw, lane);
    }
    GRID_SYNC();
    { PHASE_WS; pg8::Gemm g{HB, GU, S, NGU, DM, DM, DM}; SO.init(S, NGU, G, (int)blockIdx.x); EpiSwiglu E{ACT}; pg8::gemm_phase(lds, g, SO, E, tid); }
    GRID_SYNC();
    { PHASE_WS; pg8::Gemm g{ACT, DN, S, DM, FF, FF, FF}; SO.init(S, DM, G, (int)blockIdx.x); EpiResLnF32 E{HF, ST2, P.in[16], P.in[17], P.out, ALPHA, 0.5f}; pg8::gemm_phase(lds, g, SO, E, tid); }
    GRID_SYNC();
    { PHASE_WS; (void)ws; ln_rows(P.out, P.out, nullptr, P.in[21], P.in[22], gw, ngw, lane); }
}

extern "C" void kernel_launch(void* const* d_in, const int* in_sizes, int n_in, void* d_out, int out_size, void* d_ws, size_t ws_size, hipStream_t stream) {
    static int grid = 0;
    if (grid == 0) {
        if (n_in != 23 || out_size != S * DM || ws_size < WS_END) { fprintf(stderr, "kernel_launch: unexpected shapes (n_in %d out %d ws %zu, need %zu)\n", n_in, out_size, ws_size, (size_t)WS_END); grid = -1; return; }
        int dev = 0, cus = 0, per_cu = 0;
        hipGetDevice(&dev); hipDeviceGetAttribute(&cus, hipDeviceAttributeMultiprocessorCount, dev);
        if (hipFuncSetAttribute((const void*)fwd_megakernel, hipFuncAttributeMaxDynamicSharedMemorySize, LDS_BYTES) != hipSuccess) { fprintf(stderr, "kernel_launch: hipFuncSetAttribute failed\n"); grid = -1; return; }
        if (hipOccupancyMaxActiveBlocksPerMultiprocessor(&per_cu, (const void*)fwd_megakernel, 512, LDS_BYTES) != hipSuccess || per_cu < 1) { fprintf(stderr, "kernel_launch: occupancy query failed (%d)\n", per_cu); (void)hipGetLastError(); per_cu = 1; }
        grid = cus * per_cu;
    }
    if (grid < 0) return;
    if (hipMemsetAsync(d_ws, 0, 16384, stream) != hipSuccess) { fprintf(stderr, "kernel_launch: memset of the barrier words failed\n"); return; }
    Params p{};
    for (int i = 0; i < 23; ++i) p.in[i] = (const float*)d_in[i];
    p.out = (float*)d_out; p.ws = (unsigned char*)d_ws;
    for (int i = 0; i < 64; ++i) p.inv_freq[i] = (float)pow(10000.0, -(double)i / 64.0);
    void* args[] = {&p};
    hipError_t e = hipLaunchCooperativeKernel((const void*)fwd_megakernel, dim3(grid), dim3(512), args, LDS_BYTES, stream);
    if (e != hipSuccess) fprintf(stderr, "kernel_launch: cooperative launch failed: %s (grid %d)\n", hipGetErrorString(e), grid);
}
```

```cpp
#include <hip/hip_runtime.h>
#include <hip/hip_cooperative_groups.h>
#include <cstdio>
#include <cstdint>
#include <cmath>
namespace cg = cooperative_groups;

#define LAS __attribute__((address_space(3)))
typedef unsigned short bf16_t;
typedef short bf16x8 __attribute__((ext_vector_type(8)));
typedef short s16x4 __attribute__((ext_vector_type(4)));
typedef float f32x4 __attribute__((ext_vector_type(4)));
typedef float f32x2 __attribute__((ext_vector_type(2)));
typedef unsigned u32x4 __attribute__((ext_vector_type(4)));
typedef unsigned u32x2 __attribute__((ext_vector_type(2)));

constexpr int S = 16384, DM = 2048, FF = 5632, NGU = 2 * FF, NWIN = 11520, WIN_SRC = 11288, PLD = 3072, NOLD = 1536;
constexpr float ALPHA = 1.189207115002721f;
constexpr float LN_EPS = 1e-5f;
constexpr float SL2 = 0.08838834764831845f * 1.4426950408889634f;
constexpr int PC_QA = 0, PC_KC = 1024, PC_VC = 1280, PC_QB = 1536;
constexpr size_t MiB = 1u << 20;
constexpr size_t WS_WAB = 1 * MiB, WS_WO = 13 * MiB, WS_CW1K = 21 * MiB, WS_CW1V = 23 * MiB, WS_CW2K = 25 * MiB, WS_CW2V = 25 * MiB + 65536, WS_CBIAS = 25 * MiB + 131072;
constexpr size_t WS_KC = 26 * MiB, WS_VC = 26 * MiB + 524288, WS_GN = 27 * MiB, WS_ST1 = 28 * MiB, WS_ST2 = 28 * MiB + 131072, WS_WGF = 29 * MiB;
constexpr size_t WS_HF = 32 * MiB, WS_HB = 160 * MiB, WS_BIG = 224 * MiB;
constexpr size_t WS_GU = WS_BIG, WS_DN = WS_BIG + 44 * MiB, WS_ACT = WS_BIG + 66 * MiB;
constexpr size_t WS_KBF = WS_BIG + 96 * MiB, WS_VBF = WS_BIG + 144 * MiB;
constexpr size_t WS_PROJ = WS_BIG, WS_KSLF = WS_BIG + 192 * MiB, WS_VSLF = WS_BIG + 200 * MiB, WS_KWNF = WS_BIG + 208 * MiB, WS_VWNF = WS_BIG + 216 * MiB, WS_ROPE = WS_BIG + 224 * MiB;
constexpr size_t WS_WIN = 466 * MiB, WS_NSAOUT = 466 * MiB, WS_END = 514 * MiB;

constexpr int VROW = 288, VBUF_BYTES = 32 * VROW;
constexpr int IMP_LD = 260;
constexpr int OUT_OFF = VBUF_BYTES + 4 * IMP_LD * 4 + 256 + 512;
constexpr int WAVE_LDS = OUT_OFF + 4096;
constexpr int LDS_BYTES = 147456;
static_assert(8 * WAVE_LDS + 32 <= LDS_BYTES && 131072 <= LDS_BYTES, "LDS map");

typedef __bf16 bf16x2_t __attribute__((ext_vector_type(2)));
__device__ __forceinline__ unsigned cvt_pk_bf16(float lo, float hi) { f32x2 v = {lo, hi}; bf16x2_t b = __builtin_convertvector(v, bf16x2_t); return __builtin_bit_cast(unsigned, b); }
__device__ __forceinline__ float bf2f(unsigned short b) { return __uint_as_float(((unsigned)b) << 16); }
__device__ __forceinline__ float bflo(unsigned w) { return __uint_as_float(w << 16); }
__device__ __forceinline__ float bfhi(unsigned w) { return __uint_as_float(w & 0xffff0000u); }
__device__ __forceinline__ float fsigmoid(float x) { return __builtin_amdgcn_rcpf(1.f + __expf(-x)); }
__device__ __forceinline__ float quad_xor1(float v) { return __int_as_float(__builtin_amdgcn_update_dpp(0, __float_as_int(v), 0xB1, 0xF, 0xF, false)); }
__device__ __forceinline__ float quad_xor2(float v) { return __int_as_float(__builtin_amdgcn_update_dpp(0, __float_as_int(v), 0x4E, 0xF, 0xF, false)); }
__device__ __forceinline__ float wave_sum(float v) {
#pragma unroll
    for (int o = 1; o < 64; o <<= 1) v += __shfl_xor(v, o);
    return v;
}
typedef long i64_t;
__device__ __forceinline__ u32x2 pack8_fp8(const f32x4 a, const f32x4 b) {
    unsigned lo = 0u, hi = 0u;
    lo = __builtin_amdgcn_cvt_pk_fp8_f32(a[0], a[1], lo, false); lo = __builtin_amdgcn_cvt_pk_fp8_f32(a[2], a[3], lo, true);
    hi = __builtin_amdgcn_cvt_pk_fp8_f32(b[0], b[1], hi, false); hi = __builtin_amdgcn_cvt_pk_fp8_f32(b[2], b[3], hi, true);
    return (u32x2){lo, hi};
}
__device__ __forceinline__ u32x4 pack8(const f32x4 a, const f32x4 b) { u32x4 w; w.x = cvt_pk_bf16(a[0], a[1]); w.y = cvt_pk_bf16(a[2], a[3]); w.z = cvt_pk_bf16(b[0], b[1]); w.w = cvt_pk_bf16(b[2], b[3]); return w; }

namespace pg8 {
constexpr int BM = 256, BK = 64, HALF = 128, HTB = HALF * BK * 2, STAGE_BYTES = 8 * HTB, NXCD = 8, WGM = 8;
__host__ __device__ __forceinline__ int lds_byte(int r, int c) { const int st = (r >> 4) * 2 + (c >> 5), rr = r & 15, cc = c & 31, ob = rr * 64 + cc * 2; return st * 1024 + (ob ^ (((ob >> 9) & 1) << 5)); }
__host__ __device__ __forceinline__ void stage_rc(int b, int& R, int& C) { const int st = b / 1024, sb = b % 1024, swz = sb ^ (((sb >> 9) & 1) << 5); R = (st >> 1) * 16 + swz / 64; C = (st & 1) * 32 + (swz % 64) / 2; }
__host__ __device__ __forceinline__ int perm32(int rho) { const int n = rho >> 4, i = rho & 15; return 8 * (i >> 2) + 4 * n + (i & 3); }
struct Unit { int pm, pn; };
struct Gemm { const bf16_t* A; const bf16_t* Bt; int M, N, K, lda, ldb; };
struct StaticOrder {
    int nM, nN, nwg, G, c;
    __device__ void init(int M, int N, int G_, int c_) { nM = M / BM; nN = N / BM; nwg = nM * nN; G = G_; c = c_; }
    __device__ bool next(int i, Unit& u) const {
        const long L = (long)i * G + c; if (L >= nwg) return false;
        int wgid = (int)L; { const int q = nwg / NXCD, r = nwg % NXCD, xcd = wgid % NXCD, off = wgid / NXCD; wgid = (xcd < r ? xcd * (q + 1) : r * (q + 1) + (xcd - r) * q) + off; }
        const int nig = WGM * nN, gid = wgid / nig, fm = gid * WGM, gsz = (nM - fm) < WGM ? (nM - fm) : WGM;
        u.pm = fm + ((wgid % nig) % gsz); u.pn = (wgid % nig) / gsz; return true;
    }
};
typedef f32x4 Acc[2][2][4][2];

template <class Epi, bool FP8 = false>
__device__ __forceinline__ void gemm_phase(LAS unsigned char* lds, const Gemm g, const StaticOrder& S_, const Epi& E, const int tid) {
    const int wid = __builtin_amdgcn_readfirstlane(tid >> 6), lane = tid & 63, wr = wid >> 2, wc = wid & 3, fr = lane & 15, fq = lane >> 4;
    const int K = g.K, nt = K / BK;
    unsigned voffA[2], voffB[2];
#pragma unroll
    for (int i = 0; i < 2; ++i) { int R, C; stage_rc(tid * 16 + i * 8192, R, C); const int Rb = Epi::PERM ? ((R & ~31) + perm32(R & 31)) : R;
        voffA[i] = (unsigned)(R * g.lda + C) * 2u; voffB[i] = (unsigned)(Rb * g.ldb + C) * 2u; }
    const size_t kstep = (size_t)(BK * 2);
    const size_t hstepA = (size_t)HALF * g.lda * 2, hstepB = (size_t)HALF * g.ldb * 2;
    const size_t tstepA = 2 * hstepA, tstepB = 2 * hstepB;
    const unsigned ldsw = (unsigned)wid * 1024u;
    const int aoff = lds_byte(wr * 64 + fr, fq * 8), boff = lds_byte(wc * 32 + fr, fq * 8);
#define PG8_SA(b, h) (((b) * 2 + (h)) * HTB)
#define PG8_SB(b, h) ((4 + (b) * 2 + (h)) * HTB)
#define PG8_STAGE(bufoff, gbase, voff) do { _Pragma("unroll") for (int _i = 0; _i < 2; ++_i) \
        __builtin_amdgcn_global_load_lds((const unsigned*)((const char*)(gbase) + (voff)[_i]), (LAS unsigned*)(lds + (bufoff) + ldsw + _i * 8192), 16, 0, 0); } while (0)
#define PG8_LDA(dst, b, h) do { _Pragma("unroll") for (int m = 0; m < 4; ++m) _Pragma("unroll") for (int k = 0; k < 2; ++k) dst[m][k] = *(const LAS bf16x8*)(lds + PG8_SA(b, h) + aoff + m * 2048 + k * 1024); } while (0)
#define PG8_LDB(dst, b, h) do { _Pragma("unroll") for (int n = 0; n < 2; ++n) _Pragma("unroll") for (int k = 0; k < 2; ++k) dst[n][k] = *(const LAS bf16x8*)(lds + PG8_SB(b, h) + boff + n * 2048 + k * 1024); } while (0)
#define PG8_MMA(ai, bj, At, Bt) do { __builtin_amdgcn_s_setprio(1); _Pragma("unroll") for (int m = 0; m < 4; ++m) _Pragma("unroll") for (int n = 0; n < 2; ++n) _Pragma("unroll") for (int k = 0; k < 2; ++k) \
        { if (FP8) { typedef long i64v2 __attribute__((ext_vector_type(2))); const i64v2 b2 = __builtin_bit_cast(i64v2, Bt[n][k]), a2 = __builtin_bit_cast(i64v2, At[m][k]); \
            acc[ai][bj][m][n] = __builtin_amdgcn_mfma_f32_16x16x32_fp8_fp8(b2[0], a2[0], acc[ai][bj][m][n], 0, 0, 0); acc[ai][bj][m][n] = __builtin_amdgcn_mfma_f32_16x16x32_fp8_fp8(b2[1], a2[1], acc[ai][bj][m][n], 0, 0, 0); } \
          else acc[ai][bj][m][n] = __builtin_amdgcn_mfma_f32_16x16x32_bf16(Bt[n][k], At[m][k], acc[ai][bj][m][n], 0, 0, 0); } __builtin_amdgcn_s_setprio(0); } while (0)
#define PG8_WAIT_V(n) asm volatile("s_waitcnt vmcnt(" #n ")" ::: "memory")
#define PG8_WAIT_L(n) asm volatile("s_waitcnt lgkmcnt(" #n ")" ::: "memory")
#define PG8_BAR __builtin_amdgcn_s_barrier()
#define PG8_SCHED __builtin_amdgcn_sched_barrier(0)
    Unit cur, nxt; int ui = 0;
    if (!S_.next(0, cur)) return;
    Acc acc;
#pragma unroll
    for (int a = 0; a < 2; ++a)
#pragma unroll
        for (int b = 0; b < 2; ++b)
#pragma unroll
            for (int m = 0; m < 4; ++m)
#pragma unroll
                for (int n = 0; n < 2; ++n) acc[a][b][m][n] = (f32x4){0.f, 0.f, 0.f, 0.f};
    bf16x8 At[4][2], B0[2][2], B1[2][2];
    const char* cA = (const char*)g.A + (size_t)cur.pm * tstepA; const char* cB = (const char*)g.Bt + (size_t)cur.pn * tstepB;
    PG8_STAGE(PG8_SB(0, 0), cB, voffB); PG8_STAGE(PG8_SB(0, 1), cB + hstepB, voffB); PG8_STAGE(PG8_SA(0, 0), cA, voffA); PG8_STAGE(PG8_SA(0, 1), cA + hstepA, voffA);
    if (wr == 1) PG8_BAR;
    PG8_WAIT_V(2); PG8_BAR;
    PG8_STAGE(PG8_SB(1, 0), cB + kstep, voffB); PG8_STAGE(PG8_SA(1, 0), cA + kstep, voffA); PG8_STAGE(PG8_SB(1, 1), cB + hstepB + kstep, voffB);
    PG8_WAIT_V(6); PG8_BAR;
    for (;;) {
        const bool has_next = S_.next(ui + 1, nxt);
        const char* nA = has_next ? (const char*)g.A + (size_t)nxt.pm * tstepA : cA; const char* nB = has_next ? (const char*)g.Bt + (size_t)nxt.pn * tstepB : cB;
        for (int t = 0; t < nt; t += 2) {
            const bool last = (t == nt - 2);
            const char* a1 = cA + (size_t)(t + 1) * kstep;
            const char* a2 = last ? nA : cA + (size_t)(t + 2) * kstep; const char* b2 = last ? nB : cB + (size_t)(t + 2) * kstep;
            const char* a3 = a2 + kstep; const char* b3 = b2 + kstep;
            PG8_LDB(B0, 0, 0); PG8_LDB(B1, 0, 1); PG8_SCHED; PG8_LDA(At, 0, 0); PG8_STAGE(PG8_SA(1, 1), a1 + hstepA, voffA);
            PG8_WAIT_V(8); PG8_WAIT_L(0); PG8_BAR; PG8_MMA(0, 0, At, B0); PG8_MMA(0, 1, At, B1); PG8_BAR; PG8_SCHED;
            PG8_LDA(At, 0, 1); PG8_STAGE(PG8_SB(0, 0), b2, voffB); PG8_STAGE(PG8_SB(0, 1), b2 + hstepB, voffB); PG8_STAGE(PG8_SA(0, 0), a2, voffA);
            PG8_WAIT_V(8); PG8_WAIT_L(0); PG8_BAR; PG8_MMA(1, 0, At, B0); PG8_MMA(1, 1, At, B1); PG8_BAR; PG8_SCHED;
            PG8_LDB(B0, 1, 0); PG8_LDB(B1, 1, 1); PG8_SCHED; PG8_LDA(At, 1, 0); PG8_STAGE(PG8_SA(0, 1), a2 + hstepA, voffA);
            PG8_WAIT_V(8); PG8_WAIT_L(0); PG8_BAR; PG8_MMA(0, 0, At, B0); PG8_MMA(0, 1, At, B1); PG8_BAR; PG8_SCHED;
            PG8_LDA(At, 1, 1); PG8_STAGE(PG8_SB(1, 0), b3, voffB); PG8_STAGE(PG8_SB(1, 1), b3 + hstepB, voffB); PG8_STAGE(PG8_SA(1, 0), a3, voffA);
            PG8_WAIT_V(8); PG8_WAIT_L(0); PG8_BAR; PG8_MMA(1, 0, At, B0); PG8_MMA(1, 1, At, B1); PG8_BAR; PG8_SCHED;
        }
        if (wr == 0) PG8_BAR;
        E(acc, cur, wr, wc, fr, fq);
        if (!has_next) break;
#pragma unroll
        for (int a = 0; a < 2; ++a)
#pragma unroll
            for (int b = 0; b < 2; ++b)
#pragma unroll
                for (int m = 0; m < 4; ++m)
#pragma unroll
                    for (int n = 0; n < 2; ++n) acc[a][b][m][n] = (f32x4){0.f, 0.f, 0.f, 0.f};
        cur = nxt; cA = nA; cB = nB; ++ui;
        if (wr == 1) PG8_BAR;
    }
    PG8_WAIT_V(0);
    PG8_BAR;
#undef PG8_SA
#undef PG8_SB
#undef PG8_STAGE
#undef PG8_LDA
#undef PG8_LDB
#undef PG8_MMA
#undef PG8_WAIT_V
#undef PG8_WAIT_L
#undef PG8_BAR
#undef PG8_SCHED
}
}

struct EpiSwiglu {
    static constexpr bool PERM = true;
    bf16_t* O;
    __device__ __forceinline__ void operator()(const pg8::Acc& acc, const pg8::Unit& u, int wr, int wc, int fr, int fq) const {
        const int row0 = u.pm * 256 + wr * 64 + fr, col0 = u.pn * 128 + wc * 32 + 8 * fq;
#pragma unroll
        for (int ai = 0; ai < 2; ++ai)
#pragma unroll
            for (int m = 0; m < 4; ++m) {
                f32x4 v[2];
#pragma unroll
                for (int n = 0; n < 2; ++n)
#pragma unroll
                    for (int e = 0; e < 4; ++e) { const float gt = acc[ai][0][m][n][e], up = acc[ai][1][m][n][e]; v[n][e] = gt * fsigmoid(gt) * up; }
                *(u32x4*)(O + (size_t)(row0 + ai * 128 + m * 16) * FF + col0) = pack8(v[0], v[1]);
            }
    }
};
struct EpiResF32 {
    static constexpr bool PERM = false;
    const float* res; float* out; float a, b;
    __device__ __forceinline__ void operator()(const pg8::Acc& acc, const pg8::Unit& u, int wr, int wc, int fr, int fq) const {
        const int row0 = u.pm * 256 + wr * 64 + fr, col0 = u.pn * 256 + wc * 32 + 4 * fq;
#pragma unroll
        for (int ai = 0; ai < 2; ++ai)
#pragma unroll
            for (int m = 0; m < 4; ++m) {
                const size_t off = (size_t)(row0 + ai * 128 + m * 16) * DM + col0;
#pragma unroll
                for (int bj = 0; bj < 2; ++bj)
#pragma unroll
                    for (int n = 0; n < 2; ++n) { const f32x4 r = *(const f32x4*)(res + off + bj * 128 + n * 16); *(f32x4*)(out + off + bj * 128 + n * 16) = r * a + acc[ai][bj][m][n] * b; }
            }
    }
};
struct EpiResLnF32 {
    static constexpr bool PERM = false;
    const float* pre; const float* stats; const float* g; const float* beta; float* out; float a, b;
    __device__ __forceinline__ void operator()(const pg8::Acc& acc, const pg8::Unit& u, int wr, int wc, int fr, int fq) const {
        const int row0 = u.pm * 256 + wr * 64 + fr, col0 = u.pn * 256 + wc * 32 + 4 * fq;
#pragma unroll
        for (int ai = 0; ai < 2; ++ai)
#pragma unroll
            for (int m = 0; m < 4; ++m) {
                const int row = row0 + ai * 128 + m * 16; const size_t off = (size_t)row * DM + col0;
                const f32x2 st = *(const f32x2*)(stats + 2 * (size_t)row);
#pragma unroll
                for (int bj = 0; bj < 2; ++bj)
#pragma unroll
                    for (int n = 0; n < 2; ++n) { const int co = bj * 128 + n * 16;
                        const f32x4 r = *(const f32x4*)(pre + off + co), gv = *(const f32x4*)(g + col0 + co), bv = *(const f32x4*)(beta + col0 + co);
                        const f32x4 h = (r - st.x) * st.y * gv + bv;
                        *(f32x4*)(out + off + co) = h * a + acc[ai][bj][m][n] * b; }
                if (m & 1) asm volatile("" ::: "memory");
            }
    }
};
struct EpiSig {
    static constexpr bool PERM = true;
    bf16_t* sigg;
    __device__ __forceinline__ void operator()(const pg8::Acc& acc, const pg8::Unit& u, int wr, int wc, int fr, int fq) const {
        const int row0 = u.pm * 256 + wr * 64 + fr, cw = wc * 32 + 8 * fq;
#pragma unroll
        for (int ai = 0; ai < 2; ++ai)
#pragma unroll
            for (int m = 0; m < 4; ++m)
#pragma unroll
                for (int bj = 0; bj < 2; ++bj) {
                    f32x4 v[2];
#pragma unroll
                    for (int n = 0; n < 2; ++n)
#pragma unroll
                        for (int e = 0; e < 4; ++e) v[n][e] = fsigmoid(acc[ai][bj][m][n][e]);
                    *(u32x4*)(sigg + (size_t)(row0 + ai * 128 + m * 16) * 4096 + u.pn * 256 + bj * 128 + cw) = pack8(v[0], v[1]);
                }
    }
};
struct EpiWin {
    static constexpr bool PERM = true;
    bf16_t* proj; bf16_t* sigg; bf16_t* gn; const float* cs; bf16_t* kslf; bf16_t* kbf; int tile_off;
    __device__ __forceinline__ void operator()(const pg8::Acc& acc, const pg8::Unit& u, int wr, int wc, int fr, int fq) const {
        const int tile = u.pn + tile_off, row0 = u.pm * 256 + wr * 64 + fr, cw = wc * 32 + 8 * fq;
        if (tile < 28) {
            const bool rope = (tile == 6) | (tile == 8) | (tile >= 10 && tile < 22);
            const int dcol = (tile < 6 ? tile : tile - 4) * 256;
            if (!rope) {
                if (tile == 7 || tile == 9) {
                    unsigned char* VF = (unsigned char*)kslf + (tile == 7 ? (size_t)8 << 20 : (size_t)24 << 20);
#pragma unroll
                    for (int ai = 0; ai < 2; ++ai)
#pragma unroll
                        for (int m = 0; m < 4; ++m) {
                            const int row = row0 + ai * 128 + m * 16, kp = row & 31;
                            const size_t rbase = (size_t)(row >> 5) * 4096 + (size_t)(((kp >> 2) & 3) * 16) * 8 + 4 * (kp >> 4) + (kp & 3);
#pragma unroll
                            for (int bj = 0; bj < 2; ++bj) {
                                const u32x2 w = pack8_fp8(acc[ai][bj][m][0], acc[ai][bj][m][1]);
                                unsigned char* vb = VF + (size_t)bj * 512 * 4096 + rbase + (size_t)(cw >> 4) * 512 + (size_t)(cw & 15) * 8;
                                vb[0] = (unsigned char)(w.x & 0xffu); vb[8] = (unsigned char)((w.x >> 8) & 0xffu); vb[16] = (unsigned char)((w.x >> 16) & 0xffu); vb[24] = (unsigned char)(w.x >> 24);
                                vb[32] = (unsigned char)(w.y & 0xffu); vb[40] = (unsigned char)((w.y >> 8) & 0xffu); vb[48] = (unsigned char)((w.y >> 16) & 0xffu); vb[56] = (unsigned char)(w.y >> 24);
                            }
                        }
                } else if (tile >= 22) {
                    unsigned char* VB = (unsigned char*)kbf + ((size_t)24 << 20);
#pragma unroll
                    for (int ai = 0; ai < 2; ++ai)
#pragma unroll
                        for (int m = 0; m < 4; ++m) {
                            const int row = row0 + ai * 128 + m * 16;
#pragma unroll
                            for (int bj = 0; bj < 2; ++bj) {
                                const int hd = 2 * (tile - 22) + bj, sh = 2 * (hd >> 2), tp = ((row & ((1 << sh) - 1)) << (14 - sh)) + (row >> sh), kp = tp & 31;
                                const u32x2 w = pack8_fp8(acc[ai][bj][m][0], acc[ai][bj][m][1]);
                                unsigned char* vb = VB + (((size_t)hd * 512 + (tp >> 5)) * 8 + (cw >> 4)) * 512 + (size_t)(((kp >> 2) & 3) * 16 + (cw & 15)) * 8 + 4 * (kp >> 4) + (kp & 3);
                                vb[0] = (unsigned char)(w.x & 0xffu); vb[8] = (unsigned char)((w.x >> 8) & 0xffu); vb[16] = (unsigned char)((w.x >> 16) & 0xffu); vb[24] = (unsigned char)(w.x >> 24);
                                vb[32] = (unsigned char)(w.y & 0xffu); vb[40] = (unsigned char)((w.y >> 8) & 0xffu); vb[48] = (unsigned char)((w.y >> 16) & 0xffu); vb[56] = (unsigned char)(w.y >> 24);
                            }
                        }
                } else {
#pragma unroll
                    for (int ai = 0; ai < 2; ++ai)
#pragma unroll
                        for (int m = 0; m < 4; ++m)
#pragma unroll
                            for (int bj = 0; bj < 2; ++bj)
                                *(u32x4*)(proj + (size_t)(row0 + ai * 128 + m * 16) * PLD + dcol + bj * 128 + cw) = pack8(acc[ai][bj][m][0], acc[ai][bj][m][1]);
                }
            } else {
                const int head = cw >> 6, d = cw & 63;
                const bool frag = (tile == 6) | (tile == 8);
                unsigned char* KF = (unsigned char*)kslf + (tile == 6 ? (size_t)0 : (size_t)16 << 20); const float* sn = cs + (size_t)S * 64;
#pragma unroll
                for (int ai = 0; ai < 2; ++ai)
#pragma unroll
                    for (int m = 0; m < 4; ++m) {
                        const int row = row0 + ai * 128 + m * 16;
                        f32x4 o1[2], o2[2];
#pragma unroll
                        for (int n = 0; n < 2; ++n) {
                            const f32x4 c = *(const f32x4*)(cs + (size_t)row * 64 + d + 4 * n), sv = *(const f32x4*)(sn + (size_t)row * 64 + d + 4 * n);
                            const f32x4 x1 = acc[ai][0][m][n], x2 = acc[ai][1][m][n];
                            o1[n] = x1 * c - x2 * sv; o2[n] = x2 * c + x1 * sv;
                        }
                        if (frag) {
                            unsigned char* kb = KF + ((size_t)head * 1024 + (row >> 4)) * 2048 + (size_t)(d >> 5) * 512 + (size_t)(((d >> 3) & 3) * 16 + (row & 15)) * 8;
                            *(u32x2*)kb = pack8_fp8(o1[0], o1[1]); *(u32x2*)(kb + 1024) = pack8_fp8(o2[0], o2[1]);
                        } else if (tile >= 16) {
                            const int hd = 2 * (tile - 16) + head, sh = 2 * (hd >> 2), tp = ((row & ((1 << sh) - 1)) << (14 - sh)) + (row >> sh);
                            unsigned char* kb = (unsigned char*)kbf + ((size_t)hd * 1024 + (tp >> 4)) * 2048 + (size_t)(d >> 5) * 512 + (size_t)(((d >> 3) & 3) * 16 + (tp & 15)) * 8;
                            *(u32x2*)kb = pack8_fp8(o1[0], o1[1]); *(u32x2*)(kb + 1024) = pack8_fp8(o2[0], o2[1]);
                        } else {
                            bf16_t* p = proj + (size_t)row * PLD + dcol + head * 128 + d;
                            *(u32x4*)p = pack8(o1[0], o1[1]); *(u32x4*)(p + 64) = pack8(o2[0], o2[1]);
                        }
                        if (m & 1) asm volatile("" ::: "memory");
                    }
            }
        } else if (tile < 44) {
#pragma unroll
            for (int ai = 0; ai < 2; ++ai)
#pragma unroll
                for (int m = 0; m < 4; ++m)
#pragma unroll
                    for (int bj = 0; bj < 2; ++bj) {
                        f32x4 v[2];
#pragma unroll
                        for (int n = 0; n < 2; ++n)
#pragma unroll
                            for (int e = 0; e < 4; ++e) v[n][e] = fsigmoid(acc[ai][bj][m][n][e]);
                        *(u32x4*)(sigg + (size_t)(row0 + ai * 128 + m * 16) * 4096 + (tile - 28) * 256 + bj * 128 + cw) = pack8(v[0], v[1]);
                    }
        } else {
            if (wc == 0) {
#pragma unroll
                for (int ai = 0; ai < 2; ++ai)
#pragma unroll
                    for (int m = 0; m < 4; ++m) {
                        f32x4 v[2];
#pragma unroll
                        for (int n = 0; n < 2; ++n)
#pragma unroll
                            for (int e = 0; e < 4; ++e) v[n][e] = fsigmoid(acc[ai][0][m][n][e]);
                        *(u32x4*)(gn + (size_t)(row0 + ai * 128 + m * 16) * 32 + cw) = pack8(v[0], v[1]);
                    }
            }
        }
    }
};
template <bool FIRST> struct EpiGate {
    static constexpr bool PERM = true;
    const bf16_t* sg; bf16_t* O;
    __device__ __forceinline__ void operator()(const pg8::Acc& acc, const pg8::Unit& u, int wr, int wc, int fr, int fq) const {
        const int row0 = u.pm * 256 + wr * 64 + fr, col0 = u.pn * 256 + wc * 32 + 8 * fq;
#pragma unroll
        for (int ai = 0; ai < 2; ++ai)
#pragma unroll
            for (int m = 0; m < 4; ++m)
#pragma unroll
                for (int bj = 0; bj < 2; ++bj) {
                    const int row = row0 + ai * 128 + m * 16, col = col0 + bj * 128;
                    const u32x4 gv = *(const u32x4*)(sg + (size_t)row * 4096 + col);
                    u32x4 pv = (u32x4){0u, 0u, 0u, 0u}; if (!FIRST) pv = *(const u32x4*)(O + (size_t)row * DM + col);
                    f32x4 v[2];
#pragma unroll
                    for (int n = 0; n < 2; ++n) {
                        const unsigned g0 = n ? gv.z : gv.x, g1 = n ? gv.w : gv.y, p0 = n ? pv.z : pv.x, p1 = n ? pv.w : pv.y;
                        const f32x4 y = acc[ai][bj][m][n];
                        v[n][0] = bflo(p0) + bflo(g0) * y[0]; v[n][1] = bfhi(p0) + bfhi(g0) * y[1];
                        v[n][2] = bflo(p1) + bflo(g1) * y[2]; v[n][3] = bfhi(p1) + bfhi(g1) * y[3];
                    }
                    *(u32x4*)(O + (size_t)row * DM + col) = pack8(v[0], v[1]);
                }
    }
};

template <bool FRAG = false>
__device__ __forceinline__ void tr_item(const float* W, int ldw, int k0, int scol0, int nvalid, bf16_t* WT, int ldt, int drow0, int dk0, LAS float* scr, int lane) {
    const int c = lane & 31;
    float v[32];
#pragma unroll
    for (int i = 0; i < 32; ++i) { const int kk = 2 * i + (lane >> 5); v[i] = (c < nvalid) ? W[(size_t)(k0 + kk) * ldw + scol0 + c] : 0.f; }
#pragma unroll
    for (int i = 0; i < 32; ++i) { const int kk = 2 * i + (lane >> 5); scr[kk * 33 + c] = v[i]; }
    asm volatile("s_waitcnt lgkmcnt(0)" ::: "memory");
    const int c8 = lane & 7;
#pragma unroll
    for (int j = 0; j < 4; ++j) { const int n = (lane >> 3) + 8 * j; const LAS float* s = scr + (8 * c8) * 33 + n;
        u32x4 o; o.x = cvt_pk_bf16(s[0 * 33], s[1 * 33]); o.y = cvt_pk_bf16(s[2 * 33], s[3 * 33]); o.z = cvt_pk_bf16(s[4 * 33], s[5 * 33]); o.w = cvt_pk_bf16(s[6 * 33], s[7 * 33]);
        if (FRAG) { const int c = drow0 + n, k = dk0 + 8 * c8; *(u32x4*)(WT + ((size_t)((c >> 4) * (ldt >> 5) + (k >> 5)) * 64 + ((k >> 3) & 3) * 16 + (c & 15)) * 8) = o; }
        else *(u32x4*)(WT + (size_t)(drow0 + n) * ldt + dk0 + 8 * c8) = o; }
    asm volatile("s_waitcnt lgkmcnt(0)" ::: "memory");
}
struct TrP { const float* W; int ldw, k0, scol0, nvalid; bf16_t* WT; int ldt, drow0, dk0; int fp8; };
__device__ __forceinline__ void tr_load(float (&v)[32], const TrP& q, int lane) {
    const int c = lane & 31;
#pragma unroll
    for (int i = 0; i < 32; ++i) { const int kk = 2 * i + (lane >> 5); v[i] = (c < q.nvalid) ? q.W[(size_t)(q.k0 + kk) * q.ldw + q.scol0 + c] : 0.f; }
}
__device__ __forceinline__ void tr_store(const float (&v)[32], const TrP& q, LAS float* scr, int lane) {
    const int c = lane & 31;
#pragma unroll
    for (int i = 0; i < 32; ++i) { const int kk = 2 * i + (lane >> 5); scr[kk * 33 + c] = v[i]; }
    asm volatile("s_waitcnt lgkmcnt(0)" ::: "memory");
    const int c8 = lane & 7;
#pragma unroll
    for (int j = 0; j < 4; ++j) { const int n = (lane >> 3) + 8 * j; const LAS float* s = scr + (8 * c8) * 33 + n;
        if (q.fp8) { const f32x4 a = {s[0 * 33], s[1 * 33], s[2 * 33], s[3 * 33]}, b = {s[4 * 33], s[5 * 33], s[6 * 33], s[7 * 33]};
            *(u32x2*)((unsigned char*)q.WT + (size_t)(q.drow0 + n) * q.ldt + q.dk0 + 8 * c8) = pack8_fp8(a, b); }
        else { u32x4 o; o.x = cvt_pk_bf16(s[0 * 33], s[1 * 33]); o.y = cvt_pk_bf16(s[2 * 33], s[3 * 33]); o.z = cvt_pk_bf16(s[4 * 33], s[5 * 33]); o.w = cvt_pk_bf16(s[6 * 33], s[7 * 33]);
            *(u32x4*)(q.WT + (size_t)(q.drow0 + n) * q.ldt + q.dk0 + 8 * c8) = o; } }
    asm volatile("s_waitcnt lgkmcnt(0)" ::: "memory");
}
template <class F>
__device__ __forceinline__ void tr_stream(int n, int gw, int ngw, const F& params, LAS float* scr, int lane) {
    int it = gw; if (it >= n) return;
    float va[32], vb[32];
    TrP pa = params(it), pb = pa; tr_load(va, pa, lane);
    for (;;) {
        const int it2 = it + ngw; const bool has2 = it2 < n;
        if (has2) { pb = params(it2); tr_load(vb, pb, lane); }
        tr_store(va, pa, scr, lane);
        if (!has2) break;
        const int it3 = it2 + ngw; const bool has3 = it3 < n;
        if (has3) { pa = params(it3); tr_load(va, pa, lane); }
        tr_store(vb, pb, scr, lane);
        if (!has3) break;
        it = it3;
    }
}
__device__ __forceinline__ int win_src_col(int r) {
    if (r >= WIN_SRC) return -1;
    if (r >= 11264) return 2560 + (r - 11264);
    const int tile = r >> 8; int j = r & 255;
    const bool rope = (tile == 6) | (tile == 8) | (tile >= 10 && tile < 22);
    if (rope) { const int q = j >> 6, d = j & 63; j = (q & 1) * 128 + (q >> 1) * 64 + d; }
    const int c = tile * 256 + j;
    return c < 2560 ? c : c + 24;
}
__device__ __forceinline__ void conv_ffn(const float* Wg, const float* Wu, const float* Wd, bf16_t* GU, bf16_t* DN, LAS float* scr, int gw, int ngw, int lane) {
    constexpr int I_G = 32 * 176;
    tr_stream(2 * I_G, gw, ngw, [&](int it) { const int which = it / I_G, r = it % I_G, kb = r / 176, nb = r % 176, c0 = nb * 32;
        return TrP{which ? Wu : Wg, FF, kb * 64, c0, 32, GU, DM, 256 * (c0 >> 7) + (c0 & 127) + which * 128, kb * 64, 0}; }, scr, lane);
    tr_stream(88 * 64, gw, ngw, [&](int it) { const int kb = it / 64, nb = it % 64; return TrP{Wd, DM, kb * 64, nb * 32, 32, DN, FF, nb * 32, kb * 64, 0}; }, scr, lane);
}
__device__ __forceinline__ void ln_rows(const float* in, float* outf, bf16_t* outb, const float* g, const float* b, int gw, int ngw, int lane, float* stats = nullptr, unsigned char* out8 = nullptr) {
    f32x4 gv[8], bv[8];
#pragma unroll
    for (int j = 0; j < 8; ++j) { gv[j] = *(const f32x4*)(g + 4 * (lane + 64 * j)); bv[j] = *(const f32x4*)(b + 4 * (lane + 64 * j)); }
    for (int row = gw; row < S; row += ngw) {
        const float* xr = in + (size_t)row * DM; f32x4 v[8]; float s = 0.f;
#pragma unroll
        for (int j = 0; j < 8; ++j) { v[j] = *(const f32x4*)(xr + 4 * (lane + 64 * j)); s += (v[j][0] + v[j][1]) + (v[j][2] + v[j][3]); }
        const float mean = wave_sum(s) * (1.f / DM); float s2 = 0.f;
#pragma unroll
        for (int j = 0; j < 8; ++j) { v[j] = v[j] - mean; s2 += (v[j][0] * v[j][0] + v[j][1] * v[j][1]) + (v[j][2] * v[j][2] + v[j][3] * v[j][3]); }
        const float rstd = 1.f / sqrtf(wave_sum(s2) * (1.f / DM) + LN_EPS);
        if (stats && lane == 0) *(f32x2*)(stats + 2 * (size_t)row) = (f32x2){mean, rstd};
#pragma unroll
        for (int j = 0; j < 8; ++j) { const f32x4 o = v[j] * rstd * gv[j] + bv[j];
            if (outf) *(f32x4*)(outf + (size_t)row * DM + 4 * (lane + 64 * j)) = o;
            if (outb) { u32x2 w; w.x = cvt_pk_bf16(o[0], o[1]); w.y = cvt_pk_bf16(o[2], o[3]); *(u32x2*)(outb + (size_t)row * DM + 4 * (lane + 64 * j)) = w; }
            if (out8) { unsigned w8 = 0u; w8 = __builtin_amdgcn_cvt_pk_fp8_f32(o[0], o[1], w8, false); w8 = __builtin_amdgcn_cvt_pk_fp8_f32(o[2], o[3], w8, true); *(unsigned*)(out8 + (size_t)row * DM + 4 * (lane + 64 * j)) = w8; } }
    }
}

struct AState { float m, l; f32x4 o[8]; };
__device__ __forceinline__ void astate_init(AState& s) { s.m = -1e30f; s.l = 0.f;
#pragma unroll
    for (int i = 0; i < 8; ++i) s.o[i] = (f32x4){0.f, 0.f, 0.f, 0.f}; }
__device__ __forceinline__ int clampi(int v, int lo, int hi) { return v < lo ? lo : (v > hi ? hi : v); }

__device__ __forceinline__ void load_k(bf16x8 (&kf)[2][4], const bf16_t* __restrict__ Kb, int ld, int pos0, int dpos, int posmax, int l16, int kq) {
#pragma unroll
    for (int T = 0; T < 2; ++T) { const int p = clampi(pos0 + dpos * (16 * T + l16), 0, posmax); const bf16_t* kp = Kb + (size_t)p * ld + 8 * kq;
#pragma unroll
        for (int s = 0; s < 4; ++s) kf[T][s] = *(const bf16x8*)(kp + 32 * s); }
}
__device__ __forceinline__ void load_v(u32x4 (&vr)[8], const bf16_t* __restrict__ Vb, int ld, int pos0, int dpos, int posmax, int l16, int kq) {
#pragma unroll
    for (int i = 0; i < 8; ++i) { const int p = clampi(pos0 + dpos * (4 * i + kq), 0, posmax); vr[i] = *(const u32x4*)(Vb + (size_t)p * ld + 8 * l16); }
}
__device__ __forceinline__ void store_v(const u32x4 (&vr)[8], LAS unsigned char* vbuf, int l16, int kq) {
#pragma unroll
    for (int i = 0; i < 8; ++i) *(LAS u32x4*)(vbuf + (4 * i + kq) * VROW + 16 * l16) = vr[i];
}
template <int MODE, bool SLC, class Desc>
__device__ __forceinline__ void attn_run(const bf16x8 (&qf)[4], const bf16_t* __restrict__ Kb, const bf16_t* __restrict__ Vb, int ld, int dpos, int posmax,
                                         const Desc& desc, int n, int lo_in, int hi, int qi, AState& st, LAS unsigned char* vbuf, int lane, LAS float* imp = nullptr) {
    if (n <= 0) return;
    const int l16 = lane & 15, kq = lane >> 4;
    u32x4 kr[8];
    int dcur = desc(0);
    load_v(kr, Kb, ld, SLC ? (dcur & 0xfffff) : dcur, dpos, posmax, l16, kq);
#pragma unroll 1
    for (int i = 0; i < n; ++i) {
        const int pos0 = SLC ? (dcur & 0xfffff) : dcur;
        const int lo = SLC ? ((((dcur >> 20) == qi) | ((dcur >> 20) == 4)) ? 0 : (1 << 30)) : lo_in;
        store_v(kr, vbuf, l16, kq);
        u32x4 vr[8];
        if (MODE != 1) load_v(vr, Vb, ld, pos0, dpos, posmax, l16, kq);
        bf16x8 kf[2][4];
#pragma unroll
        for (int T = 0; T < 2; ++T)
#pragma unroll
            for (int s = 0; s < 4; ++s) kf[T][s] = *(const LAS bf16x8*)(vbuf + (16 * T + l16) * VROW + 64 * s + 16 * kq);
        f32x4 sa[2] = {(f32x4){0.f, 0.f, 0.f, 0.f}, (f32x4){0.f, 0.f, 0.f, 0.f}};
#pragma unroll
        for (int T = 0; T < 2; ++T)
#pragma unroll
            for (int s = 0; s < 4; ++s) sa[T] = __builtin_amdgcn_mfma_f32_16x16x32_bf16(kf[T][s], qf[s], sa[T], 0, 0, 0);
        const int dnext = desc(i + 1 < n ? i + 1 : i);
        load_v(kr, Kb, ld, SLC ? (dnext & 0xfffff) : dnext, dpos, posmax, l16, kq);
        float sc[8]; bool vd[8]; float mx = -1e30f;
#pragma unroll
        for (int T = 0; T < 2; ++T)
#pragma unroll
            for (int r = 0; r < 4; ++r) { const int p = pos0 + dpos * (16 * T + 4 * kq + r); const bool v = (p >= lo) & (p <= hi); const float x = sa[T][r] * SL2;
                sc[4 * T + r] = x; vd[4 * T + r] = v; mx = v ? fmaxf(mx, x) : mx; }
        float p[8];
        if (MODE == 2) {
#pragma unroll
            for (int j = 0; j < 8; ++j) p[j] = vd[j] ? __builtin_amdgcn_exp2f(sc[j] - st.m) * st.l : 0.f;
#pragma unroll
            for (int T = 0; T < 2; ++T) {
                float x = 2.f * (p[4 * T] + p[4 * T + 1] + p[4 * T + 2]) + p[4 * T + 3], y = p[4 * T + 3];
                x += quad_xor1(x); x += quad_xor2(x); y += quad_xor1(y); y += quad_xor2(y);
                if ((l16 & 3) == 0) { const int a = (pos0 >> 2) + 4 * T + kq; LAS float* ip = imp + (l16 >> 2) * IMP_LD + a;
                    ip[0] += x;
                    asm volatile("s_waitcnt lgkmcnt(0)" ::: "memory");
                    ip[1] += y; }
                asm volatile("s_waitcnt lgkmcnt(0)" ::: "memory");
            }
        } else {
            if (__builtin_amdgcn_ballot_w64(mx > st.m + 40.f) != 0ull) {
                mx = fmaxf(mx, __shfl_xor(mx, 16)); mx = fmaxf(mx, __shfl_xor(mx, 32));
                const float mn = fmaxf(st.m, mx), alpha = __builtin_amdgcn_exp2f(st.m - mn); st.m = mn; st.l *= alpha;
                if (MODE == 0) {
#pragma unroll
                    for (int j = 0; j < 8; ++j) st.o[j] = st.o[j] * alpha;
                }
            }
            float ps = 0.f;
#pragma unroll
            for (int j = 0; j < 8; ++j) { p[j] = vd[j] ? __builtin_amdgcn_exp2f(sc[j] - st.m) : 0.f; ps += p[j]; }
            st.l += ps;
        }
        if (MODE != 1) {
            store_v(vr, vbuf, l16, kq);
            u32x4 pw; pw.x = cvt_pk_bf16(p[0], p[1]); pw.y = cvt_pk_bf16(p[2], p[3]); pw.z = cvt_pk_bf16(p[4], p[5]); pw.w = cvt_pk_bf16(p[6], p[7]);
            const bf16x8 pf = __builtin_bit_cast(bf16x8, pw);
            const unsigned addr = (unsigned)(uintptr_t)(vbuf) + (4 * kq + (l16 >> 2)) * VROW + (l16 & 3) * 8;
#pragma unroll
            for (int hf = 0; hf < 2; ++hf) {
                s16x4 a[8];
                asm volatile("s_waitcnt lgkmcnt(0)\n\t"
                             "ds_read_b64_tr_b16 %0, %8 offset:0\n\t"    "ds_read_b64_tr_b16 %1, %8 offset:32\n\t"
                             "ds_read_b64_tr_b16 %2, %8 offset:64\n\t"   "ds_read_b64_tr_b16 %3, %8 offset:96\n\t"
                             "ds_read_b64_tr_b16 %4, %8 offset:4608\n\t" "ds_read_b64_tr_b16 %5, %8 offset:4640\n\t"
                             "ds_read_b64_tr_b16 %6, %8 offset:4672\n\t" "ds_read_b64_tr_b16 %7, %8 offset:4704\n\t"
                             "s_waitcnt lgkmcnt(0)"
                             : "=&v"(a[0]), "=&v"(a[1]), "=&v"(a[2]), "=&v"(a[3]), "=&v"(a[4]), "=&v"(a[5]), "=&v"(a[6]), "=&v"(a[7])
                             : "v"(addr + 128 * hf) : "memory");
#pragma unroll
                for (int d4 = 0; d4 < 4; ++d4) { const int db = 4 * hf + d4;
                    bf16x8 af; af[0] = a[d4][0]; af[1] = a[d4][1]; af[2] = a[d4][2]; af[3] = a[d4][3]; af[4] = a[d4 + 4][0]; af[5] = a[d4 + 4][1]; af[6] = a[d4 + 4][2]; af[7] = a[d4 + 4][3];
                    st.o[db] = __builtin_amdgcn_mfma_f32_16x16x32_bf16(af, pf, st.o[db], 0, 0, 0); }
            }
        }
        dcur = dnext;
    }
}
struct FragV { bf16x8 v[8]; };
__device__ __forceinline__ void load_fk(bf16x8 (&k)[2][4], const bf16_t* __restrict__ KF, int pos0, int lane) {
    const bf16_t* kp = KF + ((size_t)(pos0 >> 4) * 256 + lane) * 8;
#pragma unroll
    for (int T = 0; T < 2; ++T)
#pragma unroll
        for (int s2 = 0; s2 < 4; ++s2) k[T][s2] = *(const bf16x8*)(kp + (T * 4 + s2) * 512);
}
__device__ __forceinline__ void load_fv(FragV& f, const bf16_t* __restrict__ VF, int pos0, int lane) {
    const bf16_t* vp = VF + ((size_t)(pos0 >> 5) * 512 + lane) * 8;
#pragma unroll
    for (int db = 0; db < 8; ++db) f.v[db] = *(const bf16x8*)(vp + db * 512);
}
template <int MODE>
__device__ __forceinline__ void step_fragb(const bf16x8 (&qf)[4], bf16x8 (&kf)[2][4], FragV& cur, const bf16_t* __restrict__ KF, const bf16_t* __restrict__ VF,
                                           int pos0, int pnext, int lo, int hi, AState& st, int lane, LAS float* imp) {
    const int kq = lane >> 4;
    f32x4 sa[2] = {(f32x4){0.f, 0.f, 0.f, 0.f}, (f32x4){0.f, 0.f, 0.f, 0.f}};
#pragma unroll
    for (int T = 0; T < 2; ++T)
#pragma unroll
        for (int s2 = 0; s2 < 4; ++s2) sa[T] = __builtin_amdgcn_mfma_f32_16x16x32_bf16(kf[T][s2], qf[s2], sa[T], 0, 0, 0);
    load_fk(kf, KF, pnext, lane);
    float sc[8]; bool vd[8]; float mx = -1e30f;
#pragma unroll
    for (int T = 0; T < 2; ++T)
#pragma unroll
        for (int r = 0; r < 4; ++r) { const int p = pos0 + 16 * T + 4 * kq + r; const bool v = (p >= lo) & (p <= hi); const float x = sa[T][r] * SL2;
            sc[4 * T + r] = x; vd[4 * T + r] = v; mx = v ? fmaxf(mx, x) : mx; }
    float p[8];
    if (MODE == 2) {
        const int l16 = lane & 15;
#pragma unroll
        for (int j = 0; j < 8; ++j) p[j] = vd[j] ? __builtin_amdgcn_exp2f(sc[j] - st.m) * st.l : 0.f;
#pragma unroll
        for (int T = 0; T < 2; ++T) {
            float x = 2.f * (p[4 * T] + p[4 * T + 1] + p[4 * T + 2]) + p[4 * T + 3], y = p[4 * T + 3];
            x += quad_xor1(x); x += quad_xor2(x); y += quad_xor1(y); y += quad_xor2(y);
            if ((l16 & 3) == 0) { const int a = (pos0 >> 2) + 4 * T + kq; LAS float* ip = imp + (l16 >> 2) * IMP_LD + a;
                ip[0] += x;
                asm volatile("s_waitcnt lgkmcnt(0)" ::: "memory");
                ip[1] += y; }
            asm volatile("s_waitcnt lgkmcnt(0)" ::: "memory");
        }
    } else {
        if (__builtin_amdgcn_ballot_w64(mx > st.m + 40.f) != 0ull) {
            mx = fmaxf(mx, __shfl_xor(mx, 16)); mx = fmaxf(mx, __shfl_xor(mx, 32));
            const float mn = fmaxf(st.m, mx), alpha = __builtin_amdgcn_exp2f(st.m - mn); st.m = mn; st.l *= alpha;
            if (MODE == 0) {
#pragma unroll
                for (int j = 0; j < 8; ++j) st.o[j] = st.o[j] * alpha;
            }
        }
        float ps = 0.f;
#pragma unroll
        for (int j = 0; j < 8; ++j) { p[j] = vd[j] ? __builtin_amdgcn_exp2f(sc[j] - st.m) : 0.f; ps += p[j]; }
        st.l += ps;
    }
    if (MODE != 1) {
        u32x4 pw; pw.x = cvt_pk_bf16(p[0], p[1]); pw.y = cvt_pk_bf16(p[2], p[3]); pw.z = cvt_pk_bf16(p[4], p[5]); pw.w = cvt_pk_bf16(p[6], p[7]);
        const bf16x8 pf = __builtin_bit_cast(bf16x8, pw);
#pragma unroll
        for (int db = 0; db < 8; ++db) st.o[db] = __builtin_amdgcn_mfma_f32_16x16x32_bf16(cur.v[db], pf, st.o[db], 0, 0, 0);
        load_fv(cur, VF, pnext, lane);
    }
}
template <int MODE, bool SLC, class Desc>
__device__ __forceinline__ void attn_run_frag(const bf16x8 (&qf)[4], const bf16_t* __restrict__ KF, const bf16_t* __restrict__ VF, const Desc& desc, int n,
                                              int lo_in, int hi, int qi, AState& st, int lane, LAS float* imp = nullptr) {
    static_assert(!SLC, "the bf16 fragment walk is used without per-step query selection");
    if (n <= 0) return;
    bf16x8 kf[2][4]; FragV va;
    int d0 = desc(0);
    load_fk(kf, KF, d0, lane);
    if (MODE != 1) load_fv(va, VF, d0, lane);
#pragma unroll 1
    for (int i = 0; i < n; ++i) {
        const int d1 = desc(i + 1 < n ? i + 1 : i);
        step_fragb<MODE>(qf, kf, va, KF, VF, d0, d1, lo_in, hi, st, lane, imp);
        d0 = d1;
    }
}
struct Frag8 { i64_t k[2][4]; i64_t v[8]; };
__device__ __forceinline__ void load_frag8(Frag8& f, const unsigned char* __restrict__ KF, const unsigned char* __restrict__ VF, int pos0, int lane) {
    const unsigned char* kp = KF + ((size_t)(pos0 >> 4) * 256 + lane) * 8; const unsigned char* vp = VF + ((size_t)(pos0 >> 5) * 512 + lane) * 8;
#pragma unroll
    for (int T = 0; T < 2; ++T)
#pragma unroll
        for (int s2 = 0; s2 < 4; ++s2) f.k[T][s2] = *(const i64_t*)(kp + (T * 4 + s2) * 512);
#pragma unroll
    for (int db = 0; db < 8; ++db) f.v[db] = *(const i64_t*)(vp + db * 512);
}
template <bool SLC, bool NOMASK>
__device__ __forceinline__ void step_frag8(const i64_t (&qf)[4], const Frag8& cur, Frag8& nxt, const unsigned char* __restrict__ KF, const unsigned char* __restrict__ VF,
                                           int dcur, int dnext, int lo_in, int hi, int qi, AState& st, int lane) {
    const int kq = lane >> 4;
    const int pos0 = SLC ? (dcur & 0xfffff) : dcur;
    const int lo = SLC ? ((((dcur >> 20) == qi) | ((dcur >> 20) == 4)) ? 0 : (1 << 30)) : lo_in;
    load_frag8(nxt, KF, VF, SLC ? (dnext & 0xfffff) : dnext, lane);
    f32x4 sa[2] = {(f32x4){0.f, 0.f, 0.f, 0.f}, (f32x4){0.f, 0.f, 0.f, 0.f}};
#pragma unroll
    for (int T = 0; T < 2; ++T)
#pragma unroll
        for (int s2 = 0; s2 < 4; ++s2) sa[T] = __builtin_amdgcn_mfma_f32_16x16x32_fp8_fp8(cur.k[T][s2], qf[s2], sa[T], 0, 0, 0);
    float sc[8]; bool vd[8]; float mx = -1e30f;
    const bool act = lo == 0 || !SLC;
    if (NOMASK) {
#pragma unroll
        for (int j = 0; j < 8; ++j) { sc[j] = sa[j >> 2][j & 3]; vd[j] = act; }
        mx = fmaxf(fmaxf(fmaxf(sc[0], sc[1]), fmaxf(sc[2], sc[3])), fmaxf(fmaxf(sc[4], sc[5]), fmaxf(sc[6], sc[7])));
        mx = act ? mx : -1e30f;
    } else {
#pragma unroll
        for (int T = 0; T < 2; ++T)
#pragma unroll
            for (int r = 0; r < 4; ++r) { const int p = pos0 + 16 * T + 4 * kq + r; const bool v = (p >= lo) & (p <= hi); const float x = sa[T][r];
                sc[4 * T + r] = x; vd[4 * T + r] = v; mx = v ? fmaxf(mx, x) : mx; }
    }
    if (__builtin_amdgcn_ballot_w64(mx > st.m + 4.f) != 0ull) {
        mx = fmaxf(mx, __shfl_xor(mx, 16)); mx = fmaxf(mx, __shfl_xor(mx, 32));
        const float mn = fmaxf(st.m, mx), alpha = __builtin_amdgcn_exp2f(st.m - mn); st.m = mn; st.l *= alpha;
#pragma unroll
        for (int j = 0; j < 8; ++j) st.o[j] = st.o[j] * alpha;
    }
    f32x4 pa, pb; float ps = 0.f;
    const float mref = st.m - 4.f;
    if (NOMASK) {
#pragma unroll
        for (int j = 0; j < 4; ++j) { pa[j] = __builtin_amdgcn_exp2f(sc[j] - mref); pb[j] = __builtin_amdgcn_exp2f(sc[4 + j] - mref); }
        if (SLC) {
#pragma unroll
            for (int j = 0; j < 4; ++j) { pa[j] = act ? pa[j] : 0.f; pb[j] = act ? pb[j] : 0.f; }
        }
#pragma unroll
        for (int j = 0; j < 4; ++j) ps += pa[j] + pb[j];
    } else {
#pragma unroll
        for (int j = 0; j < 4; ++j) { pa[j] = vd[j] ? __builtin_amdgcn_exp2f(sc[j] - mref) : 0.f; pb[j] = vd[4 + j] ? __builtin_amdgcn_exp2f(sc[4 + j] - mref) : 0.f; ps += pa[j] + pb[j]; }
    }
    st.l += ps;
    const u32x2 pw = pack8_fp8(pa, pb);
    const i64_t pf = __builtin_bit_cast(i64_t, pw);
#pragma unroll
    for (int db = 0; db < 8; ++db) st.o[db] = __builtin_amdgcn_mfma_f32_16x16x32_fp8_fp8(cur.v[db], pf, st.o[db], 0, 0, 0);
}
template <bool SLC, class Desc>
__device__ __forceinline__ void attn_run_frag8(const i64_t (&qf)[4], const unsigned char* __restrict__ KF, const unsigned char* __restrict__ VF, const Desc& desc, int n,
                                               int lo_in, int hi, int qi, AState& st, int lane) {
    if (n <= 0) return;
    Frag8 fa, fb, fc;
    constexpr int NM = ~(1 << 30);
    int d0 = desc(0), d1 = desc(n > 1 ? 1 : 0);
    load_frag8(fa, KF, VF, SLC ? (d0 & 0xfffff) : (d0 & NM), lane);
    load_frag8(fb, KF, VF, SLC ? (d1 & 0xfffff) : (d1 & NM), lane);
#define F8_STEP(CUR, NXT2, DC, DN2) do { \
        if ((DC) & (1 << 30)) step_frag8<SLC, true>(qf, CUR, NXT2, KF, VF, (DC) & NM, (DN2) & NM, lo_in, hi, qi, st, lane); \
        else step_frag8<SLC, false>(qf, CUR, NXT2, KF, VF, (DC), (DN2) & NM, lo_in, hi, qi, st, lane); } while (0)
#pragma unroll 1
    for (int i = 0; i < n; i += 3) {
        const int d2 = desc(i + 2 < n ? i + 2 : n - 1);
        F8_STEP(fa, fc, d0, d2);
        if (i + 1 >= n) break;
        const int d3 = desc(i + 3 < n ? i + 3 : n - 1);
        F8_STEP(fb, fa, d1, d3);
        if (i + 2 >= n) break;
        const int d4 = desc(i + 4 < n ? i + 4 : n - 1);
        F8_STEP(fc, fb, d2, d4);
        d0 = d3; d1 = d4;
    }
#undef F8_STEP
}
__device__ __forceinline__ float quad_total(float v) { v += __shfl_xor(v, 16); v += __shfl_xor(v, 32); return v; }

__device__ __forceinline__ void dilated_unit(int unit, const bf16_t* proj, const bf16_t* kbf, bf16_t* nsaout, int lane) {
    const int l16 = lane & 15, kq = lane >> 4;
    const int hg = (unit >> 4) & 3, r16 = unit & 15, ut = unit >> 6;
    const int t0 = r16 + 256 * ut, tc = t0 + 16 * l16;
    const unsigned char* kb8 = (const unsigned char*)kbf; const unsigned char* vb8 = kb8 + ((size_t)24 << 20);
    AState st; astate_init(st);
#pragma unroll 1
    for (int pt = 0; pt < 3; ++pt) {
        const int sh = 2 * pt, head = 4 * pt + hg;
        const bf16_t* qrow = proj + (size_t)tc * PLD + PC_QB + head * 128 + 8 * kq;
        i64_t q8[4];
#pragma unroll
        for (int s = 0; s < 4; ++s) { const bf16x8 qv = *(const bf16x8*)(qrow + 32 * s); f32x4 a, b;
#pragma unroll
            for (int j = 0; j < 4; ++j) { a[j] = bf2f((unsigned short)qv[j]) * SL2; b[j] = bf2f((unsigned short)qv[4 + j]) * SL2; }
            q8[s] = __builtin_bit_cast(i64_t, pack8_fp8(a, b)); }
        const int base = (r16 & ((1 << sh) - 1)) << (14 - sh), u0 = t0 >> sh, ui = u0 + (16 >> sh) * l16;
        const int lo = base + (ui - 128 < 0 ? 0 : ui - 128), hi = base + ui;
        const int first = (base + (u0 - 128 < 0 ? 0 : u0 - 128)) >> 5, last = (base + u0 + 15 * (16 >> sh)) >> 5;
        unsigned long long hoff = (unsigned long long)head * S * 128; asm volatile("" : "+s"(hoff));
        auto desc = [&](int i) { return 32 * (first + i); };
        attn_run_frag8<false>(q8, kb8 + hoff, vb8 + hoff, desc, last - first + 1, lo, hi, 0, st, lane);
    }
    const float lt = quad_total(st.l), inv = lt > 0.f ? 1.f / lt : 0.f;
    bf16_t* op = nsaout + (size_t)tc * NOLD + 1024 + hg * 128 + 4 * kq;
#pragma unroll
    for (int db = 0; db < 8; ++db) { const f32x4 o = st.o[db] * inv; u32x2 w; w.x = cvt_pk_bf16(o[0], o[1]); w.y = cvt_pk_bf16(o[2], o[3]); *(u32x2*)(op + 16 * db) = w; }
}

__device__ __forceinline__ void compress_unit(int unit, const bf16_t* proj, const bf16_t* w1t, const bf16_t* w2t, const float* bias, bf16_t* outc, LAS unsigned char* lds, int wave, int lane) {
    const int l16 = lane & 15, kq = lane >> 4;
    const int rt = unit & 63, g = (unit >> 6) & 1, kv = unit >> 7;
    const bf16_t* raw = proj + (kv ? PC_VC : PC_KC) + 128 * g;
    const int n = 16 * rt + l16;
    f32x4 acc[16];
#pragma unroll
    for (int i = 0; i < 16; ++i) acc[i] = (f32x4){0.f, 0.f, 0.f, 0.f};
#pragma unroll 2
    for (int si = 0; si < 16; ++si) {
        const int s = 16 * wave + si;
        const int tok = clampi(16 * n + (s >> 2), 0, S - 1);
        const bf16x8 af = *(const bf16x8*)(raw + (size_t)tok * PLD + (s & 3) * 32 + 8 * kq);
#pragma unroll
        for (int ct = 0; ct < 16; ++ct) { const bf16x8 bfr = *(const bf16x8*)(w1t + ((size_t)(ct * 128 + s) * 64 + lane) * 8);
            acc[ct] = __builtin_amdgcn_mfma_f32_16x16x32_bf16(af, bfr, acc[ct], 0, 0, 0); }
    }
    LAS f32x4* part = (LAS f32x4*)lds;
#pragma unroll
    for (int ct = 0; ct < 16; ++ct) part[(wave * 16 + ct) * 64 + lane] = acc[ct];
    __syncthreads();
    LAS unsigned char* hid = lds + 131072;
#pragma unroll
    for (int c2 = 0; c2 < 2; ++c2) { const int ct = 2 * wave + c2; f32x4 sum = (f32x4){0.f, 0.f, 0.f, 0.f};
#pragma unroll
        for (int w = 0; w < 8; ++w) sum += part[(w * 16 + ct) * 64 + lane];
        const float bb = bias[16 * ct + l16];
#pragma unroll
        for (int r = 0; r < 4; ++r) { const float x = sum[r] + bb; const float u2 = 1.5957691216f * (x + 0.044715f * x * x * x); const float gl = x * fsigmoid(u2);
            *(LAS bf16_t*)(hid + (4 * kq + r) * 528 + (16 * ct + l16) * 2) = (bf16_t)(cvt_pk_bf16(gl, 0.f) & 0xffffu); } }
    __syncthreads();
    f32x4 o2 = (f32x4){0.f, 0.f, 0.f, 0.f};
    const int dt = wave;
#pragma unroll
    for (int s = 0; s < 8; ++s) {
        const bf16x8 af = *(const LAS bf16x8*)(hid + l16 * 528 + (32 * s + 8 * kq) * 2);
        const bf16x8 bfr = *(const bf16x8*)(w2t + (size_t)(16 * dt + l16) * 256 + 32 * s + 8 * kq);
        o2 = __builtin_amdgcn_mfma_f32_16x16x32_bf16(af, bfr, o2, 0, 0, 0);
    }
#pragma unroll
    for (int r = 0; r < 4; ++r) { const int nn = 16 * rt + 4 * kq + r, d = 16 * dt + l16;
        const bf16_t val = (bf16_t)(cvt_pk_bf16(o2[r], 0.f) & 0xffffu);
        if (kv == 0) outc[(((size_t)g * 64 + (nn >> 4)) * 4 + (d >> 5)) * 512 + (((d >> 3) & 3) * 16 + (nn & 15)) * 8 + (d & 7)] = val;
        else { const int kp = nn & 31; outc[(((size_t)g * 32 + (nn >> 5)) * 8 + (d >> 4)) * 512 + ((((kp >> 2) & 3) * 16) + (d & 15)) * 8 + 4 * (kp >> 4) + (kp & 3)] = val; } }
    __syncthreads();
}

__device__ __forceinline__ void nsa_unit(int unit, const bf16_t* proj, const bf16_t* kc, const bf16_t* vc, const bf16_t* gn, const float* cs, const float* sn,
                                         const bf16_t* kslf, const bf16_t* vslf, const bf16_t* kwnf, const bf16_t* vwnf, bf16_t* nsaout, LAS unsigned char* wl, int lane) {
    const int l16 = lane & 15, kq = lane >> 4;
    const int g = unit & 1, tb = unit >> 1, t0 = 4 * tb, qi = l16 >> 2, h = l16 & 3, tc = t0 + qi, head = 4 * g + h;
    LAS unsigned char* vbuf = wl; LAS float* imp = (LAS float*)(wl + VBUF_BYTES); LAS int* sel = (LAS int*)(wl + VBUF_BYTES + 4 * IMP_LD * 4);
    bf16x8 qf[4];
    { const bf16_t* qrow = proj + (size_t)tc * PLD + PC_QA + head * 128 + 8 * kq;
#pragma unroll
        for (int s = 0; s < 4; ++s) qf[s] = *(const bf16x8*)(qrow + 32 * s); }
    LAS u32x2* outl = (LAS u32x2*)(wl + OUT_OFF) + lane;
    for (int i = lane; i < 4 * IMP_LD; i += 64) imp[i] = 0.f;
    const int hic = (tc - 31) >> 4;
    const int nkmax = ((t0 + 3 - 31) >> 4) + 1, nsc = nkmax > 0 ? (nkmax + 31) >> 5 : 0;
    unsigned long long coff = (unsigned long long)g * 1024 * 128; asm volatile("" : "+s"(coff));
    const bf16_t* kcg = kc + coff; const bf16_t* vcg = vc + coff;
    AState st; astate_init(st);
    { auto desc = [&](int i) { return 32 * i; };
      attn_run_frag<1, false>(qf, kcg, vcg, desc, nsc, 0, hic, 0, st, lane);
      { const float lt = quad_total(st.l); st.l = lt > 0.f ? 1.f / lt : 0.f; }
      asm volatile("s_waitcnt lgkmcnt(0)" ::: "memory");
      attn_run_frag<2, false>(qf, kcg, vcg, desc, nsc, 0, hic, 0, st, lane, imp); }
    const float g0 = bf2f(gn[(size_t)tc * 32 + head * 3 + 0]);
#pragma unroll
    for (int i = 0; i < 8; ++i) { const f32x4 o = st.o[i] * g0; u32x2 w; w.x = cvt_pk_bf16(o[0], o[1]); w.y = cvt_pk_bf16(o[2], o[3]); outl[64 * i] = w; }
    asm volatile("s_waitcnt lgkmcnt(0)" ::: "memory");
#pragma unroll
    for (int s2 = 0; s2 < 2; ++s2) {
        const int d = 32 * s2 + 8 * kq; f32x4 c[2], sv[2];
        c[0] = *(const f32x4*)(cs + (size_t)tc * 64 + d); c[1] = *(const f32x4*)(cs + (size_t)tc * 64 + d + 4);
        sv[0] = *(const f32x4*)(sn + (size_t)tc * 64 + d); sv[1] = *(const f32x4*)(sn + (size_t)tc * 64 + d + 4);
        float o1[8], o2[8];
#pragma unroll
        for (int j = 0; j < 8; ++j) { const float x1 = bf2f((unsigned short)qf[s2][j]), x2 = bf2f((unsigned short)qf[s2 + 2][j]), cc = c[j >> 2][j & 3], ss = sv[j >> 2][j & 3];
            o1[j] = x1 * cc - x2 * ss; o2[j] = x2 * cc + x1 * ss; }
        u32x4 w1, w2; w1.x = cvt_pk_bf16(o1[0], o1[1]); w1.y = cvt_pk_bf16(o1[2], o1[3]); w1.z = cvt_pk_bf16(o1[4], o1[5]); w1.w = cvt_pk_bf16(o1[6], o1[7]);
        w2.x = cvt_pk_bf16(o2[0], o2[1]); w2.y = cvt_pk_bf16(o2[2], o2[3]); w2.z = cvt_pk_bf16(o2[4], o2[5]); w2.w = cvt_pk_bf16(o2[6], o2[7]);
        qf[s2] = __builtin_bit_cast(bf16x8, w1); qf[s2 + 2] = __builtin_bit_cast(bf16x8, w2);
    }
    unsigned key[4][4];
#pragma unroll
    for (int q = 0; q < 4; ++q) { const int cur = (t0 + q) >> 6; const f32x4 v = *(const LAS f32x4*)(imp + q * IMP_LD + 4 * lane);
#pragma unroll
        for (int i = 0; i < 4; ++i) { const int j = 4 * lane + i; const bool valid = j <= cur, forced = (j == 0) | (j == cur) | (j == cur - 1);
            const unsigned kb = forced ? 0xffffffu : ((__float_as_uint(fmaxf(v[i], 0.f)) >> 8) + 1u);
            key[q][i] = valid ? ((kb << 8) | (unsigned)(255 - j)) : 0u; } }
#pragma unroll 1
    for (int r = 0; r < 16; ++r) {
        unsigned mx[4];
#pragma unroll
        for (int q = 0; q < 4; ++q) { unsigned a = key[q][0] > key[q][1] ? key[q][0] : key[q][1], b = key[q][2] > key[q][3] ? key[q][2] : key[q][3]; mx[q] = a > b ? a : b; }
#pragma unroll
        for (int o = 1; o < 64; o <<= 1)
#pragma unroll
            for (int q = 0; q < 4; ++q) { const unsigned other = (unsigned)__shfl_xor((int)mx[q], o); mx[q] = other > mx[q] ? other : mx[q]; }
#pragma unroll
        for (int q = 0; q < 4; ++q) {
#pragma unroll
            for (int i = 0; i < 4; ++i) if (key[q][i] == mx[q]) key[q][i] = 0u;
            if (lane == 0) sel[q * 16 + r] = mx[q] ? (int)(255u - (mx[q] & 255u)) : -1;
        }
    }
    asm volatile("s_waitcnt lgkmcnt(0)" ::: "memory");
    i64_t q8[4];
#pragma unroll
    for (int s2 = 0; s2 < 4; ++s2) { f32x4 a, b;
#pragma unroll
        for (int j = 0; j < 4; ++j) { a[j] = bf2f((unsigned short)qf[s2][j]) * SL2; b[j] = bf2f((unsigned short)qf[s2][4 + j]) * SL2; }
        q8[s2] = __builtin_bit_cast(i64_t, pack8_fp8(a, b)); }
    LAS int* list = (LAS int*)(wl + VBUF_BYTES + 4 * IMP_LD * 4 + 256);
    int nslc;
    { const int b = sel[lane], q = lane >> 4, cur0 = t0 >> 6;
      const bool forced = (b == 0) | (b == cur0) | (b == cur0 - 1);
      const bool valid = (b >= 0) & !(forced & (q > 0)); const unsigned long long mask = __ballot(valid);
      const int idx = __popcll(mask & ((1ull << lane) - 1ull)); nslc = 2 * __popcll(mask);
      if (valid) { const int qc = (forced ? 4 : q) | (b < cur0 ? (1 << 10) : 0);
                   list[2 * idx] = (64 * b) | (qc << 20); list[2 * idx + 1] = (64 * b + 32) | (qc << 20); } }
    asm volatile("s_waitcnt lgkmcnt(0)" ::: "memory");
    astate_init(st);
    { auto desc = [&](int i) { return __builtin_amdgcn_readfirstlane(list[i]); };
      unsigned long long goff = (unsigned long long)g * S * 128; asm volatile("" : "+s"(goff));
      attn_run_frag8<true>(q8, (const unsigned char*)kslf + goff, (const unsigned char*)kslf + ((size_t)8 << 20) + goff, desc, nslc, 0, tc, qi, st, lane); }
    { const float g1 = bf2f(gn[(size_t)tc * 32 + head * 3 + 1]); const float lt = quad_total(st.l), inv = (lt > 0.f ? 1.f / lt : 0.f) * g1;
#pragma unroll
        for (int i = 0; i < 8; ++i) { const f32x4 o = st.o[i] * inv; u32x2 w = outl[64 * i]; w.x = cvt_pk_bf16(bflo(w.x) + o[0], bfhi(w.x) + o[1]); w.y = cvt_pk_bf16(bflo(w.y) + o[2], bfhi(w.y) + o[3]); outl[64 * i] = w; } }
    astate_init(st);
    { const int lo = tc - 511 < 0 ? 0 : tc - 511; const int first = t0 < 511 ? 0 : (t0 - 511) >> 5, last = (t0 + 3) >> 5;
      auto desc = [&](int i) { const int p0 = 32 * (first + i); return p0 | ((p0 >= t0 + 3 - 511 && p0 + 31 <= t0) ? (1 << 30) : 0); };
      unsigned long long goff = (unsigned long long)g * S * 128; asm volatile("" : "+s"(goff));
      attn_run_frag8<false>(q8, (const unsigned char*)kslf + ((size_t)16 << 20) + goff, (const unsigned char*)kslf + ((size_t)24 << 20) + goff, desc, last - first + 1, lo, tc, 0, st, lane); }
    { const float g2 = bf2f(gn[(size_t)tc * 32 + head * 3 + 2]); const float lt = quad_total(st.l), inv = (lt > 0.f ? 1.f / lt : 0.f) * g2;
#pragma unroll
        for (int i = 0; i < 8; ++i) { const f32x4 o = st.o[i] * inv; u32x2 w = outl[64 * i]; w.x = cvt_pk_bf16(bflo(w.x) + o[0], bfhi(w.x) + o[1]); w.y = cvt_pk_bf16(bflo(w.y) + o[2], bfhi(w.y) + o[3]); outl[64 * i] = w; } }
    bf16_t* op = nsaout + (size_t)tc * NOLD + head * 128 + 4 * kq;
#pragma unroll
    for (int db = 0; db < 8; ++db) *(u32x2*)(op + 16 * db) = outl[64 * db];
}


#define XB_TMO      128
#define XB_XCNT(j)  (256  + 64 * (j))
#define XB_XSUB(j)  (1280 + 64 * (j))
#define XB_XGEN(j)  (2304 + 64 * (j))
#define XB_TOP      3328
#define XB_TOPGEN   3392
#define XCD_BAR_WORDS 3456
#define XB_SPIN_CAP (1u << 18)
__device__ __forceinline__ unsigned xb_ld(unsigned* p)              { return __hip_atomic_load(p, __ATOMIC_RELAXED, __HIP_MEMORY_SCOPE_AGENT); }
__device__ __forceinline__ unsigned xb_add(unsigned* p, unsigned v) { return __hip_atomic_fetch_add(p, v, __ATOMIC_RELAXED, __HIP_MEMORY_SCOPE_AGENT); }
__device__ __forceinline__ unsigned xb_xcc_id() { return (unsigned)__builtin_amdgcn_s_getreg((3 << 11) | 20) & 0xFu; }
#define XB_SPIN(cond, bar) do { unsigned _sp = 0; while (cond) { __builtin_amdgcn_s_sleep(1); \
    if ((++_sp & 255u) == 0u) { if (xb_ld(&(bar)[XB_TMO])) break; if (_sp > XB_SPIN_CAP) { atomicAdd(&(bar)[XB_TMO], 1u); break; } } } } while (0)
struct XcdBarrier { unsigned* bar; unsigned x; volatile LAS unsigned* st; };
__device__ __forceinline__ XcdBarrier xcd_barrier_post(unsigned* bar, volatile LAS unsigned* st) {
    XcdBarrier b; b.bar = bar; b.x = xb_xcc_id(); b.st = st;
    if (threadIdx.x == 0) st[2] = xb_add(&bar[XB_XCNT(b.x)], 1u);
    return b;
}
__device__ __forceinline__ void xcd_barrier_complete(unsigned* bar, unsigned x, unsigned& nloc, unsigned& nx) {
    const unsigned G = gridDim.x * gridDim.y * gridDim.z;
    unsigned sum, cnt, mine, sp = 0u;
    for (;;) {
        sum = 0u; cnt = 0u; mine = 0u;
#pragma unroll
        for (unsigned j = 0; j < 16; ++j) { const unsigned c = xb_ld(&bar[XB_XCNT(j)]); sum += c; cnt += (c > 0u) ? 1u : 0u; mine = (j == x) ? c : mine; }
        if (sum == G) break;
        __builtin_amdgcn_s_sleep(1);
        if ((++sp & 255u) == 0u) { if (xb_ld(&bar[XB_TMO])) break; if (sp > XB_SPIN_CAP) { atomicAdd(&bar[XB_TMO], 1u); break; } }
    }
    nloc = mine > 0u ? mine : 1u; nx = cnt > 0u ? cnt : 1u;
}
__device__ __forceinline__ void xcd_barrier(const XcdBarrier& b, const int tid) {
    asm volatile("s_waitcnt vmcnt(0)" ::: "memory");
    __syncthreads();
    if (tid == 0) {
        unsigned* bar = b.bar;
        __builtin_amdgcn_s_waitcnt(0);
        unsigned nloc = b.st[0], nx = b.st[1];
        if (nloc == 0u) { xcd_barrier_complete(bar, b.x, nloc, nx); b.st[0] = nloc; b.st[1] = nx; }
        const unsigned old = xb_add(&bar[XB_XSUB(b.x)], 1u);
        const unsigned gen = old / nloc;
        if (old + 1u == (gen + 1u) * nloc) {
            __builtin_amdgcn_fence(__ATOMIC_RELEASE, "agent");
            asm volatile("s_waitcnt vmcnt(0)" ::: "memory");
            const unsigned og = xb_add(&bar[XB_TOP], 1u);
            const unsigned tg = og / nx;
            if (og + 1u == (tg + 1u) * nx) xb_add(&bar[XB_TOPGEN], 1u);
            else XB_SPIN(xb_ld(&bar[XB_TOPGEN]) == tg, bar);
            __builtin_amdgcn_fence(__ATOMIC_ACQUIRE, "agent");
            xb_add(&bar[XB_XGEN(b.x)], 1u);
            asm volatile("s_waitcnt vmcnt(0)" ::: "memory");
        } else {
            XB_SPIN(xb_ld(&bar[XB_XGEN(b.x)]) == gen, bar);
            __builtin_amdgcn_fence(__ATOMIC_ACQUIRE, "agent");
            asm volatile("s_waitcnt vmcnt(0)" ::: "memory");
        }
    }
    __syncthreads();
}

__device__ __forceinline__ void gate_tile(int tile, const bf16_t* __restrict__ hb, const bf16_t* __restrict__ wgf, bf16_t* __restrict__ gn, int lane) {
    const int l16 = lane & 15, kq = lane >> 4;
    const bf16_t* ap = hb + (size_t)(16 * tile + l16) * DM + 8 * kq; const bf16_t* bp = wgf + (size_t)lane * 8;
    f32x4 acc[2] = {(f32x4){0.f, 0.f, 0.f, 0.f}, (f32x4){0.f, 0.f, 0.f, 0.f}};
#pragma unroll 8
    for (int s2 = 0; s2 < 64; ++s2) {
        const bf16x8 af = *(const bf16x8*)(ap + 32 * s2);
        const bf16x8 b0 = *(const bf16x8*)(bp + (size_t)s2 * 512), b1 = *(const bf16x8*)(bp + (size_t)(64 + s2) * 512);
        acc[0] = __builtin_amdgcn_mfma_f32_16x16x32_bf16(af, b0, acc[0], 0, 0, 0); acc[1] = __builtin_amdgcn_mfma_f32_16x16x32_bf16(af, b1, acc[1], 0, 0, 0);
    }
#pragma unroll
    for (int ct = 0; ct < 2; ++ct)
#pragma unroll
        for (int r = 0; r < 4; ++r) gn[(size_t)(16 * tile + 4 * kq + r) * 32 + 16 * ct + l16] = (bf16_t)(cvt_pk_bf16(fsigmoid(acc[ct][r]), 0.f) & 0xffffu);
}

struct Params { const float* in[23]; float* out; unsigned char* ws; float inv_freq[64]; };

__global__ void __launch_bounds__(512, 2) fwd_megakernel(Params P) {
    extern __shared__ __attribute__((aligned(16))) unsigned char lds_raw[];
    LAS unsigned char* lds = (LAS unsigned char*)lds_raw;
    cg::grid_group grid = cg::this_grid();
    const int wave_s = __builtin_amdgcn_readfirstlane(threadIdx.x >> 6);
#define PHASE_WS unsigned long long wsv_ = (unsigned long long)P.ws; asm volatile("" : "+s"(wsv_)); unsigned char* ws = (unsigned char*)(__attribute__((address_space(1))) unsigned char*)wsv_; unsigned z_ = 0u; asm volatile("" : "+v"(z_)); const int tid = wave_s * 64 + (int)__builtin_amdgcn_mbcnt_hi(~0u, __builtin_amdgcn_mbcnt_lo(~0u, z_)); \
    const int lane = tid & 63, wave = __builtin_amdgcn_readfirstlane(tid >> 6), G = gridDim.x, gw = blockIdx.x * 8 + wave, ngw = G * 8; \
    const size_t gtid = (size_t)blockIdx.x * 512 + tid, gthreads = (size_t)G * 512; \
    LAS unsigned char* wl = lds + wave * WAVE_LDS; LAS float* scr = (LAS float*)wl; (void)lane; (void)gw; (void)ngw; (void)gtid; (void)gthreads; (void)wl; (void)scr
#define WAB ((bf16_t*)(ws + WS_WAB))
#define WO ((bf16_t*)(ws + WS_WO))
#define CW1K ((bf16_t*)(ws + WS_CW1K))
#define CW1V ((bf16_t*)(ws + WS_CW1V))
#define CW2K ((bf16_t*)(ws + WS_CW2K))
#define CW2V ((bf16_t*)(ws + WS_CW2V))
#define CBIAS ((float*)(ws + WS_CBIAS))
#define KC ((bf16_t*)(ws + WS_KC))
#define VC ((bf16_t*)(ws + WS_VC))
#define GN ((bf16_t*)(ws + WS_GN))
#define WGF ((bf16_t*)(ws + WS_WGF))
#define W8 ((unsigned char*)(ws + WS_WIN) + (size_t)7168 * DM * 2)
#define H8 ((unsigned char*)(ws + WS_BIG) + ((size_t)144 << 20))
#define ST1 ((float*)(ws + WS_ST1))
#define ST2 ((float*)(ws + WS_ST2))
#define HF ((float*)(ws + WS_HF))
#define HB ((bf16_t*)(ws + WS_HB))
#define GU ((bf16_t*)(ws + WS_GU))
#define DN ((bf16_t*)(ws + WS_DN))
#define ACT ((bf16_t*)(ws + WS_ACT))
#define PROJ ((bf16_t*)(ws + WS_PROJ))
#define KSLF ((bf16_t*)(ws + WS_KSLF))
#define KBF ((bf16_t*)(ws + WS_KBF))
#define VBF ((bf16_t*)(ws + WS_VBF))
#define VSLF ((bf16_t*)(ws + WS_VSLF))
#define KWNF ((bf16_t*)(ws + WS_KWNF))
#define VWNF ((bf16_t*)(ws + WS_VWNF))
#define RCOS ((float*)(ws + WS_ROPE))
#define RSIN ((float*)(ws + WS_ROPE) + (size_t)S * 64)
#define WINT ((bf16_t*)(ws + WS_WIN))
#define NSAOUT ((bf16_t*)(ws + WS_NSAOUT))
#define SIGG ((bf16_t*)P.out)
    pg8::StaticOrder SO;
#define CG_SYNC() do { asm volatile("s_waitcnt vmcnt(0) lgkmcnt(0)" ::: "memory"); grid.sync(); \
        if (__builtin_amdgcn_readfirstlane(threadIdx.x >> 6) == 0) { __builtin_amdgcn_fence(__ATOMIC_ACQUIRE, "agent"); asm volatile("s_waitcnt vmcnt(0)" ::: "memory"); } \
        __syncthreads(); } while (0)
    volatile LAS unsigned* xst = (volatile LAS unsigned*)(lds + 8 * WAVE_LDS);
    if (threadIdx.x < 2) xst[threadIdx.x] = 0u;
    __syncthreads();
    const XcdBarrier xbar = xcd_barrier_post((unsigned*)P.ws, xst);
    __syncthreads();
    const int vbid = (int)(xst[2] * 8u + xbar.x);
#define GRID_SYNC() do { asm volatile("s_waitcnt vmcnt(0) lgkmcnt(0)" ::: "memory"); unsigned zz_ = 0u; asm volatile("" : "+v"(zz_)); \
        xcd_barrier(xbar, wave_s * 64 + (int)__builtin_amdgcn_mbcnt_hi(~0u, __builtin_amdgcn_mbcnt_lo(~0u, zz_))); } while (0)

    { PHASE_WS;
        conv_ffn(P.in[1], P.in[2], P.in[3], GU, DN, scr, gw, ngw, lane);
        { const float* win = P.in[6]; bf16_t* wint = WINT;
          tr_stream(32 * 352, gw, ngw, [&](int it) { const int kb = it / 352, nb = it % 352, dr = nb * 32; const int sc = win_src_col(dr);
              if (dr < 7168) return TrP{win, WIN_SRC, kb * 64, sc, 32, wint, DM, dr, kb * 64, 0};
              return TrP{win, WIN_SRC, kb * 64, sc, 32, (bf16_t*)W8, DM, dr - 7168, kb * 64, 1}; }, scr, lane);
          for (int it = gw; it < 32; it += ngw) tr_item<true>(win, WIN_SRC, it * 64, 2560, 24, WGF, DM, 0, it * 64, scr, lane); }
        for (int it = gw; it < 16 * 64; it += ngw) { const int kb = it / 64, nb = it % 64; tr_item(P.in[13], DM, kb * 64, nb * 32, 32, WAB, 1024, nb * 32, kb * 64, scr, lane); }
        for (int it = gw; it < 8 * 64; it += ngw) { const int kb = it / 64, nb = it % 64; tr_item(P.in[14], DM, kb * 64, nb * 32, 32, WAB + (size_t)DM * 1024, 512, nb * 32, kb * 64, scr, lane); }
        for (int it = gw; it < 32 * 64; it += ngw) { const int kb = it / 64, nb = it % 64; tr_item(P.in[15], DM, kb * 64, nb * 32, 32, WO, DM, nb * 32, kb * 64, scr, lane); }
        for (int it = gw; it < 2 * 64 * 8; it += ngw) { const int w = it / 512, r = it % 512, kb = r / 8, nb = r % 8; tr_item<true>(w ? P.in[11] : P.in[8], 256, kb * 64, nb * 32, 32, w ? CW1V : CW1K, 4096, nb * 32, kb * 64, scr, lane); }
        for (int it = gw; it < 2 * 4 * 4; it += ngw) { const int w = it / 16, r = it % 16, kb = r / 4, nb = r % 4; tr_item(w ? P.in[12] : P.in[9], 128, kb * 64, nb * 32, 32, w ? CW2V : CW2K, 256, nb * 32, kb * 64, scr, lane); }
        { const float* x = P.in[0];
            constexpr size_t NX = (size_t)S * DM / 8;
            size_t i = gtid;
            for (; i + 3 * gthreads < NX; i += 4 * gthreads) {
                f32x4 a[4], b[4];
#pragma unroll
                for (int j = 0; j < 4; ++j) { a[j] = *(const f32x4*)(x + 8 * (i + j * gthreads)); b[j] = *(const f32x4*)(x + 8 * (i + j * gthreads) + 4); }
#pragma unroll
                for (int j = 0; j < 4; ++j) *(u32x4*)(HB + 8 * (i + j * gthreads)) = pack8(a[j], b[j]);
            }
            for (; i < NX; i += gthreads) { const f32x4 a = *(const f32x4*)(x + 8 * i), b = *(const f32x4*)(x + 8 * i + 4); *(u32x4*)(HB + 8 * i) = pack8(a, b); } }
        for (int o = gw; o < 512; o += ngw) { const int w = o >> 8, c = o & 255; const float* pos = w ? P.in[10] : P.in[7]; const float* w1 = w ? P.in[11] : P.in[8];
            float s = 0.f; for (int kk = lane; kk < 4096; kk += 64) s += pos[kk] * w1[(size_t)kk * 256 + c];
            s = wave_sum(s); if (lane == 0) CBIAS[o] = s; }
    }
    CG_SYNC();
    { PHASE_WS; pg8::Gemm g{HB, GU, S, NGU, DM, DM, DM}; SO.init(S, NGU, G, (int)blockIdx.x); EpiSwiglu E{ACT}; pg8::gemm_phase(lds, g, SO, E, tid); }
    GRID_SYNC();
    { PHASE_WS; pg8::Gemm g{ACT, DN, S, DM, FF, FF, FF}; SO.init(S, DM, G, (int)blockIdx.x); EpiResF32 E{P.in[0], HF, ALPHA, 0.5f}; pg8::gemm_phase(lds, g, SO, E, tid); }
    GRID_SYNC();
    { PHASE_WS;
        ln_rows(HF, nullptr, HB, P.in[4], P.in[5], gw, ngw, lane, ST1, H8);
        for (size_t i = gtid; i < (size_t)S * 64; i += gthreads) { const int t = (int)(i >> 6), j = (int)(i & 63); const float ang = (float)t * P.inv_freq[j]; RCOS[i] = cosf(ang); RSIN[i] = sinf(ang); }
    }
    GRID_SYNC();
    { PHASE_WS; pg8::Gemm g{HB, WINT, S, 7168, DM, DM, DM}; SO.init(S, 7168, G, (int)blockIdx.x); EpiWin E{PROJ, SIGG, GN, RCOS, KSLF, KBF, 0}; pg8::gemm_phase(lds, g, SO, E, tid); }
    { PHASE_WS; pg8::Gemm g{(const bf16_t*)H8, (const bf16_t*)W8, S, 4096, DM / 2, DM / 2, DM / 2}; SO.init(S, 4096, G, (int)blockIdx.x); EpiSig E{SIGG};
      pg8::gemm_phase<EpiSig, true>(lds, g, SO, E, tid); }
    GRID_SYNC();
    { PHASE_WS;
      int vb = (int)blockIdx.x;
      { bool ok = true; unsigned* cen = (unsigned*)P.ws;
#pragma unroll
        for (int j = 0; j < 8; ++j) ok &= (xb_ld(&cen[XB_XCNT(j)]) * 8u == (unsigned)G);
        if (ok) vb = vbid; }
        for (int t = gw; t < S / 16; t += ngw) gate_tile(t, HB, WGF, GN, lane);
        for (int u = blockIdx.x; u < 256; u += G) { const int kv = u >> 7; compress_unit(u, PROJ, kv ? CW1V : CW1K, kv ? CW2V : CW2K, CBIAS + 256 * kv, kv ? VC : KC, lds, wave, lane); }
        if ((G & 7) == 0) {
            const int x = vb & 7, lw = (vb >> 3) * 8 + wave, nlw = (G >> 3) * 8;
            for (int j = lw; j < 512; j += nlw) dilated_unit(64 * (x + 8 * (j >> 6)) + (j & 63), PROJ, KBF, NSAOUT, lane);
        } else { for (int u = gw; u < 4096; u += ngw) dilated_unit(u, PROJ, KBF, NSAOUT, lane); }
    }
    GRID_SYNC();
    { PHASE_WS;
      int vb = (int)blockIdx.x;
      { bool ok = true; unsigned* cen = (unsigned*)P.ws;
#pragma unroll
        for (int j = 0; j < 8; ++j) ok &= (xb_ld(&cen[XB_XCNT(j)]) * 8u == (unsigned)G);
        if (ok) vb = vbid; }
      if ((G & 7) == 0) {
          const int bx = vb, x = bx & 7, g = x & 1, wj = ((bx >> 3) * 4 + (x >> 1)) * 8 + wave, nwj = (G >> 1) * 8;
          for (int k = 0; k * nwj < 4096; ++k) {
              const int tb = k * nwj + ((k & 1) ? (nwj - 1 - wj) : wj);
              if (tb < 4096) nsa_unit(2 * tb + g, PROJ, KC, VC, GN, RCOS, RSIN, KSLF, VSLF, KWNF, VWNF, NSAOUT, wl, lane); }
      } else { for (int u = gw; u < 8192; u += ngw) nsa_unit(u, PROJ, KC, VC, GN, RCOS, RSIN, KSLF, VSLF, KWNF, VWNF, NSAOUT, wl, lane); } }
    GRID_SYNC();
    { PHASE_WS; SO.init(S, DM, G, (int)blockIdx.x);
      { pg8::Gemm g{NSAOUT, WAB, S, DM, 1024, NOLD, 1024}; EpiGate<true> E{SIGG, HB}; pg8::gemm_phase(lds, g, SO, E, tid); }
      { pg8::Gemm g{NSAOUT + 1024, WAB + (size_t)DM * 1024, S, DM, 512, NOLD, 512}; EpiGate<false> E{SIGG + 2048, HB}; pg8::gemm_phase(lds, g, SO, E, tid); } }
    GRID_SYNC();
    { PHASE_WS; pg8::Gemm g{HB, WO, S, DM, DM, DM, DM}; SO.init(S, DM, G, (int)blockIdx.x); EpiResLnF32 E{HF, ST1, P.in[4], P.in[5], HF, ALPHA, 1.0f}; pg8::gemm_phase(lds, g, SO, E, tid); }
    GRID_SYNC();
    { PHASE_WS;
        ln_rows(HF, nullptr, HB, P.in[16], P.in[17], gw, ngw, lane, ST2);
        conv_ffn(P.in[18], P.in[19], P.in[20], GU, DN, scr, gw, ngw, lane);
    }
    GRID_SYNC();
    { PHASE_WS; pg8::Gemm g{HB, GU, S, NGU, DM, DM, DM}; SO.init(S, NGU, G, (int)blockIdx.x); EpiSwiglu E{ACT}; pg8::gemm_phase(lds, g, SO, E, tid); }
    GRID_SYNC();
    { PHASE_WS; pg8::Gemm g{ACT, DN, S, DM, FF, FF, FF}; SO.init(S, DM, G, (int)blockIdx.x); EpiResLnF32 E{HF, ST2, P.in[16], P.in[17], P.out, ALPHA, 0.5f}; pg8::gemm_phase(lds, g, SO, E, tid); }
    GRID_SYNC();
    { PHASE_WS; (void)ws; ln_rows(P.out, P.out, nullptr, P.in[21], P.in[22], gw, ngw, lane); }
}

extern "C" void kernel_launch(void* const* d_in, const int* in_sizes, int n_in, void* d_out, int out_size, void* d_ws, size_t ws_size, hipStream_t stream) {
    static int grid = 0;
    if (grid == 0) {
        if (n_in != 23 || out_size != S * DM || ws_size < WS_END) { fprintf(stderr, "kernel_launch: unexpected shapes (n_in %d out %d ws %zu, need %zu)\n", n_in, out_size, ws_size, (size_t)WS_END); grid = -1; return; }
        int dev = 0, cus = 0, per_cu = 0;
        hipGetDevice(&dev); hipDeviceGetAttribute(&cus, hipDeviceAttributeMultiprocessorCount, dev);
        if (hipFuncSetAttribute((const void*)fwd_megakernel, hipFuncAttributeMaxDynamicSharedMemorySize, LDS_BYTES) != hipSuccess) { fprintf(stderr, "kernel_launch: hipFuncSetAttribute failed\n"); grid = -1; return; }
        if (hipOccupancyMaxActiveBlocksPerMultiprocessor(&per_cu, (const void*)fwd_megakernel, 512, LDS_BYTES) != hipSuccess || per_cu < 1) { fprintf(stderr, "kernel_launch: occupancy query failed (%d)\n", per_cu); (void)hipGetLastError(); per_cu = 1; }
        grid = cus * per_cu;
    }
    if (grid < 0) return;
    if (hipMemsetAsync(d_ws, 0, 16384, stream) != hipSuccess) { fprintf(stderr, "kernel_launch: memset of the barrier words failed\n"); return; }
    Params p{};
    for (int i = 0; i < 23; ++i) p.in[i] = (const float*)d_in[i];
    p.out = (float*)d_out; p.ws = (unsigned char*)d_ws;
    for (int i = 0; i < 64; ++i) p.inv_freq[i] = (float)pow(10000.0, -(double)i / 64.0);
    void* args[] = {&p};
    hipError_t e = hipLaunchCooperativeKernel((const void*)fwd_megakernel, dim3(grid), dim3(512), args, LDS_BYTES, stream);
    if (e != hipSuccess) fprintf(stderr, "kernel_launch: cooperative launch failed: %s (grid %d)\n", hipGetErrorString(e), grid);
}
```
